# Optimizing an MI355X kernel written in HIP

```python
import jax, jax.numpy as jnp
from jax import lax
import numpy as np

D_MODEL = 1024
BATCH = 16
SEQ = 256
DEPTH = 4
DEC_BATCH = 4
DEC_SEQ = 4096
PAST_LEN = 512

GRID_W = 64
D_MIX = D_MODEL
N_DIR = 2
RW_HEADS = 4
RW_HEAD = 64
RW_W = RW_HEADS * RW_HEAD
RW_DECAY_RANK = 64
RW_A_RANK = 64
RW_GATE_RANK = 128
RW_GN_EPS = 64e-5
RW_IN = 3 * RW_W + N_DIR * RW_DECAY_RANK + N_DIR * RW_A_RANK + RW_GATE_RANK
MLA_HEADS = 8
MLA_NOPE = 64
MLA_ROPE = 32
MLA_V = 64
MLA_Q_RANK = 256
MLA_KV_RANK = 128
MLA_W = MLA_HEADS * MLA_V
MLA_SCALE = (MLA_NOPE + MLA_ROPE) ** -0.5
ROPE_BASE = 10000.0
ROPE_AXIS_PAIRS = MLA_ROPE // 4
Q_BLOCK = 128
GM_GROUPS = 4
GM_GROUP_W = 64
GM_W = GM_GROUPS * GM_GROUP_W
CHUNK = 128
N_IN = RW_IN + MLA_Q_RANK + MLA_KV_RANK + MLA_ROPE + 2 * GM_W
D_FF = -(-8 * D_MODEL // (3 * 256)) * 256
ALPHA = (2 * DEPTH) ** 0.25
BETA = (8 * DEPTH) ** -0.25
F32 = jnp.float32

kernel_name = 'hybrid_rwkv7_mla_gmlp_diffusion_step'


def _layer_norm(x, g, b, eps=1e-5):
    xf = x.astype(F32)
    mu = jnp.mean(xf, -1, keepdims=True)
    var = jnp.mean(jnp.square(xf - mu), -1, keepdims=True)
    return ((xf - mu) * lax.rsqrt(var + eps) * g + b).astype(x.dtype)


def _rms_norm(x, g, eps=1e-6):
    xf = x.astype(F32)
    return (xf * lax.rsqrt(jnp.mean(xf * xf, -1, keepdims=True) + eps) * g).astype(x.dtype)


def _axial_rope_tables(n_tok):
    rows = n_tok // GRID_W
    rr, cc = jnp.meshgrid(jnp.arange(rows), jnp.arange(GRID_W), indexing='ij')
    rr = rr.reshape(-1).astype(F32)
    cc = cc.reshape(-1).astype(F32)
    inv = ROPE_BASE ** (-jnp.arange(ROPE_AXIS_PAIRS, dtype=F32) / ROPE_AXIS_PAIRS)
    ang = jnp.concatenate([rr[:, None] * inv, cc[:, None] * inv], -1)
    return jnp.cos(ang), jnp.sin(ang)


def _apply_rope(x, cos, sin):
    half = x.shape[-1] // 2
    x1 = x[..., :half].astype(F32)
    x2 = x[..., half:].astype(F32)
    return jnp.concatenate([x1 * cos - x2 * sin, x1 * sin + x2 * cos], -1).astype(x.dtype)


def _centred_conv3(z, w):
    zp = jnp.pad(z, ((0, 0), (1, 1), (0, 0)))
    return zp[:, :-2] * w[0] + zp[:, 1:-1] * w[1] + zp[:, 2:] * w[2]


def _adaln(cond, w, b):
    return jnp.einsum('bd,de->be', jax.nn.silu(cond), w) + b


def _split_proj(h, w_in, rw_conv):
    z = jnp.einsum('btd,dn->btn', h, w_in)
    z_rw = _centred_conv3(z[..., :RW_IN], rw_conv)
    o = RW_IN
    zq = z[..., o:o + MLA_Q_RANK]
    o += MLA_Q_RANK
    zkv = z[..., o:o + MLA_KV_RANK]
    o += MLA_KV_RANK
    zkr = z[..., o:o + MLA_ROPE]
    o += MLA_ROPE
    zu = z[..., o:o + GM_W]
    zv = z[..., o + GM_W:o + 2 * GM_W]
    return z_rw, zq, zkv, zkr, zu, zv


def _rwkv7_bidir(z, s0, p):
    B, T, _ = z.shape
    H, N = RW_HEADS, RW_HEAD
    r = z[..., :RW_W]
    k = z[..., RW_W:2 * RW_W]
    v = z[..., 2 * RW_W:3 * RW_W]
    o = 3 * RW_W
    xw = z[..., o:o + N_DIR * RW_DECAY_RANK].reshape(B, T, N_DIR, RW_DECAY_RANK)
    o += N_DIR * RW_DECAY_RANK
    xa = z[..., o:o + N_DIR * RW_A_RANK].reshape(B, T, N_DIR, RW_A_RANK)
    o += N_DIR * RW_A_RANK
    xg = z[..., o:o + RW_GATE_RANK]
    w_log = -jax.nn.softplus(-(p['rw_w0'] + jnp.einsum('btdr,drc->btdc', jnp.tanh(xw), p['rw_w2']))) - 0.5
    decay = jnp.exp(-jnp.exp(w_log.astype(F32)))
    a = jax.nn.sigmoid(p['rw_a0'] + jnp.einsum('btdr,drc->btdc', xa, p['rw_a2']))
    g = jnp.einsum('btr,rc->btc', jax.nn.sigmoid(xg), p['rw_g2'])
    kk = (k * p['rw_kk']).reshape(B, T, H, N).astype(F32)
    kk = kk * lax.rsqrt(jnp.maximum(jnp.sum(kk * kk, -1, keepdims=True), 1e-24))
    k_d = k[:, :, None, :] * (1 + (a - 1) * p['rw_ka'])

    def per_dir(t):
        return jnp.moveaxis(t.reshape(B, T, N_DIR, H, N).astype(F32), 2, 0)

    def shared(t):
        return jnp.broadcast_to(t.reshape(B, T, H, N).astype(F32), (N_DIR, B, T, H, N))

    def time_major(t):
        return jnp.moveaxis(jnp.stack([t[0], t[1][:, ::-1]]), 2, 0)

    xs = tuple(time_major(t) for t in (shared(r), per_dir(decay), per_dir(k_d), shared(v), shared(kk), per_dir(a)))

    def step(S, inp):
        r_t, w_t, k_t, v_t, kk_t, a_t = inp
        s_kk = jnp.einsum('dbhvk,dbhk->dbhv', S, -kk_t)
        S = S * w_t[..., None, :] + s_kk[..., :, None] * (kk_t * a_t)[..., None, :] + v_t[..., :, None] * k_t[..., None, :]
        return S, jnp.einsum('dbhvk,dbhk->dbhv', S, r_t)

    s_fin, out = lax.scan(step, s0.astype(F32), xs)
    out = jnp.moveaxis(out, 0, 2)
    y = out[0] + out[1][:, ::-1]
    mu = jnp.mean(y, -1, keepdims=True)
    var = jnp.mean(jnp.square(y - mu), -1, keepdims=True)
    y = ((y - mu) * lax.rsqrt(var + RW_GN_EPS)).reshape(B, T, RW_W) * p['rw_gn_g'] + p['rw_gn_b']
    rk = jnp.sum(r.reshape(B, T, 1, H, N) * k_d.reshape(B, T, N_DIR, H, N) * p['rw_rk'], axis=(2, 4))[..., None]
    bonus = (rk * v.reshape(B, T, H, N)).reshape(B, T, RW_W).astype(F32)
    return ((y + bonus) * g).astype(z.dtype), s_fin


def _mla_qk(zq, zkv, zkr, p):
    B, T, _ = zq.shape
    q = jnp.einsum('btr,rn->btn', _rms_norm(zq, p['mla_q_norm']), p['mla_q_up'])
    q = q.reshape(B, T, MLA_HEADS, MLA_NOPE + MLA_ROPE)
    ckv = _rms_norm(zkv, p['mla_kv_norm'])
    return q[..., :MLA_NOPE], q[..., MLA_NOPE:], ckv, zkr


def _mla_expand(ckv, kv_up):
    B, T, _ = ckv.shape
    kv = jnp.einsum('btr,rn->btn', ckv, kv_up).reshape(B, T, MLA_HEADS, MLA_NOPE + MLA_V)
    return kv[..., :MLA_NOPE], kv[..., MLA_NOPE:]


def _mla_attend(q_nope, q_rope, k_nope, k_rope, v):
    B, Tq, H, _ = q_nope.shape
    nb = Tq // Q_BLOCK
    qn = jnp.swapaxes(q_nope.reshape(B, nb, Q_BLOCK, H, MLA_NOPE), 0, 1)
    qr = jnp.swapaxes(q_rope.reshape(B, nb, Q_BLOCK, H, MLA_ROPE), 0, 1)

    def block(args):
        qn_i, qr_i = args
        s = jnp.einsum('bqhd,bkhd->bhqk', qn_i, k_nope) + jnp.einsum('bqhr,bkr->bhqk', qr_i, k_rope)
        prob = jax.nn.softmax(s.astype(F32) * MLA_SCALE, axis=-1).astype(v.dtype)
        return jnp.einsum('bhqk,bkhd->bqhd', prob, v)

    o = lax.map(block, (qn, qr))
    return jnp.swapaxes(o, 0, 1).reshape(B, Tq, H * MLA_V)


def _chunk_mlp(zu, zv, p):
    B, T, _ = zu.shape
    u = jax.nn.gelu(zu)
    vf = jax.nn.gelu(zv).reshape(B, T, GM_GROUPS, GM_GROUP_W).astype(F32)
    mu = jnp.mean(vf, -1, keepdims=True)
    var = jnp.mean(jnp.square(vf - mu), -1, keepdims=True)
    vn = ((vf - mu) * lax.rsqrt(var + 1e-5)).reshape(B, T, GM_W) * p['gm_norm_g'] + p['gm_norm_b']
    vc = vn.astype(zu.dtype).reshape(B, T // CHUNK, CHUNK, GM_GROUPS, GM_GROUP_W)
    s = jnp.einsum('gpq,bnqgc->bnpgc', p['gm_ws'], vc) + p['gm_bs'].T[:, :, None]
    return u * s.reshape(B, T, GM_W)


def _swiglu(h, w_in, w_out):
    gu = jnp.einsum('btd,df->btf', h, w_in)
    return jnp.einsum('btf,fd->btd', jax.nn.silu(gu[..., :D_FF]) * gu[..., D_FF:], w_out)


def _trunk_layer(x, mod, p, s0, rope, ctx):
    shift1, scale1, gate1, shift2, scale2, gate2 = jnp.split(mod[:, None, :], 6, axis=-1)
    h = x * (1 + scale1) + shift1
    z_rw, zq, zkv, zkr, zu, zv = _split_proj(h, p['w_in'], p['rw_conv'])
    y_rw, s_fin = _rwkv7_bidir(z_rw, s0, p)
    q_nope, q_rope, ckv, krope = _mla_qk(zq, zkv, zkr, p)
    k_nope, v = _mla_expand(ckv, p['mla_kv_up'])
    k_rope = krope
    if rope is not None:
        cos, sin = rope
        q_rope = _apply_rope(q_rope, cos[:, None, :], sin[:, None, :])
        k_rope = _apply_rope(krope, cos, sin)
    if ctx is not None:
        ckv_c, krope_c = ctx
        k_nope_c, v_c = _mla_expand(ckv_c, p['mla_kv_up'])
        k_nope = jnp.concatenate([k_nope, k_nope_c], 1)
        k_rope = jnp.concatenate([k_rope, krope_c], 1)
        v = jnp.concatenate([v, v_c], 1)
    y_mla = _mla_attend(q_nope, q_rope, k_nope, k_rope, v)
    y_gm = _chunk_mlp(zu, zv, p)
    mix = jnp.einsum('btm,md->btd', jnp.concatenate([y_rw, y_mla, y_gm], -1), p['w_out'])
    x = _layer_norm(ALPHA * x + gate1 * mix, p['ln1_g'], p['ln1_b'])
    ff = _swiglu(x * (1 + scale2) + shift2, p['ffn_w_in'], p['ffn_w_out'])
    x = _layer_norm(ALPHA * x + gate2 * ff, p['ln2_g'], p['ln2_b'])
    return x, ckv, krope, s_fin


def setup_inputs(seed: int = 0) -> dict:
    key = jax.random.key(seed)
    ks = iter(jax.random.split(key, 48))
    L = DEPTH

    def nrm(shape, std):
        return std * jax.random.normal(next(ks), shape, F32)

    def gain(shape):
        return 1.0 + nrm(shape, 0.05)

    return {
        'x_prompt': nrm((BATCH, SEQ, D_MODEL), 1.0),
        'x_sample': nrm((DEC_BATCH, DEC_SEQ, D_MODEL), 1.0),
        'cache_ckv': nrm((DEC_BATCH, L, PAST_LEN, MLA_KV_RANK), 1.0),
        'cache_krope': nrm((DEC_BATCH, L, PAST_LEN, MLA_ROPE), 1.0),
        'state_rwkv': nrm((DEC_BATCH, L, N_DIR, RW_HEADS, RW_HEAD, RW_HEAD), 0.5),
        'c': nrm((DEC_BATCH, D_MODEL), 1.0),
        'c_ctx': nrm((D_MODEL,), 1.0),
        'ada_w': nrm((L, D_MODEL, 6 * D_MODEL), 0.5 * D_MODEL ** -0.5),
        'ada_b': nrm((L, 6 * D_MODEL), 0.02),
        'w_in': nrm((L, D_MODEL, N_IN), D_MODEL ** -0.5),
        'rw_conv': jnp.array([0.25, 0.5, 0.25], F32)[None, :, None] + nrm((L, 3, RW_IN), 0.05),
        'rw_w0': jax.random.uniform(next(ks), (L, N_DIR, RW_W), F32, -6.0, -1.0),
        'rw_w2': nrm((L, N_DIR, RW_DECAY_RANK, RW_W), 0.1 * RW_DECAY_RANK ** -0.5),
        'rw_a0': nrm((L, N_DIR, RW_W), 0.1),
        'rw_a2': nrm((L, N_DIR, RW_A_RANK, RW_W), 0.1 * RW_A_RANK ** -0.5),
        'rw_g2': nrm((L, RW_GATE_RANK, RW_W), RW_GATE_RANK ** -0.5),
        'rw_kk': 0.85 + nrm((L, RW_W), 0.05),
        'rw_ka': gain((L, RW_W)),
        'rw_rk': nrm((L, RW_HEADS, RW_HEAD), 0.1),
        'rw_gn_g': gain((L, RW_W)),
        'rw_gn_b': nrm((L, RW_W), 0.02),
        'mla_q_norm': gain((L, MLA_Q_RANK)),
        'mla_q_up': nrm((L, MLA_Q_RANK, MLA_HEADS * (MLA_NOPE + MLA_ROPE)), MLA_Q_RANK ** -0.5),
        'mla_kv_norm': gain((L, MLA_KV_RANK)),
        'mla_kv_up': nrm((L, MLA_KV_RANK, MLA_HEADS * (MLA_NOPE + MLA_V)), MLA_KV_RANK ** -0.5),
        'gm_norm_g': gain((L, GM_W)),
        'gm_norm_b': nrm((L, GM_W), 0.02),
        'gm_ws': nrm((L, GM_GROUPS, CHUNK, CHUNK), CHUNK ** -0.5),
        'gm_bs': gain((L, GM_GROUPS, CHUNK)),
        'w_out': nrm((L, D_MIX, D_MODEL), BETA * D_MIX ** -0.5),
        'ln1_g': gain((L, D_MODEL)),
        'ln1_b': nrm((L, D_MODEL), 0.02),
        'ffn_w_in': nrm((L, D_MODEL, 2 * D_FF), D_MODEL ** -0.5),
        'ffn_w_out': nrm((L, D_FF, D_MODEL), BETA * D_FF ** -0.5),
        'ln2_g': gain((L, D_MODEL)),
        'ln2_b': nrm((L, D_MODEL), 0.02),
    }


def reference(x_prompt, x_sample, cache_ckv, cache_krope, state_rwkv, c, c_ctx, ada_w, ada_b, w_in, rw_conv,
              rw_w0, rw_w2, rw_a0, rw_a2, rw_g2, rw_kk, rw_ka, rw_rk, rw_gn_g, rw_gn_b, mla_q_norm, mla_q_up,
              mla_kv_norm, mla_kv_up, gm_norm_g, gm_norm_b, gm_ws, gm_bs, w_out, ln1_g, ln1_b, ffn_w_in,
              ffn_w_out, ln2_g, ln2_b):
    rope = _axial_rope_tables(x_sample.shape[1])
    xp = x_prompt
    xs = x_sample
    bp = x_prompt.shape[0]
    ckv_out, krope_out, state_out = [], [], []
    for l in range(DEPTH):
        p = {
            'w_in': w_in[l], 'rw_conv': rw_conv[l], 'rw_w0': rw_w0[l], 'rw_w2': rw_w2[l], 'rw_a0': rw_a0[l],
            'rw_a2': rw_a2[l], 'rw_g2': rw_g2[l], 'rw_kk': rw_kk[l], 'rw_ka': rw_ka[l], 'rw_rk': rw_rk[l],
            'rw_gn_g': rw_gn_g[l], 'rw_gn_b': rw_gn_b[l], 'mla_q_norm': mla_q_norm[l], 'mla_q_up': mla_q_up[l],
            'mla_kv_norm': mla_kv_norm[l], 'mla_kv_up': mla_kv_up[l], 'gm_norm_g': gm_norm_g[l],
            'gm_norm_b': gm_norm_b[l], 'gm_ws': gm_ws[l], 'gm_bs': gm_bs[l], 'w_out': w_out[l],
            'ln1_g': ln1_g[l], 'ln1_b': ln1_b[l], 'ffn_w_in': ffn_w_in[l], 'ffn_w_out': ffn_w_out[l],
            'ln2_g': ln2_g[l], 'ln2_b': ln2_b[l],
        }
        mod_ctx = _adaln(c_ctx[None, :], ada_w[l], ada_b[l])
        s0_ctx = jnp.zeros((N_DIR, bp, RW_HEADS, RW_HEAD, RW_HEAD), F32)
        xp, ckv, krope, s_fin = _trunk_layer(xp, mod_ctx, p, s0_ctx, None, None)
        ckv_out.append(ckv)
        krope_out.append(krope)
        state_out.append(jnp.moveaxis(s_fin, 0, 1).astype(xp.dtype))
        mod_lat = _adaln(c, ada_w[l], ada_b[l])
        s0_lat = jnp.moveaxis(state_rwkv[:, l], 1, 0)
        xs, _, _, _ = _trunk_layer(xs, mod_lat, p, s0_lat, rope, (cache_ckv[:, l], cache_krope[:, l]))
    new_cache_ckv = jnp.stack(ckv_out, axis=1)
    new_cache_krope = jnp.stack(krope_out, axis=1)
    new_state_rwkv = jnp.stack(state_out, axis=1)
    return (xp, xs, new_cache_ckv, new_cache_krope, new_state_rwkv)
```

```cpp
#include <hip/hip_runtime.h>
#include <hip/hip_cooperative_groups.h>
#include <cstdint>
#include <cstdio>
namespace cg = cooperative_groups;

typedef unsigned short bf16_t;
typedef short bf16x8 __attribute__((ext_vector_type(8)));
typedef float f32x4 __attribute__((ext_vector_type(4)));
typedef float f32x2 __attribute__((ext_vector_type(2)));
typedef float f32x16 __attribute__((ext_vector_type(16)));
typedef unsigned u32x4 __attribute__((ext_vector_type(4)));
typedef unsigned u32x2 __attribute__((ext_vector_type(2)));

#define M_ALL 20480
#define M_CTX 4096
#define DM 1024
#define NIN 2080
#define DFF 2816
#define ALPHA_F 1.6817928305074290f
#define QSCALE (0.10206207261596575f * 1.4426950408889634f)
#define LAS __attribute__((address_space(3)))

#define ZQ 1152
#define ZKV 1408
#define ZKR 1536
#define ZU 1568
#define ZV 1824

#define LDS_STRIDE 72
#define TILE_BYTES (128 * LDS_STRIDE * 2)
#define RS_OFF (4 * TILE_BYTES)
#define SMEM_BYTES (RS_OFF + 1024)

struct P {
    const float *x_prompt, *x_sample, *cache_ckv, *cache_krope, *state_rwkv, *c, *c_ctx, *ada_w, *ada_b, *w_in, *rw_conv, *rw_w0, *rw_w2,
        *rw_a0, *rw_a2, *rw_g2, *rw_kk, *rw_ka, *rw_rk, *rw_gn_g, *rw_gn_b, *q_norm, *q_up, *kv_norm, *kv_up, *gm_g, *gm_b, *gm_ws, *gm_bs,
        *w_out, *ln1_g, *ln1_b, *ffn_in, *ffn_out, *ln2_g, *ln2_b;
    float* out;
    unsigned* bar; int* ctr; float* mod; float* ropeC; float* ropeS; bf16_t* CkvB;
    bf16_t *WtIn, *WtQ, *WtKVn, *WtKV, *WtOut, *WtF1, *WtF2, *WsB, *W2t, *A2t, *G2t;
    bf16_t *Z, *RKV, *Ee, *Aa, *Gg, *Qb, *Kb, *Kc, *Vt, *Vtc, *hbmix, *hidden;
    float* ydir;
};


struct Args { const float* in[36]; float* out; char* ws; };
typedef const __attribute__((address_space(4))) char* kargp_t;
constexpr size_t al256(size_t x) { return (x + 255) & ~(size_t)255; }
constexpr size_t OFF_BAR = 0;
constexpr size_t OFF_CTR = OFF_BAR + 16384;
constexpr size_t OFF_MOD = OFF_CTR + 4096;
constexpr size_t OFF_ROPEC = OFF_MOD + al256((size_t)4 * 5 * 6144 * 4);
constexpr size_t OFF_ROPES = OFF_ROPEC + 65536 * 4;
constexpr size_t OFF_CKVB = OFF_ROPES + 65536 * 4;
constexpr size_t OFF_WTIN = OFF_CKVB + (size_t)4 * 2048 * 128 * 2;
constexpr size_t OFF_WTQ = OFF_WTIN + (size_t)2176 * 1024 * 2;
constexpr size_t OFF_WTKVN = OFF_WTQ + (size_t)768 * 256 * 2;
constexpr size_t OFF_WTKV = OFF_WTKVN + (size_t)1024 * 128 * 2;
constexpr size_t OFF_WTOUT = OFF_WTKV + (size_t)1024 * 128 * 2;
constexpr size_t OFF_WTF1 = OFF_WTOUT + (size_t)1024 * 1024 * 2;
constexpr size_t OFF_WTF2 = OFF_WTF1 + (size_t)5632 * 1024 * 2;
constexpr size_t OFF_WSB = OFF_WTF2 + (size_t)1024 * DFF * 2;
constexpr size_t OFF_W2T = OFF_WSB + (size_t)65536 * 2;
constexpr size_t OFF_A2T = OFF_W2T + (size_t)2 * 256 * 64 * 2;
constexpr size_t OFF_G2T = OFF_A2T + (size_t)2 * 256 * 64 * 2;
constexpr size_t OFF_Z = OFF_G2T + (size_t)256 * 128 * 2;
constexpr size_t OFF_HIDDEN = OFF_Z;
constexpr size_t OFF_RKV = OFF_Z + al256((size_t)M_ALL * NIN * 2);
constexpr size_t OFF_EE = OFF_RKV + (size_t)M_ALL * 768 * 2;
constexpr size_t OFF_AA = OFF_EE + (size_t)2 * M_ALL * 256 * 2;
constexpr size_t OFF_GG = OFF_AA + (size_t)2 * M_ALL * 256 * 2;
constexpr size_t OFF_QB = OFF_GG + (size_t)M_ALL * 256 * 2;
constexpr size_t OFF_KB = OFF_QB + (size_t)M_ALL * 768 * 2;
constexpr size_t OFF_KC = OFF_KB + (size_t)M_ALL * 768 * 2;
constexpr size_t OFF_VT = OFF_KC + (size_t)2048 * 768 * 2;
constexpr size_t OFF_VTC = OFF_VT + (size_t)M_ALL * 512 * 2;
constexpr size_t OFF_YDIR = OFF_VTC + (size_t)2048 * 512 * 2;
constexpr size_t OFF_HBMIX = OFF_YDIR + (size_t)2 * M_ALL * 256 * 4;
constexpr size_t WS_TOTAL = OFF_HBMIX + (size_t)M_ALL * DM * 2;
static_assert(OFF_RKV + (size_t)M_ALL * 768 * 2 - OFF_HIDDEN >= (size_t)M_ALL * DFF * 2, "hidden overlay");

__device__ __forceinline__ P getP(kargp_t& kp) {
    asm volatile("" : "+s"(kp));
    typedef const float* const __attribute__((address_space(4)))* inp_t;
    inp_t in = (inp_t)kp;
    P p;
    p.x_prompt = in[0]; p.x_sample = in[1]; p.cache_ckv = in[2]; p.cache_krope = in[3]; p.state_rwkv = in[4]; p.c = in[5]; p.c_ctx = in[6];
    p.ada_w = in[7]; p.ada_b = in[8]; p.w_in = in[9]; p.rw_conv = in[10]; p.rw_w0 = in[11]; p.rw_w2 = in[12]; p.rw_a0 = in[13]; p.rw_a2 = in[14];
    p.rw_g2 = in[15]; p.rw_kk = in[16]; p.rw_ka = in[17]; p.rw_rk = in[18]; p.rw_gn_g = in[19]; p.rw_gn_b = in[20]; p.q_norm = in[21]; p.q_up = in[22];
    p.kv_norm = in[23]; p.kv_up = in[24]; p.gm_g = in[25]; p.gm_b = in[26]; p.gm_ws = in[27]; p.gm_bs = in[28]; p.w_out = in[29]; p.ln1_g = in[30];
    p.ln1_b = in[31]; p.ffn_in = in[32]; p.ffn_out = in[33]; p.ln2_g = in[34]; p.ln2_b = in[35];
    p.out = (float*)in[36]; char* ws = (char*)in[37];
    p.bar = (unsigned*)(ws + OFF_BAR); p.ctr = (int*)(ws + OFF_CTR); p.mod = (float*)(ws + OFF_MOD); p.ropeC = (float*)(ws + OFF_ROPEC); p.ropeS = (float*)(ws + OFF_ROPES);
    p.CkvB = (bf16_t*)(ws + OFF_CKVB); p.WtIn = (bf16_t*)(ws + OFF_WTIN); p.WtQ = (bf16_t*)(ws + OFF_WTQ); p.WtKVn = (bf16_t*)(ws + OFF_WTKVN); p.WtKV = (bf16_t*)(ws + OFF_WTKV);
    p.WtOut = (bf16_t*)(ws + OFF_WTOUT); p.WtF1 = (bf16_t*)(ws + OFF_WTF1); p.WtF2 = (bf16_t*)(ws + OFF_WTF2); p.WsB = (bf16_t*)(ws + OFF_WSB); p.W2t = (bf16_t*)(ws + OFF_W2T);
    p.A2t = (bf16_t*)(ws + OFF_A2T); p.G2t = (bf16_t*)(ws + OFF_G2T); p.Z = (bf16_t*)(ws + OFF_Z); p.RKV = (bf16_t*)(ws + OFF_RKV); p.Ee = (bf16_t*)(ws + OFF_EE); p.Aa = (bf16_t*)(ws + OFF_AA);
    p.Gg = (bf16_t*)(ws + OFF_GG); p.Qb = (bf16_t*)(ws + OFF_QB); p.Kb = (bf16_t*)(ws + OFF_KB); p.Kc = (bf16_t*)(ws + OFF_KC); p.Vt = (bf16_t*)(ws + OFF_VT); p.Vtc = (bf16_t*)(ws + OFF_VTC);
    p.hbmix = (bf16_t*)(ws + OFF_HBMIX); p.hidden = (bf16_t*)(ws + OFF_HIDDEN); p.ydir = (float*)(ws + OFF_YDIR);
    return p;
}

__device__ __forceinline__ float bf2f(bf16_t b) { return __uint_as_float(((unsigned)b) << 16); }
__device__ __forceinline__ unsigned pack2(float lo, float hi) { unsigned r; asm("v_cvt_pk_bf16_f32 %0, %1, %2" : "=v"(r) : "v"(lo), "v"(hi)); return r; }
__device__ __forceinline__ bf16_t f2bf(float f) { return (bf16_t)(pack2(f, 0.f) & 0xffffu); }
__device__ __forceinline__ float lo_bf(unsigned w) { return __uint_as_float(w << 16); }
__device__ __forceinline__ float hi_bf(unsigned w) { return __uint_as_float(w & 0xffff0000u); }
__device__ __forceinline__ float sigmoidf_(float x) { return 1.0f / (1.0f + __expf(-x)); }
__device__ __forceinline__ float tanhf_(float x) { float e = __expf(2.0f * x); return 1.0f - 2.0f / (e + 1.0f); }
__device__ __forceinline__ float geluf_(float x) { return 0.5f * x * (1.0f + tanhf_(0.7978845608028654f * (x + 0.044715f * x * x * x))); }
template <int CTRL> __device__ __forceinline__ float dpp_add(float x) {
    int y = __builtin_amdgcn_update_dpp(0, __float_as_int(x), CTRL, 0xf, 0xf, false);
    return x + __int_as_float(y);
}
__device__ __forceinline__ float red4(float x) { x = dpp_add<0xB1>(x); x = dpp_add<0x4E>(x); return x; }
__device__ __forceinline__ float red8(float x) { x = red4(x); x = dpp_add<0x141>(x); return x; }
__device__ __forceinline__ float red16(float x) { x = red8(x); x = dpp_add<0x140>(x); return x; }
__device__ __forceinline__ int opaque_tid() { int t = threadIdx.x; asm volatile("" : "+v"(t)); return t; }
__device__ __forceinline__ int modrow_of(int row) { return row < M_CTX ? 0 : 1 + ((row - M_CTX) >> 12); }

#define XB_TMO 128
#define XB_XCNT(j) (256 + 64 * (j))
#define XB_XSUB(j) (1280 + 64 * (j))
#define XB_XGEN(j) (2304 + 64 * (j))
#define XB_TOP 3328
#define XB_TOPGEN 3392
#define XCD_BAR_WORDS 3456
#define XB_SPIN_CAP (1u << 22)
__device__ __forceinline__ unsigned xb_ld(unsigned* p) { return __hip_atomic_load(p, __ATOMIC_RELAXED, __HIP_MEMORY_SCOPE_AGENT); }
__device__ __forceinline__ unsigned xb_add(unsigned* p, unsigned v) { return __hip_atomic_fetch_add(p, v, __ATOMIC_RELAXED, __HIP_MEMORY_SCOPE_AGENT); }
__device__ __forceinline__ unsigned xb_xcc_id() { return (unsigned)__builtin_amdgcn_s_getreg((3 << 11) | 20) & 0xFu; }
#define XB_SPIN(cond, bar) do { unsigned _sp = 0; while (cond) { __builtin_amdgcn_s_sleep(1); \
    if ((++_sp & 255u) == 0u) { if (xb_ld(&(bar)[XB_TMO])) break; if (_sp > XB_SPIN_CAP) { atomicAdd(&(bar)[XB_TMO], 1u); break; } } } } while (0)
struct XcdBarrier { unsigned* bar; unsigned x; volatile LAS unsigned* st; };
__device__ __forceinline__ XcdBarrier xcd_barrier_post(unsigned* bar, volatile LAS unsigned* st) {
    XcdBarrier b; b.bar = bar; b.x = xb_xcc_id(); b.st = st;
    if (threadIdx.x == 0) (void)xb_add(&bar[XB_XCNT(b.x)], 1u);
    return b;
}
__device__ __forceinline__ void xcd_barrier_complete(unsigned* bar, unsigned x, unsigned& nloc, unsigned& nx) {
    const unsigned G = gridDim.x * gridDim.y * gridDim.z;
    unsigned sum, cnt, mine, sp = 0u;
    for (;;) {
        sum = 0u; cnt = 0u; mine = 0u;
#pragma unroll
        for (unsigned j = 0; j < 16; ++j) { const unsigned c = xb_ld(&bar[XB_XCNT(j)]); sum += c; cnt += (c > 0u) ? 1u : 0u; mine = (j == x) ? c : mine; }
        if (sum == G) break;
        __builtin_amdgcn_s_sleep(1);
        if ((++sp & 255u) == 0u) { if (xb_ld(&bar[XB_TMO])) break; if (sp > XB_SPIN_CAP) { atomicAdd(&bar[XB_TMO], 1u); break; } }
    }
    nloc = mine > 0u ? mine : 1u; nx = cnt > 0u ? cnt : 1u;
}
__device__ __forceinline__ void xcd_barrier(const XcdBarrier& b) {
    asm volatile("s_waitcnt vmcnt(0)" ::: "memory");
    __syncthreads();
    if (threadIdx.x == 0) {
        unsigned* bar = b.bar;
        __builtin_amdgcn_s_waitcnt(0);
        unsigned nloc = b.st[0], nx = b.st[1];
        if (nloc == 0u) { xcd_barrier_complete(bar, b.x, nloc, nx); b.st[0] = nloc; b.st[1] = nx; }
        const unsigned old = xb_add(&bar[XB_XSUB(b.x)], 1u);
        const unsigned gen = old / nloc;
        if (old + 1u == (gen + 1u) * nloc) {
            __builtin_amdgcn_fence(__ATOMIC_RELEASE, "agent");
            asm volatile("s_waitcnt vmcnt(0)" ::: "memory");
            const unsigned og = xb_add(&bar[XB_TOP], 1u);
            const unsigned tg = og / nx;
            if (og + 1u == (tg + 1u) * nx) xb_add(&bar[XB_TOPGEN], 1u);
            else XB_SPIN(xb_ld(&bar[XB_TOPGEN]) == tg, bar);
            __builtin_amdgcn_fence(__ATOMIC_ACQUIRE, "agent");
            xb_add(&bar[XB_XGEN(b.x)], 1u);
            asm volatile("s_waitcnt vmcnt(0)" ::: "memory");
        } else {
            XB_SPIN(xb_ld(&bar[XB_XGEN(b.x)]) == gen, bar);
            __builtin_amdgcn_fence(__ATOMIC_ACQUIRE, "agent");
            asm volatile("s_waitcnt vmcnt(0)" ::: "memory");
        }
    }
    __syncthreads();
}

template <class Epi>
__device__ __forceinline__ void gemm128(const bf16_t* __restrict__ A, int lda, const bf16_t* __restrict__ B, int ldb, int K, char* smem, const Epi& epi) {
    const int tid = opaque_tid(), lane = tid & 63, wid = tid >> 6, wr = wid >> 1, wc = wid & 1, fr = lane & 15, fq = lane >> 4;
    f32x4 acc[4][4];
#pragma unroll
    for (int m = 0; m < 4; ++m)
#pragma unroll
        for (int n = 0; n < 4; ++n) acc[m][n] = (f32x4){0.f, 0.f, 0.f, 0.f};
    const int crow = tid >> 3, ckc = tid & 7;
    const bf16_t* ap = A + (size_t)crow * lda + ckc * 8;
    const bf16_t* bp = B + (size_t)crow * ldb + ckc * 8;
    u32x4 ra[4], rb[4];
#pragma unroll
    for (int i = 0; i < 4; ++i) { ra[i] = *(const u32x4*)(ap + (size_t)(32 * i) * lda); rb[i] = *(const u32x4*)(bp + (size_t)(32 * i) * ldb); }
    {
        char* sa = smem; char* sb = smem + TILE_BYTES;
#pragma unroll
        for (int i = 0; i < 4; ++i) { *(u32x4*)(sa + ((crow + 32 * i) * LDS_STRIDE + ckc * 8) * 2) = ra[i]; *(u32x4*)(sb + ((crow + 32 * i) * LDS_STRIDE + ckc * 8) * 2) = rb[i]; }
    }
    __syncthreads();
    const int nk = K >> 6;
    for (int kt = 0; kt < nk; ++kt) {
        const bool more = (kt + 1 < nk);
        if (more) {
            const int k0 = (kt + 1) << 6;
#pragma unroll
            for (int i = 0; i < 4; ++i) { ra[i] = *(const u32x4*)(ap + (size_t)(32 * i) * lda + k0); rb[i] = *(const u32x4*)(bp + (size_t)(32 * i) * ldb + k0); }
        }
        const char* sa = smem + (kt & 1) * 2 * TILE_BYTES; const char* sb = sa + TILE_BYTES;
#pragma unroll
        for (int ks = 0; ks < 2; ++ks) {
            bf16x8 af[4], bfr[4];
#pragma unroll
            for (int m = 0; m < 4; ++m) af[m] = *(const bf16x8*)(sa + ((wr * 64 + m * 16 + fr) * LDS_STRIDE + ks * 32 + fq * 8) * 2);
#pragma unroll
            for (int n = 0; n < 4; ++n) bfr[n] = *(const bf16x8*)(sb + ((wc * 64 + n * 16 + fr) * LDS_STRIDE + ks * 32 + fq * 8) * 2);
#pragma unroll
            for (int m = 0; m < 4; ++m)
#pragma unroll
                for (int n = 0; n < 4; ++n) acc[m][n] = __builtin_amdgcn_mfma_f32_16x16x32_bf16(af[m], bfr[n], acc[m][n], 0, 0, 0);
        }
        if (more) {
            char* da = smem + ((kt + 1) & 1) * 2 * TILE_BYTES; char* db = da + TILE_BYTES;
#pragma unroll
            for (int i = 0; i < 4; ++i) { *(u32x4*)(da + ((crow + 32 * i) * LDS_STRIDE + ckc * 8) * 2) = ra[i]; *(u32x4*)(db + ((crow + 32 * i) * LDS_STRIDE + ckc * 8) * 2) = rb[i]; }
        }
        __syncthreads();
    }
    epi(acc, wr * 64, wc * 64, fr, fq);
}

struct EpiZ {
    bf16_t* Z; int R0, C0;
    __device__ __forceinline__ void operator()(f32x4 (&acc)[4][4], int r0, int c0, int fr, int fq) const {
#pragma unroll
        for (int n = 0; n < 4; ++n) { const int col = C0 + c0 + n * 16 + fr; if (col < NIN) {
#pragma unroll
            for (int m = 0; m < 4; ++m)
#pragma unroll
                for (int j = 0; j < 4; ++j) Z[(size_t)(R0 + r0 + m * 16 + fq * 4 + j) * NIN + col] = f2bf(acc[m][n][j]); } }
    }
};
struct EpiQ {
    bf16_t* Q; const float* rs; const float* ropeC; const float* ropeS; int R0, C0;
    __device__ __forceinline__ void operator()(f32x4 (&acc)[4][4], int r0, int c0, int fr, int fq) const {
        const bool lat = R0 >= M_CTX;
#pragma unroll
        for (int n = 0; n < 4; ++n) {
            const int cb = C0 + c0 + n * 16; const int hcs = cb % 96;
            if (lat && hcs == 80) continue;
            const bool rot = lat && hcs == 64;
#pragma unroll
            for (int m = 0; m < 4; ++m)
#pragma unroll
                for (int j = 0; j < 4; ++j) {
                    const int rl = r0 + m * 16 + fq * 4 + j; const int row = R0 + rl; const float s = rs[rl] * QSCALE;
                    const float x1 = acc[m][n][j] * s;
                    if (rot) {
                        const float x2 = acc[m][(n + 1) & 3][j] * s; const int t = (row - M_CTX) & 4095;
                        const float cv = ropeC[t * 16 + fr], sv = ropeS[t * 16 + fr];
                        Q[(size_t)row * 768 + cb + fr] = f2bf(x1 * cv - x2 * sv);
                        Q[(size_t)row * 768 + cb + 16 + fr] = f2bf(x1 * sv + x2 * cv);
                    } else Q[(size_t)row * 768 + cb + fr] = f2bf(x1);
                }
        }
    }
};
struct EpiKV {
    bf16_t* Kd; bf16_t* Vd; const float* rs; int R0, C0; int seqshift; size_t vbase0;
    __device__ __forceinline__ void operator()(f32x4 (&acc)[4][4], int r0, int c0, int fr, int fq) const {
#pragma unroll
        for (int n = 0; n < 4; ++n) {
            const int col = C0 + c0 + n * 16 + fr;
#pragma unroll
            for (int m = 0; m < 4; ++m) {
                const int rl = r0 + m * 16 + fq * 4; const int row = R0 + rl;
                float v[4];
#pragma unroll
                for (int j = 0; j < 4; ++j) v[j] = acc[m][n][j] * (rs ? rs[rl + j] : 1.0f);
                if (col < 512) {
                    const int h = col >> 6, d = col & 63;
#pragma unroll
                    for (int j = 0; j < 4; ++j) Kd[(size_t)(row + j) * 768 + h * 96 + d] = f2bf(v[j]);
                } else {
                    const int vc = col - 512, h = vc >> 6, dv = vc & 63; const int b = row >> seqshift, t = row & ((1 << seqshift) - 1);
                    u32x2 w; w.x = pack2(v[0], v[1]); w.y = pack2(v[2], v[3]);
                    *(u32x2*)(Vd + vbase0 + ((size_t)((b * 8 + h) * 64 + dv) << seqshift) + t) = w;
                }
            }
        }
    }
};
struct EpiRes {
    float* X; const float* gate; int R0, C0;
    __device__ __forceinline__ void operator()(f32x4 (&acc)[4][4], int r0, int c0, int fr, int fq) const {
#pragma unroll
        for (int n = 0; n < 4; ++n) { const int col = C0 + c0 + n * 16 + fr; const float g = gate[col];
#pragma unroll
            for (int m = 0; m < 4; ++m)
#pragma unroll
                for (int j = 0; j < 4; ++j) { float* px = X + (size_t)(R0 + r0 + m * 16 + fq * 4 + j) * DM + col; *px = ALPHA_F * (*px) + g * acc[m][n][j]; } }
    }
};
struct EpiSwi {
    bf16_t* H; int R0, C0;
    __device__ __forceinline__ void operator()(f32x4 (&acc)[4][4], int r0, int c0, int fr, int fq) const {
        const int hb = (C0 + c0) >> 1;
#pragma unroll
        for (int n = 0; n < 2; ++n)
#pragma unroll
            for (int m = 0; m < 4; ++m)
#pragma unroll
                for (int j = 0; j < 4; ++j) { const float g = acc[m][n][j], u = acc[m][n + 2][j];
                    H[(size_t)(R0 + r0 + m * 16 + fq * 4 + j) * DFF + hb + n * 16 + fr] = f2bf(g * sigmoidf_(g) * u); }
    }
};

__device__ __forceinline__ void ada_unit(const P& p, int u, char* smem) {
    const int tid = opaque_tid(); const int l = u / 96, c0 = (u % 96) * 64;
    float* cs = (float*)smem;
    for (int i = tid; i < 5 * 1024; i += 256) { const int r = i >> 10, k = i & 1023; const float v = (r == 0) ? p.c_ctx[k] : p.c[(r - 1) * 1024 + k]; cs[i] = v * sigmoidf_(v); }
    __syncthreads();
    const int col = tid & 63, kq = tid >> 6;
    float s0 = 0.f, s1 = 0.f, s2 = 0.f, s3 = 0.f, s4 = 0.f;
    const float* w = p.ada_w + ((size_t)l * 1024 + kq * 256) * 6144 + c0 + col;
    const float* cq = cs + kq * 256;
    for (int k = 0; k < 256; ++k) { const float wv = w[(size_t)k * 6144]; s0 += cq[k] * wv; s1 += cq[1024 + k] * wv; s2 += cq[2048 + k] * wv; s3 += cq[3072 + k] * wv; s4 += cq[4096 + k] * wv; }
    float* red = cs + 5 * 1024;
    red[(kq * 5 + 0) * 64 + col] = s0; red[(kq * 5 + 1) * 64 + col] = s1; red[(kq * 5 + 2) * 64 + col] = s2; red[(kq * 5 + 3) * 64 + col] = s3; red[(kq * 5 + 4) * 64 + col] = s4;
    __syncthreads();
    for (int o = tid; o < 320; o += 256) { const int i = o >> 6, cc = o & 63;
        const float v = red[(0 * 5 + i) * 64 + cc] + red[(1 * 5 + i) * 64 + cc] + red[(2 * 5 + i) * 64 + cc] + red[(3 * 5 + i) * 64 + cc] + p.ada_b[l * 6144 + c0 + cc];
        p.mod[((size_t)l * 5 + i) * 6144 + c0 + cc] = v; }
    __syncthreads();
}
__device__ __forceinline__ int map_col(int kind, int n) {
    if (kind == 1) { const int blk = n >> 6, r = n & 63; return r < 32 ? blk * 32 + r : DFF + blk * 32 + (r - 32); }
    if (kind == 2) { if (n < 512) return (n >> 6) * 128 + (n & 63); const int vc = n - 512; return (vc >> 6) * 128 + 64 + (vc & 63); }
    return n;
}
__device__ __forceinline__ void conv_tile(const float* src, int ldsrc, bf16_t* dst, bf16_t* dst2, int Kdst, int n0, int k0, int kind, int Nvalid, const float* kscale, char* smem) {
    const int tid = opaque_tid(); float* tile = (float*)smem;
    { const int j = tid & 63, i0 = tid >> 6; const int n = n0 + j; const int sc = (n < Nvalid) ? map_col(kind, n) : -1;
#pragma unroll 4
      for (int ii = 0; ii < 16; ++ii) { const int i = i0 + 4 * ii; tile[i * 65 + j] = (sc >= 0) ? src[(size_t)(k0 + i) * ldsrc + sc] : 0.f; } }
    __syncthreads();
    { const int i = tid & 63, j0 = tid >> 6; const float ks = kscale ? kscale[k0 + i] : 1.f;
#pragma unroll 4
      for (int jj = 0; jj < 16; ++jj) { const int jx = j0 + 4 * jj; const float v = tile[i * 65 + jx];
          dst[(size_t)(n0 + jx) * Kdst + k0 + i] = f2bf(v * ks); if (dst2) dst2[(size_t)(n0 + jx) * Kdst + k0 + i] = f2bf(v); } }
    __syncthreads();
}
#define NCONV 3032
__device__ __forceinline__ void conv_unit(const P& p, int l, int u, char* smem) {
    const float* src; int ldsrc; bf16_t* dst; bf16_t* dst2 = nullptr; int Kdst, n0, k0, kind = 0, Nvalid; const float* kscale = nullptr;
    if (u < 544) { src = p.w_in + (size_t)l * 1024 * NIN; ldsrc = NIN; dst = p.WtIn; Kdst = 1024; n0 = (u / 16) * 64; k0 = (u % 16) * 64; Nvalid = NIN; }
    else if (u < 592) { u -= 544; src = p.q_up + (size_t)l * 256 * 768; ldsrc = 768; dst = p.WtQ; Kdst = 256; n0 = (u / 4) * 64; k0 = (u % 4) * 64; Nvalid = 768; kscale = p.q_norm + l * 256; }
    else if (u < 624) { u -= 592; src = p.kv_up + (size_t)l * 128 * 1024; ldsrc = 1024; dst = p.WtKVn; dst2 = p.WtKV; Kdst = 128; n0 = (u / 2) * 64; k0 = (u % 2) * 64; kind = 2; Nvalid = 1024; kscale = p.kv_norm + l * 128; }
    else if (u < 880) { u -= 624; src = p.w_out + (size_t)l * 1024 * 1024; ldsrc = 1024; dst = p.WtOut; Kdst = 1024; n0 = (u / 16) * 64; k0 = (u % 16) * 64; Nvalid = 1024; }
    else if (u < 2288) { u -= 880; src = p.ffn_in + (size_t)l * 1024 * 5632; ldsrc = 5632; dst = p.WtF1; Kdst = 1024; n0 = (u / 16) * 64; k0 = (u % 16) * 64; kind = 1; Nvalid = 5632; }
    else if (u < 2992) { u -= 2288; src = p.ffn_out + (size_t)l * DFF * 1024; ldsrc = 1024; dst = p.WtF2; Kdst = DFF; n0 = (u / 44) * 64; k0 = (u % 44) * 64; Nvalid = 1024; }
    else if (u < 3008) { u -= 2992; const float* sp = p.gm_ws + (size_t)l * 65536 + u * 4096; bf16_t* d = p.WsB + u * 4096; for (int i = threadIdx.x; i < 4096; i += 256) d[i] = f2bf(sp[i]); return; }
    else if (u < 3016) { u -= 3008; const int d = u >> 2; src = p.rw_w2 + ((size_t)l * 2 + d) * 64 * 256; ldsrc = 256; dst = p.W2t + d * 256 * 64; Kdst = 64; n0 = (u & 3) * 64; k0 = 0; Nvalid = 256; }
    else if (u < 3024) { u -= 3016; const int d = u >> 2; src = p.rw_a2 + ((size_t)l * 2 + d) * 64 * 256; ldsrc = 256; dst = p.A2t + d * 256 * 64; Kdst = 64; n0 = (u & 3) * 64; k0 = 0; Nvalid = 256; }
    else { u -= 3024; src = p.rw_g2 + (size_t)l * 128 * 256; ldsrc = 256; dst = p.G2t; Kdst = 128; n0 = (u / 2) * 64; k0 = (u % 2) * 64; Nvalid = 256; }
    conv_tile(src, ldsrc, dst, dst2, Kdst, n0, k0, kind, Nvalid, kscale, smem);
}
__device__ __forceinline__ void misc0_unit(const P& p, int u) {
    const int tid = opaque_tid();
    if (u < 16) {
        for (int e = tid; e < 4096; e += 256) { const int idx = u * 4096 + e; const int t = idx >> 4, i = idx & 15;
            const float pos = (float)((i < 8) ? (t >> 6) : (t & 63)); const float inv = exp2f(-(float)(i & 7) * 1.6609640474436813f);
            const float ang = pos * inv; const float kf = rintf(ang * 0.15915494309189535f);
            float r = fmaf(-kf, 6.28318548202514648f, ang); r = fmaf(-kf, -1.74845553e-7f, r);
            p.ropeC[idx] = __cosf(r); p.ropeS[idx] = __sinf(r); }
    } else {
        const int v = u - 16;
        for (int e = tid; e < 4096; e += 256) { const int idx = v * 4096 + e;
            const int c = idx & 127, t = (idx >> 7) & 511, b = (idx >> 16) & 3, l = idx >> 18;
            p.CkvB[idx] = f2bf(p.cache_ckv[(((size_t)b * 4 + l) * 512 + t) * 128 + c]); }
    }
}

__device__ __forceinline__ void ln_phase(const P& p, int l, int which) {
    const int tid = opaque_tid(), lane = tid & 63, wid = tid >> 6;
    const float* g = which == 1 ? p.ln1_g + l * DM : p.ln2_g + l * DM; const float* bb = which == 1 ? p.ln1_b + l * DM : p.ln2_b + l * DM;
    const int ml = which == 2 ? l + 1 : l; const int shoff = which == 1 ? 3072 : 0, scoff = which == 1 ? 4096 : 1024;
    const bool dohb = !(which == 2 && l == 3);
    for (int row = blockIdx.x * 4 + wid; row < M_ALL; row += gridDim.x * 4) {
        float* xr = p.out + (size_t)row * DM;
        const float* src = which == 0 ? (row < M_CTX ? p.x_prompt + (size_t)row * DM : p.x_sample + (size_t)(row - M_CTX) * DM) : xr;
        f32x4 v[4];
#pragma unroll
        for (int i = 0; i < 4; ++i) v[i] = *(const f32x4*)(src + lane * 4 + 256 * i);
        if (which != 0) {
            float s = 0.f;
#pragma unroll
            for (int i = 0; i < 4; ++i) s += (v[i][0] + v[i][1]) + (v[i][2] + v[i][3]);
            s = red16(s); s += __shfl_xor(s, 16); s += __shfl_xor(s, 32);
            const float mu = s * (1.0f / 1024.0f); float q = 0.f;
#pragma unroll
            for (int i = 0; i < 4; ++i) { const f32x4 d = v[i] - mu; q += (d[0] * d[0] + d[1] * d[1]) + (d[2] * d[2] + d[3] * d[3]); }
            q = red16(q); q += __shfl_xor(q, 16); q += __shfl_xor(q, 32);
            const float rstd = rsqrtf(q * (1.0f / 1024.0f) + 1e-5f);
#pragma unroll
            for (int i = 0; i < 4; ++i) { const f32x4 gg = *(const f32x4*)(g + lane * 4 + 256 * i), bv = *(const f32x4*)(bb + lane * 4 + 256 * i); v[i] = (v[i] - mu) * rstd * gg + bv; }
        }
#pragma unroll
        for (int i = 0; i < 4; ++i) *(f32x4*)(xr + lane * 4 + 256 * i) = v[i];
        if (dohb) {
            const float* md = p.mod + ((size_t)ml * 5 + modrow_of(row)) * 6144;
#pragma unroll
            for (int i = 0; i < 4; ++i) { const f32x4 sh = *(const f32x4*)(md + shoff + lane * 4 + 256 * i), sc = *(const f32x4*)(md + scoff + lane * 4 + 256 * i);
                const f32x4 h = v[i] * (1.0f + sc) + sh; u32x2 w; w.x = pack2(h[0], h[1]); w.y = pack2(h[2], h[3]);
                *(u32x2*)(p.hbmix + (size_t)row * DM + lane * 4 + 256 * i) = w; }
        }
    }
}

__device__ __forceinline__ void rwprep_unit(const P& p, int l, int u, char* smem) {
    const int tid = opaque_tid(), lane = tid & 63, wid = tid >> 6, fr = lane & 15, fq = lane >> 4;
    const int R0 = u * 64;
    const int ss = R0 < M_CTX ? (R0 & ~255) : M_CTX + ((R0 - M_CTX) & ~4095); const int se = ss + (R0 < M_CTX ? 256 : 4096);
    bf16_t* XW = (bf16_t*)smem; bf16_t* XA = XW + 64 * 136; bf16_t* XG = XA + 64 * 136;
    const float* cw = p.rw_conv + (size_t)l * 3 * 1152;
    for (int it = tid; it < 576; it += 256) {
        const int cc = it % 144, tg = it / 144; const int c = cc * 8;
        float w0[8], w1[8], w2[8];
#pragma unroll
        for (int i = 0; i < 8; ++i) { w0[i] = cw[c + i]; w1[i] = cw[1152 + c + i]; w2[i] = cw[2304 + c + i]; }
        const int rfirst = R0 + tg * 16;
        u32x4 prev = (u32x4){0u, 0u, 0u, 0u}, cur, nxt;
        if (rfirst - 1 >= ss) prev = *(const u32x4*)(p.Z + (size_t)(rfirst - 1) * NIN + c);
        cur = *(const u32x4*)(p.Z + (size_t)rfirst * NIN + c);
        for (int tt = 0; tt < 16; ++tt) {
            const int row = rfirst + tt;
            nxt = (u32x4){0u, 0u, 0u, 0u};
            if (row + 1 < se) nxt = *(const u32x4*)(p.Z + (size_t)(row + 1) * NIN + c);
            float o[8];
#pragma unroll
            for (int i = 0; i < 4; ++i) {
                o[2 * i] = w0[2 * i] * lo_bf(prev[i]) + w1[2 * i] * lo_bf(cur[i]) + w2[2 * i] * lo_bf(nxt[i]);
                o[2 * i + 1] = w0[2 * i + 1] * hi_bf(prev[i]) + w1[2 * i + 1] * hi_bf(cur[i]) + w2[2 * i + 1] * hi_bf(nxt[i]);
            }
            if (c >= 768 && c < 896) {
#pragma unroll
                for (int i = 0; i < 8; ++i) o[i] = tanhf_(o[i]);
            } else if (c >= 1024) {
#pragma unroll
                for (int i = 0; i < 8; ++i) o[i] = sigmoidf_(o[i]);
            }
            u32x4 w; w.x = pack2(o[0], o[1]); w.y = pack2(o[2], o[3]); w.z = pack2(o[4], o[5]); w.w = pack2(o[6], o[7]);
            const int tl = tg * 16 + tt;
            if (c < 768) *(u32x4*)(p.RKV + (size_t)row * 768 + c) = w;
            else if (c < 896) *(u32x4*)(XW + tl * 136 + (c - 768)) = w;
            else if (c < 1024) *(u32x4*)(XA + tl * 136 + (c - 896)) = w;
            else *(u32x4*)(XG + tl * 136 + (c - 1024)) = w;
            prev = cur; cur = nxt;
        }
    }
    __syncthreads();
#pragma unroll 1
    for (int mh = 0; mh < 10; ++mh) {
        const int mat = mh >> 1, nh = mh & 1;
        const int d = mat & 1; const bf16_t* As; const bf16_t* Bw; int kofs, nks, ldw;
        if (mat < 2) { As = XW; Bw = p.W2t + d * 256 * 64; kofs = d * 64; nks = 2; ldw = 64; }
        else if (mat < 4) { As = XA; Bw = p.A2t + d * 256 * 64; kofs = d * 64; nks = 2; ldw = 64; }
        else { As = XG; Bw = p.G2t; kofs = 0; nks = 4; ldw = 128; }
        f32x4 acc[4][2];
#pragma unroll
        for (int m = 0; m < 4; ++m)
#pragma unroll
            for (int n = 0; n < 2; ++n) acc[m][n] = (f32x4){0.f, 0.f, 0.f, 0.f};
#pragma unroll 1
        for (int ks = 0; ks < nks; ++ks) {
            bf16x8 af[4], bfr[2];
#pragma unroll
            for (int m = 0; m < 4; ++m) af[m] = *(const bf16x8*)(As + (m * 16 + fr) * 136 + kofs + ks * 32 + fq * 8);
#pragma unroll
            for (int n = 0; n < 2; ++n) bfr[n] = *(const bf16x8*)(Bw + (size_t)(wid * 64 + nh * 32 + n * 16 + fr) * ldw + ks * 32 + fq * 8);
#pragma unroll
            for (int m = 0; m < 4; ++m)
#pragma unroll
                for (int n = 0; n < 2; ++n) acc[m][n] = __builtin_amdgcn_mfma_f32_16x16x32_bf16(af[m], bfr[n], acc[m][n], 0, 0, 0);
        }
#pragma unroll
        for (int n = 0; n < 2; ++n) {
            const int c = wid * 64 + nh * 32 + n * 16 + fr;
            float bias = 0.f; if (mat < 2) bias = p.rw_w0[(l * 2 + d) * 256 + c]; else if (mat < 4) bias = p.rw_a0[(l * 2 + d) * 256 + c];
            bf16_t* dst; float mul;
            if (mat < 2) { dst = p.Ee + ((size_t)d * M_ALL + R0) * 256 + c; mul = 0.6065306597126334f; }
            else if (mat < 4) { dst = p.Aa + ((size_t)d * M_ALL + R0) * 256 + c; mul = 1.0f; }
            else { dst = p.Gg + (size_t)R0 * 256 + c; mul = 1.0f; }
#pragma unroll
            for (int m = 0; m < 4; ++m)
#pragma unroll
                for (int j = 0; j < 4; ++j) {
                    const float x = acc[m][n][j] + bias;
                    dst[(size_t)(m * 16 + fq * 4 + j) * 256] = f2bf(mat < 4 ? mul * sigmoidf_(x) : x);
                }
        }
    }
    __syncthreads();
}
__device__ __forceinline__ void rowscale128(const bf16_t* Z, int R0, int zoff, int ncols, float eps, float* rs) {
    const int tid = opaque_tid(); const int r = tid >> 1, half = tid & 1; const int per = ncols >> 1;
    const bf16_t* zp = Z + (size_t)(R0 + r) * NIN + zoff + half * per;
    float ss = 0.f;
    for (int i = 0; i < per; i += 8) { const u32x4 w = *(const u32x4*)(zp + i);
#pragma unroll
        for (int q = 0; q < 4; ++q) { const float a = lo_bf(w[q]), b = hi_bf(w[q]); ss += a * a + b * b; } }
    ss = dpp_add<0xB1>(ss);
    if (half == 0) rs[r] = rsqrtf(ss / (float)ncols + eps);
}
__device__ __forceinline__ void small_unit(const P& p, int l, int u) {
    const int tid = opaque_tid(), sub = tid >> 5, li = tid & 31;
    if (u < 2560) {
        const int row = u * 8 + sub; const bf16_t* zr = p.Z + (size_t)row * NIN;
        const u32x2 w = *(const u32x2*)(zr + ZKV + li * 4);
        const float z0 = lo_bf(w.x), z1 = hi_bf(w.x), z2 = lo_bf(w.y), z3 = hi_bf(w.y);
        float ss = z0 * z0 + z1 * z1 + z2 * z2 + z3 * z3; ss = red16(ss); ss += __shfl_xor(ss, 16);
        const float rsv = rsqrtf(ss * (1.0f / 128.0f) + 1e-6f);
        const float x1 = bf2f(zr[ZKR + (li & 15)]), x2 = bf2f(zr[ZKR + 16 + (li & 15)]);
        float val;
        if (row < M_CTX) {
            const int b = row >> 8, t = row & 255; const size_t o = ((size_t)(b * 4 + l) * 256 + t);
            const f32x4 g = *(const f32x4*)(p.kv_norm + l * 128 + li * 4);
            *(f32x4*)(p.out + 20971520 + o * 128 + li * 4) = (f32x4){z0 * rsv * g[0], z1 * rsv * g[1], z2 * rsv * g[2], z3 * rsv * g[3]};
            val = li < 16 ? x1 : x2;
            p.out[20971520 + 2097152 + o * 32 + li] = val;
        } else {
            const int t = (row - M_CTX) & 4095; const float cv = p.ropeC[t * 16 + (li & 15)], sv = p.ropeS[t * 16 + (li & 15)];
            val = li < 16 ? x1 * cv - x2 * sv : x1 * sv + x2 * cv;
        }
        const bf16_t bv = f2bf(val);
#pragma unroll
        for (int h = 0; h < 8; ++h) p.Kb[(size_t)row * 768 + h * 96 + 64 + li] = bv;
    } else {
        const int r = (u - 2560) * 8 + sub; const int b = r >> 9, t = r & 511;
        const bf16_t bv = f2bf(p.cache_krope[((size_t)(b * 4 + l) * 512 + t) * 32 + li]);
#pragma unroll
        for (int h = 0; h < 8; ++h) p.Kc[(size_t)r * 768 + h * 96 + 64 + li] = bv;
    }
}
__device__ __forceinline__ void gmlp_unit(const P& p, int l, int u, char* smem) {
    const int tid = opaque_tid(), lane = tid & 63, wid = tid >> 6, fr = lane & 15, fq = lane >> 4;
    const int R0 = (u >> 2) * 128, g = u & 3;
    bf16_t* VnT = (bf16_t*)smem;
    {
        const int tok = tid >> 1, half = tid & 1; const bf16_t* zp = p.Z + (size_t)(R0 + tok) * NIN + ZV + g * 64 + half * 32;
        float x[32];
#pragma unroll
        for (int i = 0; i < 4; ++i) { const u32x4 w = *(const u32x4*)(zp + i * 8);
#pragma unroll
            for (int q = 0; q < 4; ++q) { x[i * 8 + 2 * q] = geluf_(lo_bf(w[q])); x[i * 8 + 2 * q + 1] = geluf_(hi_bf(w[q])); } }
        float s = 0.f;
#pragma unroll
        for (int i = 0; i < 32; ++i) s += x[i];
        s = dpp_add<0xB1>(s); const float mu = s * (1.0f / 64.0f);
        float q2 = 0.f;
#pragma unroll
        for (int i = 0; i < 32; ++i) { const float d = x[i] - mu; q2 += d * d; }
        q2 = dpp_add<0xB1>(q2); const float rstd = rsqrtf(q2 * (1.0f / 64.0f) + 1e-5f);
        const float* gg = p.gm_g + l * 256 + g * 64 + half * 32; const float* gb = p.gm_b + l * 256 + g * 64 + half * 32;
#pragma unroll
        for (int i = 0; i < 32; ++i) VnT[(half * 32 + i) * 136 + tok] = f2bf((x[i] - mu) * rstd * gg[i] + gb[i]);
    }
    __syncthreads();
    f32x4 acc[2][4];
#pragma unroll
    for (int m = 0; m < 2; ++m)
#pragma unroll
        for (int n = 0; n < 4; ++n) acc[m][n] = (f32x4){0.f, 0.f, 0.f, 0.f};
    const bf16_t* Wg = p.WsB + g * 128 * 128;
#pragma unroll
    for (int ks = 0; ks < 4; ++ks) {
        bf16x8 af[2], bfr[4];
#pragma unroll
        for (int m = 0; m < 2; ++m) af[m] = *(const bf16x8*)(Wg + (wid * 32 + m * 16 + fr) * 128 + ks * 32 + fq * 8);
#pragma unroll
        for (int n = 0; n < 4; ++n) bfr[n] = *(const bf16x8*)(VnT + (n * 16 + fr) * 136 + ks * 32 + fq * 8);
#pragma unroll
        for (int m = 0; m < 2; ++m)
#pragma unroll
            for (int n = 0; n < 4; ++n) acc[m][n] = __builtin_amdgcn_mfma_f32_16x16x32_bf16(af[m], bfr[n], acc[m][n], 0, 0, 0);
    }
#pragma unroll
    for (int m = 0; m < 2; ++m)
#pragma unroll
        for (int j = 0; j < 4; ++j) {
            const int pp = wid * 32 + m * 16 + fq * 4 + j; const float bs = p.gm_bs[l * 512 + g * 128 + pp];
#pragma unroll
            for (int n = 0; n < 4; ++n) { const int c = n * 16 + fr;
                const float uu = geluf_(bf2f(p.Z[(size_t)(R0 + pp) * NIN + ZU + g * 64 + c]));
                p.hbmix[(size_t)(R0 + pp) * DM + 768 + g * 64 + c] = f2bf(uu * (acc[m][n][j] + bs)); }
        }
    __syncthreads();
}

__device__ __forceinline__ void scan_unit(const P& p, int l, int u, char* smem) {
    const int tid = opaque_tid(), lane = tid & 63, wid = tid >> 6;
    int b, T, row0; const bool lat = u < 128;
    if (lat) { b = u >> 5; T = 4096; row0 = M_CTX + b * 4096; } else { b = (u - 128) >> 5; T = 256; row0 = b * 256; }
    const int h = (u >> 3) & 3, d = (u >> 2) & 1, rsl = u & 3;
    float* W = (float*)smem; float* NKK = W + 2048; float* KKA = NKK + 2048; float* KD = KKA + 2048; float* RR = KD + 2048; float* VS = RR + 2048; float* OUT = VS + 512;
    const int rl = lane >> 4, kq = lane & 15; const int r16 = wid * 4 + rl; const int row = rsl * 16 + r16;
    f32x4 S = (f32x4){0.f, 0.f, 0.f, 0.f};
    const size_t stoff = ((((size_t)b * 4 + l) * 2 + d) * 4 + h) * 4096 + row * 64 + kq * 4;
    if (lat) S = *(const f32x4*)(p.state_rwkv + stoff);
    const int tok = tid >> 3, cg8 = tid & 7;
    float kkp[8], kap[8];
#pragma unroll
    for (int i = 0; i < 8; ++i) { kkp[i] = p.rw_kk[l * 256 + h * 64 + cg8 * 8 + i]; kap[i] = p.rw_ka[l * 256 + h * 64 + cg8 * 8 + i]; }
    const int nch = T >> 5;
    u32x4 r8, k8, e8, a8, v8;
    int grow;
    {
        const int sidx = tok; const int t = d ? T - 1 - sidx : sidx; grow = row0 + t;
        r8 = *(const u32x4*)(p.RKV + (size_t)grow * 768 + h * 64 + cg8 * 8);
        k8 = *(const u32x4*)(p.RKV + (size_t)grow * 768 + 256 + h * 64 + cg8 * 8);
        v8 = *(const u32x4*)(p.RKV + (size_t)grow * 768 + 512 + h * 64 + rsl * 16 + (cg8 & 1) * 8);
        e8 = *(const u32x4*)(p.Ee + ((size_t)d * M_ALL + grow) * 256 + h * 64 + cg8 * 8);
        a8 = *(const u32x4*)(p.Aa + ((size_t)d * M_ALL + grow) * 256 + h * 64 + cg8 * 8);
    }
    for (int ch = 0; ch < nch; ++ch) {
        {
            float kf[8], kkv[8], rf[8], ef[8], af[8];
#pragma unroll
            for (int q = 0; q < 4; ++q) { kf[2 * q] = lo_bf(k8[q]); kf[2 * q + 1] = hi_bf(k8[q]); rf[2 * q] = lo_bf(r8[q]); rf[2 * q + 1] = hi_bf(r8[q]);
                ef[2 * q] = lo_bf(e8[q]); ef[2 * q + 1] = hi_bf(e8[q]); af[2 * q] = lo_bf(a8[q]); af[2 * q + 1] = hi_bf(a8[q]); }
            float ss = 0.f;
#pragma unroll
            for (int i = 0; i < 8; ++i) { kkv[i] = kf[i] * kkp[i]; ss += kkv[i] * kkv[i]; }
            ss = red8(ss);
            const float inv = rsqrtf(fmaxf(ss, 1e-24f));
            f32x4 o0, o1; const int base = tok * 64 + cg8 * 8;
#pragma unroll
            for (int i = 0; i < 4; ++i) { o0[i] = __expf(-ef[i]); o1[i] = __expf(-ef[4 + i]); }
            *(f32x4*)(W + base) = o0; *(f32x4*)(W + base + 4) = o1;
#pragma unroll
            for (int i = 0; i < 4; ++i) { o0[i] = -kkv[i] * inv; o1[i] = -kkv[4 + i] * inv; }
            *(f32x4*)(NKK + base) = o0; *(f32x4*)(NKK + base + 4) = o1;
#pragma unroll
            for (int i = 0; i < 4; ++i) { o0[i] = kkv[i] * inv * af[i]; o1[i] = kkv[4 + i] * inv * af[4 + i]; }
            *(f32x4*)(KKA + base) = o0; *(f32x4*)(KKA + base + 4) = o1;
#pragma unroll
            for (int i = 0; i < 4; ++i) { o0[i] = kf[i] * (1.0f + (af[i] - 1.0f) * kap[i]); o1[i] = kf[4 + i] * (1.0f + (af[4 + i] - 1.0f) * kap[4 + i]); }
            *(f32x4*)(KD + base) = o0; *(f32x4*)(KD + base + 4) = o1;
#pragma unroll
            for (int i = 0; i < 4; ++i) { o0[i] = rf[i]; o1[i] = rf[4 + i]; }
            *(f32x4*)(RR + base) = o0; *(f32x4*)(RR + base + 4) = o1;
            if (cg8 < 2) {
#pragma unroll
                for (int q = 0; q < 4; ++q) { VS[tok * 16 + cg8 * 8 + 2 * q] = lo_bf(v8[q]); VS[tok * 16 + cg8 * 8 + 2 * q + 1] = hi_bf(v8[q]); }
            }
        }
        __syncthreads();
        const int grow_cur = grow;
        if (ch + 1 < nch) {
            const int sidx = (ch + 1) * 32 + tok; const int t = d ? T - 1 - sidx : sidx; grow = row0 + t;
            r8 = *(const u32x4*)(p.RKV + (size_t)grow * 768 + h * 64 + cg8 * 8);
            k8 = *(const u32x4*)(p.RKV + (size_t)grow * 768 + 256 + h * 64 + cg8 * 8);
            v8 = *(const u32x4*)(p.RKV + (size_t)grow * 768 + 512 + h * 64 + rsl * 16 + (cg8 & 1) * 8);
            e8 = *(const u32x4*)(p.Ee + ((size_t)d * M_ALL + grow) * 256 + h * 64 + cg8 * 8);
            a8 = *(const u32x4*)(p.Aa + ((size_t)d * M_ALL + grow) * 256 + h * 64 + cg8 * 8);
        }
#pragma unroll 4
        for (int s = 0; s < 32; ++s) {
            const f32x4 w = *(const f32x4*)(W + s * 64 + kq * 4), nk = *(const f32x4*)(NKK + s * 64 + kq * 4), ka = *(const f32x4*)(KKA + s * 64 + kq * 4),
                        kd = *(const f32x4*)(KD + s * 64 + kq * 4), rr = *(const f32x4*)(RR + s * 64 + kq * 4);
            const float v = VS[s * 16 + r16];
            float pd = S[0] * nk[0] + S[1] * nk[1] + S[2] * nk[2] + S[3] * nk[3];
            pd = red16(pd);
#pragma unroll
            for (int i = 0; i < 4; ++i) S[i] = fmaf(S[i], w[i], fmaf(pd, ka[i], v * kd[i]));
            float o = S[0] * rr[0] + S[1] * rr[1] + S[2] * rr[2] + S[3] * rr[3];
            o = red16(o);
            if (kq == 0) OUT[s * 16 + r16] = o;
        }
        __syncthreads();
        {
            const int rr2 = cg8 * 2; const f32x2 ov = *(const f32x2*)(OUT + tok * 16 + rr2);
            *(f32x2*)(p.ydir + ((size_t)d * M_ALL + grow_cur) * 256 + h * 64 + rsl * 16 + rr2) = ov;
        }
    }
    if (!lat) *(f32x4*)(p.out + 20971520 + 2097152 + 524288 + stoff) = S;
    __syncthreads();
}

#define KS_STRIDE 104
#define VS_STRIDE 72
#define KS_BYTES (64 * KS_STRIDE * 2)
#define ATT_STAGE (KS_BYTES + 64 * VS_STRIDE * 2)
__device__ __forceinline__ void attn_unit(const P& p, int u, char* smem) {
    const int tid = opaque_tid(), lane = tid & 63, wid = tid >> 6, q = lane & 31, hf = lane >> 5;
    int b, h, qt, qrow0, krow0, nown, ntot, Tv; size_t vbase, vcbase = 0; int kcrow0 = 0;
    if (u < 1024) { b = u >> 8; h = (u >> 5) & 7; qt = u & 31; krow0 = M_CTX + b * 4096; qrow0 = krow0 + qt * 128; nown = 64; ntot = 72; Tv = 4096;
        vbase = 2097152 + (size_t)(b * 8 + h) * 64 * 4096; kcrow0 = b * 512; vcbase = (size_t)(b * 8 + h) * 64 * 512; }
    else { const int v = u - 1024; b = v >> 4; h = (v >> 1) & 7; qt = v & 1; krow0 = b * 256; qrow0 = krow0 + qt * 128; nown = 4; ntot = 4; Tv = 256; vbase = (size_t)(b * 8 + h) * 64 * 256; }
    bf16x8 qf[6];
    { const bf16_t* qp = p.Qb + (size_t)(qrow0 + wid * 32 + q) * 768 + h * 96 + hf * 8;
#pragma unroll
      for (int ks = 0; ks < 6; ++ks) qf[ks] = *(const bf16x8*)(qp + ks * 16); }
    f32x16 oT[2];
#pragma unroll
    for (int i = 0; i < 16; ++i) { oT[0][i] = 0.f; oT[1][i] = 0.f; }
    float mrun = -1e30f, lrun = 0.f;
    u32x4 rk[3], rv[2];
    int krow[3], kc[3];
#pragma unroll
    for (int i = 0; i < 3; ++i) { const int c = tid + 256 * i; krow[i] = c / 12; kc[i] = c % 12; }
    const int vdv0 = tid >> 3, vkc = tid & 7;
#define ATT_LOAD(kt) do { const bf16_t* kptr; const bf16_t* vptr; int vstr; \
        if ((kt) < nown) { kptr = p.Kb + (size_t)(krow0 + (kt) * 64) * 768 + h * 96; vptr = p.Vt + vbase + (kt) * 64; vstr = Tv; } \
        else { kptr = p.Kc + (size_t)(kcrow0 + ((kt) - nown) * 64) * 768 + h * 96; vptr = p.Vtc + vcbase + ((kt) - nown) * 64; vstr = 512; } \
        _Pragma("unroll") for (int i = 0; i < 3; ++i) rk[i] = *(const u32x4*)(kptr + (size_t)krow[i] * 768 + kc[i] * 8); \
        _Pragma("unroll") for (int i = 0; i < 2; ++i) rv[i] = *(const u32x4*)(vptr + (size_t)(vdv0 + 32 * i) * vstr + vkc * 8); } while (0)
#define ATT_STORE(buf) do { char* Ks_ = smem + (buf) * ATT_STAGE; char* Vs_ = Ks_ + KS_BYTES; \
        _Pragma("unroll") for (int i = 0; i < 3; ++i) *(u32x4*)(Ks_ + (krow[i] * KS_STRIDE + kc[i] * 8) * 2) = rk[i]; \
        _Pragma("unroll") for (int i = 0; i < 2; ++i) *(u32x4*)(Vs_ + ((vdv0 + 32 * i) * VS_STRIDE + vkc * 8) * 2) = rv[i]; } while (0)
    ATT_LOAD(0); ATT_STORE(0);
    __syncthreads();
    for (int kt = 0; kt < ntot; ++kt) {
        const bool more = kt + 1 < ntot;
        if (more) ATT_LOAD(kt + 1);
        const char* Ks = smem + (kt & 1) * ATT_STAGE; const char* Vs = Ks + KS_BYTES;
        f32x16 sT[2];
#pragma unroll
        for (int i = 0; i < 16; ++i) { sT[0][i] = 0.f; sT[1][i] = 0.f; }
#pragma unroll
        for (int kb = 0; kb < 2; ++kb)
#pragma unroll
            for (int ks = 0; ks < 6; ++ks) { const bf16x8 kf = *(const bf16x8*)(Ks + ((kb * 32 + q) * KS_STRIDE + ks * 16 + hf * 8) * 2);
                sT[kb] = __builtin_amdgcn_mfma_f32_32x32x16_bf16(kf, qf[ks], sT[kb], 0, 0, 0); }
        float mx = sT[0][0];
#pragma unroll
        for (int i = 1; i < 16; ++i) mx = fmaxf(mx, sT[0][i]);
#pragma unroll
        for (int i = 0; i < 16; ++i) mx = fmaxf(mx, sT[1][i]);
        mx = fmaxf(mx, __shfl_xor(mx, 32));
        const float mnew = fmaxf(mrun, mx); const float alpha = exp2f(mrun - mnew); mrun = mnew;
        float psum = 0.f; bf16x8 pf[2][2];
#pragma unroll
        for (int kb = 0; kb < 2; ++kb)
#pragma unroll
            for (int s = 0; s < 2; ++s) { float e[8];
#pragma unroll
                for (int j = 0; j < 8; ++j) { e[j] = exp2f(sT[kb][8 * s + j] - mnew); psum += e[j]; }
                u32x4 w; w.x = pack2(e[0], e[1]); w.y = pack2(e[2], e[3]); w.z = pack2(e[4], e[5]); w.w = pack2(e[6], e[7]);
                pf[kb][s] = __builtin_bit_cast(bf16x8, w); }
        lrun = lrun * alpha + psum;
#pragma unroll
        for (int i = 0; i < 16; ++i) { oT[0][i] *= alpha; oT[1][i] *= alpha; }
#pragma unroll
        for (int kb = 0; kb < 2; ++kb)
#pragma unroll
            for (int s = 0; s < 2; ++s)
#pragma unroll
                for (int db = 0; db < 2; ++db) {
                    const char* vp = Vs + ((db * 32 + q) * VS_STRIDE + kb * 32 + 16 * s + 4 * hf) * 2;
                    const u32x2 lo = *(const u32x2*)vp, hi = *(const u32x2*)(vp + 16);
                    const u32x4 w = (u32x4){lo.x, lo.y, hi.x, hi.y};
                    oT[db] = __builtin_amdgcn_mfma_f32_32x32x16_bf16(__builtin_bit_cast(bf16x8, w), pf[kb][s], oT[db], 0, 0, 0);
                }
        if (more) ATT_STORE((kt + 1) & 1);
        __syncthreads();
    }
    const float lt = lrun + __shfl_xor(lrun, 32); const float inv = 1.0f / lt;
    bf16_t* op = p.hbmix + (size_t)(qrow0 + wid * 32 + q) * DM + 256 + h * 64;
#pragma unroll
    for (int db = 0; db < 2; ++db)
#pragma unroll
        for (int g = 0; g < 4; ++g) { u32x2 w; w.x = pack2(oT[db][4 * g] * inv, oT[db][4 * g + 1] * inv); w.y = pack2(oT[db][4 * g + 2] * inv, oT[db][4 * g + 3] * inv);
            *(u32x2*)(op + db * 32 + 8 * g + 4 * hf) = w; }
}

__device__ __forceinline__ void rwcomb_phase(const P& p, int l) {
    const int tid = opaque_tid(), lane = tid & 63, wid = tid >> 6; const int c = lane * 4;
    const f32x4 gng = *(const f32x4*)(p.rw_gn_g + l * 256 + c), gnb = *(const f32x4*)(p.rw_gn_b + l * 256 + c), kap = *(const f32x4*)(p.rw_ka + l * 256 + c), rkp = *(const f32x4*)(p.rw_rk + l * 256 + c);
    for (int row = blockIdx.x * 4 + wid; row < M_ALL; row += gridDim.x * 4) {
        const f32x4 y0 = *(const f32x4*)(p.ydir + (size_t)row * 256 + c), y1 = *(const f32x4*)(p.ydir + ((size_t)M_ALL + row) * 256 + c);
        f32x4 y = y0 + y1;
        float s = (y[0] + y[1]) + (y[2] + y[3]); s = red16(s); const float mu = s * (1.0f / 64.0f);
        const f32x4 dd = y - mu; float q2 = (dd[0] * dd[0] + dd[1] * dd[1]) + (dd[2] * dd[2] + dd[3] * dd[3]); q2 = red16(q2);
        const float rstd = rsqrtf(q2 * (1.0f / 64.0f) + 64e-5f);
        const f32x4 yn = dd * rstd * gng + gnb;
        const u32x2 rw = *(const u32x2*)(p.RKV + (size_t)row * 768 + c), kw = *(const u32x2*)(p.RKV + (size_t)row * 768 + 256 + c), vw = *(const u32x2*)(p.RKV + (size_t)row * 768 + 512 + c);
        const u32x2 a0w = *(const u32x2*)(p.Aa + (size_t)row * 256 + c), a1w = *(const u32x2*)(p.Aa + ((size_t)M_ALL + row) * 256 + c), gw = *(const u32x2*)(p.Gg + (size_t)row * 256 + c);
        const f32x4 r = (f32x4){lo_bf(rw.x), hi_bf(rw.x), lo_bf(rw.y), hi_bf(rw.y)}, k = (f32x4){lo_bf(kw.x), hi_bf(kw.x), lo_bf(kw.y), hi_bf(kw.y)}, v = (f32x4){lo_bf(vw.x), hi_bf(vw.x), lo_bf(vw.y), hi_bf(vw.y)};
        const f32x4 a0 = (f32x4){lo_bf(a0w.x), hi_bf(a0w.x), lo_bf(a0w.y), hi_bf(a0w.y)}, a1 = (f32x4){lo_bf(a1w.x), hi_bf(a1w.x), lo_bf(a1w.y), hi_bf(a1w.y)}, gt = (f32x4){lo_bf(gw.x), hi_bf(gw.x), lo_bf(gw.y), hi_bf(gw.y)};
        const f32x4 kds = k * (1.0f + (a0 - 1.0f) * kap) + k * (1.0f + (a1 - 1.0f) * kap);
        const f32x4 t4 = r * kds * rkp; float rk = (t4[0] + t4[1]) + (t4[2] + t4[3]); rk = red16(rk);
        const f32x4 o = (yn + rk * v) * gt;
        u32x2 w; w.x = pack2(o[0], o[1]); w.y = pack2(o[2], o[3]);
        *(u32x2*)(p.hbmix + (size_t)row * DM + c) = w;
    }
}

__global__ void __launch_bounds__(256, 2) mega(Args a_unused) {
    extern __shared__ __attribute__((aligned(16))) char smem[];
    __shared__ uint4 xbw; __shared__ int s_unit;
    kargp_t kp = (kargp_t)__builtin_amdgcn_kernarg_segment_ptr();
    const int tid = threadIdx.x; const int G = gridDim.x;
    if (tid == 0) xbw = make_uint4(0u, 0u, 0u, 0u);
    __syncthreads();
    XcdBarrier xb;
    { const P p = getP(kp); xb = xcd_barrier_post(p.bar, (volatile LAS unsigned*)&xbw); }
    for (int u = blockIdx.x; u < 384 + NCONV + 272; u += G) {
        if (u < 384) { const P p = getP(kp); ada_unit(p, u, smem); } else if (u < 384 + NCONV) { const P p = getP(kp); conv_unit(p, 0, u - 384, smem); } else { const P p = getP(kp); misc0_unit(p, u - 384 - NCONV); }
    }
    cg::this_grid().sync();
    { const P p = getP(kp); ln_phase(p, 0, 0); }
    xcd_barrier(xb);
    float* rs = (float*)(smem + RS_OFF);
#pragma unroll 1
    for (int l = 0; l < 4; ++l) {
        for (int u = blockIdx.x; u < 160 * 17; u += G) { const P p = getP(kp); const int mt = u / 17, nt = u % 17;
            EpiZ e{p.Z, mt * 128, nt * 128};
            gemm128(p.hbmix + (size_t)mt * 128 * DM, DM, p.WtIn + (size_t)nt * 128 * DM, DM, DM, smem, e); }
        xcd_barrier(xb);
        for (;;) {
            { const P pc = getP(kp); if (tid == 0) s_unit = atomicAdd(&pc.ctr[l * 2], 1); }
            __syncthreads(); int u = s_unit; __syncthreads();
            if (u >= 320 + 960 + 1408 + 2816 + 640) break;
            if (u < 320) { const P p = getP(kp); rwprep_unit(p, l, u, smem); continue; }
            u -= 320;
            if (u < 960) { const P p = getP(kp); const int mt = u / 6, nt = u % 6;
                rowscale128(p.Z, mt * 128, ZQ, 256, 1e-6f, rs);
                EpiQ e{p.Qb, rs, p.ropeC, p.ropeS, mt * 128, nt * 128};
                gemm128(p.Z + (size_t)mt * 128 * NIN + ZQ, NIN, p.WtQ + (size_t)nt * 128 * 256, 256, 256, smem, e); __syncthreads(); continue; }
            u -= 960;
            if (u < 1280) { const P p = getP(kp); const int mt = u >> 3, nt = u & 7; const int R0 = mt * 128; const bool latr = R0 >= M_CTX;
                rowscale128(p.Z, R0, ZKV, 128, 1e-6f, rs);
                EpiKV e{latr ? p.Kb + (size_t)M_CTX * 768 : p.Kb, p.Vt, rs, latr ? R0 - M_CTX : R0, nt * 128, latr ? 12 : 8, latr ? (size_t)2097152 : (size_t)0};
                gemm128(p.Z + (size_t)R0 * NIN + ZKV, NIN, p.WtKVn + (size_t)nt * 128 * 128, 128, 128, smem, e); __syncthreads(); continue; }
            u -= 1280;
            if (u < 128) { const P p = getP(kp); const int mt = u >> 3, nt = u & 7;
                EpiKV e{p.Kc, p.Vtc, nullptr, mt * 128, nt * 128, 9, (size_t)0};
                gemm128(p.CkvB + ((size_t)l * 2048 + mt * 128) * 128, 128, p.WtKV + (size_t)nt * 128 * 128, 128, 128, smem, e); continue; }
            u -= 128;
            if (u < 2816) { const P p = getP(kp); small_unit(p, l, u); continue; }
            u -= 2816;
            { const P p = getP(kp); gmlp_unit(p, l, u, smem); }
        }
        xcd_barrier(xb);
        for (;;) {
            { const P pc = getP(kp); if (tid == 0) s_unit = atomicAdd(&pc.ctr[l * 2 + 1], 1); }
            __syncthreads(); int u = s_unit; __syncthreads();
            if (u >= 640 + 1280) break;
            if (u < 640) { const P p = getP(kp); scan_unit(p, l, u, smem); } else { const P p = getP(kp); attn_unit(p, u - 640, smem); }
        }
        xcd_barrier(xb);
        { const P p = getP(kp); rwcomb_phase(p, l); }
        xcd_barrier(xb);
        for (int u = blockIdx.x; u < 160 * 8; u += G) { const P p = getP(kp); const int mt = u >> 3, nt = u & 7;
            EpiRes e{p.out, p.mod + ((size_t)l * 5 + modrow_of(mt * 128)) * 6144 + 2048, mt * 128, nt * 128};
            gemm128(p.hbmix + (size_t)mt * 128 * DM, DM, p.WtOut + (size_t)nt * 128 * DM, DM, DM, smem, e); }
        xcd_barrier(xb);
        { const P p = getP(kp); ln_phase(p, l, 1); }
        xcd_barrier(xb);
        for (int u = blockIdx.x; u < 160 * 44; u += G) { const P p = getP(kp); const int mt = u / 44, nt = u % 44;
            EpiSwi e{p.hidden, mt * 128, nt * 128};
            gemm128(p.hbmix + (size_t)mt * 128 * DM, DM, p.WtF1 + (size_t)nt * 128 * DM, DM, DM, smem, e); }
        xcd_barrier(xb);
        for (int u = blockIdx.x; u < 160 * 8; u += G) { const P p = getP(kp); const int mt = u >> 3, nt = u & 7;
            EpiRes e{p.out, p.mod + ((size_t)l * 5 + modrow_of(mt * 128)) * 6144 + 5120, mt * 128, nt * 128};
            gemm128(p.hidden + (size_t)mt * 128 * DFF, DFF, p.WtF2 + (size_t)nt * 128 * DFF, DFF, DFF, smem, e); }
        xcd_barrier(xb);
        { const P p = getP(kp); ln_phase(p, l, 2); }
        if (l < 3) { for (int u = blockIdx.x; u < NCONV; u += G) { const P p = getP(kp); conv_unit(p, l + 1, u, smem); } }
        xcd_barrier(xb);
    }
}

extern "C" void kernel_launch(void* const* d_in, const int* in_sizes, int n_in, void* d_out, int out_size, void* d_ws, size_t ws_size, hipStream_t stream) {
    static int grid_blocks = 0;
    if (!grid_blocks) {
        int dev = 0, cus = 0, per_cu = 0;
        (void)hipGetDevice(&dev);
        (void)hipDeviceGetAttribute(&cus, hipDeviceAttributeMultiprocessorCount, dev);
        (void)hipFuncSetAttribute((const void*)mega, hipFuncAttributeMaxDynamicSharedMemorySize, SMEM_BYTES);
        (void)hipOccupancyMaxActiveBlocksPerMultiprocessor(&per_cu, (const void*)mega, 256, SMEM_BYTES);
        if (per_cu > 2) per_cu = 2;
        if (per_cu < 1) per_cu = 1;
        grid_blocks = cus * per_cu;
    }
    if (WS_TOTAL > ws_size) { fprintf(stderr, "kernel_launch: workspace too small: need %zu have %zu\n", (size_t)WS_TOTAL, ws_size); return; }
    Args a{};
    for (int i = 0; i < 36; ++i) a.in[i] = (const float*)d_in[i];
    a.out = (float*)d_out; a.ws = (char*)d_ws;
    (void)hipMemsetAsync((char*)d_ws + OFF_BAR, 0, 16384 + 4096, stream);
    void* args[] = {&a};
    hipError_t e = hipLaunchCooperativeKernel((const void*)mega, dim3(grid_blocks), dim3(256), args, SMEM_BYTES, stream);
    if (e != hipSuccess) fprintf(stderr, "cooperative launch failed: %s (grid %d)\n", hipGetErrorString(e), grid_blocks);
}
```

```cpp
#include <hip/hip_runtime.h>
#include <hip/hip_cooperative_groups.h>
#include <cstdint>
#include <cstdio>
namespace cg = cooperative_groups;

typedef unsigned short bf16_t;
typedef short bf16x8 __attribute__((ext_vector_type(8)));
typedef float f32x4 __attribute__((ext_vector_type(4)));
typedef float f32x2 __attribute__((ext_vector_type(2)));
typedef float f32x16 __attribute__((ext_vector_type(16)));
typedef unsigned u32x4 __attribute__((ext_vector_type(4)));
typedef unsigned u32x2 __attribute__((ext_vector_type(2)));

#define M_ALL 20480
#define M_CTX 4096
#define DM 1024
#define NIN 2080
#define DFF 2816
#define ALPHA_F 1.6817928305074290f
#define QSCALE (0.10206207261596575f * 1.4426950408889634f)
#define LAS __attribute__((address_space(3)))
#ifndef DUP_P2
#define DUP_P2 1
#endif
#ifndef DUP_P3
#define DUP_P3 1
#endif
#ifndef DUP_P5
#define DUP_P5 1
#endif

#define ZQ 1152
#define ZKV 1408
#define ZKR 1536
#define ZU 1568
#define ZV 1824

#define LDS_STRIDE 72
#define TILE_BYTES (128 * LDS_STRIDE * 2)
#define RS_OFF (4 * TILE_BYTES)
#define SMEM_BYTES (RS_OFF + 3072)

struct P {
    const float *x_prompt, *x_sample, *cache_ckv, *cache_krope, *state_rwkv, *c, *c_ctx, *ada_w, *ada_b, *w_in, *rw_conv, *rw_w0, *rw_w2,
        *rw_a0, *rw_a2, *rw_g2, *rw_kk, *rw_ka, *rw_rk, *rw_gn_g, *rw_gn_b, *q_norm, *q_up, *kv_norm, *kv_up, *gm_g, *gm_b, *gm_ws, *gm_bs,
        *w_out, *ln1_g, *ln1_b, *ffn_in, *ffn_out, *ln2_g, *ln2_b;
    float* out;
    unsigned* bar; int* ctr; float* mod; float* ropeC; float* ropeS; bf16_t* CkvB;
    bf16_t *WtIn, *WtQ, *WtKVn, *WtKV, *WtOut, *WtF1, *WtF2, *WsB, *W2t, *A2t, *G2t;
    bf16_t *Z, *RKV, *Ee, *Aa, *Gg, *Qb, *Kb, *Kc, *Vt, *Vtc, *hbmix, *hidden;
    float* ydir;
};


struct Args { const float* in[36]; float* out; char* ws; };
typedef const __attribute__((address_space(4))) char* kargp_t;
constexpr size_t al256(size_t x) { return (x + 255) & ~(size_t)255; }
constexpr size_t OFF_BAR = 0;
constexpr size_t OFF_CTR = OFF_BAR + 16384;
constexpr size_t OFF_MOD = OFF_CTR + 4096;
constexpr size_t OFF_ROPEC = OFF_MOD + al256((size_t)4 * 5 * 6144 * 4);
constexpr size_t OFF_ROPES = OFF_ROPEC + 65536 * 4;
constexpr size_t OFF_CKVB = OFF_ROPES + 65536 * 4;
constexpr size_t OFF_WTIN = OFF_CKVB + (size_t)4 * 2048 * 128 * 2;
constexpr size_t OFF_WTQ = OFF_WTIN + (size_t)2176 * 1024 * 2;
constexpr size_t OFF_WTKVN = OFF_WTQ + (size_t)768 * 256 * 2;
constexpr size_t OFF_WTKV = OFF_WTKVN + (size_t)1024 * 128 * 2;
constexpr size_t OFF_WTOUT = OFF_WTKV + (size_t)1024 * 128 * 2;
constexpr size_t OFF_WTF1 = OFF_WTOUT + (size_t)1024 * 1024 * 2;
constexpr size_t OFF_WTF2 = OFF_WTF1 + (size_t)5632 * 1024 * 2;
constexpr size_t OFF_WSB = OFF_WTF2 + (size_t)1024 * DFF * 2;
constexpr size_t OFF_W2T = OFF_WSB + (size_t)65536 * 2;
constexpr size_t OFF_A2T = OFF_W2T + (size_t)2 * 256 * 64 * 2;
constexpr size_t OFF_G2T = OFF_A2T + (size_t)2 * 256 * 64 * 2;
constexpr size_t OFF_Z = OFF_G2T + (size_t)256 * 128 * 2;
constexpr size_t OFF_HIDDEN = OFF_Z;
constexpr size_t OFF_RKV = OFF_Z + al256((size_t)M_ALL * NIN * 2);
constexpr size_t OFF_EE = OFF_RKV + (size_t)M_ALL * 768 * 2;
constexpr size_t OFF_AA = OFF_EE + (size_t)2 * M_ALL * 256 * 2;
constexpr size_t OFF_GG = OFF_AA + (size_t)2 * M_ALL * 256 * 2;
constexpr size_t OFF_QB = OFF_GG + (size_t)M_ALL * 256 * 2;
constexpr size_t OFF_KB = OFF_QB + (size_t)M_ALL * 768 * 2;
constexpr size_t OFF_KC = OFF_KB + (size_t)M_ALL * 768 * 2;
constexpr size_t OFF_VT = OFF_KC + (size_t)2048 * 768 * 2;
constexpr size_t OFF_VTC = OFF_VT + (size_t)M_ALL * 512 * 2;
constexpr size_t OFF_YDIR = OFF_VTC + (size_t)2048 * 512 * 2;
constexpr size_t OFF_HBMIX = OFF_YDIR + (size_t)2 * M_ALL * 256 * 4;
constexpr size_t WS_TOTAL = OFF_HBMIX + (size_t)M_ALL * DM * 2;
static_assert(OFF_RKV + (size_t)M_ALL * 768 * 2 - OFF_HIDDEN >= (size_t)M_ALL * DFF * 2, "hidden overlay");

__device__ __forceinline__ P getP(kargp_t& kp) {
    asm volatile("" : "+s"(kp));
    typedef const float* const __attribute__((address_space(4)))* inp_t;
    inp_t in = (inp_t)kp;
    P p;
    p.x_prompt = in[0]; p.x_sample = in[1]; p.cache_ckv = in[2]; p.cache_krope = in[3]; p.state_rwkv = in[4]; p.c = in[5]; p.c_ctx = in[6];
    p.ada_w = in[7]; p.ada_b = in[8]; p.w_in = in[9]; p.rw_conv = in[10]; p.rw_w0 = in[11]; p.rw_w2 = in[12]; p.rw_a0 = in[13]; p.rw_a2 = in[14];
    p.rw_g2 = in[15]; p.rw_kk = in[16]; p.rw_ka = in[17]; p.rw_rk = in[18]; p.rw_gn_g = in[19]; p.rw_gn_b = in[20]; p.q_norm = in[21]; p.q_up = in[22];
    p.kv_norm = in[23]; p.kv_up = in[24]; p.gm_g = in[25]; p.gm_b = in[26]; p.gm_ws = in[27]; p.gm_bs = in[28]; p.w_out = in[29]; p.ln1_g = in[30];
    p.ln1_b = in[31]; p.ffn_in = in[32]; p.ffn_out = in[33]; p.ln2_g = in[34]; p.ln2_b = in[35];
    p.out = (float*)in[36]; char* ws = (char*)in[37];
    p.bar = (unsigned*)(ws + OFF_BAR); p.ctr = (int*)(ws + OFF_CTR); p.mod = (float*)(ws + OFF_MOD); p.ropeC = (float*)(ws + OFF_ROPEC); p.ropeS = (float*)(ws + OFF_ROPES);
    p.CkvB = (bf16_t*)(ws + OFF_CKVB); p.WtIn = (bf16_t*)(ws + OFF_WTIN); p.WtQ = (bf16_t*)(ws + OFF_WTQ); p.WtKVn = (bf16_t*)(ws + OFF_WTKVN); p.WtKV = (bf16_t*)(ws + OFF_WTKV);
    p.WtOut = (bf16_t*)(ws + OFF_WTOUT); p.WtF1 = (bf16_t*)(ws + OFF_WTF1); p.WtF2 = (bf16_t*)(ws + OFF_WTF2); p.WsB = (bf16_t*)(ws + OFF_WSB); p.W2t = (bf16_t*)(ws + OFF_W2T);
    p.A2t = (bf16_t*)(ws + OFF_A2T); p.G2t = (bf16_t*)(ws + OFF_G2T); p.Z = (bf16_t*)(ws + OFF_Z); p.RKV = (bf16_t*)(ws + OFF_RKV); p.Ee = (bf16_t*)(ws + OFF_EE); p.Aa = (bf16_t*)(ws + OFF_AA);
    p.Gg = (bf16_t*)(ws + OFF_GG); p.Qb = (bf16_t*)(ws + OFF_QB); p.Kb = (bf16_t*)(ws + OFF_KB); p.Kc = (bf16_t*)(ws + OFF_KC); p.Vt = (bf16_t*)(ws + OFF_VT); p.Vtc = (bf16_t*)(ws + OFF_VTC);
    p.hbmix = (bf16_t*)(ws + OFF_HBMIX); p.hidden = (bf16_t*)(ws + OFF_HIDDEN); p.ydir = (float*)(ws + OFF_YDIR);
    return p;
}

__device__ __forceinline__ float bf2f(bf16_t b) { return __uint_as_float(((unsigned)b) << 16); }
__device__ __forceinline__ unsigned pack2(float lo, float hi) { unsigned r; asm("v_cvt_pk_bf16_f32 %0, %1, %2" : "=v"(r) : "v"(lo), "v"(hi)); return r; }
__device__ __forceinline__ bf16_t f2bf(float f) { return (bf16_t)(pack2(f, 0.f) & 0xffffu); }
__device__ __forceinline__ float lo_bf(unsigned w) { return __uint_as_float(w << 16); }
__device__ __forceinline__ float hi_bf(unsigned w) { return __uint_as_float(w & 0xffff0000u); }
__device__ __forceinline__ float sigmoidf_(float x) { return __builtin_amdgcn_rcpf(1.0f + __builtin_amdgcn_exp2f(-1.4426950408889634f * x)); }
__device__ __forceinline__ float tanhf_(float x) { float e = __builtin_amdgcn_exp2f(2.8853900817779268f * x); return 1.0f - 2.0f * __builtin_amdgcn_rcpf(e + 1.0f); }
__device__ __forceinline__ float geluf_(float x) { return 0.5f * x * (1.0f + tanhf_(0.7978845608028654f * (x + 0.044715f * x * x * x))); }
template <int CTRL> __device__ __forceinline__ float dpp_add(float x) {
    int y = __builtin_amdgcn_update_dpp(0, __float_as_int(x), CTRL, 0xf, 0xf, false);
    return x + __int_as_float(y);
}
__device__ __forceinline__ float red4(float x) { x = dpp_add<0xB1>(x); x = dpp_add<0x4E>(x); return x; }
__device__ __forceinline__ float red8(float x) { x = red4(x); x = dpp_add<0x141>(x); return x; }
__device__ __forceinline__ float red16(float x) { x = red8(x); x = dpp_add<0x140>(x); return x; }
__device__ __forceinline__ int opaque_tid() { int t = threadIdx.x; asm volatile("" : "+v"(t)); return t; }
__device__ __forceinline__ int modrow_of(int row) { return row < M_CTX ? 0 : 1 + ((row - M_CTX) >> 12); }

#define XB_TMO 128
#define XB_XCNT(j) (256 + 64 * (j))
#define XB_XSUB(j) (1280 + 64 * (j))
#define XB_XGEN(j) (2304 + 64 * (j))
#define XB_TOP 3328
#define XB_TOPGEN 3392
#define XCD_BAR_WORDS 3456
#define XB_SPIN_CAP (1u << 22)
__device__ __forceinline__ unsigned xb_ld(unsigned* p) { return __hip_atomic_load(p, __ATOMIC_RELAXED, __HIP_MEMORY_SCOPE_AGENT); }
__device__ __forceinline__ unsigned xb_add(unsigned* p, unsigned v) { return __hip_atomic_fetch_add(p, v, __ATOMIC_RELAXED, __HIP_MEMORY_SCOPE_AGENT); }
__device__ __forceinline__ unsigned xb_xcc_id() { return (unsigned)__builtin_amdgcn_s_getreg((3 << 11) | 20) & 0xFu; }
#define XB_SPIN(cond, bar) do { unsigned _sp = 0; while (cond) { __builtin_amdgcn_s_sleep(1); \
    if ((++_sp & 255u) == 0u) { if (xb_ld(&(bar)[XB_TMO])) break; if (_sp > XB_SPIN_CAP) { atomicAdd(&(bar)[XB_TMO], 1u); break; } } } } while (0)
struct XcdBarrier { unsigned* bar; unsigned x; volatile LAS unsigned* st; };
__device__ __forceinline__ XcdBarrier xcd_barrier_post(unsigned* bar, volatile LAS unsigned* st) {
    XcdBarrier b; b.bar = bar; b.x = xb_xcc_id(); b.st = st;
    if (threadIdx.x == 0) (void)xb_add(&bar[XB_XCNT(b.x)], 1u);
    return b;
}
__device__ __forceinline__ void xcd_barrier_complete(unsigned* bar, unsigned x, unsigned& nloc, unsigned& nx) {
    const unsigned G = gridDim.x * gridDim.y * gridDim.z;
    unsigned sum, cnt, mine, sp = 0u;
    for (;;) {
        sum = 0u; cnt = 0u; mine = 0u;
#pragma unroll
        for (unsigned j = 0; j < 16; ++j) { const unsigned c = xb_ld(&bar[XB_XCNT(j)]); sum += c; cnt += (c > 0u) ? 1u : 0u; mine = (j == x) ? c : mine; }
        if (sum == G) break;
        __builtin_amdgcn_s_sleep(1);
        if ((++sp & 255u) == 0u) { if (xb_ld(&bar[XB_TMO])) break; if (sp > XB_SPIN_CAP) { atomicAdd(&bar[XB_TMO], 1u); break; } }
    }
    nloc = mine > 0u ? mine : 1u; nx = cnt > 0u ? cnt : 1u;
}
__device__ __forceinline__ void xcd_barrier(const XcdBarrier& b) {
    asm volatile("s_waitcnt vmcnt(0)" ::: "memory");
    __syncthreads();
    if (threadIdx.x == 0) {
        unsigned* bar = b.bar;
        __builtin_amdgcn_s_waitcnt(0);
        unsigned nloc = b.st[0], nx = b.st[1];
        if (nloc == 0u) { xcd_barrier_complete(bar, b.x, nloc, nx); b.st[0] = nloc; b.st[1] = nx; }
        const unsigned old = xb_add(&bar[XB_XSUB(b.x)], 1u);
        const unsigned gen = old / nloc;
        if (old + 1u == (gen + 1u) * nloc) {
            __builtin_amdgcn_fence(__ATOMIC_RELEASE, "agent");
            asm volatile("s_waitcnt vmcnt(0)" ::: "memory");
            const unsigned og = xb_add(&bar[XB_TOP], 1u);
            const unsigned tg = og / nx;
            if (og + 1u == (tg + 1u) * nx) xb_add(&bar[XB_TOPGEN], 1u);
            else XB_SPIN(xb_ld(&bar[XB_TOPGEN]) == tg, bar);
            __builtin_amdgcn_fence(__ATOMIC_ACQUIRE, "agent");
            xb_add(&bar[XB_XGEN(b.x)], 1u);
            asm volatile("s_waitcnt vmcnt(0)" ::: "memory");
        } else {
            XB_SPIN(xb_ld(&bar[XB_XGEN(b.x)]) == gen, bar);
            __builtin_amdgcn_fence(__ATOMIC_ACQUIRE, "agent");
            asm volatile("s_waitcnt vmcnt(0)" ::: "memory");
        }
    }
    __syncthreads();
}

template <class Epi>
__device__ __forceinline__ void gemm128(const bf16_t* __restrict__ A, int lda, const bf16_t* __restrict__ B, int ldb, int K, char* smem, const Epi& epi) {
    const int tid = opaque_tid(), lane = tid & 63, wid = tid >> 6, wr = wid >> 1, wc = wid & 1, fr = lane & 15, fq = lane >> 4;
    f32x4 acc[4][4];
#pragma unroll
    for (int m = 0; m < 4; ++m)
#pragma unroll
        for (int n = 0; n < 4; ++n) acc[m][n] = (f32x4){0.f, 0.f, 0.f, 0.f};
    const int crow = tid >> 3, ckc = tid & 7;
    const bf16_t* ap = A + (size_t)crow * lda + ckc * 8;
    const bf16_t* bp = B + (size_t)crow * ldb + ckc * 8;
    u32x4 ra[4], rb[4];
#pragma unroll
    for (int i = 0; i < 4; ++i) { ra[i] = *(const u32x4*)(ap + (size_t)(32 * i) * lda); rb[i] = *(const u32x4*)(bp + (size_t)(32 * i) * ldb); }
    {
        char* sa = smem; char* sb = smem + TILE_BYTES;
#pragma unroll
        for (int i = 0; i < 4; ++i) { *(u32x4*)(sa + ((crow + 32 * i) * LDS_STRIDE + ckc * 8) * 2) = ra[i]; *(u32x4*)(sb + ((crow + 32 * i) * LDS_STRIDE + ckc * 8) * 2) = rb[i]; }
    }
    __syncthreads();
    const int nk = K >> 6;
    for (int kt = 0; kt < nk; ++kt) {
        const bool more = (kt + 1 < nk);
        if (more) {
            const int k0 = (kt + 1) << 6;
#pragma unroll
            for (int i = 0; i < 4; ++i) { ra[i] = *(const u32x4*)(ap + (size_t)(32 * i) * lda + k0); rb[i] = *(const u32x4*)(bp + (size_t)(32 * i) * ldb + k0); }
        }
        const char* sa = smem + (kt & 1) * 2 * TILE_BYTES; const char* sb = sa + TILE_BYTES;
#pragma unroll
        for (int ks = 0; ks < 2; ++ks) {
            bf16x8 af[4], bfr[4];
#pragma unroll
            for (int m = 0; m < 4; ++m) af[m] = *(const bf16x8*)(sa + ((wr * 64 + m * 16 + fr) * LDS_STRIDE + ks * 32 + fq * 8) * 2);
#pragma unroll
            for (int n = 0; n < 4; ++n) bfr[n] = *(const bf16x8*)(sb + ((wc * 64 + n * 16 + fr) * LDS_STRIDE + ks * 32 + fq * 8) * 2);
#pragma unroll
            for (int m = 0; m < 4; ++m)
#pragma unroll
                for (int n = 0; n < 4; ++n) acc[m][n] = __builtin_amdgcn_mfma_f32_16x16x32_bf16(af[m], bfr[n], acc[m][n], 0, 0, 0);
        }
        if (more) {
            char* da = smem + ((kt + 1) & 1) * 2 * TILE_BYTES; char* db = da + TILE_BYTES;
#pragma unroll
            for (int i = 0; i < 4; ++i) { *(u32x4*)(da + ((crow + 32 * i) * LDS_STRIDE + ckc * 8) * 2) = ra[i]; *(u32x4*)(db + ((crow + 32 * i) * LDS_STRIDE + ckc * 8) * 2) = rb[i]; }
        }
        __syncthreads();
    }
    epi(acc, wr * 64, wc * 64, fr, fq);
}

struct EpiZ {
    bf16_t* Z; int R0, C0;
    __device__ __forceinline__ void operator()(f32x4 (&acc)[4][4], int r0, int c0, int fr, int fq) const {
#pragma unroll
        for (int n = 0; n < 4; ++n) { const int col = C0 + c0 + n * 16 + fr; if (col < NIN) {
#pragma unroll
            for (int m = 0; m < 4; ++m)
#pragma unroll
                for (int j = 0; j < 4; ++j) Z[(size_t)(R0 + r0 + m * 16 + fq * 4 + j) * NIN + col] = f2bf(acc[m][n][j]); } }
    }
};
struct EpiQ {
    bf16_t* Q; const float* rs; const float* ropeC; const float* ropeS; int R0, C0;
    __device__ __forceinline__ void operator()(f32x4 (&acc)[4][4], int r0, int c0, int fr, int fq) const {
        const bool lat = R0 >= M_CTX;
#pragma unroll
        for (int n = 0; n < 4; ++n) {
            const int cb = C0 + c0 + n * 16; const int hcs = cb % 96;
            if (lat && hcs == 80) continue;
            const bool rot = lat && hcs == 64;
#pragma unroll
            for (int m = 0; m < 4; ++m)
#pragma unroll
                for (int j = 0; j < 4; ++j) {
                    const int rl = r0 + m * 16 + fq * 4 + j; const int row = R0 + rl; const float s = rs[rl] * QSCALE;
                    const float x1 = acc[m][n][j] * s;
                    if (rot) {
                        const float x2 = acc[m][(n + 1) & 3][j] * s; const int t = (row - M_CTX) & 4095;
                        const float cv = ropeC[t * 16 + fr], sv = ropeS[t * 16 + fr];
                        Q[(size_t)row * 768 + cb + fr] = f2bf(x1 * cv - x2 * sv);
                        Q[(size_t)row * 768 + cb + 16 + fr] = f2bf(x1 * sv + x2 * cv);
                    } else Q[(size_t)row * 768 + cb + fr] = f2bf(x1);
                }
        }
    }
};
struct EpiKV {
    bf16_t* Kd; bf16_t* Vd; const float* rs; int R0, C0; int seqshift; size_t vbase0;
    __device__ __forceinline__ void operator()(f32x4 (&acc)[4][4], int r0, int c0, int fr, int fq) const {
#pragma unroll
        for (int n = 0; n < 4; ++n) {
            const int col = C0 + c0 + n * 16 + fr;
#pragma unroll
            for (int m = 0; m < 4; ++m) {
                const int rl = r0 + m * 16 + fq * 4; const int row = R0 + rl;
                float v[4];
#pragma unroll
                for (int j = 0; j < 4; ++j) v[j] = acc[m][n][j] * (rs ? rs[rl + j] : 1.0f);
                if (col < 512) {
                    const int h = col >> 6, d = col & 63;
#pragma unroll
                    for (int j = 0; j < 4; ++j) Kd[(size_t)(row + j) * 768 + h * 96 + d] = f2bf(v[j]);
                } else {
                    const int vc = col - 512, h = vc >> 6, dv = vc & 63; const int b = row >> seqshift, t = row & ((1 << seqshift) - 1);
                    u32x2 w; w.x = pack2(v[0], v[1]); w.y = pack2(v[2], v[3]);
                    *(u32x2*)(Vd + vbase0 + ((size_t)((b * 8 + h) * 64 + dv) << seqshift) + t) = w;
                }
            }
        }
    }
};
struct EpiRes {
    float* X; const float* gate; int R0, C0;
    __device__ __forceinline__ void operator()(f32x4 (&acc)[4][4], int r0, int c0, int fr, int fq) const {
#pragma unroll
        for (int n = 0; n < 4; ++n) { const int col = C0 + c0 + n * 16 + fr; const float g = gate[col];
#pragma unroll
            for (int m = 0; m < 4; ++m)
#pragma unroll
                for (int j = 0; j < 4; ++j) { float* px = X + (size_t)(R0 + r0 + m * 16 + fq * 4 + j) * DM + col; *px = ALPHA_F * (*px) + g * acc[m][n][j]; } }
    }
};
struct EpiSwi {
    bf16_t* H; int R0, C0;
    __device__ __forceinline__ void operator()(f32x4 (&acc)[4][4], int r0, int c0, int fr, int fq) const {
        const int hb = (C0 + c0) >> 1;
#pragma unroll
        for (int n = 0; n < 2; ++n)
#pragma unroll
            for (int m = 0; m < 4; ++m)
#pragma unroll
                for (int j = 0; j < 4; ++j) { const float g = acc[m][n][j], u = acc[m][n + 2][j];
                    H[(size_t)(R0 + r0 + m * 16 + fq * 4 + j) * DFF + hb + n * 16 + fr] = f2bf(g * sigmoidf_(g) * u); }
    }
};

__device__ __forceinline__ void ada_unit(const P& p, int u, char* smem) {
    const int tid = opaque_tid(); const int l = u / 96, c0 = (u % 96) * 64;
    float* cs = (float*)smem;
    for (int i = tid; i < 5 * 1024; i += 256) { const int r = i >> 10, k = i & 1023; const float v = (r == 0) ? p.c_ctx[k] : p.c[(r - 1) * 1024 + k]; cs[i] = v * sigmoidf_(v); }
    __syncthreads();
    const int col = tid & 63, kq = tid >> 6;
    float s0 = 0.f, s1 = 0.f, s2 = 0.f, s3 = 0.f, s4 = 0.f;
    const float* w = p.ada_w + ((size_t)l * 1024 + kq * 256) * 6144 + c0 + col;
    const float* cq = cs + kq * 256;
    for (int k = 0; k < 256; ++k) { const float wv = w[(size_t)k * 6144]; s0 += cq[k] * wv; s1 += cq[1024 + k] * wv; s2 += cq[2048 + k] * wv; s3 += cq[3072 + k] * wv; s4 += cq[4096 + k] * wv; }
    float* red = cs + 5 * 1024;
    red[(kq * 5 + 0) * 64 + col] = s0; red[(kq * 5 + 1) * 64 + col] = s1; red[(kq * 5 + 2) * 64 + col] = s2; red[(kq * 5 + 3) * 64 + col] = s3; red[(kq * 5 + 4) * 64 + col] = s4;
    __syncthreads();
    for (int o = tid; o < 320; o += 256) { const int i = o >> 6, cc = o & 63;
        const float v = red[(0 * 5 + i) * 64 + cc] + red[(1 * 5 + i) * 64 + cc] + red[(2 * 5 + i) * 64 + cc] + red[(3 * 5 + i) * 64 + cc] + p.ada_b[l * 6144 + c0 + cc];
        p.mod[((size_t)l * 5 + i) * 6144 + c0 + cc] = v; }
    __syncthreads();
}
__device__ __forceinline__ int map_col(int kind, int n) {
    if (kind == 1) { const int blk = n >> 6, r = n & 63; return r < 32 ? blk * 32 + r : DFF + blk * 32 + (r - 32); }
    if (kind == 2) { if (n < 512) return (n >> 6) * 128 + (n & 63); const int vc = n - 512; return (vc >> 6) * 128 + 64 + (vc & 63); }
    return n;
}
__device__ __forceinline__ void conv_tile(const float* src, int ldsrc, bf16_t* dst, bf16_t* dst2, int Kdst, int n0, int k0, int kind, int Nvalid, const float* kscale, char* smem) {
    const int tid = opaque_tid(); float* tile = (float*)smem;
    { const int j = tid & 63, i0 = tid >> 6; const int n = n0 + j; const int sc = (n < Nvalid) ? map_col(kind, n) : -1;
#pragma unroll 4
      for (int ii = 0; ii < 16; ++ii) { const int i = i0 + 4 * ii; tile[i * 65 + j] = (sc >= 0) ? src[(size_t)(k0 + i) * ldsrc + sc] : 0.f; } }
    __syncthreads();
    { const int i = tid & 63, j0 = tid >> 6; const float ks = kscale ? kscale[k0 + i] : 1.f;
#pragma unroll 4
      for (int jj = 0; jj < 16; ++jj) { const int jx = j0 + 4 * jj; const float v = tile[i * 65 + jx];
          dst[(size_t)(n0 + jx) * Kdst + k0 + i] = f2bf(v * ks); if (dst2) dst2[(size_t)(n0 + jx) * Kdst + k0 + i] = f2bf(v); } }
    __syncthreads();
}
#define NCONV 3032
__device__ __forceinline__ void conv_unit(const P& p, int l, int u, char* smem) {
    const float* src; int ldsrc; bf16_t* dst; bf16_t* dst2 = nullptr; int Kdst, n0, k0, kind = 0, Nvalid; const float* kscale = nullptr;
    if (u < 544) { src = p.w_in + (size_t)l * 1024 * NIN; ldsrc = NIN; dst = p.WtIn; Kdst = 1024; n0 = (u / 16) * 64; k0 = (u % 16) * 64; Nvalid = NIN; }
    else if (u < 592) { u -= 544; src = p.q_up + (size_t)l * 256 * 768; ldsrc = 768; dst = p.WtQ; Kdst = 256; n0 = (u / 4) * 64; k0 = (u % 4) * 64; Nvalid = 768; kscale = p.q_norm + l * 256; }
    else if (u < 624) { u -= 592; src = p.kv_up + (size_t)l * 128 * 1024; ldsrc = 1024; dst = p.WtKVn; dst2 = p.WtKV; Kdst = 128; n0 = (u / 2) * 64; k0 = (u % 2) * 64; kind = 2; Nvalid = 1024; kscale = p.kv_norm + l * 128; }
    else if (u < 880) { u -= 624; src = p.w_out + (size_t)l * 1024 * 1024; ldsrc = 1024; dst = p.WtOut; Kdst = 1024; n0 = (u / 16) * 64; k0 = (u % 16) * 64; Nvalid = 1024; }
    else if (u < 2288) { u -= 880; src = p.ffn_in + (size_t)l * 1024 * 5632; ldsrc = 5632; dst = p.WtF1; Kdst = 1024; n0 = (u / 16) * 64; k0 = (u % 16) * 64; kind = 1; Nvalid = 5632; }
    else if (u < 2992) { u -= 2288; src = p.ffn_out + (size_t)l * DFF * 1024; ldsrc = 1024; dst = p.WtF2; Kdst = DFF; n0 = (u / 44) * 64; k0 = (u % 44) * 64; Nvalid = 1024; }
    else if (u < 3008) { u -= 2992; const float* sp = p.gm_ws + (size_t)l * 65536 + u * 4096; bf16_t* d = p.WsB + u * 4096; for (int i = threadIdx.x; i < 4096; i += 256) d[i] = f2bf(sp[i]); return; }
    else if (u < 3016) { u -= 3008; const int d = u >> 2; src = p.rw_w2 + ((size_t)l * 2 + d) * 64 * 256; ldsrc = 256; dst = p.W2t + d * 256 * 64; Kdst = 64; n0 = (u & 3) * 64; k0 = 0; Nvalid = 256; }
    else if (u < 3024) { u -= 3016; const int d = u >> 2; src = p.rw_a2 + ((size_t)l * 2 + d) * 64 * 256; ldsrc = 256; dst = p.A2t + d * 256 * 64; Kdst = 64; n0 = (u & 3) * 64; k0 = 0; Nvalid = 256; }
    else { u -= 3024; src = p.rw_g2 + (size_t)l * 128 * 256; ldsrc = 256; dst = p.G2t; Kdst = 128; n0 = (u / 2) * 64; k0 = (u % 2) * 64; Nvalid = 256; }
    conv_tile(src, ldsrc, dst, dst2, Kdst, n0, k0, kind, Nvalid, kscale, smem);
}
__device__ __forceinline__ void misc0_unit(const P& p, int u) {
    const int tid = opaque_tid();
    if (u < 16) {
        for (int e = tid; e < 4096; e += 256) { const int idx = u * 4096 + e; const int t = idx >> 4, i = idx & 15;
            const float pos = (float)((i < 8) ? (t >> 6) : (t & 63)); const float inv = exp2f(-(float)(i & 7) * 1.6609640474436813f);
            const float ang = pos * inv; const float kf = rintf(ang * 0.15915494309189535f);
            float r = fmaf(-kf, 6.28318548202514648f, ang); r = fmaf(-kf, -1.74845553e-7f, r);
            p.ropeC[idx] = __cosf(r); p.ropeS[idx] = __sinf(r); }
    } else {
        const int v = u - 16;
        for (int e = tid; e < 4096; e += 256) { const int idx = v * 4096 + e;
            const int c = idx & 127, t = (idx >> 7) & 511, b = (idx >> 16) & 3, l = idx >> 18;
            p.CkvB[idx] = f2bf(p.cache_ckv[(((size_t)b * 4 + l) * 512 + t) * 128 + c]); }
    }
}

__device__ __forceinline__ void ln_phase(const P& p, int l, int which) {
    const int tid = opaque_tid(), lane = tid & 63, wid = tid >> 6;
    const float* g = which == 1 ? p.ln1_g + l * DM : p.ln2_g + l * DM; const float* bb = which == 1 ? p.ln1_b + l * DM : p.ln2_b + l * DM;
    const int ml = which == 2 ? l + 1 : l; const int shoff = which == 1 ? 3072 : 0, scoff = which == 1 ? 4096 : 1024;
    const bool dohb = !(which == 2 && l == 3);
    for (int row = blockIdx.x * 4 + wid; row < M_ALL; row += gridDim.x * 4) {
        float* xr = p.out + (size_t)row * DM;
        const float* src = which == 0 ? (row < M_CTX ? p.x_prompt + (size_t)row * DM : p.x_sample + (size_t)(row - M_CTX) * DM) : xr;
        f32x4 v[4];
#pragma unroll
        for (int i = 0; i < 4; ++i) v[i] = *(const f32x4*)(src + lane * 4 + 256 * i);
        if (which != 0) {
            float s = 0.f;
#pragma unroll
            for (int i = 0; i < 4; ++i) s += (v[i][0] + v[i][1]) + (v[i][2] + v[i][3]);
            s = red16(s); s += __shfl_xor(s, 16); s += __shfl_xor(s, 32);
            const float mu = s * (1.0f / 1024.0f); float q = 0.f;
#pragma unroll
            for (int i = 0; i < 4; ++i) { const f32x4 d = v[i] - mu; q += (d[0] * d[0] + d[1] * d[1]) + (d[2] * d[2] + d[3] * d[3]); }
            q = red16(q); q += __shfl_xor(q, 16); q += __shfl_xor(q, 32);
            const float rstd = rsqrtf(q * (1.0f / 1024.0f) + 1e-5f);
#pragma unroll
            for (int i = 0; i < 4; ++i) { const f32x4 gg = *(const f32x4*)(g + lane * 4 + 256 * i), bv = *(const f32x4*)(bb + lane * 4 + 256 * i); v[i] = (v[i] - mu) * rstd * gg + bv; }
        }
#pragma unroll
        for (int i = 0; i < 4; ++i) *(f32x4*)(xr + lane * 4 + 256 * i) = v[i];
        if (dohb) {
            const float* md = p.mod + ((size_t)ml * 5 + modrow_of(row)) * 6144;
#pragma unroll
            for (int i = 0; i < 4; ++i) { const f32x4 sh = *(const f32x4*)(md + shoff + lane * 4 + 256 * i), sc = *(const f32x4*)(md + scoff + lane * 4 + 256 * i);
                const f32x4 h = v[i] * (1.0f + sc) + sh; u32x2 w; w.x = pack2(h[0], h[1]); w.y = pack2(h[2], h[3]);
                *(u32x2*)(p.hbmix + (size_t)row * DM + lane * 4 + 256 * i) = w; }
        }
    }
}

__device__ __forceinline__ void rwprep_unit(const P& p, int l, int u, char* smem) {
    const int tid = opaque_tid(), lane = tid & 63, wid = tid >> 6, fr = lane & 15, fq = lane >> 4;
    const int R0 = u * 64;
    const int ss = R0 < M_CTX ? (R0 & ~255) : M_CTX + ((R0 - M_CTX) & ~4095); const int se = ss + (R0 < M_CTX ? 256 : 4096);
    bf16_t* XW = (bf16_t*)smem; bf16_t* XA = XW + 64 * 136; bf16_t* XG = XA + 64 * 136;
    const float* cw = p.rw_conv + (size_t)l * 3 * 1152;
    for (int it = tid; it < 576; it += 256) {
        const int cc = it % 144, tg = it / 144; const int c = cc * 8;
        float w0[8], w1[8], w2[8];
#pragma unroll
        for (int i = 0; i < 8; ++i) { w0[i] = cw[c + i]; w1[i] = cw[1152 + c + i]; w2[i] = cw[2304 + c + i]; }
        const int rfirst = R0 + tg * 16;
        u32x4 prev = (u32x4){0u, 0u, 0u, 0u}, cur, nxt;
        if (rfirst - 1 >= ss) prev = *(const u32x4*)(p.Z + (size_t)(rfirst - 1) * NIN + c);
        cur = *(const u32x4*)(p.Z + (size_t)rfirst * NIN + c);
        for (int tt = 0; tt < 16; ++tt) {
            const int row = rfirst + tt;
            nxt = (u32x4){0u, 0u, 0u, 0u};
            if (row + 1 < se) nxt = *(const u32x4*)(p.Z + (size_t)(row + 1) * NIN + c);
            float o[8];
#pragma unroll
            for (int i = 0; i < 4; ++i) {
                o[2 * i] = w0[2 * i] * lo_bf(prev[i]) + w1[2 * i] * lo_bf(cur[i]) + w2[2 * i] * lo_bf(nxt[i]);
                o[2 * i + 1] = w0[2 * i + 1] * hi_bf(prev[i]) + w1[2 * i + 1] * hi_bf(cur[i]) + w2[2 * i + 1] * hi_bf(nxt[i]);
            }
            if (c >= 768 && c < 896) {
#pragma unroll
                for (int i = 0; i < 8; ++i) o[i] = tanhf_(o[i]);
            } else if (c >= 1024) {
#pragma unroll
                for (int i = 0; i < 8; ++i) o[i] = sigmoidf_(o[i]);
            }
            u32x4 w; w.x = pack2(o[0], o[1]); w.y = pack2(o[2], o[3]); w.z = pack2(o[4], o[5]); w.w = pack2(o[6], o[7]);
            const int tl = tg * 16 + tt;
            if (c < 768) *(u32x4*)(p.RKV + (size_t)row * 768 + c) = w;
            else if (c < 896) *(u32x4*)(XW + tl * 136 + (c - 768)) = w;
            else if (c < 1024) *(u32x4*)(XA + tl * 136 + (c - 896)) = w;
            else *(u32x4*)(XG + tl * 136 + (c - 1024)) = w;
            prev = cur; cur = nxt;
        }
    }
    __syncthreads();
#pragma unroll 1
    for (int mh = 0; mh < 10; ++mh) {
        const int mat = mh >> 1, nh = mh & 1;
        const int d = mat & 1; const bf16_t* As; const bf16_t* Bw; int kofs, nks, ldw;
        if (mat < 2) { As = XW; Bw = p.W2t + d * 256 * 64; kofs = d * 64; nks = 2; ldw = 64; }
        else if (mat < 4) { As = XA; Bw = p.A2t + d * 256 * 64; kofs = d * 64; nks = 2; ldw = 64; }
        else { As = XG; Bw = p.G2t; kofs = 0; nks = 4; ldw = 128; }
        f32x4 acc[4][2];
#pragma unroll
        for (int m = 0; m < 4; ++m)
#pragma unroll
            for (int n = 0; n < 2; ++n) acc[m][n] = (f32x4){0.f, 0.f, 0.f, 0.f};
#pragma unroll 1
        for (int ks = 0; ks < nks; ++ks) {
            bf16x8 af[4], bfr[2];
#pragma unroll
            for (int m = 0; m < 4; ++m) af[m] = *(const bf16x8*)(As + (m * 16 + fr) * 136 + kofs + ks * 32 + fq * 8);
#pragma unroll
            for (int n = 0; n < 2; ++n) bfr[n] = *(const bf16x8*)(Bw + (size_t)(wid * 64 + nh * 32 + n * 16 + fr) * ldw + ks * 32 + fq * 8);
#pragma unroll
            for (int m = 0; m < 4; ++m)
#pragma unroll
                for (int n = 0; n < 2; ++n) acc[m][n] = __builtin_amdgcn_mfma_f32_16x16x32_bf16(af[m], bfr[n], acc[m][n], 0, 0, 0);
        }
#pragma unroll
        for (int n = 0; n < 2; ++n) {
            const int c = wid * 64 + nh * 32 + n * 16 + fr;
            float bias = 0.f; if (mat < 2) bias = p.rw_w0[(l * 2 + d) * 256 + c]; else if (mat < 4) bias = p.rw_a0[(l * 2 + d) * 256 + c];
            bf16_t* dst; float mul;
            if (mat < 2) { dst = p.Ee + ((size_t)d * M_ALL + R0) * 256 + c; mul = 0.6065306597126334f; }
            else if (mat < 4) { dst = p.Aa + ((size_t)d * M_ALL + R0) * 256 + c; mul = 1.0f; }
            else { dst = p.Gg + (size_t)R0 * 256 + c; mul = 1.0f; }
#pragma unroll
            for (int m = 0; m < 4; ++m)
#pragma unroll
                for (int j = 0; j < 4; ++j) {
                    const float x = acc[m][n][j] + bias;
                    dst[(size_t)(m * 16 + fq * 4 + j) * 256] = f2bf(mat < 4 ? mul * sigmoidf_(x) : x);
                }
        }
    }
    __syncthreads();
}
__device__ __forceinline__ void rowscale128(const bf16_t* Z, int R0, int zoff, int ncols, float eps, float* rs) {
    const int tid = opaque_tid(); const int r = tid >> 1, half = tid & 1; const int per = ncols >> 1;
    const bf16_t* zp = Z + (size_t)(R0 + r) * NIN + zoff + half * per;
    float ss = 0.f;
    for (int i = 0; i < per; i += 8) { const u32x4 w = *(const u32x4*)(zp + i);
#pragma unroll
        for (int q = 0; q < 4; ++q) { const float a = lo_bf(w[q]), b = hi_bf(w[q]); ss += a * a + b * b; } }
    ss = dpp_add<0xB1>(ss);
    if (half == 0) rs[r] = rsqrtf(ss / (float)ncols + eps);
}
__device__ __forceinline__ void small_unit(const P& p, int l, int u) {
    const int tid = opaque_tid(), sub = tid >> 5, li = tid & 31;
    if (u < 2560) {
        const int row = u * 8 + sub; const bf16_t* zr = p.Z + (size_t)row * NIN;
        const u32x2 w = *(const u32x2*)(zr + ZKV + li * 4);
        const float z0 = lo_bf(w.x), z1 = hi_bf(w.x), z2 = lo_bf(w.y), z3 = hi_bf(w.y);
        float ss = z0 * z0 + z1 * z1 + z2 * z2 + z3 * z3; ss = red16(ss); ss += __shfl_xor(ss, 16);
        const float rsv = rsqrtf(ss * (1.0f / 128.0f) + 1e-6f);
        const float x1 = bf2f(zr[ZKR + (li & 15)]), x2 = bf2f(zr[ZKR + 16 + (li & 15)]);
        float val;
        if (row < M_CTX) {
            const int b = row >> 8, t = row & 255; const size_t o = ((size_t)(b * 4 + l) * 256 + t);
            const f32x4 g = *(const f32x4*)(p.kv_norm + l * 128 + li * 4);
            *(f32x4*)(p.out + 20971520 + o * 128 + li * 4) = (f32x4){z0 * rsv * g[0], z1 * rsv * g[1], z2 * rsv * g[2], z3 * rsv * g[3]};
            val = li < 16 ? x1 : x2;
            p.out[20971520 + 2097152 + o * 32 + li] = val;
        } else {
            const int t = (row - M_CTX) & 4095; const float cv = p.ropeC[t * 16 + (li & 15)], sv = p.ropeS[t * 16 + (li & 15)];
            val = li < 16 ? x1 * cv - x2 * sv : x1 * sv + x2 * cv;
        }
        const bf16_t bv = f2bf(val);
#pragma unroll
        for (int h = 0; h < 8; ++h) p.Kb[(size_t)row * 768 + h * 96 + 64 + li] = bv;
    } else {
        const int r = (u - 2560) * 8 + sub; const int b = r >> 9, t = r & 511;
        const bf16_t bv = f2bf(p.cache_krope[((size_t)(b * 4 + l) * 512 + t) * 32 + li]);
#pragma unroll
        for (int h = 0; h < 8; ++h) p.Kc[(size_t)r * 768 + h * 96 + 64 + li] = bv;
    }
}
__device__ __forceinline__ void gmlp_unit(const P& p, int l, int u, char* smem) {
    const int tid = opaque_tid(), lane = tid & 63, wid = tid >> 6, fr = lane & 15, fq = lane >> 4;
    const int R0 = (u >> 2) * 128, g = u & 3;
    bf16_t* VnT = (bf16_t*)smem;
    {
        const int tok = tid >> 1, half = tid & 1; const bf16_t* zp = p.Z + (size_t)(R0 + tok) * NIN + ZV + g * 64 + half * 32;
        float x[32];
#pragma unroll
        for (int i = 0; i < 4; ++i) { const u32x4 w = *(const u32x4*)(zp + i * 8);
#pragma unroll
            for (int q = 0; q < 4; ++q) { x[i * 8 + 2 * q] = geluf_(lo_bf(w[q])); x[i * 8 + 2 * q + 1] = geluf_(hi_bf(w[q])); } }
        float s = 0.f;
#pragma unroll
        for (int i = 0; i < 32; ++i) s += x[i];
        s = dpp_add<0xB1>(s); const float mu = s * (1.0f / 64.0f);
        float q2 = 0.f;
#pragma unroll
        for (int i = 0; i < 32; ++i) { const float d = x[i] - mu; q2 += d * d; }
        q2 = dpp_add<0xB1>(q2); const float rstd = rsqrtf(q2 * (1.0f / 64.0f) + 1e-5f);
        const float* gg = p.gm_g + l * 256 + g * 64 + half * 32; const float* gb = p.gm_b + l * 256 + g * 64 + half * 32;
#pragma unroll
        for (int i = 0; i < 32; ++i) VnT[(half * 32 + i) * 136 + tok] = f2bf((x[i] - mu) * rstd * gg[i] + gb[i]);
    }
    __syncthreads();
    f32x4 acc[2][4];
#pragma unroll
    for (int m = 0; m < 2; ++m)
#pragma unroll
        for (int n = 0; n < 4; ++n) acc[m][n] = (f32x4){0.f, 0.f, 0.f, 0.f};
    const bf16_t* Wg = p.WsB + g * 128 * 128;
#pragma unroll
    for (int ks = 0; ks < 4; ++ks) {
        bf16x8 af[2], bfr[4];
#pragma unroll
        for (int m = 0; m < 2; ++m) af[m] = *(const bf16x8*)(Wg + (wid * 32 + m * 16 + fr) * 128 + ks * 32 + fq * 8);
#pragma unroll
        for (int n = 0; n < 4; ++n) bfr[n] = *(const bf16x8*)(VnT + (n * 16 + fr) * 136 + ks * 32 + fq * 8);
#pragma unroll
        for (int m = 0; m < 2; ++m)
#pragma unroll
            for (int n = 0; n < 4; ++n) acc[m][n] = __builtin_amdgcn_mfma_f32_16x16x32_bf16(af[m], bfr[n], acc[m][n], 0, 0, 0);
    }
#pragma unroll
    for (int m = 0; m < 2; ++m)
#pragma unroll
        for (int j = 0; j < 4; ++j) {
            const int pp = wid * 32 + m * 16 + fq * 4 + j; const float bs = p.gm_bs[l * 512 + g * 128 + pp];
#pragma unroll
            for (int n = 0; n < 4; ++n) { const int c = n * 16 + fr;
                const float uu = geluf_(bf2f(p.Z[(size_t)(R0 + pp) * NIN + ZU + g * 64 + c]));
                p.hbmix[(size_t)(R0 + pp) * DM + 768 + g * 64 + c] = f2bf(uu * (acc[m][n][j] + bs)); }
        }
    __syncthreads();
}

__device__ __forceinline__ void scan_unit(const P& p, int l, int u, char* smem) {
    const int tid = opaque_tid(), lane = tid & 63, wid = tid >> 6;
    int b, T, row0; const bool lat = u < 128;
    if (lat) { b = u >> 5; T = 4096; row0 = M_CTX + b * 4096; } else { b = (u - 128) >> 5; T = 256; row0 = b * 256; }
    const int h = (u >> 3) & 3, d = (u >> 2) & 1, rsl = u & 3;
    float* W = (float*)smem; float* NKK = W + 2048; float* KKA = NKK + 2048; float* KD = KKA + 2048; float* RR = KD + 2048; float* VS = RR + 2048; float* OUTP = VS + 512;
    const int rl = lane >> 4, kq = lane & 15; const int r16 = wid * 4 + rl; const int row = rsl * 16 + r16;
    f32x4 S = (f32x4){0.f, 0.f, 0.f, 0.f};
    const size_t stoff = ((((size_t)b * 4 + l) * 2 + d) * 4 + h) * 4096 + row * 64 + kq * 4;
    if (lat) S = *(const f32x4*)(p.state_rwkv + stoff);
    const int tok = tid >> 3, cg8 = tid & 7;
    float kkp[8], kap[8];
#pragma unroll
    for (int i = 0; i < 8; ++i) { kkp[i] = p.rw_kk[l * 256 + h * 64 + cg8 * 8 + i]; kap[i] = p.rw_ka[l * 256 + h * 64 + cg8 * 8 + i]; }
    const int nch = T >> 5;
    u32x4 r8, k8, e8, a8, v8;
    int grow, grow_prev = 0; f32x2 oreg = (f32x2){0.f, 0.f};
    {
        const int sidx = tok; const int t = d ? T - 1 - sidx : sidx; grow = row0 + t;
        r8 = *(const u32x4*)(p.RKV + (size_t)grow * 768 + h * 64 + cg8 * 8);
        k8 = *(const u32x4*)(p.RKV + (size_t)grow * 768 + 256 + h * 64 + cg8 * 8);
        v8 = *(const u32x4*)(p.RKV + (size_t)grow * 768 + 512 + h * 64 + rsl * 16 + (cg8 & 1) * 8);
        e8 = *(const u32x4*)(p.Ee + ((size_t)d * M_ALL + grow) * 256 + h * 64 + cg8 * 8);
        a8 = *(const u32x4*)(p.Aa + ((size_t)d * M_ALL + grow) * 256 + h * 64 + cg8 * 8);
    }
    for (int ch = 0; ch < nch; ++ch) {
        {
            float kf[8], kkv[8], rf[8], ef[8], af[8];
#pragma unroll
            for (int q = 0; q < 4; ++q) { kf[2 * q] = lo_bf(k8[q]); kf[2 * q + 1] = hi_bf(k8[q]); rf[2 * q] = lo_bf(r8[q]); rf[2 * q + 1] = hi_bf(r8[q]);
                ef[2 * q] = lo_bf(e8[q]); ef[2 * q + 1] = hi_bf(e8[q]); af[2 * q] = lo_bf(a8[q]); af[2 * q + 1] = hi_bf(a8[q]); }
            float ss = 0.f;
#pragma unroll
            for (int i = 0; i < 8; ++i) { kkv[i] = kf[i] * kkp[i]; ss += kkv[i] * kkv[i]; }
            ss = red8(ss);
            const float inv = rsqrtf(fmaxf(ss, 1e-24f));
            f32x4 o0, o1; const int base = tok * 64 + cg8 * 8;
#pragma unroll
            for (int i = 0; i < 4; ++i) { o0[i] = __expf(-ef[i]); o1[i] = __expf(-ef[4 + i]); }
            *(f32x4*)(W + base) = o0; *(f32x4*)(W + base + 4) = o1;
#pragma unroll
            for (int i = 0; i < 4; ++i) { o0[i] = -kkv[i] * inv; o1[i] = -kkv[4 + i] * inv; }
            *(f32x4*)(NKK + base) = o0; *(f32x4*)(NKK + base + 4) = o1;
#pragma unroll
            for (int i = 0; i < 4; ++i) { o0[i] = kkv[i] * inv * af[i]; o1[i] = kkv[4 + i] * inv * af[4 + i]; }
            *(f32x4*)(KKA + base) = o0; *(f32x4*)(KKA + base + 4) = o1;
#pragma unroll
            for (int i = 0; i < 4; ++i) { o0[i] = kf[i] * (1.0f + (af[i] - 1.0f) * kap[i]); o1[i] = kf[4 + i] * (1.0f + (af[4 + i] - 1.0f) * kap[4 + i]); }
            *(f32x4*)(KD + base) = o0; *(f32x4*)(KD + base + 4) = o1;
#pragma unroll
            for (int i = 0; i < 4; ++i) { o0[i] = rf[i]; o1[i] = rf[4 + i]; }
            *(f32x4*)(RR + base) = o0; *(f32x4*)(RR + base + 4) = o1;
            if (cg8 < 2) {
#pragma unroll
                for (int q = 0; q < 4; ++q) { VS[tok * 16 + cg8 * 8 + 2 * q] = lo_bf(v8[q]); VS[tok * 16 + cg8 * 8 + 2 * q + 1] = hi_bf(v8[q]); }
            }
        }
        __syncthreads();
        if (ch > 0) *(f32x2*)(p.ydir + ((size_t)d * M_ALL + grow_prev) * 256 + h * 64 + rsl * 16 + cg8 * 2) = oreg;
        grow_prev = grow;
        if (ch + 1 < nch) {
            const int sidx = (ch + 1) * 32 + tok; const int t = d ? T - 1 - sidx : sidx; grow = row0 + t;
            r8 = *(const u32x4*)(p.RKV + (size_t)grow * 768 + h * 64 + cg8 * 8);
            k8 = *(const u32x4*)(p.RKV + (size_t)grow * 768 + 256 + h * 64 + cg8 * 8);
            v8 = *(const u32x4*)(p.RKV + (size_t)grow * 768 + 512 + h * 64 + rsl * 16 + (cg8 & 1) * 8);
            e8 = *(const u32x4*)(p.Ee + ((size_t)d * M_ALL + grow) * 256 + h * 64 + cg8 * 8);
            a8 = *(const u32x4*)(p.Aa + ((size_t)d * M_ALL + grow) * 256 + h * 64 + cg8 * 8);
        }
        {
            const float* Wq = W + kq * 4; const float* NKq = NKK + kq * 4; const float* KAq = KKA + kq * 4; const float* KDq = KD + kq * 4; const float* RRq = RR + kq * 4; const float* VSq = VS + r16;
            float* OPq = OUTP + r16 * 16 + kq;
            f32x4 wv[4], nkv[4], kav[4], kdv[4], rrv[4]; float vv[4];
#define SCAN_LD(slot, st) do { wv[slot] = *(const f32x4*)(Wq + (st) * 64); nkv[slot] = *(const f32x4*)(NKq + (st) * 64); kav[slot] = *(const f32x4*)(KAq + (st) * 64); \
        kdv[slot] = *(const f32x4*)(KDq + (st) * 64); rrv[slot] = *(const f32x4*)(RRq + (st) * 64); vv[slot] = VSq[(st) * 16]; } while (0)
            SCAN_LD(0, 0); SCAN_LD(1, 1); SCAN_LD(2, 2);
#pragma unroll
            for (int s = 0; s < 32; ++s) {
                if (s + 3 < 32) SCAN_LD((s + 3) & 3, s + 3);
                const f32x4 w = wv[s & 3], nk = nkv[s & 3], ka = kav[s & 3], kd = kdv[s & 3], rr = rrv[s & 3]; const float v = vv[s & 3];
                float pd = fmaf(S[1], nk[1], S[0] * nk[0]) + fmaf(S[3], nk[3], S[2] * nk[2]);
                pd = red16(pd);
#pragma unroll
                for (int i = 0; i < 4; ++i) S[i] = fmaf(S[i], w[i], fmaf(pd, ka[i], v * kd[i]));
                OPq[s * 256] = fmaf(S[1], rr[1], S[0] * rr[0]) + fmaf(S[3], rr[3], S[2] * rr[2]);
            }
        }
        __syncthreads();
        {
            const float* op = OUTP + (tok * 16 + cg8 * 2) * 16;
            f32x4 a0 = *(const f32x4*)(op), a1 = *(const f32x4*)(op + 4), a2 = *(const f32x4*)(op + 8), a3 = *(const f32x4*)(op + 12);
            f32x4 b0 = *(const f32x4*)(op + 16), b1 = *(const f32x4*)(op + 20), b2 = *(const f32x4*)(op + 24), b3 = *(const f32x4*)(op + 28);
            a0 = (a0 + a1) + (a2 + a3); b0 = (b0 + b1) + (b2 + b3);
            oreg = (f32x2){(a0[0] + a0[1]) + (a0[2] + a0[3]), (b0[0] + b0[1]) + (b0[2] + b0[3])};
        }
    }
    *(f32x2*)(p.ydir + ((size_t)d * M_ALL + grow_prev) * 256 + h * 64 + rsl * 16 + cg8 * 2) = oreg;
    if (!lat) *(f32x4*)(p.out + 20971520 + 2097152 + 524288 + stoff) = S;
    __syncthreads();
}

#define KS_STRIDE 104
#define VS_STRIDE 72
#define KS_BYTES (64 * KS_STRIDE * 2)
#define ATT_STAGE (KS_BYTES + 64 * VS_STRIDE * 2)
__device__ __forceinline__ void attn_unit(const P& p, int u, char* smem) {
    const int tid = opaque_tid(), lane = tid & 63, wid = tid >> 6, q = lane & 31, hf = lane >> 5;
    int b, h, qt, qrow0, krow0, nown, ntot, Tv; size_t vbase, vcbase = 0; int kcrow0 = 0;
    if (u < 1024) { b = u >> 8; h = (u >> 5) & 7; qt = u & 31; krow0 = M_CTX + b * 4096; qrow0 = krow0 + qt * 128; nown = 64; ntot = 72; Tv = 4096;
        vbase = 2097152 + (size_t)(b * 8 + h) * 64 * 4096; kcrow0 = b * 512; vcbase = (size_t)(b * 8 + h) * 64 * 512; }
    else { const int v = u - 1024; b = v >> 4; h = (v >> 1) & 7; qt = v & 1; krow0 = b * 256; qrow0 = krow0 + qt * 128; nown = 4; ntot = 4; Tv = 256; vbase = (size_t)(b * 8 + h) * 64 * 256; }
    bf16x8 qf[6];
    { const bf16_t* qp = p.Qb + (size_t)(qrow0 + wid * 32 + q) * 768 + h * 96 + hf * 8;
#pragma unroll
      for (int ks = 0; ks < 6; ++ks) qf[ks] = *(const bf16x8*)(qp + ks * 16); }
    f32x16 oT[2];
#pragma unroll
    for (int i = 0; i < 16; ++i) { oT[0][i] = 0.f; oT[1][i] = 0.f; }
    float mrun = -1e30f, lrun = 0.f;
    u32x4 rk[3], rv[2];
    int krow[3], kc[3];
#pragma unroll
    for (int i = 0; i < 3; ++i) { const int c = tid + 256 * i; krow[i] = c / 12; kc[i] = c % 12; }
    const int vdv0 = tid >> 3, vkc = tid & 7;
#define ATT_LOAD(kt) do { const bf16_t* kptr; const bf16_t* vptr; int vstr; \
        if ((kt) < nown) { kptr = p.Kb + (size_t)(krow0 + (kt) * 64) * 768 + h * 96; vptr = p.Vt + vbase + (kt) * 64; vstr = Tv; } \
        else { kptr = p.Kc + (size_t)(kcrow0 + ((kt) - nown) * 64) * 768 + h * 96; vptr = p.Vtc + vcbase + ((kt) - nown) * 64; vstr = 512; } \
        _Pragma("unroll") for (int i = 0; i < 3; ++i) rk[i] = *(const u32x4*)(kptr + (size_t)krow[i] * 768 + kc[i] * 8); \
        _Pragma("unroll") for (int i = 0; i < 2; ++i) rv[i] = *(const u32x4*)(vptr + (size_t)(vdv0 + 32 * i) * vstr + vkc * 8); } while (0)
#define ATT_STORE(buf) do { char* Ks_ = smem + (buf) * ATT_STAGE; char* Vs_ = Ks_ + KS_BYTES; \
        _Pragma("unroll") for (int i = 0; i < 3; ++i) *(u32x4*)(Ks_ + (krow[i] * KS_STRIDE + kc[i] * 8) * 2) = rk[i]; \
        _Pragma("unroll") for (int i = 0; i < 2; ++i) *(u32x4*)(Vs_ + ((vdv0 + 32 * i) * VS_STRIDE + vkc * 8) * 2) = rv[i]; } while (0)
    ATT_LOAD(0); ATT_STORE(0);
    __syncthreads();
    for (int kt = 0; kt < ntot; ++kt) {
        const bool more = kt + 1 < ntot;
        if (more) ATT_LOAD(kt + 1);
        const char* Ks = smem + (kt & 1) * ATT_STAGE; const char* Vs = Ks + KS_BYTES;
        f32x16 sT[2];
#pragma unroll
        for (int i = 0; i < 16; ++i) { sT[0][i] = 0.f; sT[1][i] = 0.f; }
#pragma unroll
        for (int kb = 0; kb < 2; ++kb)
#pragma unroll
            for (int ks = 0; ks < 6; ++ks) { const bf16x8 kf = *(const bf16x8*)(Ks + ((kb * 32 + q) * KS_STRIDE + ks * 16 + hf * 8) * 2);
                sT[kb] = __builtin_amdgcn_mfma_f32_32x32x16_bf16(kf, qf[ks], sT[kb], 0, 0, 0); }
        float mx = sT[0][0];
#pragma unroll
        for (int i = 1; i < 16; ++i) mx = fmaxf(mx, sT[0][i]);
#pragma unroll
        for (int i = 0; i < 16; ++i) mx = fmaxf(mx, sT[1][i]);
        mx = fmaxf(mx, __shfl_xor(mx, 32));
        const float mnew = fmaxf(mrun, mx); const float alpha = __builtin_amdgcn_exp2f(mrun - mnew); const bool resc = __any(mnew > mrun); mrun = mnew;
        float psum = 0.f; bf16x8 pf[2][2];
#pragma unroll
        for (int kb = 0; kb < 2; ++kb)
#pragma unroll
            for (int s = 0; s < 2; ++s) { float e[8];
#pragma unroll
                for (int j = 0; j < 8; ++j) { e[j] = __builtin_amdgcn_exp2f(sT[kb][8 * s + j] - mnew); psum += e[j]; }
                u32x4 w; w.x = pack2(e[0], e[1]); w.y = pack2(e[2], e[3]); w.z = pack2(e[4], e[5]); w.w = pack2(e[6], e[7]);
                pf[kb][s] = __builtin_bit_cast(bf16x8, w); }
        lrun = lrun * alpha + psum;
        if (resc) {
#pragma unroll
            for (int i = 0; i < 16; ++i) { oT[0][i] *= alpha; oT[1][i] *= alpha; }
        }
#pragma unroll
        for (int kb = 0; kb < 2; ++kb)
#pragma unroll
            for (int s = 0; s < 2; ++s)
#pragma unroll
                for (int db = 0; db < 2; ++db) {
                    const char* vp = Vs + ((db * 32 + q) * VS_STRIDE + kb * 32 + 16 * s + 4 * hf) * 2;
                    const u32x2 lo = *(const u32x2*)vp, hi = *(const u32x2*)(vp + 16);
                    const u32x4 w = (u32x4){lo.x, lo.y, hi.x, hi.y};
                    oT[db] = __builtin_amdgcn_mfma_f32_32x32x16_bf16(__builtin_bit_cast(bf16x8, w), pf[kb][s], oT[db], 0, 0, 0);
                }
        if (more) ATT_STORE((kt + 1) & 1);
        __syncthreads();
    }
    const float lt = lrun + __shfl_xor(lrun, 32); const float inv = 1.0f / lt;
    bf16_t* op = p.hbmix + (size_t)(qrow0 + wid * 32 + q) * DM + 256 + h * 64;
#pragma unroll
    for (int db = 0; db < 2; ++db)
#pragma unroll
        for (int g = 0; g < 4; ++g) { u32x2 w; w.x = pack2(oT[db][4 * g] * inv, oT[db][4 * g + 1] * inv); w.y = pack2(oT[db][4 * g + 2] * inv, oT[db][4 * g + 3] * inv);
            *(u32x2*)(op + db * 32 + 8 * g + 4 * hf) = w; }
}

__device__ __forceinline__ void rwcomb_phase(const P& p, int l) {
    const int tid = opaque_tid(), lane = tid & 63, wid = tid >> 6; const int c = lane * 4;
    const f32x4 gng = *(const f32x4*)(p.rw_gn_g + l * 256 + c), gnb = *(const f32x4*)(p.rw_gn_b + l * 256 + c), kap = *(const f32x4*)(p.rw_ka + l * 256 + c), rkp = *(const f32x4*)(p.rw_rk + l * 256 + c);
    for (int row = blockIdx.x * 4 + wid; row < M_ALL; row += gridDim.x * 4) {
        const f32x4 y0 = *(const f32x4*)(p.ydir + (size_t)row * 256 + c), y1 = *(const f32x4*)(p.ydir + ((size_t)M_ALL + row) * 256 + c);
        f32x4 y = y0 + y1;
        float s = (y[0] + y[1]) + (y[2] + y[3]); s = red16(s); const float mu = s * (1.0f / 64.0f);
        const f32x4 dd = y - mu; float q2 = (dd[0] * dd[0] + dd[1] * dd[1]) + (dd[2] * dd[2] + dd[3] * dd[3]); q2 = red16(q2);
        const float rstd = rsqrtf(q2 * (1.0f / 64.0f) + 64e-5f);
        const f32x4 yn = dd * rstd * gng + gnb;
        const u32x2 rw = *(const u32x2*)(p.RKV + (size_t)row * 768 + c), kw = *(const u32x2*)(p.RKV + (size_t)row * 768 + 256 + c), vw = *(const u32x2*)(p.RKV + (size_t)row * 768 + 512 + c);
        const u32x2 a0w = *(const u32x2*)(p.Aa + (size_t)row * 256 + c), a1w = *(const u32x2*)(p.Aa + ((size_t)M_ALL + row) * 256 + c), gw = *(const u32x2*)(p.Gg + (size_t)row * 256 + c);
        const f32x4 r = (f32x4){lo_bf(rw.x), hi_bf(rw.x), lo_bf(rw.y), hi_bf(rw.y)}, k = (f32x4){lo_bf(kw.x), hi_bf(kw.x), lo_bf(kw.y), hi_bf(kw.y)}, v = (f32x4){lo_bf(vw.x), hi_bf(vw.x), lo_bf(vw.y), hi_bf(vw.y)};
        const f32x4 a0 = (f32x4){lo_bf(a0w.x), hi_bf(a0w.x), lo_bf(a0w.y), hi_bf(a0w.y)}, a1 = (f32x4){lo_bf(a1w.x), hi_bf(a1w.x), lo_bf(a1w.y), hi_bf(a1w.y)}, gt = (f32x4){lo_bf(gw.x), hi_bf(gw.x), lo_bf(gw.y), hi_bf(gw.y)};
        const f32x4 kds = k * (1.0f + (a0 - 1.0f) * kap) + k * (1.0f + (a1 - 1.0f) * kap);
        const f32x4 t4 = r * kds * rkp; float rk = (t4[0] + t4[1]) + (t4[2] + t4[3]); rk = red16(rk);
        const f32x4 o = (yn + rk * v) * gt;
        u32x2 w; w.x = pack2(o[0], o[1]); w.y = pack2(o[2], o[3]);
        *(u32x2*)(p.hbmix + (size_t)row * DM + c) = w;
    }
}

__global__ void __launch_bounds__(256, 2) mega(Args a_unused) {
    extern __shared__ __attribute__((aligned(16))) char smem[];
    __shared__ uint4 xbw; __shared__ int s_unit;
    kargp_t kp = (kargp_t)__builtin_amdgcn_kernarg_segment_ptr();
    const int tid = threadIdx.x; const int G = gridDim.x;
    if (tid == 0) xbw = make_uint4(0u, 0u, 0u, 0u);
    __syncthreads();
    XcdBarrier xb;
    { const P p = getP(kp); xb = xcd_barrier_post(p.bar, (volatile LAS unsigned*)&xbw); }
    for (int u = blockIdx.x; u < 384 + NCONV + 272; u += G) {
        if (u < 384) { const P p = getP(kp); ada_unit(p, u, smem); } else if (u < 384 + NCONV) { const P p = getP(kp); conv_unit(p, 0, u - 384, smem); } else { const P p = getP(kp); misc0_unit(p, u - 384 - NCONV); }
    }
    cg::this_grid().sync();
    { const P p = getP(kp); ln_phase(p, 0, 0); }
    xcd_barrier(xb);
    float* rs = (float*)(smem + RS_OFF);
#pragma unroll 1
    for (int l = 0; l < 4; ++l) {
        for (int u = blockIdx.x; u < 160 * 17; u += G) { const P p = getP(kp); const int mt = u / 17, nt = u % 17;
            EpiZ e{p.Z, mt * 128, nt * 128};
            gemm128(p.hbmix + (size_t)mt * 128 * DM, DM, p.WtIn + (size_t)nt * 128 * DM, DM, DM, smem, e); }
        xcd_barrier(xb);
        for (int rep2 = 0; rep2 < DUP_P2; ++rep2) {
        for (;;) {
            { const P pc = getP(kp); if (tid == 0) s_unit = atomicAdd(&pc.ctr[l * 4 + 0 + 2 * rep2], 1); }
            __syncthreads(); int u = s_unit; __syncthreads();
            if (u >= 320 + 960 + 1408 + 2816 + 640) break;
            if (u < 320) { const P p = getP(kp); rwprep_unit(p, l, u, smem); continue; }
            u -= 320;
            if (u < 960) { const P p = getP(kp); const int mt = u / 6, nt = u % 6;
                rowscale128(p.Z, mt * 128, ZQ, 256, 1e-6f, rs);
                EpiQ e{p.Qb, rs, p.ropeC, p.ropeS, mt * 128, nt * 128};
                gemm128(p.Z + (size_t)mt * 128 * NIN + ZQ, NIN, p.WtQ + (size_t)nt * 128 * 256, 256, 256, smem, e); __syncthreads(); continue; }
            u -= 960;
            if (u < 1280) { const P p = getP(kp); const int mt = u >> 3, nt = u & 7; const int R0 = mt * 128; const bool latr = R0 >= M_CTX;
                rowscale128(p.Z, R0, ZKV, 128, 1e-6f, rs);
                EpiKV e{latr ? p.Kb + (size_t)M_CTX * 768 : p.Kb, p.Vt, rs, latr ? R0 - M_CTX : R0, nt * 128, latr ? 12 : 8, latr ? (size_t)2097152 : (size_t)0};
                gemm128(p.Z + (size_t)R0 * NIN + ZKV, NIN, p.WtKVn + (size_t)nt * 128 * 128, 128, 128, smem, e); __syncthreads(); continue; }
            u -= 1280;
            if (u < 128) { const P p = getP(kp); const int mt = u >> 3, nt = u & 7;
                EpiKV e{p.Kc, p.Vtc, nullptr, mt * 128, nt * 128, 9, (size_t)0};
                gemm128(p.CkvB + ((size_t)l * 2048 + mt * 128) * 128, 128, p.WtKV + (size_t)nt * 128 * 128, 128, 128, smem, e); continue; }
            u -= 128;
            if (u < 2816) { const P p = getP(kp); small_unit(p, l, u); continue; }
            u -= 2816;
            { const P p = getP(kp); gmlp_unit(p, l, u, smem); }
        }
        xcd_barrier(xb);
        }
        for (int rep3 = 0; rep3 < DUP_P3; ++rep3) {
        for (;;) {
            { const P pc = getP(kp); if (tid == 0) s_unit = atomicAdd(&pc.ctr[l * 4 + 1 + 2 * rep3], 1); }
            __syncthreads(); int u = s_unit; __syncthreads();
            if (u >= 640 + 1280) break;
#ifdef PROBE_SCAN_ONLY
            if (rep3 == 1 && u >= 640) break;
#endif
#ifdef PROBE_ATTN_ONLY
            if (rep3 == 1 && u < 640) continue;
#endif
            if (u < 640) { const P p = getP(kp); scan_unit(p, l, u, smem); } else { const P p = getP(kp); attn_unit(p, u - 640, smem); }
        }
        xcd_barrier(xb);
        }
        { const P p = getP(kp); rwcomb_phase(p, l); }
        xcd_barrier(xb);
        for (int u = blockIdx.x; u < 160 * 8; u += G) { const P p = getP(kp); const int mt = u >> 3, nt = u & 7;
            EpiRes e{p.out, p.mod + ((size_t)l * 5 + modrow_of(mt * 128)) * 6144 + 2048, mt * 128, nt * 128};
            gemm128(p.hbmix + (size_t)mt * 128 * DM, DM, p.WtOut + (size_t)nt * 128 * DM, DM, DM, smem, e); }
        xcd_barrier(xb);
        { const P p = getP(kp); ln_phase(p, l, 1); }
        xcd_barrier(xb);
        for (int rep5 = 0; rep5 < DUP_P5; ++rep5)
        for (int u = blockIdx.x; u < 160 * 44; u += G) { const P p = getP(kp); const int mt = u / 44, nt = u % 44;
            EpiSwi e{p.hidden, mt * 128, nt * 128};
            gemm128(p.hbmix + (size_t)mt * 128 * DM, DM, p.WtF1 + (size_t)nt * 128 * DM, DM, DM, smem, e); }
        xcd_barrier(xb);
        for (int u = blockIdx.x; u < 160 * 8; u += G) { const P p = getP(kp); const int mt = u >> 3, nt = u & 7;
            EpiRes e{p.out, p.mod + ((size_t)l * 5 + modrow_of(mt * 128)) * 6144 + 5120, mt * 128, nt * 128};
            gemm128(p.hidden + (size_t)mt * 128 * DFF, DFF, p.WtF2 + (size_t)nt * 128 * DFF, DFF, DFF, smem, e); }
        xcd_barrier(xb);
        { const P p = getP(kp); ln_phase(p, l, 2); }
        if (l < 3) { for (int u = blockIdx.x; u < NCONV; u += G) { const P p = getP(kp); conv_unit(p, l + 1, u, smem); } }
        xcd_barrier(xb);
    }
}

extern "C" void kernel_launch(void* const* d_in, const int* in_sizes, int n_in, void* d_out, int out_size, void* d_ws, size_t ws_size, hipStream_t stream) {
    static int grid_blocks = 0;
    if (!grid_blocks) {
        int dev = 0, cus = 0, per_cu = 0;
        (void)hipGetDevice(&dev);
        (void)hipDeviceGetAttribute(&cus, hipDeviceAttributeMultiprocessorCount, dev);
        (void)hipFuncSetAttribute((const void*)mega, hipFuncAttributeMaxDynamicSharedMemorySize, SMEM_BYTES);
        (void)hipOccupancyMaxActiveBlocksPerMultiprocessor(&per_cu, (const void*)mega, 256, SMEM_BYTES);
        if (per_cu > 2) per_cu = 2;
        if (per_cu < 1) per_cu = 1;
        grid_blocks = cus * per_cu;
    }
    if (WS_TOTAL > ws_size) { fprintf(stderr, "kernel_launch: workspace too small: need %zu have %zu\n", (size_t)WS_TOTAL, ws_size); return; }
    Args a{};
    for (int i = 0; i < 36; ++i) a.in[i] = (const float*)d_in[i];
    a.out = (float*)d_out; a.ws = (char*)d_ws;
    (void)hipMemsetAsync((char*)d_ws + OFF_BAR, 0, 16384 + 4096, stream);
    void* args[] = {&a};
    hipError_t e = hipLaunchCooperativeKernel((const void*)mega, dim3(grid_blocks), dim3(256), args, SMEM_BYTES, stream);
    if (e != hipSuccess) fprintf(stderr, "cooperative launch failed: %s (grid %d)\n", hipGetErrorString(e), grid_blocks);
}
```

```cpp
#include <hip/hip_runtime.h>
#include <hip/hip_cooperative_groups.h>
#include <cstdint>
#include <cstdio>
namespace cg = cooperative_groups;

typedef unsigned short bf16_t;
typedef short bf16x8 __attribute__((ext_vector_type(8)));
typedef float f32x4 __attribute__((ext_vector_type(4)));
typedef float f32x2 __attribute__((ext_vector_type(2)));
typedef float f32x16 __attribute__((ext_vector_type(16)));
typedef unsigned u32x4 __attribute__((ext_vector_type(4)));
typedef unsigned u32x2 __attribute__((ext_vector_type(2)));

#define M_ALL 20480
#define M_CTX 4096
#define DM 1024
#define NIN 2080
#define DFF 2816
#define ALPHA_F 1.6817928305074290f
#define QSCALE (0.10206207261596575f * 1.4426950408889634f)
#define LAS __attribute__((address_space(3)))
#ifndef DUP_P2
#define DUP_P2 1
#endif
#ifndef DUP_P3
#define DUP_P3 1
#endif
#ifndef DUP_P5
#define DUP_P5 1
#endif

#define ZQ 1152
#define ZKV 1408
#define ZKR 1536
#define ZU 1568
#define ZV 1824

#define LDS_STRIDE 72
#define TILE_BYTES (128 * LDS_STRIDE * 2)
#define RS_OFF (4 * TILE_BYTES)
#define SMEM_BYTES (RS_OFF + 3072)

struct P {
    const float *x_prompt, *x_sample, *cache_ckv, *cache_krope, *state_rwkv, *c, *c_ctx, *ada_w, *ada_b, *w_in, *rw_conv, *rw_w0, *rw_w2,
        *rw_a0, *rw_a2, *rw_g2, *rw_kk, *rw_ka, *rw_rk, *rw_gn_g, *rw_gn_b, *q_norm, *q_up, *kv_norm, *kv_up, *gm_g, *gm_b, *gm_ws, *gm_bs,
        *w_out, *ln1_g, *ln1_b, *ffn_in, *ffn_out, *ln2_g, *ln2_b;
    float* out;
    unsigned* bar; int* ctr; float* mod; float* ropeC; float* ropeS; bf16_t* CkvB;
    bf16_t *WtIn, *WtQ, *WtKVn, *WtKV, *WtOut, *WtF1, *WtF2, *WsB, *W2t, *A2t, *G2t;
    bf16_t *Z, *RKV, *Ee, *Aa, *Gg, *Qb, *Kb, *Kc, *Vt, *Vtc, *hbmix, *hidden;
    float* ydir;
};


struct Args { const float* in[36]; float* out; char* ws; };
typedef const __attribute__((address_space(4))) char* kargp_t;
constexpr size_t al256(size_t x) { return (x + 255) & ~(size_t)255; }
constexpr size_t OFF_BAR = 0;
constexpr size_t OFF_CTR = OFF_BAR + 16384;
constexpr size_t OFF_MOD = OFF_CTR + 4096;
constexpr size_t OFF_ROPEC = OFF_MOD + al256((size_t)4 * 5 * 6144 * 4);
constexpr size_t OFF_ROPES = OFF_ROPEC + 65536 * 4;
constexpr size_t OFF_CKVB = OFF_ROPES + 65536 * 4;
constexpr size_t OFF_WTIN = OFF_CKVB + (size_t)4 * 2048 * 128 * 2;
constexpr size_t OFF_WTQ = OFF_WTIN + (size_t)2176 * 1024 * 2;
constexpr size_t OFF_WTKVN = OFF_WTQ + (size_t)768 * 256 * 2;
constexpr size_t OFF_WTKV = OFF_WTKVN + (size_t)1024 * 128 * 2;
constexpr size_t OFF_WTOUT = OFF_WTKV + (size_t)1024 * 128 * 2;
constexpr size_t OFF_WTF1 = OFF_WTOUT + (size_t)1024 * 1024 * 2;
constexpr size_t OFF_WTF2 = OFF_WTF1 + (size_t)5632 * 1024 * 2;
constexpr size_t OFF_WSB = OFF_WTF2 + (size_t)1024 * DFF * 2;
constexpr size_t OFF_W2T = OFF_WSB + (size_t)65536 * 2;
constexpr size_t OFF_A2T = OFF_W2T + (size_t)2 * 256 * 64 * 2;
constexpr size_t OFF_G2T = OFF_A2T + (size_t)2 * 256 * 64 * 2;
constexpr size_t OFF_Z = OFF_G2T + (size_t)256 * 128 * 2;
constexpr size_t OFF_HIDDEN = OFF_Z;
constexpr size_t OFF_RKV = OFF_Z + al256((size_t)M_ALL * NIN * 2);
constexpr size_t OFF_EE = OFF_RKV + (size_t)M_ALL * 768 * 2;
constexpr size_t OFF_AA = OFF_EE + (size_t)2 * M_ALL * 256 * 2;
constexpr size_t OFF_GG = OFF_AA + (size_t)2 * M_ALL * 256 * 2;
constexpr size_t OFF_QB = OFF_GG + (size_t)M_ALL * 256 * 2;
constexpr size_t OFF_KB = OFF_QB + (size_t)M_ALL * 768 * 2;
constexpr size_t OFF_KC = OFF_KB + (size_t)M_ALL * 768 * 2;
constexpr size_t OFF_VT = OFF_KC + (size_t)2048 * 768 * 2;
constexpr size_t OFF_VTC = OFF_VT + (size_t)M_ALL * 512 * 2;
constexpr size_t OFF_YDIR = OFF_VTC + (size_t)2048 * 512 * 2;
constexpr size_t OFF_HBMIX = OFF_YDIR + (size_t)2 * M_ALL * 256 * 4;
constexpr size_t WS_TOTAL = OFF_HBMIX + (size_t)M_ALL * DM * 2;
static_assert(OFF_RKV + (size_t)M_ALL * 768 * 2 - OFF_HIDDEN >= (size_t)M_ALL * DFF * 2, "hidden overlay");

__device__ __forceinline__ P getP(kargp_t& kp) {
    asm volatile("" : "+s"(kp));
    typedef const float* const __attribute__((address_space(4)))* inp_t;
    inp_t in = (inp_t)kp;
    P p;
    p.x_prompt = in[0]; p.x_sample = in[1]; p.cache_ckv = in[2]; p.cache_krope = in[3]; p.state_rwkv = in[4]; p.c = in[5]; p.c_ctx = in[6];
    p.ada_w = in[7]; p.ada_b = in[8]; p.w_in = in[9]; p.rw_conv = in[10]; p.rw_w0 = in[11]; p.rw_w2 = in[12]; p.rw_a0 = in[13]; p.rw_a2 = in[14];
    p.rw_g2 = in[15]; p.rw_kk = in[16]; p.rw_ka = in[17]; p.rw_rk = in[18]; p.rw_gn_g = in[19]; p.rw_gn_b = in[20]; p.q_norm = in[21]; p.q_up = in[22];
    p.kv_norm = in[23]; p.kv_up = in[24]; p.gm_g = in[25]; p.gm_b = in[26]; p.gm_ws = in[27]; p.gm_bs = in[28]; p.w_out = in[29]; p.ln1_g = in[30];
    p.ln1_b = in[31]; p.ffn_in = in[32]; p.ffn_out = in[33]; p.ln2_g = in[34]; p.ln2_b = in[35];
    p.out = (float*)in[36]; char* ws = (char*)in[37];
    p.bar = (unsigned*)(ws + OFF_BAR); p.ctr = (int*)(ws + OFF_CTR); p.mod = (float*)(ws + OFF_MOD); p.ropeC = (float*)(ws + OFF_ROPEC); p.ropeS = (float*)(ws + OFF_ROPES);
    p.CkvB = (bf16_t*)(ws + OFF_CKVB); p.WtIn = (bf16_t*)(ws + OFF_WTIN); p.WtQ = (bf16_t*)(ws + OFF_WTQ); p.WtKVn = (bf16_t*)(ws + OFF_WTKVN); p.WtKV = (bf16_t*)(ws + OFF_WTKV);
    p.WtOut = (bf16_t*)(ws + OFF_WTOUT); p.WtF1 = (bf16_t*)(ws + OFF_WTF1); p.WtF2 = (bf16_t*)(ws + OFF_WTF2); p.WsB = (bf16_t*)(ws + OFF_WSB); p.W2t = (bf16_t*)(ws + OFF_W2T);
    p.A2t = (bf16_t*)(ws + OFF_A2T); p.G2t = (bf16_t*)(ws + OFF_G2T); p.Z = (bf16_t*)(ws + OFF_Z); p.RKV = (bf16_t*)(ws + OFF_RKV); p.Ee = (bf16_t*)(ws + OFF_EE); p.Aa = (bf16_t*)(ws + OFF_AA);
    p.Gg = (bf16_t*)(ws + OFF_GG); p.Qb = (bf16_t*)(ws + OFF_QB); p.Kb = (bf16_t*)(ws + OFF_KB); p.Kc = (bf16_t*)(ws + OFF_KC); p.Vt = (bf16_t*)(ws + OFF_VT); p.Vtc = (bf16_t*)(ws + OFF_VTC);
    p.hbmix = (bf16_t*)(ws + OFF_HBMIX); p.hidden = (bf16_t*)(ws + OFF_HIDDEN); p.ydir = (float*)(ws + OFF_YDIR);
    return p;
}

__device__ __forceinline__ float bf2f(bf16_t b) { return __uint_as_float(((unsigned)b) << 16); }
__device__ __forceinline__ unsigned pack2(float lo, float hi) { unsigned r; asm("v_cvt_pk_bf16_f32 %0, %1, %2" : "=v"(r) : "v"(lo), "v"(hi)); return r; }
__device__ __forceinline__ bf16_t f2bf(float f) { return (bf16_t)(pack2(f, 0.f) & 0xffffu); }
__device__ __forceinline__ float lo_bf(unsigned w) { return __uint_as_float(w << 16); }
__device__ __forceinline__ float hi_bf(unsigned w) { return __uint_as_float(w & 0xffff0000u); }
__device__ __forceinline__ float sigmoidf_(float x) { return __builtin_amdgcn_rcpf(1.0f + __builtin_amdgcn_exp2f(-1.4426950408889634f * x)); }
__device__ __forceinline__ float tanhf_(float x) { float e = __builtin_amdgcn_exp2f(2.8853900817779268f * x); return 1.0f - 2.0f * __builtin_amdgcn_rcpf(e + 1.0f); }
__device__ __forceinline__ float geluf_(float x) { return 0.5f * x * (1.0f + tanhf_(0.7978845608028654f * (x + 0.044715f * x * x * x))); }
template <int CTRL> __device__ __forceinline__ float dpp_add(float x) {
    int y = __builtin_amdgcn_update_dpp(0, __float_as_int(x), CTRL, 0xf, 0xf, false);
    return x + __int_as_float(y);
}
__device__ __forceinline__ float red4(float x) { x = dpp_add<0xB1>(x); x = dpp_add<0x4E>(x); return x; }
__device__ __forceinline__ float red8(float x) { x = red4(x); x = dpp_add<0x141>(x); return x; }
__device__ __forceinline__ float red16(float x) { x = red8(x); x = dpp_add<0x140>(x); return x; }
__device__ __forceinline__ int opaque_tid() { int t = threadIdx.x; asm volatile("" : "+v"(t)); return t; }
__device__ __forceinline__ int modrow_of(int row) { return row < M_CTX ? 0 : 1 + ((row - M_CTX) >> 12); }

#define XB_TMO 128
#define XB_XCNT(j) (256 + 64 * (j))
#define XB_XSUB(j) (1280 + 64 * (j))
#define XB_XGEN(j) (2304 + 64 * (j))
#define XB_TOP 3328
#define XB_TOPGEN 3392
#define XCD_BAR_WORDS 3456
#define XB_SPIN_CAP (1u << 22)
__device__ __forceinline__ unsigned xb_ld(unsigned* p) { return __hip_atomic_load(p, __ATOMIC_RELAXED, __HIP_MEMORY_SCOPE_AGENT); }
__device__ __forceinline__ unsigned xb_add(unsigned* p, unsigned v) { return __hip_atomic_fetch_add(p, v, __ATOMIC_RELAXED, __HIP_MEMORY_SCOPE_AGENT); }
__device__ __forceinline__ unsigned xb_xcc_id() { return (unsigned)__builtin_amdgcn_s_getreg((3 << 11) | 20) & 0xFu; }
#define XB_SPIN(cond, bar) do { unsigned _sp = 0; while (cond) { __builtin_amdgcn_s_sleep(1); \
    if ((++_sp & 255u) == 0u) { if (xb_ld(&(bar)[XB_TMO])) break; if (_sp > XB_SPIN_CAP) { atomicAdd(&(bar)[XB_TMO], 1u); break; } } } } while (0)
struct XcdBarrier { unsigned* bar; unsigned x; volatile LAS unsigned* st; };
__device__ __forceinline__ XcdBarrier xcd_barrier_post(unsigned* bar, volatile LAS unsigned* st) {
    XcdBarrier b; b.bar = bar; b.x = xb_xcc_id(); b.st = st;
    if (threadIdx.x == 0) (void)xb_add(&bar[XB_XCNT(b.x)], 1u);
    return b;
}
__device__ __forceinline__ void xcd_barrier_complete(unsigned* bar, unsigned x, unsigned& nloc, unsigned& nx) {
    const unsigned G = gridDim.x * gridDim.y * gridDim.z;
    unsigned sum, cnt, mine, sp = 0u;
    for (;;) {
        sum = 0u; cnt = 0u; mine = 0u;
#pragma unroll
        for (unsigned j = 0; j < 16; ++j) { const unsigned c = xb_ld(&bar[XB_XCNT(j)]); sum += c; cnt += (c > 0u) ? 1u : 0u; mine = (j == x) ? c : mine; }
        if (sum == G) break;
        __builtin_amdgcn_s_sleep(1);
        if ((++sp & 255u) == 0u) { if (xb_ld(&bar[XB_TMO])) break; if (sp > XB_SPIN_CAP) { atomicAdd(&bar[XB_TMO], 1u); break; } }
    }
    nloc = mine > 0u ? mine : 1u; nx = cnt > 0u ? cnt : 1u;
}
__device__ __forceinline__ void xcd_barrier(const XcdBarrier& b) {
    asm volatile("s_waitcnt vmcnt(0)" ::: "memory");
    __syncthreads();
    if (threadIdx.x == 0) {
        unsigned* bar = b.bar;
        __builtin_amdgcn_s_waitcnt(0);
        unsigned nloc = b.st[0], nx = b.st[1];
        if (nloc == 0u) { xcd_barrier_complete(bar, b.x, nloc, nx); b.st[0] = nloc; b.st[1] = nx; }
        const unsigned old = xb_add(&bar[XB_XSUB(b.x)], 1u);
        const unsigned gen = old / nloc;
        if (old + 1u == (gen + 1u) * nloc) {
            __builtin_amdgcn_fence(__ATOMIC_RELEASE, "agent");
            asm volatile("s_waitcnt vmcnt(0)" ::: "memory");
            const unsigned og = xb_add(&bar[XB_TOP], 1u);
            const unsigned tg = og / nx;
            if (og + 1u == (tg + 1u) * nx) xb_add(&bar[XB_TOPGEN], 1u);
            else XB_SPIN(xb_ld(&bar[XB_TOPGEN]) == tg, bar);
            __builtin_amdgcn_fence(__ATOMIC_ACQUIRE, "agent");
            xb_add(&bar[XB_XGEN(b.x)], 1u);
            asm volatile("s_waitcnt vmcnt(0)" ::: "memory");
        } else {
            XB_SPIN(xb_ld(&bar[XB_XGEN(b.x)]) == gen, bar);
            __builtin_amdgcn_fence(__ATOMIC_ACQUIRE, "agent");
            asm volatile("s_waitcnt vmcnt(0)" ::: "memory");
        }
    }
    __syncthreads();
}

template <class Epi>
__device__ __forceinline__ void gemm128(const bf16_t* __restrict__ A, int lda, const bf16_t* __restrict__ B, int ldb, int K, char* smem, const Epi& epi) {
    const int tid = opaque_tid(), lane = tid & 63, wid = tid >> 6, wr = wid >> 1, wc = wid & 1, fr = lane & 15, fq = lane >> 4;
    f32x4 acc[4][4];
#pragma unroll
    for (int m = 0; m < 4; ++m)
#pragma unroll
        for (int n = 0; n < 4; ++n) acc[m][n] = (f32x4){0.f, 0.f, 0.f, 0.f};
    const int crow = tid >> 3, ckc = tid & 7;
    const bf16_t* ap = A + (size_t)crow * lda + ckc * 8;
    const bf16_t* bp = B + (size_t)crow * ldb + ckc * 8;
    u32x4 ra[4], rb[4];
#pragma unroll
    for (int i = 0; i < 4; ++i) { ra[i] = *(const u32x4*)(ap + (size_t)(32 * i) * lda); rb[i] = *(const u32x4*)(bp + (size_t)(32 * i) * ldb); }
    {
        char* sa = smem; char* sb = smem + TILE_BYTES;
#pragma unroll
        for (int i = 0; i < 4; ++i) { *(u32x4*)(sa + ((crow + 32 * i) * LDS_STRIDE + ckc * 8) * 2) = ra[i]; *(u32x4*)(sb + ((crow + 32 * i) * LDS_STRIDE + ckc * 8) * 2) = rb[i]; }
    }
    __syncthreads();
    const int nk = K >> 6;
    for (int kt = 0; kt < nk; ++kt) {
        const bool more = (kt + 1 < nk);
        if (more) {
            const int k0 = (kt + 1) << 6;
#pragma unroll
            for (int i = 0; i < 4; ++i) { ra[i] = *(const u32x4*)(ap + (size_t)(32 * i) * lda + k0); rb[i] = *(const u32x4*)(bp + (size_t)(32 * i) * ldb + k0); }
        }
        const char* sa = smem + (kt & 1) * 2 * TILE_BYTES; const char* sb = sa + TILE_BYTES;
#pragma unroll
        for (int ks = 0; ks < 2; ++ks) {
            bf16x8 af[4], bfr[4];
#pragma unroll
            for (int m = 0; m < 4; ++m) af[m] = *(const bf16x8*)(sa + ((wr * 64 + m * 16 + fr) * LDS_STRIDE + ks * 32 + fq * 8) * 2);
#pragma unroll
            for (int n = 0; n < 4; ++n) bfr[n] = *(const bf16x8*)(sb + ((wc * 64 + n * 16 + fr) * LDS_STRIDE + ks * 32 + fq * 8) * 2);
#pragma unroll
            for (int m = 0; m < 4; ++m)
#pragma unroll
                for (int n = 0; n < 4; ++n) acc[m][n] = __builtin_amdgcn_mfma_f32_16x16x32_bf16(af[m], bfr[n], acc[m][n], 0, 0, 0);
        }
        if (more) {
            char* da = smem + ((kt + 1) & 1) * 2 * TILE_BYTES; char* db = da + TILE_BYTES;
#pragma unroll
            for (int i = 0; i < 4; ++i) { *(u32x4*)(da + ((crow + 32 * i) * LDS_STRIDE + ckc * 8) * 2) = ra[i]; *(u32x4*)(db + ((crow + 32 * i) * LDS_STRIDE + ckc * 8) * 2) = rb[i]; }
        }
        __syncthreads();
    }
    epi(acc, wr * 64, wc * 64, fr, fq);
}

struct EpiZ {
    bf16_t* Z; int R0, C0;
    __device__ __forceinline__ void operator()(f32x4 (&acc)[4][4], int r0, int c0, int fr, int fq) const {
#pragma unroll
        for (int n = 0; n < 4; ++n) { const int col = C0 + c0 + n * 16 + fr; if (col < NIN) {
#pragma unroll
            for (int m = 0; m < 4; ++m)
#pragma unroll
                for (int j = 0; j < 4; ++j) Z[(size_t)(R0 + r0 + m * 16 + fq * 4 + j) * NIN + col] = f2bf(acc[m][n][j]); } }
    }
};
struct EpiQ {
    bf16_t* Q; const float* rs; const float* ropeC; const float* ropeS; int R0, C0;
    __device__ __forceinline__ void operator()(f32x4 (&acc)[4][4], int r0, int c0, int fr, int fq) const {
        const bool lat = R0 >= M_CTX;
#pragma unroll
        for (int n = 0; n < 4; ++n) {
            const int cb = C0 + c0 + n * 16; const int hcs = cb % 96;
            if (lat && hcs == 80) continue;
            const bool rot = lat && hcs == 64;
#pragma unroll
            for (int m = 0; m < 4; ++m)
#pragma unroll
                for (int j = 0; j < 4; ++j) {
                    const int rl = r0 + m * 16 + fq * 4 + j; const int row = R0 + rl; const float s = rs[rl] * QSCALE;
                    const float x1 = acc[m][n][j] * s;
                    if (rot) {
                        const float x2 = acc[m][(n + 1) & 3][j] * s; const int t = (row - M_CTX) & 4095;
                        const float cv = ropeC[t * 16 + fr], sv = ropeS[t * 16 + fr];
                        Q[(size_t)row * 768 + cb + fr] = f2bf(x1 * cv - x2 * sv);
                        Q[(size_t)row * 768 + cb + 16 + fr] = f2bf(x1 * sv + x2 * cv);
                    } else Q[(size_t)row * 768 + cb + fr] = f2bf(x1);
                }
        }
    }
};
struct EpiKV {
    bf16_t* Kd; bf16_t* Vd; const float* rs; int R0, C0; int seqshift; size_t vbase0;
    __device__ __forceinline__ void operator()(f32x4 (&acc)[4][4], int r0, int c0, int fr, int fq) const {
#pragma unroll
        for (int n = 0; n < 4; ++n) {
            const int col = C0 + c0 + n * 16 + fr;
#pragma unroll
            for (int m = 0; m < 4; ++m) {
                const int rl = r0 + m * 16 + fq * 4; const int row = R0 + rl;
                float v[4];
#pragma unroll
                for (int j = 0; j < 4; ++j) v[j] = acc[m][n][j] * (rs ? rs[rl + j] : 1.0f);
                if (col < 512) {
                    const int h = col >> 6, d = col & 63;
#pragma unroll
                    for (int j = 0; j < 4; ++j) Kd[(size_t)(row + j) * 768 + h * 96 + d] = f2bf(v[j]);
                } else {
                    const int vc = col - 512, h = vc >> 6, dv = vc & 63; const int b = row >> seqshift, t = row & ((1 << seqshift) - 1);
                    u32x2 w; w.x = pack2(v[0], v[1]); w.y = pack2(v[2], v[3]);
                    *(u32x2*)(Vd + vbase0 + ((size_t)((b * 8 + h) * 64 + dv) << seqshift) + t) = w;
                }
            }
        }
    }
};
struct EpiRes {
    float* X; const float* gate; int R0, C0;
    __device__ __forceinline__ void operator()(f32x4 (&acc)[4][4], int r0, int c0, int fr, int fq) const {
#pragma unroll
        for (int n = 0; n < 4; ++n) { const int col = C0 + c0 + n * 16 + fr; const float g = gate[col];
#pragma unroll
            for (int m = 0; m < 4; ++m)
#pragma unroll
                for (int j = 0; j < 4; ++j) { float* px = X + (size_t)(R0 + r0 + m * 16 + fq * 4 + j) * DM + col; *px = ALPHA_F * (*px) + g * acc[m][n][j]; } }
    }
};
struct EpiSwi {
    bf16_t* H; int R0, C0;
    __device__ __forceinline__ void operator()(f32x4 (&acc)[4][4], int r0, int c0, int fr, int fq) const {
        const int hb = (C0 + c0) >> 1;
#pragma unroll
        for (int n = 0; n < 2; ++n)
#pragma unroll
            for (int m = 0; m < 4; ++m)
#pragma unroll
                for (int j = 0; j < 4; ++j) { const float g = acc[m][n][j], u = acc[m][n + 2][j];
                    H[(size_t)(R0 + r0 + m * 16 + fq * 4 + j) * DFF + hb + n * 16 + fr] = f2bf(g * sigmoidf_(g) * u); }
    }
};

__device__ __forceinline__ void ada_unit(const P& p, int u, char* smem) {
    const int tid = opaque_tid(); const int l = u / 96, c0 = (u % 96) * 64;
    float* cs = (float*)smem;
    for (int i = tid; i < 5 * 1024; i += 256) { const int r = i >> 10, k = i & 1023; const float v = (r == 0) ? p.c_ctx[k] : p.c[(r - 1) * 1024 + k]; cs[i] = v * sigmoidf_(v); }
    __syncthreads();
    const int col = tid & 63, kq = tid >> 6;
    float s0 = 0.f, s1 = 0.f, s2 = 0.f, s3 = 0.f, s4 = 0.f;
    const float* w = p.ada_w + ((size_t)l * 1024 + kq * 256) * 6144 + c0 + col;
    const float* cq = cs + kq * 256;
    for (int k = 0; k < 256; ++k) { const float wv = w[(size_t)k * 6144]; s0 += cq[k] * wv; s1 += cq[1024 + k] * wv; s2 += cq[2048 + k] * wv; s3 += cq[3072 + k] * wv; s4 += cq[4096 + k] * wv; }
    float* red = cs + 5 * 1024;
    red[(kq * 5 + 0) * 64 + col] = s0; red[(kq * 5 + 1) * 64 + col] = s1; red[(kq * 5 + 2) * 64 + col] = s2; red[(kq * 5 + 3) * 64 + col] = s3; red[(kq * 5 + 4) * 64 + col] = s4;
    __syncthreads();
    for (int o = tid; o < 320; o += 256) { const int i = o >> 6, cc = o & 63;
        const float v = red[(0 * 5 + i) * 64 + cc] + red[(1 * 5 + i) * 64 + cc] + red[(2 * 5 + i) * 64 + cc] + red[(3 * 5 + i) * 64 + cc] + p.ada_b[l * 6144 + c0 + cc];
        p.mod[((size_t)l * 5 + i) * 6144 + c0 + cc] = v; }
    __syncthreads();
}
__device__ __forceinline__ int map_col(int kind, int n) {
    if (kind == 1) { const int blk = n >> 6, r = n & 63; return r < 32 ? blk * 32 + r : DFF + blk * 32 + (r - 32); }
    if (kind == 2) { if (n < 512) return (n >> 6) * 128 + (n & 63); const int vc = n - 512; return (vc >> 6) * 128 + 64 + (vc & 63); }
    return n;
}
__device__ __forceinline__ void conv_tile(const float* src, int ldsrc, bf16_t* dst, bf16_t* dst2, int Kdst, int n0, int k0, int kind, int Nvalid, const float* kscale, char* smem) {
    const int tid = opaque_tid(); float* tile = (float*)smem;
    { const int j = tid & 63, i0 = tid >> 6; const int n = n0 + j; const int sc = (n < Nvalid) ? map_col(kind, n) : -1;
#pragma unroll 4
      for (int ii = 0; ii < 16; ++ii) { const int i = i0 + 4 * ii; tile[i * 65 + j] = (sc >= 0) ? src[(size_t)(k0 + i) * ldsrc + sc] : 0.f; } }
    __syncthreads();
    { const int i = tid & 63, j0 = tid >> 6; const float ks = kscale ? kscale[k0 + i] : 1.f;
#pragma unroll 4
      for (int jj = 0; jj < 16; ++jj) { const int jx = j0 + 4 * jj; const float v = tile[i * 65 + jx];
          dst[(size_t)(n0 + jx) * Kdst + k0 + i] = f2bf(v * ks); if (dst2) dst2[(size_t)(n0 + jx) * Kdst + k0 + i] = f2bf(v); } }
    __syncthreads();
}
#define NCONV 3032
__device__ __forceinline__ void conv_unit(const P& p, int l, int u, char* smem) {
    const float* src; int ldsrc; bf16_t* dst; bf16_t* dst2 = nullptr; int Kdst, n0, k0, kind = 0, Nvalid; const float* kscale = nullptr;
    if (u < 544) { src = p.w_in + (size_t)l * 1024 * NIN; ldsrc = NIN; dst = p.WtIn; Kdst = 1024; n0 = (u / 16) * 64; k0 = (u % 16) * 64; Nvalid = NIN; }
    else if (u < 592) { u -= 544; src = p.q_up + (size_t)l * 256 * 768; ldsrc = 768; dst = p.WtQ; Kdst = 256; n0 = (u / 4) * 64; k0 = (u % 4) * 64; Nvalid = 768; kscale = p.q_norm + l * 256; }
    else if (u < 624) { u -= 592; src = p.kv_up + (size_t)l * 128 * 1024; ldsrc = 1024; dst = p.WtKVn; dst2 = p.WtKV; Kdst = 128; n0 = (u / 2) * 64; k0 = (u % 2) * 64; kind = 2; Nvalid = 1024; kscale = p.kv_norm + l * 128; }
    else if (u < 880) { u -= 624; src = p.w_out + (size_t)l * 1024 * 1024; ldsrc = 1024; dst = p.WtOut; Kdst = 1024; n0 = (u / 16) * 64; k0 = (u % 16) * 64; Nvalid = 1024; }
    else if (u < 2288) { u -= 880; src = p.ffn_in + (size_t)l * 1024 * 5632; ldsrc = 5632; dst = p.WtF1; Kdst = 1024; n0 = (u / 16) * 64; k0 = (u % 16) * 64; kind = 1; Nvalid = 5632; }
    else if (u < 2992) { u -= 2288; src = p.ffn_out + (size_t)l * DFF * 1024; ldsrc = 1024; dst = p.WtF2; Kdst = DFF; n0 = (u / 44) * 64; k0 = (u % 44) * 64; Nvalid = 1024; }
    else if (u < 3008) { u -= 2992; const float* sp = p.gm_ws + (size_t)l * 65536 + u * 4096; bf16_t* d = p.WsB + u * 4096; for (int i = threadIdx.x; i < 4096; i += 256) d[i] = f2bf(sp[i]); return; }
    else if (u < 3016) { u -= 3008; const int d = u >> 2; src = p.rw_w2 + ((size_t)l * 2 + d) * 64 * 256; ldsrc = 256; dst = p.W2t + d * 256 * 64; Kdst = 64; n0 = (u & 3) * 64; k0 = 0; Nvalid = 256; }
    else if (u < 3024) { u -= 3016; const int d = u >> 2; src = p.rw_a2 + ((size_t)l * 2 + d) * 64 * 256; ldsrc = 256; dst = p.A2t + d * 256 * 64; Kdst = 64; n0 = (u & 3) * 64; k0 = 0; Nvalid = 256; }
    else { u -= 3024; src = p.rw_g2 + (size_t)l * 128 * 256; ldsrc = 256; dst = p.G2t; Kdst = 128; n0 = (u / 2) * 64; k0 = (u % 2) * 64; Nvalid = 256; }
    conv_tile(src, ldsrc, dst, dst2, Kdst, n0, k0, kind, Nvalid, kscale, smem);
}
__device__ __forceinline__ void misc0_unit(const P& p, int u) {
    const int tid = opaque_tid();
    if (u < 16) {
        for (int e = tid; e < 4096; e += 256) { const int idx = u * 4096 + e; const int t = idx >> 4, i = idx & 15;
            const float pos = (float)((i < 8) ? (t >> 6) : (t & 63)); const float inv = exp2f(-(float)(i & 7) * 1.6609640474436813f);
            const float ang = pos * inv; const float kf = rintf(ang * 0.15915494309189535f);
            float r = fmaf(-kf, 6.28318548202514648f, ang); r = fmaf(-kf, -1.74845553e-7f, r);
            p.ropeC[idx] = __cosf(r); p.ropeS[idx] = __sinf(r); }
    } else {
        const int v = u - 16;
        for (int e = tid; e < 4096; e += 256) { const int idx = v * 4096 + e;
            const int c = idx & 127, t = (idx >> 7) & 511, b = (idx >> 16) & 3, l = idx >> 18;
            p.CkvB[idx] = f2bf(p.cache_ckv[(((size_t)b * 4 + l) * 512 + t) * 128 + c]); }
    }
}

__device__ __forceinline__ void ln_phase(const P& p, int l, int which) {
    const int tid = opaque_tid(), lane = tid & 63, wid = tid >> 6;
    const float* g = which == 1 ? p.ln1_g + l * DM : p.ln2_g + l * DM; const float* bb = which == 1 ? p.ln1_b + l * DM : p.ln2_b + l * DM;
    const int ml = which == 2 ? l + 1 : l; const int shoff = which == 1 ? 3072 : 0, scoff = which == 1 ? 4096 : 1024;
    const bool dohb = !(which == 2 && l == 3);
    for (int row = blockIdx.x * 4 + wid; row < M_ALL; row += gridDim.x * 4) {
        float* xr = p.out + (size_t)row * DM;
        const float* src = which == 0 ? (row < M_CTX ? p.x_prompt + (size_t)row * DM : p.x_sample + (size_t)(row - M_CTX) * DM) : xr;
        f32x4 v[4];
#pragma unroll
        for (int i = 0; i < 4; ++i) v[i] = *(const f32x4*)(src + lane * 4 + 256 * i);
        if (which != 0) {
            float s = 0.f;
#pragma unroll
            for (int i = 0; i < 4; ++i) s += (v[i][0] + v[i][1]) + (v[i][2] + v[i][3]);
            s = red16(s); s += __shfl_xor(s, 16); s += __shfl_xor(s, 32);
            const float mu = s * (1.0f / 1024.0f); float q = 0.f;
#pragma unroll
            for (int i = 0; i < 4; ++i) { const f32x4 d = v[i] - mu; q += (d[0] * d[0] + d[1] * d[1]) + (d[2] * d[2] + d[3] * d[3]); }
            q = red16(q); q += __shfl_xor(q, 16); q += __shfl_xor(q, 32);
            const float rstd = rsqrtf(q * (1.0f / 1024.0f) + 1e-5f);
#pragma unroll
            for (int i = 0; i < 4; ++i) { const f32x4 gg = *(const f32x4*)(g + lane * 4 + 256 * i), bv = *(const f32x4*)(bb + lane * 4 + 256 * i); v[i] = (v[i] - mu) * rstd * gg + bv; }
        }
#pragma unroll
        for (int i = 0; i < 4; ++i) *(f32x4*)(xr + lane * 4 + 256 * i) = v[i];
        if (dohb) {
            const float* md = p.mod + ((size_t)ml * 5 + modrow_of(row)) * 6144;
#pragma unroll
            for (int i = 0; i < 4; ++i) { const f32x4 sh = *(const f32x4*)(md + shoff + lane * 4 + 256 * i), sc = *(const f32x4*)(md + scoff + lane * 4 + 256 * i);
                const f32x4 h = v[i] * (1.0f + sc) + sh; u32x2 w; w.x = pack2(h[0], h[1]); w.y = pack2(h[2], h[3]);
                *(u32x2*)(p.hbmix + (size_t)row * DM + lane * 4 + 256 * i) = w; }
        }
    }
}

__device__ __forceinline__ void rwprep_unit(const P& p, int l, int u, char* smem) {
    const int tid = opaque_tid(), lane = tid & 63, wid = tid >> 6, fr = lane & 15, fq = lane >> 4;
    const int R0 = u * 64;
    const int ss = R0 < M_CTX ? (R0 & ~255) : M_CTX + ((R0 - M_CTX) & ~4095); const int se = ss + (R0 < M_CTX ? 256 : 4096);
    bf16_t* XW = (bf16_t*)smem; bf16_t* XA = XW + 64 * 136; bf16_t* XG = XA + 64 * 136;
    const float* cw = p.rw_conv + (size_t)l * 3 * 1152;
    for (int it = tid; it < 576; it += 256) {
        const int cc = it % 144, tg = it / 144; const int c = cc * 8;
        float w0[8], w1[8], w2[8];
#pragma unroll
        for (int i = 0; i < 8; ++i) { w0[i] = cw[c + i]; w1[i] = cw[1152 + c + i]; w2[i] = cw[2304 + c + i]; }
        const int rfirst = R0 + tg * 16;
        u32x4 prev = (u32x4){0u, 0u, 0u, 0u}, cur, nxt;
        if (rfirst - 1 >= ss) prev = *(const u32x4*)(p.Z + (size_t)(rfirst - 1) * NIN + c);
        cur = *(const u32x4*)(p.Z + (size_t)rfirst * NIN + c);
        for (int tt = 0; tt < 16; ++tt) {
            const int row = rfirst + tt;
            nxt = (u32x4){0u, 0u, 0u, 0u};
            if (row + 1 < se) nxt = *(const u32x4*)(p.Z + (size_t)(row + 1) * NIN + c);
            float o[8];
#pragma unroll
            for (int i = 0; i < 4; ++i) {
                o[2 * i] = w0[2 * i] * lo_bf(prev[i]) + w1[2 * i] * lo_bf(cur[i]) + w2[2 * i] * lo_bf(nxt[i]);
                o[2 * i + 1] = w0[2 * i + 1] * hi_bf(prev[i]) + w1[2 * i + 1] * hi_bf(cur[i]) + w2[2 * i + 1] * hi_bf(nxt[i]);
            }
            if (c >= 768 && c < 896) {
#pragma unroll
                for (int i = 0; i < 8; ++i) o[i] = tanhf_(o[i]);
            } else if (c >= 1024) {
#pragma unroll
                for (int i = 0; i < 8; ++i) o[i] = sigmoidf_(o[i]);
            }
            u32x4 w; w.x = pack2(o[0], o[1]); w.y = pack2(o[2], o[3]); w.z = pack2(o[4], o[5]); w.w = pack2(o[6], o[7]);
            const int tl = tg * 16 + tt;
            if (c < 768) *(u32x4*)(p.RKV + (size_t)row * 768 + c) = w;
            else if (c < 896) *(u32x4*)(XW + tl * 136 + (c - 768)) = w;
            else if (c < 1024) *(u32x4*)(XA + tl * 136 + (c - 896)) = w;
            else *(u32x4*)(XG + tl * 136 + (c - 1024)) = w;
            prev = cur; cur = nxt;
        }
    }
    __syncthreads();
#pragma unroll 1
    for (int mh = 0; mh < 10; ++mh) {
        const int mat = mh >> 1, nh = mh & 1;
        const int d = mat & 1; const bf16_t* As; const bf16_t* Bw; int kofs, nks, ldw;
        if (mat < 2) { As = XW; Bw = p.W2t + d * 256 * 64; kofs = d * 64; nks = 2; ldw = 64; }
        else if (mat < 4) { As = XA; Bw = p.A2t + d * 256 * 64; kofs = d * 64; nks = 2; ldw = 64; }
        else { As = XG; Bw = p.G2t; kofs = 0; nks = 4; ldw = 128; }
        f32x4 acc[4][2];
#pragma unroll
        for (int m = 0; m < 4; ++m)
#pragma unroll
            for (int n = 0; n < 2; ++n) acc[m][n] = (f32x4){0.f, 0.f, 0.f, 0.f};
#pragma unroll 1
        for (int ks = 0; ks < nks; ++ks) {
            bf16x8 af[4], bfr[2];
#pragma unroll
            for (int m = 0; m < 4; ++m) af[m] = *(const bf16x8*)(As + (m * 16 + fr) * 136 + kofs + ks * 32 + fq * 8);
#pragma unroll
            for (int n = 0; n < 2; ++n) bfr[n] = *(const bf16x8*)(Bw + (size_t)(wid * 64 + nh * 32 + n * 16 + fr) * ldw + ks * 32 + fq * 8);
#pragma unroll
            for (int m = 0; m < 4; ++m)
#pragma unroll
                for (int n = 0; n < 2; ++n) acc[m][n] = __builtin_amdgcn_mfma_f32_16x16x32_bf16(af[m], bfr[n], acc[m][n], 0, 0, 0);
        }
#pragma unroll
        for (int n = 0; n < 2; ++n) {
            const int c = wid * 64 + nh * 32 + n * 16 + fr;
            float bias = 0.f; if (mat < 2) bias = p.rw_w0[(l * 2 + d) * 256 + c]; else if (mat < 4) bias = p.rw_a0[(l * 2 + d) * 256 + c];
            bf16_t* dst; float mul;
            if (mat < 2) { dst = p.Ee + ((size_t)d * M_ALL + R0) * 256 + c; mul = 0.6065306597126334f; }
            else if (mat < 4) { dst = p.Aa + ((size_t)d * M_ALL + R0) * 256 + c; mul = 1.0f; }
            else { dst = p.Gg + (size_t)R0 * 256 + c; mul = 1.0f; }
#pragma unroll
            for (int m = 0; m < 4; ++m)
#pragma unroll
                for (int j = 0; j < 4; ++j) {
                    const float x = acc[m][n][j] + bias;
                    dst[(size_t)(m * 16 + fq * 4 + j) * 256] = f2bf(mat < 4 ? mul * sigmoidf_(x) : x);
                }
        }
    }
    __syncthreads();
}
__device__ __forceinline__ void rowscale128(const bf16_t* Z, int R0, int zoff, int ncols, float eps, float* rs) {
    const int tid = opaque_tid(); const int r = tid >> 1, half = tid & 1; const int per = ncols >> 1;
    const bf16_t* zp = Z + (size_t)(R0 + r) * NIN + zoff + half * per;
    float ss = 0.f;
    for (int i = 0; i < per; i += 8) { const u32x4 w = *(const u32x4*)(zp + i);
#pragma unroll
        for (int q = 0; q < 4; ++q) { const float a = lo_bf(w[q]), b = hi_bf(w[q]); ss += a * a + b * b; } }
    ss = dpp_add<0xB1>(ss);
    if (half == 0) rs[r] = rsqrtf(ss / (float)ncols + eps);
}
__device__ __forceinline__ void small_unit(const P& p, int l, int u) {
    const int tid = opaque_tid(), sub = tid >> 5, li = tid & 31;
    if (u < 2560) {
        const int row = u * 8 + sub; const bf16_t* zr = p.Z + (size_t)row * NIN;
        const u32x2 w = *(const u32x2*)(zr + ZKV + li * 4);
        const float z0 = lo_bf(w.x), z1 = hi_bf(w.x), z2 = lo_bf(w.y), z3 = hi_bf(w.y);
        float ss = z0 * z0 + z1 * z1 + z2 * z2 + z3 * z3; ss = red16(ss); ss += __shfl_xor(ss, 16);
        const float rsv = rsqrtf(ss * (1.0f / 128.0f) + 1e-6f);
        const float x1 = bf2f(zr[ZKR + (li & 15)]), x2 = bf2f(zr[ZKR + 16 + (li & 15)]);
        float val;
        if (row < M_CTX) {
            const int b = row >> 8, t = row & 255; const size_t o = ((size_t)(b * 4 + l) * 256 + t);
            const f32x4 g = *(const f32x4*)(p.kv_norm + l * 128 + li * 4);
            *(f32x4*)(p.out + 20971520 + o * 128 + li * 4) = (f32x4){z0 * rsv * g[0], z1 * rsv * g[1], z2 * rsv * g[2], z3 * rsv * g[3]};
            val = li < 16 ? x1 : x2;
            p.out[20971520 + 2097152 + o * 32 + li] = val;
        } else {
            const int t = (row - M_CTX) & 4095; const float cv = p.ropeC[t * 16 + (li & 15)], sv = p.ropeS[t * 16 + (li & 15)];
            val = li < 16 ? x1 * cv - x2 * sv : x1 * sv + x2 * cv;
        }
        const bf16_t bv = f2bf(val);
#pragma unroll
        for (int h = 0; h < 8; ++h) p.Kb[(size_t)row * 768 + h * 96 + 64 + li] = bv;
    } else {
        const int r = (u - 2560) * 8 + sub; const int b = r >> 9, t = r & 511;
        const bf16_t bv = f2bf(p.cache_krope[((size_t)(b * 4 + l) * 512 + t) * 32 + li]);
#pragma unroll
        for (int h = 0; h < 8; ++h) p.Kc[(size_t)r * 768 + h * 96 + 64 + li] = bv;
    }
}
__device__ __forceinline__ void gmlp_unit(const P& p, int l, int u, char* smem) {
    const int tid = opaque_tid(), lane = tid & 63, wid = tid >> 6, fr = lane & 15, fq = lane >> 4;
    const int R0 = (u >> 2) * 128, g = u & 3;
    bf16_t* VnT = (bf16_t*)smem;
    {
        const int tok = tid >> 1, half = tid & 1; const bf16_t* zp = p.Z + (size_t)(R0 + tok) * NIN + ZV + g * 64 + half * 32;
        float x[32];
#pragma unroll
        for (int i = 0; i < 4; ++i) { const u32x4 w = *(const u32x4*)(zp + i * 8);
#pragma unroll
            for (int q = 0; q < 4; ++q) { x[i * 8 + 2 * q] = geluf_(lo_bf(w[q])); x[i * 8 + 2 * q + 1] = geluf_(hi_bf(w[q])); } }
        float s = 0.f;
#pragma unroll
        for (int i = 0; i < 32; ++i) s += x[i];
        s = dpp_add<0xB1>(s); const float mu = s * (1.0f / 64.0f);
        float q2 = 0.f;
#pragma unroll
        for (int i = 0; i < 32; ++i) { const float d = x[i] - mu; q2 += d * d; }
        q2 = dpp_add<0xB1>(q2); const float rstd = rsqrtf(q2 * (1.0f / 64.0f) + 1e-5f);
        const float* gg = p.gm_g + l * 256 + g * 64 + half * 32; const float* gb = p.gm_b + l * 256 + g * 64 + half * 32;
#pragma unroll
        for (int i = 0; i < 32; ++i) VnT[(half * 32 + i) * 136 + tok] = f2bf((x[i] - mu) * rstd * gg[i] + gb[i]);
    }
    __syncthreads();
    f32x4 acc[2][4];
#pragma unroll
    for (int m = 0; m < 2; ++m)
#pragma unroll
        for (int n = 0; n < 4; ++n) acc[m][n] = (f32x4){0.f, 0.f, 0.f, 0.f};
    const bf16_t* Wg = p.WsB + g * 128 * 128;
#pragma unroll
    for (int ks = 0; ks < 4; ++ks) {
        bf16x8 af[2], bfr[4];
#pragma unroll
        for (int m = 0; m < 2; ++m) af[m] = *(const bf16x8*)(Wg + (wid * 32 + m * 16 + fr) * 128 + ks * 32 + fq * 8);
#pragma unroll
        for (int n = 0; n < 4; ++n) bfr[n] = *(const bf16x8*)(VnT + (n * 16 + fr) * 136 + ks * 32 + fq * 8);
#pragma unroll
        for (int m = 0; m < 2; ++m)
#pragma unroll
            for (int n = 0; n < 4; ++n) acc[m][n] = __builtin_amdgcn_mfma_f32_16x16x32_bf16(af[m], bfr[n], acc[m][n], 0, 0, 0);
    }
#pragma unroll
    for (int m = 0; m < 2; ++m)
#pragma unroll
        for (int j = 0; j < 4; ++j) {
            const int pp = wid * 32 + m * 16 + fq * 4 + j; const float bs = p.gm_bs[l * 512 + g * 128 + pp];
#pragma unroll
            for (int n = 0; n < 4; ++n) { const int c = n * 16 + fr;
                const float uu = geluf_(bf2f(p.Z[(size_t)(R0 + pp) * NIN + ZU + g * 64 + c]));
                p.hbmix[(size_t)(R0 + pp) * DM + 768 + g * 64 + c] = f2bf(uu * (acc[m][n][j] + bs)); }
        }
    __syncthreads();
}

__device__ __forceinline__ void scan_unit(const P& p, int l, int u, char* smem) {
    const int tid = opaque_tid(), lane = tid & 63, wid = tid >> 6;
    int b, T, row0; const bool lat = u < 128;
    if (lat) { b = u >> 5; T = 4096; row0 = M_CTX + b * 4096; } else { b = (u - 128) >> 5; T = 256; row0 = b * 256; }
    const int h = (u >> 3) & 3, d = (u >> 2) & 1, rsl = u & 3;
    float* W = (float*)smem; float* NKK = W + 2048; float* KKA = NKK + 2048; float* KD = KKA + 2048; float* RR = KD + 2048; float* VS = RR + 2048; float* OUTP = VS + 512;
    const int rl = lane >> 4, kq = lane & 15; const int r16 = wid * 4 + rl; const int row = rsl * 16 + r16;
    f32x4 S = (f32x4){0.f, 0.f, 0.f, 0.f};
    const size_t stoff = ((((size_t)b * 4 + l) * 2 + d) * 4 + h) * 4096 + row * 64 + kq * 4;
    if (lat) S = *(const f32x4*)(p.state_rwkv + stoff);
    const int tok = tid >> 3, cg8 = tid & 7;
    float kkp[8], kap[8];
#pragma unroll
    for (int i = 0; i < 8; ++i) { kkp[i] = p.rw_kk[l * 256 + h * 64 + cg8 * 8 + i]; kap[i] = p.rw_ka[l * 256 + h * 64 + cg8 * 8 + i]; }
    const int nch = T >> 5;
    u32x4 r8, k8, e8, a8, v8;
    int grow, grow_prev = 0; f32x2 oreg = (f32x2){0.f, 0.f};
    {
        const int sidx = tok; const int t = d ? T - 1 - sidx : sidx; grow = row0 + t;
        r8 = *(const u32x4*)(p.RKV + (size_t)grow * 768 + h * 64 + cg8 * 8);
        k8 = *(const u32x4*)(p.RKV + (size_t)grow * 768 + 256 + h * 64 + cg8 * 8);
        v8 = *(const u32x4*)(p.RKV + (size_t)grow * 768 + 512 + h * 64 + rsl * 16 + (cg8 & 1) * 8);
        e8 = *(const u32x4*)(p.Ee + ((size_t)d * M_ALL + grow) * 256 + h * 64 + cg8 * 8);
        a8 = *(const u32x4*)(p.Aa + ((size_t)d * M_ALL + grow) * 256 + h * 64 + cg8 * 8);
    }
    for (int ch = 0; ch < nch; ++ch) {
        {
            float kf[8], kkv[8], rf[8], ef[8], af[8];
#pragma unroll
            for (int q = 0; q < 4; ++q) { kf[2 * q] = lo_bf(k8[q]); kf[2 * q + 1] = hi_bf(k8[q]); rf[2 * q] = lo_bf(r8[q]); rf[2 * q + 1] = hi_bf(r8[q]);
                ef[2 * q] = lo_bf(e8[q]); ef[2 * q + 1] = hi_bf(e8[q]); af[2 * q] = lo_bf(a8[q]); af[2 * q + 1] = hi_bf(a8[q]); }
            float ss = 0.f;
#pragma unroll
            for (int i = 0; i < 8; ++i) { kkv[i] = kf[i] * kkp[i]; ss += kkv[i] * kkv[i]; }
            ss = red8(ss);
            const float inv = rsqrtf(fmaxf(ss, 1e-24f));
            f32x4 o0, o1; const int base = tok * 64 + cg8 * 8;
#pragma unroll
            for (int i = 0; i < 4; ++i) { o0[i] = __expf(-ef[i]); o1[i] = __expf(-ef[4 + i]); }
            *(f32x4*)(W + base) = o0; *(f32x4*)(W + base + 4) = o1;
#pragma unroll
            for (int i = 0; i < 4; ++i) { o0[i] = -kkv[i] * inv; o1[i] = -kkv[4 + i] * inv; }
            *(f32x4*)(NKK + base) = o0; *(f32x4*)(NKK + base + 4) = o1;
#pragma unroll
            for (int i = 0; i < 4; ++i) { o0[i] = kkv[i] * inv * af[i]; o1[i] = kkv[4 + i] * inv * af[4 + i]; }
            *(f32x4*)(KKA + base) = o0; *(f32x4*)(KKA + base + 4) = o1;
#pragma unroll
            for (int i = 0; i < 4; ++i) { o0[i] = kf[i] * (1.0f + (af[i] - 1.0f) * kap[i]); o1[i] = kf[4 + i] * (1.0f + (af[4 + i] - 1.0f) * kap[4 + i]); }
            *(f32x4*)(KD + base) = o0; *(f32x4*)(KD + base + 4) = o1;
#pragma unroll
            for (int i = 0; i < 4; ++i) { o0[i] = rf[i]; o1[i] = rf[4 + i]; }
            *(f32x4*)(RR + base) = o0; *(f32x4*)(RR + base + 4) = o1;
            if (cg8 < 2) {
#pragma unroll
                for (int q = 0; q < 4; ++q) { VS[tok * 16 + cg8 * 8 + 2 * q] = lo_bf(v8[q]); VS[tok * 16 + cg8 * 8 + 2 * q + 1] = hi_bf(v8[q]); }
            }
        }
        __syncthreads();
        if (ch > 0) *(f32x2*)(p.ydir + ((size_t)d * M_ALL + grow_prev) * 256 + h * 64 + rsl * 16 + cg8 * 2) = oreg;
        grow_prev = grow;
        if (ch + 1 < nch) {
            const int sidx = (ch + 1) * 32 + tok; const int t = d ? T - 1 - sidx : sidx; grow = row0 + t;
            r8 = *(const u32x4*)(p.RKV + (size_t)grow * 768 + h * 64 + cg8 * 8);
            k8 = *(const u32x4*)(p.RKV + (size_t)grow * 768 + 256 + h * 64 + cg8 * 8);
            v8 = *(const u32x4*)(p.RKV + (size_t)grow * 768 + 512 + h * 64 + rsl * 16 + (cg8 & 1) * 8);
            e8 = *(const u32x4*)(p.Ee + ((size_t)d * M_ALL + grow) * 256 + h * 64 + cg8 * 8);
            a8 = *(const u32x4*)(p.Aa + ((size_t)d * M_ALL + grow) * 256 + h * 64 + cg8 * 8);
        }
        {
            const float* Wq = W + kq * 4; const float* NKq = NKK + kq * 4; const float* KAq = KKA + kq * 4; const float* KDq = KD + kq * 4; const float* RRq = RR + kq * 4; const float* VSq = VS + r16;
            float* OPq = OUTP + r16 * 16 + kq;
            f32x4 wv[4], nkv[4], kav[4], kdv[4], rrv[4]; float vv[4];
#define SCAN_LD(slot, st) do { wv[slot] = *(const f32x4*)(Wq + (st) * 64); nkv[slot] = *(const f32x4*)(NKq + (st) * 64); kav[slot] = *(const f32x4*)(KAq + (st) * 64); \
        kdv[slot] = *(const f32x4*)(KDq + (st) * 64); rrv[slot] = *(const f32x4*)(RRq + (st) * 64); vv[slot] = VSq[(st) * 16]; } while (0)
            SCAN_LD(0, 0); SCAN_LD(1, 1); SCAN_LD(2, 2);
#pragma unroll
            for (int s = 0; s < 32; ++s) {
                if (s + 3 < 32) SCAN_LD((s + 3) & 3, s + 3);
                const f32x4 w = wv[s & 3], nk = nkv[s & 3], ka = kav[s & 3], kd = kdv[s & 3], rr = rrv[s & 3]; const float v = vv[s & 3];
                float pd = fmaf(S[1], nk[1], S[0] * nk[0]) + fmaf(S[3], nk[3], S[2] * nk[2]);
                pd = red16(pd);
#pragma unroll
                for (int i = 0; i < 4; ++i) S[i] = fmaf(S[i], w[i], fmaf(pd, ka[i], v * kd[i]));
                OPq[s * 256] = fmaf(S[1], rr[1], S[0] * rr[0]) + fmaf(S[3], rr[3], S[2] * rr[2]);
            }
        }
        __syncthreads();
        {
            const float* op = OUTP + (tok * 16 + cg8 * 2) * 16;
            f32x4 a0 = *(const f32x4*)(op), a1 = *(const f32x4*)(op + 4), a2 = *(const f32x4*)(op + 8), a3 = *(const f32x4*)(op + 12);
            f32x4 b0 = *(const f32x4*)(op + 16), b1 = *(const f32x4*)(op + 20), b2 = *(const f32x4*)(op + 24), b3 = *(const f32x4*)(op + 28);
            a0 = (a0 + a1) + (a2 + a3); b0 = (b0 + b1) + (b2 + b3);
            oreg = (f32x2){(a0[0] + a0[1]) + (a0[2] + a0[3]), (b0[0] + b0[1]) + (b0[2] + b0[3])};
        }
    }
    *(f32x2*)(p.ydir + ((size_t)d * M_ALL + grow_prev) * 256 + h * 64 + rsl * 16 + cg8 * 2) = oreg;
    if (!lat) *(f32x4*)(p.out + 20971520 + 2097152 + 524288 + stoff) = S;
    __syncthreads();
}

#define KS_STRIDE 104
#define VS_STRIDE 72
#define KS_BYTES (64 * KS_STRIDE * 2)
#define ATT_STAGE (KS_BYTES + 64 * VS_STRIDE * 2)
__device__ __forceinline__ void attn_unit(const P& p, int u, char* smem) {
    const int tid = opaque_tid(), lane = tid & 63, wid = tid >> 6, q = lane & 31, hf = lane >> 5;
    int b, h, qt, qrow0, krow0, nown, ntot, Tv; size_t vbase, vcbase = 0; int kcrow0 = 0;
    if (u < 1024) { b = u >> 8; h = (u >> 5) & 7; qt = u & 31; krow0 = M_CTX + b * 4096; qrow0 = krow0 + qt * 128; nown = 64; ntot = 72; Tv = 4096;
        vbase = 2097152 + (size_t)(b * 8 + h) * 64 * 4096; kcrow0 = b * 512; vcbase = (size_t)(b * 8 + h) * 64 * 512; }
    else { const int v = u - 1024; b = v >> 4; h = (v >> 1) & 7; qt = v & 1; krow0 = b * 256; qrow0 = krow0 + qt * 128; nown = 4; ntot = 4; Tv = 256; vbase = (size_t)(b * 8 + h) * 64 * 256; }
    bf16x8 qf[6];
    { const bf16_t* qp = p.Qb + (size_t)(qrow0 + wid * 32 + q) * 768 + h * 96 + hf * 8;
#pragma unroll
      for (int ks = 0; ks < 6; ++ks) qf[ks] = *(const bf16x8*)(qp + ks * 16); }
    f32x16 oT[2];
#pragma unroll
    for (int i = 0; i < 16; ++i) { oT[0][i] = 0.f; oT[1][i] = 0.f; }
    float mrun = -1e30f, lrun = 0.f;
    u32x4 rk[3], rv[2];
    int krow[3], kc[3];
#pragma unroll
    for (int i = 0; i < 3; ++i) { const int c = tid + 256 * i; krow[i] = c / 12; kc[i] = c % 12; }
    const int vdv0 = tid >> 3, vkc = tid & 7;
#define ATT_LOAD(kt) do { const bf16_t* kptr; const bf16_t* vptr; int vstr; \
        if ((kt) < nown) { kptr = p.Kb + (size_t)(krow0 + (kt) * 64) * 768 + h * 96; vptr = p.Vt + vbase + (kt) * 64; vstr = Tv; } \
        else { kptr = p.Kc + (size_t)(kcrow0 + ((kt) - nown) * 64) * 768 + h * 96; vptr = p.Vtc + vcbase + ((kt) - nown) * 64; vstr = 512; } \
        _Pragma("unroll") for (int i = 0; i < 3; ++i) rk[i] = *(const u32x4*)(kptr + (size_t)krow[i] * 768 + kc[i] * 8); \
        _Pragma("unroll") for (int i = 0; i < 2; ++i) rv[i] = *(const u32x4*)(vptr + (size_t)(vdv0 + 32 * i) * vstr + vkc * 8); } while (0)
#define ATT_STORE(buf) do { char* Ks_ = smem + (buf) * ATT_STAGE; char* Vs_ = Ks_ + KS_BYTES; \
        _Pragma("unroll") for (int i = 0; i < 3; ++i) *(u32x4*)(Ks_ + (krow[i] * KS_STRIDE + kc[i] * 8) * 2) = rk[i]; \
        _Pragma("unroll") for (int i = 0; i < 2; ++i) *(u32x4*)(Vs_ + ((vdv0 + 32 * i) * VS_STRIDE + vkc * 8) * 2) = rv[i]; } while (0)
    ATT_LOAD(0); ATT_STORE(0);
    __syncthreads();
    for (int kt = 0; kt < ntot; ++kt) {
        const bool more = kt + 1 < ntot;
        if (more) ATT_LOAD(kt + 1);
        const char* Ks = smem + (kt & 1) * ATT_STAGE; const char* Vs = Ks + KS_BYTES;
        f32x16 sT[2];
#pragma unroll
        for (int i = 0; i < 16; ++i) { sT[0][i] = 0.f; sT[1][i] = 0.f; }
#pragma unroll
        for (int kb = 0; kb < 2; ++kb)
#pragma unroll
            for (int ks = 0; ks < 6; ++ks) { const bf16x8 kf = *(const bf16x8*)(Ks + ((kb * 32 + q) * KS_STRIDE + ks * 16 + hf * 8) * 2);
                sT[kb] = __builtin_amdgcn_mfma_f32_32x32x16_bf16(kf, qf[ks], sT[kb], 0, 0, 0); }
        float mx = sT[0][0];
#pragma unroll
        for (int i = 1; i < 16; ++i) mx = fmaxf(mx, sT[0][i]);
#pragma unroll
        for (int i = 0; i < 16; ++i) mx = fmaxf(mx, sT[1][i]);
        mx = fmaxf(mx, __shfl_xor(mx, 32));
        const float mnew = fmaxf(mrun, mx); const float alpha = __builtin_amdgcn_exp2f(mrun - mnew); const bool resc = __any(mnew > mrun); mrun = mnew;
        float psum = 0.f; bf16x8 pf[2][2];
#pragma unroll
        for (int kb = 0; kb < 2; ++kb)
#pragma unroll
            for (int s = 0; s < 2; ++s) { float e[8];
#pragma unroll
                for (int j = 0; j < 8; ++j) { e[j] = __builtin_amdgcn_exp2f(sT[kb][8 * s + j] - mnew); psum += e[j]; }
                u32x4 w; w.x = pack2(e[0], e[1]); w.y = pack2(e[2], e[3]); w.z = pack2(e[4], e[5]); w.w = pack2(e[6], e[7]);
                pf[kb][s] = __builtin_bit_cast(bf16x8, w); }
        lrun = lrun * alpha + psum;
        if (resc) {
#pragma unroll
            for (int i = 0; i < 16; ++i) { oT[0][i] *= alpha; oT[1][i] *= alpha; }
        }
#pragma unroll
        for (int kb = 0; kb < 2; ++kb)
#pragma unroll
            for (int s = 0; s < 2; ++s)
#pragma unroll
                for (int db = 0; db < 2; ++db) {
                    const char* vp = Vs + ((db * 32 + q) * VS_STRIDE + kb * 32 + 16 * s + 4 * hf) * 2;
                    const u32x2 lo = *(const u32x2*)vp, hi = *(const u32x2*)(vp + 16);
                    const u32x4 w = (u32x4){lo.x, lo.y, hi.x, hi.y};
                    oT[db] = __builtin_amdgcn_mfma_f32_32x32x16_bf16(__builtin_bit_cast(bf16x8, w), pf[kb][s], oT[db], 0, 0, 0);
                }
        if (more) ATT_STORE((kt + 1) & 1);
        __syncthreads();
    }
    const float lt = lrun + __shfl_xor(lrun, 32); const float inv = 1.0f / lt;
    bf16_t* op = p.hbmix + (size_t)(qrow0 + wid * 32 + q) * DM + 256 + h * 64;
#pragma unroll
    for (int db = 0; db < 2; ++db)
#pragma unroll
        for (int g = 0; g < 4; ++g) { u32x2 w; w.x = pack2(oT[db][4 * g] * inv, oT[db][4 * g + 1] * inv); w.y = pack2(oT[db][4 * g + 2] * inv, oT[db][4 * g + 3] * inv);
            *(u32x2*)(op + db * 32 + 8 * g + 4 * hf) = w; }
}

__device__ __forceinline__ void rwcomb_phase(const P& p, int l) {
    const int tid = opaque_tid(), lane = tid & 63, wid = tid >> 6; const int c = lane * 4;
    const f32x4 gng = *(const f32x4*)(p.rw_gn_g + l * 256 + c), gnb = *(const f32x4*)(p.rw_gn_b + l * 256 + c), kap = *(const f32x4*)(p.rw_ka + l * 256 + c), rkp = *(const f32x4*)(p.rw_rk + l * 256 + c);
    for (int row = blockIdx.x * 4 + wid; row < M_ALL; row += gridDim.x * 4) {
        const f32x4 y0 = *(const f32x4*)(p.ydir + (size_t)row * 256 + c), y1 = *(const f32x4*)(p.ydir + ((size_t)M_ALL + row) * 256 + c);
        f32x4 y = y0 + y1;
        float s = (y[0] + y[1]) + (y[2] + y[3]); s = red16(s); const float mu = s * (1.0f / 64.0f);
        const f32x4 dd = y - mu; float q2 = (dd[0] * dd[0] + dd[1] * dd[1]) + (dd[2] * dd[2] + dd[3] * dd[3]); q2 = red16(q2);
        const float rstd = rsqrtf(q2 * (1.0f / 64.0f) + 64e-5f);
        const f32x4 yn = dd * rstd * gng + gnb;
        const u32x2 rw = *(const u32x2*)(p.RKV + (size_t)row * 768 + c), kw = *(const u32x2*)(p.RKV + (size_t)row * 768 + 256 + c), vw = *(const u32x2*)(p.RKV + (size_t)row * 768 + 512 + c);
        const u32x2 a0w = *(const u32x2*)(p.Aa + (size_t)row * 256 + c), a1w = *(const u32x2*)(p.Aa + ((size_t)M_ALL + row) * 256 + c), gw = *(const u32x2*)(p.Gg + (size_t)row * 256 + c);
        const f32x4 r = (f32x4){lo_bf(rw.x), hi_bf(rw.x), lo_bf(rw.y), hi_bf(rw.y)}, k = (f32x4){lo_bf(kw.x), hi_bf(kw.x), lo_bf(kw.y), hi_bf(kw.y)}, v = (f32x4){lo_bf(vw.x), hi_bf(vw.x), lo_bf(vw.y), hi_bf(vw.y)};
        const f32x4 a0 = (f32x4){lo_bf(a0w.x), hi_bf(a0w.x), lo_bf(a0w.y), hi_bf(a0w.y)}, a1 = (f32x4){lo_bf(a1w.x), hi_bf(a1w.x), lo_bf(a1w.y), hi_bf(a1w.y)}, gt = (f32x4){lo_bf(gw.x), hi_bf(gw.x), lo_bf(gw.y), hi_bf(gw.y)};
        const f32x4 kds = k * (1.0f + (a0 - 1.0f) * kap) + k * (1.0f + (a1 - 1.0f) * kap);
        const f32x4 t4 = r * kds * rkp; float rk = (t4[0] + t4[1]) + (t4[2] + t4[3]); rk = red16(rk);
        const f32x4 o = (yn + rk * v) * gt;
        u32x2 w; w.x = pack2(o[0], o[1]); w.y = pack2(o[2], o[3]);
        *(u32x2*)(p.hbmix + (size_t)row * DM + c) = w;
    }
}


__device__ __forceinline__ bool xcd_tile(int i, int TT, int NT, int& mt, int& nt) {
    const int per = TT >> 3; if (i >= per) return false;
    const int t = (blockIdx.x & 7) * per + i; const int band = t / (8 * NT), rem = t - band * 8 * NT;
    nt = rem >> 3; mt = band * 8 + (rem & 7); return true;
}
__global__ void __launch_bounds__(256, 2) mega(Args a_unused) {
    extern __shared__ __attribute__((aligned(16))) char smem[];
    __shared__ uint4 xbw; __shared__ int s_unit;
    kargp_t kp = (kargp_t)__builtin_amdgcn_kernarg_segment_ptr();
    const int tid = threadIdx.x; const int G = gridDim.x;
    if (tid == 0) xbw = make_uint4(0u, 0u, 0u, 0u);
    __syncthreads();
    XcdBarrier xb;
    { const P p = getP(kp); xb = xcd_barrier_post(p.bar, (volatile LAS unsigned*)&xbw); }
    for (int u = blockIdx.x; u < 384 + NCONV + 272; u += G) {
        if (u < 384) { const P p = getP(kp); ada_unit(p, u, smem); } else if (u < 384 + NCONV) { const P p = getP(kp); conv_unit(p, 0, u - 384, smem); } else { const P p = getP(kp); misc0_unit(p, u - 384 - NCONV); }
    }
    cg::this_grid().sync();
    { const P p = getP(kp); ln_phase(p, 0, 0); }
    xcd_barrier(xb);
    float* rs = (float*)(smem + RS_OFF);
#pragma unroll 1
    for (int l = 0; l < 4; ++l) {
        for (int i = blockIdx.x >> 3; ; i += G >> 3) { int mt, nt; if (!xcd_tile(i, 160 * 17, 17, mt, nt)) break; const P p = getP(kp);
            EpiZ e{p.Z, mt * 128, nt * 128};
            gemm128(p.hbmix + (size_t)mt * 128 * DM, DM, p.WtIn + (size_t)nt * 128 * DM, DM, DM, smem, e); }
        xcd_barrier(xb);
        for (int rep2 = 0; rep2 < DUP_P2; ++rep2) {
        for (;;) {
            { const P pc = getP(kp); if (tid == 0) s_unit = atomicAdd(&pc.ctr[l * 4 + 0 + 2 * rep2], 1); }
            __syncthreads(); int u = s_unit; __syncthreads();
            if (u >= 320 + 960 + 1408 + 2816 + 640) break;
            if (u < 320) { const P p = getP(kp); rwprep_unit(p, l, u, smem); continue; }
            u -= 320;
            if (u < 960) { const P p = getP(kp); const int mt = u / 6, nt = u % 6;
                rowscale128(p.Z, mt * 128, ZQ, 256, 1e-6f, rs);
                EpiQ e{p.Qb, rs, p.ropeC, p.ropeS, mt * 128, nt * 128};
                gemm128(p.Z + (size_t)mt * 128 * NIN + ZQ, NIN, p.WtQ + (size_t)nt * 128 * 256, 256, 256, smem, e); __syncthreads(); continue; }
            u -= 960;
            if (u < 1280) { const P p = getP(kp); const int mt = u >> 3, nt = u & 7; const int R0 = mt * 128; const bool latr = R0 >= M_CTX;
                rowscale128(p.Z, R0, ZKV, 128, 1e-6f, rs);
                EpiKV e{latr ? p.Kb + (size_t)M_CTX * 768 : p.Kb, p.Vt, rs, latr ? R0 - M_CTX : R0, nt * 128, latr ? 12 : 8, latr ? (size_t)2097152 : (size_t)0};
                gemm128(p.Z + (size_t)R0 * NIN + ZKV, NIN, p.WtKVn + (size_t)nt * 128 * 128, 128, 128, smem, e); __syncthreads(); continue; }
            u -= 1280;
            if (u < 128) { const P p = getP(kp); const int mt = u >> 3, nt = u & 7;
                EpiKV e{p.Kc, p.Vtc, nullptr, mt * 128, nt * 128, 9, (size_t)0};
                gemm128(p.CkvB + ((size_t)l * 2048 + mt * 128) * 128, 128, p.WtKV + (size_t)nt * 128 * 128, 128, 128, smem, e); continue; }
            u -= 128;
            if (u < 2816) { const P p = getP(kp); small_unit(p, l, u); continue; }
            u -= 2816;
            { const P p = getP(kp); gmlp_unit(p, l, u, smem); }
        }
        xcd_barrier(xb);
        }
        for (int rep3 = 0; rep3 < DUP_P3; ++rep3) {
        for (;;) {
            { const P pc = getP(kp); if (tid == 0) s_unit = atomicAdd(&pc.ctr[l * 4 + 1 + 2 * rep3], 1); }
            __syncthreads(); int u = s_unit; __syncthreads();
            if (u >= 640 + 1280) break;
#ifdef PROBE_SCAN_ONLY
            if (rep3 == 1 && u >= 640) break;
#endif
#ifdef PROBE_ATTN_ONLY
            if (rep3 == 1 && u < 640) continue;
#endif
            if (u < 640) { const P p = getP(kp); scan_unit(p, l, u, smem); } else { const P p = getP(kp); attn_unit(p, u - 640, smem); }
        }
        xcd_barrier(xb);
        }
        { const P p = getP(kp); rwcomb_phase(p, l); }
        xcd_barrier(xb);
        for (int i = blockIdx.x >> 3; ; i += G >> 3) { int mt, nt; if (!xcd_tile(i, 160 * 8, 8, mt, nt)) break; const P p = getP(kp);
            EpiRes e{p.out, p.mod + ((size_t)l * 5 + modrow_of(mt * 128)) * 6144 + 2048, mt * 128, nt * 128};
            gemm128(p.hbmix + (size_t)mt * 128 * DM, DM, p.WtOut + (size_t)nt * 128 * DM, DM, DM, smem, e); }
        xcd_barrier(xb);
        { const P p = getP(kp); ln_phase(p, l, 1); }
        xcd_barrier(xb);
        for (int rep5 = 0; rep5 < DUP_P5; ++rep5)
        for (int i = blockIdx.x >> 3; ; i += G >> 3) { int mt, nt; if (!xcd_tile(i, 160 * 44, 44, mt, nt)) break; const P p = getP(kp);
            EpiSwi e{p.hidden, mt * 128, nt * 128};
            gemm128(p.hbmix + (size_t)mt * 128 * DM, DM, p.WtF1 + (size_t)nt * 128 * DM, DM, DM, smem, e); }
        xcd_barrier(xb);
        for (int i = blockIdx.x >> 3; ; i += G >> 3) { int mt, nt; if (!xcd_tile(i, 160 * 8, 8, mt, nt)) break; const P p = getP(kp);
            EpiRes e{p.out, p.mod + ((size_t)l * 5 + modrow_of(mt * 128)) * 6144 + 5120, mt * 128, nt * 128};
            gemm128(p.hidden + (size_t)mt * 128 * DFF, DFF, p.WtF2 + (size_t)nt * 128 * DFF, DFF, DFF, smem, e); }
        xcd_barrier(xb);
        { const P p = getP(kp); ln_phase(p, l, 2); }
        if (l < 3) { for (int u = blockIdx.x; u < NCONV; u += G) { const P p = getP(kp); conv_unit(p, l + 1, u, smem); } }
        xcd_barrier(xb);
    }
}

extern "C" void kernel_launch(void* const* d_in, const int* in_sizes, int n_in, void* d_out, int out_size, void* d_ws, size_t ws_size, hipStream_t stream) {
    static int grid_blocks = 0;
    if (!grid_blocks) {
        int dev = 0, cus = 0, per_cu = 0;
        (void)hipGetDevice(&dev);
        (void)hipDeviceGetAttribute(&cus, hipDeviceAttributeMultiprocessorCount, dev);
        (void)hipFuncSetAttribute((const void*)mega, hipFuncAttributeMaxDynamicSharedMemorySize, SMEM_BYTES);
        (void)hipOccupancyMaxActiveBlocksPerMultiprocessor(&per_cu, (const void*)mega, 256, SMEM_BYTES);
        if (per_cu > 2) per_cu = 2;
        if (per_cu < 1) per_cu = 1;
        grid_blocks = (cus * per_cu) & ~7;
    }
    if (WS_TOTAL > ws_size) { fprintf(stderr, "kernel_launch: workspace too small: need %zu have %zu\n", (size_t)WS_TOTAL, ws_size); return; }
    Args a{};
    for (int i = 0; i < 36; ++i) a.in[i] = (const float*)d_in[i];
    a.out = (float*)d_out; a.ws = (char*)d_ws;
    (void)hipMemsetAsync((char*)d_ws + OFF_BAR, 0, 16384 + 4096, stream);
    void* args[] = {&a};
    hipError_t e = hipLaunchCooperativeKernel((const void*)mega, dim3(grid_blocks), dim3(256), args, SMEM_BYTES, stream);
    if (e != hipSuccess) fprintf(stderr, "cooperative launch failed: %s (grid %d)\n", hipGetErrorString(e), grid_blocks);
}
```

```cpp
#include <hip/hip_runtime.h>
#include <hip/hip_cooperative_groups.h>
#include <cstdint>
#include <cstdio>
namespace cg = cooperative_groups;

typedef unsigned short bf16_t;
typedef short bf16x8 __attribute__((ext_vector_type(8)));
typedef float f32x4 __attribute__((ext_vector_type(4)));
typedef float f32x2 __attribute__((ext_vector_type(2)));
typedef float f32x16 __attribute__((ext_vector_type(16)));
typedef unsigned u32x4 __attribute__((ext_vector_type(4)));
typedef unsigned u32x2 __attribute__((ext_vector_type(2)));

#define M_ALL 20480
#define M_CTX 4096
#define DM 1024
#define NIN 2080
#define DFF 2816
#define ALPHA_F 1.6817928305074290f
#define QSCALE (0.10206207261596575f * 1.4426950408889634f)
#define LAS __attribute__((address_space(3)))
#ifndef DUP_P2
#define DUP_P2 1
#endif
#ifndef DUP_P3
#define DUP_P3 1
#endif
#ifndef DUP_P5
#define DUP_P5 1
#endif

#define ZQ 1152
#define ZKV 1408
#define ZKR 1536
#define ZU 1568
#define ZV 1824

#define LDS_STRIDE 72
#define TILE_BYTES (128 * LDS_STRIDE * 2)
#define RS_OFF (4 * TILE_BYTES)
#define SMEM_BYTES (RS_OFF + 3072)

struct P {
    const float *x_prompt, *x_sample, *cache_ckv, *cache_krope, *state_rwkv, *c, *c_ctx, *ada_w, *ada_b, *w_in, *rw_conv, *rw_w0, *rw_w2,
        *rw_a0, *rw_a2, *rw_g2, *rw_kk, *rw_ka, *rw_rk, *rw_gn_g, *rw_gn_b, *q_norm, *q_up, *kv_norm, *kv_up, *gm_g, *gm_b, *gm_ws, *gm_bs,
        *w_out, *ln1_g, *ln1_b, *ffn_in, *ffn_out, *ln2_g, *ln2_b;
    float* out;
    unsigned* bar; int* ctr; float* mod; float* ropeC; float* ropeS; bf16_t* CkvB;
    bf16_t *WtIn, *WtQ, *WtKVn, *WtKV, *WtOut, *WtF1, *WtF2, *WsB, *W2t, *A2t, *G2t;
    bf16_t *Z, *RKV, *Ee, *Aa, *Gg, *Qb, *Kb, *Kc, *Vt, *Vtc, *hbmix, *hidden;
    float* ydir;
};


struct Args { const float* in[36]; float* out; char* ws; };
typedef const __attribute__((address_space(4))) char* kargp_t;
constexpr size_t al256(size_t x) { return (x + 255) & ~(size_t)255; }
constexpr size_t OFF_BAR = 0;
constexpr size_t OFF_CTR = OFF_BAR + 16384;
constexpr size_t OFF_MOD = OFF_CTR + 4096;
constexpr size_t OFF_ROPEC = OFF_MOD + al256((size_t)4 * 5 * 6144 * 4);
constexpr size_t OFF_ROPES = OFF_ROPEC + 65536 * 4;
constexpr size_t OFF_CKVB = OFF_ROPES + 65536 * 4;
constexpr size_t OFF_WTIN = OFF_CKVB + (size_t)4 * 2048 * 128 * 2;
constexpr size_t OFF_WTQ = OFF_WTIN + (size_t)2176 * 1024 * 2;
constexpr size_t OFF_WTKVN = OFF_WTQ + (size_t)768 * 256 * 2;
constexpr size_t OFF_WTKV = OFF_WTKVN + (size_t)1024 * 128 * 2;
constexpr size_t OFF_WTOUT = OFF_WTKV + (size_t)1024 * 128 * 2;
constexpr size_t OFF_WTF1 = OFF_WTOUT + (size_t)1024 * 1024 * 2;
constexpr size_t OFF_WTF2 = OFF_WTF1 + (size_t)5632 * 1024 * 2;
constexpr size_t OFF_WSB = OFF_WTF2 + (size_t)1024 * DFF * 2;
constexpr size_t OFF_W2T = OFF_WSB + (size_t)65536 * 2;
constexpr size_t OFF_A2T = OFF_W2T + (size_t)2 * 256 * 64 * 2;
constexpr size_t OFF_G2T = OFF_A2T + (size_t)2 * 256 * 64 * 2;
constexpr size_t OFF_Z = OFF_G2T + (size_t)256 * 128 * 2;
constexpr size_t OFF_HIDDEN = OFF_Z;
constexpr size_t OFF_RKV = OFF_Z + al256((size_t)M_ALL * NIN * 2);
constexpr size_t OFF_EE = OFF_RKV + (size_t)M_ALL * 768 * 2;
constexpr size_t OFF_AA = OFF_EE + (size_t)2 * M_ALL * 256 * 2;
constexpr size_t OFF_GG = OFF_AA + (size_t)2 * M_ALL * 256 * 2;
constexpr size_t OFF_QB = OFF_GG + (size_t)M_ALL * 256 * 2;
constexpr size_t OFF_KB = OFF_QB + (size_t)M_ALL * 768 * 2;
constexpr size_t OFF_KC = OFF_KB + (size_t)M_ALL * 768 * 2;
constexpr size_t OFF_VT = OFF_KC + (size_t)2048 * 768 * 2;
constexpr size_t OFF_VTC = OFF_VT + (size_t)M_ALL * 512 * 2;
constexpr size_t OFF_YDIR = OFF_VTC + (size_t)2048 * 512 * 2;
constexpr size_t OFF_HBMIX = OFF_YDIR + (size_t)2 * M_ALL * 256 * 4;
constexpr size_t WS_TOTAL = OFF_HBMIX + (size_t)M_ALL * DM * 2;
static_assert(OFF_RKV + (size_t)M_ALL * 768 * 2 - OFF_HIDDEN >= (size_t)M_ALL * DFF * 2, "hidden overlay");

__device__ __forceinline__ P getP(kargp_t& kp) {
    asm volatile("" : "+s"(kp));
    typedef const float* const __attribute__((address_space(4)))* inp_t;
    inp_t in = (inp_t)kp;
    P p;
    p.x_prompt = in[0]; p.x_sample = in[1]; p.cache_ckv = in[2]; p.cache_krope = in[3]; p.state_rwkv = in[4]; p.c = in[5]; p.c_ctx = in[6];
    p.ada_w = in[7]; p.ada_b = in[8]; p.w_in = in[9]; p.rw_conv = in[10]; p.rw_w0 = in[11]; p.rw_w2 = in[12]; p.rw_a0 = in[13]; p.rw_a2 = in[14];
    p.rw_g2 = in[15]; p.rw_kk = in[16]; p.rw_ka = in[17]; p.rw_rk = in[18]; p.rw_gn_g = in[19]; p.rw_gn_b = in[20]; p.q_norm = in[21]; p.q_up = in[22];
    p.kv_norm = in[23]; p.kv_up = in[24]; p.gm_g = in[25]; p.gm_b = in[26]; p.gm_ws = in[27]; p.gm_bs = in[28]; p.w_out = in[29]; p.ln1_g = in[30];
    p.ln1_b = in[31]; p.ffn_in = in[32]; p.ffn_out = in[33]; p.ln2_g = in[34]; p.ln2_b = in[35];
    p.out = (float*)in[36]; char* ws = (char*)in[37];
    p.bar = (unsigned*)(ws + OFF_BAR); p.ctr = (int*)(ws + OFF_CTR); p.mod = (float*)(ws + OFF_MOD); p.ropeC = (float*)(ws + OFF_ROPEC); p.ropeS = (float*)(ws + OFF_ROPES);
    p.CkvB = (bf16_t*)(ws + OFF_CKVB); p.WtIn = (bf16_t*)(ws + OFF_WTIN); p.WtQ = (bf16_t*)(ws + OFF_WTQ); p.WtKVn = (bf16_t*)(ws + OFF_WTKVN); p.WtKV = (bf16_t*)(ws + OFF_WTKV);
    p.WtOut = (bf16_t*)(ws + OFF_WTOUT); p.WtF1 = (bf16_t*)(ws + OFF_WTF1); p.WtF2 = (bf16_t*)(ws + OFF_WTF2); p.WsB = (bf16_t*)(ws + OFF_WSB); p.W2t = (bf16_t*)(ws + OFF_W2T);
    p.A2t = (bf16_t*)(ws + OFF_A2T); p.G2t = (bf16_t*)(ws + OFF_G2T); p.Z = (bf16_t*)(ws + OFF_Z); p.RKV = (bf16_t*)(ws + OFF_RKV); p.Ee = (bf16_t*)(ws + OFF_EE); p.Aa = (bf16_t*)(ws + OFF_AA);
    p.Gg = (bf16_t*)(ws + OFF_GG); p.Qb = (bf16_t*)(ws + OFF_QB); p.Kb = (bf16_t*)(ws + OFF_KB); p.Kc = (bf16_t*)(ws + OFF_KC); p.Vt = (bf16_t*)(ws + OFF_VT); p.Vtc = (bf16_t*)(ws + OFF_VTC);
    p.hbmix = (bf16_t*)(ws + OFF_HBMIX); p.hidden = (bf16_t*)(ws + OFF_HIDDEN); p.ydir = (float*)(ws + OFF_YDIR);
    return p;
}

__device__ __forceinline__ float bf2f(bf16_t b) { return __uint_as_float(((unsigned)b) << 16); }
__device__ __forceinline__ unsigned pack2(float lo, float hi) { unsigned r; asm("v_cvt_pk_bf16_f32 %0, %1, %2" : "=v"(r) : "v"(lo), "v"(hi)); return r; }
__device__ __forceinline__ bf16_t f2bf(float f) { return (bf16_t)(pack2(f, 0.f) & 0xffffu); }
__device__ __forceinline__ float lo_bf(unsigned w) { return __uint_as_float(w << 16); }
__device__ __forceinline__ float hi_bf(unsigned w) { return __uint_as_float(w & 0xffff0000u); }
__device__ __forceinline__ float sigmoidf_(float x) { return __builtin_amdgcn_rcpf(1.0f + __builtin_amdgcn_exp2f(-1.4426950408889634f * x)); }
__device__ __forceinline__ float tanhf_(float x) { float e = __builtin_amdgcn_exp2f(2.8853900817779268f * x); return 1.0f - 2.0f * __builtin_amdgcn_rcpf(e + 1.0f); }
__device__ __forceinline__ float geluf_(float x) { return 0.5f * x * (1.0f + tanhf_(0.7978845608028654f * (x + 0.044715f * x * x * x))); }
template <int CTRL> __device__ __forceinline__ float dpp_add(float x) {
    int y = __builtin_amdgcn_update_dpp(0, __float_as_int(x), CTRL, 0xf, 0xf, false);
    return x + __int_as_float(y);
}
__device__ __forceinline__ float red4(float x) { x = dpp_add<0xB1>(x); x = dpp_add<0x4E>(x); return x; }
__device__ __forceinline__ float red8(float x) { x = red4(x); x = dpp_add<0x141>(x); return x; }
__device__ __forceinline__ float red16(float x) { x = red8(x); x = dpp_add<0x140>(x); return x; }
__device__ __forceinline__ int opaque_tid() { int t = threadIdx.x; asm volatile("" : "+v"(t)); return t; }
__device__ __forceinline__ int modrow_of(int row) { return row < M_CTX ? 0 : 1 + ((row - M_CTX) >> 12); }

#define XB_TMO 128
#define XB_XCNT(j) (256 + 64 * (j))
#define XB_XSUB(j) (1280 + 64 * (j))
#define XB_XGEN(j) (2304 + 64 * (j))
#define XB_TOP 3328
#define XB_TOPGEN 3392
#define XCD_BAR_WORDS 3456
#define XB_SPIN_CAP (1u << 22)
__device__ __forceinline__ unsigned xb_ld(unsigned* p) { return __hip_atomic_load(p, __ATOMIC_RELAXED, __HIP_MEMORY_SCOPE_AGENT); }
__device__ __forceinline__ unsigned xb_add(unsigned* p, unsigned v) { return __hip_atomic_fetch_add(p, v, __ATOMIC_RELAXED, __HIP_MEMORY_SCOPE_AGENT); }
__device__ __forceinline__ unsigned xb_xcc_id() { return (unsigned)__builtin_amdgcn_s_getreg((3 << 11) | 20) & 0xFu; }
#define XB_SPIN(cond, bar) do { unsigned _sp = 0; while (cond) { __builtin_amdgcn_s_sleep(1); \
    if ((++_sp & 255u) == 0u) { if (xb_ld(&(bar)[XB_TMO])) break; if (_sp > XB_SPIN_CAP) { atomicAdd(&(bar)[XB_TMO], 1u); break; } } } } while (0)
struct XcdBarrier { unsigned* bar; unsigned x; volatile LAS unsigned* st; };
__device__ __forceinline__ XcdBarrier xcd_barrier_post(unsigned* bar, volatile LAS unsigned* st) {
    XcdBarrier b; b.bar = bar; b.x = xb_xcc_id(); b.st = st;
    if (threadIdx.x == 0) (void)xb_add(&bar[XB_XCNT(b.x)], 1u);
    return b;
}
__device__ __forceinline__ void xcd_barrier_complete(unsigned* bar, unsigned x, unsigned& nloc, unsigned& nx) {
    const unsigned G = gridDim.x * gridDim.y * gridDim.z;
    unsigned sum, cnt, mine, sp = 0u;
    for (;;) {
        sum = 0u; cnt = 0u; mine = 0u;
#pragma unroll
        for (unsigned j = 0; j < 16; ++j) { const unsigned c = xb_ld(&bar[XB_XCNT(j)]); sum += c; cnt += (c > 0u) ? 1u : 0u; mine = (j == x) ? c : mine; }
        if (sum == G) break;
        __builtin_amdgcn_s_sleep(1);
        if ((++sp & 255u) == 0u) { if (xb_ld(&bar[XB_TMO])) break; if (sp > XB_SPIN_CAP) { atomicAdd(&bar[XB_TMO], 1u); break; } }
    }
    nloc = mine > 0u ? mine : 1u; nx = cnt > 0u ? cnt : 1u;
}
__device__ __forceinline__ void xcd_barrier(const XcdBarrier& b) {
    asm volatile("s_waitcnt vmcnt(0)" ::: "memory");
    __syncthreads();
    if (threadIdx.x == 0) {
        unsigned* bar = b.bar;
        __builtin_amdgcn_s_waitcnt(0);
        unsigned nloc = b.st[0], nx = b.st[1];
        if (nloc == 0u) { xcd_barrier_complete(bar, b.x, nloc, nx); b.st[0] = nloc; b.st[1] = nx; }
        const unsigned old = xb_add(&bar[XB_XSUB(b.x)], 1u);
        const unsigned gen = old / nloc;
        if (old + 1u == (gen + 1u) * nloc) {
            __builtin_amdgcn_fence(__ATOMIC_RELEASE, "agent");
            asm volatile("s_waitcnt vmcnt(0)" ::: "memory");
            const unsigned og = xb_add(&bar[XB_TOP], 1u);
            const unsigned tg = og / nx;
            if (og + 1u == (tg + 1u) * nx) xb_add(&bar[XB_TOPGEN], 1u);
            else XB_SPIN(xb_ld(&bar[XB_TOPGEN]) == tg, bar);
            __builtin_amdgcn_fence(__ATOMIC_ACQUIRE, "agent");
            xb_add(&bar[XB_XGEN(b.x)], 1u);
            asm volatile("s_waitcnt vmcnt(0)" ::: "memory");
        } else {
            XB_SPIN(xb_ld(&bar[XB_XGEN(b.x)]) == gen, bar);
            __builtin_amdgcn_fence(__ATOMIC_ACQUIRE, "agent");
            asm volatile("s_waitcnt vmcnt(0)" ::: "memory");
        }
    }
    __syncthreads();
}

template <class Epi>
__device__ __forceinline__ void gemm128(const bf16_t* __restrict__ A, int lda, const bf16_t* __restrict__ B, int ldb, int K, char* smem, const Epi& epi) {
    const int tid = opaque_tid(), lane = tid & 63, wid = tid >> 6, wr = wid >> 1, wc = wid & 1, fr = lane & 15, fq = lane >> 4;
    f32x4 acc[4][4];
#pragma unroll
    for (int m = 0; m < 4; ++m)
#pragma unroll
        for (int n = 0; n < 4; ++n) acc[m][n] = (f32x4){0.f, 0.f, 0.f, 0.f};
    const int crow = tid >> 3, ckc = tid & 7;
    const bf16_t* ap = A + (size_t)crow * lda + ckc * 8;
    const bf16_t* bp = B + (size_t)crow * ldb + ckc * 8;
    u32x4 ra[4], rb[4];
#pragma unroll
    for (int i = 0; i < 4; ++i) { ra[i] = *(const u32x4*)(ap + (size_t)(32 * i) * lda); rb[i] = *(const u32x4*)(bp + (size_t)(32 * i) * ldb); }
    {
        char* sa = smem; char* sb = smem + TILE_BYTES;
#pragma unroll
        for (int i = 0; i < 4; ++i) { *(u32x4*)(sa + ((crow + 32 * i) * LDS_STRIDE + ckc * 8) * 2) = ra[i]; *(u32x4*)(sb + ((crow + 32 * i) * LDS_STRIDE + ckc * 8) * 2) = rb[i]; }
    }
    __syncthreads();
    const int nk = K >> 6;
    for (int kt = 0; kt < nk; ++kt) {
        const bool more = (kt + 1 < nk);
        if (more) {
            const int k0 = (kt + 1) << 6;
#pragma unroll
            for (int i = 0; i < 4; ++i) { ra[i] = *(const u32x4*)(ap + (size_t)(32 * i) * lda + k0); rb[i] = *(const u32x4*)(bp + (size_t)(32 * i) * ldb + k0); }
        }
        const char* sa = smem + (kt & 1) * 2 * TILE_BYTES; const char* sb = sa + TILE_BYTES;
#pragma unroll
        for (int ks = 0; ks < 2; ++ks) {
            bf16x8 af[4], bfr[4];
#pragma unroll
            for (int m = 0; m < 4; ++m) af[m] = *(const bf16x8*)(sa + ((wr * 64 + m * 16 + fr) * LDS_STRIDE + ks * 32 + fq * 8) * 2);
#pragma unroll
            for (int n = 0; n < 4; ++n) bfr[n] = *(const bf16x8*)(sb + ((wc * 64 + n * 16 + fr) * LDS_STRIDE + ks * 32 + fq * 8) * 2);
#pragma unroll
            for (int m = 0; m < 4; ++m)
#pragma unroll
                for (int n = 0; n < 4; ++n) acc[m][n] = __builtin_amdgcn_mfma_f32_16x16x32_bf16(af[m], bfr[n], acc[m][n], 0, 0, 0);
        }
        if (more) {
            char* da = smem + ((kt + 1) & 1) * 2 * TILE_BYTES; char* db = da + TILE_BYTES;
#pragma unroll
            for (int i = 0; i < 4; ++i) { *(u32x4*)(da + ((crow + 32 * i) * LDS_STRIDE + ckc * 8) * 2) = ra[i]; *(u32x4*)(db + ((crow + 32 * i) * LDS_STRIDE + ckc * 8) * 2) = rb[i]; }
        }
        __syncthreads();
    }
    epi(acc, wr * 64, wc * 64, fr, fq);
}

struct EpiZ {
    bf16_t* Z; int R0, C0;
    __device__ __forceinline__ void operator()(f32x4 (&acc)[4][4], int r0, int c0, int fr, int fq) const {
#pragma unroll
        for (int n = 0; n < 4; ++n) { const int col = C0 + c0 + n * 16 + fr; if (col < NIN) {
#pragma unroll
            for (int m = 0; m < 4; ++m)
#pragma unroll
                for (int j = 0; j < 4; ++j) Z[(size_t)(R0 + r0 + m * 16 + fq * 4 + j) * NIN + col] = f2bf(acc[m][n][j]); } }
    }
};
struct EpiQ {
    bf16_t* Q; const float* rs; const float* ropeC; const float* ropeS; int R0, C0;
    __device__ __forceinline__ void operator()(f32x4 (&acc)[4][4], int r0, int c0, int fr, int fq) const {
        const bool lat = R0 >= M_CTX;
#pragma unroll
        for (int n = 0; n < 4; ++n) {
            const int cb = C0 + c0 + n * 16; const int hcs = cb % 96;
            if (lat && hcs == 80) continue;
            const bool rot = lat && hcs == 64;
#pragma unroll
            for (int m = 0; m < 4; ++m)
#pragma unroll
                for (int j = 0; j < 4; ++j) {
                    const int rl = r0 + m * 16 + fq * 4 + j; const int row = R0 + rl; const float s = rs[rl] * QSCALE;
                    const float x1 = acc[m][n][j] * s;
                    if (rot) {
                        const float x2 = acc[m][(n + 1) & 3][j] * s; const int t = (row - M_CTX) & 4095;
                        const float cv = ropeC[t * 16 + fr], sv = ropeS[t * 16 + fr];
                        Q[(size_t)row * 768 + cb + fr] = f2bf(x1 * cv - x2 * sv);
                        Q[(size_t)row * 768 + cb + 16 + fr] = f2bf(x1 * sv + x2 * cv);
                    } else Q[(size_t)row * 768 + cb + fr] = f2bf(x1);
                }
        }
    }
};
struct EpiKV {
    bf16_t* Kd; bf16_t* Vd; const float* rs; int R0, C0; int seqshift; size_t vbase0;
    __device__ __forceinline__ void operator()(f32x4 (&acc)[4][4], int r0, int c0, int fr, int fq) const {
#pragma unroll
        for (int n = 0; n < 4; ++n) {
            const int col = C0 + c0 + n * 16 + fr;
#pragma unroll
            for (int m = 0; m < 4; ++m) {
                const int rl = r0 + m * 16 + fq * 4; const int row = R0 + rl;
                float v[4];
#pragma unroll
                for (int j = 0; j < 4; ++j) v[j] = acc[m][n][j] * (rs ? rs[rl + j] : 1.0f);
                if (col < 512) {
                    const int h = col >> 6, d = col & 63;
#pragma unroll
                    for (int j = 0; j < 4; ++j) Kd[(size_t)(row + j) * 768 + h * 96 + d] = f2bf(v[j]);
                } else {
                    const int vc = col - 512, h = vc >> 6, dv = vc & 63; const int b = row >> seqshift, t = row & ((1 << seqshift) - 1);
                    u32x2 w; w.x = pack2(v[0], v[1]); w.y = pack2(v[2], v[3]);
                    *(u32x2*)(Vd + vbase0 + ((size_t)((b * 8 + h) * 64 + dv) << seqshift) + t) = w;
                }
            }
        }
    }
};
struct EpiRes {
    float* X; const float* gate; int R0, C0;
    __device__ __forceinline__ void operator()(f32x4 (&acc)[4][4], int r0, int c0, int fr, int fq) const {
#pragma unroll
        for (int n = 0; n < 4; ++n) { const int col = C0 + c0 + n * 16 + fr; const float g = gate[col];
#pragma unroll
            for (int m = 0; m < 4; ++m)
#pragma unroll
                for (int j = 0; j < 4; ++j) { float* px = X + (size_t)(R0 + r0 + m * 16 + fq * 4 + j) * DM + col; *px = ALPHA_F * (*px) + g * acc[m][n][j]; } }
    }
};
struct EpiSwi {
    bf16_t* H; int R0, C0;
    __device__ __forceinline__ void operator()(f32x4 (&acc)[4][4], int r0, int c0, int fr, int fq) const {
        const int hb = (C0 + c0) >> 1;
#pragma unroll
        for (int n = 0; n < 2; ++n)
#pragma unroll
            for (int m = 0; m < 4; ++m)
#pragma unroll
                for (int j = 0; j < 4; ++j) { const float g = acc[m][n][j], u = acc[m][n + 2][j];
                    H[(size_t)(R0 + r0 + m * 16 + fq * 4 + j) * DFF + hb + n * 16 + fr] = f2bf(g * sigmoidf_(g) * u); }
    }
};

__device__ __forceinline__ void ada_unit(const P& p, int u, char* smem) {
    const int tid = opaque_tid(); const int l = u / 96, c0 = (u % 96) * 64;
    float* cs = (float*)smem;
    for (int i = tid; i < 5 * 1024; i += 256) { const int r = i >> 10, k = i & 1023; const float v = (r == 0) ? p.c_ctx[k] : p.c[(r - 1) * 1024 + k]; cs[i] = v * sigmoidf_(v); }
    __syncthreads();
    const int col = tid & 63, kq = tid >> 6;
    float s0 = 0.f, s1 = 0.f, s2 = 0.f, s3 = 0.f, s4 = 0.f;
    const float* w = p.ada_w + ((size_t)l * 1024 + kq * 256) * 6144 + c0 + col;
    const float* cq = cs + kq * 256;
    for (int k = 0; k < 256; ++k) { const float wv = w[(size_t)k * 6144]; s0 += cq[k] * wv; s1 += cq[1024 + k] * wv; s2 += cq[2048 + k] * wv; s3 += cq[3072 + k] * wv; s4 += cq[4096 + k] * wv; }
    float* red = cs + 5 * 1024;
    red[(kq * 5 + 0) * 64 + col] = s0; red[(kq * 5 + 1) * 64 + col] = s1; red[(kq * 5 + 2) * 64 + col] = s2; red[(kq * 5 + 3) * 64 + col] = s3; red[(kq * 5 + 4) * 64 + col] = s4;
    __syncthreads();
    for (int o = tid; o < 320; o += 256) { const int i = o >> 6, cc = o & 63;
        const float v = red[(0 * 5 + i) * 64 + cc] + red[(1 * 5 + i) * 64 + cc] + red[(2 * 5 + i) * 64 + cc] + red[(3 * 5 + i) * 64 + cc] + p.ada_b[l * 6144 + c0 + cc];
        p.mod[((size_t)l * 5 + i) * 6144 + c0 + cc] = v; }
    __syncthreads();
}
__device__ __forceinline__ int map_col(int kind, int n) {
    if (kind == 1) { const int blk = n >> 6, r = n & 63; return r < 32 ? blk * 32 + r : DFF + blk * 32 + (r - 32); }
    if (kind == 2) { if (n < 512) return (n >> 6) * 128 + (n & 63); const int vc = n - 512; return (vc >> 6) * 128 + 64 + (vc & 63); }
    return n;
}
__device__ __forceinline__ void conv_tile(const float* src, int ldsrc, bf16_t* dst, bf16_t* dst2, int Kdst, int n0, int k0, int kind, int Nvalid, const float* kscale, char* smem) {
    const int tid = opaque_tid(); float* tile = (float*)smem;
    { const int j = tid & 63, i0 = tid >> 6; const int n = n0 + j; const int sc = (n < Nvalid) ? map_col(kind, n) : -1;
#pragma unroll 4
      for (int ii = 0; ii < 16; ++ii) { const int i = i0 + 4 * ii; tile[i * 65 + j] = (sc >= 0) ? src[(size_t)(k0 + i) * ldsrc + sc] : 0.f; } }
    __syncthreads();
    { const int i = tid & 63, j0 = tid >> 6; const float ks = kscale ? kscale[k0 + i] : 1.f;
#pragma unroll 4
      for (int jj = 0; jj < 16; ++jj) { const int jx = j0 + 4 * jj; const float v = tile[i * 65 + jx];
          dst[(size_t)(n0 + jx) * Kdst + k0 + i] = f2bf(v * ks); if (dst2) dst2[(size_t)(n0 + jx) * Kdst + k0 + i] = f2bf(v); } }
    __syncthreads();
}
#define NCONV 3032
__device__ __forceinline__ void conv_unit(const P& p, int l, int u, char* smem) {
    const float* src; int ldsrc; bf16_t* dst; bf16_t* dst2 = nullptr; int Kdst, n0, k0, kind = 0, Nvalid; const float* kscale = nullptr;
    if (u < 544) { src = p.w_in + (size_t)l * 1024 * NIN; ldsrc = NIN; dst = p.WtIn; Kdst = 1024; n0 = (u / 16) * 64; k0 = (u % 16) * 64; Nvalid = NIN; }
    else if (u < 592) { u -= 544; src = p.q_up + (size_t)l * 256 * 768; ldsrc = 768; dst = p.WtQ; Kdst = 256; n0 = (u / 4) * 64; k0 = (u % 4) * 64; Nvalid = 768; kscale = p.q_norm + l * 256; }
    else if (u < 624) { u -= 592; src = p.kv_up + (size_t)l * 128 * 1024; ldsrc = 1024; dst = p.WtKVn; dst2 = p.WtKV; Kdst = 128; n0 = (u / 2) * 64; k0 = (u % 2) * 64; kind = 2; Nvalid = 1024; kscale = p.kv_norm + l * 128; }
    else if (u < 880) { u -= 624; src = p.w_out + (size_t)l * 1024 * 1024; ldsrc = 1024; dst = p.WtOut; Kdst = 1024; n0 = (u / 16) * 64; k0 = (u % 16) * 64; Nvalid = 1024; }
    else if (u < 2288) { u -= 880; src = p.ffn_in + (size_t)l * 1024 * 5632; ldsrc = 5632; dst = p.WtF1; Kdst = 1024; n0 = (u / 16) * 64; k0 = (u % 16) * 64; kind = 1; Nvalid = 5632; }
    else if (u < 2992) { u -= 2288; src = p.ffn_out + (size_t)l * DFF * 1024; ldsrc = 1024; dst = p.WtF2; Kdst = DFF; n0 = (u / 44) * 64; k0 = (u % 44) * 64; Nvalid = 1024; }
    else if (u < 3008) { u -= 2992; const float* sp = p.gm_ws + (size_t)l * 65536 + u * 4096; bf16_t* d = p.WsB + u * 4096; for (int i = threadIdx.x; i < 4096; i += 256) d[i] = f2bf(sp[i]); return; }
    else if (u < 3016) { u -= 3008; const int d = u >> 2; src = p.rw_w2 + ((size_t)l * 2 + d) * 64 * 256; ldsrc = 256; dst = p.W2t + d * 256 * 64; Kdst = 64; n0 = (u & 3) * 64; k0 = 0; Nvalid = 256; }
    else if (u < 3024) { u -= 3016; const int d = u >> 2; src = p.rw_a2 + ((size_t)l * 2 + d) * 64 * 256; ldsrc = 256; dst = p.A2t + d * 256 * 64; Kdst = 64; n0 = (u & 3) * 64; k0 = 0; Nvalid = 256; }
    else { u -= 3024; src = p.rw_g2 + (size_t)l * 128 * 256; ldsrc = 256; dst = p.G2t; Kdst = 128; n0 = (u / 2) * 64; k0 = (u % 2) * 64; Nvalid = 256; }
    conv_tile(src, ldsrc, dst, dst2, Kdst, n0, k0, kind, Nvalid, kscale, smem);
}
__device__ __forceinline__ void misc0_unit(const P& p, int u) {
    const int tid = opaque_tid();
    if (u < 16) {
        for (int e = tid; e < 4096; e += 256) { const int idx = u * 4096 + e; const int t = idx >> 4, i = idx & 15;
            const float pos = (float)((i < 8) ? (t >> 6) : (t & 63)); const float inv = exp2f(-(float)(i & 7) * 1.6609640474436813f);
            const float ang = pos * inv; const float kf = rintf(ang * 0.15915494309189535f);
            float r = fmaf(-kf, 6.28318548202514648f, ang); r = fmaf(-kf, -1.74845553e-7f, r);
            p.ropeC[idx] = __cosf(r); p.ropeS[idx] = __sinf(r); }
    } else {
        const int v = u - 16;
        for (int e = tid; e < 4096; e += 256) { const int idx = v * 4096 + e;
            const int c = idx & 127, t = (idx >> 7) & 511, b = (idx >> 16) & 3, l = idx >> 18;
            p.CkvB[idx] = f2bf(p.cache_ckv[(((size_t)b * 4 + l) * 512 + t) * 128 + c]); }
    }
}

__device__ __forceinline__ void ln_phase(const P& p, int l, int which) {
    const int tid = opaque_tid(), lane = tid & 63, wid = tid >> 6;
    const float* g = which == 1 ? p.ln1_g + l * DM : p.ln2_g + l * DM; const float* bb = which == 1 ? p.ln1_b + l * DM : p.ln2_b + l * DM;
    const int ml = which == 2 ? l + 1 : l; const int shoff = which == 1 ? 3072 : 0, scoff = which == 1 ? 4096 : 1024;
    const bool dohb = !(which == 2 && l == 3);
    for (int row = blockIdx.x * 4 + wid; row < M_ALL; row += gridDim.x * 4) {
        float* xr = p.out + (size_t)row * DM;
        const float* src = which == 0 ? (row < M_CTX ? p.x_prompt + (size_t)row * DM : p.x_sample + (size_t)(row - M_CTX) * DM) : xr;
        f32x4 v[4];
#pragma unroll
        for (int i = 0; i < 4; ++i) v[i] = *(const f32x4*)(src + lane * 4 + 256 * i);
        if (which != 0) {
            float s = 0.f;
#pragma unroll
            for (int i = 0; i < 4; ++i) s += (v[i][0] + v[i][1]) + (v[i][2] + v[i][3]);
            s = red16(s); s += __shfl_xor(s, 16); s += __shfl_xor(s, 32);
            const float mu = s * (1.0f / 1024.0f); float q = 0.f;
#pragma unroll
            for (int i = 0; i < 4; ++i) { const f32x4 d = v[i] - mu; q += (d[0] * d[0] + d[1] * d[1]) + (d[2] * d[2] + d[3] * d[3]); }
            q = red16(q); q += __shfl_xor(q, 16); q += __shfl_xor(q, 32);
            const float rstd = rsqrtf(q * (1.0f / 1024.0f) + 1e-5f);
#pragma unroll
            for (int i = 0; i < 4; ++i) { const f32x4 gg = *(const f32x4*)(g + lane * 4 + 256 * i), bv = *(const f32x4*)(bb + lane * 4 + 256 * i); v[i] = (v[i] - mu) * rstd * gg + bv; }
        }
#pragma unroll
        for (int i = 0; i < 4; ++i) *(f32x4*)(xr + lane * 4 + 256 * i) = v[i];
        if (dohb) {
            const float* md = p.mod + ((size_t)ml * 5 + modrow_of(row)) * 6144;
#pragma unroll
            for (int i = 0; i < 4; ++i) { const f32x4 sh = *(const f32x4*)(md + shoff + lane * 4 + 256 * i), sc = *(const f32x4*)(md + scoff + lane * 4 + 256 * i);
                const f32x4 h = v[i] * (1.0f + sc) + sh; u32x2 w; w.x = pack2(h[0], h[1]); w.y = pack2(h[2], h[3]);
                *(u32x2*)(p.hbmix + (size_t)row * DM + lane * 4 + 256 * i) = w; }
        }
    }
}

__device__ __forceinline__ void rwprep_unit(const P& p, int l, int u, char* smem) {
    const int tid = opaque_tid(), lane = tid & 63, wid = tid >> 6, fr = lane & 15, fq = lane >> 4;
    const int R0 = u * 64;
    const int ss = R0 < M_CTX ? (R0 & ~255) : M_CTX + ((R0 - M_CTX) & ~4095); const int se = ss + (R0 < M_CTX ? 256 : 4096);
    bf16_t* XW = (bf16_t*)smem; bf16_t* XA = XW + 64 * 136; bf16_t* XG = XA + 64 * 136;
    const float* cw = p.rw_conv + (size_t)l * 3 * 1152;
    for (int it = tid; it < 576; it += 256) {
        const int cc = it % 144, tg = it / 144; const int c = cc * 8;
        float w0[8], w1[8], w2[8];
#pragma unroll
        for (int i = 0; i < 8; ++i) { w0[i] = cw[c + i]; w1[i] = cw[1152 + c + i]; w2[i] = cw[2304 + c + i]; }
        const int rfirst = R0 + tg * 16;
        u32x4 prev = (u32x4){0u, 0u, 0u, 0u}, cur, nxt;
        if (rfirst - 1 >= ss) prev = *(const u32x4*)(p.Z + (size_t)(rfirst - 1) * NIN + c);
        cur = *(const u32x4*)(p.Z + (size_t)rfirst * NIN + c);
        for (int tt = 0; tt < 16; ++tt) {
            const int row = rfirst + tt;
            nxt = (u32x4){0u, 0u, 0u, 0u};
            if (row + 1 < se) nxt = *(const u32x4*)(p.Z + (size_t)(row + 1) * NIN + c);
            float o[8];
#pragma unroll
            for (int i = 0; i < 4; ++i) {
                o[2 * i] = w0[2 * i] * lo_bf(prev[i]) + w1[2 * i] * lo_bf(cur[i]) + w2[2 * i] * lo_bf(nxt[i]);
                o[2 * i + 1] = w0[2 * i + 1] * hi_bf(prev[i]) + w1[2 * i + 1] * hi_bf(cur[i]) + w2[2 * i + 1] * hi_bf(nxt[i]);
            }
            if (c >= 768 && c < 896) {
#pragma unroll
                for (int i = 0; i < 8; ++i) o[i] = tanhf_(o[i]);
            } else if (c >= 1024) {
#pragma unroll
                for (int i = 0; i < 8; ++i) o[i] = sigmoidf_(o[i]);
            }
            u32x4 w; w.x = pack2(o[0], o[1]); w.y = pack2(o[2], o[3]); w.z = pack2(o[4], o[5]); w.w = pack2(o[6], o[7]);
            const int tl = tg * 16 + tt;
            if (c < 768) *(u32x4*)(p.RKV + (size_t)row * 768 + c) = w;
            else if (c < 896) *(u32x4*)(XW + tl * 136 + (c - 768)) = w;
            else if (c < 1024) *(u32x4*)(XA + tl * 136 + (c - 896)) = w;
            else *(u32x4*)(XG + tl * 136 + (c - 1024)) = w;
            prev = cur; cur = nxt;
        }
    }
    __syncthreads();
#pragma unroll 1
    for (int mh = 0; mh < 10; ++mh) {
        const int mat = mh >> 1, nh = mh & 1;
        const int d = mat & 1; const bf16_t* As; const bf16_t* Bw; int kofs, nks, ldw;
        if (mat < 2) { As = XW; Bw = p.W2t + d * 256 * 64; kofs = d * 64; nks = 2; ldw = 64; }
        else if (mat < 4) { As = XA; Bw = p.A2t + d * 256 * 64; kofs = d * 64; nks = 2; ldw = 64; }
        else { As = XG; Bw = p.G2t; kofs = 0; nks = 4; ldw = 128; }
        f32x4 acc[4][2];
#pragma unroll
        for (int m = 0; m < 4; ++m)
#pragma unroll
            for (int n = 0; n < 2; ++n) acc[m][n] = (f32x4){0.f, 0.f, 0.f, 0.f};
#pragma unroll 1
        for (int ks = 0; ks < nks; ++ks) {
            bf16x8 af[4], bfr[2];
#pragma unroll
            for (int m = 0; m < 4; ++m) af[m] = *(const bf16x8*)(As + (m * 16 + fr) * 136 + kofs + ks * 32 + fq * 8);
#pragma unroll
            for (int n = 0; n < 2; ++n) bfr[n] = *(const bf16x8*)(Bw + (size_t)(wid * 64 + nh * 32 + n * 16 + fr) * ldw + ks * 32 + fq * 8);
#pragma unroll
            for (int m = 0; m < 4; ++m)
#pragma unroll
                for (int n = 0; n < 2; ++n) acc[m][n] = __builtin_amdgcn_mfma_f32_16x16x32_bf16(af[m], bfr[n], acc[m][n], 0, 0, 0);
        }
#pragma unroll
        for (int n = 0; n < 2; ++n) {
            const int c = wid * 64 + nh * 32 + n * 16 + fr;
            float bias = 0.f; if (mat < 2) bias = p.rw_w0[(l * 2 + d) * 256 + c]; else if (mat < 4) bias = p.rw_a0[(l * 2 + d) * 256 + c];
            bf16_t* dst; float mul;
            if (mat < 2) { dst = p.Ee + ((size_t)d * M_ALL + R0) * 256 + c; mul = 0.6065306597126334f; }
            else if (mat < 4) { dst = p.Aa + ((size_t)d * M_ALL + R0) * 256 + c; mul = 1.0f; }
            else { dst = p.Gg + (size_t)R0 * 256 + c; mul = 1.0f; }
#pragma unroll
            for (int m = 0; m < 4; ++m)
#pragma unroll
                for (int j = 0; j < 4; ++j) {
                    const float x = acc[m][n][j] + bias;
                    dst[(size_t)(m * 16 + fq * 4 + j) * 256] = f2bf(mat < 4 ? mul * sigmoidf_(x) : x);
                }
        }
    }
    __syncthreads();
}
__device__ __forceinline__ void rowscale128(const bf16_t* Z, int R0, int zoff, int ncols, float eps, float* rs) {
    const int tid = opaque_tid(); const int r = tid >> 1, half = tid & 1; const int per = ncols >> 1;
    const bf16_t* zp = Z + (size_t)(R0 + r) * NIN + zoff + half * per;
    float ss = 0.f;
    for (int i = 0; i < per; i += 8) { const u32x4 w = *(const u32x4*)(zp + i);
#pragma unroll
        for (int q = 0; q < 4; ++q) { const float a = lo_bf(w[q]), b = hi_bf(w[q]); ss += a * a + b * b; } }
    ss = dpp_add<0xB1>(ss);
    if (half == 0) rs[r] = rsqrtf(ss / (float)ncols + eps);
}
__device__ __forceinline__ void small_unit(const P& p, int l, int u) {
    const int tid = opaque_tid(), sub = tid >> 5, li = tid & 31;
    if (u < 2560) {
        const int row = u * 8 + sub; const bf16_t* zr = p.Z + (size_t)row * NIN;
        const u32x2 w = *(const u32x2*)(zr + ZKV + li * 4);
        const float z0 = lo_bf(w.x), z1 = hi_bf(w.x), z2 = lo_bf(w.y), z3 = hi_bf(w.y);
        float ss = z0 * z0 + z1 * z1 + z2 * z2 + z3 * z3; ss = red16(ss); ss += __shfl_xor(ss, 16);
        const float rsv = rsqrtf(ss * (1.0f / 128.0f) + 1e-6f);
        const float x1 = bf2f(zr[ZKR + (li & 15)]), x2 = bf2f(zr[ZKR + 16 + (li & 15)]);
        float val;
        if (row < M_CTX) {
            const int b = row >> 8, t = row & 255; const size_t o = ((size_t)(b * 4 + l) * 256 + t);
            const f32x4 g = *(const f32x4*)(p.kv_norm + l * 128 + li * 4);
            *(f32x4*)(p.out + 20971520 + o * 128 + li * 4) = (f32x4){z0 * rsv * g[0], z1 * rsv * g[1], z2 * rsv * g[2], z3 * rsv * g[3]};
            val = li < 16 ? x1 : x2;
            p.out[20971520 + 2097152 + o * 32 + li] = val;
        } else {
            const int t = (row - M_CTX) & 4095; const float cv = p.ropeC[t * 16 + (li & 15)], sv = p.ropeS[t * 16 + (li & 15)];
            val = li < 16 ? x1 * cv - x2 * sv : x1 * sv + x2 * cv;
        }
        const bf16_t bv = f2bf(val);
#pragma unroll
        for (int h = 0; h < 8; ++h) p.Kb[(size_t)row * 768 + h * 96 + 64 + li] = bv;
    } else {
        const int r = (u - 2560) * 8 + sub; const int b = r >> 9, t = r & 511;
        const bf16_t bv = f2bf(p.cache_krope[((size_t)(b * 4 + l) * 512 + t) * 32 + li]);
#pragma unroll
        for (int h = 0; h < 8; ++h) p.Kc[(size_t)r * 768 + h * 96 + 64 + li] = bv;
    }
}
__device__ __forceinline__ void gmlp_unit(const P& p, int l, int u, char* smem) {
    const int tid = opaque_tid(), lane = tid & 63, wid = tid >> 6, fr = lane & 15, fq = lane >> 4;
    const int R0 = (u >> 2) * 128, g = u & 3;
    bf16_t* VnT = (bf16_t*)smem;
    {
        const int tok = tid >> 1, half = tid & 1; const bf16_t* zp = p.Z + (size_t)(R0 + tok) * NIN + ZV + g * 64 + half * 32;
        float x[32];
#pragma unroll
        for (int i = 0; i < 4; ++i) { const u32x4 w = *(const u32x4*)(zp + i * 8);
#pragma unroll
            for (int q = 0; q < 4; ++q) { x[i * 8 + 2 * q] = geluf_(lo_bf(w[q])); x[i * 8 + 2 * q + 1] = geluf_(hi_bf(w[q])); } }
        float s = 0.f;
#pragma unroll
        for (int i = 0; i < 32; ++i) s += x[i];
        s = dpp_add<0xB1>(s); const float mu = s * (1.0f / 64.0f);
        float q2 = 0.f;
#pragma unroll
        for (int i = 0; i < 32; ++i) { const float d = x[i] - mu; q2 += d * d; }
        q2 = dpp_add<0xB1>(q2); const float rstd = rsqrtf(q2 * (1.0f / 64.0f) + 1e-5f);
        const float* gg = p.gm_g + l * 256 + g * 64 + half * 32; const float* gb = p.gm_b + l * 256 + g * 64 + half * 32;
#pragma unroll
        for (int i = 0; i < 32; ++i) VnT[(half * 32 + i) * 136 + tok] = f2bf((x[i] - mu) * rstd * gg[i] + gb[i]);
    }
    __syncthreads();
    f32x4 acc[2][4];
#pragma unroll
    for (int m = 0; m < 2; ++m)
#pragma unroll
        for (int n = 0; n < 4; ++n) acc[m][n] = (f32x4){0.f, 0.f, 0.f, 0.f};
    const bf16_t* Wg = p.WsB + g * 128 * 128;
#pragma unroll
    for (int ks = 0; ks < 4; ++ks) {
        bf16x8 af[2], bfr[4];
#pragma unroll
        for (int m = 0; m < 2; ++m) af[m] = *(const bf16x8*)(Wg + (wid * 32 + m * 16 + fr) * 128 + ks * 32 + fq * 8);
#pragma unroll
        for (int n = 0; n < 4; ++n) bfr[n] = *(const bf16x8*)(VnT + (n * 16 + fr) * 136 + ks * 32 + fq * 8);
#pragma unroll
        for (int m = 0; m < 2; ++m)
#pragma unroll
            for (int n = 0; n < 4; ++n) acc[m][n] = __builtin_amdgcn_mfma_f32_16x16x32_bf16(af[m], bfr[n], acc[m][n], 0, 0, 0);
    }
#pragma unroll
    for (int m = 0; m < 2; ++m)
#pragma unroll
        for (int j = 0; j < 4; ++j) {
            const int pp = wid * 32 + m * 16 + fq * 4 + j; const float bs = p.gm_bs[l * 512 + g * 128 + pp];
#pragma unroll
            for (int n = 0; n < 4; ++n) { const int c = n * 16 + fr;
                const float uu = geluf_(bf2f(p.Z[(size_t)(R0 + pp) * NIN + ZU + g * 64 + c]));
                p.hbmix[(size_t)(R0 + pp) * DM + 768 + g * 64 + c] = f2bf(uu * (acc[m][n][j] + bs)); }
        }
    __syncthreads();
}

__device__ __forceinline__ void scan_unit(const P& p, int l, int u, char* smem) {
    const int tid = opaque_tid(), lane = tid & 63, wid = tid >> 6;
    int b, T, row0; const bool lat = u < 128;
    if (lat) { b = u >> 5; T = 4096; row0 = M_CTX + b * 4096; } else { b = (u - 128) >> 5; T = 256; row0 = b * 256; }
    const int h = (u >> 3) & 3, d = (u >> 2) & 1, rsl = u & 3;
    float* W = (float*)smem; float* NKK = W + 2048; float* KKA = NKK + 2048; float* KD = KKA + 2048; float* RR = KD + 2048; float* VS = RR + 2048; float* OUTP = VS + 512;
    const int rl = lane >> 4, kq = lane & 15; const int r16 = wid * 4 + rl; const int row = rsl * 16 + r16;
    f32x4 S = (f32x4){0.f, 0.f, 0.f, 0.f};
    const size_t stoff = ((((size_t)b * 4 + l) * 2 + d) * 4 + h) * 4096 + row * 64 + kq * 4;
    if (lat) S = *(const f32x4*)(p.state_rwkv + stoff);
    const int tok = tid >> 3, cg8 = tid & 7;
    float kkp[8], kap[8];
#pragma unroll
    for (int i = 0; i < 8; ++i) { kkp[i] = p.rw_kk[l * 256 + h * 64 + cg8 * 8 + i]; kap[i] = p.rw_ka[l * 256 + h * 64 + cg8 * 8 + i]; }
    const int nch = T >> 5;
    u32x4 r8, k8, e8, a8, v8;
    int grow, grow_prev = 0; f32x2 oreg = (f32x2){0.f, 0.f};
    {
        const int sidx = tok; const int t = d ? T - 1 - sidx : sidx; grow = row0 + t;
        r8 = *(const u32x4*)(p.RKV + (size_t)grow * 768 + h * 64 + cg8 * 8);
        k8 = *(const u32x4*)(p.RKV + (size_t)grow * 768 + 256 + h * 64 + cg8 * 8);
        v8 = *(const u32x4*)(p.RKV + (size_t)grow * 768 + 512 + h * 64 + rsl * 16 + (cg8 & 1) * 8);
        e8 = *(const u32x4*)(p.Ee + ((size_t)d * M_ALL + grow) * 256 + h * 64 + cg8 * 8);
        a8 = *(const u32x4*)(p.Aa + ((size_t)d * M_ALL + grow) * 256 + h * 64 + cg8 * 8);
    }
    for (int ch = 0; ch < nch; ++ch) {
        {
            float kf[8], kkv[8], rf[8], ef[8], af[8];
#pragma unroll
            for (int q = 0; q < 4; ++q) { kf[2 * q] = lo_bf(k8[q]); kf[2 * q + 1] = hi_bf(k8[q]); rf[2 * q] = lo_bf(r8[q]); rf[2 * q + 1] = hi_bf(r8[q]);
                ef[2 * q] = lo_bf(e8[q]); ef[2 * q + 1] = hi_bf(e8[q]); af[2 * q] = lo_bf(a8[q]); af[2 * q + 1] = hi_bf(a8[q]); }
            float ss = 0.f;
#pragma unroll
            for (int i = 0; i < 8; ++i) { kkv[i] = kf[i] * kkp[i]; ss += kkv[i] * kkv[i]; }
            ss = red8(ss);
            const float inv = rsqrtf(fmaxf(ss, 1e-24f));
            f32x4 o0, o1; const int base = tok * 64 + cg8 * 8;
#pragma unroll
            for (int i = 0; i < 4; ++i) { o0[i] = __expf(-ef[i]); o1[i] = __expf(-ef[4 + i]); }
            *(f32x4*)(W + base) = o0; *(f32x4*)(W + base + 4) = o1;
#pragma unroll
            for (int i = 0; i < 4; ++i) { o0[i] = -kkv[i] * inv; o1[i] = -kkv[4 + i] * inv; }
            *(f32x4*)(NKK + base) = o0; *(f32x4*)(NKK + base + 4) = o1;
#pragma unroll
            for (int i = 0; i < 4; ++i) { o0[i] = kkv[i] * inv * af[i]; o1[i] = kkv[4 + i] * inv * af[4 + i]; }
            *(f32x4*)(KKA + base) = o0; *(f32x4*)(KKA + base + 4) = o1;
#pragma unroll
            for (int i = 0; i < 4; ++i) { o0[i] = kf[i] * (1.0f + (af[i] - 1.0f) * kap[i]); o1[i] = kf[4 + i] * (1.0f + (af[4 + i] - 1.0f) * kap[4 + i]); }
            *(f32x4*)(KD + base) = o0; *(f32x4*)(KD + base + 4) = o1;
#pragma unroll
            for (int i = 0; i < 4; ++i) { o0[i] = rf[i]; o1[i] = rf[4 + i]; }
            *(f32x4*)(RR + base) = o0; *(f32x4*)(RR + base + 4) = o1;
            if (cg8 < 2) {
#pragma unroll
                for (int q = 0; q < 4; ++q) { VS[tok * 16 + cg8 * 8 + 2 * q] = lo_bf(v8[q]); VS[tok * 16 + cg8 * 8 + 2 * q + 1] = hi_bf(v8[q]); }
            }
        }
        __syncthreads();
        if (ch > 0) *(f32x2*)(p.ydir + ((size_t)d * M_ALL + grow_prev) * 256 + h * 64 + rsl * 16 + cg8 * 2) = oreg;
        grow_prev = grow;
        if (ch + 1 < nch) {
            const int sidx = (ch + 1) * 32 + tok; const int t = d ? T - 1 - sidx : sidx; grow = row0 + t;
            r8 = *(const u32x4*)(p.RKV + (size_t)grow * 768 + h * 64 + cg8 * 8);
            k8 = *(const u32x4*)(p.RKV + (size_t)grow * 768 + 256 + h * 64 + cg8 * 8);
            v8 = *(const u32x4*)(p.RKV + (size_t)grow * 768 + 512 + h * 64 + rsl * 16 + (cg8 & 1) * 8);
            e8 = *(const u32x4*)(p.Ee + ((size_t)d * M_ALL + grow) * 256 + h * 64 + cg8 * 8);
            a8 = *(const u32x4*)(p.Aa + ((size_t)d * M_ALL + grow) * 256 + h * 64 + cg8 * 8);
        }
        {
            const float* Wq = W + kq * 4; const float* NKq = NKK + kq * 4; const float* KAq = KKA + kq * 4; const float* KDq = KD + kq * 4; const float* RRq = RR + kq * 4; const float* VSq = VS + r16;
            float* OPq = OUTP + r16 * 16 + kq;
            f32x4 wv[4], nkv[4], kav[4], kdv[4], rrv[4]; float vv[4];
#define SCAN_LD(slot, st) do { wv[slot] = *(const f32x4*)(Wq + (st) * 64); nkv[slot] = *(const f32x4*)(NKq + (st) * 64); kav[slot] = *(const f32x4*)(KAq + (st) * 64); \
        kdv[slot] = *(const f32x4*)(KDq + (st) * 64); rrv[slot] = *(const f32x4*)(RRq + (st) * 64); vv[slot] = VSq[(st) * 16]; } while (0)
            __builtin_amdgcn_s_setprio(3);
            SCAN_LD(0, 0); SCAN_LD(1, 1); SCAN_LD(2, 2);
#pragma unroll
            for (int s = 0; s < 32; ++s) {
                if (s + 3 < 32) SCAN_LD((s + 3) & 3, s + 3);
                const f32x4 w = wv[s & 3], nk = nkv[s & 3], ka = kav[s & 3], kd = kdv[s & 3], rr = rrv[s & 3]; const float v = vv[s & 3];
                float pd = fmaf(S[1], nk[1], S[0] * nk[0]) + fmaf(S[3], nk[3], S[2] * nk[2]);
                pd = red16(pd);
#pragma unroll
                for (int i = 0; i < 4; ++i) S[i] = fmaf(S[i], w[i], fmaf(pd, ka[i], v * kd[i]));
                OPq[s * 256] = fmaf(S[1], rr[1], S[0] * rr[0]) + fmaf(S[3], rr[3], S[2] * rr[2]);
            }
        }
        __builtin_amdgcn_s_setprio(0);
        __syncthreads();
        {
            const float* op = OUTP + (tok * 16 + cg8 * 2) * 16;
            f32x4 a0 = *(const f32x4*)(op), a1 = *(const f32x4*)(op + 4), a2 = *(const f32x4*)(op + 8), a3 = *(const f32x4*)(op + 12);
            f32x4 b0 = *(const f32x4*)(op + 16), b1 = *(const f32x4*)(op + 20), b2 = *(const f32x4*)(op + 24), b3 = *(const f32x4*)(op + 28);
            a0 = (a0 + a1) + (a2 + a3); b0 = (b0 + b1) + (b2 + b3);
            oreg = (f32x2){(a0[0] + a0[1]) + (a0[2] + a0[3]), (b0[0] + b0[1]) + (b0[2] + b0[3])};
        }
    }
    *(f32x2*)(p.ydir + ((size_t)d * M_ALL + grow_prev) * 256 + h * 64 + rsl * 16 + cg8 * 2) = oreg;
    if (!lat) *(f32x4*)(p.out + 20971520 + 2097152 + 524288 + stoff) = S;
    __syncthreads();
}

#define KS_STRIDE 104
#define VS_STRIDE 72
#define KS_BYTES (64 * KS_STRIDE * 2)
#define ATT_STAGE (KS_BYTES + 64 * VS_STRIDE * 2)
__device__ __forceinline__ void attn_unit(const P& p, int u, char* smem) {
    const int tid = opaque_tid(), lane = tid & 63, wid = tid >> 6, q = lane & 31, hf = lane >> 5;
    int b, h, qt, qrow0, krow0, nown, ntot, Tv; size_t vbase, vcbase = 0; int kcrow0 = 0;
    if (u < 1024) { b = u >> 8; h = (u >> 5) & 7; qt = u & 31; krow0 = M_CTX + b * 4096; qrow0 = krow0 + qt * 128; nown = 64; ntot = 72; Tv = 4096;
        vbase = 2097152 + (size_t)(b * 8 + h) * 64 * 4096; kcrow0 = b * 512; vcbase = (size_t)(b * 8 + h) * 64 * 512; }
    else { const int v = u - 1024; b = v >> 4; h = (v >> 1) & 7; qt = v & 1; krow0 = b * 256; qrow0 = krow0 + qt * 128; nown = 4; ntot = 4; Tv = 256; vbase = (size_t)(b * 8 + h) * 64 * 256; }
    bf16x8 qf[6];
    { const bf16_t* qp = p.Qb + (size_t)(qrow0 + wid * 32 + q) * 768 + h * 96 + hf * 8;
#pragma unroll
      for (int ks = 0; ks < 6; ++ks) qf[ks] = *(const bf16x8*)(qp + ks * 16); }
    f32x16 oT[2];
#pragma unroll
    for (int i = 0; i < 16; ++i) { oT[0][i] = 0.f; oT[1][i] = 0.f; }
    float mrun = -1e30f, lrun = 0.f;
    u32x4 rk[3], rv[2];
    int krow[3], kc[3];
#pragma unroll
    for (int i = 0; i < 3; ++i) { const int c = tid + 256 * i; krow[i] = c / 12; kc[i] = c % 12; }
    const int vdv0 = tid >> 3, vkc = tid & 7;
#define ATT_LOAD(kt) do { const bf16_t* kptr; const bf16_t* vptr; int vstr; \
        if ((kt) < nown) { kptr = p.Kb + (size_t)(krow0 + (kt) * 64) * 768 + h * 96; vptr = p.Vt + vbase + (kt) * 64; vstr = Tv; } \
        else { kptr = p.Kc + (size_t)(kcrow0 + ((kt) - nown) * 64) * 768 + h * 96; vptr = p.Vtc + vcbase + ((kt) - nown) * 64; vstr = 512; } \
        _Pragma("unroll") for (int i = 0; i < 3; ++i) rk[i] = *(const u32x4*)(kptr + (size_t)krow[i] * 768 + kc[i] * 8); \
        _Pragma("unroll") for (int i = 0; i < 2; ++i) rv[i] = *(const u32x4*)(vptr + (size_t)(vdv0 + 32 * i) * vstr + vkc * 8); } while (0)
#define ATT_STORE(buf) do { char* Ks_ = smem + (buf) * ATT_STAGE; char* Vs_ = Ks_ + KS_BYTES; \
        _Pragma("unroll") for (int i = 0; i < 3; ++i) *(u32x4*)(Ks_ + (krow[i] * KS_STRIDE + kc[i] * 8) * 2) = rk[i]; \
        _Pragma("unroll") for (int i = 0; i < 2; ++i) *(u32x4*)(Vs_ + ((vdv0 + 32 * i) * VS_STRIDE + vkc * 8) * 2) = rv[i]; } while (0)
    ATT_LOAD(0); ATT_STORE(0);
    __syncthreads();
    for (int kt = 0; kt < ntot; ++kt) {
        const bool more = kt + 1 < ntot;
        if (more) ATT_LOAD(kt + 1);
        const char* Ks = smem + (kt & 1) * ATT_STAGE; const char* Vs = Ks + KS_BYTES;
        f32x16 sT[2];
#pragma unroll
        for (int i = 0; i < 16; ++i) { sT[0][i] = 0.f; sT[1][i] = 0.f; }
#pragma unroll
        for (int kb = 0; kb < 2; ++kb)
#pragma unroll
            for (int ks = 0; ks < 6; ++ks) { const bf16x8 kf = *(const bf16x8*)(Ks + ((kb * 32 + q) * KS_STRIDE + ks * 16 + hf * 8) * 2);
                sT[kb] = __builtin_amdgcn_mfma_f32_32x32x16_bf16(kf, qf[ks], sT[kb], 0, 0, 0); }
        float mx = sT[0][0];
#pragma unroll
        for (int i = 1; i < 16; ++i) mx = fmaxf(mx, sT[0][i]);
#pragma unroll
        for (int i = 0; i < 16; ++i) mx = fmaxf(mx, sT[1][i]);
        mx = fmaxf(mx, __shfl_xor(mx, 32));
        const float mnew = fmaxf(mrun, mx); const float alpha = __builtin_amdgcn_exp2f(mrun - mnew); const bool resc = __any(mnew > mrun); mrun = mnew;
        float psum = 0.f; bf16x8 pf[2][2];
#pragma unroll
        for (int kb = 0; kb < 2; ++kb)
#pragma unroll
            for (int s = 0; s < 2; ++s) { float e[8];
#pragma unroll
                for (int j = 0; j < 8; ++j) { e[j] = __builtin_amdgcn_exp2f(sT[kb][8 * s + j] - mnew); psum += e[j]; }
                u32x4 w; w.x = pack2(e[0], e[1]); w.y = pack2(e[2], e[3]); w.z = pack2(e[4], e[5]); w.w = pack2(e[6], e[7]);
                pf[kb][s] = __builtin_bit_cast(bf16x8, w); }
        lrun = lrun * alpha + psum;
        if (resc) {
#pragma unroll
            for (int i = 0; i < 16; ++i) { oT[0][i] *= alpha; oT[1][i] *= alpha; }
        }
#pragma unroll
        for (int kb = 0; kb < 2; ++kb)
#pragma unroll
            for (int s = 0; s < 2; ++s)
#pragma unroll
                for (int db = 0; db < 2; ++db) {
                    const char* vp = Vs + ((db * 32 + q) * VS_STRIDE + kb * 32 + 16 * s + 4 * hf) * 2;
                    const u32x2 lo = *(const u32x2*)vp, hi = *(const u32x2*)(vp + 16);
                    const u32x4 w = (u32x4){lo.x, lo.y, hi.x, hi.y};
                    oT[db] = __builtin_amdgcn_mfma_f32_32x32x16_bf16(__builtin_bit_cast(bf16x8, w), pf[kb][s], oT[db], 0, 0, 0);
                }
        if (more) ATT_STORE((kt + 1) & 1);
        __syncthreads();
    }
    const float lt = lrun + __shfl_xor(lrun, 32); const float inv = 1.0f / lt;
    bf16_t* op = p.hbmix + (size_t)(qrow0 + wid * 32 + q) * DM + 256 + h * 64;
#pragma unroll
    for (int db = 0; db < 2; ++db)
#pragma unroll
        for (int g = 0; g < 4; ++g) { u32x2 w; w.x = pack2(oT[db][4 * g] * inv, oT[db][4 * g + 1] * inv); w.y = pack2(oT[db][4 * g + 2] * inv, oT[db][4 * g + 3] * inv);
            *(u32x2*)(op + db * 32 + 8 * g + 4 * hf) = w; }
}

__device__ __forceinline__ void rwcomb_phase(const P& p, int l) {
    const int tid = opaque_tid(), lane = tid & 63, wid = tid >> 6; const int c = lane * 4;
    const f32x4 gng = *(const f32x4*)(p.rw_gn_g + l * 256 + c), gnb = *(const f32x4*)(p.rw_gn_b + l * 256 + c), kap = *(const f32x4*)(p.rw_ka + l * 256 + c), rkp = *(const f32x4*)(p.rw_rk + l * 256 + c);
    for (int row = blockIdx.x * 4 + wid; row < M_ALL; row += gridDim.x * 4) {
        const f32x4 y0 = *(const f32x4*)(p.ydir + (size_t)row * 256 + c), y1 = *(const f32x4*)(p.ydir + ((size_t)M_ALL + row) * 256 + c);
        f32x4 y = y0 + y1;
        float s = (y[0] + y[1]) + (y[2] + y[3]); s = red16(s); const float mu = s * (1.0f / 64.0f);
        const f32x4 dd = y - mu; float q2 = (dd[0] * dd[0] + dd[1] * dd[1]) + (dd[2] * dd[2] + dd[3] * dd[3]); q2 = red16(q2);
        const float rstd = rsqrtf(q2 * (1.0f / 64.0f) + 64e-5f);
        const f32x4 yn = dd * rstd * gng + gnb;
        const u32x2 rw = *(const u32x2*)(p.RKV + (size_t)row * 768 + c), kw = *(const u32x2*)(p.RKV + (size_t)row * 768 + 256 + c), vw = *(const u32x2*)(p.RKV + (size_t)row * 768 + 512 + c);
        const u32x2 a0w = *(const u32x2*)(p.Aa + (size_t)row * 256 + c), a1w = *(const u32x2*)(p.Aa + ((size_t)M_ALL + row) * 256 + c), gw = *(const u32x2*)(p.Gg + (size_t)row * 256 + c);
        const f32x4 r = (f32x4){lo_bf(rw.x), hi_bf(rw.x), lo_bf(rw.y), hi_bf(rw.y)}, k = (f32x4){lo_bf(kw.x), hi_bf(kw.x), lo_bf(kw.y), hi_bf(kw.y)}, v = (f32x4){lo_bf(vw.x), hi_bf(vw.x), lo_bf(vw.y), hi_bf(vw.y)};
        const f32x4 a0 = (f32x4){lo_bf(a0w.x), hi_bf(a0w.x), lo_bf(a0w.y), hi_bf(a0w.y)}, a1 = (f32x4){lo_bf(a1w.x), hi_bf(a1w.x), lo_bf(a1w.y), hi_bf(a1w.y)}, gt = (f32x4){lo_bf(gw.x), hi_bf(gw.x), lo_bf(gw.y), hi_bf(gw.y)};
        const f32x4 kds = k * (1.0f + (a0 - 1.0f) * kap) + k * (1.0f + (a1 - 1.0f) * kap);
        const f32x4 t4 = r * kds * rkp; float rk = (t4[0] + t4[1]) + (t4[2] + t4[3]); rk = red16(rk);
        const f32x4 o = (yn + rk * v) * gt;
        u32x2 w; w.x = pack2(o[0], o[1]); w.y = pack2(o[2], o[3]);
        *(u32x2*)(p.hbmix + (size_t)row * DM + c) = w;
    }
}


__device__ __forceinline__ bool xcd_tile(int i, int TT, int NT, int& mt, int& nt) {
    const int per = TT >> 3; if (i >= per) return false;
    const int t = (blockIdx.x & 7) * per + i; const int band = t / (8 * NT), rem = t - band * 8 * NT;
    nt = rem >> 3; mt = band * 8 + (rem & 7); return true;
}
__global__ void __launch_bounds__(256, 2) mega(Args a_unused) {
    extern __shared__ __attribute__((aligned(16))) char smem[];
    __shared__ uint4 xbw; __shared__ int s_unit;
    kargp_t kp = (kargp_t)__builtin_amdgcn_kernarg_segment_ptr();
    const int tid = threadIdx.x; const int G = gridDim.x;
    if (tid == 0) xbw = make_uint4(0u, 0u, 0u, 0u);
    __syncthreads();
    XcdBarrier xb;
    { const P p = getP(kp); xb = xcd_barrier_post(p.bar, (volatile LAS unsigned*)&xbw); }
    for (int u = blockIdx.x; u < 384 + NCONV + 272; u += G) {
        if (u < 384) { const P p = getP(kp); ada_unit(p, u, smem); } else if (u < 384 + NCONV) { const P p = getP(kp); conv_unit(p, 0, u - 384, smem); } else { const P p = getP(kp); misc0_unit(p, u - 384 - NCONV); }
    }
    cg::this_grid().sync();
    { const P p = getP(kp); ln_phase(p, 0, 0); }
    xcd_barrier(xb);
    float* rs = (float*)(smem + RS_OFF);
#pragma unroll 1
    for (int l = 0; l < 4; ++l) {
        for (int i = blockIdx.x >> 3; ; i += G >> 3) { int mt, nt; if (!xcd_tile(i, 160 * 17, 17, mt, nt)) break; const P p = getP(kp);
            EpiZ e{p.Z, mt * 128, nt * 128};
            gemm128(p.hbmix + (size_t)mt * 128 * DM, DM, p.WtIn + (size_t)nt * 128 * DM, DM, DM, smem, e); }
        xcd_barrier(xb);
        for (int rep2 = 0; rep2 < DUP_P2; ++rep2) {
        for (;;) {
            { const P pc = getP(kp); if (tid == 0) s_unit = atomicAdd(&pc.ctr[l * 4 + 0 + 2 * rep2], 1); }
            __syncthreads(); int u = s_unit; __syncthreads();
            if (u >= 320 + 960 + 1408 + 2816 + 640) break;
            if (u < 320) { const P p = getP(kp); rwprep_unit(p, l, u, smem); continue; }
            u -= 320;
            if (u < 960) { const P p = getP(kp); const int mt = u / 6, nt = u % 6;
                rowscale128(p.Z, mt * 128, ZQ, 256, 1e-6f, rs);
                EpiQ e{p.Qb, rs, p.ropeC, p.ropeS, mt * 128, nt * 128};
                gemm128(p.Z + (size_t)mt * 128 * NIN + ZQ, NIN, p.WtQ + (size_t)nt * 128 * 256, 256, 256, smem, e); __syncthreads(); continue; }
            u -= 960;
            if (u < 1280) { const P p = getP(kp); const int mt = u >> 3, nt = u & 7; const int R0 = mt * 128; const bool latr = R0 >= M_CTX;
                rowscale128(p.Z, R0, ZKV, 128, 1e-6f, rs);
                EpiKV e{latr ? p.Kb + (size_t)M_CTX * 768 : p.Kb, p.Vt, rs, latr ? R0 - M_CTX : R0, nt * 128, latr ? 12 : 8, latr ? (size_t)2097152 : (size_t)0};
                gemm128(p.Z + (size_t)R0 * NIN + ZKV, NIN, p.WtKVn + (size_t)nt * 128 * 128, 128, 128, smem, e); __syncthreads(); continue; }
            u -= 1280;
            if (u < 128) { const P p = getP(kp); const int mt = u >> 3, nt = u & 7;
                EpiKV e{p.Kc, p.Vtc, nullptr, mt * 128, nt * 128, 9, (size_t)0};
                gemm128(p.CkvB + ((size_t)l * 2048 + mt * 128) * 128, 128, p.WtKV + (size_t)nt * 128 * 128, 128, 128, smem, e); continue; }
            u -= 128;
            if (u < 2816) { const P p = getP(kp); small_unit(p, l, u); continue; }
            u -= 2816;
            { const P p = getP(kp); gmlp_unit(p, l, u, smem); }
        }
        xcd_barrier(xb);
        }
        for (int rep3 = 0; rep3 < DUP_P3; ++rep3) {
        for (;;) {
            { const P pc = getP(kp); if (tid == 0) s_unit = atomicAdd(&pc.ctr[l * 4 + 1 + 2 * rep3], 1); }
            __syncthreads(); int u = s_unit; __syncthreads();
            if (u >= 640 + 1280) break;
#ifdef PROBE_SCAN_ONLY
            if (rep3 == 1 && u >= 640) break;
#endif
#ifdef PROBE_ATTN_ONLY
            if (rep3 == 1 && u < 640) continue;
#endif
            if (u < 640) { const P p = getP(kp); scan_unit(p, l, u, smem); } else { const P p = getP(kp); attn_unit(p, u - 640, smem); }
        }
        xcd_barrier(xb);
        }
        { const P p = getP(kp); rwcomb_phase(p, l); }
        xcd_barrier(xb);
        for (int i = blockIdx.x >> 3; ; i += G >> 3) { int mt, nt; if (!xcd_tile(i, 160 * 8, 8, mt, nt)) break; const P p = getP(kp);
            EpiRes e{p.out, p.mod + ((size_t)l * 5 + modrow_of(mt * 128)) * 6144 + 2048, mt * 128, nt * 128};
            gemm128(p.hbmix + (size_t)mt * 128 * DM, DM, p.WtOut + (size_t)nt * 128 * DM, DM, DM, smem, e); }
        xcd_barrier(xb);
        { const P p = getP(kp); ln_phase(p, l, 1); }
        xcd_barrier(xb);
        for (int rep5 = 0; rep5 < DUP_P5; ++rep5)
        for (int i = blockIdx.x >> 3; ; i += G >> 3) { int mt, nt; if (!xcd_tile(i, 160 * 44, 44, mt, nt)) break; const P p = getP(kp);
            EpiSwi e{p.hidden, mt * 128, nt * 128};
            gemm128(p.hbmix + (size_t)mt * 128 * DM, DM, p.WtF1 + (size_t)nt * 128 * DM, DM, DM, smem, e); }
        xcd_barrier(xb);
        for (int i = blockIdx.x >> 3; ; i += G >> 3) { int mt, nt; if (!xcd_tile(i, 160 * 8, 8, mt, nt)) break; const P p = getP(kp);
            EpiRes e{p.out, p.mod + ((size_t)l * 5 + modrow_of(mt * 128)) * 6144 + 5120, mt * 128, nt * 128};
            gemm128(p.hidden + (size_t)mt * 128 * DFF, DFF, p.WtF2 + (size_t)nt * 128 * DFF, DFF, DFF, smem, e); }
        xcd_barrier(xb);
        { const P p = getP(kp); ln_phase(p, l, 2); }
        if (l < 3) { for (int u = blockIdx.x; u < NCONV; u += G) { const P p = getP(kp); conv_unit(p, l + 1, u, smem); } }
        xcd_barrier(xb);
    }
}

extern "C" void kernel_launch(void* const* d_in, const int* in_sizes, int n_in, void* d_out, int out_size, void* d_ws, size_t ws_size, hipStream_t stream) {
    static int grid_blocks = 0;
    if (!grid_blocks) {
        int dev = 0, cus = 0, per_cu = 0;
        (void)hipGetDevice(&dev);
        (void)hipDeviceGetAttribute(&cus, hipDeviceAttributeMultiprocessorCount, dev);
        (void)hipFuncSetAttribute((const void*)mega, hipFuncAttributeMaxDynamicSharedMemorySize, SMEM_BYTES);
        (void)hipOccupancyMaxActiveBlocksPerMultiprocessor(&per_cu, (const void*)mega, 256, SMEM_BYTES);
        if (per_cu > 2) per_cu = 2;
        if (per_cu < 1) per_cu = 1;
        grid_blocks = (cus * per_cu) & ~7;
    }
    if (WS_TOTAL > ws_size) { fprintf(stderr, "kernel_launch: workspace too small: need %zu have %zu\n", (size_t)WS_TOTAL, ws_size); return; }
    Args a{};
    for (int i = 0; i < 36; ++i) a.in[i] = (const float*)d_in[i];
    a.out = (float*)d_out; a.ws = (char*)d_ws;
    (void)hipMemsetAsync((char*)d_ws + OFF_BAR, 0, 16384 + 4096, stream);
    void* args[] = {&a};
    hipError_t e = hipLaunchCooperativeKernel((const void*)mega, dim3(grid_blocks), dim3(256), args, SMEM_BYTES, stream);
    if (e != hipSuccess) fprintf(stderr, "cooperative launch failed: %s (grid %d)\n", hipGetErrorString(e), grid_blocks);
}
```

```cpp
#include <hip/hip_runtime.h>
#include <hip/hip_cooperative_groups.h>
#include <cstdint>
#include <cstdio>
namespace cg = cooperative_groups;

typedef unsigned short bf16_t;
typedef short bf16x8 __attribute__((ext_vector_type(8)));
typedef float f32x4 __attribute__((ext_vector_type(4)));
typedef float f32x2 __attribute__((ext_vector_type(2)));
typedef float f32x16 __attribute__((ext_vector_type(16)));
typedef unsigned u32x4 __attribute__((ext_vector_type(4)));
typedef unsigned u32x2 __attribute__((ext_vector_type(2)));

#define M_ALL 20480
#define M_CTX 4096
#define DM 1024
#define NIN 2080
#define DFF 2816
#define ALPHA_F 1.6817928305074290f
#define QSCALE (0.10206207261596575f * 1.4426950408889634f)
#define LAS __attribute__((address_space(3)))
#ifndef DUP_P2
#define DUP_P2 1
#endif
#ifndef DUP_P3
#define DUP_P3 1
#endif
#ifndef DUP_P5
#define DUP_P5 1
#endif

#define ZQ 1152
#define ZKV 1408
#define ZKR 1536
#define ZU 1568
#define ZV 1824

#define LDS_STRIDE 72
#define TILE_BYTES (128 * LDS_STRIDE * 2)
#define RS_OFF (4 * TILE_BYTES)
#define SMEM_BYTES (RS_OFF + 3072)

struct P {
    const float *x_prompt, *x_sample, *cache_ckv, *cache_krope, *state_rwkv, *c, *c_ctx, *ada_w, *ada_b, *w_in, *rw_conv, *rw_w0, *rw_w2,
        *rw_a0, *rw_a2, *rw_g2, *rw_kk, *rw_ka, *rw_rk, *rw_gn_g, *rw_gn_b, *q_norm, *q_up, *kv_norm, *kv_up, *gm_g, *gm_b, *gm_ws, *gm_bs,
        *w_out, *ln1_g, *ln1_b, *ffn_in, *ffn_out, *ln2_g, *ln2_b;
    float* out;
    unsigned* bar; int* ctr; float* mod; float* ropeC; float* ropeS; bf16_t* CkvB;
    bf16_t *WtIn, *WtQ, *WtKVn, *WtKV, *WtOut, *WtF1, *WtF2, *WsB, *W2t, *A2t, *G2t;
    bf16_t *Z, *RKV, *Ee, *Aa, *Gg, *Qb, *Kb, *Kc, *Vt, *Vtc, *hbmix, *hidden;
    float* ydir;
};


struct Args { const float* in[36]; float* out; char* ws; };
typedef const __attribute__((address_space(4))) char* kargp_t;
constexpr size_t al256(size_t x) { return (x + 255) & ~(size_t)255; }
constexpr size_t OFF_BAR = 0;
constexpr size_t OFF_CTR = OFF_BAR + 16384;
constexpr size_t OFF_MOD = OFF_CTR + 4096;
constexpr size_t OFF_ROPEC = OFF_MOD + al256((size_t)4 * 5 * 6144 * 4);
constexpr size_t OFF_ROPES = OFF_ROPEC + 65536 * 4;
constexpr size_t OFF_CKVB = OFF_ROPES + 65536 * 4;
constexpr size_t OFF_WTIN = OFF_CKVB + (size_t)4 * 2048 * 128 * 2;
constexpr size_t OFF_WTQ = OFF_WTIN + (size_t)2176 * 1024 * 2;
constexpr size_t OFF_WTKVN = OFF_WTQ + (size_t)768 * 256 * 2;
constexpr size_t OFF_WTKV = OFF_WTKVN + (size_t)1024 * 128 * 2;
constexpr size_t OFF_WTOUT = OFF_WTKV + (size_t)1024 * 128 * 2;
constexpr size_t OFF_WTF1 = OFF_WTOUT + (size_t)1024 * 1024 * 2;
constexpr size_t OFF_WTF2 = OFF_WTF1 + (size_t)5632 * 1024 * 2;
constexpr size_t OFF_WSB = OFF_WTF2 + (size_t)1024 * DFF * 2;
constexpr size_t OFF_W2T = OFF_WSB + (size_t)65536 * 2;
constexpr size_t OFF_A2T = OFF_W2T + (size_t)2 * 256 * 64 * 2;
constexpr size_t OFF_G2T = OFF_A2T + (size_t)2 * 256 * 64 * 2;
constexpr size_t OFF_Z = OFF_G2T + (size_t)256 * 128 * 2;
constexpr size_t OFF_HIDDEN = OFF_Z;
constexpr size_t OFF_RKV = OFF_Z + al256((size_t)M_ALL * NIN * 2);
constexpr size_t OFF_EE = OFF_RKV + (size_t)M_ALL * 768 * 2;
constexpr size_t OFF_AA = OFF_EE + (size_t)2 * M_ALL * 256 * 2;
constexpr size_t OFF_GG = OFF_AA + (size_t)2 * M_ALL * 256 * 2;
constexpr size_t OFF_QB = OFF_GG + (size_t)M_ALL * 256 * 2;
constexpr size_t OFF_KB = OFF_QB + (size_t)M_ALL * 768 * 2;
constexpr size_t OFF_KC = OFF_KB + (size_t)M_ALL * 768 * 2;
constexpr size_t OFF_VT = OFF_KC + (size_t)2048 * 768 * 2;
constexpr size_t OFF_VTC = OFF_VT + (size_t)M_ALL * 512 * 2;
constexpr size_t OFF_YDIR = OFF_VTC + (size_t)2048 * 512 * 2;
constexpr size_t OFF_HBMIX = OFF_YDIR + (size_t)2 * M_ALL * 256 * 4;
constexpr size_t WS_TOTAL = OFF_HBMIX + (size_t)M_ALL * DM * 2;
static_assert(OFF_RKV + (size_t)M_ALL * 768 * 2 - OFF_HIDDEN >= (size_t)M_ALL * DFF * 2, "hidden overlay");

__device__ __forceinline__ P getP(kargp_t& kp) {
    asm volatile("" : "+s"(kp));
    typedef const float* const __attribute__((address_space(4)))* inp_t;
    inp_t in = (inp_t)kp;
    P p;
    p.x_prompt = in[0]; p.x_sample = in[1]; p.cache_ckv = in[2]; p.cache_krope = in[3]; p.state_rwkv = in[4]; p.c = in[5]; p.c_ctx = in[6];
    p.ada_w = in[7]; p.ada_b = in[8]; p.w_in = in[9]; p.rw_conv = in[10]; p.rw_w0 = in[11]; p.rw_w2 = in[12]; p.rw_a0 = in[13]; p.rw_a2 = in[14];
    p.rw_g2 = in[15]; p.rw_kk = in[16]; p.rw_ka = in[17]; p.rw_rk = in[18]; p.rw_gn_g = in[19]; p.rw_gn_b = in[20]; p.q_norm = in[21]; p.q_up = in[22];
    p.kv_norm = in[23]; p.kv_up = in[24]; p.gm_g = in[25]; p.gm_b = in[26]; p.gm_ws = in[27]; p.gm_bs = in[28]; p.w_out = in[29]; p.ln1_g = in[30];
    p.ln1_b = in[31]; p.ffn_in = in[32]; p.ffn_out = in[33]; p.ln2_g = in[34]; p.ln2_b = in[35];
    p.out = (float*)in[36]; char* ws = (char*)in[37];
    p.bar = (unsigned*)(ws + OFF_BAR); p.ctr = (int*)(ws + OFF_CTR); p.mod = (float*)(ws + OFF_MOD); p.ropeC = (float*)(ws + OFF_ROPEC); p.ropeS = (float*)(ws + OFF_ROPES);
    p.CkvB = (bf16_t*)(ws + OFF_CKVB); p.WtIn = (bf16_t*)(ws + OFF_WTIN); p.WtQ = (bf16_t*)(ws + OFF_WTQ); p.WtKVn = (bf16_t*)(ws + OFF_WTKVN); p.WtKV = (bf16_t*)(ws + OFF_WTKV);
    p.WtOut = (bf16_t*)(ws + OFF_WTOUT); p.WtF1 = (bf16_t*)(ws + OFF_WTF1); p.WtF2 = (bf16_t*)(ws + OFF_WTF2); p.WsB = (bf16_t*)(ws + OFF_WSB); p.W2t = (bf16_t*)(ws + OFF_W2T);
    p.A2t = (bf16_t*)(ws + OFF_A2T); p.G2t = (bf16_t*)(ws + OFF_G2T); p.Z = (bf16_t*)(ws + OFF_Z); p.RKV = (bf16_t*)(ws + OFF_RKV); p.Ee = (bf16_t*)(ws + OFF_EE); p.Aa = (bf16_t*)(ws + OFF_AA);
    p.Gg = (bf16_t*)(ws + OFF_GG); p.Qb = (bf16_t*)(ws + OFF_QB); p.Kb = (bf16_t*)(ws + OFF_KB); p.Kc = (bf16_t*)(ws + OFF_KC); p.Vt = (bf16_t*)(ws + OFF_VT); p.Vtc = (bf16_t*)(ws + OFF_VTC);
    p.hbmix = (bf16_t*)(ws + OFF_HBMIX); p.hidden = (bf16_t*)(ws + OFF_HIDDEN); p.ydir = (float*)(ws + OFF_YDIR);
    return p;
}

__device__ __forceinline__ float bf2f(bf16_t b) { return __uint_as_float(((unsigned)b) << 16); }
__device__ __forceinline__ unsigned pack2(float lo, float hi) { unsigned r; asm("v_cvt_pk_bf16_f32 %0, %1, %2" : "=v"(r) : "v"(lo), "v"(hi)); return r; }
__device__ __forceinline__ bf16_t f2bf(float f) { return (bf16_t)(pack2(f, 0.f) & 0xffffu); }
__device__ __forceinline__ float lo_bf(unsigned w) { return __uint_as_float(w << 16); }
__device__ __forceinline__ float hi_bf(unsigned w) { return __uint_as_float(w & 0xffff0000u); }
__device__ __forceinline__ float sigmoidf_(float x) { return __builtin_amdgcn_rcpf(1.0f + __builtin_amdgcn_exp2f(-1.4426950408889634f * x)); }
__device__ __forceinline__ float tanhf_(float x) { float e = __builtin_amdgcn_exp2f(2.8853900817779268f * x); return 1.0f - 2.0f * __builtin_amdgcn_rcpf(e + 1.0f); }
__device__ __forceinline__ float geluf_(float x) { return 0.5f * x * (1.0f + tanhf_(0.7978845608028654f * (x + 0.044715f * x * x * x))); }
template <int CTRL> __device__ __forceinline__ float dpp_add(float x) {
    int y = __builtin_amdgcn_update_dpp(0, __float_as_int(x), CTRL, 0xf, 0xf, false);
    return x + __int_as_float(y);
}
__device__ __forceinline__ float red4(float x) { x = dpp_add<0xB1>(x); x = dpp_add<0x4E>(x); return x; }
__device__ __forceinline__ float red8(float x) { x = red4(x); x = dpp_add<0x141>(x); return x; }
__device__ __forceinline__ float red16(float x) { x = red8(x); x = dpp_add<0x140>(x); return x; }
__device__ __forceinline__ int opaque_tid() { int t = threadIdx.x; asm volatile("" : "+v"(t)); return t; }
__device__ __forceinline__ int modrow_of(int row) { return row < M_CTX ? 0 : 1 + ((row - M_CTX) >> 12); }

#define XB_TMO 128
#define XB_XCNT(j) (256 + 64 * (j))
#define XB_XSUB(j) (1280 + 64 * (j))
#define XB_XGEN(j) (2304 + 64 * (j))
#define XB_TOP 3328
#define XB_TOPGEN 3392
#define XCD_BAR_WORDS 3456
#define XB_SPIN_CAP (1u << 22)
__device__ __forceinline__ unsigned xb_ld(unsigned* p) { return __hip_atomic_load(p, __ATOMIC_RELAXED, __HIP_MEMORY_SCOPE_AGENT); }
__device__ __forceinline__ unsigned xb_add(unsigned* p, unsigned v) { return __hip_atomic_fetch_add(p, v, __ATOMIC_RELAXED, __HIP_MEMORY_SCOPE_AGENT); }
__device__ __forceinline__ unsigned xb_xcc_id() { return (unsigned)__builtin_amdgcn_s_getreg((3 << 11) | 20) & 0xFu; }
#define XB_SPIN(cond, bar) do { unsigned _sp = 0; while (cond) { __builtin_amdgcn_s_sleep(1); \
    if ((++_sp & 255u) == 0u) { if (xb_ld(&(bar)[XB_TMO])) break; if (_sp > XB_SPIN_CAP) { atomicAdd(&(bar)[XB_TMO], 1u); break; } } } } while (0)
struct XcdBarrier { unsigned* bar; unsigned x; volatile LAS unsigned* st; };
__device__ __forceinline__ XcdBarrier xcd_barrier_post(unsigned* bar, volatile LAS unsigned* st) {
    XcdBarrier b; b.bar = bar; b.x = xb_xcc_id(); b.st = st;
    if (threadIdx.x == 0) (void)xb_add(&bar[XB_XCNT(b.x)], 1u);
    return b;
}
__device__ __forceinline__ void xcd_barrier_complete(unsigned* bar, unsigned x, unsigned& nloc, unsigned& nx) {
    const unsigned G = gridDim.x * gridDim.y * gridDim.z;
    unsigned sum, cnt, mine, sp = 0u;
    for (;;) {
        sum = 0u; cnt = 0u; mine = 0u;
#pragma unroll
        for (unsigned j = 0; j < 16; ++j) { const unsigned c = xb_ld(&bar[XB_XCNT(j)]); sum += c; cnt += (c > 0u) ? 1u : 0u; mine = (j == x) ? c : mine; }
        if (sum == G) break;
        __builtin_amdgcn_s_sleep(1);
        if ((++sp & 255u) == 0u) { if (xb_ld(&bar[XB_TMO])) break; if (sp > XB_SPIN_CAP) { atomicAdd(&bar[XB_TMO], 1u); break; } }
    }
    nloc = mine > 0u ? mine : 1u; nx = cnt > 0u ? cnt : 1u;
}
__device__ __forceinline__ void xcd_barrier(const XcdBarrier& b) {
    asm volatile("s_waitcnt vmcnt(0)" ::: "memory");
    __syncthreads();
    if (threadIdx.x == 0) {
        unsigned* bar = b.bar;
        __builtin_amdgcn_s_waitcnt(0);
        unsigned nloc = b.st[0], nx = b.st[1];
        if (nloc == 0u) { xcd_barrier_complete(bar, b.x, nloc, nx); b.st[0] = nloc; b.st[1] = nx; }
        const unsigned old = xb_add(&bar[XB_XSUB(b.x)], 1u);
        const unsigned gen = old / nloc;
        if (old + 1u == (gen + 1u) * nloc) {
            __builtin_amdgcn_fence(__ATOMIC_RELEASE, "agent");
            asm volatile("s_waitcnt vmcnt(0)" ::: "memory");
            const unsigned og = xb_add(&bar[XB_TOP], 1u);
            const unsigned tg = og / nx;
            if (og + 1u == (tg + 1u) * nx) xb_add(&bar[XB_TOPGEN], 1u);
            else XB_SPIN(xb_ld(&bar[XB_TOPGEN]) == tg, bar);
            __builtin_amdgcn_fence(__ATOMIC_ACQUIRE, "agent");
            xb_add(&bar[XB_XGEN(b.x)], 1u);
            asm volatile("s_waitcnt vmcnt(0)" ::: "memory");
        } else {
            XB_SPIN(xb_ld(&bar[XB_XGEN(b.x)]) == gen, bar);
            __builtin_amdgcn_fence(__ATOMIC_ACQUIRE, "agent");
            asm volatile("s_waitcnt vmcnt(0)" ::: "memory");
        }
    }
    __syncthreads();
}

template <class Epi>
__device__ __forceinline__ void gemm128(const bf16_t* __restrict__ A, int lda, const bf16_t* __restrict__ B, int ldb, int K, char* smem, const Epi& epi) {
    const int tid = opaque_tid(), lane = tid & 63, wid = tid >> 6, wr = wid >> 1, wc = wid & 1, fr = lane & 15, fq = lane >> 4;
    f32x4 acc[4][4];
#pragma unroll
    for (int m = 0; m < 4; ++m)
#pragma unroll
        for (int n = 0; n < 4; ++n) acc[m][n] = (f32x4){0.f, 0.f, 0.f, 0.f};
    const int crow = tid >> 3, ckc = tid & 7;
    const bf16_t* ap = A + (size_t)crow * lda + ckc * 8;
    const bf16_t* bp = B + (size_t)crow * ldb + ckc * 8;
    u32x4 ra[4], rb[4];
#pragma unroll
    for (int i = 0; i < 4; ++i) { ra[i] = *(const u32x4*)(ap + (size_t)(32 * i) * lda); rb[i] = *(const u32x4*)(bp + (size_t)(32 * i) * ldb); }
    {
        char* sa = smem; char* sb = smem + TILE_BYTES;
#pragma unroll
        for (int i = 0; i < 4; ++i) { *(u32x4*)(sa + ((crow + 32 * i) * LDS_STRIDE + ckc * 8) * 2) = ra[i]; *(u32x4*)(sb + ((crow + 32 * i) * LDS_STRIDE + ckc * 8) * 2) = rb[i]; }
    }
    __syncthreads();
    const int nk = K >> 6;
    for (int kt = 0; kt < nk; ++kt) {
        const bool more = (kt + 1 < nk);
        if (more) {
            const int k0 = (kt + 1) << 6;
#pragma unroll
            for (int i = 0; i < 4; ++i) { ra[i] = *(const u32x4*)(ap + (size_t)(32 * i) * lda + k0); rb[i] = *(const u32x4*)(bp + (size_t)(32 * i) * ldb + k0); }
        }
        const char* sa = smem + (kt & 1) * 2 * TILE_BYTES; const char* sb = sa + TILE_BYTES;
#pragma unroll
        for (int ks = 0; ks < 2; ++ks) {
            bf16x8 af[4], bfr[4];
#pragma unroll
            for (int m = 0; m < 4; ++m) af[m] = *(const bf16x8*)(sa + ((wr * 64 + m * 16 + fr) * LDS_STRIDE + ks * 32 + fq * 8) * 2);
#pragma unroll
            for (int n = 0; n < 4; ++n) bfr[n] = *(const bf16x8*)(sb + ((wc * 64 + n * 16 + fr) * LDS_STRIDE + ks * 32 + fq * 8) * 2);
#pragma unroll
            for (int m = 0; m < 4; ++m)
#pragma unroll
                for (int n = 0; n < 4; ++n) acc[m][n] = __builtin_amdgcn_mfma_f32_16x16x32_bf16(af[m], bfr[n], acc[m][n], 0, 0, 0);
        }
        if (more) {
            char* da = smem + ((kt + 1) & 1) * 2 * TILE_BYTES; char* db = da + TILE_BYTES;
#pragma unroll
            for (int i = 0; i < 4; ++i) { *(u32x4*)(da + ((crow + 32 * i) * LDS_STRIDE + ckc * 8) * 2) = ra[i]; *(u32x4*)(db + ((crow + 32 * i) * LDS_STRIDE + ckc * 8) * 2) = rb[i]; }
        }
        __syncthreads();
    }
    epi(acc, wr * 64, wc * 64, fr, fq);
}

struct EpiZ {
    bf16_t* Z; int R0, C0;
    __device__ __forceinline__ void operator()(f32x4 (&acc)[4][4], int r0, int c0, int fr, int fq) const {
#pragma unroll
        for (int n = 0; n < 4; ++n) { const int col = C0 + c0 + n * 16 + fr; if (col < NIN) {
#pragma unroll
            for (int m = 0; m < 4; ++m)
#pragma unroll
                for (int j = 0; j < 4; ++j) Z[(size_t)(R0 + r0 + m * 16 + fq * 4 + j) * NIN + col] = f2bf(acc[m][n][j]); } }
    }
};
struct EpiQ {
    bf16_t* Q; const float* rs; const float* ropeC; const float* ropeS; int R0, C0;
    __device__ __forceinline__ void operator()(f32x4 (&acc)[4][4], int r0, int c0, int fr, int fq) const {
        const bool lat = R0 >= M_CTX;
#pragma unroll
        for (int n = 0; n < 4; ++n) {
            const int cb = C0 + c0 + n * 16; const int hcs = cb % 96;
            if (lat && hcs == 80) continue;
            const bool rot = lat && hcs == 64;
#pragma unroll
            for (int m = 0; m < 4; ++m)
#pragma unroll
                for (int j = 0; j < 4; ++j) {
                    const int rl = r0 + m * 16 + fq * 4 + j; const int row = R0 + rl; const float s = rs[rl] * QSCALE;
                    const float x1 = acc[m][n][j] * s;
                    if (rot) {
                        const float x2 = acc[m][(n + 1) & 3][j] * s; const int t = (row - M_CTX) & 4095;
                        const float cv = ropeC[t * 16 + fr], sv = ropeS[t * 16 + fr];
                        Q[(size_t)row * 768 + cb + fr] = f2bf(x1 * cv - x2 * sv);
                        Q[(size_t)row * 768 + cb + 16 + fr] = f2bf(x1 * sv + x2 * cv);
                    } else Q[(size_t)row * 768 + cb + fr] = f2bf(x1);
                }
        }
    }
};
struct EpiKV {
    bf16_t* Kd; bf16_t* Vd; const float* rs; int R0, C0; int seqshift; size_t vbase0;
    __device__ __forceinline__ void operator()(f32x4 (&acc)[4][4], int r0, int c0, int fr, int fq) const {
#pragma unroll
        for (int n = 0; n < 4; ++n) {
            const int col = C0 + c0 + n * 16 + fr;
#pragma unroll
            for (int m = 0; m < 4; ++m) {
                const int rl = r0 + m * 16 + fq * 4; const int row = R0 + rl;
                float v[4];
#pragma unroll
                for (int j = 0; j < 4; ++j) v[j] = acc[m][n][j] * (rs ? rs[rl + j] : 1.0f);
                if (col < 512) {
                    const int h = col >> 6, d = col & 63;
#pragma unroll
                    for (int j = 0; j < 4; ++j) Kd[(size_t)(row + j) * 768 + h * 96 + d] = f2bf(v[j]);
                } else {
                    const int vc = col - 512, h = vc >> 6, dv = vc & 63; const int b = row >> seqshift, t = row & ((1 << seqshift) - 1);
                    u32x2 w; w.x = pack2(v[0], v[1]); w.y = pack2(v[2], v[3]);
                    *(u32x2*)(Vd + vbase0 + ((size_t)((b * 8 + h) * 64 + dv) << seqshift) + t) = w;
                }
            }
        }
    }
};
struct EpiRes {
    float* X; const float* gate; int R0, C0;
    __device__ __forceinline__ void operator()(f32x4 (&acc)[4][4], int r0, int c0, int fr, int fq) const {
#pragma unroll
        for (int n = 0; n < 4; ++n) { const int col = C0 + c0 + n * 16 + fr; const float g = gate[col];
#pragma unroll
            for (int m = 0; m < 4; ++m)
#pragma unroll
                for (int j = 0; j < 4; ++j) { float* px = X + (size_t)(R0 + r0 + m * 16 + fq * 4 + j) * DM + col; *px = ALPHA_F * (*px) + g * acc[m][n][j]; } }
    }
};
struct EpiSwi {
    bf16_t* H; int R0, C0;
    __device__ __forceinline__ void operator()(f32x4 (&acc)[4][4], int r0, int c0, int fr, int fq) const {
        const int hb = (C0 + c0) >> 1;
#pragma unroll
        for (int n = 0; n < 2; ++n)
#pragma unroll
            for (int m = 0; m < 4; ++m)
#pragma unroll
                for (int j = 0; j < 4; ++j) { const float g = acc[m][n][j], u = acc[m][n + 2][j];
                    H[(size_t)(R0 + r0 + m * 16 + fq * 4 + j) * DFF + hb + n * 16 + fr] = f2bf(g * sigmoidf_(g) * u); }
    }
};

__device__ __forceinline__ void ada_unit(const P& p, int u, char* smem) {
    const int tid = opaque_tid(); const int l = u / 96, c0 = (u % 96) * 64;
    float* cs = (float*)smem;
    for (int i = tid; i < 5 * 1024; i += 256) { const int r = i >> 10, k = i & 1023; const float v = (r == 0) ? p.c_ctx[k] : p.c[(r - 1) * 1024 + k]; cs[i] = v * sigmoidf_(v); }
    __syncthreads();
    const int col = tid & 63, kq = tid >> 6;
    float s0 = 0.f, s1 = 0.f, s2 = 0.f, s3 = 0.f, s4 = 0.f;
    const float* w = p.ada_w + ((size_t)l * 1024 + kq * 256) * 6144 + c0 + col;
    const float* cq = cs + kq * 256;
    for (int k = 0; k < 256; ++k) { const float wv = w[(size_t)k * 6144]; s0 += cq[k] * wv; s1 += cq[1024 + k] * wv; s2 += cq[2048 + k] * wv; s3 += cq[3072 + k] * wv; s4 += cq[4096 + k] * wv; }
    float* red = cs + 5 * 1024;
    red[(kq * 5 + 0) * 64 + col] = s0; red[(kq * 5 + 1) * 64 + col] = s1; red[(kq * 5 + 2) * 64 + col] = s2; red[(kq * 5 + 3) * 64 + col] = s3; red[(kq * 5 + 4) * 64 + col] = s4;
    __syncthreads();
    for (int o = tid; o < 320; o += 256) { const int i = o >> 6, cc = o & 63;
        const float v = red[(0 * 5 + i) * 64 + cc] + red[(1 * 5 + i) * 64 + cc] + red[(2 * 5 + i) * 64 + cc] + red[(3 * 5 + i) * 64 + cc] + p.ada_b[l * 6144 + c0 + cc];
        p.mod[((size_t)l * 5 + i) * 6144 + c0 + cc] = v; }
    __syncthreads();
}
__device__ __forceinline__ int map_col(int kind, int n) {
    if (kind == 1) { const int blk = n >> 6, r = n & 63; return r < 32 ? blk * 32 + r : DFF + blk * 32 + (r - 32); }
    if (kind == 2) { if (n < 512) return (n >> 6) * 128 + (n & 63); const int vc = n - 512; return (vc >> 6) * 128 + 64 + (vc & 63); }
    return n;
}
__device__ __forceinline__ void conv_tile(const float* src, int ldsrc, bf16_t* dst, bf16_t* dst2, int Kdst, int n0, int k0, int kind, int Nvalid, const float* kscale, char* smem) {
    const int tid = opaque_tid(); float* tile = (float*)smem;
    { const int j = tid & 63, i0 = tid >> 6; const int n = n0 + j; const int sc = (n < Nvalid) ? map_col(kind, n) : -1;
#pragma unroll 4
      for (int ii = 0; ii < 16; ++ii) { const int i = i0 + 4 * ii; tile[i * 65 + j] = (sc >= 0) ? src[(size_t)(k0 + i) * ldsrc + sc] : 0.f; } }
    __syncthreads();
    { const int i = tid & 63, j0 = tid >> 6; const float ks = kscale ? kscale[k0 + i] : 1.f;
#pragma unroll 4
      for (int jj = 0; jj < 16; ++jj) { const int jx = j0 + 4 * jj; const float v = tile[i * 65 + jx];
          dst[(size_t)(n0 + jx) * Kdst + k0 + i] = f2bf(v * ks); if (dst2) dst2[(size_t)(n0 + jx) * Kdst + k0 + i] = f2bf(v); } }
    __syncthreads();
}
#define NCONV 3032
__device__ __forceinline__ void conv_unit(const P& p, int l, int u, char* smem) {
    const float* src; int ldsrc; bf16_t* dst; bf16_t* dst2 = nullptr; int Kdst, n0, k0, kind = 0, Nvalid; const float* kscale = nullptr;
    if (u < 544) { src = p.w_in + (size_t)l * 1024 * NIN; ldsrc = NIN; dst = p.WtIn; Kdst = 1024; n0 = (u / 16) * 64; k0 = (u % 16) * 64; Nvalid = NIN; }
    else if (u < 592) { u -= 544; src = p.q_up + (size_t)l * 256 * 768; ldsrc = 768; dst = p.WtQ; Kdst = 256; n0 = (u / 4) * 64; k0 = (u % 4) * 64; Nvalid = 768; kscale = p.q_norm + l * 256; }
    else if (u < 624) { u -= 592; src = p.kv_up + (size_t)l * 128 * 1024; ldsrc = 1024; dst = p.WtKVn; dst2 = p.WtKV; Kdst = 128; n0 = (u / 2) * 64; k0 = (u % 2) * 64; kind = 2; Nvalid = 1024; kscale = p.kv_norm + l * 128; }
    else if (u < 880) { u -= 624; src = p.w_out + (size_t)l * 1024 * 1024; ldsrc = 1024; dst = p.WtOut; Kdst = 1024; n0 = (u / 16) * 64; k0 = (u % 16) * 64; Nvalid = 1024; }
    else if (u < 2288) { u -= 880; src = p.ffn_in + (size_t)l * 1024 * 5632; ldsrc = 5632; dst = p.WtF1; Kdst = 1024; n0 = (u / 16) * 64; k0 = (u % 16) * 64; kind = 1; Nvalid = 5632; }
    else if (u < 2992) { u -= 2288; src = p.ffn_out + (size_t)l * DFF * 1024; ldsrc = 1024; dst = p.WtF2; Kdst = DFF; n0 = (u / 44) * 64; k0 = (u % 44) * 64; Nvalid = 1024; }
    else if (u < 3008) { u -= 2992; const float* sp = p.gm_ws + (size_t)l * 65536 + u * 4096; bf16_t* d = p.WsB + u * 4096; for (int i = threadIdx.x; i < 4096; i += 256) d[i] = f2bf(sp[i]); return; }
    else if (u < 3016) { u -= 3008; const int d = u >> 2; src = p.rw_w2 + ((size_t)l * 2 + d) * 64 * 256; ldsrc = 256; dst = p.W2t + d * 256 * 64; Kdst = 64; n0 = (u & 3) * 64; k0 = 0; Nvalid = 256; }
    else if (u < 3024) { u -= 3016; const int d = u >> 2; src = p.rw_a2 + ((size_t)l * 2 + d) * 64 * 256; ldsrc = 256; dst = p.A2t + d * 256 * 64; Kdst = 64; n0 = (u & 3) * 64; k0 = 0; Nvalid = 256; }
    else { u -= 3024; src = p.rw_g2 + (size_t)l * 128 * 256; ldsrc = 256; dst = p.G2t; Kdst = 128; n0 = (u / 2) * 64; k0 = (u % 2) * 64; Nvalid = 256; }
    conv_tile(src, ldsrc, dst, dst2, Kdst, n0, k0, kind, Nvalid, kscale, smem);
}
__device__ __forceinline__ void misc0_unit(const P& p, int u) {
    const int tid = opaque_tid();
    if (u < 16) {
        for (int e = tid; e < 4096; e += 256) { const int idx = u * 4096 + e; const int t = idx >> 4, i = idx & 15;
            const float pos = (float)((i < 8) ? (t >> 6) : (t & 63)); const float inv = exp2f(-(float)(i & 7) * 1.6609640474436813f);
            const float ang = pos * inv; const float kf = rintf(ang * 0.15915494309189535f);
            float r = fmaf(-kf, 6.28318548202514648f, ang); r = fmaf(-kf, -1.74845553e-7f, r);
            p.ropeC[idx] = __cosf(r); p.ropeS[idx] = __sinf(r); }
    } else {
        const int v = u - 16;
        for (int e = tid; e < 4096; e += 256) { const int idx = v * 4096 + e;
            const int c = idx & 127, t = (idx >> 7) & 511, b = (idx >> 16) & 3, l = idx >> 18;
            p.CkvB[idx] = f2bf(p.cache_ckv[(((size_t)b * 4 + l) * 512 + t) * 128 + c]); }
    }
}

__device__ __forceinline__ void ln_phase(const P& p, int l, int which) {
    const int tid = opaque_tid(), lane = tid & 63, wid = tid >> 6;
    const float* g = which == 1 ? p.ln1_g + l * DM : p.ln2_g + l * DM; const float* bb = which == 1 ? p.ln1_b + l * DM : p.ln2_b + l * DM;
    const int ml = which == 2 ? l + 1 : l; const int shoff = which == 1 ? 3072 : 0, scoff = which == 1 ? 4096 : 1024;
    const bool dohb = !(which == 2 && l == 3);
    for (int row = blockIdx.x * 4 + wid; row < M_ALL; row += gridDim.x * 4) {
        float* xr = p.out + (size_t)row * DM;
        const float* src = which == 0 ? (row < M_CTX ? p.x_prompt + (size_t)row * DM : p.x_sample + (size_t)(row - M_CTX) * DM) : xr;
        f32x4 v[4];
#pragma unroll
        for (int i = 0; i < 4; ++i) v[i] = *(const f32x4*)(src + lane * 4 + 256 * i);
        if (which != 0) {
            float s = 0.f;
#pragma unroll
            for (int i = 0; i < 4; ++i) s += (v[i][0] + v[i][1]) + (v[i][2] + v[i][3]);
            s = red16(s); s += __shfl_xor(s, 16); s += __shfl_xor(s, 32);
            const float mu = s * (1.0f / 1024.0f); float q = 0.f;
#pragma unroll
            for (int i = 0; i < 4; ++i) { const f32x4 d = v[i] - mu; q += (d[0] * d[0] + d[1] * d[1]) + (d[2] * d[2] + d[3] * d[3]); }
            q = red16(q); q += __shfl_xor(q, 16); q += __shfl_xor(q, 32);
            const float rstd = rsqrtf(q * (1.0f / 1024.0f) + 1e-5f);
#pragma unroll
            for (int i = 0; i < 4; ++i) { const f32x4 gg = *(const f32x4*)(g + lane * 4 + 256 * i), bv = *(const f32x4*)(bb + lane * 4 + 256 * i); v[i] = (v[i] - mu) * rstd * gg + bv; }
        }
#pragma unroll
        for (int i = 0; i < 4; ++i) *(f32x4*)(xr + lane * 4 + 256 * i) = v[i];
        if (dohb) {
            const float* md = p.mod + ((size_t)ml * 5 + modrow_of(row)) * 6144;
#pragma unroll
            for (int i = 0; i < 4; ++i) { const f32x4 sh = *(const f32x4*)(md + shoff + lane * 4 + 256 * i), sc = *(const f32x4*)(md + scoff + lane * 4 + 256 * i);
                const f32x4 h = v[i] * (1.0f + sc) + sh; u32x2 w; w.x = pack2(h[0], h[1]); w.y = pack2(h[2], h[3]);
                *(u32x2*)(p.hbmix + (size_t)row * DM + lane * 4 + 256 * i) = w; }
        }
    }
}

__device__ __forceinline__ void rwprep_unit(const P& p, int l, int u, char* smem) {
    const int tid = opaque_tid(), lane = tid & 63, wid = tid >> 6, fr = lane & 15, fq = lane >> 4;
    const int R0 = u * 64;
    const int ss = R0 < M_CTX ? (R0 & ~255) : M_CTX + ((R0 - M_CTX) & ~4095); const int se = ss + (R0 < M_CTX ? 256 : 4096);
    bf16_t* XW = (bf16_t*)smem; bf16_t* XA = XW + 64 * 136; bf16_t* XG = XA + 64 * 136;
    const float* cw = p.rw_conv + (size_t)l * 3 * 1152;
    for (int it = tid; it < 576; it += 256) {
        const int cc = it % 144, tg = it / 144; const int c = cc * 8;
        float w0[8], w1[8], w2[8];
#pragma unroll
        for (int i = 0; i < 8; ++i) { w0[i] = cw[c + i]; w1[i] = cw[1152 + c + i]; w2[i] = cw[2304 + c + i]; }
        const int rfirst = R0 + tg * 16;
        u32x4 prev = (u32x4){0u, 0u, 0u, 0u}, cur, nxt;
        if (rfirst - 1 >= ss) prev = *(const u32x4*)(p.Z + (size_t)(rfirst - 1) * NIN + c);
        cur = *(const u32x4*)(p.Z + (size_t)rfirst * NIN + c);
        for (int tt = 0; tt < 16; ++tt) {
            const int row = rfirst + tt;
            nxt = (u32x4){0u, 0u, 0u, 0u};
            if (row + 1 < se) nxt = *(const u32x4*)(p.Z + (size_t)(row + 1) * NIN + c);
            float o[8];
#pragma unroll
            for (int i = 0; i < 4; ++i) {
                o[2 * i] = w0[2 * i] * lo_bf(prev[i]) + w1[2 * i] * lo_bf(cur[i]) + w2[2 * i] * lo_bf(nxt[i]);
                o[2 * i + 1] = w0[2 * i + 1] * hi_bf(prev[i]) + w1[2 * i + 1] * hi_bf(cur[i]) + w2[2 * i + 1] * hi_bf(nxt[i]);
            }
            if (c >= 768 && c < 896) {
#pragma unroll
                for (int i = 0; i < 8; ++i) o[i] = tanhf_(o[i]);
            } else if (c >= 1024) {
#pragma unroll
                for (int i = 0; i < 8; ++i) o[i] = sigmoidf_(o[i]);
            }
            u32x4 w; w.x = pack2(o[0], o[1]); w.y = pack2(o[2], o[3]); w.z = pack2(o[4], o[5]); w.w = pack2(o[6], o[7]);
            const int tl = tg * 16 + tt;
            if (c < 768) *(u32x4*)(p.RKV + (size_t)row * 768 + c) = w;
            else if (c < 896) *(u32x4*)(XW + tl * 136 + (c - 768)) = w;
            else if (c < 1024) *(u32x4*)(XA + tl * 136 + (c - 896)) = w;
            else *(u32x4*)(XG + tl * 136 + (c - 1024)) = w;
            prev = cur; cur = nxt;
        }
    }
    __syncthreads();
#pragma unroll 1
    for (int mh = 0; mh < 10; ++mh) {
        const int mat = mh >> 1, nh = mh & 1;
        const int d = mat & 1; const bf16_t* As; const bf16_t* Bw; int kofs, nks, ldw;
        if (mat < 2) { As = XW; Bw = p.W2t + d * 256 * 64; kofs = d * 64; nks = 2; ldw = 64; }
        else if (mat < 4) { As = XA; Bw = p.A2t + d * 256 * 64; kofs = d * 64; nks = 2; ldw = 64; }
        else { As = XG; Bw = p.G2t; kofs = 0; nks = 4; ldw = 128; }
        f32x4 acc[4][2];
#pragma unroll
        for (int m = 0; m < 4; ++m)
#pragma unroll
            for (int n = 0; n < 2; ++n) acc[m][n] = (f32x4){0.f, 0.f, 0.f, 0.f};
#pragma unroll 1
        for (int ks = 0; ks < nks; ++ks) {
            bf16x8 af[4], bfr[2];
#pragma unroll
            for (int m = 0; m < 4; ++m) af[m] = *(const bf16x8*)(As + (m * 16 + fr) * 136 + kofs + ks * 32 + fq * 8);
#pragma unroll
            for (int n = 0; n < 2; ++n) bfr[n] = *(const bf16x8*)(Bw + (size_t)(wid * 64 + nh * 32 + n * 16 + fr) * ldw + ks * 32 + fq * 8);
#pragma unroll
            for (int m = 0; m < 4; ++m)
#pragma unroll
                for (int n = 0; n < 2; ++n) acc[m][n] = __builtin_amdgcn_mfma_f32_16x16x32_bf16(af[m], bfr[n], acc[m][n], 0, 0, 0);
        }
#pragma unroll
        for (int n = 0; n < 2; ++n) {
            const int c = wid * 64 + nh * 32 + n * 16 + fr;
            float bias = 0.f; if (mat < 2) bias = p.rw_w0[(l * 2 + d) * 256 + c]; else if (mat < 4) bias = p.rw_a0[(l * 2 + d) * 256 + c];
            bf16_t* dst; float mul;
            if (mat < 2) { dst = p.Ee + ((size_t)d * M_ALL + R0) * 256 + c; mul = 0.6065306597126334f; }
            else if (mat < 4) { dst = p.Aa + ((size_t)d * M_ALL + R0) * 256 + c; mul = 1.0f; }
            else { dst = p.Gg + (size_t)R0 * 256 + c; mul = 1.0f; }
#pragma unroll
            for (int m = 0; m < 4; ++m)
#pragma unroll
                for (int j = 0; j < 4; ++j) {
                    const float x = acc[m][n][j] + bias;
                    dst[(size_t)(m * 16 + fq * 4 + j) * 256] = f2bf(mat < 4 ? mul * sigmoidf_(x) : x);
                }
        }
    }
    __syncthreads();
}
__device__ __forceinline__ void rowscale128(const bf16_t* Z, int R0, int zoff, int ncols, float eps, float* rs) {
    const int tid = opaque_tid(); const int r = tid >> 1, half = tid & 1; const int per = ncols >> 1;
    const bf16_t* zp = Z + (size_t)(R0 + r) * NIN + zoff + half * per;
    float ss = 0.f;
    for (int i = 0; i < per; i += 8) { const u32x4 w = *(const u32x4*)(zp + i);
#pragma unroll
        for (int q = 0; q < 4; ++q) { const float a = lo_bf(w[q]), b = hi_bf(w[q]); ss += a * a + b * b; } }
    ss = dpp_add<0xB1>(ss);
    if (half == 0) rs[r] = rsqrtf(ss / (float)ncols + eps);
}
__device__ __forceinline__ void small_unit(const P& p, int l, int u) {
    const int tid = opaque_tid(), sub = tid >> 5, li = tid & 31;
    if (u < 2560) {
        const int row = u * 8 + sub; const bf16_t* zr = p.Z + (size_t)row * NIN;
        const u32x2 w = *(const u32x2*)(zr + ZKV + li * 4);
        const float z0 = lo_bf(w.x), z1 = hi_bf(w.x), z2 = lo_bf(w.y), z3 = hi_bf(w.y);
        float ss = z0 * z0 + z1 * z1 + z2 * z2 + z3 * z3; ss = red16(ss); ss += __shfl_xor(ss, 16);
        const float rsv = rsqrtf(ss * (1.0f / 128.0f) + 1e-6f);
        const float x1 = bf2f(zr[ZKR + (li & 15)]), x2 = bf2f(zr[ZKR + 16 + (li & 15)]);
        float val;
        if (row < M_CTX) {
            const int b = row >> 8, t = row & 255; const size_t o = ((size_t)(b * 4 + l) * 256 + t);
            const f32x4 g = *(const f32x4*)(p.kv_norm + l * 128 + li * 4);
            *(f32x4*)(p.out + 20971520 + o * 128 + li * 4) = (f32x4){z0 * rsv * g[0], z1 * rsv * g[1], z2 * rsv * g[2], z3 * rsv * g[3]};
            val = li < 16 ? x1 : x2;
            p.out[20971520 + 2097152 + o * 32 + li] = val;
        } else {
            const int t = (row - M_CTX) & 4095; const float cv = p.ropeC[t * 16 + (li & 15)], sv = p.ropeS[t * 16 + (li & 15)];
            val = li < 16 ? x1 * cv - x2 * sv : x1 * sv + x2 * cv;
        }
        const bf16_t bv = f2bf(val);
#pragma unroll
        for (int h = 0; h < 8; ++h) p.Kb[(size_t)row * 768 + h * 96 + 64 + li] = bv;
    } else {
        const int r = (u - 2560) * 8 + sub; const int b = r >> 9, t = r & 511;
        const bf16_t bv = f2bf(p.cache_krope[((size_t)(b * 4 + l) * 512 + t) * 32 + li]);
#pragma unroll
        for (int h = 0; h < 8; ++h) p.Kc[(size_t)r * 768 + h * 96 + 64 + li] = bv;
    }
}
__device__ __forceinline__ void gmlp_unit(const P& p, int l, int u, char* smem) {
    const int tid = opaque_tid(), lane = tid & 63, wid = tid >> 6, fr = lane & 15, fq = lane >> 4;
    const int R0 = (u >> 2) * 128, g = u & 3;
    bf16_t* VnT = (bf16_t*)smem;
    {
        const int tok = tid >> 1, half = tid & 1; const bf16_t* zp = p.Z + (size_t)(R0 + tok) * NIN + ZV + g * 64 + half * 32;
        float x[32];
#pragma unroll
        for (int i = 0; i < 4; ++i) { const u32x4 w = *(const u32x4*)(zp + i * 8);
#pragma unroll
            for (int q = 0; q < 4; ++q) { x[i * 8 + 2 * q] = geluf_(lo_bf(w[q])); x[i * 8 + 2 * q + 1] = geluf_(hi_bf(w[q])); } }
        float s = 0.f;
#pragma unroll
        for (int i = 0; i < 32; ++i) s += x[i];
        s = dpp_add<0xB1>(s); const float mu = s * (1.0f / 64.0f);
        float q2 = 0.f;
#pragma unroll
        for (int i = 0; i < 32; ++i) { const float d = x[i] - mu; q2 += d * d; }
        q2 = dpp_add<0xB1>(q2); const float rstd = rsqrtf(q2 * (1.0f / 64.0f) + 1e-5f);
        const float* gg = p.gm_g + l * 256 + g * 64 + half * 32; const float* gb = p.gm_b + l * 256 + g * 64 + half * 32;
#pragma unroll
        for (int i = 0; i < 32; ++i) VnT[(half * 32 + i) * 136 + tok] = f2bf((x[i] - mu) * rstd * gg[i] + gb[i]);
    }
    __syncthreads();
    f32x4 acc[2][4];
#pragma unroll
    for (int m = 0; m < 2; ++m)
#pragma unroll
        for (int n = 0; n < 4; ++n) acc[m][n] = (f32x4){0.f, 0.f, 0.f, 0.f};
    const bf16_t* Wg = p.WsB + g * 128 * 128;
#pragma unroll
    for (int ks = 0; ks < 4; ++ks) {
        bf16x8 af[2], bfr[4];
#pragma unroll
        for (int m = 0; m < 2; ++m) af[m] = *(const bf16x8*)(Wg + (wid * 32 + m * 16 + fr) * 128 + ks * 32 + fq * 8);
#pragma unroll
        for (int n = 0; n < 4; ++n) bfr[n] = *(const bf16x8*)(VnT + (n * 16 + fr) * 136 + ks * 32 + fq * 8);
#pragma unroll
        for (int m = 0; m < 2; ++m)
#pragma unroll
            for (int n = 0; n < 4; ++n) acc[m][n] = __builtin_amdgcn_mfma_f32_16x16x32_bf16(af[m], bfr[n], acc[m][n], 0, 0, 0);
    }
#pragma unroll
    for (int m = 0; m < 2; ++m)
#pragma unroll
        for (int j = 0; j < 4; ++j) {
            const int pp = wid * 32 + m * 16 + fq * 4 + j; const float bs = p.gm_bs[l * 512 + g * 128 + pp];
#pragma unroll
            for (int n = 0; n < 4; ++n) { const int c = n * 16 + fr;
                const float uu = geluf_(bf2f(p.Z[(size_t)(R0 + pp) * NIN + ZU + g * 64 + c]));
                p.hbmix[(size_t)(R0 + pp) * DM + 768 + g * 64 + c] = f2bf(uu * (acc[m][n][j] + bs)); }
        }
    __syncthreads();
}

__device__ __forceinline__ float swap16_add(float x) {
    auto r = __builtin_amdgcn_permlane16_swap(__float_as_uint(x), __float_as_uint(x), false, false);
    return __uint_as_float(r[0]) + __uint_as_float(r[1]);
}
#define NSCAN_LAT 256
#define NSCAN (256 + 1024)
__device__ __forceinline__ void scan_unit(const P& p, int l, int u, char* smem) {
    const int tid = opaque_tid(), lane = tid & 63, wid = tid >> 6;
    int b, T, row0; const bool lat = u < NSCAN_LAT;
    if (lat) { b = u >> 6; T = 4096; row0 = M_CTX + b * 4096; } else { b = (u - NSCAN_LAT) >> 6; T = 256; row0 = b * 256; }
    const int h = (u >> 4) & 3, d = (u >> 3) & 1, rsl = u & 7;
    float* W = (float*)smem; float* NKK = W + 2048; float* KKA = NKK + 2048; float* KD = KKA + 2048; float* RR = KD + 2048; float* VS = RR + 2048; float* OUTP = VS + 256;
    const int rl = lane >> 5, kq = lane & 31; const int r8 = wid * 2 + rl; const int row = rsl * 8 + r8;
    f32x2 S = (f32x2){0.f, 0.f};
    const size_t stoff = ((((size_t)b * 4 + l) * 2 + d) * 4 + h) * 4096 + row * 64 + kq * 2;
    if (lat) S = *(const f32x2*)(p.state_rwkv + stoff);
    const int tok = tid >> 3, cg8 = tid & 7;
    float kkp[8], kap[8];
#pragma unroll
    for (int i = 0; i < 8; ++i) { kkp[i] = p.rw_kk[l * 256 + h * 64 + cg8 * 8 + i]; kap[i] = p.rw_ka[l * 256 + h * 64 + cg8 * 8 + i]; }
    const int nch = T >> 5;
    u32x4 r8v, k8, e8, a8, v8;
    int grow, grow_prev = 0; float oreg = 0.f;
    {
        const int sidx = tok; const int t = d ? T - 1 - sidx : sidx; grow = row0 + t;
        r8v = *(const u32x4*)(p.RKV + (size_t)grow * 768 + h * 64 + cg8 * 8);
        k8 = *(const u32x4*)(p.RKV + (size_t)grow * 768 + 256 + h * 64 + cg8 * 8);
        v8 = *(const u32x4*)(p.RKV + (size_t)grow * 768 + 512 + h * 64 + rsl * 8);
        e8 = *(const u32x4*)(p.Ee + ((size_t)d * M_ALL + grow) * 256 + h * 64 + cg8 * 8);
        a8 = *(const u32x4*)(p.Aa + ((size_t)d * M_ALL + grow) * 256 + h * 64 + cg8 * 8);
    }
    for (int ch = 0; ch < nch; ++ch) {
        {
            float kf[8], kkv[8], rf[8], ef[8], af[8];
#pragma unroll
            for (int q = 0; q < 4; ++q) { kf[2 * q] = lo_bf(k8[q]); kf[2 * q + 1] = hi_bf(k8[q]); rf[2 * q] = lo_bf(r8v[q]); rf[2 * q + 1] = hi_bf(r8v[q]);
                ef[2 * q] = lo_bf(e8[q]); ef[2 * q + 1] = hi_bf(e8[q]); af[2 * q] = lo_bf(a8[q]); af[2 * q + 1] = hi_bf(a8[q]); }
            float ss = 0.f;
#pragma unroll
            for (int i = 0; i < 8; ++i) { kkv[i] = kf[i] * kkp[i]; ss += kkv[i] * kkv[i]; }
            ss = red8(ss);
            const float inv = rsqrtf(fmaxf(ss, 1e-24f));
            f32x4 o0, o1; const int base = tok * 64 + cg8 * 8;
#pragma unroll
            for (int i = 0; i < 4; ++i) { o0[i] = __expf(-ef[i]); o1[i] = __expf(-ef[4 + i]); }
            *(f32x4*)(W + base) = o0; *(f32x4*)(W + base + 4) = o1;
#pragma unroll
            for (int i = 0; i < 4; ++i) { o0[i] = -kkv[i] * inv; o1[i] = -kkv[4 + i] * inv; }
            *(f32x4*)(NKK + base) = o0; *(f32x4*)(NKK + base + 4) = o1;
#pragma unroll
            for (int i = 0; i < 4; ++i) { o0[i] = kkv[i] * inv * af[i]; o1[i] = kkv[4 + i] * inv * af[4 + i]; }
            *(f32x4*)(KKA + base) = o0; *(f32x4*)(KKA + base + 4) = o1;
#pragma unroll
            for (int i = 0; i < 4; ++i) { o0[i] = kf[i] * (1.0f + (af[i] - 1.0f) * kap[i]); o1[i] = kf[4 + i] * (1.0f + (af[4 + i] - 1.0f) * kap[4 + i]); }
            *(f32x4*)(KD + base) = o0; *(f32x4*)(KD + base + 4) = o1;
#pragma unroll
            for (int i = 0; i < 4; ++i) { o0[i] = rf[i]; o1[i] = rf[4 + i]; }
            *(f32x4*)(RR + base) = o0; *(f32x4*)(RR + base + 4) = o1;
            if (cg8 == 0) {
#pragma unroll
                for (int q = 0; q < 4; ++q) { VS[tok * 8 + 2 * q] = lo_bf(v8[q]); VS[tok * 8 + 2 * q + 1] = hi_bf(v8[q]); }
            }
        }
        __syncthreads();
        if (ch > 0) p.ydir[((size_t)d * M_ALL + grow_prev) * 256 + h * 64 + rsl * 8 + cg8] = oreg;
        grow_prev = grow;
        if (ch + 1 < nch) {
            const int sidx = (ch + 1) * 32 + tok; const int t = d ? T - 1 - sidx : sidx; grow = row0 + t;
            r8v = *(const u32x4*)(p.RKV + (size_t)grow * 768 + h * 64 + cg8 * 8);
            k8 = *(const u32x4*)(p.RKV + (size_t)grow * 768 + 256 + h * 64 + cg8 * 8);
            v8 = *(const u32x4*)(p.RKV + (size_t)grow * 768 + 512 + h * 64 + rsl * 8);
            e8 = *(const u32x4*)(p.Ee + ((size_t)d * M_ALL + grow) * 256 + h * 64 + cg8 * 8);
            a8 = *(const u32x4*)(p.Aa + ((size_t)d * M_ALL + grow) * 256 + h * 64 + cg8 * 8);
        }
        {
            const float* Wq = W + kq * 2; const float* NKq = NKK + kq * 2; const float* KAq = KKA + kq * 2; const float* KDq = KD + kq * 2; const float* RRq = RR + kq * 2; const float* VSq = VS + r8;
            float* OPq = OUTP + r8 * 32 + kq;
            f32x2 wv[4], nkv[4], kav[4], kdv[4], rrv[4]; float vv[4];
#define SCAN_LD(slot, st) do { wv[slot] = *(const f32x2*)(Wq + (st) * 64); nkv[slot] = *(const f32x2*)(NKq + (st) * 64); kav[slot] = *(const f32x2*)(KAq + (st) * 64); \
        kdv[slot] = *(const f32x2*)(KDq + (st) * 64); rrv[slot] = *(const f32x2*)(RRq + (st) * 64); vv[slot] = VSq[(st) * 8]; } while (0)
            __builtin_amdgcn_s_setprio(3);
            SCAN_LD(0, 0); SCAN_LD(1, 1); SCAN_LD(2, 2);
#pragma unroll
            for (int s = 0; s < 32; ++s) {
                if (s + 3 < 32) SCAN_LD((s + 3) & 3, s + 3);
                const f32x2 w = wv[s & 3], nk = nkv[s & 3], ka = kav[s & 3], kd = kdv[s & 3], rr = rrv[s & 3]; const float v = vv[s & 3];
                float pd = fmaf(S[1], nk[1], S[0] * nk[0]);
                pd = red16(pd); pd = swap16_add(pd);
                S[0] = fmaf(S[0], w[0], fmaf(pd, ka[0], v * kd[0]));
                S[1] = fmaf(S[1], w[1], fmaf(pd, ka[1], v * kd[1]));
                OPq[s * 256] = fmaf(S[1], rr[1], S[0] * rr[0]);
            }
            __builtin_amdgcn_s_setprio(0);
        }
        __syncthreads();
        {
            const float* op = OUTP + (tok * 8 + cg8) * 32;
            f32x4 a0 = *(const f32x4*)(op), a1 = *(const f32x4*)(op + 4), a2 = *(const f32x4*)(op + 8), a3 = *(const f32x4*)(op + 12);
            f32x4 b0 = *(const f32x4*)(op + 16), b1 = *(const f32x4*)(op + 20), b2 = *(const f32x4*)(op + 24), b3 = *(const f32x4*)(op + 28);
            a0 = ((a0 + a1) + (a2 + a3)) + ((b0 + b1) + (b2 + b3));
            oreg = (a0[0] + a0[1]) + (a0[2] + a0[3]);
        }
    }
    p.ydir[((size_t)d * M_ALL + grow_prev) * 256 + h * 64 + rsl * 8 + cg8] = oreg;
    if (!lat) *(f32x2*)(p.out + 20971520 + 2097152 + 524288 + stoff) = S;
    __syncthreads();
}

#define KS_STRIDE 104
#define VS_STRIDE 72
#define KS_BYTES (64 * KS_STRIDE * 2)
#define ATT_STAGE (KS_BYTES + 64 * VS_STRIDE * 2)
__device__ __forceinline__ void attn_unit(const P& p, int u, char* smem) {
    const int tid = opaque_tid(), lane = tid & 63, wid = tid >> 6, q = lane & 31, hf = lane >> 5;
    int b, h, qt, qrow0, krow0, nown, ntot, Tv; size_t vbase, vcbase = 0; int kcrow0 = 0;
    if (u < 1024) { b = u >> 8; h = (u >> 5) & 7; qt = u & 31; krow0 = M_CTX + b * 4096; qrow0 = krow0 + qt * 128; nown = 64; ntot = 72; Tv = 4096;
        vbase = 2097152 + (size_t)(b * 8 + h) * 64 * 4096; kcrow0 = b * 512; vcbase = (size_t)(b * 8 + h) * 64 * 512; }
    else { const int v = u - 1024; b = v >> 4; h = (v >> 1) & 7; qt = v & 1; krow0 = b * 256; qrow0 = krow0 + qt * 128; nown = 4; ntot = 4; Tv = 256; vbase = (size_t)(b * 8 + h) * 64 * 256; }
    bf16x8 qf[6];
    { const bf16_t* qp = p.Qb + (size_t)(qrow0 + wid * 32 + q) * 768 + h * 96 + hf * 8;
#pragma unroll
      for (int ks = 0; ks < 6; ++ks) qf[ks] = *(const bf16x8*)(qp + ks * 16); }
    f32x16 oT[2];
#pragma unroll
    for (int i = 0; i < 16; ++i) { oT[0][i] = 0.f; oT[1][i] = 0.f; }
    float mrun = -1e30f, lrun = 0.f;
    u32x4 rk[3], rv[2];
    int krow[3], kc[3];
#pragma unroll
    for (int i = 0; i < 3; ++i) { const int c = tid + 256 * i; krow[i] = c / 12; kc[i] = c % 12; }
    const int vdv0 = tid >> 3, vkc = tid & 7;
#define ATT_LOAD(kt) do { const bf16_t* kptr; const bf16_t* vptr; int vstr; \
        if ((kt) < nown) { kptr = p.Kb + (size_t)(krow0 + (kt) * 64) * 768 + h * 96; vptr = p.Vt + vbase + (kt) * 64; vstr = Tv; } \
        else { kptr = p.Kc + (size_t)(kcrow0 + ((kt) - nown) * 64) * 768 + h * 96; vptr = p.Vtc + vcbase + ((kt) - nown) * 64; vstr = 512; } \
        _Pragma("unroll") for (int i = 0; i < 3; ++i) rk[i] = *(const u32x4*)(kptr + (size_t)krow[i] * 768 + kc[i] * 8); \
        _Pragma("unroll") for (int i = 0; i < 2; ++i) rv[i] = *(const u32x4*)(vptr + (size_t)(vdv0 + 32 * i) * vstr + vkc * 8); } while (0)
#define ATT_STORE(buf) do { char* Ks_ = smem + (buf) * ATT_STAGE; char* Vs_ = Ks_ + KS_BYTES; \
        _Pragma("unroll") for (int i = 0; i < 3; ++i) *(u32x4*)(Ks_ + (krow[i] * KS_STRIDE + kc[i] * 8) * 2) = rk[i]; \
        _Pragma("unroll") for (int i = 0; i < 2; ++i) *(u32x4*)(Vs_ + ((vdv0 + 32 * i) * VS_STRIDE + vkc * 8) * 2) = rv[i]; } while (0)
    ATT_LOAD(0); ATT_STORE(0);
    __syncthreads();
    for (int kt = 0; kt < ntot; ++kt) {
        const bool more = kt + 1 < ntot;
        if (more) ATT_LOAD(kt + 1);
        const char* Ks = smem + (kt & 1) * ATT_STAGE; const char* Vs = Ks + KS_BYTES;
        f32x16 sT[2];
#pragma unroll
        for (int i = 0; i < 16; ++i) { sT[0][i] = 0.f; sT[1][i] = 0.f; }
#pragma unroll
        for (int kb = 0; kb < 2; ++kb)
#pragma unroll
            for (int ks = 0; ks < 6; ++ks) { const bf16x8 kf = *(const bf16x8*)(Ks + ((kb * 32 + q) * KS_STRIDE + ks * 16 + hf * 8) * 2);
                sT[kb] = __builtin_amdgcn_mfma_f32_32x32x16_bf16(kf, qf[ks], sT[kb], 0, 0, 0); }
        float mx = sT[0][0];
#pragma unroll
        for (int i = 1; i < 16; ++i) mx = fmaxf(mx, sT[0][i]);
#pragma unroll
        for (int i = 0; i < 16; ++i) mx = fmaxf(mx, sT[1][i]);
        mx = fmaxf(mx, __shfl_xor(mx, 32));
        const float mnew = fmaxf(mrun, mx); const float alpha = __builtin_amdgcn_exp2f(mrun - mnew); const bool resc = __any(mnew > mrun); mrun = mnew;
        float psum = 0.f; bf16x8 pf[2][2];
#pragma unroll
        for (int kb = 0; kb < 2; ++kb)
#pragma unroll
            for (int s = 0; s < 2; ++s) { float e[8];
#pragma unroll
                for (int j = 0; j < 8; ++j) { e[j] = __builtin_amdgcn_exp2f(sT[kb][8 * s + j] - mnew); psum += e[j]; }
                u32x4 w; w.x = pack2(e[0], e[1]); w.y = pack2(e[2], e[3]); w.z = pack2(e[4], e[5]); w.w = pack2(e[6], e[7]);
                pf[kb][s] = __builtin_bit_cast(bf16x8, w); }
        lrun = lrun * alpha + psum;
        if (resc) {
#pragma unroll
            for (int i = 0; i < 16; ++i) { oT[0][i] *= alpha; oT[1][i] *= alpha; }
        }
#pragma unroll
        for (int kb = 0; kb < 2; ++kb)
#pragma unroll
            for (int s = 0; s < 2; ++s)
#pragma unroll
                for (int db = 0; db < 2; ++db) {
                    const char* vp = Vs + ((db * 32 + q) * VS_STRIDE + kb * 32 + 16 * s + 4 * hf) * 2;
                    const u32x2 lo = *(const u32x2*)vp, hi = *(const u32x2*)(vp + 16);
                    const u32x4 w = (u32x4){lo.x, lo.y, hi.x, hi.y};
                    oT[db] = __builtin_amdgcn_mfma_f32_32x32x16_bf16(__builtin_bit_cast(bf16x8, w), pf[kb][s], oT[db], 0, 0, 0);
                }
        if (more) ATT_STORE((kt + 1) & 1);
        __syncthreads();
    }
    const float lt = lrun + __shfl_xor(lrun, 32); const float inv = 1.0f / lt;
    bf16_t* op = p.hbmix + (size_t)(qrow0 + wid * 32 + q) * DM + 256 + h * 64;
#pragma unroll
    for (int db = 0; db < 2; ++db)
#pragma unroll
        for (int g = 0; g < 4; ++g) { u32x2 w; w.x = pack2(oT[db][4 * g] * inv, oT[db][4 * g + 1] * inv); w.y = pack2(oT[db][4 * g + 2] * inv, oT[db][4 * g + 3] * inv);
            *(u32x2*)(op + db * 32 + 8 * g + 4 * hf) = w; }
}

__device__ __forceinline__ void rwcomb_phase(const P& p, int l) {
    const int tid = opaque_tid(), lane = tid & 63, wid = tid >> 6; const int c = lane * 4;
    const f32x4 gng = *(const f32x4*)(p.rw_gn_g + l * 256 + c), gnb = *(const f32x4*)(p.rw_gn_b + l * 256 + c), kap = *(const f32x4*)(p.rw_ka + l * 256 + c), rkp = *(const f32x4*)(p.rw_rk + l * 256 + c);
    for (int row = blockIdx.x * 4 + wid; row < M_ALL; row += gridDim.x * 4) {
        const f32x4 y0 = *(const f32x4*)(p.ydir + (size_t)row * 256 + c), y1 = *(const f32x4*)(p.ydir + ((size_t)M_ALL + row) * 256 + c);
        f32x4 y = y0 + y1;
        float s = (y[0] + y[1]) + (y[2] + y[3]); s = red16(s); const float mu = s * (1.0f / 64.0f);
        const f32x4 dd = y - mu; float q2 = (dd[0] * dd[0] + dd[1] * dd[1]) + (dd[2] * dd[2] + dd[3] * dd[3]); q2 = red16(q2);
        const float rstd = rsqrtf(q2 * (1.0f / 64.0f) + 64e-5f);
        const f32x4 yn = dd * rstd * gng + gnb;
        const u32x2 rw = *(const u32x2*)(p.RKV + (size_t)row * 768 + c), kw = *(const u32x2*)(p.RKV + (size_t)row * 768 + 256 + c), vw = *(const u32x2*)(p.RKV + (size_t)row * 768 + 512 + c);
        const u32x2 a0w = *(const u32x2*)(p.Aa + (size_t)row * 256 + c), a1w = *(const u32x2*)(p.Aa + ((size_t)M_ALL + row) * 256 + c), gw = *(const u32x2*)(p.Gg + (size_t)row * 256 + c);
        const f32x4 r = (f32x4){lo_bf(rw.x), hi_bf(rw.x), lo_bf(rw.y), hi_bf(rw.y)}, k = (f32x4){lo_bf(kw.x), hi_bf(kw.x), lo_bf(kw.y), hi_bf(kw.y)}, v = (f32x4){lo_bf(vw.x), hi_bf(vw.x), lo_bf(vw.y), hi_bf(vw.y)};
        const f32x4 a0 = (f32x4){lo_bf(a0w.x), hi_bf(a0w.x), lo_bf(a0w.y), hi_bf(a0w.y)}, a1 = (f32x4){lo_bf(a1w.x), hi_bf(a1w.x), lo_bf(a1w.y), hi_bf(a1w.y)}, gt = (f32x4){lo_bf(gw.x), hi_bf(gw.x), lo_bf(gw.y), hi_bf(gw.y)};
        const f32x4 kds = k * (1.0f + (a0 - 1.0f) * kap) + k * (1.0f + (a1 - 1.0f) * kap);
        const f32x4 t4 = r * kds * rkp; float rk = (t4[0] + t4[1]) + (t4[2] + t4[3]); rk = red16(rk);
        const f32x4 o = (yn + rk * v) * gt;
        u32x2 w; w.x = pack2(o[0], o[1]); w.y = pack2(o[2], o[3]);
        *(u32x2*)(p.hbmix + (size_t)row * DM + c) = w;
    }
}


__device__ __forceinline__ bool xcd_tile(int i, int TT, int NT, int& mt, int& nt) {
    const int per = TT >> 3; if (i >= per) return false;
    const int t = (blockIdx.x & 7) * per + i; const int band = t / (8 * NT), rem = t - band * 8 * NT;
    nt = rem >> 3; mt = band * 8 + (rem & 7); return true;
}
__global__ void __launch_bounds__(256, 2) mega(Args a_unused) {
    extern __shared__ __attribute__((aligned(16))) char smem[];
    __shared__ uint4 xbw; __shared__ int s_unit;
    kargp_t kp = (kargp_t)__builtin_amdgcn_kernarg_segment_ptr();
    const int tid = threadIdx.x; const int G = gridDim.x;
    if (tid == 0) xbw = make_uint4(0u, 0u, 0u, 0u);
    __syncthreads();
    XcdBarrier xb;
    { const P p = getP(kp); xb = xcd_barrier_post(p.bar, (volatile LAS unsigned*)&xbw); }
    for (int u = blockIdx.x; u < 384 + NCONV + 272; u += G) {
        if (u < 384) { const P p = getP(kp); ada_unit(p, u, smem); } else if (u < 384 + NCONV) { const P p = getP(kp); conv_unit(p, 0, u - 384, smem); } else { const P p = getP(kp); misc0_unit(p, u - 384 - NCONV); }
    }
    cg::this_grid().sync();
    { const P p = getP(kp); ln_phase(p, 0, 0); }
    xcd_barrier(xb);
    float* rs = (float*)(smem + RS_OFF);
#pragma unroll 1
    for (int l = 0; l < 4; ++l) {
        for (int i = blockIdx.x >> 3; ; i += G >> 3) { int mt, nt; if (!xcd_tile(i, 160 * 17, 17, mt, nt)) break; const P p = getP(kp);
            EpiZ e{p.Z, mt * 128, nt * 128};
            gemm128(p.hbmix + (size_t)mt * 128 * DM, DM, p.WtIn + (size_t)nt * 128 * DM, DM, DM, smem, e); }
        xcd_barrier(xb);
        for (int rep2 = 0; rep2 < DUP_P2; ++rep2) {
        for (;;) {
            { const P pc = getP(kp); if (tid == 0) s_unit = atomicAdd(&pc.ctr[l * 4 + 0 + 2 * rep2], 1); }
            __syncthreads(); int u = s_unit; __syncthreads();
            if (u >= 320 + 960 + 1408 + 2816 + 640) break;
            if (u < 320) { const P p = getP(kp); rwprep_unit(p, l, u, smem); continue; }
            u -= 320;
            if (u < 960) { const P p = getP(kp); const int mt = u / 6, nt = u % 6;
                rowscale128(p.Z, mt * 128, ZQ, 256, 1e-6f, rs);
                EpiQ e{p.Qb, rs, p.ropeC, p.ropeS, mt * 128, nt * 128};
                gemm128(p.Z + (size_t)mt * 128 * NIN + ZQ, NIN, p.WtQ + (size_t)nt * 128 * 256, 256, 256, smem, e); __syncthreads(); continue; }
            u -= 960;
            if (u < 1280) { const P p = getP(kp); const int mt = u >> 3, nt = u & 7; const int R0 = mt * 128; const bool latr = R0 >= M_CTX;
                rowscale128(p.Z, R0, ZKV, 128, 1e-6f, rs);
                EpiKV e{latr ? p.Kb + (size_t)M_CTX * 768 : p.Kb, p.Vt, rs, latr ? R0 - M_CTX : R0, nt * 128, latr ? 12 : 8, latr ? (size_t)2097152 : (size_t)0};
                gemm128(p.Z + (size_t)R0 * NIN + ZKV, NIN, p.WtKVn + (size_t)nt * 128 * 128, 128, 128, smem, e); __syncthreads(); continue; }
            u -= 1280;
            if (u < 128) { const P p = getP(kp); const int mt = u >> 3, nt = u & 7;
                EpiKV e{p.Kc, p.Vtc, nullptr, mt * 128, nt * 128, 9, (size_t)0};
                gemm128(p.CkvB + ((size_t)l * 2048 + mt * 128) * 128, 128, p.WtKV + (size_t)nt * 128 * 128, 128, 128, smem, e); continue; }
            u -= 128;
            if (u < 2816) { const P p = getP(kp); small_unit(p, l, u); continue; }
            u -= 2816;
            { const P p = getP(kp); gmlp_unit(p, l, u, smem); }
        }
        xcd_barrier(xb);
        }
        for (int rep3 = 0; rep3 < DUP_P3; ++rep3) {
        for (;;) {
            { const P pc = getP(kp); if (tid == 0) s_unit = atomicAdd(&pc.ctr[l * 4 + 1 + 2 * rep3], 1); }
            __syncthreads(); int u = s_unit; __syncthreads();
            if (u >= NSCAN + 1280) break;
#ifdef PROBE_SCAN_ONLY
            if (rep3 == 1 && u >= NSCAN) break;
#endif
#ifdef PROBE_ATTN_ONLY
            if (rep3 == 1 && u < NSCAN) continue;
#endif
            if (u < NSCAN) { const P p = getP(kp); scan_unit(p, l, u, smem); } else { const P p = getP(kp); attn_unit(p, u - NSCAN, smem); }
        }
        xcd_barrier(xb);
        }
        { const P p = getP(kp); rwcomb_phase(p, l); }
        xcd_barrier(xb);
        for (int i = blockIdx.x >> 3; ; i += G >> 3) { int mt, nt; if (!xcd_tile(i, 160 * 8, 8, mt, nt)) break; const P p = getP(kp);
            EpiRes e{p.out, p.mod + ((size_t)l * 5 + modrow_of(mt * 128)) * 6144 + 2048, mt * 128, nt * 128};
            gemm128(p.hbmix + (size_t)mt * 128 * DM, DM, p.WtOut + (size_t)nt * 128 * DM, DM, DM, smem, e); }
        xcd_barrier(xb);
        { const P p = getP(kp); ln_phase(p, l, 1); }
        xcd_barrier(xb);
        for (int rep5 = 0; rep5 < DUP_P5; ++rep5)
        for (int i = blockIdx.x >> 3; ; i += G >> 3) { int mt, nt; if (!xcd_tile(i, 160 * 44, 44, mt, nt)) break; const P p = getP(kp);
            EpiSwi e{p.hidden, mt * 128, nt * 128};
            gemm128(p.hbmix + (size_t)mt * 128 * DM, DM, p.WtF1 + (size_t)nt * 128 * DM, DM, DM, smem, e); }
        xcd_barrier(xb);
        for (int i = blockIdx.x >> 3; ; i += G >> 3) { int mt, nt; if (!xcd_tile(i, 160 * 8, 8, mt, nt)) break; const P p = getP(kp);
            EpiRes e{p.out, p.mod + ((size_t)l * 5 + modrow_of(mt * 128)) * 6144 + 5120, mt * 128, nt * 128};
            gemm128(p.hidden + (size_t)mt * 128 * DFF, DFF, p.WtF2 + (size_t)nt * 128 * DFF, DFF, DFF, smem, e); }
        xcd_barrier(xb);
        { const P p = getP(kp); ln_phase(p, l, 2); }
        if (l < 3) { for (int u = blockIdx.x; u < NCONV; u += G) { const P p = getP(kp); conv_unit(p, l + 1, u, smem); } }
        xcd_barrier(xb);
    }
}

extern "C" void kernel_launch(void* const* d_in, const int* in_sizes, int n_in, void* d_out, int out_size, void* d_ws, size_t ws_size, hipStream_t stream) {
    static int grid_blocks = 0;
    if (!grid_blocks) {
        int dev = 0, cus = 0, per_cu = 0;
        (void)hipGetDevice(&dev);
        (void)hipDeviceGetAttribute(&cus, hipDeviceAttributeMultiprocessorCount, dev);
        (void)hipFuncSetAttribute((const void*)mega, hipFuncAttributeMaxDynamicSharedMemorySize, SMEM_BYTES);
        (void)hipOccupancyMaxActiveBlocksPerMultiprocessor(&per_cu, (const void*)mega, 256, SMEM_BYTES);
        if (per_cu > 2) per_cu = 2;
        if (per_cu < 1) per_cu = 1;
        grid_blocks = (cus * per_cu) & ~7;
    }
    if (WS_TOTAL > ws_size) { fprintf(stderr, "kernel_launch: workspace too small: need %zu have %zu\n", (size_t)WS_TOTAL, ws_size); return; }
    Args a{};
    for (int i = 0; i < 36; ++i) a.in[i] = (const float*)d_in[i];
    a.out = (float*)d_out; a.ws = (char*)d_ws;
    (void)hipMemsetAsync((char*)d_ws + OFF_BAR, 0, 16384 + 4096, stream);
    void* args[] = {&a};
    hipError_t e = hipLaunchCooperativeKernel((const void*)mega, dim3(grid_blocks), dim3(256), args, SMEM_BYTES, stream);
    if (e != hipSuccess) fprintf(stderr, "cooperative launch failed: %s (grid %d)\n", hipGetErrorString(e), grid_blocks);
}
```

```cpp
#include <hip/hip_runtime.h>
#include <hip/hip_cooperative_groups.h>
#include <cstdint>
#include <cstdio>
namespace cg = cooperative_groups;

typedef unsigned short bf16_t;
typedef short bf16x8 __attribute__((ext_vector_type(8)));
typedef float f32x4 __attribute__((ext_vector_type(4)));
typedef float f32x2 __attribute__((ext_vector_type(2)));
typedef float f32x16 __attribute__((ext_vector_type(16)));
typedef unsigned u32x4 __attribute__((ext_vector_type(4)));
typedef unsigned u32x2 __attribute__((ext_vector_type(2)));

#define M_ALL 20480
#define M_CTX 4096
#define DM 1024
#define NIN 2080
#define DFF 2816
#define ALPHA_F 1.6817928305074290f
#define QSCALE (0.10206207261596575f * 1.4426950408889634f)
#define LAS __attribute__((address_space(3)))
#ifndef DUP_P2
#define DUP_P2 1
#endif
#ifndef DUP_P3
#define DUP_P3 1
#endif
#ifndef DUP_P5
#define DUP_P5 1
#endif

#define ZQ 1152
#define ZKV 1408
#define ZKR 1536
#define ZU 1568
#define ZV 1824

#define LDS_STRIDE 72
#define TILE_BYTES (128 * LDS_STRIDE * 2)
#define RS_OFF (4 * TILE_BYTES)
#define SMEM_BYTES (RS_OFF + 3072)

struct P {
    const float *x_prompt, *x_sample, *cache_ckv, *cache_krope, *state_rwkv, *c, *c_ctx, *ada_w, *ada_b, *w_in, *rw_conv, *rw_w0, *rw_w2,
        *rw_a0, *rw_a2, *rw_g2, *rw_kk, *rw_ka, *rw_rk, *rw_gn_g, *rw_gn_b, *q_norm, *q_up, *kv_norm, *kv_up, *gm_g, *gm_b, *gm_ws, *gm_bs,
        *w_out, *ln1_g, *ln1_b, *ffn_in, *ffn_out, *ln2_g, *ln2_b;
    float* out;
    unsigned* bar; int* ctr; float* mod; float* ropeC; float* ropeS; bf16_t* CkvB;
    bf16_t *WtIn, *WtQ, *WtKVn, *WtKV, *WtOut, *WtF1, *WtF2, *WsB, *W2t, *A2t, *G2t;
    bf16_t *Z, *RKV, *Ee, *Aa, *Gg, *Qb, *Kb, *Kc, *Vt, *Vtc, *hbmix, *hidden;
    float* ydir;
};


struct Args { const float* in[36]; float* out; char* ws; };
typedef const __attribute__((address_space(4))) char* kargp_t;
constexpr size_t al256(size_t x) { return (x + 255) & ~(size_t)255; }
constexpr size_t OFF_BAR = 0;
constexpr size_t OFF_CTR = OFF_BAR + 16384;
constexpr size_t OFF_MOD = OFF_CTR + 4096;
constexpr size_t OFF_ROPEC = OFF_MOD + al256((size_t)4 * 5 * 6144 * 4);
constexpr size_t OFF_ROPES = OFF_ROPEC + 65536 * 4;
constexpr size_t OFF_CKVB = OFF_ROPES + 65536 * 4;
constexpr size_t OFF_WTIN = OFF_CKVB + (size_t)4 * 2048 * 128 * 2;
constexpr size_t OFF_WTQ = OFF_WTIN + (size_t)2176 * 1024 * 2;
constexpr size_t OFF_WTKVN = OFF_WTQ + (size_t)768 * 256 * 2;
constexpr size_t OFF_WTKV = OFF_WTKVN + (size_t)1024 * 128 * 2;
constexpr size_t OFF_WTOUT = OFF_WTKV + (size_t)1024 * 128 * 2;
constexpr size_t OFF_WTF1 = OFF_WTOUT + (size_t)1024 * 1024 * 2;
constexpr size_t OFF_WTF2 = OFF_WTF1 + (size_t)5632 * 1024 * 2;
constexpr size_t OFF_WSB = OFF_WTF2 + (size_t)1024 * DFF * 2;
constexpr size_t OFF_W2T = OFF_WSB + (size_t)65536 * 2;
constexpr size_t OFF_A2T = OFF_W2T + (size_t)2 * 256 * 64 * 2;
constexpr size_t OFF_G2T = OFF_A2T + (size_t)2 * 256 * 64 * 2;
constexpr size_t OFF_Z = OFF_G2T + (size_t)256 * 128 * 2;
constexpr size_t OFF_HIDDEN = OFF_Z;
constexpr size_t OFF_RKV = OFF_Z + al256((size_t)M_ALL * NIN * 2);
constexpr size_t OFF_EE = OFF_RKV + (size_t)M_ALL * 768 * 2;
constexpr size_t OFF_AA = OFF_EE + (size_t)2 * M_ALL * 256 * 2;
constexpr size_t OFF_GG = OFF_AA + (size_t)2 * M_ALL * 256 * 2;
constexpr size_t OFF_QB = OFF_GG + (size_t)M_ALL * 256 * 2;
constexpr size_t OFF_KB = OFF_QB + (size_t)M_ALL * 768 * 2;
constexpr size_t OFF_KC = OFF_KB + (size_t)M_ALL * 768 * 2;
constexpr size_t OFF_VT = OFF_KC + (size_t)2048 * 768 * 2;
constexpr size_t OFF_VTC = OFF_VT + (size_t)M_ALL * 512 * 2;
constexpr size_t OFF_YDIR = OFF_VTC + (size_t)2048 * 512 * 2;
constexpr size_t OFF_HBMIX = OFF_YDIR + (size_t)2 * M_ALL * 256 * 4;
constexpr size_t WS_TOTAL = OFF_HBMIX + (size_t)M_ALL * DM * 2;
static_assert(OFF_RKV + (size_t)M_ALL * 768 * 2 - OFF_HIDDEN >= (size_t)M_ALL * DFF * 2, "hidden overlay");

__device__ __forceinline__ P getP(kargp_t& kp) {
    asm volatile("" : "+s"(kp));
    typedef const float* const __attribute__((address_space(4)))* inp_t;
    inp_t in = (inp_t)kp;
    P p;
    p.x_prompt = in[0]; p.x_sample = in[1]; p.cache_ckv = in[2]; p.cache_krope = in[3]; p.state_rwkv = in[4]; p.c = in[5]; p.c_ctx = in[6];
    p.ada_w = in[7]; p.ada_b = in[8]; p.w_in = in[9]; p.rw_conv = in[10]; p.rw_w0 = in[11]; p.rw_w2 = in[12]; p.rw_a0 = in[13]; p.rw_a2 = in[14];
    p.rw_g2 = in[15]; p.rw_kk = in[16]; p.rw_ka = in[17]; p.rw_rk = in[18]; p.rw_gn_g = in[19]; p.rw_gn_b = in[20]; p.q_norm = in[21]; p.q_up = in[22];
    p.kv_norm = in[23]; p.kv_up = in[24]; p.gm_g = in[25]; p.gm_b = in[26]; p.gm_ws = in[27]; p.gm_bs = in[28]; p.w_out = in[29]; p.ln1_g = in[30];
    p.ln1_b = in[31]; p.ffn_in = in[32]; p.ffn_out = in[33]; p.ln2_g = in[34]; p.ln2_b = in[35];
    p.out = (float*)in[36]; char* ws = (char*)in[37];
    p.bar = (unsigned*)(ws + OFF_BAR); p.ctr = (int*)(ws + OFF_CTR); p.mod = (float*)(ws + OFF_MOD); p.ropeC = (float*)(ws + OFF_ROPEC); p.ropeS = (float*)(ws + OFF_ROPES);
    p.CkvB = (bf16_t*)(ws + OFF_CKVB); p.WtIn = (bf16_t*)(ws + OFF_WTIN); p.WtQ = (bf16_t*)(ws + OFF_WTQ); p.WtKVn = (bf16_t*)(ws + OFF_WTKVN); p.WtKV = (bf16_t*)(ws + OFF_WTKV);
    p.WtOut = (bf16_t*)(ws + OFF_WTOUT); p.WtF1 = (bf16_t*)(ws + OFF_WTF1); p.WtF2 = (bf16_t*)(ws + OFF_WTF2); p.WsB = (bf16_t*)(ws + OFF_WSB); p.W2t = (bf16_t*)(ws + OFF_W2T);
    p.A2t = (bf16_t*)(ws + OFF_A2T); p.G2t = (bf16_t*)(ws + OFF_G2T); p.Z = (bf16_t*)(ws + OFF_Z); p.RKV = (bf16_t*)(ws + OFF_RKV); p.Ee = (bf16_t*)(ws + OFF_EE); p.Aa = (bf16_t*)(ws + OFF_AA);
    p.Gg = (bf16_t*)(ws + OFF_GG); p.Qb = (bf16_t*)(ws + OFF_QB); p.Kb = (bf16_t*)(ws + OFF_KB); p.Kc = (bf16_t*)(ws + OFF_KC); p.Vt = (bf16_t*)(ws + OFF_VT); p.Vtc = (bf16_t*)(ws + OFF_VTC);
    p.hbmix = (bf16_t*)(ws + OFF_HBMIX); p.hidden = (bf16_t*)(ws + OFF_HIDDEN); p.ydir = (float*)(ws + OFF_YDIR);
    return p;
}

__device__ __forceinline__ float bf2f(bf16_t b) { return __uint_as_float(((unsigned)b) << 16); }
__device__ __forceinline__ unsigned pack2(float lo, float hi) { unsigned r; asm("v_cvt_pk_bf16_f32 %0, %1, %2" : "=v"(r) : "v"(lo), "v"(hi)); return r; }
__device__ __forceinline__ bf16_t f2bf(float f) { return (bf16_t)(pack2(f, 0.f) & 0xffffu); }
__device__ __forceinline__ float lo_bf(unsigned w) { return __uint_as_float(w << 16); }
__device__ __forceinline__ float hi_bf(unsigned w) { return __uint_as_float(w & 0xffff0000u); }
__device__ __forceinline__ float sigmoidf_(float x) { return __builtin_amdgcn_rcpf(1.0f + __builtin_amdgcn_exp2f(-1.4426950408889634f * x)); }
__device__ __forceinline__ float tanhf_(float x) { float e = __builtin_amdgcn_exp2f(2.8853900817779268f * x); return 1.0f - 2.0f * __builtin_amdgcn_rcpf(e + 1.0f); }
__device__ __forceinline__ float geluf_(float x) { return 0.5f * x * (1.0f + tanhf_(0.7978845608028654f * (x + 0.044715f * x * x * x))); }
template <int CTRL> __device__ __forceinline__ float dpp_add(float x) {
    int y = __builtin_amdgcn_update_dpp(0, __float_as_int(x), CTRL, 0xf, 0xf, false);
    return x + __int_as_float(y);
}
__device__ __forceinline__ float red4(float x) { x = dpp_add<0xB1>(x); x = dpp_add<0x4E>(x); return x; }
__device__ __forceinline__ float red8(float x) { x = red4(x); x = dpp_add<0x141>(x); return x; }
__device__ __forceinline__ float red16(float x) { x = red8(x); x = dpp_add<0x140>(x); return x; }
__device__ __forceinline__ int opaque_tid() { int t = threadIdx.x; asm volatile("" : "+v"(t)); return t; }
__device__ __forceinline__ int modrow_of(int row) { return row < M_CTX ? 0 : 1 + ((row - M_CTX) >> 12); }

#define XB_TMO 128
#define XB_XCNT(j) (256 + 64 * (j))
#define XB_XSUB(j) (1280 + 64 * (j))
#define XB_XGEN(j) (2304 + 64 * (j))
#define XB_TOP 3328
#define XB_TOPGEN 3392
#define XCD_BAR_WORDS 3456
#define XB_SPIN_CAP (1u << 22)
__device__ __forceinline__ unsigned xb_ld(unsigned* p) { return __hip_atomic_load(p, __ATOMIC_RELAXED, __HIP_MEMORY_SCOPE_AGENT); }
__device__ __forceinline__ unsigned xb_add(unsigned* p, unsigned v) { return __hip_atomic_fetch_add(p, v, __ATOMIC_RELAXED, __HIP_MEMORY_SCOPE_AGENT); }
__device__ __forceinline__ unsigned xb_xcc_id() { return (unsigned)__builtin_amdgcn_s_getreg((3 << 11) | 20) & 0xFu; }
#define XB_SPIN(cond, bar) do { unsigned _sp = 0; while (cond) { __builtin_amdgcn_s_sleep(1); \
    if ((++_sp & 255u) == 0u) { if (xb_ld(&(bar)[XB_TMO])) break; if (_sp > XB_SPIN_CAP) { atomicAdd(&(bar)[XB_TMO], 1u); break; } } } } while (0)
struct XcdBarrier { unsigned* bar; unsigned x; volatile LAS unsigned* st; };
__device__ __forceinline__ XcdBarrier xcd_barrier_post(unsigned* bar, volatile LAS unsigned* st) {
    XcdBarrier b; b.bar = bar; b.x = xb_xcc_id(); b.st = st;
    if (threadIdx.x == 0) (void)xb_add(&bar[XB_XCNT(b.x)], 1u);
    return b;
}
__device__ __forceinline__ void xcd_barrier_complete(unsigned* bar, unsigned x, unsigned& nloc, unsigned& nx) {
    const unsigned G = gridDim.x * gridDim.y * gridDim.z;
    unsigned sum, cnt, mine, sp = 0u;
    for (;;) {
        sum = 0u; cnt = 0u; mine = 0u;
#pragma unroll
        for (unsigned j = 0; j < 16; ++j) { const unsigned c = xb_ld(&bar[XB_XCNT(j)]); sum += c; cnt += (c > 0u) ? 1u : 0u; mine = (j == x) ? c : mine; }
        if (sum == G) break;
        __builtin_amdgcn_s_sleep(1);
        if ((++sp & 255u) == 0u) { if (xb_ld(&bar[XB_TMO])) break; if (sp > XB_SPIN_CAP) { atomicAdd(&bar[XB_TMO], 1u); break; } }
    }
    nloc = mine > 0u ? mine : 1u; nx = cnt > 0u ? cnt : 1u;
}
__device__ __forceinline__ void xcd_barrier(const XcdBarrier& b) {
    asm volatile("s_waitcnt vmcnt(0)" ::: "memory");
    __syncthreads();
    if (threadIdx.x == 0) {
        unsigned* bar = b.bar;
        __builtin_amdgcn_s_waitcnt(0);
        unsigned nloc = b.st[0], nx = b.st[1];
        if (nloc == 0u) { xcd_barrier_complete(bar, b.x, nloc, nx); b.st[0] = nloc; b.st[1] = nx; }
        const unsigned old = xb_add(&bar[XB_XSUB(b.x)], 1u);
        const unsigned gen = old / nloc;
        if (old + 1u == (gen + 1u) * nloc) {
            __builtin_amdgcn_fence(__ATOMIC_RELEASE, "agent");
            asm volatile("s_waitcnt vmcnt(0)" ::: "memory");
            const unsigned og = xb_add(&bar[XB_TOP], 1u);
            const unsigned tg = og / nx;
            if (og + 1u == (tg + 1u) * nx) xb_add(&bar[XB_TOPGEN], 1u);
            else XB_SPIN(xb_ld(&bar[XB_TOPGEN]) == tg, bar);
            __builtin_amdgcn_fence(__ATOMIC_ACQUIRE, "agent");
            xb_add(&bar[XB_XGEN(b.x)], 1u);
            asm volatile("s_waitcnt vmcnt(0)" ::: "memory");
        } else {
            XB_SPIN(xb_ld(&bar[XB_XGEN(b.x)]) == gen, bar);
            __builtin_amdgcn_fence(__ATOMIC_ACQUIRE, "agent");
            asm volatile("s_waitcnt vmcnt(0)" ::: "memory");
        }
    }
    __syncthreads();
}

template <class Epi>
__device__ __forceinline__ void gemm128(const bf16_t* __restrict__ A, int lda, const bf16_t* __restrict__ B, int ldb, int K, char* smem, const Epi& epi) {
    const int tid = opaque_tid(), lane = tid & 63, wid = tid >> 6, wr = wid >> 1, wc = wid & 1, fr = lane & 15, fq = lane >> 4;
    f32x4 acc[4][4];
#pragma unroll
    for (int m = 0; m < 4; ++m)
#pragma unroll
        for (int n = 0; n < 4; ++n) acc[m][n] = (f32x4){0.f, 0.f, 0.f, 0.f};
    const int crow = tid >> 3, ckc = tid & 7;
    const bf16_t* ap = A + (size_t)crow * lda + ckc * 8;
    const bf16_t* bp = B + (size_t)crow * ldb + ckc * 8;
    u32x4 ra[4], rb[4];
#pragma unroll
    for (int i = 0; i < 4; ++i) { ra[i] = *(const u32x4*)(ap + (size_t)(32 * i) * lda); rb[i] = *(const u32x4*)(bp + (size_t)(32 * i) * ldb); }
    {
        char* sa = smem; char* sb = smem + TILE_BYTES;
#pragma unroll
        for (int i = 0; i < 4; ++i) { *(u32x4*)(sa + ((crow + 32 * i) * LDS_STRIDE + ckc * 8) * 2) = ra[i]; *(u32x4*)(sb + ((crow + 32 * i) * LDS_STRIDE + ckc * 8) * 2) = rb[i]; }
    }
    __syncthreads();
    const int nk = K >> 6;
    for (int kt = 0; kt < nk; ++kt) {
        const bool more = (kt + 1 < nk);
        if (more) {
            const int k0 = (kt + 1) << 6;
#pragma unroll
            for (int i = 0; i < 4; ++i) { ra[i] = *(const u32x4*)(ap + (size_t)(32 * i) * lda + k0); rb[i] = *(const u32x4*)(bp + (size_t)(32 * i) * ldb + k0); }
        }
        const char* sa = smem + (kt & 1) * 2 * TILE_BYTES; const char* sb = sa + TILE_BYTES;
#pragma unroll
        for (int ks = 0; ks < 2; ++ks) {
            bf16x8 af[4], bfr[4];
#pragma unroll
            for (int m = 0; m < 4; ++m) af[m] = *(const bf16x8*)(sa + ((wr * 64 + m * 16 + fr) * LDS_STRIDE + ks * 32 + fq * 8) * 2);
#pragma unroll
            for (int n = 0; n < 4; ++n) bfr[n] = *(const bf16x8*)(sb + ((wc * 64 + n * 16 + fr) * LDS_STRIDE + ks * 32 + fq * 8) * 2);
            __builtin_amdgcn_s_setprio(1);
#pragma unroll
            for (int m = 0; m < 4; ++m)
#pragma unroll
                for (int n = 0; n < 4; ++n) acc[m][n] = __builtin_amdgcn_mfma_f32_16x16x32_bf16(af[m], bfr[n], acc[m][n], 0, 0, 0);
            __builtin_amdgcn_s_setprio(0);
        }
        if (more) {
            char* da = smem + ((kt + 1) & 1) * 2 * TILE_BYTES; char* db = da + TILE_BYTES;
#pragma unroll
            for (int i = 0; i < 4; ++i) { *(u32x4*)(da + ((crow + 32 * i) * LDS_STRIDE + ckc * 8) * 2) = ra[i]; *(u32x4*)(db + ((crow + 32 * i) * LDS_STRIDE + ckc * 8) * 2) = rb[i]; }
        }
        __syncthreads();
    }
    epi(acc, wr * 64, wc * 64, fr, fq);
}

struct EpiZ {
    bf16_t* Z; int R0, C0;
    __device__ __forceinline__ void operator()(f32x4 (&acc)[4][4], int r0, int c0, int fr, int fq) const {
#pragma unroll
        for (int n = 0; n < 4; ++n) { const int col = C0 + c0 + n * 16 + fr; if (col < NIN) {
#pragma unroll
            for (int m = 0; m < 4; ++m)
#pragma unroll
                for (int j = 0; j < 4; ++j) Z[(size_t)(R0 + r0 + m * 16 + fq * 4 + j) * NIN + col] = f2bf(acc[m][n][j]); } }
    }
};
struct EpiQ {
    bf16_t* Q; const float* rs; const float* ropeC; const float* ropeS; int R0, C0;
    __device__ __forceinline__ void operator()(f32x4 (&acc)[4][4], int r0, int c0, int fr, int fq) const {
        const bool lat = R0 >= M_CTX;
#pragma unroll
        for (int n = 0; n < 4; ++n) {
            const int cb = C0 + c0 + n * 16; const int hcs = cb % 96;
            if (lat && hcs == 80) continue;
            const bool rot = lat && hcs == 64;
#pragma unroll
            for (int m = 0; m < 4; ++m)
#pragma unroll
                for (int j = 0; j < 4; ++j) {
                    const int rl = r0 + m * 16 + fq * 4 + j; const int row = R0 + rl; const float s = rs[rl] * QSCALE;
                    const float x1 = acc[m][n][j] * s;
                    if (rot) {
                        const float x2 = acc[m][(n + 1) & 3][j] * s; const int t = (row - M_CTX) & 4095;
                        const float cv = ropeC[t * 16 + fr], sv = ropeS[t * 16 + fr];
                        Q[(size_t)row * 768 + cb + fr] = f2bf(x1 * cv - x2 * sv);
                        Q[(size_t)row * 768 + cb + 16 + fr] = f2bf(x1 * sv + x2 * cv);
                    } else Q[(size_t)row * 768 + cb + fr] = f2bf(x1);
                }
        }
    }
};
struct EpiKV {
    bf16_t* Kd; bf16_t* Vd; const float* rs; int R0, C0; int seqshift; size_t vbase0;
    __device__ __forceinline__ void operator()(f32x4 (&acc)[4][4], int r0, int c0, int fr, int fq) const {
#pragma unroll
        for (int n = 0; n < 4; ++n) {
            const int col = C0 + c0 + n * 16 + fr;
#pragma unroll
            for (int m = 0; m < 4; ++m) {
                const int rl = r0 + m * 16 + fq * 4; const int row = R0 + rl;
                float v[4];
#pragma unroll
                for (int j = 0; j < 4; ++j) v[j] = acc[m][n][j] * (rs ? rs[rl + j] : 1.0f);
                if (col < 512) {
                    const int h = col >> 6, d = col & 63;
#pragma unroll
                    for (int j = 0; j < 4; ++j) Kd[(size_t)(row + j) * 768 + h * 96 + d] = f2bf(v[j]);
                } else {
                    const int vc = col - 512, h = vc >> 6, dv = vc & 63; const int b = row >> seqshift, t = row & ((1 << seqshift) - 1);
                    u32x2 w; w.x = pack2(v[0], v[1]); w.y = pack2(v[2], v[3]);
                    *(u32x2*)(Vd + vbase0 + ((size_t)((b * 8 + h) * 64 + dv) << seqshift) + t) = w;
                }
            }
        }
    }
};
struct EpiRes {
    float* X; const float* gate; int R0, C0;
    __device__ __forceinline__ void operator()(f32x4 (&acc)[4][4], int r0, int c0, int fr, int fq) const {
#pragma unroll
        for (int n = 0; n < 4; ++n) { const int col = C0 + c0 + n * 16 + fr; const float g = gate[col];
#pragma unroll
            for (int m = 0; m < 4; ++m)
#pragma unroll
                for (int j = 0; j < 4; ++j) { float* px = X + (size_t)(R0 + r0 + m * 16 + fq * 4 + j) * DM + col; *px = ALPHA_F * (*px) + g * acc[m][n][j]; } }
    }
};
struct EpiSwi {
    bf16_t* H; int R0, C0;
    __device__ __forceinline__ void operator()(f32x4 (&acc)[4][4], int r0, int c0, int fr, int fq) const {
        const int hb = (C0 + c0) >> 1;
#pragma unroll
        for (int n = 0; n < 2; ++n)
#pragma unroll
            for (int m = 0; m < 4; ++m)
#pragma unroll
                for (int j = 0; j < 4; ++j) { const float g = acc[m][n][j], u = acc[m][n + 2][j];
                    H[(size_t)(R0 + r0 + m * 16 + fq * 4 + j) * DFF + hb + n * 16 + fr] = f2bf(g * sigmoidf_(g) * u); }
    }
};

__device__ __forceinline__ void ada_unit(const P& p, int u, char* smem) {
    const int tid = opaque_tid(); const int l = u / 96, c0 = (u % 96) * 64;
    float* cs = (float*)smem;
    for (int i = tid; i < 5 * 1024; i += 256) { const int r = i >> 10, k = i & 1023; const float v = (r == 0) ? p.c_ctx[k] : p.c[(r - 1) * 1024 + k]; cs[i] = v * sigmoidf_(v); }
    __syncthreads();
    const int col = tid & 63, kq = tid >> 6;
    float s0 = 0.f, s1 = 0.f, s2 = 0.f, s3 = 0.f, s4 = 0.f;
    const float* w = p.ada_w + ((size_t)l * 1024 + kq * 256) * 6144 + c0 + col;
    const float* cq = cs + kq * 256;
    for (int k = 0; k < 256; ++k) { const float wv = w[(size_t)k * 6144]; s0 += cq[k] * wv; s1 += cq[1024 + k] * wv; s2 += cq[2048 + k] * wv; s3 += cq[3072 + k] * wv; s4 += cq[4096 + k] * wv; }
    float* red = cs + 5 * 1024;
    red[(kq * 5 + 0) * 64 + col] = s0; red[(kq * 5 + 1) * 64 + col] = s1; red[(kq * 5 + 2) * 64 + col] = s2; red[(kq * 5 + 3) * 64 + col] = s3; red[(kq * 5 + 4) * 64 + col] = s4;
    __syncthreads();
    for (int o = tid; o < 320; o += 256) { const int i = o >> 6, cc = o & 63;
        const float v = red[(0 * 5 + i) * 64 + cc] + red[(1 * 5 + i) * 64 + cc] + red[(2 * 5 + i) * 64 + cc] + red[(3 * 5 + i) * 64 + cc] + p.ada_b[l * 6144 + c0 + cc];
        p.mod[((size_t)l * 5 + i) * 6144 + c0 + cc] = v; }
    __syncthreads();
}
__device__ __forceinline__ int map_col(int kind, int n) {
    if (kind == 1) { const int blk = n >> 6, r = n & 63; return r < 32 ? blk * 32 + r : DFF + blk * 32 + (r - 32); }
    if (kind == 2) { if (n < 512) return (n >> 6) * 128 + (n & 63); const int vc = n - 512; return (vc >> 6) * 128 + 64 + (vc & 63); }
    return n;
}
__device__ __forceinline__ void conv_tile(const float* src, int ldsrc, bf16_t* dst, bf16_t* dst2, int Kdst, int n0, int k0, int kind, int Nvalid, const float* kscale, char* smem) {
    const int tid = opaque_tid(); float* tile = (float*)smem;
    { const int j = tid & 63, i0 = tid >> 6; const int n = n0 + j; const int sc = (n < Nvalid) ? map_col(kind, n) : -1;
#pragma unroll 4
      for (int ii = 0; ii < 16; ++ii) { const int i = i0 + 4 * ii; tile[i * 65 + j] = (sc >= 0) ? src[(size_t)(k0 + i) * ldsrc + sc] : 0.f; } }
    __syncthreads();
    { const int i = tid & 63, j0 = tid >> 6; const float ks = kscale ? kscale[k0 + i] : 1.f;
#pragma unroll 4
      for (int jj = 0; jj < 16; ++jj) { const int jx = j0 + 4 * jj; const float v = tile[i * 65 + jx];
          dst[(size_t)(n0 + jx) * Kdst + k0 + i] = f2bf(v * ks); if (dst2) dst2[(size_t)(n0 + jx) * Kdst + k0 + i] = f2bf(v); } }
    __syncthreads();
}
#define NCONV 3032
__device__ __forceinline__ void conv_unit(const P& p, int l, int u, char* smem) {
    const float* src; int ldsrc; bf16_t* dst; bf16_t* dst2 = nullptr; int Kdst, n0, k0, kind = 0, Nvalid; const float* kscale = nullptr;
    if (u < 544) { src = p.w_in + (size_t)l * 1024 * NIN; ldsrc = NIN; dst = p.WtIn; Kdst = 1024; n0 = (u / 16) * 64; k0 = (u % 16) * 64; Nvalid = NIN; }
    else if (u < 592) { u -= 544; src = p.q_up + (size_t)l * 256 * 768; ldsrc = 768; dst = p.WtQ; Kdst = 256; n0 = (u / 4) * 64; k0 = (u % 4) * 64; Nvalid = 768; kscale = p.q_norm + l * 256; }
    else if (u < 624) { u -= 592; src = p.kv_up + (size_t)l * 128 * 1024; ldsrc = 1024; dst = p.WtKVn; dst2 = p.WtKV; Kdst = 128; n0 = (u / 2) * 64; k0 = (u % 2) * 64; kind = 2; Nvalid = 1024; kscale = p.kv_norm + l * 128; }
    else if (u < 880) { u -= 624; src = p.w_out + (size_t)l * 1024 * 1024; ldsrc = 1024; dst = p.WtOut; Kdst = 1024; n0 = (u / 16) * 64; k0 = (u % 16) * 64; Nvalid = 1024; }
    else if (u < 2288) { u -= 880; src = p.ffn_in + (size_t)l * 1024 * 5632; ldsrc = 5632; dst = p.WtF1; Kdst = 1024; n0 = (u / 16) * 64; k0 = (u % 16) * 64; kind = 1; Nvalid = 5632; }
    else if (u < 2992) { u -= 2288; src = p.ffn_out + (size_t)l * DFF * 1024; ldsrc = 1024; dst = p.WtF2; Kdst = DFF; n0 = (u / 44) * 64; k0 = (u % 44) * 64; Nvalid = 1024; }
    else if (u < 3008) { u -= 2992; const float* sp = p.gm_ws + (size_t)l * 65536 + u * 4096; bf16_t* d = p.WsB + u * 4096; for (int i = threadIdx.x; i < 4096; i += 256) d[i] = f2bf(sp[i]); return; }
    else if (u < 3016) { u -= 3008; const int d = u >> 2; src = p.rw_w2 + ((size_t)l * 2 + d) * 64 * 256; ldsrc = 256; dst = p.W2t + d * 256 * 64; Kdst = 64; n0 = (u & 3) * 64; k0 = 0; Nvalid = 256; }
    else if (u < 3024) { u -= 3016; const int d = u >> 2; src = p.rw_a2 + ((size_t)l * 2 + d) * 64 * 256; ldsrc = 256; dst = p.A2t + d * 256 * 64; Kdst = 64; n0 = (u & 3) * 64; k0 = 0; Nvalid = 256; }
    else { u -= 3024; src = p.rw_g2 + (size_t)l * 128 * 256; ldsrc = 256; dst = p.G2t; Kdst = 128; n0 = (u / 2) * 64; k0 = (u % 2) * 64; Nvalid = 256; }
    conv_tile(src, ldsrc, dst, dst2, Kdst, n0, k0, kind, Nvalid, kscale, smem);
}
__device__ __forceinline__ void misc0_unit(const P& p, int u) {
    const int tid = opaque_tid();
    if (u < 16) {
        for (int e = tid; e < 4096; e += 256) { const int idx = u * 4096 + e; const int t = idx >> 4, i = idx & 15;
            const float pos = (float)((i < 8) ? (t >> 6) : (t & 63)); const float inv = exp2f(-(float)(i & 7) * 1.6609640474436813f);
            const float ang = pos * inv; const float kf = rintf(ang * 0.15915494309189535f);
            float r = fmaf(-kf, 6.28318548202514648f, ang); r = fmaf(-kf, -1.74845553e-7f, r);
            p.ropeC[idx] = __cosf(r); p.ropeS[idx] = __sinf(r); }
    } else {
        const int v = u - 16;
        for (int e = tid; e < 4096; e += 256) { const int idx = v * 4096 + e;
            const int c = idx & 127, t = (idx >> 7) & 511, b = (idx >> 16) & 3, l = idx >> 18;
            p.CkvB[idx] = f2bf(p.cache_ckv[(((size_t)b * 4 + l) * 512 + t) * 128 + c]); }
    }
}

__device__ __forceinline__ void ln_phase(const P& p, int l, int which) {
    const int tid = opaque_tid(), lane = tid & 63, wid = tid >> 6;
    const float* g = which == 1 ? p.ln1_g + l * DM : p.ln2_g + l * DM; const float* bb = which == 1 ? p.ln1_b + l * DM : p.ln2_b + l * DM;
    const int ml = which == 2 ? l + 1 : l; const int shoff = which == 1 ? 3072 : 0, scoff = which == 1 ? 4096 : 1024;
    const bool dohb = !(which == 2 && l == 3);
    for (int row = blockIdx.x * 4 + wid; row < M_ALL; row += gridDim.x * 4) {
        float* xr = p.out + (size_t)row * DM;
        const float* src = which == 0 ? (row < M_CTX ? p.x_prompt + (size_t)row * DM : p.x_sample + (size_t)(row - M_CTX) * DM) : xr;
        f32x4 v[4];
#pragma unroll
        for (int i = 0; i < 4; ++i) v[i] = *(const f32x4*)(src + lane * 4 + 256 * i);
        if (which != 0) {
            float s = 0.f;
#pragma unroll
            for (int i = 0; i < 4; ++i) s += (v[i][0] + v[i][1]) + (v[i][2] + v[i][3]);
            s = red16(s); s += __shfl_xor(s, 16); s += __shfl_xor(s, 32);
            const float mu = s * (1.0f / 1024.0f); float q = 0.f;
#pragma unroll
            for (int i = 0; i < 4; ++i) { const f32x4 d = v[i] - mu; q += (d[0] * d[0] + d[1] * d[1]) + (d[2] * d[2] + d[3] * d[3]); }
            q = red16(q); q += __shfl_xor(q, 16); q += __shfl_xor(q, 32);
            const float rstd = rsqrtf(q * (1.0f / 1024.0f) + 1e-5f);
#pragma unroll
            for (int i = 0; i < 4; ++i) { const f32x4 gg = *(const f32x4*)(g + lane * 4 + 256 * i), bv = *(const f32x4*)(bb + lane * 4 + 256 * i); v[i] = (v[i] - mu) * rstd * gg + bv; }
        }
#pragma unroll
        for (int i = 0; i < 4; ++i) *(f32x4*)(xr + lane * 4 + 256 * i) = v[i];
        if (dohb) {
            const float* md = p.mod + ((size_t)ml * 5 + modrow_of(row)) * 6144;
#pragma unroll
            for (int i = 0; i < 4; ++i) { const f32x4 sh = *(const f32x4*)(md + shoff + lane * 4 + 256 * i), sc = *(const f32x4*)(md + scoff + lane * 4 + 256 * i);
                const f32x4 h = v[i] * (1.0f + sc) + sh; u32x2 w; w.x = pack2(h[0], h[1]); w.y = pack2(h[2], h[3]);
                *(u32x2*)(p.hbmix + (size_t)row * DM + lane * 4 + 256 * i) = w; }
        }
    }
}

__device__ __forceinline__ void rwprep_unit(const P& p, int l, int u, char* smem) {
    const int tid = opaque_tid(), lane = tid & 63, wid = tid >> 6, fr = lane & 15, fq = lane >> 4;
    const int R0 = u * 64;
    const int ss = R0 < M_CTX ? (R0 & ~255) : M_CTX + ((R0 - M_CTX) & ~4095); const int se = ss + (R0 < M_CTX ? 256 : 4096);
    bf16_t* XW = (bf16_t*)smem; bf16_t* XA = XW + 64 * 136; bf16_t* XG = XA + 64 * 136;
    const float* cw = p.rw_conv + (size_t)l * 3 * 1152;
    for (int it = tid; it < 576; it += 256) {
        const int cc = it % 144, tg = it / 144; const int c = cc * 8;
        float w0[8], w1[8], w2[8];
#pragma unroll
        for (int i = 0; i < 8; ++i) { w0[i] = cw[c + i]; w1[i] = cw[1152 + c + i]; w2[i] = cw[2304 + c + i]; }
        const int rfirst = R0 + tg * 16;
        u32x4 prev = (u32x4){0u, 0u, 0u, 0u}, cur, nxt;
        if (rfirst - 1 >= ss) prev = *(const u32x4*)(p.Z + (size_t)(rfirst - 1) * NIN + c);
        cur = *(const u32x4*)(p.Z + (size_t)rfirst * NIN + c);
        for (int tt = 0; tt < 16; ++tt) {
            const int row = rfirst + tt;
            nxt = (u32x4){0u, 0u, 0u, 0u};
            if (row + 1 < se) nxt = *(const u32x4*)(p.Z + (size_t)(row + 1) * NIN + c);
            float o[8];
#pragma unroll
            for (int i = 0; i < 4; ++i) {
                o[2 * i] = w0[2 * i] * lo_bf(prev[i]) + w1[2 * i] * lo_bf(cur[i]) + w2[2 * i] * lo_bf(nxt[i]);
                o[2 * i + 1] = w0[2 * i + 1] * hi_bf(prev[i]) + w1[2 * i + 1] * hi_bf(cur[i]) + w2[2 * i + 1] * hi_bf(nxt[i]);
            }
            if (c >= 768 && c < 896) {
#pragma unroll
                for (int i = 0; i < 8; ++i) o[i] = tanhf_(o[i]);
            } else if (c >= 1024) {
#pragma unroll
                for (int i = 0; i < 8; ++i) o[i] = sigmoidf_(o[i]);
            }
            u32x4 w; w.x = pack2(o[0], o[1]); w.y = pack2(o[2], o[3]); w.z = pack2(o[4], o[5]); w.w = pack2(o[6], o[7]);
            const int tl = tg * 16 + tt;
            if (c < 768) *(u32x4*)(p.RKV + (size_t)row * 768 + c) = w;
            else if (c < 896) *(u32x4*)(XW + tl * 136 + (c - 768)) = w;
            else if (c < 1024) *(u32x4*)(XA + tl * 136 + (c - 896)) = w;
            else *(u32x4*)(XG + tl * 136 + (c - 1024)) = w;
            prev = cur; cur = nxt;
        }
    }
    __syncthreads();
#pragma unroll 1
    for (int mh = 0; mh < 10; ++mh) {
        const int mat = mh >> 1, nh = mh & 1;
        const int d = mat & 1; const bf16_t* As; const bf16_t* Bw; int kofs, nks, ldw;
        if (mat < 2) { As = XW; Bw = p.W2t + d * 256 * 64; kofs = d * 64; nks = 2; ldw = 64; }
        else if (mat < 4) { As = XA; Bw = p.A2t + d * 256 * 64; kofs = d * 64; nks = 2; ldw = 64; }
        else { As = XG; Bw = p.G2t; kofs = 0; nks = 4; ldw = 128; }
        f32x4 acc[4][2];
#pragma unroll
        for (int m = 0; m < 4; ++m)
#pragma unroll
            for (int n = 0; n < 2; ++n) acc[m][n] = (f32x4){0.f, 0.f, 0.f, 0.f};
#pragma unroll 1
        for (int ks = 0; ks < nks; ++ks) {
            bf16x8 af[4], bfr[2];
#pragma unroll
            for (int m = 0; m < 4; ++m) af[m] = *(const bf16x8*)(As + (m * 16 + fr) * 136 + kofs + ks * 32 + fq * 8);
#pragma unroll
            for (int n = 0; n < 2; ++n) bfr[n] = *(const bf16x8*)(Bw + (size_t)(wid * 64 + nh * 32 + n * 16 + fr) * ldw + ks * 32 + fq * 8);
#pragma unroll
            for (int m = 0; m < 4; ++m)
#pragma unroll
                for (int n = 0; n < 2; ++n) acc[m][n] = __builtin_amdgcn_mfma_f32_16x16x32_bf16(af[m], bfr[n], acc[m][n], 0, 0, 0);
        }
#pragma unroll
        for (int n = 0; n < 2; ++n) {
            const int c = wid * 64 + nh * 32 + n * 16 + fr;
            float bias = 0.f; if (mat < 2) bias = p.rw_w0[(l * 2 + d) * 256 + c]; else if (mat < 4) bias = p.rw_a0[(l * 2 + d) * 256 + c];
            bf16_t* dst; float mul;
            if (mat < 2) { dst = p.Ee + ((size_t)d * M_ALL + R0) * 256 + c; mul = 0.6065306597126334f; }
            else if (mat < 4) { dst = p.Aa + ((size_t)d * M_ALL + R0) * 256 + c; mul = 1.0f; }
            else { dst = p.Gg + (size_t)R0 * 256 + c; mul = 1.0f; }
#pragma unroll
            for (int m = 0; m < 4; ++m)
#pragma unroll
                for (int j = 0; j < 4; ++j) {
                    const float x = acc[m][n][j] + bias;
                    dst[(size_t)(m * 16 + fq * 4 + j) * 256] = f2bf(mat < 4 ? mul * sigmoidf_(x) : x);
                }
        }
    }
    __syncthreads();
}
__device__ __forceinline__ void rowscale128(const bf16_t* Z, int R0, int zoff, int ncols, float eps, float* rs) {
    const int tid = opaque_tid(); const int r = tid >> 1, half = tid & 1; const int per = ncols >> 1;
    const bf16_t* zp = Z + (size_t)(R0 + r) * NIN + zoff + half * per;
    float ss = 0.f;
    for (int i = 0; i < per; i += 8) { const u32x4 w = *(const u32x4*)(zp + i);
#pragma unroll
        for (int q = 0; q < 4; ++q) { const float a = lo_bf(w[q]), b = hi_bf(w[q]); ss += a * a + b * b; } }
    ss = dpp_add<0xB1>(ss);
    if (half == 0) rs[r] = rsqrtf(ss / (float)ncols + eps);
}
__device__ __forceinline__ void small_unit(const P& p, int l, int u) {
    const int tid = opaque_tid(), sub = tid >> 5, li = tid & 31;
    if (u < 2560) {
        const int row = u * 8 + sub; const bf16_t* zr = p.Z + (size_t)row * NIN;
        const u32x2 w = *(const u32x2*)(zr + ZKV + li * 4);
        const float z0 = lo_bf(w.x), z1 = hi_bf(w.x), z2 = lo_bf(w.y), z3 = hi_bf(w.y);
        float ss = z0 * z0 + z1 * z1 + z2 * z2 + z3 * z3; ss = red16(ss); ss += __shfl_xor(ss, 16);
        const float rsv = rsqrtf(ss * (1.0f / 128.0f) + 1e-6f);
        const float x1 = bf2f(zr[ZKR + (li & 15)]), x2 = bf2f(zr[ZKR + 16 + (li & 15)]);
        float val;
        if (row < M_CTX) {
            const int b = row >> 8, t = row & 255; const size_t o = ((size_t)(b * 4 + l) * 256 + t);
            const f32x4 g = *(const f32x4*)(p.kv_norm + l * 128 + li * 4);
            *(f32x4*)(p.out + 20971520 + o * 128 + li * 4) = (f32x4){z0 * rsv * g[0], z1 * rsv * g[1], z2 * rsv * g[2], z3 * rsv * g[3]};
            val = li < 16 ? x1 : x2;
            p.out[20971520 + 2097152 + o * 32 + li] = val;
        } else {
            const int t = (row - M_CTX) & 4095; const float cv = p.ropeC[t * 16 + (li & 15)], sv = p.ropeS[t * 16 + (li & 15)];
            val = li < 16 ? x1 * cv - x2 * sv : x1 * sv + x2 * cv;
        }
        const bf16_t bv = f2bf(val);
#pragma unroll
        for (int h = 0; h < 8; ++h) p.Kb[(size_t)row * 768 + h * 96 + 64 + li] = bv;
    } else {
        const int r = (u - 2560) * 8 + sub; const int b = r >> 9, t = r & 511;
        const bf16_t bv = f2bf(p.cache_krope[((size_t)(b * 4 + l) * 512 + t) * 32 + li]);
#pragma unroll
        for (int h = 0; h < 8; ++h) p.Kc[(size_t)r * 768 + h * 96 + 64 + li] = bv;
    }
}
__device__ __forceinline__ void gmlp_unit(const P& p, int l, int u, char* smem) {
    const int tid = opaque_tid(), lane = tid & 63, wid = tid >> 6, fr = lane & 15, fq = lane >> 4;
    const int R0 = (u >> 2) * 128, g = u & 3;
    bf16_t* VnT = (bf16_t*)smem;
    {
        const int tok = tid >> 1, half = tid & 1; const bf16_t* zp = p.Z + (size_t)(R0 + tok) * NIN + ZV + g * 64 + half * 32;
        float x[32];
#pragma unroll
        for (int i = 0; i < 4; ++i) { const u32x4 w = *(const u32x4*)(zp + i * 8);
#pragma unroll
            for (int q = 0; q < 4; ++q) { x[i * 8 + 2 * q] = geluf_(lo_bf(w[q])); x[i * 8 + 2 * q + 1] = geluf_(hi_bf(w[q])); } }
        float s = 0.f;
#pragma unroll
        for (int i = 0; i < 32; ++i) s += x[i];
        s = dpp_add<0xB1>(s); const float mu = s * (1.0f / 64.0f);
        float q2 = 0.f;
#pragma unroll
        for (int i = 0; i < 32; ++i) { const float d = x[i] - mu; q2 += d * d; }
        q2 = dpp_add<0xB1>(q2); const float rstd = rsqrtf(q2 * (1.0f / 64.0f) + 1e-5f);
        const float* gg = p.gm_g + l * 256 + g * 64 + half * 32; const float* gb = p.gm_b + l * 256 + g * 64 + half * 32;
#pragma unroll
        for (int i = 0; i < 32; ++i) VnT[(half * 32 + i) * 136 + tok] = f2bf((x[i] - mu) * rstd * gg[i] + gb[i]);
    }
    __syncthreads();
    f32x4 acc[2][4];
#pragma unroll
    for (int m = 0; m < 2; ++m)
#pragma unroll
        for (int n = 0; n < 4; ++n) acc[m][n] = (f32x4){0.f, 0.f, 0.f, 0.f};
    const bf16_t* Wg = p.WsB + g * 128 * 128;
#pragma unroll
    for (int ks = 0; ks < 4; ++ks) {
        bf16x8 af[2], bfr[4];
#pragma unroll
        for (int m = 0; m < 2; ++m) af[m] = *(const bf16x8*)(Wg + (wid * 32 + m * 16 + fr) * 128 + ks * 32 + fq * 8);
#pragma unroll
        for (int n = 0; n < 4; ++n) bfr[n] = *(const bf16x8*)(VnT + (n * 16 + fr) * 136 + ks * 32 + fq * 8);
#pragma unroll
        for (int m = 0; m < 2; ++m)
#pragma unroll
            for (int n = 0; n < 4; ++n) acc[m][n] = __builtin_amdgcn_mfma_f32_16x16x32_bf16(af[m], bfr[n], acc[m][n], 0, 0, 0);
    }
#pragma unroll
    for (int m = 0; m < 2; ++m)
#pragma unroll
        for (int j = 0; j < 4; ++j) {
            const int pp = wid * 32 + m * 16 + fq * 4 + j; const float bs = p.gm_bs[l * 512 + g * 128 + pp];
#pragma unroll
            for (int n = 0; n < 4; ++n) { const int c = n * 16 + fr;
                const float uu = geluf_(bf2f(p.Z[(size_t)(R0 + pp) * NIN + ZU + g * 64 + c]));
                p.hbmix[(size_t)(R0 + pp) * DM + 768 + g * 64 + c] = f2bf(uu * (acc[m][n][j] + bs)); }
        }
    __syncthreads();
}

__device__ __forceinline__ float swap16_add(float x) {
    auto r = __builtin_amdgcn_permlane16_swap(__float_as_uint(x), __float_as_uint(x), false, false);
    return __uint_as_float(r[0]) + __uint_as_float(r[1]);
}
#define NSCAN_LAT 256
#define NSCAN (256 + 1024)
__device__ __forceinline__ void scan_unit(const P& p, int l, int u, char* smem) {
    const int tid = opaque_tid(), lane = tid & 63, wid = tid >> 6;
    int b, T, row0; const bool lat = u < NSCAN_LAT;
    if (lat) { b = u >> 6; T = 4096; row0 = M_CTX + b * 4096; } else { b = (u - NSCAN_LAT) >> 6; T = 256; row0 = b * 256; }
    const int h = (u >> 4) & 3, d = (u >> 3) & 1, rsl = u & 7;
    float* W = (float*)smem; float* NKK = W + 2048; float* KKA = NKK + 2048; float* KD = KKA + 2048; float* RR = KD + 2048; float* VS = RR + 2048; float* OUTP = VS + 256;
    const int rl = lane >> 5, kq = lane & 31; const int r8 = wid * 2 + rl; const int row = rsl * 8 + r8;
    f32x2 S = (f32x2){0.f, 0.f};
    const size_t stoff = ((((size_t)b * 4 + l) * 2 + d) * 4 + h) * 4096 + row * 64 + kq * 2;
    if (lat) S = *(const f32x2*)(p.state_rwkv + stoff);
    const int tok = tid >> 3, cg8 = tid & 7;
    float kkp[8], kap[8];
#pragma unroll
    for (int i = 0; i < 8; ++i) { kkp[i] = p.rw_kk[l * 256 + h * 64 + cg8 * 8 + i]; kap[i] = p.rw_ka[l * 256 + h * 64 + cg8 * 8 + i]; }
    const int nch = T >> 5;
    u32x4 r8v, k8, e8, a8, v8;
    int grow, grow_prev = 0; float oreg = 0.f;
    {
        const int sidx = tok; const int t = d ? T - 1 - sidx : sidx; grow = row0 + t;
        r8v = *(const u32x4*)(p.RKV + (size_t)grow * 768 + h * 64 + cg8 * 8);
        k8 = *(const u32x4*)(p.RKV + (size_t)grow * 768 + 256 + h * 64 + cg8 * 8);
        v8 = *(const u32x4*)(p.RKV + (size_t)grow * 768 + 512 + h * 64 + rsl * 8);
        e8 = *(const u32x4*)(p.Ee + ((size_t)d * M_ALL + grow) * 256 + h * 64 + cg8 * 8);
        a8 = *(const u32x4*)(p.Aa + ((size_t)d * M_ALL + grow) * 256 + h * 64 + cg8 * 8);
    }
    for (int ch = 0; ch < nch; ++ch) {
        {
            float kf[8], kkv[8], rf[8], ef[8], af[8];
#pragma unroll
            for (int q = 0; q < 4; ++q) { kf[2 * q] = lo_bf(k8[q]); kf[2 * q + 1] = hi_bf(k8[q]); rf[2 * q] = lo_bf(r8v[q]); rf[2 * q + 1] = hi_bf(r8v[q]);
                ef[2 * q] = lo_bf(e8[q]); ef[2 * q + 1] = hi_bf(e8[q]); af[2 * q] = lo_bf(a8[q]); af[2 * q + 1] = hi_bf(a8[q]); }
            float ss = 0.f;
#pragma unroll
            for (int i = 0; i < 8; ++i) { kkv[i] = kf[i] * kkp[i]; ss += kkv[i] * kkv[i]; }
            ss = red8(ss);
            const float inv = rsqrtf(fmaxf(ss, 1e-24f));
            f32x4 o0, o1; const int base = tok * 64 + cg8 * 8;
#pragma unroll
            for (int i = 0; i < 4; ++i) { o0[i] = __expf(-ef[i]); o1[i] = __expf(-ef[4 + i]); }
            *(f32x4*)(W + base) = o0; *(f32x4*)(W + base + 4) = o1;
#pragma unroll
            for (int i = 0; i < 4; ++i) { o0[i] = -kkv[i] * inv; o1[i] = -kkv[4 + i] * inv; }
            *(f32x4*)(NKK + base) = o0; *(f32x4*)(NKK + base + 4) = o1;
#pragma unroll
            for (int i = 0; i < 4; ++i) { o0[i] = kkv[i] * inv * af[i]; o1[i] = kkv[4 + i] * inv * af[4 + i]; }
            *(f32x4*)(KKA + base) = o0; *(f32x4*)(KKA + base + 4) = o1;
#pragma unroll
            for (int i = 0; i < 4; ++i) { o0[i] = kf[i] * (1.0f + (af[i] - 1.0f) * kap[i]); o1[i] = kf[4 + i] * (1.0f + (af[4 + i] - 1.0f) * kap[4 + i]); }
            *(f32x4*)(KD + base) = o0; *(f32x4*)(KD + base + 4) = o1;
#pragma unroll
            for (int i = 0; i < 4; ++i) { o0[i] = rf[i]; o1[i] = rf[4 + i]; }
            *(f32x4*)(RR + base) = o0; *(f32x4*)(RR + base + 4) = o1;
            if (cg8 == 0) {
#pragma unroll
                for (int q = 0; q < 4; ++q) { VS[tok * 8 + 2 * q] = lo_bf(v8[q]); VS[tok * 8 + 2 * q + 1] = hi_bf(v8[q]); }
            }
        }
        __syncthreads();
        if (ch > 0) p.ydir[((size_t)d * M_ALL + grow_prev) * 256 + h * 64 + rsl * 8 + cg8] = oreg;
        grow_prev = grow;
        if (ch + 1 < nch) {
            const int sidx = (ch + 1) * 32 + tok; const int t = d ? T - 1 - sidx : sidx; grow = row0 + t;
            r8v = *(const u32x4*)(p.RKV + (size_t)grow * 768 + h * 64 + cg8 * 8);
            k8 = *(const u32x4*)(p.RKV + (size_t)grow * 768 + 256 + h * 64 + cg8 * 8);
            v8 = *(const u32x4*)(p.RKV + (size_t)grow * 768 + 512 + h * 64 + rsl * 8);
            e8 = *(const u32x4*)(p.Ee + ((size_t)d * M_ALL + grow) * 256 + h * 64 + cg8 * 8);
            a8 = *(const u32x4*)(p.Aa + ((size_t)d * M_ALL + grow) * 256 + h * 64 + cg8 * 8);
        }
        {
            const float* Wq = W + kq * 2; const float* NKq = NKK + kq * 2; const float* KAq = KKA + kq * 2; const float* KDq = KD + kq * 2; const float* RRq = RR + kq * 2; const float* VSq = VS + r8;
            float* OPq = OUTP + r8 * 32 + kq;
            f32x2 wv[4], nkv[4], kav[4], kdv[4], rrv[4]; float vv[4];
#define SCAN_LD(slot, st) do { wv[slot] = *(const f32x2*)(Wq + (st) * 64); nkv[slot] = *(const f32x2*)(NKq + (st) * 64); kav[slot] = *(const f32x2*)(KAq + (st) * 64); \
        kdv[slot] = *(const f32x2*)(KDq + (st) * 64); rrv[slot] = *(const f32x2*)(RRq + (st) * 64); vv[slot] = VSq[(st) * 8]; } while (0)
            __builtin_amdgcn_s_setprio(3);
            SCAN_LD(0, 0); SCAN_LD(1, 1); SCAN_LD(2, 2);
#pragma unroll
            for (int s = 0; s < 32; ++s) {
                if (s + 3 < 32) SCAN_LD((s + 3) & 3, s + 3);
                const f32x2 w = wv[s & 3], nk = nkv[s & 3], ka = kav[s & 3], kd = kdv[s & 3], rr = rrv[s & 3]; const float v = vv[s & 3];
                float pd = fmaf(S[1], nk[1], S[0] * nk[0]);
                pd = red16(pd); pd = swap16_add(pd);
                S[0] = fmaf(S[0], w[0], fmaf(pd, ka[0], v * kd[0]));
                S[1] = fmaf(S[1], w[1], fmaf(pd, ka[1], v * kd[1]));
                OPq[s * 256] = fmaf(S[1], rr[1], S[0] * rr[0]);
            }
            __builtin_amdgcn_s_setprio(0);
        }
        __syncthreads();
        {
            const float* op = OUTP + (tok * 8 + cg8) * 32;
            f32x4 a0 = *(const f32x4*)(op), a1 = *(const f32x4*)(op + 4), a2 = *(const f32x4*)(op + 8), a3 = *(const f32x4*)(op + 12);
            f32x4 b0 = *(const f32x4*)(op + 16), b1 = *(const f32x4*)(op + 20), b2 = *(const f32x4*)(op + 24), b3 = *(const f32x4*)(op + 28);
            a0 = ((a0 + a1) + (a2 + a3)) + ((b0 + b1) + (b2 + b3));
            oreg = (a0[0] + a0[1]) + (a0[2] + a0[3]);
        }
    }
    p.ydir[((size_t)d * M_ALL + grow_prev) * 256 + h * 64 + rsl * 8 + cg8] = oreg;
    if (!lat) *(f32x2*)(p.out + 20971520 + 2097152 + 524288 + stoff) = S;
    __syncthreads();
}

#define KS_STRIDE 104
#define VS_STRIDE 72
#define KS_BYTES (64 * KS_STRIDE * 2)
#define ATT_STAGE (KS_BYTES + 64 * VS_STRIDE * 2)
__device__ __forceinline__ void attn_unit(const P& p, int u, char* smem) {
    const int tid = opaque_tid(), lane = tid & 63, wid = tid >> 6, q = lane & 31, hf = lane >> 5;
    int b, h, qt, qrow0, krow0, nown, ntot, Tv; size_t vbase, vcbase = 0; int kcrow0 = 0;
    if (u < 1024) { b = u >> 8; h = (u >> 5) & 7; qt = u & 31; krow0 = M_CTX + b * 4096; qrow0 = krow0 + qt * 128; nown = 64; ntot = 72; Tv = 4096;
        vbase = 2097152 + (size_t)(b * 8 + h) * 64 * 4096; kcrow0 = b * 512; vcbase = (size_t)(b * 8 + h) * 64 * 512; }
    else { const int v = u - 1024; b = v >> 4; h = (v >> 1) & 7; qt = v & 1; krow0 = b * 256; qrow0 = krow0 + qt * 128; nown = 4; ntot = 4; Tv = 256; vbase = (size_t)(b * 8 + h) * 64 * 256; }
    bf16x8 qf[6];
    { const bf16_t* qp = p.Qb + (size_t)(qrow0 + wid * 32 + q) * 768 + h * 96 + hf * 8;
#pragma unroll
      for (int ks = 0; ks < 6; ++ks) qf[ks] = *(const bf16x8*)(qp + ks * 16); }
    f32x16 oT[2];
#pragma unroll
    for (int i = 0; i < 16; ++i) { oT[0][i] = 0.f; oT[1][i] = 0.f; }
    float mrun = -1e30f, lrun = 0.f;
    u32x4 rk[3], rv[2];
    int krow[3], kc[3];
#pragma unroll
    for (int i = 0; i < 3; ++i) { const int c = tid + 256 * i; krow[i] = c / 12; kc[i] = c % 12; }
    const int vdv0 = tid >> 3, vkc = tid & 7;
#define ATT_LOAD(kt) do { const bf16_t* kptr; const bf16_t* vptr; int vstr; \
        if ((kt) < nown) { kptr = p.Kb + (size_t)(krow0 + (kt) * 64) * 768 + h * 96; vptr = p.Vt + vbase + (kt) * 64; vstr = Tv; } \
        else { kptr = p.Kc + (size_t)(kcrow0 + ((kt) - nown) * 64) * 768 + h * 96; vptr = p.Vtc + vcbase + ((kt) - nown) * 64; vstr = 512; } \
        _Pragma("unroll") for (int i = 0; i < 3; ++i) rk[i] = *(const u32x4*)(kptr + (size_t)krow[i] * 768 + kc[i] * 8); \
        _Pragma("unroll") for (int i = 0; i < 2; ++i) rv[i] = *(const u32x4*)(vptr + (size_t)(vdv0 + 32 * i) * vstr + vkc * 8); } while (0)
#define ATT_STORE(buf) do { char* Ks_ = smem + (buf) * ATT_STAGE; char* Vs_ = Ks_ + KS_BYTES; \
        _Pragma("unroll") for (int i = 0; i < 3; ++i) *(u32x4*)(Ks_ + (krow[i] * KS_STRIDE + kc[i] * 8) * 2) = rk[i]; \
        _Pragma("unroll") for (int i = 0; i < 2; ++i) *(u32x4*)(Vs_ + ((vdv0 + 32 * i) * VS_STRIDE + vkc * 8) * 2) = rv[i]; } while (0)
    ATT_LOAD(0); ATT_STORE(0);
    __syncthreads();
    for (int kt = 0; kt < ntot; ++kt) {
        const bool more = kt + 1 < ntot;
        if (more) ATT_LOAD(kt + 1);
        const char* Ks = smem + (kt & 1) * ATT_STAGE; const char* Vs = Ks + KS_BYTES;
        f32x16 sT[2];
#pragma unroll
        for (int i = 0; i < 16; ++i) { sT[0][i] = 0.f; sT[1][i] = 0.f; }
#pragma unroll
        for (int kb = 0; kb < 2; ++kb)
#pragma unroll
            for (int ks = 0; ks < 6; ++ks) { const bf16x8 kf = *(const bf16x8*)(Ks + ((kb * 32 + q) * KS_STRIDE + ks * 16 + hf * 8) * 2);
                sT[kb] = __builtin_amdgcn_mfma_f32_32x32x16_bf16(kf, qf[ks], sT[kb], 0, 0, 0); }
        float mx = sT[0][0];
#pragma unroll
        for (int i = 1; i < 16; ++i) mx = fmaxf(mx, sT[0][i]);
#pragma unroll
        for (int i = 0; i < 16; ++i) mx = fmaxf(mx, sT[1][i]);
        mx = fmaxf(mx, __shfl_xor(mx, 32));
        const float mnew = fmaxf(mrun, mx); const float alpha = __builtin_amdgcn_exp2f(mrun - mnew); const bool resc = __any(mnew > mrun); mrun = mnew;
        float psum = 0.f; bf16x8 pf[2][2];
#pragma unroll
        for (int kb = 0; kb < 2; ++kb)
#pragma unroll
            for (int s = 0; s < 2; ++s) { float e[8];
#pragma unroll
                for (int j = 0; j < 8; ++j) { e[j] = __builtin_amdgcn_exp2f(sT[kb][8 * s + j] - mnew); psum += e[j]; }
                u32x4 w; w.x = pack2(e[0], e[1]); w.y = pack2(e[2], e[3]); w.z = pack2(e[4], e[5]); w.w = pack2(e[6], e[7]);
                pf[kb][s] = __builtin_bit_cast(bf16x8, w); }
        lrun = lrun * alpha + psum;
        if (resc) {
#pragma unroll
            for (int i = 0; i < 16; ++i) { oT[0][i] *= alpha; oT[1][i] *= alpha; }
        }
#pragma unroll
        for (int kb = 0; kb < 2; ++kb)
#pragma unroll
            for (int s = 0; s < 2; ++s)
#pragma unroll
                for (int db = 0; db < 2; ++db) {
                    const char* vp = Vs + ((db * 32 + q) * VS_STRIDE + kb * 32 + 16 * s + 4 * hf) * 2;
                    const u32x2 lo = *(const u32x2*)vp, hi = *(const u32x2*)(vp + 16);
                    const u32x4 w = (u32x4){lo.x, lo.y, hi.x, hi.y};
                    oT[db] = __builtin_amdgcn_mfma_f32_32x32x16_bf16(__builtin_bit_cast(bf16x8, w), pf[kb][s], oT[db], 0, 0, 0);
                }
        if (more) ATT_STORE((kt + 1) & 1);
        __syncthreads();
    }
    const float lt = lrun + __shfl_xor(lrun, 32); const float inv = 1.0f / lt;
    bf16_t* op = p.hbmix + (size_t)(qrow0 + wid * 32 + q) * DM + 256 + h * 64;
#pragma unroll
    for (int db = 0; db < 2; ++db)
#pragma unroll
        for (int g = 0; g < 4; ++g) { u32x2 w; w.x = pack2(oT[db][4 * g] * inv, oT[db][4 * g + 1] * inv); w.y = pack2(oT[db][4 * g + 2] * inv, oT[db][4 * g + 3] * inv);
            *(u32x2*)(op + db * 32 + 8 * g + 4 * hf) = w; }
}

__device__ __forceinline__ void rwcomb_phase(const P& p, int l) {
    const int tid = opaque_tid(), lane = tid & 63, wid = tid >> 6; const int c = lane * 4;
    const f32x4 gng = *(const f32x4*)(p.rw_gn_g + l * 256 + c), gnb = *(const f32x4*)(p.rw_gn_b + l * 256 + c), kap = *(const f32x4*)(p.rw_ka + l * 256 + c), rkp = *(const f32x4*)(p.rw_rk + l * 256 + c);
    for (int row = blockIdx.x * 4 + wid; row < M_ALL; row += gridDim.x * 4) {
        const f32x4 y0 = *(const f32x4*)(p.ydir + (size_t)row * 256 + c), y1 = *(const f32x4*)(p.ydir + ((size_t)M_ALL + row) * 256 + c);
        f32x4 y = y0 + y1;
        float s = (y[0] + y[1]) + (y[2] + y[3]); s = red16(s); const float mu = s * (1.0f / 64.0f);
        const f32x4 dd = y - mu; float q2 = (dd[0] * dd[0] + dd[1] * dd[1]) + (dd[2] * dd[2] + dd[3] * dd[3]); q2 = red16(q2);
        const float rstd = rsqrtf(q2 * (1.0f / 64.0f) + 64e-5f);
        const f32x4 yn = dd * rstd * gng + gnb;
        const u32x2 rw = *(const u32x2*)(p.RKV + (size_t)row * 768 + c), kw = *(const u32x2*)(p.RKV + (size_t)row * 768 + 256 + c), vw = *(const u32x2*)(p.RKV + (size_t)row * 768 + 512 + c);
        const u32x2 a0w = *(const u32x2*)(p.Aa + (size_t)row * 256 + c), a1w = *(const u32x2*)(p.Aa + ((size_t)M_ALL + row) * 256 + c), gw = *(const u32x2*)(p.Gg + (size_t)row * 256 + c);
        const f32x4 r = (f32x4){lo_bf(rw.x), hi_bf(rw.x), lo_bf(rw.y), hi_bf(rw.y)}, k = (f32x4){lo_bf(kw.x), hi_bf(kw.x), lo_bf(kw.y), hi_bf(kw.y)}, v = (f32x4){lo_bf(vw.x), hi_bf(vw.x), lo_bf(vw.y), hi_bf(vw.y)};
        const f32x4 a0 = (f32x4){lo_bf(a0w.x), hi_bf(a0w.x), lo_bf(a0w.y), hi_bf(a0w.y)}, a1 = (f32x4){lo_bf(a1w.x), hi_bf(a1w.x), lo_bf(a1w.y), hi_bf(a1w.y)}, gt = (f32x4){lo_bf(gw.x), hi_bf(gw.x), lo_bf(gw.y), hi_bf(gw.y)};
        const f32x4 kds = k * (1.0f + (a0 - 1.0f) * kap) + k * (1.0f + (a1 - 1.0f) * kap);
        const f32x4 t4 = r * kds * rkp; float rk = (t4[0] + t4[1]) + (t4[2] + t4[3]); rk = red16(rk);
        const f32x4 o = (yn + rk * v) * gt;
        u32x2 w; w.x = pack2(o[0], o[1]); w.y = pack2(o[2], o[3]);
        *(u32x2*)(p.hbmix + (size_t)row * DM + c) = w;
    }
}


__device__ __forceinline__ bool xcd_tile(int i, int TT, int NT, int& mt, int& nt) {
    const int per = TT >> 3; if (i >= per) return false;
    const int t = (blockIdx.x & 7) * per + i; const int band = t / (8 * NT), rem = t - band * 8 * NT;
    nt = rem >> 3; mt = band * 8 + (rem & 7); return true;
}
__global__ void __launch_bounds__(256, 2) mega(Args a_unused) {
    extern __shared__ __attribute__((aligned(16))) char smem[];
    __shared__ uint4 xbw; __shared__ int s_unit;
    kargp_t kp = (kargp_t)__builtin_amdgcn_kernarg_segment_ptr();
    const int tid = threadIdx.x; const int G = gridDim.x;
    if (tid == 0) xbw = make_uint4(0u, 0u, 0u, 0u);
    __syncthreads();
    XcdBarrier xb;
    { const P p = getP(kp); xb = xcd_barrier_post(p.bar, (volatile LAS unsigned*)&xbw); }
    for (int u = blockIdx.x; u < 384 + NCONV + 272; u += G) {
        if (u < 384) { const P p = getP(kp); ada_unit(p, u, smem); } else if (u < 384 + NCONV) { const P p = getP(kp); conv_unit(p, 0, u - 384, smem); } else { const P p = getP(kp); misc0_unit(p, u - 384 - NCONV); }
    }
    cg::this_grid().sync();
    { const P p = getP(kp); ln_phase(p, 0, 0); }
    xcd_barrier(xb);
    float* rs = (float*)(smem + RS_OFF);
#pragma unroll 1
    for (int l = 0; l < 4; ++l) {
        for (int i = blockIdx.x >> 3; ; i += G >> 3) { int mt, nt; if (!xcd_tile(i, 160 * 17, 17, mt, nt)) break; const P p = getP(kp);
            EpiZ e{p.Z, mt * 128, nt * 128};
            gemm128(p.hbmix + (size_t)mt * 128 * DM, DM, p.WtIn + (size_t)nt * 128 * DM, DM, DM, smem, e); }
        xcd_barrier(xb);
        for (int rep2 = 0; rep2 < DUP_P2; ++rep2) {
        for (;;) {
            { const P pc = getP(kp); if (tid == 0) s_unit = atomicAdd(&pc.ctr[l * 4 + 0 + 2 * rep2], 1); }
            __syncthreads(); int u = s_unit; __syncthreads();
            if (u >= 320 + 960 + 1408 + 2816 + 640) break;
            if (u < 320) { const P p = getP(kp); rwprep_unit(p, l, u, smem); continue; }
            u -= 320;
            if (u < 960) { const P p = getP(kp); const int mt = u / 6, nt = u % 6;
                rowscale128(p.Z, mt * 128, ZQ, 256, 1e-6f, rs);
                EpiQ e{p.Qb, rs, p.ropeC, p.ropeS, mt * 128, nt * 128};
                gemm128(p.Z + (size_t)mt * 128 * NIN + ZQ, NIN, p.WtQ + (size_t)nt * 128 * 256, 256, 256, smem, e); __syncthreads(); continue; }
            u -= 960;
            if (u < 1280) { const P p = getP(kp); const int mt = u >> 3, nt = u & 7; const int R0 = mt * 128; const bool latr = R0 >= M_CTX;
                rowscale128(p.Z, R0, ZKV, 128, 1e-6f, rs);
                EpiKV e{latr ? p.Kb + (size_t)M_CTX * 768 : p.Kb, p.Vt, rs, latr ? R0 - M_CTX : R0, nt * 128, latr ? 12 : 8, latr ? (size_t)2097152 : (size_t)0};
                gemm128(p.Z + (size_t)R0 * NIN + ZKV, NIN, p.WtKVn + (size_t)nt * 128 * 128, 128, 128, smem, e); __syncthreads(); continue; }
            u -= 1280;
            if (u < 128) { const P p = getP(kp); const int mt = u >> 3, nt = u & 7;
                EpiKV e{p.Kc, p.Vtc, nullptr, mt * 128, nt * 128, 9, (size_t)0};
                gemm128(p.CkvB + ((size_t)l * 2048 + mt * 128) * 128, 128, p.WtKV + (size_t)nt * 128 * 128, 128, 128, smem, e); continue; }
            u -= 128;
            if (u < 2816) { const P p = getP(kp); small_unit(p, l, u); continue; }
            u -= 2816;
            { const P p = getP(kp); gmlp_unit(p, l, u, smem); }
        }
        xcd_barrier(xb);
        }
        for (int rep3 = 0; rep3 < DUP_P3; ++rep3) {
        for (;;) {
            { const P pc = getP(kp); if (tid == 0) s_unit = atomicAdd(&pc.ctr[l * 4 + 1 + 2 * rep3], 1); }
            __syncthreads(); int u = s_unit; __syncthreads();
            if (u >= NSCAN + 1280) break;
#ifdef PROBE_SCAN_ONLY
            if (rep3 == 1 && u >= NSCAN) break;
#endif
#ifdef PROBE_ATTN_ONLY
            if (rep3 == 1 && u < NSCAN) continue;
#endif
            if (u < NSCAN) { const P p = getP(kp); scan_unit(p, l, u, smem); } else { const P p = getP(kp); attn_unit(p, u - NSCAN, smem); }
        }
        xcd_barrier(xb);
        }
        { const P p = getP(kp); rwcomb_phase(p, l); }
        xcd_barrier(xb);
        for (int i = blockIdx.x >> 3; ; i += G >> 3) { int mt, nt; if (!xcd_tile(i, 160 * 8, 8, mt, nt)) break; const P p = getP(kp);
            EpiRes e{p.out, p.mod + ((size_t)l * 5 + modrow_of(mt * 128)) * 6144 + 2048, mt * 128, nt * 128};
            gemm128(p.hbmix + (size_t)mt * 128 * DM, DM, p.WtOut + (size_t)nt * 128 * DM, DM, DM, smem, e); }
        xcd_barrier(xb);
        { const P p = getP(kp); ln_phase(p, l, 1); }
        xcd_barrier(xb);
        for (int rep5 = 0; rep5 < DUP_P5; ++rep5)
        for (int i = blockIdx.x >> 3; ; i += G >> 3) { int mt, nt; if (!xcd_tile(i, 160 * 44, 44, mt, nt)) break; const P p = getP(kp);
            EpiSwi e{p.hidden, mt * 128, nt * 128};
            gemm128(p.hbmix + (size_t)mt * 128 * DM, DM, p.WtF1 + (size_t)nt * 128 * DM, DM, DM, smem, e); }
        xcd_barrier(xb);
        for (int i = blockIdx.x >> 3; ; i += G >> 3) { int mt, nt; if (!xcd_tile(i, 160 * 8, 8, mt, nt)) break; const P p = getP(kp);
            EpiRes e{p.out, p.mod + ((size_t)l * 5 + modrow_of(mt * 128)) * 6144 + 5120, mt * 128, nt * 128};
            gemm128(p.hidden + (size_t)mt * 128 * DFF, DFF, p.WtF2 + (size_t)nt * 128 * DFF, DFF, DFF, smem, e); }
        xcd_barrier(xb);
        { const P p = getP(kp); ln_phase(p, l, 2); }
        if (l < 3) { for (int u = blockIdx.x; u < NCONV; u += G) { const P p = getP(kp); conv_unit(p, l + 1, u, smem); } }
        xcd_barrier(xb);
    }
}

extern "C" void kernel_launch(void* const* d_in, const int* in_sizes, int n_in, void* d_out, int out_size, void* d_ws, size_t ws_size, hipStream_t stream) {
    static int grid_blocks = 0;
    if (!grid_blocks) {
        int dev = 0, cus = 0, per_cu = 0;
        (void)hipGetDevice(&dev);
        (void)hipDeviceGetAttribute(&cus, hipDeviceAttributeMultiprocessorCount, dev);
        (void)hipFuncSetAttribute((const void*)mega, hipFuncAttributeMaxDynamicSharedMemorySize, SMEM_BYTES);
        (void)hipOccupancyMaxActiveBlocksPerMultiprocessor(&per_cu, (const void*)mega, 256, SMEM_BYTES);
        if (per_cu > 2) per_cu = 2;
        if (per_cu < 1) per_cu = 1;
        grid_blocks = (cus * per_cu) & ~7;
    }
    if (WS_TOTAL > ws_size) { fprintf(stderr, "kernel_launch: workspace too small: need %zu have %zu\n", (size_t)WS_TOTAL, ws_size); return; }
    Args a{};
    for (int i = 0; i < 36; ++i) a.in[i] = (const float*)d_in[i];
    a.out = (float*)d_out; a.ws = (char*)d_ws;
    (void)hipMemsetAsync((char*)d_ws + OFF_BAR, 0, 16384 + 4096, stream);
    void* args[] = {&a};
    hipError_t e = hipLaunchCooperativeKernel((const void*)mega, dim3(grid_blocks), dim3(256), args, SMEM_BYTES, stream);
    if (e != hipSuccess) fprintf(stderr, "cooperative launch failed: %s (grid %d)\n", hipGetErrorString(e), grid_blocks);
}
```

```cpp
#include <hip/hip_runtime.h>
#include <hip/hip_cooperative_groups.h>
#include <cstdint>
#include <cstdio>
namespace cg = cooperative_groups;

typedef unsigned short bf16_t;
typedef short bf16x8 __attribute__((ext_vector_type(8)));
typedef float f32x4 __attribute__((ext_vector_type(4)));
typedef float f32x2 __attribute__((ext_vector_type(2)));
typedef float f32x16 __attribute__((ext_vector_type(16)));
typedef unsigned u32x4 __attribute__((ext_vector_type(4)));
typedef unsigned u32x2 __attribute__((ext_vector_type(2)));

#define M_ALL 20480
#define M_CTX 4096
#define DM 1024
#define NIN 2080
#define DFF 2816
#define ALPHA_F 1.6817928305074290f
#define QSCALE (0.10206207261596575f * 1.4426950408889634f)
#define LAS __attribute__((address_space(3)))
#ifndef DUP_P2
#define DUP_P2 1
#endif
#ifndef DUP_P3
#define DUP_P3 1
#endif
#ifndef DUP_P5
#define DUP_P5 1
#endif

#define ZQ 1152
#define ZKV 1408
#define ZKR 1536
#define ZU 1568
#define ZV 1824

#define LDS_STRIDE 72
#define TILE_BYTES (128 * LDS_STRIDE * 2)
#define RS_OFF (4 * TILE_BYTES)
#define SMEM_BYTES (RS_OFF + 3072)

struct P {
    const float *x_prompt, *x_sample, *cache_ckv, *cache_krope, *state_rwkv, *c, *c_ctx, *ada_w, *ada_b, *w_in, *rw_conv, *rw_w0, *rw_w2,
        *rw_a0, *rw_a2, *rw_g2, *rw_kk, *rw_ka, *rw_rk, *rw_gn_g, *rw_gn_b, *q_norm, *q_up, *kv_norm, *kv_up, *gm_g, *gm_b, *gm_ws, *gm_bs,
        *w_out, *ln1_g, *ln1_b, *ffn_in, *ffn_out, *ln2_g, *ln2_b;
    float* out;
    unsigned* bar; int* ctr; float* mod; float* ropeC; float* ropeS; bf16_t* CkvB;
    bf16_t *WtIn, *WtQ, *WtKVn, *WtKV, *WtOut, *WtF1, *WtF2, *WsB, *W2t, *A2t, *G2t;
    bf16_t *Z, *RKV, *Ee, *Aa, *Gg, *Qb, *Kb, *Kc, *Vt, *Vtc, *hbmix, *hidden;
    float* ydir;
};


struct Args { const float* in[36]; float* out; char* ws; };
typedef const __attribute__((address_space(4))) char* kargp_t;
constexpr size_t al256(size_t x) { return (x + 255) & ~(size_t)255; }
constexpr size_t OFF_BAR = 0;
constexpr size_t OFF_CTR = OFF_BAR + 16384;
constexpr size_t OFF_MOD = OFF_CTR + 4096;
constexpr size_t OFF_ROPEC = OFF_MOD + al256((size_t)4 * 5 * 6144 * 4);
constexpr size_t OFF_ROPES = OFF_ROPEC + 65536 * 4;
constexpr size_t OFF_CKVB = OFF_ROPES + 65536 * 4;
constexpr size_t OFF_WTIN = OFF_CKVB + (size_t)4 * 2048 * 128 * 2;
constexpr size_t OFF_WTQ = OFF_WTIN + (size_t)2176 * 1024 * 2;
constexpr size_t OFF_WTKVN = OFF_WTQ + (size_t)768 * 256 * 2;
constexpr size_t OFF_WTKV = OFF_WTKVN + (size_t)1024 * 128 * 2;
constexpr size_t OFF_WTOUT = OFF_WTKV + (size_t)1024 * 128 * 2;
constexpr size_t OFF_WTF1 = OFF_WTOUT + (size_t)1024 * 1024 * 2;
constexpr size_t OFF_WTF2 = OFF_WTF1 + (size_t)5632 * 1024 * 2;
constexpr size_t OFF_WSB = OFF_WTF2 + (size_t)1024 * DFF * 2;
constexpr size_t OFF_W2T = OFF_WSB + (size_t)65536 * 2;
constexpr size_t OFF_A2T = OFF_W2T + (size_t)2 * 256 * 64 * 2;
constexpr size_t OFF_G2T = OFF_A2T + (size_t)2 * 256 * 64 * 2;
constexpr size_t OFF_Z = OFF_G2T + (size_t)256 * 128 * 2;
constexpr size_t OFF_HIDDEN = OFF_Z;
constexpr size_t OFF_RKV = OFF_Z + al256((size_t)M_ALL * NIN * 2);
constexpr size_t OFF_EE = OFF_RKV + (size_t)M_ALL * 768 * 2;
constexpr size_t OFF_AA = OFF_EE + (size_t)2 * M_ALL * 256 * 2;
constexpr size_t OFF_GG = OFF_AA + (size_t)2 * M_ALL * 256 * 2;
constexpr size_t OFF_QB = OFF_GG + (size_t)M_ALL * 256 * 2;
constexpr size_t OFF_KB = OFF_QB + (size_t)M_ALL * 768 * 2;
constexpr size_t OFF_KC = OFF_KB + (size_t)M_ALL * 768 * 2;
constexpr size_t OFF_VT = OFF_KC + (size_t)2048 * 768 * 2;
constexpr size_t OFF_VTC = OFF_VT + (size_t)M_ALL * 512 * 2;
constexpr size_t OFF_YDIR = OFF_VTC + (size_t)2048 * 512 * 2;
constexpr size_t OFF_HBMIX = OFF_YDIR + (size_t)2 * M_ALL * 256 * 4;
constexpr size_t WS_TOTAL = OFF_HBMIX + (size_t)M_ALL * DM * 2;
static_assert(OFF_RKV + (size_t)M_ALL * 768 * 2 - OFF_HIDDEN >= (size_t)M_ALL * DFF * 2, "hidden overlay");

__device__ __forceinline__ P getP(kargp_t& kp) {
    asm volatile("" : "+s"(kp));
    typedef const float* const __attribute__((address_space(4)))* inp_t;
    inp_t in = (inp_t)kp;
    P p;
    p.x_prompt = in[0]; p.x_sample = in[1]; p.cache_ckv = in[2]; p.cache_krope = in[3]; p.state_rwkv = in[4]; p.c = in[5]; p.c_ctx = in[6];
    p.ada_w = in[7]; p.ada_b = in[8]; p.w_in = in[9]; p.rw_conv = in[10]; p.rw_w0 = in[11]; p.rw_w2 = in[12]; p.rw_a0 = in[13]; p.rw_a2 = in[14];
    p.rw_g2 = in[15]; p.rw_kk = in[16]; p.rw_ka = in[17]; p.rw_rk = in[18]; p.rw_gn_g = in[19]; p.rw_gn_b = in[20]; p.q_norm = in[21]; p.q_up = in[22];
    p.kv_norm = in[23]; p.kv_up = in[24]; p.gm_g = in[25]; p.gm_b = in[26]; p.gm_ws = in[27]; p.gm_bs = in[28]; p.w_out = in[29]; p.ln1_g = in[30];
    p.ln1_b = in[31]; p.ffn_in = in[32]; p.ffn_out = in[33]; p.ln2_g = in[34]; p.ln2_b = in[35];
    p.out = (float*)in[36]; char* ws = (char*)in[37];
    p.bar = (unsigned*)(ws + OFF_BAR); p.ctr = (int*)(ws + OFF_CTR); p.mod = (float*)(ws + OFF_MOD); p.ropeC = (float*)(ws + OFF_ROPEC); p.ropeS = (float*)(ws + OFF_ROPES);
    p.CkvB = (bf16_t*)(ws + OFF_CKVB); p.WtIn = (bf16_t*)(ws + OFF_WTIN); p.WtQ = (bf16_t*)(ws + OFF_WTQ); p.WtKVn = (bf16_t*)(ws + OFF_WTKVN); p.WtKV = (bf16_t*)(ws + OFF_WTKV);
    p.WtOut = (bf16_t*)(ws + OFF_WTOUT); p.WtF1 = (bf16_t*)(ws + OFF_WTF1); p.WtF2 = (bf16_t*)(ws + OFF_WTF2); p.WsB = (bf16_t*)(ws + OFF_WSB); p.W2t = (bf16_t*)(ws + OFF_W2T);
    p.A2t = (bf16_t*)(ws + OFF_A2T); p.G2t = (bf16_t*)(ws + OFF_G2T); p.Z = (bf16_t*)(ws + OFF_Z); p.RKV = (bf16_t*)(ws + OFF_RKV); p.Ee = (bf16_t*)(ws + OFF_EE); p.Aa = (bf16_t*)(ws + OFF_AA);
    p.Gg = (bf16_t*)(ws + OFF_GG); p.Qb = (bf16_t*)(ws + OFF_QB); p.Kb = (bf16_t*)(ws + OFF_KB); p.Kc = (bf16_t*)(ws + OFF_KC); p.Vt = (bf16_t*)(ws + OFF_VT); p.Vtc = (bf16_t*)(ws + OFF_VTC);
    p.hbmix = (bf16_t*)(ws + OFF_HBMIX); p.hidden = (bf16_t*)(ws + OFF_HIDDEN); p.ydir = (float*)(ws + OFF_YDIR);
    return p;
}

__device__ __forceinline__ float bf2f(bf16_t b) { return __uint_as_float(((unsigned)b) << 16); }
__device__ __forceinline__ unsigned pack2(float lo, float hi) { unsigned r; asm("v_cvt_pk_bf16_f32 %0, %1, %2" : "=v"(r) : "v"(lo), "v"(hi)); return r; }
__device__ __forceinline__ bf16_t f2bf(float f) { return (bf16_t)(pack2(f, 0.f) & 0xffffu); }
__device__ __forceinline__ float lo_bf(unsigned w) { return __uint_as_float(w << 16); }
__device__ __forceinline__ float hi_bf(unsigned w) { return __uint_as_float(w & 0xffff0000u); }
__device__ __forceinline__ float sigmoidf_(float x) { return __builtin_amdgcn_rcpf(1.0f + __builtin_amdgcn_exp2f(-1.4426950408889634f * x)); }
__device__ __forceinline__ float tanhf_(float x) { float e = __builtin_amdgcn_exp2f(2.8853900817779268f * x); return 1.0f - 2.0f * __builtin_amdgcn_rcpf(e + 1.0f); }
__device__ __forceinline__ float geluf_(float x) { return 0.5f * x * (1.0f + tanhf_(0.7978845608028654f * (x + 0.044715f * x * x * x))); }
template <int CTRL> __device__ __forceinline__ float dpp_add(float x) {
    int y = __builtin_amdgcn_update_dpp(0, __float_as_int(x), CTRL, 0xf, 0xf, false);
    return x + __int_as_float(y);
}
__device__ __forceinline__ float red4(float x) { x = dpp_add<0xB1>(x); x = dpp_add<0x4E>(x); return x; }
__device__ __forceinline__ float red8(float x) { x = red4(x); x = dpp_add<0x141>(x); return x; }
__device__ __forceinline__ float red16(float x) { x = red8(x); x = dpp_add<0x140>(x); return x; }
__device__ __forceinline__ int opaque_tid() { int t = threadIdx.x; asm volatile("" : "+v"(t)); return t; }
__device__ __forceinline__ int modrow_of(int row) { return row < M_CTX ? 0 : 1 + ((row - M_CTX) >> 12); }

#define XB_TMO 128
#define XB_XCNT(j) (256 + 64 * (j))
#define XB_XSUB(j) (1280 + 64 * (j))
#define XB_XGEN(j) (2304 + 64 * (j))
#define XB_TOP 3328
#define XB_TOPGEN 3392
#define XCD_BAR_WORDS 3456
#define XB_SPIN_CAP (1u << 22)
__device__ __forceinline__ unsigned xb_ld(unsigned* p) { return __hip_atomic_load(p, __ATOMIC_RELAXED, __HIP_MEMORY_SCOPE_AGENT); }
__device__ __forceinline__ unsigned xb_add(unsigned* p, unsigned v) { return __hip_atomic_fetch_add(p, v, __ATOMIC_RELAXED, __HIP_MEMORY_SCOPE_AGENT); }
__device__ __forceinline__ unsigned xb_xcc_id() { return (unsigned)__builtin_amdgcn_s_getreg((3 << 11) | 20) & 0xFu; }
#define XB_SPIN(cond, bar) do { unsigned _sp = 0; while (cond) { __builtin_amdgcn_s_sleep(1); \
    if ((++_sp & 255u) == 0u) { if (xb_ld(&(bar)[XB_TMO])) break; if (_sp > XB_SPIN_CAP) { atomicAdd(&(bar)[XB_TMO], 1u); break; } } } } while (0)
struct XcdBarrier { unsigned* bar; unsigned x; volatile LAS unsigned* st; };
__device__ __forceinline__ XcdBarrier xcd_barrier_post(unsigned* bar, volatile LAS unsigned* st) {
    XcdBarrier b; b.bar = bar; b.x = xb_xcc_id(); b.st = st;
    if (threadIdx.x == 0) (void)xb_add(&bar[XB_XCNT(b.x)], 1u);
    return b;
}
__device__ __forceinline__ void xcd_barrier_complete(unsigned* bar, unsigned x, unsigned& nloc, unsigned& nx) {
    const unsigned G = gridDim.x * gridDim.y * gridDim.z;
    unsigned sum, cnt, mine, sp = 0u;
    for (;;) {
        sum = 0u; cnt = 0u; mine = 0u;
#pragma unroll
        for (unsigned j = 0; j < 16; ++j) { const unsigned c = xb_ld(&bar[XB_XCNT(j)]); sum += c; cnt += (c > 0u) ? 1u : 0u; mine = (j == x) ? c : mine; }
        if (sum == G) break;
        __builtin_amdgcn_s_sleep(1);
        if ((++sp & 255u) == 0u) { if (xb_ld(&bar[XB_TMO])) break; if (sp > XB_SPIN_CAP) { atomicAdd(&bar[XB_TMO], 1u); break; } }
    }
    nloc = mine > 0u ? mine : 1u; nx = cnt > 0u ? cnt : 1u;
}
__device__ __forceinline__ void xcd_barrier(const XcdBarrier& b) {
    asm volatile("s_waitcnt vmcnt(0)" ::: "memory");
    __syncthreads();
    if (threadIdx.x == 0) {
        unsigned* bar = b.bar;
        __builtin_amdgcn_s_waitcnt(0);
        unsigned nloc = b.st[0], nx = b.st[1];
        if (nloc == 0u) { xcd_barrier_complete(bar, b.x, nloc, nx); b.st[0] = nloc; b.st[1] = nx; }
        const unsigned old = xb_add(&bar[XB_XSUB(b.x)], 1u);
        const unsigned gen = old / nloc;
        if (old + 1u == (gen + 1u) * nloc) {
            __builtin_amdgcn_fence(__ATOMIC_RELEASE, "agent");
            asm volatile("s_waitcnt vmcnt(0)" ::: "memory");
            const unsigned og = xb_add(&bar[XB_TOP], 1u);
            const unsigned tg = og / nx;
            if (og + 1u == (tg + 1u) * nx) xb_add(&bar[XB_TOPGEN], 1u);
            else XB_SPIN(xb_ld(&bar[XB_TOPGEN]) == tg, bar);
            __builtin_amdgcn_fence(__ATOMIC_ACQUIRE, "agent");
            xb_add(&bar[XB_XGEN(b.x)], 1u);
            asm volatile("s_waitcnt vmcnt(0)" ::: "memory");
        } else {
            XB_SPIN(xb_ld(&bar[XB_XGEN(b.x)]) == gen, bar);
            __builtin_amdgcn_fence(__ATOMIC_ACQUIRE, "agent");
            asm volatile("s_waitcnt vmcnt(0)" ::: "memory");
        }
    }
    __syncthreads();
}

template <class Epi>
__device__ __forceinline__ void gemm128(const bf16_t* __restrict__ A, int lda, const bf16_t* __restrict__ B, int ldb, int K, char* smem, const Epi& epi) {
    const int tid = opaque_tid(), lane = tid & 63, wid = tid >> 6, wr = wid >> 1, wc = wid & 1, fr = lane & 15, fq = lane >> 4;
    f32x4 acc[4][4];
#pragma unroll
    for (int m = 0; m < 4; ++m)
#pragma unroll
        for (int n = 0; n < 4; ++n) acc[m][n] = (f32x4){0.f, 0.f, 0.f, 0.f};
    const int crow = tid >> 3, ckc = tid & 7;
    const bf16_t* ap = A + (size_t)crow * lda + ckc * 8;
    const bf16_t* bp = B + (size_t)crow * ldb + ckc * 8;
    u32x4 ra[4], rb[4];
#pragma unroll
    for (int i = 0; i < 4; ++i) { ra[i] = *(const u32x4*)(ap + (size_t)(32 * i) * lda); rb[i] = *(const u32x4*)(bp + (size_t)(32 * i) * ldb); }
    {
        char* sa = smem; char* sb = smem + TILE_BYTES;
#pragma unroll
        for (int i = 0; i < 4; ++i) { *(u32x4*)(sa + ((crow + 32 * i) * LDS_STRIDE + ckc * 8) * 2) = ra[i]; *(u32x4*)(sb + ((crow + 32 * i) * LDS_STRIDE + ckc * 8) * 2) = rb[i]; }
    }
    __syncthreads();
    const int nk = K >> 6;
    for (int kt = 0; kt < nk; ++kt) {
        const bool more = (kt + 1 < nk);
        if (more) {
            const int k0 = (kt + 1) << 6;
#pragma unroll
            for (int i = 0; i < 4; ++i) { ra[i] = *(const u32x4*)(ap + (size_t)(32 * i) * lda + k0); rb[i] = *(const u32x4*)(bp + (size_t)(32 * i) * ldb + k0); }
        }
        const char* sa = smem + (kt & 1) * 2 * TILE_BYTES; const char* sb = sa + TILE_BYTES;
#pragma unroll
        for (int ks = 0; ks < 2; ++ks) {
            bf16x8 af[4], bfr[4];
#pragma unroll
            for (int m = 0; m < 4; ++m) af[m] = *(const bf16x8*)(sa + ((wr * 64 + m * 16 + fr) * LDS_STRIDE + ks * 32 + fq * 8) * 2);
#pragma unroll
            for (int n = 0; n < 4; ++n) bfr[n] = *(const bf16x8*)(sb + ((wc * 64 + n * 16 + fr) * LDS_STRIDE + ks * 32 + fq * 8) * 2);
            __builtin_amdgcn_s_setprio(1);
#pragma unroll
            for (int m = 0; m < 4; ++m)
#pragma unroll
                for (int n = 0; n < 4; ++n) acc[m][n] = __builtin_amdgcn_mfma_f32_16x16x32_bf16(af[m], bfr[n], acc[m][n], 0, 0, 0);
            __builtin_amdgcn_s_setprio(0);
        }
        if (more) {
            char* da = smem + ((kt + 1) & 1) * 2 * TILE_BYTES; char* db = da + TILE_BYTES;
#pragma unroll
            for (int i = 0; i < 4; ++i) { *(u32x4*)(da + ((crow + 32 * i) * LDS_STRIDE + ckc * 8) * 2) = ra[i]; *(u32x4*)(db + ((crow + 32 * i) * LDS_STRIDE + ckc * 8) * 2) = rb[i]; }
        }
        __syncthreads();
    }
    epi(acc, wr * 64, wc * 64, fr, fq);
}


#define L2_STRIDE 40
#define A2_BYTES (256 * L2_STRIDE * 2)
#define B2_BYTES (128 * L2_STRIDE * 2)
#define ST2_BYTES (A2_BYTES + B2_BYTES)
template <class Epi>
__device__ __forceinline__ void gemm256(const bf16_t* __restrict__ A, int lda, const bf16_t* __restrict__ B, int ldb, int K, char* smem, const Epi& epi) {
    const int tid = opaque_tid(), lane = tid & 63, wid = tid >> 6, wr = wid >> 1, wc = wid & 1, fr = lane & 15, fq = lane >> 4;
    f32x4 acc[2][4][4];
#pragma unroll
    for (int hh = 0; hh < 2; ++hh)
#pragma unroll
        for (int m = 0; m < 4; ++m)
#pragma unroll
            for (int n = 0; n < 4; ++n) acc[hh][m][n] = (f32x4){0.f, 0.f, 0.f, 0.f};
    const int crow = tid >> 2, ckc = tid & 3;
    const bf16_t* ap = A + (size_t)crow * lda + ckc * 8;
    const bf16_t* bp = B + (size_t)crow * ldb + ckc * 8;
    u32x4 ra[4], rb[2];
#pragma unroll
    for (int i = 0; i < 4; ++i) ra[i] = *(const u32x4*)(ap + (size_t)(64 * i) * lda);
#pragma unroll
    for (int i = 0; i < 2; ++i) rb[i] = *(const u32x4*)(bp + (size_t)(64 * i) * ldb);
    {
        char* sa = smem; char* sb = smem + A2_BYTES;
#pragma unroll
        for (int i = 0; i < 4; ++i) *(u32x4*)(sa + ((crow + 64 * i) * L2_STRIDE + ckc * 8) * 2) = ra[i];
#pragma unroll
        for (int i = 0; i < 2; ++i) *(u32x4*)(sb + ((crow + 64 * i) * L2_STRIDE + ckc * 8) * 2) = rb[i];
    }
    __syncthreads();
    const int nk = K >> 5;
    for (int kt = 0; kt < nk; ++kt) {
        const bool more = (kt + 1 < nk);
        if (more) {
            const int k0 = (kt + 1) << 5;
#pragma unroll
            for (int i = 0; i < 4; ++i) ra[i] = *(const u32x4*)(ap + (size_t)(64 * i) * lda + k0);
#pragma unroll
            for (int i = 0; i < 2; ++i) rb[i] = *(const u32x4*)(bp + (size_t)(64 * i) * ldb + k0);
        }
        const char* sa = smem + (kt & 1) * ST2_BYTES; const char* sb = sa + A2_BYTES;
        bf16x8 bfr[4];
#pragma unroll
        for (int n = 0; n < 4; ++n) bfr[n] = *(const bf16x8*)(sb + ((wc * 64 + n * 16 + fr) * L2_STRIDE + fq * 8) * 2);
#pragma unroll
        for (int hh = 0; hh < 2; ++hh) {
            bf16x8 af[4];
#pragma unroll
            for (int m = 0; m < 4; ++m) af[m] = *(const bf16x8*)(sa + ((wr * 128 + hh * 64 + m * 16 + fr) * L2_STRIDE + fq * 8) * 2);
            __builtin_amdgcn_s_setprio(1);
#pragma unroll
            for (int m = 0; m < 4; ++m)
#pragma unroll
                for (int n = 0; n < 4; ++n) acc[hh][m][n] = __builtin_amdgcn_mfma_f32_16x16x32_bf16(af[m], bfr[n], acc[hh][m][n], 0, 0, 0);
            __builtin_amdgcn_s_setprio(0);
        }
        if (more) {
            char* da = smem + ((kt + 1) & 1) * ST2_BYTES; char* db = da + A2_BYTES;
#pragma unroll
            for (int i = 0; i < 4; ++i) *(u32x4*)(da + ((crow + 64 * i) * L2_STRIDE + ckc * 8) * 2) = ra[i];
#pragma unroll
            for (int i = 0; i < 2; ++i) *(u32x4*)(db + ((crow + 64 * i) * L2_STRIDE + ckc * 8) * 2) = rb[i];
        }
        __syncthreads();
    }
    epi(acc[0], wr * 128, wc * 64, fr, fq);
    epi(acc[1], wr * 128 + 64, wc * 64, fr, fq);
}

struct EpiZ {
    bf16_t* Z; int R0, C0;
    __device__ __forceinline__ void operator()(f32x4 (&acc)[4][4], int r0, int c0, int fr, int fq) const {
#pragma unroll
        for (int n = 0; n < 4; ++n) { const int col = C0 + c0 + n * 16 + fr; if (col < NIN) {
#pragma unroll
            for (int m = 0; m < 4; ++m)
#pragma unroll
                for (int j = 0; j < 4; ++j) Z[(size_t)(R0 + r0 + m * 16 + fq * 4 + j) * NIN + col] = f2bf(acc[m][n][j]); } }
    }
};
struct EpiQ {
    bf16_t* Q; const float* rs; const float* ropeC; const float* ropeS; int R0, C0;
    __device__ __forceinline__ void operator()(f32x4 (&acc)[4][4], int r0, int c0, int fr, int fq) const {
        const bool lat = R0 >= M_CTX;
#pragma unroll
        for (int n = 0; n < 4; ++n) {
            const int cb = C0 + c0 + n * 16; const int hcs = cb % 96;
            if (lat && hcs == 80) continue;
            const bool rot = lat && hcs == 64;
#pragma unroll
            for (int m = 0; m < 4; ++m)
#pragma unroll
                for (int j = 0; j < 4; ++j) {
                    const int rl = r0 + m * 16 + fq * 4 + j; const int row = R0 + rl; const float s = rs[rl] * QSCALE;
                    const float x1 = acc[m][n][j] * s;
                    if (rot) {
                        const float x2 = acc[m][(n + 1) & 3][j] * s; const int t = (row - M_CTX) & 4095;
                        const float cv = ropeC[t * 16 + fr], sv = ropeS[t * 16 + fr];
                        Q[(size_t)row * 768 + cb + fr] = f2bf(x1 * cv - x2 * sv);
                        Q[(size_t)row * 768 + cb + 16 + fr] = f2bf(x1 * sv + x2 * cv);
                    } else Q[(size_t)row * 768 + cb + fr] = f2bf(x1);
                }
        }
    }
};
struct EpiKV {
    bf16_t* Kd; bf16_t* Vd; const float* rs; int R0, C0; int seqshift; size_t vbase0;
    __device__ __forceinline__ void operator()(f32x4 (&acc)[4][4], int r0, int c0, int fr, int fq) const {
#pragma unroll
        for (int n = 0; n < 4; ++n) {
            const int col = C0 + c0 + n * 16 + fr;
#pragma unroll
            for (int m = 0; m < 4; ++m) {
                const int rl = r0 + m * 16 + fq * 4; const int row = R0 + rl;
                float v[4];
#pragma unroll
                for (int j = 0; j < 4; ++j) v[j] = acc[m][n][j] * (rs ? rs[rl + j] : 1.0f);
                if (col < 512) {
                    const int h = col >> 6, d = col & 63;
#pragma unroll
                    for (int j = 0; j < 4; ++j) Kd[(size_t)(row + j) * 768 + h * 96 + d] = f2bf(v[j]);
                } else {
                    const int vc = col - 512, h = vc >> 6, dv = vc & 63; const int b = row >> seqshift, t = row & ((1 << seqshift) - 1);
                    u32x2 w; w.x = pack2(v[0], v[1]); w.y = pack2(v[2], v[3]);
                    *(u32x2*)(Vd + vbase0 + ((size_t)((b * 8 + h) * 64 + dv) << seqshift) + t) = w;
                }
            }
        }
    }
};
struct EpiRes {
    float* X; const float* gate; int R0, C0;
    __device__ __forceinline__ void operator()(f32x4 (&acc)[4][4], int r0, int c0, int fr, int fq) const {
#pragma unroll
        for (int n = 0; n < 4; ++n) { const int col = C0 + c0 + n * 16 + fr; const float g = gate[col];
#pragma unroll
            for (int m = 0; m < 4; ++m)
#pragma unroll
                for (int j = 0; j < 4; ++j) { float* px = X + (size_t)(R0 + r0 + m * 16 + fq * 4 + j) * DM + col; *px = ALPHA_F * (*px) + g * acc[m][n][j]; } }
    }
};
struct EpiSwi {
    bf16_t* H; int R0, C0;
    __device__ __forceinline__ void operator()(f32x4 (&acc)[4][4], int r0, int c0, int fr, int fq) const {
        const int hb = (C0 + c0) >> 1;
#pragma unroll
        for (int n = 0; n < 2; ++n)
#pragma unroll
            for (int m = 0; m < 4; ++m)
#pragma unroll
                for (int j = 0; j < 4; ++j) { const float g = acc[m][n][j], u = acc[m][n + 2][j];
                    H[(size_t)(R0 + r0 + m * 16 + fq * 4 + j) * DFF + hb + n * 16 + fr] = f2bf(g * sigmoidf_(g) * u); }
    }
};

__device__ __forceinline__ void ada_unit(const P& p, int u, char* smem) {
    const int tid = opaque_tid(); const int l = u / 96, c0 = (u % 96) * 64;
    float* cs = (float*)smem;
    for (int i = tid; i < 5 * 1024; i += 256) { const int r = i >> 10, k = i & 1023; const float v = (r == 0) ? p.c_ctx[k] : p.c[(r - 1) * 1024 + k]; cs[i] = v * sigmoidf_(v); }
    __syncthreads();
    const int col = tid & 63, kq = tid >> 6;
    float s0 = 0.f, s1 = 0.f, s2 = 0.f, s3 = 0.f, s4 = 0.f;
    const float* w = p.ada_w + ((size_t)l * 1024 + kq * 256) * 6144 + c0 + col;
    const float* cq = cs + kq * 256;
    for (int k = 0; k < 256; ++k) { const float wv = w[(size_t)k * 6144]; s0 += cq[k] * wv; s1 += cq[1024 + k] * wv; s2 += cq[2048 + k] * wv; s3 += cq[3072 + k] * wv; s4 += cq[4096 + k] * wv; }
    float* red = cs + 5 * 1024;
    red[(kq * 5 + 0) * 64 + col] = s0; red[(kq * 5 + 1) * 64 + col] = s1; red[(kq * 5 + 2) * 64 + col] = s2; red[(kq * 5 + 3) * 64 + col] = s3; red[(kq * 5 + 4) * 64 + col] = s4;
    __syncthreads();
    for (int o = tid; o < 320; o += 256) { const int i = o >> 6, cc = o & 63;
        const float v = red[(0 * 5 + i) * 64 + cc] + red[(1 * 5 + i) * 64 + cc] + red[(2 * 5 + i) * 64 + cc] + red[(3 * 5 + i) * 64 + cc] + p.ada_b[l * 6144 + c0 + cc];
        p.mod[((size_t)l * 5 + i) * 6144 + c0 + cc] = v; }
    __syncthreads();
}
__device__ __forceinline__ int map_col(int kind, int n) {
    if (kind == 1) { const int blk = n >> 6, r = n & 63; return r < 32 ? blk * 32 + r : DFF + blk * 32 + (r - 32); }
    if (kind == 2) { if (n < 512) return (n >> 6) * 128 + (n & 63); const int vc = n - 512; return (vc >> 6) * 128 + 64 + (vc & 63); }
    return n;
}
__device__ __forceinline__ void conv_tile(const float* src, int ldsrc, bf16_t* dst, bf16_t* dst2, int Kdst, int n0, int k0, int kind, int Nvalid, const float* kscale, char* smem) {
    const int tid = opaque_tid(); float* tile = (float*)smem;
    { const int j = tid & 63, i0 = tid >> 6; const int n = n0 + j; const int sc = (n < Nvalid) ? map_col(kind, n) : -1;
#pragma unroll 4
      for (int ii = 0; ii < 16; ++ii) { const int i = i0 + 4 * ii; tile[i * 65 + j] = (sc >= 0) ? src[(size_t)(k0 + i) * ldsrc + sc] : 0.f; } }
    __syncthreads();
    { const int i = tid & 63, j0 = tid >> 6; const float ks = kscale ? kscale[k0 + i] : 1.f;
#pragma unroll 4
      for (int jj = 0; jj < 16; ++jj) { const int jx = j0 + 4 * jj; const float v = tile[i * 65 + jx];
          dst[(size_t)(n0 + jx) * Kdst + k0 + i] = f2bf(v * ks); if (dst2) dst2[(size_t)(n0 + jx) * Kdst + k0 + i] = f2bf(v); } }
    __syncthreads();
}
#define NCONV 3032
__device__ __forceinline__ void conv_unit(const P& p, int l, int u, char* smem) {
    const float* src; int ldsrc; bf16_t* dst; bf16_t* dst2 = nullptr; int Kdst, n0, k0, kind = 0, Nvalid; const float* kscale = nullptr;
    if (u < 544) { src = p.w_in + (size_t)l * 1024 * NIN; ldsrc = NIN; dst = p.WtIn; Kdst = 1024; n0 = (u / 16) * 64; k0 = (u % 16) * 64; Nvalid = NIN; }
    else if (u < 592) { u -= 544; src = p.q_up + (size_t)l * 256 * 768; ldsrc = 768; dst = p.WtQ; Kdst = 256; n0 = (u / 4) * 64; k0 = (u % 4) * 64; Nvalid = 768; kscale = p.q_norm + l * 256; }
    else if (u < 624) { u -= 592; src = p.kv_up + (size_t)l * 128 * 1024; ldsrc = 1024; dst = p.WtKVn; dst2 = p.WtKV; Kdst = 128; n0 = (u / 2) * 64; k0 = (u % 2) * 64; kind = 2; Nvalid = 1024; kscale = p.kv_norm + l * 128; }
    else if (u < 880) { u -= 624; src = p.w_out + (size_t)l * 1024 * 1024; ldsrc = 1024; dst = p.WtOut; Kdst = 1024; n0 = (u / 16) * 64; k0 = (u % 16) * 64; Nvalid = 1024; }
    else if (u < 2288) { u -= 880; src = p.ffn_in + (size_t)l * 1024 * 5632; ldsrc = 5632; dst = p.WtF1; Kdst = 1024; n0 = (u / 16) * 64; k0 = (u % 16) * 64; kind = 1; Nvalid = 5632; }
    else if (u < 2992) { u -= 2288; src = p.ffn_out + (size_t)l * DFF * 1024; ldsrc = 1024; dst = p.WtF2; Kdst = DFF; n0 = (u / 44) * 64; k0 = (u % 44) * 64; Nvalid = 1024; }
    else if (u < 3008) { u -= 2992; const float* sp = p.gm_ws + (size_t)l * 65536 + u * 4096; bf16_t* d = p.WsB + u * 4096; for (int i = threadIdx.x; i < 4096; i += 256) d[i] = f2bf(sp[i]); return; }
    else if (u < 3016) { u -= 3008; const int d = u >> 2; src = p.rw_w2 + ((size_t)l * 2 + d) * 64 * 256; ldsrc = 256; dst = p.W2t + d * 256 * 64; Kdst = 64; n0 = (u & 3) * 64; k0 = 0; Nvalid = 256; }
    else if (u < 3024) { u -= 3016; const int d = u >> 2; src = p.rw_a2 + ((size_t)l * 2 + d) * 64 * 256; ldsrc = 256; dst = p.A2t + d * 256 * 64; Kdst = 64; n0 = (u & 3) * 64; k0 = 0; Nvalid = 256; }
    else { u -= 3024; src = p.rw_g2 + (size_t)l * 128 * 256; ldsrc = 256; dst = p.G2t; Kdst = 128; n0 = (u / 2) * 64; k0 = (u % 2) * 64; Nvalid = 256; }
    conv_tile(src, ldsrc, dst, dst2, Kdst, n0, k0, kind, Nvalid, kscale, smem);
}
__device__ __forceinline__ void misc0_unit(const P& p, int u) {
    const int tid = opaque_tid();
    if (u < 16) {
        for (int e = tid; e < 4096; e += 256) { const int idx = u * 4096 + e; const int t = idx >> 4, i = idx & 15;
            const float pos = (float)((i < 8) ? (t >> 6) : (t & 63)); const float inv = exp2f(-(float)(i & 7) * 1.6609640474436813f);
            const float ang = pos * inv; const float kf = rintf(ang * 0.15915494309189535f);
            float r = fmaf(-kf, 6.28318548202514648f, ang); r = fmaf(-kf, -1.74845553e-7f, r);
            p.ropeC[idx] = __cosf(r); p.ropeS[idx] = __sinf(r); }
    } else {
        const int v = u - 16;
        for (int e = tid; e < 4096; e += 256) { const int idx = v * 4096 + e;
            const int c = idx & 127, t = (idx >> 7) & 511, b = (idx >> 16) & 3, l = idx >> 18;
            p.CkvB[idx] = f2bf(p.cache_ckv[(((size_t)b * 4 + l) * 512 + t) * 128 + c]); }
    }
}

__device__ __forceinline__ void ln_phase(const P& p, int l, int which) {
    const int tid = opaque_tid(), lane = tid & 63, wid = tid >> 6;
    const float* g = which == 1 ? p.ln1_g + l * DM : p.ln2_g + l * DM; const float* bb = which == 1 ? p.ln1_b + l * DM : p.ln2_b + l * DM;
    const int ml = which == 2 ? l + 1 : l; const int shoff = which == 1 ? 3072 : 0, scoff = which == 1 ? 4096 : 1024;
    const bool dohb = !(which == 2 && l == 3);
    for (int row = blockIdx.x * 4 + wid; row < M_ALL; row += gridDim.x * 4) {
        float* xr = p.out + (size_t)row * DM;
        const float* src = which == 0 ? (row < M_CTX ? p.x_prompt + (size_t)row * DM : p.x_sample + (size_t)(row - M_CTX) * DM) : xr;
        f32x4 v[4];
#pragma unroll
        for (int i = 0; i < 4; ++i) v[i] = *(const f32x4*)(src + lane * 4 + 256 * i);
        if (which != 0) {
            float s = 0.f;
#pragma unroll
            for (int i = 0; i < 4; ++i) s += (v[i][0] + v[i][1]) + (v[i][2] + v[i][3]);
            s = red16(s); s += __shfl_xor(s, 16); s += __shfl_xor(s, 32);
            const float mu = s * (1.0f / 1024.0f); float q = 0.f;
#pragma unroll
            for (int i = 0; i < 4; ++i) { const f32x4 d = v[i] - mu; q += (d[0] * d[0] + d[1] * d[1]) + (d[2] * d[2] + d[3] * d[3]); }
            q = red16(q); q += __shfl_xor(q, 16); q += __shfl_xor(q, 32);
            const float rstd = rsqrtf(q * (1.0f / 1024.0f) + 1e-5f);
#pragma unroll
            for (int i = 0; i < 4; ++i) { const f32x4 gg = *(const f32x4*)(g + lane * 4 + 256 * i), bv = *(const f32x4*)(bb + lane * 4 + 256 * i); v[i] = (v[i] - mu) * rstd * gg + bv; }
        }
#pragma unroll
        for (int i = 0; i < 4; ++i) *(f32x4*)(xr + lane * 4 + 256 * i) = v[i];
        if (dohb) {
            const float* md = p.mod + ((size_t)ml * 5 + modrow_of(row)) * 6144;
#pragma unroll
            for (int i = 0; i < 4; ++i) { const f32x4 sh = *(const f32x4*)(md + shoff + lane * 4 + 256 * i), sc = *(const f32x4*)(md + scoff + lane * 4 + 256 * i);
                const f32x4 h = v[i] * (1.0f + sc) + sh; u32x2 w; w.x = pack2(h[0], h[1]); w.y = pack2(h[2], h[3]);
                *(u32x2*)(p.hbmix + (size_t)row * DM + lane * 4 + 256 * i) = w; }
        }
    }
}

__device__ __forceinline__ void rwprep_unit(const P& p, int l, int u, char* smem) {
    const int tid = opaque_tid(), lane = tid & 63, wid = tid >> 6, fr = lane & 15, fq = lane >> 4;
    const int R0 = u * 64;
    const int ss = R0 < M_CTX ? (R0 & ~255) : M_CTX + ((R0 - M_CTX) & ~4095); const int se = ss + (R0 < M_CTX ? 256 : 4096);
    bf16_t* XW = (bf16_t*)smem; bf16_t* XA = XW + 64 * 136; bf16_t* XG = XA + 64 * 136;
    const float* cw = p.rw_conv + (size_t)l * 3 * 1152;
    for (int it = tid; it < 576; it += 256) {
        const int cc = it % 144, tg = it / 144; const int c = cc * 8;
        float w0[8], w1[8], w2[8];
#pragma unroll
        for (int i = 0; i < 8; ++i) { w0[i] = cw[c + i]; w1[i] = cw[1152 + c + i]; w2[i] = cw[2304 + c + i]; }
        const int rfirst = R0 + tg * 16;
        u32x4 prev = (u32x4){0u, 0u, 0u, 0u}, cur, nxt;
        if (rfirst - 1 >= ss) prev = *(const u32x4*)(p.Z + (size_t)(rfirst - 1) * NIN + c);
        cur = *(const u32x4*)(p.Z + (size_t)rfirst * NIN + c);
        for (int tt = 0; tt < 16; ++tt) {
            const int row = rfirst + tt;
            nxt = (u32x4){0u, 0u, 0u, 0u};
            if (row + 1 < se) nxt = *(const u32x4*)(p.Z + (size_t)(row + 1) * NIN + c);
            float o[8];
#pragma unroll
            for (int i = 0; i < 4; ++i) {
                o[2 * i] = w0[2 * i] * lo_bf(prev[i]) + w1[2 * i] * lo_bf(cur[i]) + w2[2 * i] * lo_bf(nxt[i]);
                o[2 * i + 1] = w0[2 * i + 1] * hi_bf(prev[i]) + w1[2 * i + 1] * hi_bf(cur[i]) + w2[2 * i + 1] * hi_bf(nxt[i]);
            }
            if (c >= 768 && c < 896) {
#pragma unroll
                for (int i = 0; i < 8; ++i) o[i] = tanhf_(o[i]);
            } else if (c >= 1024) {
#pragma unroll
                for (int i = 0; i < 8; ++i) o[i] = sigmoidf_(o[i]);
            }
            u32x4 w; w.x = pack2(o[0], o[1]); w.y = pack2(o[2], o[3]); w.z = pack2(o[4], o[5]); w.w = pack2(o[6], o[7]);
            const int tl = tg * 16 + tt;
            if (c < 768) *(u32x4*)(p.RKV + (size_t)row * 768 + c) = w;
            else if (c < 896) *(u32x4*)(XW + tl * 136 + (c - 768)) = w;
            else if (c < 1024) *(u32x4*)(XA + tl * 136 + (c - 896)) = w;
            else *(u32x4*)(XG + tl * 136 + (c - 1024)) = w;
            prev = cur; cur = nxt;
        }
    }
    __syncthreads();
#pragma unroll 1
    for (int mh = 0; mh < 10; ++mh) {
        const int mat = mh >> 1, nh = mh & 1;
        const int d = mat & 1; const bf16_t* As; const bf16_t* Bw; int kofs, nks, ldw;
        if (mat < 2) { As = XW; Bw = p.W2t + d * 256 * 64; kofs = d * 64; nks = 2; ldw = 64; }
        else if (mat < 4) { As = XA; Bw = p.A2t + d * 256 * 64; kofs = d * 64; nks = 2; ldw = 64; }
        else { As = XG; Bw = p.G2t; kofs = 0; nks = 4; ldw = 128; }
        f32x4 acc[4][2];
#pragma unroll
        for (int m = 0; m < 4; ++m)
#pragma unroll
            for (int n = 0; n < 2; ++n) acc[m][n] = (f32x4){0.f, 0.f, 0.f, 0.f};
#pragma unroll 1
        for (int ks = 0; ks < nks; ++ks) {
            bf16x8 af[4], bfr[2];
#pragma unroll
            for (int m = 0; m < 4; ++m) af[m] = *(const bf16x8*)(As + (m * 16 + fr) * 136 + kofs + ks * 32 + fq * 8);
#pragma unroll
            for (int n = 0; n < 2; ++n) bfr[n] = *(const bf16x8*)(Bw + (size_t)(wid * 64 + nh * 32 + n * 16 + fr) * ldw + ks * 32 + fq * 8);
#pragma unroll
            for (int m = 0; m < 4; ++m)
#pragma unroll
                for (int n = 0; n < 2; ++n) acc[m][n] = __builtin_amdgcn_mfma_f32_16x16x32_bf16(af[m], bfr[n], acc[m][n], 0, 0, 0);
        }
#pragma unroll
        for (int n = 0; n < 2; ++n) {
            const int c = wid * 64 + nh * 32 + n * 16 + fr;
            float bias = 0.f; if (mat < 2) bias = p.rw_w0[(l * 2 + d) * 256 + c]; else if (mat < 4) bias = p.rw_a0[(l * 2 + d) * 256 + c];
            bf16_t* dst; float mul;
            if (mat < 2) { dst = p.Ee + ((size_t)d * M_ALL + R0) * 256 + c; mul = 0.6065306597126334f; }
            else if (mat < 4) { dst = p.Aa + ((size_t)d * M_ALL + R0) * 256 + c; mul = 1.0f; }
            else { dst = p.Gg + (size_t)R0 * 256 + c; mul = 1.0f; }
#pragma unroll
            for (int m = 0; m < 4; ++m)
#pragma unroll
                for (int j = 0; j < 4; ++j) {
                    const float x = acc[m][n][j] + bias;
                    dst[(size_t)(m * 16 + fq * 4 + j) * 256] = f2bf(mat < 4 ? mul * sigmoidf_(x) : x);
                }
        }
    }
    __syncthreads();
}
__device__ __forceinline__ void rowscale128(const bf16_t* Z, int R0, int zoff, int ncols, float eps, float* rs) {
    const int tid = opaque_tid(); const int r = tid >> 1, half = tid & 1; const int per = ncols >> 1;
    const bf16_t* zp = Z + (size_t)(R0 + r) * NIN + zoff + half * per;
    float ss = 0.f;
    for (int i = 0; i < per; i += 8) { const u32x4 w = *(const u32x4*)(zp + i);
#pragma unroll
        for (int q = 0; q < 4; ++q) { const float a = lo_bf(w[q]), b = hi_bf(w[q]); ss += a * a + b * b; } }
    ss = dpp_add<0xB1>(ss);
    if (half == 0) rs[r] = rsqrtf(ss / (float)ncols + eps);
}
__device__ __forceinline__ void small_unit(const P& p, int l, int u) {
    const int tid = opaque_tid(), sub = tid >> 5, li = tid & 31;
    if (u < 2560) {
        const int row = u * 8 + sub; const bf16_t* zr = p.Z + (size_t)row * NIN;
        const u32x2 w = *(const u32x2*)(zr + ZKV + li * 4);
        const float z0 = lo_bf(w.x), z1 = hi_bf(w.x), z2 = lo_bf(w.y), z3 = hi_bf(w.y);
        float ss = z0 * z0 + z1 * z1 + z2 * z2 + z3 * z3; ss = red16(ss); ss += __shfl_xor(ss, 16);
        const float rsv = rsqrtf(ss * (1.0f / 128.0f) + 1e-6f);
        const float x1 = bf2f(zr[ZKR + (li & 15)]), x2 = bf2f(zr[ZKR + 16 + (li & 15)]);
        float val;
        if (row < M_CTX) {
            const int b = row >> 8, t = row & 255; const size_t o = ((size_t)(b * 4 + l) * 256 + t);
            const f32x4 g = *(const f32x4*)(p.kv_norm + l * 128 + li * 4);
            *(f32x4*)(p.out + 20971520 + o * 128 + li * 4) = (f32x4){z0 * rsv * g[0], z1 * rsv * g[1], z2 * rsv * g[2], z3 * rsv * g[3]};
            val = li < 16 ? x1 : x2;
            p.out[20971520 + 2097152 + o * 32 + li] = val;
        } else {
            const int t = (row - M_CTX) & 4095; const float cv = p.ropeC[t * 16 + (li & 15)], sv = p.ropeS[t * 16 + (li & 15)];
            val = li < 16 ? x1 * cv - x2 * sv : x1 * sv + x2 * cv;
        }
        const bf16_t bv = f2bf(val);
#pragma unroll
        for (int h = 0; h < 8; ++h) p.Kb[(size_t)row * 768 + h * 96 + 64 + li] = bv;
    } else {
        const int r = (u - 2560) * 8 + sub; const int b = r >> 9, t = r & 511;
        const bf16_t bv = f2bf(p.cache_krope[((size_t)(b * 4 + l) * 512 + t) * 32 + li]);
#pragma unroll
        for (int h = 0; h < 8; ++h) p.Kc[(size_t)r * 768 + h * 96 + 64 + li] = bv;
    }
}
__device__ __forceinline__ void gmlp_unit(const P& p, int l, int u, char* smem) {
    const int tid = opaque_tid(), lane = tid & 63, wid = tid >> 6, fr = lane & 15, fq = lane >> 4;
    const int R0 = (u >> 2) * 128, g = u & 3;
    bf16_t* VnT = (bf16_t*)smem;
    {
        const int tok = tid >> 1, half = tid & 1; const bf16_t* zp = p.Z + (size_t)(R0 + tok) * NIN + ZV + g * 64 + half * 32;
        float x[32];
#pragma unroll
        for (int i = 0; i < 4; ++i) { const u32x4 w = *(const u32x4*)(zp + i * 8);
#pragma unroll
            for (int q = 0; q < 4; ++q) { x[i * 8 + 2 * q] = geluf_(lo_bf(w[q])); x[i * 8 + 2 * q + 1] = geluf_(hi_bf(w[q])); } }
        float s = 0.f;
#pragma unroll
        for (int i = 0; i < 32; ++i) s += x[i];
        s = dpp_add<0xB1>(s); const float mu = s * (1.0f / 64.0f);
        float q2 = 0.f;
#pragma unroll
        for (int i = 0; i < 32; ++i) { const float d = x[i] - mu; q2 += d * d; }
        q2 = dpp_add<0xB1>(q2); const float rstd = rsqrtf(q2 * (1.0f / 64.0f) + 1e-5f);
        const float* gg = p.gm_g + l * 256 + g * 64 + half * 32; const float* gb = p.gm_b + l * 256 + g * 64 + half * 32;
#pragma unroll
        for (int i = 0; i < 32; ++i) VnT[(half * 32 + i) * 136 + tok] = f2bf((x[i] - mu) * rstd * gg[i] + gb[i]);
    }
    __syncthreads();
    f32x4 acc[2][4];
#pragma unroll
    for (int m = 0; m < 2; ++m)
#pragma unroll
        for (int n = 0; n < 4; ++n) acc[m][n] = (f32x4){0.f, 0.f, 0.f, 0.f};
    const bf16_t* Wg = p.WsB + g * 128 * 128;
#pragma unroll
    for (int ks = 0; ks < 4; ++ks) {
        bf16x8 af[2], bfr[4];
#pragma unroll
        for (int m = 0; m < 2; ++m) af[m] = *(const bf16x8*)(Wg + (wid * 32 + m * 16 + fr) * 128 + ks * 32 + fq * 8);
#pragma unroll
        for (int n = 0; n < 4; ++n) bfr[n] = *(const bf16x8*)(VnT + (n * 16 + fr) * 136 + ks * 32 + fq * 8);
#pragma unroll
        for (int m = 0; m < 2; ++m)
#pragma unroll
            for (int n = 0; n < 4; ++n) acc[m][n] = __builtin_amdgcn_mfma_f32_16x16x32_bf16(af[m], bfr[n], acc[m][n], 0, 0, 0);
    }
#pragma unroll
    for (int m = 0; m < 2; ++m)
#pragma unroll
        for (int j = 0; j < 4; ++j) {
            const int pp = wid * 32 + m * 16 + fq * 4 + j; const float bs = p.gm_bs[l * 512 + g * 128 + pp];
#pragma unroll
            for (int n = 0; n < 4; ++n) { const int c = n * 16 + fr;
                const float uu = geluf_(bf2f(p.Z[(size_t)(R0 + pp) * NIN + ZU + g * 64 + c]));
                p.hbmix[(size_t)(R0 + pp) * DM + 768 + g * 64 + c] = f2bf(uu * (acc[m][n][j] + bs)); }
        }
    __syncthreads();
}

__device__ __forceinline__ float swap16_add(float x) {
    auto r = __builtin_amdgcn_permlane16_swap(__float_as_uint(x), __float_as_uint(x), false, false);
    return __uint_as_float(r[0]) + __uint_as_float(r[1]);
}
#define NSCAN_LAT 256
#define NSCAN (256 + 1024)
__device__ __forceinline__ void scan_unit(const P& p, int l, int u, char* smem) {
    const int tid = opaque_tid(), lane = tid & 63, wid = tid >> 6;
    int b, T, row0; const bool lat = u < NSCAN_LAT;
    if (lat) { b = u >> 6; T = 4096; row0 = M_CTX + b * 4096; } else { b = (u - NSCAN_LAT) >> 6; T = 256; row0 = b * 256; }
    const int h = (u >> 4) & 3, d = (u >> 3) & 1, rsl = u & 7;
    float* W = (float*)smem; float* NKK = W + 2048; float* KKA = NKK + 2048; float* KD = KKA + 2048; float* RR = KD + 2048; float* VS = RR + 2048; float* OUTP = VS + 256;
    const int rl = lane >> 5, kq = lane & 31; const int r8 = wid * 2 + rl; const int row = rsl * 8 + r8;
    f32x2 S = (f32x2){0.f, 0.f};
    const size_t stoff = ((((size_t)b * 4 + l) * 2 + d) * 4 + h) * 4096 + row * 64 + kq * 2;
    if (lat) S = *(const f32x2*)(p.state_rwkv + stoff);
    const int tok = tid >> 3, cg8 = tid & 7;
    float kkp[8], kap[8];
#pragma unroll
    for (int i = 0; i < 8; ++i) { kkp[i] = p.rw_kk[l * 256 + h * 64 + cg8 * 8 + i]; kap[i] = p.rw_ka[l * 256 + h * 64 + cg8 * 8 + i]; }
    const int nch = T >> 5;
    u32x4 r8v, k8, e8, a8, v8;
    int grow, grow_prev = 0; float oreg = 0.f;
    {
        const int sidx = tok; const int t = d ? T - 1 - sidx : sidx; grow = row0 + t;
        r8v = *(const u32x4*)(p.RKV + (size_t)grow * 768 + h * 64 + cg8 * 8);
        k8 = *(const u32x4*)(p.RKV + (size_t)grow * 768 + 256 + h * 64 + cg8 * 8);
        v8 = *(const u32x4*)(p.RKV + (size_t)grow * 768 + 512 + h * 64 + rsl * 8);
        e8 = *(const u32x4*)(p.Ee + ((size_t)d * M_ALL + grow) * 256 + h * 64 + cg8 * 8);
        a8 = *(const u32x4*)(p.Aa + ((size_t)d * M_ALL + grow) * 256 + h * 64 + cg8 * 8);
    }
    for (int ch = 0; ch < nch; ++ch) {
        {
            float kf[8], kkv[8], rf[8], ef[8], af[8];
#pragma unroll
            for (int q = 0; q < 4; ++q) { kf[2 * q] = lo_bf(k8[q]); kf[2 * q + 1] = hi_bf(k8[q]); rf[2 * q] = lo_bf(r8v[q]); rf[2 * q + 1] = hi_bf(r8v[q]);
                ef[2 * q] = lo_bf(e8[q]); ef[2 * q + 1] = hi_bf(e8[q]); af[2 * q] = lo_bf(a8[q]); af[2 * q + 1] = hi_bf(a8[q]); }
            float ss = 0.f;
#pragma unroll
            for (int i = 0; i < 8; ++i) { kkv[i] = kf[i] * kkp[i]; ss += kkv[i] * kkv[i]; }
            ss = red8(ss);
            const float inv = rsqrtf(fmaxf(ss, 1e-24f));
            f32x4 o0, o1; const int base = tok * 64 + cg8 * 8;
#pragma unroll
            for (int i = 0; i < 4; ++i) { o0[i] = __expf(-ef[i]); o1[i] = __expf(-ef[4 + i]); }
            *(f32x4*)(W + base) = o0; *(f32x4*)(W + base + 4) = o1;
#pragma unroll
            for (int i = 0; i < 4; ++i) { o0[i] = -kkv[i] * inv; o1[i] = -kkv[4 + i] * inv; }
            *(f32x4*)(NKK + base) = o0; *(f32x4*)(NKK + base + 4) = o1;
#pragma unroll
            for (int i = 0; i < 4; ++i) { o0[i] = kkv[i] * inv * af[i]; o1[i] = kkv[4 + i] * inv * af[4 + i]; }
            *(f32x4*)(KKA + base) = o0; *(f32x4*)(KKA + base + 4) = o1;
#pragma unroll
            for (int i = 0; i < 4; ++i) { o0[i] = kf[i] * (1.0f + (af[i] - 1.0f) * kap[i]); o1[i] = kf[4 + i] * (1.0f + (af[4 + i] - 1.0f) * kap[4 + i]); }
            *(f32x4*)(KD + base) = o0; *(f32x4*)(KD + base + 4) = o1;
#pragma unroll
            for (int i = 0; i < 4; ++i) { o0[i] = rf[i]; o1[i] = rf[4 + i]; }
            *(f32x4*)(RR + base) = o0; *(f32x4*)(RR + base + 4) = o1;
            if (cg8 == 0) {
#pragma unroll
                for (int q = 0; q < 4; ++q) { VS[tok * 8 + 2 * q] = lo_bf(v8[q]); VS[tok * 8 + 2 * q + 1] = hi_bf(v8[q]); }
            }
        }
        __syncthreads();
        if (ch > 0) p.ydir[((size_t)d * M_ALL + grow_prev) * 256 + h * 64 + rsl * 8 + cg8] = oreg;
        grow_prev = grow;
        if (ch + 1 < nch) {
            const int sidx = (ch + 1) * 32 + tok; const int t = d ? T - 1 - sidx : sidx; grow = row0 + t;
            r8v = *(const u32x4*)(p.RKV + (size_t)grow * 768 + h * 64 + cg8 * 8);
            k8 = *(const u32x4*)(p.RKV + (size_t)grow * 768 + 256 + h * 64 + cg8 * 8);
            v8 = *(const u32x4*)(p.RKV + (size_t)grow * 768 + 512 + h * 64 + rsl * 8);
            e8 = *(const u32x4*)(p.Ee + ((size_t)d * M_ALL + grow) * 256 + h * 64 + cg8 * 8);
            a8 = *(const u32x4*)(p.Aa + ((size_t)d * M_ALL + grow) * 256 + h * 64 + cg8 * 8);
        }
        {
            const float* Wq = W + kq * 2; const float* NKq = NKK + kq * 2; const float* KAq = KKA + kq * 2; const float* KDq = KD + kq * 2; const float* RRq = RR + kq * 2; const float* VSq = VS + r8;
            float* OPq = OUTP + r8 * 32 + kq;
            f32x2 wv[4], nkv[4], kav[4], kdv[4], rrv[4]; float vv[4];
#define SCAN_LD(slot, st) do { wv[slot] = *(const f32x2*)(Wq + (st) * 64); nkv[slot] = *(const f32x2*)(NKq + (st) * 64); kav[slot] = *(const f32x2*)(KAq + (st) * 64); \
        kdv[slot] = *(const f32x2*)(KDq + (st) * 64); rrv[slot] = *(const f32x2*)(RRq + (st) * 64); vv[slot] = VSq[(st) * 8]; } while (0)
            __builtin_amdgcn_s_setprio(3);
            SCAN_LD(0, 0); SCAN_LD(1, 1); SCAN_LD(2, 2);
#pragma unroll
            for (int s = 0; s < 32; ++s) {
                if (s + 3 < 32) SCAN_LD((s + 3) & 3, s + 3);
                const f32x2 w = wv[s & 3], nk = nkv[s & 3], ka = kav[s & 3], kd = kdv[s & 3], rr = rrv[s & 3]; const float v = vv[s & 3];
                float pd = fmaf(S[1], nk[1], S[0] * nk[0]);
                pd = red16(pd); pd = swap16_add(pd);
                S[0] = fmaf(S[0], w[0], fmaf(pd, ka[0], v * kd[0]));
                S[1] = fmaf(S[1], w[1], fmaf(pd, ka[1], v * kd[1]));
                OPq[s * 256] = fmaf(S[1], rr[1], S[0] * rr[0]);
            }
            __builtin_amdgcn_s_setprio(0);
        }
        __syncthreads();
        {
            const float* op = OUTP + (tok * 8 + cg8) * 32;
            f32x4 a0 = *(const f32x4*)(op), a1 = *(const f32x4*)(op + 4), a2 = *(const f32x4*)(op + 8), a3 = *(const f32x4*)(op + 12);
            f32x4 b0 = *(const f32x4*)(op + 16), b1 = *(const f32x4*)(op + 20), b2 = *(const f32x4*)(op + 24), b3 = *(const f32x4*)(op + 28);
            a0 = ((a0 + a1) + (a2 + a3)) + ((b0 + b1) + (b2 + b3));
            oreg = (a0[0] + a0[1]) + (a0[2] + a0[3]);
        }
    }
    p.ydir[((size_t)d * M_ALL + grow_prev) * 256 + h * 64 + rsl * 8 + cg8] = oreg;
    if (!lat) *(f32x2*)(p.out + 20971520 + 2097152 + 524288 + stoff) = S;
    __syncthreads();
}

#define KS_STRIDE 104
#define VS_STRIDE 72
#define KS_BYTES (64 * KS_STRIDE * 2)
#define ATT_STAGE (KS_BYTES + 64 * VS_STRIDE * 2)
__device__ __forceinline__ void attn_unit(const P& p, int u, char* smem) {
    const int tid = opaque_tid(), lane = tid & 63, wid = tid >> 6, q = lane & 31, hf = lane >> 5;
    int b, h, qt, qrow0, krow0, nown, ntot, Tv; size_t vbase, vcbase = 0; int kcrow0 = 0;
    if (u < 1024) { b = u >> 8; h = (u >> 5) & 7; qt = u & 31; krow0 = M_CTX + b * 4096; qrow0 = krow0 + qt * 128; nown = 64; ntot = 72; Tv = 4096;
        vbase = 2097152 + (size_t)(b * 8 + h) * 64 * 4096; kcrow0 = b * 512; vcbase = (size_t)(b * 8 + h) * 64 * 512; }
    else { const int v = u - 1024; b = v >> 4; h = (v >> 1) & 7; qt = v & 1; krow0 = b * 256; qrow0 = krow0 + qt * 128; nown = 4; ntot = 4; Tv = 256; vbase = (size_t)(b * 8 + h) * 64 * 256; }
    bf16x8 qf[6];
    { const bf16_t* qp = p.Qb + (size_t)(qrow0 + wid * 32 + q) * 768 + h * 96 + hf * 8;
#pragma unroll
      for (int ks = 0; ks < 6; ++ks) qf[ks] = *(const bf16x8*)(qp + ks * 16); }
    f32x16 oT[2];
#pragma unroll
    for (int i = 0; i < 16; ++i) { oT[0][i] = 0.f; oT[1][i] = 0.f; }
    float mrun = -1e30f, lrun = 0.f;
    u32x4 rk[3], rv[2];
    int krow[3], kc[3];
#pragma unroll
    for (int i = 0; i < 3; ++i) { const int c = tid + 256 * i; krow[i] = c / 12; kc[i] = c % 12; }
    const int vdv0 = tid >> 3, vkc = tid & 7;
#define ATT_LOAD(kt) do { const bf16_t* kptr; const bf16_t* vptr; int vstr; \
        if ((kt) < nown) { kptr = p.Kb + (size_t)(krow0 + (kt) * 64) * 768 + h * 96; vptr = p.Vt + vbase + (kt) * 64; vstr = Tv; } \
        else { kptr = p.Kc + (size_t)(kcrow0 + ((kt) - nown) * 64) * 768 + h * 96; vptr = p.Vtc + vcbase + ((kt) - nown) * 64; vstr = 512; } \
        _Pragma("unroll") for (int i = 0; i < 3; ++i) rk[i] = *(const u32x4*)(kptr + (size_t)krow[i] * 768 + kc[i] * 8); \
        _Pragma("unroll") for (int i = 0; i < 2; ++i) rv[i] = *(const u32x4*)(vptr + (size_t)(vdv0 + 32 * i) * vstr + vkc * 8); } while (0)
#define ATT_STORE(buf) do { char* Ks_ = smem + (buf) * ATT_STAGE; char* Vs_ = Ks_ + KS_BYTES; \
        _Pragma("unroll") for (int i = 0; i < 3; ++i) *(u32x4*)(Ks_ + (krow[i] * KS_STRIDE + kc[i] * 8) * 2) = rk[i]; \
        _Pragma("unroll") for (int i = 0; i < 2; ++i) *(u32x4*)(Vs_ + ((vdv0 + 32 * i) * VS_STRIDE + vkc * 8) * 2) = rv[i]; } while (0)
    ATT_LOAD(0); ATT_STORE(0);
    __syncthreads();
    for (int kt = 0; kt < ntot; ++kt) {
        const bool more = kt + 1 < ntot;
        if (more) ATT_LOAD(kt + 1);
        const char* Ks = smem + (kt & 1) * ATT_STAGE; const char* Vs = Ks + KS_BYTES;
        f32x16 sT[2];
#pragma unroll
        for (int i = 0; i < 16; ++i) { sT[0][i] = 0.f; sT[1][i] = 0.f; }
#pragma unroll
        for (int kb = 0; kb < 2; ++kb)
#pragma unroll
            for (int ks = 0; ks < 6; ++ks) { const bf16x8 kf = *(const bf16x8*)(Ks + ((kb * 32 + q) * KS_STRIDE + ks * 16 + hf * 8) * 2);
                sT[kb] = __builtin_amdgcn_mfma_f32_32x32x16_bf16(kf, qf[ks], sT[kb], 0, 0, 0); }
        float mx = sT[0][0];
#pragma unroll
        for (int i = 1; i < 16; ++i) mx = fmaxf(mx, sT[0][i]);
#pragma unroll
        for (int i = 0; i < 16; ++i) mx = fmaxf(mx, sT[1][i]);
        mx = fmaxf(mx, __shfl_xor(mx, 32));
        const float mnew = fmaxf(mrun, mx); const float alpha = __builtin_amdgcn_exp2f(mrun - mnew); const bool resc = __any(mnew > mrun); mrun = mnew;
        float psum = 0.f; bf16x8 pf[2][2];
#pragma unroll
        for (int kb = 0; kb < 2; ++kb)
#pragma unroll
            for (int s = 0; s < 2; ++s) { float e[8];
#pragma unroll
                for (int j = 0; j < 8; ++j) { e[j] = __builtin_amdgcn_exp2f(sT[kb][8 * s + j] - mnew); psum += e[j]; }
                u32x4 w; w.x = pack2(e[0], e[1]); w.y = pack2(e[2], e[3]); w.z = pack2(e[4], e[5]); w.w = pack2(e[6], e[7]);
                pf[kb][s] = __builtin_bit_cast(bf16x8, w); }
        lrun = lrun * alpha + psum;
        if (resc) {
#pragma unroll
            for (int i = 0; i < 16; ++i) { oT[0][i] *= alpha; oT[1][i] *= alpha; }
        }
#pragma unroll
        for (int kb = 0; kb < 2; ++kb)
#pragma unroll
            for (int s = 0; s < 2; ++s)
#pragma unroll
                for (int db = 0; db < 2; ++db) {
                    const char* vp = Vs + ((db * 32 + q) * VS_STRIDE + kb * 32 + 16 * s + 4 * hf) * 2;
                    const u32x2 lo = *(const u32x2*)vp, hi = *(const u32x2*)(vp + 16);
                    const u32x4 w = (u32x4){lo.x, lo.y, hi.x, hi.y};
                    oT[db] = __builtin_amdgcn_mfma_f32_32x32x16_bf16(__builtin_bit_cast(bf16x8, w), pf[kb][s], oT[db], 0, 0, 0);
                }
        if (more) ATT_STORE((kt + 1) & 1);
        __syncthreads();
    }
    const float lt = lrun + __shfl_xor(lrun, 32); const float inv = 1.0f / lt;
    bf16_t* op = p.hbmix + (size_t)(qrow0 + wid * 32 + q) * DM + 256 + h * 64;
#pragma unroll
    for (int db = 0; db < 2; ++db)
#pragma unroll
        for (int g = 0; g < 4; ++g) { u32x2 w; w.x = pack2(oT[db][4 * g] * inv, oT[db][4 * g + 1] * inv); w.y = pack2(oT[db][4 * g + 2] * inv, oT[db][4 * g + 3] * inv);
            *(u32x2*)(op + db * 32 + 8 * g + 4 * hf) = w; }
}

__device__ __forceinline__ void rwcomb_phase(const P& p, int l) {
    const int tid = opaque_tid(), lane = tid & 63, wid = tid >> 6; const int c = lane * 4;
    const f32x4 gng = *(const f32x4*)(p.rw_gn_g + l * 256 + c), gnb = *(const f32x4*)(p.rw_gn_b + l * 256 + c), kap = *(const f32x4*)(p.rw_ka + l * 256 + c), rkp = *(const f32x4*)(p.rw_rk + l * 256 + c);
    for (int row = blockIdx.x * 4 + wid; row < M_ALL; row += gridDim.x * 4) {
        const f32x4 y0 = *(const f32x4*)(p.ydir + (size_t)row * 256 + c), y1 = *(const f32x4*)(p.ydir + ((size_t)M_ALL + row) * 256 + c);
        f32x4 y = y0 + y1;
        float s = (y[0] + y[1]) + (y[2] + y[3]); s = red16(s); const float mu = s * (1.0f / 64.0f);
        const f32x4 dd = y - mu; float q2 = (dd[0] * dd[0] + dd[1] * dd[1]) + (dd[2] * dd[2] + dd[3] * dd[3]); q2 = red16(q2);
        const float rstd = rsqrtf(q2 * (1.0f / 64.0f) + 64e-5f);
        const f32x4 yn = dd * rstd * gng + gnb;
        const u32x2 rw = *(const u32x2*)(p.RKV + (size_t)row * 768 + c), kw = *(const u32x2*)(p.RKV + (size_t)row * 768 + 256 + c), vw = *(const u32x2*)(p.RKV + (size_t)row * 768 + 512 + c);
        const u32x2 a0w = *(const u32x2*)(p.Aa + (size_t)row * 256 + c), a1w = *(const u32x2*)(p.Aa + ((size_t)M_ALL + row) * 256 + c), gw = *(const u32x2*)(p.Gg + (size_t)row * 256 + c);
        const f32x4 r = (f32x4){lo_bf(rw.x), hi_bf(rw.x), lo_bf(rw.y), hi_bf(rw.y)}, k = (f32x4){lo_bf(kw.x), hi_bf(kw.x), lo_bf(kw.y), hi_bf(kw.y)}, v = (f32x4){lo_bf(vw.x), hi_bf(vw.x), lo_bf(vw.y), hi_bf(vw.y)};
        const f32x4 a0 = (f32x4){lo_bf(a0w.x), hi_bf(a0w.x), lo_bf(a0w.y), hi_bf(a0w.y)}, a1 = (f32x4){lo_bf(a1w.x), hi_bf(a1w.x), lo_bf(a1w.y), hi_bf(a1w.y)}, gt = (f32x4){lo_bf(gw.x), hi_bf(gw.x), lo_bf(gw.y), hi_bf(gw.y)};
        const f32x4 kds = k * (1.0f + (a0 - 1.0f) * kap) + k * (1.0f + (a1 - 1.0f) * kap);
        const f32x4 t4 = r * kds * rkp; float rk = (t4[0] + t4[1]) + (t4[2] + t4[3]); rk = red16(rk);
        const f32x4 o = (yn + rk * v) * gt;
        u32x2 w; w.x = pack2(o[0], o[1]); w.y = pack2(o[2], o[3]);
        *(u32x2*)(p.hbmix + (size_t)row * DM + c) = w;
    }
}


__device__ __forceinline__ bool xcd_tile(int i, int TT, int NT, int& mt, int& nt) {
    const int per = TT >> 3; if (i >= per) return false;
    const int t = (blockIdx.x & 7) * per + i; const int band = t / (8 * NT), rem = t - band * 8 * NT;
    nt = rem >> 3; mt = band * 8 + (rem & 7); return true;
}
__global__ void __launch_bounds__(256, 2) mega(Args a_unused) {
    extern __shared__ __attribute__((aligned(16))) char smem[];
    __shared__ uint4 xbw; __shared__ int s_unit;
    kargp_t kp = (kargp_t)__builtin_amdgcn_kernarg_segment_ptr();
    const int tid = threadIdx.x; const int G = gridDim.x;
    if (tid == 0) xbw = make_uint4(0u, 0u, 0u, 0u);
    __syncthreads();
    XcdBarrier xb;
    { const P p = getP(kp); xb = xcd_barrier_post(p.bar, (volatile LAS unsigned*)&xbw); }
    for (int u = blockIdx.x; u < 384 + NCONV + 272; u += G) {
        if (u < 384) { const P p = getP(kp); ada_unit(p, u, smem); } else if (u < 384 + NCONV) { const P p = getP(kp); conv_unit(p, 0, u - 384, smem); } else { const P p = getP(kp); misc0_unit(p, u - 384 - NCONV); }
    }
    cg::this_grid().sync();
    { const P p = getP(kp); ln_phase(p, 0, 0); }
    xcd_barrier(xb);
    float* rs = (float*)(smem + RS_OFF);
#pragma unroll 1
    for (int l = 0; l < 4; ++l) {
        for (int i = blockIdx.x >> 3; ; i += G >> 3) { int mt, nt; if (!xcd_tile(i, 80 * 17, 17, mt, nt)) break; const P p = getP(kp);
            EpiZ e{p.Z, mt * 256, nt * 128};
            gemm256(p.hbmix + (size_t)mt * 256 * DM, DM, p.WtIn + (size_t)nt * 128 * DM, DM, DM, smem, e); }
        xcd_barrier(xb);
        for (int rep2 = 0; rep2 < DUP_P2; ++rep2) {
        for (;;) {
            { const P pc = getP(kp); if (tid == 0) s_unit = atomicAdd(&pc.ctr[l * 4 + 0 + 2 * rep2], 1); }
            __syncthreads(); int u = s_unit; __syncthreads();
            if (u >= 320 + 960 + 1408 + 2816 + 640) break;
            if (u < 320) { const P p = getP(kp); rwprep_unit(p, l, u, smem); continue; }
            u -= 320;
            if (u < 960) { const P p = getP(kp); const int mt = u / 6, nt = u % 6;
                rowscale128(p.Z, mt * 128, ZQ, 256, 1e-6f, rs);
                EpiQ e{p.Qb, rs, p.ropeC, p.ropeS, mt * 128, nt * 128};
                gemm128(p.Z + (size_t)mt * 128 * NIN + ZQ, NIN, p.WtQ + (size_t)nt * 128 * 256, 256, 256, smem, e); __syncthreads(); continue; }
            u -= 960;
            if (u < 1280) { const P p = getP(kp); const int mt = u >> 3, nt = u & 7; const int R0 = mt * 128; const bool latr = R0 >= M_CTX;
                rowscale128(p.Z, R0, ZKV, 128, 1e-6f, rs);
                EpiKV e{latr ? p.Kb + (size_t)M_CTX * 768 : p.Kb, p.Vt, rs, latr ? R0 - M_CTX : R0, nt * 128, latr ? 12 : 8, latr ? (size_t)2097152 : (size_t)0};
                gemm128(p.Z + (size_t)R0 * NIN + ZKV, NIN, p.WtKVn + (size_t)nt * 128 * 128, 128, 128, smem, e); __syncthreads(); continue; }
            u -= 1280;
            if (u < 128) { const P p = getP(kp); const int mt = u >> 3, nt = u & 7;
                EpiKV e{p.Kc, p.Vtc, nullptr, mt * 128, nt * 128, 9, (size_t)0};
                gemm128(p.CkvB + ((size_t)l * 2048 + mt * 128) * 128, 128, p.WtKV + (size_t)nt * 128 * 128, 128, 128, smem, e); continue; }
            u -= 128;
            if (u < 2816) { const P p = getP(kp); small_unit(p, l, u); continue; }
            u -= 2816;
            { const P p = getP(kp); gmlp_unit(p, l, u, smem); }
        }
        xcd_barrier(xb);
        }
        for (int rep3 = 0; rep3 < DUP_P3; ++rep3) {
        for (;;) {
            { const P pc = getP(kp); if (tid == 0) s_unit = atomicAdd(&pc.ctr[l * 4 + 1 + 2 * rep3], 1); }
            __syncthreads(); int u = s_unit; __syncthreads();
            if (u >= NSCAN + 1280) break;
#ifdef PROBE_SCAN_ONLY
            if (rep3 == 1 && u >= NSCAN) break;
#endif
#ifdef PROBE_ATTN_ONLY
            if (rep3 == 1 && u < NSCAN) continue;
#endif
            if (u < NSCAN) { const P p = getP(kp); scan_unit(p, l, u, smem); } else { const P p = getP(kp); attn_unit(p, u - NSCAN, smem); }
        }
        xcd_barrier(xb);
        }
        { const P p = getP(kp); rwcomb_phase(p, l); }
        xcd_barrier(xb);
        for (int i = blockIdx.x >> 3; ; i += G >> 3) { int mt, nt; if (!xcd_tile(i, 160 * 8, 8, mt, nt)) break; const P p = getP(kp);
            EpiRes e{p.out, p.mod + ((size_t)l * 5 + modrow_of(mt * 128)) * 6144 + 2048, mt * 128, nt * 128};
            gemm128(p.hbmix + (size_t)mt * 128 * DM, DM, p.WtOut + (size_t)nt * 128 * DM, DM, DM, smem, e); }
        xcd_barrier(xb);
        { const P p = getP(kp); ln_phase(p, l, 1); }
        xcd_barrier(xb);
        for (int rep5 = 0; rep5 < DUP_P5; ++rep5)
        for (int i = blockIdx.x >> 3; ; i += G >> 3) { int mt, nt; if (!xcd_tile(i, 80 * 44, 44, mt, nt)) break; const P p = getP(kp);
            EpiSwi e{p.hidden, mt * 256, nt * 128};
            gemm256(p.hbmix + (size_t)mt * 256 * DM, DM, p.WtF1 + (size_t)nt * 128 * DM, DM, DM, smem, e); }
        xcd_barrier(xb);
        for (int i = blockIdx.x >> 3; ; i += G >> 3) { int mt, nt; if (!xcd_tile(i, 160 * 8, 8, mt, nt)) break; const P p = getP(kp);
            EpiRes e{p.out, p.mod + ((size_t)l * 5 + modrow_of(mt * 128)) * 6144 + 5120, mt * 128, nt * 128};
            gemm128(p.hidden + (size_t)mt * 128 * DFF, DFF, p.WtF2 + (size_t)nt * 128 * DFF, DFF, DFF, smem, e); }
        xcd_barrier(xb);
        { const P p = getP(kp); ln_phase(p, l, 2); }
        if (l < 3) { for (int u = blockIdx.x; u < NCONV; u += G) { const P p = getP(kp); conv_unit(p, l + 1, u, smem); } }
        xcd_barrier(xb);
    }
}

extern "C" void kernel_launch(void* const* d_in, const int* in_sizes, int n_in, void* d_out, int out_size, void* d_ws, size_t ws_size, hipStream_t stream) {
    static int grid_blocks = 0;
    if (!grid_blocks) {
        int dev = 0, cus = 0, per_cu = 0;
        (void)hipGetDevice(&dev);
        (void)hipDeviceGetAttribute(&cus, hipDeviceAttributeMultiprocessorCount, dev);
        (void)hipFuncSetAttribute((const void*)mega, hipFuncAttributeMaxDynamicSharedMemorySize, SMEM_BYTES);
        (void)hipOccupancyMaxActiveBlocksPerMultiprocessor(&per_cu, (const void*)mega, 256, SMEM_BYTES);
        if (per_cu > 2) per_cu = 2;
        if (per_cu < 1) per_cu = 1;
        grid_blocks = (cus * per_cu) & ~7;
    }
    if (WS_TOTAL > ws_size) { fprintf(stderr, "kernel_launch: workspace too small: need %zu have %zu\n", (size_t)WS_TOTAL, ws_size); return; }
    Args a{};
    for (int i = 0; i < 36; ++i) a.in[i] = (const float*)d_in[i];
    a.out = (float*)d_out; a.ws = (char*)d_ws;
    (void)hipMemsetAsync((char*)d_ws + OFF_BAR, 0, 16384 + 4096, stream);
    void* args[] = {&a};
    hipError_t e = hipLaunchCooperativeKernel((const void*)mega, dim3(grid_blocks), dim3(256), args, SMEM_BYTES, stream);
    if (e != hipSuccess) fprintf(stderr, "cooperative launch failed: %s (grid %d)\n", hipGetErrorString(e), grid_blocks);
}
```

```cpp
#include <hip/hip_runtime.h>
#include <hip/hip_cooperative_groups.h>
#include <cstdint>
#include <cstdio>
namespace cg = cooperative_groups;

typedef unsigned short bf16_t;
typedef short bf16x8 __attribute__((ext_vector_type(8)));
typedef float f32x4 __attribute__((ext_vector_type(4)));
typedef float f32x2 __attribute__((ext_vector_type(2)));
typedef float f32x16 __attribute__((ext_vector_type(16)));
typedef unsigned u32x4 __attribute__((ext_vector_type(4)));
typedef unsigned u32x2 __attribute__((ext_vector_type(2)));

#define M_ALL 20480
#define M_CTX 4096
#define DM 1024
#define NIN 2080
#define DFF 2816
#define ALPHA_F 1.6817928305074290f
#define QSCALE (0.10206207261596575f * 1.4426950408889634f)
#define LAS __attribute__((address_space(3)))
#ifndef DUP_P2
#define DUP_P2 1
#endif
#ifndef DUP_P3
#define DUP_P3 1
#endif
#ifndef DUP_P5
#define DUP_P5 1
#endif

#define ZQ 1152
#define ZKV 1408
#define ZKR 1536
#define ZU 1568
#define ZV 1824

#define LDS_STRIDE 72
#define TILE_BYTES (128 * LDS_STRIDE * 2)
#define RS_OFF (4 * TILE_BYTES)
#define SMEM_BYTES (RS_OFF + 3072)

struct P {
    const float *x_prompt, *x_sample, *cache_ckv, *cache_krope, *state_rwkv, *c, *c_ctx, *ada_w, *ada_b, *w_in, *rw_conv, *rw_w0, *rw_w2,
        *rw_a0, *rw_a2, *rw_g2, *rw_kk, *rw_ka, *rw_rk, *rw_gn_g, *rw_gn_b, *q_norm, *q_up, *kv_norm, *kv_up, *gm_g, *gm_b, *gm_ws, *gm_bs,
        *w_out, *ln1_g, *ln1_b, *ffn_in, *ffn_out, *ln2_g, *ln2_b;
    float* out;
    unsigned* bar; int* ctr; float* mod; float* ropeC; float* ropeS; bf16_t* CkvB;
    bf16_t *WtIn, *WtQ, *WtKVn, *WtKV, *WtOut, *WtF1, *WtF2, *WsB, *W2t, *A2t, *G2t;
    bf16_t *Z, *RKV, *Ee, *Aa, *Gg, *Qb, *Kb, *Kc, *Vt, *Vtc, *hbmix, *hidden;
    float* ydir;
};


struct Args { const float* in[36]; float* out; char* ws; };
typedef const __attribute__((address_space(4))) char* kargp_t;
constexpr size_t al256(size_t x) { return (x + 255) & ~(size_t)255; }
constexpr size_t OFF_BAR = 0;
constexpr size_t OFF_CTR = OFF_BAR + 16384;
constexpr size_t OFF_MOD = OFF_CTR + 4096;
constexpr size_t OFF_ROPEC = OFF_MOD + al256((size_t)4 * 5 * 6144 * 4);
constexpr size_t OFF_ROPES = OFF_ROPEC + 65536 * 4;
constexpr size_t OFF_CKVB = OFF_ROPES + 65536 * 4;
constexpr size_t OFF_WTIN = OFF_CKVB + (size_t)4 * 2048 * 128 * 2;
constexpr size_t OFF_WTQ = OFF_WTIN + (size_t)2176 * 1024 * 2;
constexpr size_t OFF_WTKVN = OFF_WTQ + (size_t)768 * 256 * 2;
constexpr size_t OFF_WTKV = OFF_WTKVN + (size_t)1024 * 128 * 2;
constexpr size_t OFF_WTOUT = OFF_WTKV + (size_t)1024 * 128 * 2;
constexpr size_t OFF_WTF1 = OFF_WTOUT + (size_t)1024 * 1024 * 2;
constexpr size_t OFF_WTF2 = OFF_WTF1 + (size_t)5632 * 1024 * 2;
constexpr size_t OFF_WSB = OFF_WTF2 + (size_t)1024 * DFF * 2;
constexpr size_t OFF_W2T = OFF_WSB + (size_t)65536 * 2;
constexpr size_t OFF_A2T = OFF_W2T + (size_t)2 * 256 * 64 * 2;
constexpr size_t OFF_G2T = OFF_A2T + (size_t)2 * 256 * 64 * 2;
constexpr size_t OFF_Z = OFF_G2T + (size_t)256 * 128 * 2;
constexpr size_t OFF_HIDDEN = OFF_Z;
constexpr size_t OFF_RKV = OFF_Z + al256((size_t)M_ALL * NIN * 2);
constexpr size_t OFF_EE = OFF_RKV + (size_t)M_ALL * 768 * 2;
constexpr size_t OFF_AA = OFF_EE + (size_t)2 * M_ALL * 256 * 2;
constexpr size_t OFF_GG = OFF_AA + (size_t)2 * M_ALL * 256 * 2;
constexpr size_t OFF_QB = OFF_GG + (size_t)M_ALL * 256 * 2;
constexpr size_t OFF_KB = OFF_QB + (size_t)M_ALL * 768 * 2;
constexpr size_t OFF_KC = OFF_KB + (size_t)M_ALL * 768 * 2;
constexpr size_t OFF_VT = OFF_KC + (size_t)2048 * 768 * 2;
constexpr size_t OFF_VTC = OFF_VT + (size_t)M_ALL * 512 * 2;
constexpr size_t OFF_YDIR = OFF_VTC + (size_t)2048 * 512 * 2;
constexpr size_t OFF_HBMIX = OFF_YDIR + (size_t)2 * M_ALL * 256 * 4;
constexpr size_t WS_TOTAL = OFF_HBMIX + (size_t)M_ALL * DM * 2;
static_assert(OFF_RKV + (size_t)M_ALL * 768 * 2 - OFF_HIDDEN >= (size_t)M_ALL * DFF * 2, "hidden overlay");

__device__ __forceinline__ P getP(kargp_t& kp) {
    asm volatile("" : "+s"(kp));
    typedef const float* const __attribute__((address_space(4)))* inp_t;
    inp_t in = (inp_t)kp;
    P p;
    p.x_prompt = in[0]; p.x_sample = in[1]; p.cache_ckv = in[2]; p.cache_krope = in[3]; p.state_rwkv = in[4]; p.c = in[5]; p.c_ctx = in[6];
    p.ada_w = in[7]; p.ada_b = in[8]; p.w_in = in[9]; p.rw_conv = in[10]; p.rw_w0 = in[11]; p.rw_w2 = in[12]; p.rw_a0 = in[13]; p.rw_a2 = in[14];
    p.rw_g2 = in[15]; p.rw_kk = in[16]; p.rw_ka = in[17]; p.rw_rk = in[18]; p.rw_gn_g = in[19]; p.rw_gn_b = in[20]; p.q_norm = in[21]; p.q_up = in[22];
    p.kv_norm = in[23]; p.kv_up = in[24]; p.gm_g = in[25]; p.gm_b = in[26]; p.gm_ws = in[27]; p.gm_bs = in[28]; p.w_out = in[29]; p.ln1_g = in[30];
    p.ln1_b = in[31]; p.ffn_in = in[32]; p.ffn_out = in[33]; p.ln2_g = in[34]; p.ln2_b = in[35];
    p.out = (float*)in[36]; char* ws = (char*)in[37];
    p.bar = (unsigned*)(ws + OFF_BAR); p.ctr = (int*)(ws + OFF_CTR); p.mod = (float*)(ws + OFF_MOD); p.ropeC = (float*)(ws + OFF_ROPEC); p.ropeS = (float*)(ws + OFF_ROPES);
    p.CkvB = (bf16_t*)(ws + OFF_CKVB); p.WtIn = (bf16_t*)(ws + OFF_WTIN); p.WtQ = (bf16_t*)(ws + OFF_WTQ); p.WtKVn = (bf16_t*)(ws + OFF_WTKVN); p.WtKV = (bf16_t*)(ws + OFF_WTKV);
    p.WtOut = (bf16_t*)(ws + OFF_WTOUT); p.WtF1 = (bf16_t*)(ws + OFF_WTF1); p.WtF2 = (bf16_t*)(ws + OFF_WTF2); p.WsB = (bf16_t*)(ws + OFF_WSB); p.W2t = (bf16_t*)(ws + OFF_W2T);
    p.A2t = (bf16_t*)(ws + OFF_A2T); p.G2t = (bf16_t*)(ws + OFF_G2T); p.Z = (bf16_t*)(ws + OFF_Z); p.RKV = (bf16_t*)(ws + OFF_RKV); p.Ee = (bf16_t*)(ws + OFF_EE); p.Aa = (bf16_t*)(ws + OFF_AA);
    p.Gg = (bf16_t*)(ws + OFF_GG); p.Qb = (bf16_t*)(ws + OFF_QB); p.Kb = (bf16_t*)(ws + OFF_KB); p.Kc = (bf16_t*)(ws + OFF_KC); p.Vt = (bf16_t*)(ws + OFF_VT); p.Vtc = (bf16_t*)(ws + OFF_VTC);
    p.hbmix = (bf16_t*)(ws + OFF_HBMIX); p.hidden = (bf16_t*)(ws + OFF_HIDDEN); p.ydir = (float*)(ws + OFF_YDIR);
    return p;
}

__device__ __forceinline__ float bf2f(bf16_t b) { return __uint_as_float(((unsigned)b) << 16); }
__device__ __forceinline__ unsigned pack2(float lo, float hi) { unsigned r; asm("v_cvt_pk_bf16_f32 %0, %1, %2" : "=v"(r) : "v"(lo), "v"(hi)); return r; }
__device__ __forceinline__ bf16_t f2bf(float f) { return (bf16_t)(pack2(f, 0.f) & 0xffffu); }
__device__ __forceinline__ float lo_bf(unsigned w) { return __uint_as_float(w << 16); }
__device__ __forceinline__ float hi_bf(unsigned w) { return __uint_as_float(w & 0xffff0000u); }
__device__ __forceinline__ float sigmoidf_(float x) { return __builtin_amdgcn_rcpf(1.0f + __builtin_amdgcn_exp2f(-1.4426950408889634f * x)); }
__device__ __forceinline__ float tanhf_(float x) { float e = __builtin_amdgcn_exp2f(2.8853900817779268f * x); return 1.0f - 2.0f * __builtin_amdgcn_rcpf(e + 1.0f); }
__device__ __forceinline__ float geluf_(float x) { return 0.5f * x * (1.0f + tanhf_(0.7978845608028654f * (x + 0.044715f * x * x * x))); }
template <int CTRL> __device__ __forceinline__ float dpp_add(float x) {
    int y = __builtin_amdgcn_update_dpp(0, __float_as_int(x), CTRL, 0xf, 0xf, false);
    return x + __int_as_float(y);
}
__device__ __forceinline__ float red4(float x) { x = dpp_add<0xB1>(x); x = dpp_add<0x4E>(x); return x; }
__device__ __forceinline__ float red8(float x) { x = red4(x); x = dpp_add<0x141>(x); return x; }
__device__ __forceinline__ float red16(float x) { x = red8(x); x = dpp_add<0x140>(x); return x; }
__device__ __forceinline__ int opaque_tid() { int t = threadIdx.x; asm volatile("" : "+v"(t)); return t; }
__device__ __forceinline__ int modrow_of(int row) { return row < M_CTX ? 0 : 1 + ((row - M_CTX) >> 12); }

#define XB_TMO 128
#define XB_XCNT(j) (256 + 64 * (j))
#define XB_XSUB(j) (1280 + 64 * (j))
#define XB_XGEN(j) (2304 + 64 * (j))
#define XB_TOP 3328
#define XB_TOPGEN 3392
#define XCD_BAR_WORDS 3456
#define XB_SPIN_CAP (1u << 22)
__device__ __forceinline__ unsigned xb_ld(unsigned* p) { return __hip_atomic_load(p, __ATOMIC_RELAXED, __HIP_MEMORY_SCOPE_AGENT); }
__device__ __forceinline__ unsigned xb_add(unsigned* p, unsigned v) { return __hip_atomic_fetch_add(p, v, __ATOMIC_RELAXED, __HIP_MEMORY_SCOPE_AGENT); }
__device__ __forceinline__ unsigned xb_xcc_id() { return (unsigned)__builtin_amdgcn_s_getreg((3 << 11) | 20) & 0xFu; }
#define XB_SPIN(cond, bar) do { unsigned _sp = 0; while (cond) { __builtin_amdgcn_s_sleep(1); \
    if ((++_sp & 255u) == 0u) { if (xb_ld(&(bar)[XB_TMO])) break; if (_sp > XB_SPIN_CAP) { atomicAdd(&(bar)[XB_TMO], 1u); break; } } } } while (0)
struct XcdBarrier { unsigned* bar; unsigned x; volatile LAS unsigned* st; };
__device__ __forceinline__ XcdBarrier xcd_barrier_post(unsigned* bar, volatile LAS unsigned* st) {
    XcdBarrier b; b.bar = bar; b.x = xb_xcc_id(); b.st = st;
    if (threadIdx.x == 0) (void)xb_add(&bar[XB_XCNT(b.x)], 1u);
    return b;
}
__device__ __forceinline__ void xcd_barrier_complete(unsigned* bar, unsigned x, unsigned& nloc, unsigned& nx) {
    const unsigned G = gridDim.x * gridDim.y * gridDim.z;
    unsigned sum, cnt, mine, sp = 0u;
    for (;;) {
        sum = 0u; cnt = 0u; mine = 0u;
#pragma unroll
        for (unsigned j = 0; j < 16; ++j) { const unsigned c = xb_ld(&bar[XB_XCNT(j)]); sum += c; cnt += (c > 0u) ? 1u : 0u; mine = (j == x) ? c : mine; }
        if (sum == G) break;
        __builtin_amdgcn_s_sleep(1);
        if ((++sp & 255u) == 0u) { if (xb_ld(&bar[XB_TMO])) break; if (sp > XB_SPIN_CAP) { atomicAdd(&bar[XB_TMO], 1u); break; } }
    }
    nloc = mine > 0u ? mine : 1u; nx = cnt > 0u ? cnt : 1u;
}
__device__ __forceinline__ void xcd_barrier(const XcdBarrier& b) {
    asm volatile("s_waitcnt vmcnt(0)" ::: "memory");
    __syncthreads();
    if (threadIdx.x == 0) {
        unsigned* bar = b.bar;
        __builtin_amdgcn_s_waitcnt(0);
        unsigned nloc = b.st[0], nx = b.st[1];
        if (nloc == 0u) { xcd_barrier_complete(bar, b.x, nloc, nx); b.st[0] = nloc; b.st[1] = nx; }
        const unsigned old = xb_add(&bar[XB_XSUB(b.x)], 1u);
        const unsigned gen = old / nloc;
        if (old + 1u == (gen + 1u) * nloc) {
            __builtin_amdgcn_fence(__ATOMIC_RELEASE, "agent");
            asm volatile("s_waitcnt vmcnt(0)" ::: "memory");
            const unsigned og = xb_add(&bar[XB_TOP], 1u);
            const unsigned tg = og / nx;
            if (og + 1u == (tg + 1u) * nx) xb_add(&bar[XB_TOPGEN], 1u);
            else XB_SPIN(xb_ld(&bar[XB_TOPGEN]) == tg, bar);
            __builtin_amdgcn_fence(__ATOMIC_ACQUIRE, "agent");
            xb_add(&bar[XB_XGEN(b.x)], 1u);
            asm volatile("s_waitcnt vmcnt(0)" ::: "memory");
        } else {
            XB_SPIN(xb_ld(&bar[XB_XGEN(b.x)]) == gen, bar);
            __builtin_amdgcn_fence(__ATOMIC_ACQUIRE, "agent");
            asm volatile("s_waitcnt vmcnt(0)" ::: "memory");
        }
    }
    __syncthreads();
}

template <class Epi>
__device__ __forceinline__ void gemm128(const bf16_t* __restrict__ A, int lda, const bf16_t* __restrict__ B, int ldb, int K, char* smem, const Epi& epi) {
    const int tid = opaque_tid(), lane = tid & 63, wid = tid >> 6, wr = wid >> 1, wc = wid & 1, fr = lane & 15, fq = lane >> 4;
    f32x4 acc[4][4];
#pragma unroll
    for (int m = 0; m < 4; ++m)
#pragma unroll
        for (int n = 0; n < 4; ++n) acc[m][n] = (f32x4){0.f, 0.f, 0.f, 0.f};
    const int crow = tid >> 3, ckc = tid & 7;
    const bf16_t* ap = A + (size_t)crow * lda + ckc * 8;
    const bf16_t* bp = B + (size_t)crow * ldb + ckc * 8;
    u32x4 ra[4], rb[4];
#pragma unroll
    for (int i = 0; i < 4; ++i) { ra[i] = *(const u32x4*)(ap + (size_t)(32 * i) * lda); rb[i] = *(const u32x4*)(bp + (size_t)(32 * i) * ldb); }
    {
        char* sa = smem; char* sb = smem + TILE_BYTES;
#pragma unroll
        for (int i = 0; i < 4; ++i) { *(u32x4*)(sa + ((crow + 32 * i) * LDS_STRIDE + ckc * 8) * 2) = ra[i]; *(u32x4*)(sb + ((crow + 32 * i) * LDS_STRIDE + ckc * 8) * 2) = rb[i]; }
    }
    __syncthreads();
    const int nk = K >> 6;
    for (int kt = 0; kt < nk; ++kt) {
        const bool more = (kt + 1 < nk);
        if (more) {
            const int k0 = (kt + 1) << 6;
#pragma unroll
            for (int i = 0; i < 4; ++i) { ra[i] = *(const u32x4*)(ap + (size_t)(32 * i) * lda + k0); rb[i] = *(const u32x4*)(bp + (size_t)(32 * i) * ldb + k0); }
        }
        const char* sa = smem + (kt & 1) * 2 * TILE_BYTES; const char* sb = sa + TILE_BYTES;
#pragma unroll
        for (int ks = 0; ks < 2; ++ks) {
            bf16x8 af[4], bfr[4];
#pragma unroll
            for (int m = 0; m < 4; ++m) af[m] = *(const bf16x8*)(sa + ((wr * 64 + m * 16 + fr) * LDS_STRIDE + ks * 32 + fq * 8) * 2);
#pragma unroll
            for (int n = 0; n < 4; ++n) bfr[n] = *(const bf16x8*)(sb + ((wc * 64 + n * 16 + fr) * LDS_STRIDE + ks * 32 + fq * 8) * 2);
            __builtin_amdgcn_s_setprio(1);
#pragma unroll
            for (int m = 0; m < 4; ++m)
#pragma unroll
                for (int n = 0; n < 4; ++n) acc[m][n] = __builtin_amdgcn_mfma_f32_16x16x32_bf16(af[m], bfr[n], acc[m][n], 0, 0, 0);
            __builtin_amdgcn_s_setprio(0);
        }
        if (more) {
            char* da = smem + ((kt + 1) & 1) * 2 * TILE_BYTES; char* db = da + TILE_BYTES;
#pragma unroll
            for (int i = 0; i < 4; ++i) { *(u32x4*)(da + ((crow + 32 * i) * LDS_STRIDE + ckc * 8) * 2) = ra[i]; *(u32x4*)(db + ((crow + 32 * i) * LDS_STRIDE + ckc * 8) * 2) = rb[i]; }
        }
        __syncthreads();
    }
    epi(acc, wr * 64, wc * 64, fr, fq);
}


#define L2_STRIDE 40
#define A2_BYTES (256 * L2_STRIDE * 2)
#define B2_BYTES (128 * L2_STRIDE * 2)
#define ST2_BYTES (A2_BYTES + B2_BYTES)
template <class Epi>
__device__ __forceinline__ void gemm256(const bf16_t* __restrict__ A, int lda, const bf16_t* __restrict__ B, int ldb, int K, char* smem, const Epi& epi) {
    const int tid = opaque_tid(), lane = tid & 63, wid = tid >> 6, wr = wid >> 1, wc = wid & 1, fr = lane & 15, fq = lane >> 4;
    f32x4 acc[2][4][4];
#pragma unroll
    for (int hh = 0; hh < 2; ++hh)
#pragma unroll
        for (int m = 0; m < 4; ++m)
#pragma unroll
            for (int n = 0; n < 4; ++n) acc[hh][m][n] = (f32x4){0.f, 0.f, 0.f, 0.f};
    const int crow = tid >> 2, ckc = tid & 3;
    const bf16_t* ap = A + (size_t)crow * lda + ckc * 8;
    const bf16_t* bp = B + (size_t)crow * ldb + ckc * 8;
    u32x4 ra[4], rb[2];
#pragma unroll
    for (int i = 0; i < 4; ++i) ra[i] = *(const u32x4*)(ap + (size_t)(64 * i) * lda);
#pragma unroll
    for (int i = 0; i < 2; ++i) rb[i] = *(const u32x4*)(bp + (size_t)(64 * i) * ldb);
    {
        char* sa = smem; char* sb = smem + A2_BYTES;
#pragma unroll
        for (int i = 0; i < 4; ++i) *(u32x4*)(sa + ((crow + 64 * i) * L2_STRIDE + ckc * 8) * 2) = ra[i];
#pragma unroll
        for (int i = 0; i < 2; ++i) *(u32x4*)(sb + ((crow + 64 * i) * L2_STRIDE + ckc * 8) * 2) = rb[i];
    }
    __syncthreads();
    const int nk = K >> 5;
    for (int kt = 0; kt < nk; ++kt) {
        const bool more = (kt + 1 < nk);
        if (more) {
            const int k0 = (kt + 1) << 5;
#pragma unroll
            for (int i = 0; i < 4; ++i) ra[i] = *(const u32x4*)(ap + (size_t)(64 * i) * lda + k0);
#pragma unroll
            for (int i = 0; i < 2; ++i) rb[i] = *(const u32x4*)(bp + (size_t)(64 * i) * ldb + k0);
        }
        const char* sa = smem + (kt & 1) * ST2_BYTES; const char* sb = sa + A2_BYTES;
        bf16x8 bfr[4];
#pragma unroll
        for (int n = 0; n < 4; ++n) bfr[n] = *(const bf16x8*)(sb + ((wc * 64 + n * 16 + fr) * L2_STRIDE + fq * 8) * 2);
#pragma unroll
        for (int hh = 0; hh < 2; ++hh) {
            bf16x8 af[4];
#pragma unroll
            for (int m = 0; m < 4; ++m) af[m] = *(const bf16x8*)(sa + ((wr * 128 + hh * 64 + m * 16 + fr) * L2_STRIDE + fq * 8) * 2);
            __builtin_amdgcn_s_setprio(1);
#pragma unroll
            for (int m = 0; m < 4; ++m)
#pragma unroll
                for (int n = 0; n < 4; ++n) acc[hh][m][n] = __builtin_amdgcn_mfma_f32_16x16x32_bf16(af[m], bfr[n], acc[hh][m][n], 0, 0, 0);
            __builtin_amdgcn_s_setprio(0);
        }
        if (more) {
            char* da = smem + ((kt + 1) & 1) * ST2_BYTES; char* db = da + A2_BYTES;
#pragma unroll
            for (int i = 0; i < 4; ++i) *(u32x4*)(da + ((crow + 64 * i) * L2_STRIDE + ckc * 8) * 2) = ra[i];
#pragma unroll
            for (int i = 0; i < 2; ++i) *(u32x4*)(db + ((crow + 64 * i) * L2_STRIDE + ckc * 8) * 2) = rb[i];
        }
        __syncthreads();
    }
    epi(acc[0], wr * 128, wc * 64, fr, fq);
    epi(acc[1], wr * 128 + 64, wc * 64, fr, fq);
}

struct EpiZ {
    bf16_t* Z; int R0, C0;
    __device__ __forceinline__ void operator()(f32x4 (&acc)[4][4], int r0, int c0, int fr, int fq) const {
#pragma unroll
        for (int n = 0; n < 4; ++n) { const int col = C0 + c0 + n * 16 + fr; if (col < NIN) {
#pragma unroll
            for (int m = 0; m < 4; ++m)
#pragma unroll
                for (int j = 0; j < 4; ++j) Z[(size_t)(R0 + r0 + m * 16 + fq * 4 + j) * NIN + col] = f2bf(acc[m][n][j]); } }
    }
};
struct EpiQ {
    bf16_t* Q; const float* rs; const float* ropeC; const float* ropeS; int R0, C0;
    __device__ __forceinline__ void operator()(f32x4 (&acc)[4][4], int r0, int c0, int fr, int fq) const {
        const bool lat = R0 >= M_CTX;
#pragma unroll
        for (int n = 0; n < 4; ++n) {
            const int cb = C0 + c0 + n * 16; const int hcs = cb % 96;
            if (lat && hcs == 80) continue;
            const bool rot = lat && hcs == 64;
#pragma unroll
            for (int m = 0; m < 4; ++m)
#pragma unroll
                for (int j = 0; j < 4; ++j) {
                    const int rl = r0 + m * 16 + fq * 4 + j; const int row = R0 + rl; const float s = rs[rl] * QSCALE;
                    const float x1 = acc[m][n][j] * s;
                    if (rot) {
                        const float x2 = acc[m][(n + 1) & 3][j] * s; const int t = (row - M_CTX) & 4095;
                        const float cv = ropeC[t * 16 + fr], sv = ropeS[t * 16 + fr];
                        Q[(size_t)row * 768 + cb + fr] = f2bf(x1 * cv - x2 * sv);
                        Q[(size_t)row * 768 + cb + 16 + fr] = f2bf(x1 * sv + x2 * cv);
                    } else Q[(size_t)row * 768 + cb + fr] = f2bf(x1);
                }
        }
    }
};
struct EpiKV {
    bf16_t* Kd; bf16_t* Vd; const float* rs; int R0, C0; int seqshift; size_t vbase0;
    __device__ __forceinline__ void operator()(f32x4 (&acc)[4][4], int r0, int c0, int fr, int fq) const {
#pragma unroll
        for (int n = 0; n < 4; ++n) {
            const int col = C0 + c0 + n * 16 + fr;
#pragma unroll
            for (int m = 0; m < 4; ++m) {
                const int rl = r0 + m * 16 + fq * 4; const int row = R0 + rl;
                float v[4];
#pragma unroll
                for (int j = 0; j < 4; ++j) v[j] = acc[m][n][j] * (rs ? rs[rl + j] : 1.0f);
                if (col < 512) {
                    const int h = col >> 6, d = col & 63;
#pragma unroll
                    for (int j = 0; j < 4; ++j) Kd[(size_t)(row + j) * 768 + h * 96 + d] = f2bf(v[j]);
                } else {
                    const int vc = col - 512, h = vc >> 6, dv = vc & 63; const int b = row >> seqshift, t = row & ((1 << seqshift) - 1);
                    u32x2 w; w.x = pack2(v[0], v[1]); w.y = pack2(v[2], v[3]);
                    *(u32x2*)(Vd + vbase0 + ((size_t)((b * 8 + h) * 64 + dv) << seqshift) + t) = w;
                }
            }
        }
    }
};
struct EpiRes {
    float* X; const float* gate; int R0, C0;
    __device__ __forceinline__ void operator()(f32x4 (&acc)[4][4], int r0, int c0, int fr, int fq) const {
#pragma unroll
        for (int n = 0; n < 4; ++n) { const int col = C0 + c0 + n * 16 + fr; const float g = gate[col];
#pragma unroll
            for (int m = 0; m < 4; ++m)
#pragma unroll
                for (int j = 0; j < 4; ++j) { float* px = X + (size_t)(R0 + r0 + m * 16 + fq * 4 + j) * DM + col; *px = ALPHA_F * (*px) + g * acc[m][n][j]; } }
    }
};
struct EpiSwi {
    bf16_t* H; int R0, C0;
    __device__ __forceinline__ void operator()(f32x4 (&acc)[4][4], int r0, int c0, int fr, int fq) const {
        const int hb = (C0 + c0) >> 1;
#pragma unroll
        for (int n = 0; n < 2; ++n)
#pragma unroll
            for (int m = 0; m < 4; ++m)
#pragma unroll
                for (int j = 0; j < 4; ++j) { const float g = acc[m][n][j], u = acc[m][n + 2][j];
                    H[(size_t)(R0 + r0 + m * 16 + fq * 4 + j) * DFF + hb + n * 16 + fr] = f2bf(g * sigmoidf_(g) * u); }
    }
};

__device__ __forceinline__ void ada_unit(const P& p, int u, char* smem) {
    const int tid = opaque_tid(); const int l = u / 96, c0 = (u % 96) * 64;
    float* cs = (float*)smem;
    for (int i = tid; i < 5 * 1024; i += 256) { const int r = i >> 10, k = i & 1023; const float v = (r == 0) ? p.c_ctx[k] : p.c[(r - 1) * 1024 + k]; cs[i] = v * sigmoidf_(v); }
    __syncthreads();
    const int col = tid & 63, kq = tid >> 6;
    float s0 = 0.f, s1 = 0.f, s2 = 0.f, s3 = 0.f, s4 = 0.f;
    const float* w = p.ada_w + ((size_t)l * 1024 + kq * 256) * 6144 + c0 + col;
    const float* cq = cs + kq * 256;
    for (int k = 0; k < 256; ++k) { const float wv = w[(size_t)k * 6144]; s0 += cq[k] * wv; s1 += cq[1024 + k] * wv; s2 += cq[2048 + k] * wv; s3 += cq[3072 + k] * wv; s4 += cq[4096 + k] * wv; }
    float* red = cs + 5 * 1024;
    red[(kq * 5 + 0) * 64 + col] = s0; red[(kq * 5 + 1) * 64 + col] = s1; red[(kq * 5 + 2) * 64 + col] = s2; red[(kq * 5 + 3) * 64 + col] = s3; red[(kq * 5 + 4) * 64 + col] = s4;
    __syncthreads();
    for (int o = tid; o < 320; o += 256) { const int i = o >> 6, cc = o & 63;
        const float v = red[(0 * 5 + i) * 64 + cc] + red[(1 * 5 + i) * 64 + cc] + red[(2 * 5 + i) * 64 + cc] + red[(3 * 5 + i) * 64 + cc] + p.ada_b[l * 6144 + c0 + cc];
        p.mod[((size_t)l * 5 + i) * 6144 + c0 + cc] = v; }
    __syncthreads();
}
__device__ __forceinline__ int map_col(int kind, int n) {
    if (kind == 1) { const int blk = n >> 6, r = n & 63; return r < 32 ? blk * 32 + r : DFF + blk * 32 + (r - 32); }
    if (kind == 2) { if (n < 512) return (n >> 6) * 128 + (n & 63); const int vc = n - 512; return (vc >> 6) * 128 + 64 + (vc & 63); }
    return n;
}
__device__ __forceinline__ void conv_tile(const float* src, int ldsrc, bf16_t* dst, bf16_t* dst2, int Kdst, int n0, int k0, int kind, int Nvalid, const float* kscale, char* smem) {
    const int tid = opaque_tid(); float* tile = (float*)smem;
    { const int j = tid & 63, i0 = tid >> 6; const int n = n0 + j; const int sc = (n < Nvalid) ? map_col(kind, n) : -1;
#pragma unroll 4
      for (int ii = 0; ii < 16; ++ii) { const int i = i0 + 4 * ii; tile[i * 65 + j] = (sc >= 0) ? src[(size_t)(k0 + i) * ldsrc + sc] : 0.f; } }
    __syncthreads();
    { const int i = tid & 63, j0 = tid >> 6; const float ks = kscale ? kscale[k0 + i] : 1.f;
#pragma unroll 4
      for (int jj = 0; jj < 16; ++jj) { const int jx = j0 + 4 * jj; const float v = tile[i * 65 + jx];
          dst[(size_t)(n0 + jx) * Kdst + k0 + i] = f2bf(v * ks); if (dst2) dst2[(size_t)(n0 + jx) * Kdst + k0 + i] = f2bf(v); } }
    __syncthreads();
}
#define NCONV 3032
__device__ __forceinline__ void conv_unit(const P& p, int l, int u, char* smem) {
    const float* src; int ldsrc; bf16_t* dst; bf16_t* dst2 = nullptr; int Kdst, n0, k0, kind = 0, Nvalid; const float* kscale = nullptr;
    if (u < 544) { src = p.w_in + (size_t)l * 1024 * NIN; ldsrc = NIN; dst = p.WtIn; Kdst = 1024; n0 = (u / 16) * 64; k0 = (u % 16) * 64; Nvalid = NIN; }
    else if (u < 592) { u -= 544; src = p.q_up + (size_t)l * 256 * 768; ldsrc = 768; dst = p.WtQ; Kdst = 256; n0 = (u / 4) * 64; k0 = (u % 4) * 64; Nvalid = 768; kscale = p.q_norm + l * 256; }
    else if (u < 624) { u -= 592; src = p.kv_up + (size_t)l * 128 * 1024; ldsrc = 1024; dst = p.WtKVn; dst2 = p.WtKV; Kdst = 128; n0 = (u / 2) * 64; k0 = (u % 2) * 64; kind = 2; Nvalid = 1024; kscale = p.kv_norm + l * 128; }
    else if (u < 880) { u -= 624; src = p.w_out + (size_t)l * 1024 * 1024; ldsrc = 1024; dst = p.WtOut; Kdst = 1024; n0 = (u / 16) * 64; k0 = (u % 16) * 64; Nvalid = 1024; }
    else if (u < 2288) { u -= 880; src = p.ffn_in + (size_t)l * 1024 * 5632; ldsrc = 5632; dst = p.WtF1; Kdst = 1024; n0 = (u / 16) * 64; k0 = (u % 16) * 64; kind = 1; Nvalid = 5632; }
    else if (u < 2992) { u -= 2288; src = p.ffn_out + (size_t)l * DFF * 1024; ldsrc = 1024; dst = p.WtF2; Kdst = DFF; n0 = (u / 44) * 64; k0 = (u % 44) * 64; Nvalid = 1024; }
    else if (u < 3008) { u -= 2992; const float* sp = p.gm_ws + (size_t)l * 65536 + u * 4096; bf16_t* d = p.WsB + u * 4096; for (int i = threadIdx.x; i < 4096; i += 256) d[i] = f2bf(sp[i]); return; }
    else if (u < 3016) { u -= 3008; const int d = u >> 2; src = p.rw_w2 + ((size_t)l * 2 + d) * 64 * 256; ldsrc = 256; dst = p.W2t + d * 256 * 64; Kdst = 64; n0 = (u & 3) * 64; k0 = 0; Nvalid = 256; }
    else if (u < 3024) { u -= 3016; const int d = u >> 2; src = p.rw_a2 + ((size_t)l * 2 + d) * 64 * 256; ldsrc = 256; dst = p.A2t + d * 256 * 64; Kdst = 64; n0 = (u & 3) * 64; k0 = 0; Nvalid = 256; }
    else { u -= 3024; src = p.rw_g2 + (size_t)l * 128 * 256; ldsrc = 256; dst = p.G2t; Kdst = 128; n0 = (u / 2) * 64; k0 = (u % 2) * 64; Nvalid = 256; }
    conv_tile(src, ldsrc, dst, dst2, Kdst, n0, k0, kind, Nvalid, kscale, smem);
}
__device__ __forceinline__ void misc0_unit(const P& p, int u) {
    const int tid = opaque_tid();
    if (u < 16) {
        for (int e = tid; e < 4096; e += 256) { const int idx = u * 4096 + e; const int t = idx >> 4, i = idx & 15;
            const float pos = (float)((i < 8) ? (t >> 6) : (t & 63)); const float inv = exp2f(-(float)(i & 7) * 1.6609640474436813f);
            const float ang = pos * inv; const float kf = rintf(ang * 0.15915494309189535f);
            float r = fmaf(-kf, 6.28318548202514648f, ang); r = fmaf(-kf, -1.74845553e-7f, r);
            p.ropeC[idx] = __cosf(r); p.ropeS[idx] = __sinf(r); }
    } else {
        const int v = u - 16;
        for (int e = tid; e < 4096; e += 256) { const int idx = v * 4096 + e;
            const int c = idx & 127, t = (idx >> 7) & 511, b = (idx >> 16) & 3, l = idx >> 18;
            p.CkvB[idx] = f2bf(p.cache_ckv[(((size_t)b * 4 + l) * 512 + t) * 128 + c]); }
    }
}

__device__ __forceinline__ void ln_phase(const P& p, int l, int which) {
    const int tid = opaque_tid(), lane = tid & 63, wid = tid >> 6;
    const float* g = which == 1 ? p.ln1_g + l * DM : p.ln2_g + l * DM; const float* bb = which == 1 ? p.ln1_b + l * DM : p.ln2_b + l * DM;
    const int ml = which == 2 ? l + 1 : l; const int shoff = which == 1 ? 3072 : 0, scoff = which == 1 ? 4096 : 1024;
    const bool dohb = !(which == 2 && l == 3);
    for (int row = blockIdx.x * 4 + wid; row < M_ALL; row += gridDim.x * 4) {
        float* xr = p.out + (size_t)row * DM;
        const float* src = which == 0 ? (row < M_CTX ? p.x_prompt + (size_t)row * DM : p.x_sample + (size_t)(row - M_CTX) * DM) : xr;
        f32x4 v[4];
#pragma unroll
        for (int i = 0; i < 4; ++i) v[i] = *(const f32x4*)(src + lane * 4 + 256 * i);
        if (which != 0) {
            float s = 0.f;
#pragma unroll
            for (int i = 0; i < 4; ++i) s += (v[i][0] + v[i][1]) + (v[i][2] + v[i][3]);
            s = red16(s); s += __shfl_xor(s, 16); s += __shfl_xor(s, 32);
            const float mu = s * (1.0f / 1024.0f); float q = 0.f;
#pragma unroll
            for (int i = 0; i < 4; ++i) { const f32x4 d = v[i] - mu; q += (d[0] * d[0] + d[1] * d[1]) + (d[2] * d[2] + d[3] * d[3]); }
            q = red16(q); q += __shfl_xor(q, 16); q += __shfl_xor(q, 32);
            const float rstd = rsqrtf(q * (1.0f / 1024.0f) + 1e-5f);
#pragma unroll
            for (int i = 0; i < 4; ++i) { const f32x4 gg = *(const f32x4*)(g + lane * 4 + 256 * i), bv = *(const f32x4*)(bb + lane * 4 + 256 * i); v[i] = (v[i] - mu) * rstd * gg + bv; }
        }
#pragma unroll
        for (int i = 0; i < 4; ++i) *(f32x4*)(xr + lane * 4 + 256 * i) = v[i];
        if (dohb) {
            const float* md = p.mod + ((size_t)ml * 5 + modrow_of(row)) * 6144;
#pragma unroll
            for (int i = 0; i < 4; ++i) { const f32x4 sh = *(const f32x4*)(md + shoff + lane * 4 + 256 * i), sc = *(const f32x4*)(md + scoff + lane * 4 + 256 * i);
                const f32x4 h = v[i] * (1.0f + sc) + sh; u32x2 w; w.x = pack2(h[0], h[1]); w.y = pack2(h[2], h[3]);
                *(u32x2*)(p.hbmix + (size_t)row * DM + lane * 4 + 256 * i) = w; }
        }
    }
}

__device__ __forceinline__ void rwprep_unit(const P& p, int l, int u, char* smem) {
    const int tid = opaque_tid(), lane = tid & 63, wid = tid >> 6, fr = lane & 15, fq = lane >> 4;
    const int R0 = u * 64;
    const int ss = R0 < M_CTX ? (R0 & ~255) : M_CTX + ((R0 - M_CTX) & ~4095); const int se = ss + (R0 < M_CTX ? 256 : 4096);
    bf16_t* XW = (bf16_t*)smem; bf16_t* XA = XW + 64 * 136; bf16_t* XG = XA + 64 * 136;
    const float* cw = p.rw_conv + (size_t)l * 3 * 1152;
    for (int it = tid; it < 576; it += 256) {
        const int cc = it % 144, tg = it / 144; const int c = cc * 8;
        float w0[8], w1[8], w2[8];
#pragma unroll
        for (int i = 0; i < 8; ++i) { w0[i] = cw[c + i]; w1[i] = cw[1152 + c + i]; w2[i] = cw[2304 + c + i]; }
        const int rfirst = R0 + tg * 16;
        u32x4 prev = (u32x4){0u, 0u, 0u, 0u}, cur, nxt;
        if (rfirst - 1 >= ss) prev = *(const u32x4*)(p.Z + (size_t)(rfirst - 1) * NIN + c);
        cur = *(const u32x4*)(p.Z + (size_t)rfirst * NIN + c);
        for (int tt = 0; tt < 16; ++tt) {
            const int row = rfirst + tt;
            nxt = (u32x4){0u, 0u, 0u, 0u};
            if (row + 1 < se) nxt = *(const u32x4*)(p.Z + (size_t)(row + 1) * NIN + c);
            float o[8];
#pragma unroll
            for (int i = 0; i < 4; ++i) {
                o[2 * i] = w0[2 * i] * lo_bf(prev[i]) + w1[2 * i] * lo_bf(cur[i]) + w2[2 * i] * lo_bf(nxt[i]);
                o[2 * i + 1] = w0[2 * i + 1] * hi_bf(prev[i]) + w1[2 * i + 1] * hi_bf(cur[i]) + w2[2 * i + 1] * hi_bf(nxt[i]);
            }
            if (c >= 768 && c < 896) {
#pragma unroll
                for (int i = 0; i < 8; ++i) o[i] = tanhf_(o[i]);
            } else if (c >= 1024) {
#pragma unroll
                for (int i = 0; i < 8; ++i) o[i] = sigmoidf_(o[i]);
            }
            u32x4 w; w.x = pack2(o[0], o[1]); w.y = pack2(o[2], o[3]); w.z = pack2(o[4], o[5]); w.w = pack2(o[6], o[7]);
            const int tl = tg * 16 + tt;
            if (c < 768) *(u32x4*)(p.RKV + (size_t)row * 768 + c) = w;
            else if (c < 896) *(u32x4*)(XW + tl * 136 + (c - 768)) = w;
            else if (c < 1024) *(u32x4*)(XA + tl * 136 + (c - 896)) = w;
            else *(u32x4*)(XG + tl * 136 + (c - 1024)) = w;
            prev = cur; cur = nxt;
        }
    }
    __syncthreads();
#pragma unroll 1
    for (int mh = 0; mh < 10; ++mh) {
        const int mat = mh >> 1, nh = mh & 1;
        const int d = mat & 1; const bf16_t* As; const bf16_t* Bw; int kofs, nks, ldw;
        if (mat < 2) { As = XW; Bw = p.W2t + d * 256 * 64; kofs = d * 64; nks = 2; ldw = 64; }
        else if (mat < 4) { As = XA; Bw = p.A2t + d * 256 * 64; kofs = d * 64; nks = 2; ldw = 64; }
        else { As = XG; Bw = p.G2t; kofs = 0; nks = 4; ldw = 128; }
        f32x4 acc[4][2];
#pragma unroll
        for (int m = 0; m < 4; ++m)
#pragma unroll
            for (int n = 0; n < 2; ++n) acc[m][n] = (f32x4){0.f, 0.f, 0.f, 0.f};
#pragma unroll 1
        for (int ks = 0; ks < nks; ++ks) {
            bf16x8 af[4], bfr[2];
#pragma unroll
            for (int m = 0; m < 4; ++m) af[m] = *(const bf16x8*)(As + (m * 16 + fr) * 136 + kofs + ks * 32 + fq * 8);
#pragma unroll
            for (int n = 0; n < 2; ++n) bfr[n] = *(const bf16x8*)(Bw + (size_t)(wid * 64 + nh * 32 + n * 16 + fr) * ldw + ks * 32 + fq * 8);
#pragma unroll
            for (int m = 0; m < 4; ++m)
#pragma unroll
                for (int n = 0; n < 2; ++n) acc[m][n] = __builtin_amdgcn_mfma_f32_16x16x32_bf16(af[m], bfr[n], acc[m][n], 0, 0, 0);
        }
#pragma unroll
        for (int n = 0; n < 2; ++n) {
            const int c = wid * 64 + nh * 32 + n * 16 + fr;
            float bias = 0.f; if (mat < 2) bias = p.rw_w0[(l * 2 + d) * 256 + c]; else if (mat < 4) bias = p.rw_a0[(l * 2 + d) * 256 + c];
            bf16_t* dst; float mul;
            if (mat < 2) { dst = p.Ee + ((size_t)d * M_ALL + R0) * 256 + c; mul = 0.6065306597126334f; }
            else if (mat < 4) { dst = p.Aa + ((size_t)d * M_ALL + R0) * 256 + c; mul = 1.0f; }
            else { dst = p.Gg + (size_t)R0 * 256 + c; mul = 1.0f; }
#pragma unroll
            for (int m = 0; m < 4; ++m)
#pragma unroll
                for (int j = 0; j < 4; ++j) {
                    const float x = acc[m][n][j] + bias;
                    dst[(size_t)(m * 16 + fq * 4 + j) * 256] = f2bf(mat < 4 ? mul * sigmoidf_(x) : x);
                }
        }
    }
    __syncthreads();
}
__device__ __forceinline__ void rowscale128(const bf16_t* Z, int R0, int zoff, int ncols, float eps, float* rs) {
    const int tid = opaque_tid(); const int r = tid >> 1, half = tid & 1; const int per = ncols >> 1;
    const bf16_t* zp = Z + (size_t)(R0 + r) * NIN + zoff + half * per;
    float ss = 0.f;
    for (int i = 0; i < per; i += 8) { const u32x4 w = *(const u32x4*)(zp + i);
#pragma unroll
        for (int q = 0; q < 4; ++q) { const float a = lo_bf(w[q]), b = hi_bf(w[q]); ss += a * a + b * b; } }
    ss = dpp_add<0xB1>(ss);
    if (half == 0) rs[r] = rsqrtf(ss / (float)ncols + eps);
}
__device__ __forceinline__ void small_unit(const P& p, int l, int u) {
    const int tid = opaque_tid(), sub = tid >> 5, li = tid & 31;
    if (u < 2560) {
        const int row = u * 8 + sub; const bf16_t* zr = p.Z + (size_t)row * NIN;
        const u32x2 w = *(const u32x2*)(zr + ZKV + li * 4);
        const float z0 = lo_bf(w.x), z1 = hi_bf(w.x), z2 = lo_bf(w.y), z3 = hi_bf(w.y);
        float ss = z0 * z0 + z1 * z1 + z2 * z2 + z3 * z3; ss = red16(ss); ss += __shfl_xor(ss, 16);
        const float rsv = rsqrtf(ss * (1.0f / 128.0f) + 1e-6f);
        const float x1 = bf2f(zr[ZKR + (li & 15)]), x2 = bf2f(zr[ZKR + 16 + (li & 15)]);
        float val;
        if (row < M_CTX) {
            const int b = row >> 8, t = row & 255; const size_t o = ((size_t)(b * 4 + l) * 256 + t);
            const f32x4 g = *(const f32x4*)(p.kv_norm + l * 128 + li * 4);
            *(f32x4*)(p.out + 20971520 + o * 128 + li * 4) = (f32x4){z0 * rsv * g[0], z1 * rsv * g[1], z2 * rsv * g[2], z3 * rsv * g[3]};
            val = li < 16 ? x1 : x2;
            p.out[20971520 + 2097152 + o * 32 + li] = val;
        } else {
            const int t = (row - M_CTX) & 4095; const float cv = p.ropeC[t * 16 + (li & 15)], sv = p.ropeS[t * 16 + (li & 15)];
            val = li < 16 ? x1 * cv - x2 * sv : x1 * sv + x2 * cv;
        }
        const bf16_t bv = f2bf(val);
#pragma unroll
        for (int h = 0; h < 8; ++h) p.Kb[(size_t)row * 768 + h * 96 + 64 + li] = bv;
    } else {
        const int r = (u - 2560) * 8 + sub; const int b = r >> 9, t = r & 511;
        const bf16_t bv = f2bf(p.cache_krope[((size_t)(b * 4 + l) * 512 + t) * 32 + li]);
#pragma unroll
        for (int h = 0; h < 8; ++h) p.Kc[(size_t)r * 768 + h * 96 + 64 + li] = bv;
    }
}
__device__ __forceinline__ void gmlp_unit(const P& p, int l, int u, char* smem) {
    const int tid = opaque_tid(), lane = tid & 63, wid = tid >> 6, fr = lane & 15, fq = lane >> 4;
    const int R0 = (u >> 2) * 128, g = u & 3;
    bf16_t* VnT = (bf16_t*)smem;
    {
        const int tok = tid >> 1, half = tid & 1; const bf16_t* zp = p.Z + (size_t)(R0 + tok) * NIN + ZV + g * 64 + half * 32;
        float x[32];
#pragma unroll
        for (int i = 0; i < 4; ++i) { const u32x4 w = *(const u32x4*)(zp + i * 8);
#pragma unroll
            for (int q = 0; q < 4; ++q) { x[i * 8 + 2 * q] = geluf_(lo_bf(w[q])); x[i * 8 + 2 * q + 1] = geluf_(hi_bf(w[q])); } }
        float s = 0.f;
#pragma unroll
        for (int i = 0; i < 32; ++i) s += x[i];
        s = dpp_add<0xB1>(s); const float mu = s * (1.0f / 64.0f);
        float q2 = 0.f;
#pragma unroll
        for (int i = 0; i < 32; ++i) { const float d = x[i] - mu; q2 += d * d; }
        q2 = dpp_add<0xB1>(q2); const float rstd = rsqrtf(q2 * (1.0f / 64.0f) + 1e-5f);
        const float* gg = p.gm_g + l * 256 + g * 64 + half * 32; const float* gb = p.gm_b + l * 256 + g * 64 + half * 32;
#pragma unroll
        for (int i = 0; i < 32; ++i) VnT[(half * 32 + i) * 136 + tok] = f2bf((x[i] - mu) * rstd * gg[i] + gb[i]);
    }
    __syncthreads();
    f32x4 acc[2][4];
#pragma unroll
    for (int m = 0; m < 2; ++m)
#pragma unroll
        for (int n = 0; n < 4; ++n) acc[m][n] = (f32x4){0.f, 0.f, 0.f, 0.f};
    const bf16_t* Wg = p.WsB + g * 128 * 128;
#pragma unroll
    for (int ks = 0; ks < 4; ++ks) {
        bf16x8 af[2], bfr[4];
#pragma unroll
        for (int m = 0; m < 2; ++m) af[m] = *(const bf16x8*)(Wg + (wid * 32 + m * 16 + fr) * 128 + ks * 32 + fq * 8);
#pragma unroll
        for (int n = 0; n < 4; ++n) bfr[n] = *(const bf16x8*)(VnT + (n * 16 + fr) * 136 + ks * 32 + fq * 8);
#pragma unroll
        for (int m = 0; m < 2; ++m)
#pragma unroll
            for (int n = 0; n < 4; ++n) acc[m][n] = __builtin_amdgcn_mfma_f32_16x16x32_bf16(af[m], bfr[n], acc[m][n], 0, 0, 0);
    }
#pragma unroll
    for (int m = 0; m < 2; ++m)
#pragma unroll
        for (int j = 0; j < 4; ++j) {
            const int pp = wid * 32 + m * 16 + fq * 4 + j; const float bs = p.gm_bs[l * 512 + g * 128 + pp];
#pragma unroll
            for (int n = 0; n < 4; ++n) { const int c = n * 16 + fr;
                const float uu = geluf_(bf2f(p.Z[(size_t)(R0 + pp) * NIN + ZU + g * 64 + c]));
                p.hbmix[(size_t)(R0 + pp) * DM + 768 + g * 64 + c] = f2bf(uu * (acc[m][n][j] + bs)); }
        }
    __syncthreads();
}

__device__ __forceinline__ float swap16_add(float x) {
    auto r = __builtin_amdgcn_permlane16_swap(__float_as_uint(x), __float_as_uint(x), false, false);
    return __uint_as_float(r[0]) + __uint_as_float(r[1]);
}
#define NSCAN_LAT 256
#define NSCAN (256 + 1024)
__device__ __forceinline__ void scan_unit(const P& p, int l, int u, char* smem) {
    const int tid = opaque_tid(), lane = tid & 63, wid = tid >> 6;
    int b, T, row0; const bool lat = u < NSCAN_LAT;
    if (lat) { b = u >> 6; T = 4096; row0 = M_CTX + b * 4096; } else { b = (u - NSCAN_LAT) >> 6; T = 256; row0 = b * 256; }
    const int h = (u >> 4) & 3, d = (u >> 3) & 1, rsl = u & 7;
    float* W = (float*)smem; float* NKK = W + 2048; float* KKA = NKK + 2048; float* KD = KKA + 2048; float* RR = KD + 2048; float* VS = RR + 2048; float* OUTP = VS + 256;
    const int rl = lane >> 5, kq = lane & 31; const int r8 = wid * 2 + rl; const int row = rsl * 8 + r8;
    f32x2 S = (f32x2){0.f, 0.f};
    const size_t stoff = ((((size_t)b * 4 + l) * 2 + d) * 4 + h) * 4096 + row * 64 + kq * 2;
    if (lat) S = *(const f32x2*)(p.state_rwkv + stoff);
    const int tok = tid >> 3, cg8 = tid & 7;
    float kkp[8], kap[8];
#pragma unroll
    for (int i = 0; i < 8; ++i) { kkp[i] = p.rw_kk[l * 256 + h * 64 + cg8 * 8 + i]; kap[i] = p.rw_ka[l * 256 + h * 64 + cg8 * 8 + i]; }
    const int nch = T >> 5;
    u32x4 r8v, k8, e8, a8, v8;
    int grow, grow_prev = 0; float oreg = 0.f;
    {
        const int sidx = tok; const int t = d ? T - 1 - sidx : sidx; grow = row0 + t;
        r8v = *(const u32x4*)(p.RKV + (size_t)grow * 768 + h * 64 + cg8 * 8);
        k8 = *(const u32x4*)(p.RKV + (size_t)grow * 768 + 256 + h * 64 + cg8 * 8);
        v8 = *(const u32x4*)(p.RKV + (size_t)grow * 768 + 512 + h * 64 + rsl * 8);
        e8 = *(const u32x4*)(p.Ee + ((size_t)d * M_ALL + grow) * 256 + h * 64 + cg8 * 8);
        a8 = *(const u32x4*)(p.Aa + ((size_t)d * M_ALL + grow) * 256 + h * 64 + cg8 * 8);
    }
    for (int ch = 0; ch < nch; ++ch) {
        {
            float kf[8], kkv[8], rf[8], ef[8], af[8];
#pragma unroll
            for (int q = 0; q < 4; ++q) { kf[2 * q] = lo_bf(k8[q]); kf[2 * q + 1] = hi_bf(k8[q]); rf[2 * q] = lo_bf(r8v[q]); rf[2 * q + 1] = hi_bf(r8v[q]);
                ef[2 * q] = lo_bf(e8[q]); ef[2 * q + 1] = hi_bf(e8[q]); af[2 * q] = lo_bf(a8[q]); af[2 * q + 1] = hi_bf(a8[q]); }
            float ss = 0.f;
#pragma unroll
            for (int i = 0; i < 8; ++i) { kkv[i] = kf[i] * kkp[i]; ss += kkv[i] * kkv[i]; }
            ss = red8(ss);
            const float inv = rsqrtf(fmaxf(ss, 1e-24f));
            f32x4 o0, o1; const int base = tok * 64 + cg8 * 8;
#pragma unroll
            for (int i = 0; i < 4; ++i) { o0[i] = __expf(-ef[i]); o1[i] = __expf(-ef[4 + i]); }
            *(f32x4*)(W + base) = o0; *(f32x4*)(W + base + 4) = o1;
#pragma unroll
            for (int i = 0; i < 4; ++i) { o0[i] = -kkv[i] * inv; o1[i] = -kkv[4 + i] * inv; }
            *(f32x4*)(NKK + base) = o0; *(f32x4*)(NKK + base + 4) = o1;
#pragma unroll
            for (int i = 0; i < 4; ++i) { o0[i] = kkv[i] * inv * af[i]; o1[i] = kkv[4 + i] * inv * af[4 + i]; }
            *(f32x4*)(KKA + base) = o0; *(f32x4*)(KKA + base + 4) = o1;
#pragma unroll
            for (int i = 0; i < 4; ++i) { o0[i] = kf[i] * (1.0f + (af[i] - 1.0f) * kap[i]); o1[i] = kf[4 + i] * (1.0f + (af[4 + i] - 1.0f) * kap[4 + i]); }
            *(f32x4*)(KD + base) = o0; *(f32x4*)(KD + base + 4) = o1;
#pragma unroll
            for (int i = 0; i < 4; ++i) { o0[i] = rf[i]; o1[i] = rf[4 + i]; }
            *(f32x4*)(RR + base) = o0; *(f32x4*)(RR + base + 4) = o1;
            if (cg8 == 0) {
#pragma unroll
                for (int q = 0; q < 4; ++q) { VS[tok * 8 + 2 * q] = lo_bf(v8[q]); VS[tok * 8 + 2 * q + 1] = hi_bf(v8[q]); }
            }
        }
        __syncthreads();
        if (ch > 0) p.ydir[((size_t)d * M_ALL + grow_prev) * 256 + h * 64 + rsl * 8 + cg8] = oreg;
        grow_prev = grow;
        if (ch + 1 < nch) {
            const int sidx = (ch + 1) * 32 + tok; const int t = d ? T - 1 - sidx : sidx; grow = row0 + t;
            r8v = *(const u32x4*)(p.RKV + (size_t)grow * 768 + h * 64 + cg8 * 8);
            k8 = *(const u32x4*)(p.RKV + (size_t)grow * 768 + 256 + h * 64 + cg8 * 8);
            v8 = *(const u32x4*)(p.RKV + (size_t)grow * 768 + 512 + h * 64 + rsl * 8);
            e8 = *(const u32x4*)(p.Ee + ((size_t)d * M_ALL + grow) * 256 + h * 64 + cg8 * 8);
            a8 = *(const u32x4*)(p.Aa + ((size_t)d * M_ALL + grow) * 256 + h * 64 + cg8 * 8);
        }
        {
            const float* Wq = W + kq * 2; const float* NKq = NKK + kq * 2; const float* KAq = KKA + kq * 2; const float* KDq = KD + kq * 2; const float* RRq = RR + kq * 2; const float* VSq = VS + r8;
            float* OPq = OUTP + r8 * 32 + kq;
            f32x2 wv[4], nkv[4], kav[4], kdv[4], rrv[4]; float vv[4];
#define SCAN_LD(slot, st) do { wv[slot] = *(const f32x2*)(Wq + (st) * 64); nkv[slot] = *(const f32x2*)(NKq + (st) * 64); kav[slot] = *(const f32x2*)(KAq + (st) * 64); \
        kdv[slot] = *(const f32x2*)(KDq + (st) * 64); rrv[slot] = *(const f32x2*)(RRq + (st) * 64); vv[slot] = VSq[(st) * 8]; } while (0)
            __builtin_amdgcn_s_setprio(3);
            SCAN_LD(0, 0); SCAN_LD(1, 1); SCAN_LD(2, 2);
#pragma unroll
            for (int s = 0; s < 32; ++s) {
                if (s + 3 < 32) SCAN_LD((s + 3) & 3, s + 3);
                const f32x2 w = wv[s & 3], nk = nkv[s & 3], ka = kav[s & 3], kd = kdv[s & 3], rr = rrv[s & 3]; const float v = vv[s & 3];
                float pd = fmaf(S[1], nk[1], S[0] * nk[0]);
                pd = red16(pd); pd = swap16_add(pd);
                S[0] = fmaf(S[0], w[0], fmaf(pd, ka[0], v * kd[0]));
                S[1] = fmaf(S[1], w[1], fmaf(pd, ka[1], v * kd[1]));
                OPq[s * 256] = fmaf(S[1], rr[1], S[0] * rr[0]);
            }
            __builtin_amdgcn_s_setprio(0);
        }
        __syncthreads();
        {
            const float* op = OUTP + (tok * 8 + cg8) * 32;
            f32x4 a0 = *(const f32x4*)(op), a1 = *(const f32x4*)(op + 4), a2 = *(const f32x4*)(op + 8), a3 = *(const f32x4*)(op + 12);
            f32x4 b0 = *(const f32x4*)(op + 16), b1 = *(const f32x4*)(op + 20), b2 = *(const f32x4*)(op + 24), b3 = *(const f32x4*)(op + 28);
            a0 = ((a0 + a1) + (a2 + a3)) + ((b0 + b1) + (b2 + b3));
            oreg = (a0[0] + a0[1]) + (a0[2] + a0[3]);
        }
    }
    p.ydir[((size_t)d * M_ALL + grow_prev) * 256 + h * 64 + rsl * 8 + cg8] = oreg;
    if (!lat) *(f32x2*)(p.out + 20971520 + 2097152 + 524288 + stoff) = S;
    __syncthreads();
}

#define KS_STRIDE 104
#define VS_STRIDE 68
#define KS_BYTES (64 * KS_STRIDE * 2)
#define ATT_STAGE (KS_BYTES + 64 * VS_STRIDE * 2)
__device__ __forceinline__ void attn_unit(const P& p, int u, char* smem) {
    const int tid = opaque_tid(), lane = tid & 63, wid = tid >> 6, q = lane & 31, hf = lane >> 5;
    int b, h, qt, qrow0, krow0, nown, ntot, Tv; size_t vbase, vcbase = 0; int kcrow0 = 0;
    if (u < 1024) { b = u >> 8; h = (u >> 5) & 7; qt = u & 31; krow0 = M_CTX + b * 4096; qrow0 = krow0 + qt * 128; nown = 64; ntot = 72; Tv = 4096;
        vbase = 2097152 + (size_t)(b * 8 + h) * 64 * 4096; kcrow0 = b * 512; vcbase = (size_t)(b * 8 + h) * 64 * 512; }
    else { const int v = u - 1024; b = v >> 4; h = (v >> 1) & 7; qt = v & 1; krow0 = b * 256; qrow0 = krow0 + qt * 128; nown = 4; ntot = 4; Tv = 256; vbase = (size_t)(b * 8 + h) * 64 * 256; }
    bf16x8 qf[6];
    { const bf16_t* qp = p.Qb + (size_t)(qrow0 + wid * 32 + q) * 768 + h * 96 + hf * 8;
#pragma unroll
      for (int ks = 0; ks < 6; ++ks) qf[ks] = *(const bf16x8*)(qp + ks * 16); }
    f32x16 oT[2];
#pragma unroll
    for (int i = 0; i < 16; ++i) { oT[0][i] = 0.f; oT[1][i] = 0.f; }
    float mrun = -1e30f, lrun = 0.f;
    u32x4 rk[3], rv[2];
    int krow[3], kc[3];
#pragma unroll
    for (int i = 0; i < 3; ++i) { const int c = tid + 256 * i; krow[i] = c / 12; kc[i] = c % 12; }
    const int vdv0 = tid >> 3, vkc = tid & 7;
#define ATT_LOAD(kt) do { const bf16_t* kptr; const bf16_t* vptr; int vstr; \
        if ((kt) < nown) { kptr = p.Kb + (size_t)(krow0 + (kt) * 64) * 768 + h * 96; vptr = p.Vt + vbase + (kt) * 64; vstr = Tv; } \
        else { kptr = p.Kc + (size_t)(kcrow0 + ((kt) - nown) * 64) * 768 + h * 96; vptr = p.Vtc + vcbase + ((kt) - nown) * 64; vstr = 512; } \
        _Pragma("unroll") for (int i = 0; i < 3; ++i) rk[i] = *(const u32x4*)(kptr + (size_t)krow[i] * 768 + kc[i] * 8); \
        _Pragma("unroll") for (int i = 0; i < 2; ++i) rv[i] = *(const u32x4*)(vptr + (size_t)(vdv0 + 32 * i) * vstr + vkc * 8); } while (0)
#define ATT_STORE(buf) do { char* Ks_ = smem + (buf) * ATT_STAGE; char* Vs_ = Ks_ + KS_BYTES; \
        _Pragma("unroll") for (int i = 0; i < 3; ++i) *(u32x4*)(Ks_ + (krow[i] * KS_STRIDE + kc[i] * 8) * 2) = rk[i]; \
        _Pragma("unroll") for (int i = 0; i < 2; ++i) { char* vd_ = Vs_ + ((vdv0 + 32 * i) * VS_STRIDE + vkc * 8) * 2; *(u32x2*)vd_ = (u32x2){rv[i].x, rv[i].y}; *(u32x2*)(vd_ + 8) = (u32x2){rv[i].z, rv[i].w}; } } while (0)
    ATT_LOAD(0); ATT_STORE(0);
    __syncthreads();
    for (int kt = 0; kt < ntot; ++kt) {
        const bool more = kt + 1 < ntot;
        if (more) ATT_LOAD(kt + 1);
        const char* Ks = smem + (kt & 1) * ATT_STAGE; const char* Vs = Ks + KS_BYTES;
        f32x16 sT[2];
#pragma unroll
        for (int i = 0; i < 16; ++i) { sT[0][i] = 0.f; sT[1][i] = 0.f; }
#pragma unroll
        for (int kb = 0; kb < 2; ++kb)
#pragma unroll
            for (int ks = 0; ks < 6; ++ks) { const bf16x8 kf = *(const bf16x8*)(Ks + ((kb * 32 + q) * KS_STRIDE + ks * 16 + hf * 8) * 2);
                sT[kb] = __builtin_amdgcn_mfma_f32_32x32x16_bf16(kf, qf[ks], sT[kb], 0, 0, 0); }
        float mx = sT[0][0];
#pragma unroll
        for (int i = 1; i < 16; ++i) mx = fmaxf(mx, sT[0][i]);
#pragma unroll
        for (int i = 0; i < 16; ++i) mx = fmaxf(mx, sT[1][i]);
        mx = fmaxf(mx, __shfl_xor(mx, 32));
        const float mnew = fmaxf(mrun, mx); const float alpha = __builtin_amdgcn_exp2f(mrun - mnew); const bool resc = __any(mnew > mrun); mrun = mnew;
        float psum = 0.f; bf16x8 pf[2][2];
#pragma unroll
        for (int kb = 0; kb < 2; ++kb)
#pragma unroll
            for (int s = 0; s < 2; ++s) { float e[8];
#pragma unroll
                for (int j = 0; j < 8; ++j) { e[j] = __builtin_amdgcn_exp2f(sT[kb][8 * s + j] - mnew); psum += e[j]; }
                u32x4 w; w.x = pack2(e[0], e[1]); w.y = pack2(e[2], e[3]); w.z = pack2(e[4], e[5]); w.w = pack2(e[6], e[7]);
                pf[kb][s] = __builtin_bit_cast(bf16x8, w); }
        lrun = lrun * alpha + psum;
        if (resc) {
#pragma unroll
            for (int i = 0; i < 16; ++i) { oT[0][i] *= alpha; oT[1][i] *= alpha; }
        }
#pragma unroll
        for (int kb = 0; kb < 2; ++kb)
#pragma unroll
            for (int s = 0; s < 2; ++s)
#pragma unroll
                for (int db = 0; db < 2; ++db) {
                    const char* vp = Vs + ((db * 32 + q) * VS_STRIDE + kb * 32 + 16 * s + 4 * hf) * 2;
                    const u32x2 lo = *(const u32x2*)vp, hi = *(const u32x2*)(vp + 16);
                    const u32x4 w = (u32x4){lo.x, lo.y, hi.x, hi.y};
                    oT[db] = __builtin_amdgcn_mfma_f32_32x32x16_bf16(__builtin_bit_cast(bf16x8, w), pf[kb][s], oT[db], 0, 0, 0);
                }
        if (more) ATT_STORE((kt + 1) & 1);
        __syncthreads();
    }
    const float lt = lrun + __shfl_xor(lrun, 32); const float inv = 1.0f / lt;
    bf16_t* op = p.hbmix + (size_t)(qrow0 + wid * 32 + q) * DM + 256 + h * 64;
#pragma unroll
    for (int db = 0; db < 2; ++db)
#pragma unroll
        for (int g = 0; g < 4; ++g) { u32x2 w; w.x = pack2(oT[db][4 * g] * inv, oT[db][4 * g + 1] * inv); w.y = pack2(oT[db][4 * g + 2] * inv, oT[db][4 * g + 3] * inv);
            *(u32x2*)(op + db * 32 + 8 * g + 4 * hf) = w; }
}

__device__ __forceinline__ void rwcomb_phase(const P& p, int l) {
    const int tid = opaque_tid(), lane = tid & 63, wid = tid >> 6; const int c = lane * 4;
    const f32x4 gng = *(const f32x4*)(p.rw_gn_g + l * 256 + c), gnb = *(const f32x4*)(p.rw_gn_b + l * 256 + c), kap = *(const f32x4*)(p.rw_ka + l * 256 + c), rkp = *(const f32x4*)(p.rw_rk + l * 256 + c);
    for (int row = blockIdx.x * 4 + wid; row < M_ALL; row += gridDim.x * 4) {
        const f32x4 y0 = *(const f32x4*)(p.ydir + (size_t)row * 256 + c), y1 = *(const f32x4*)(p.ydir + ((size_t)M_ALL + row) * 256 + c);
        f32x4 y = y0 + y1;
        float s = (y[0] + y[1]) + (y[2] + y[3]); s = red16(s); const float mu = s * (1.0f / 64.0f);
        const f32x4 dd = y - mu; float q2 = (dd[0] * dd[0] + dd[1] * dd[1]) + (dd[2] * dd[2] + dd[3] * dd[3]); q2 = red16(q2);
        const float rstd = rsqrtf(q2 * (1.0f / 64.0f) + 64e-5f);
        const f32x4 yn = dd * rstd * gng + gnb;
        const u32x2 rw = *(const u32x2*)(p.RKV + (size_t)row * 768 + c), kw = *(const u32x2*)(p.RKV + (size_t)row * 768 + 256 + c), vw = *(const u32x2*)(p.RKV + (size_t)row * 768 + 512 + c);
        const u32x2 a0w = *(const u32x2*)(p.Aa + (size_t)row * 256 + c), a1w = *(const u32x2*)(p.Aa + ((size_t)M_ALL + row) * 256 + c), gw = *(const u32x2*)(p.Gg + (size_t)row * 256 + c);
        const f32x4 r = (f32x4){lo_bf(rw.x), hi_bf(rw.x), lo_bf(rw.y), hi_bf(rw.y)}, k = (f32x4){lo_bf(kw.x), hi_bf(kw.x), lo_bf(kw.y), hi_bf(kw.y)}, v = (f32x4){lo_bf(vw.x), hi_bf(vw.x), lo_bf(vw.y), hi_bf(vw.y)};
        const f32x4 a0 = (f32x4){lo_bf(a0w.x), hi_bf(a0w.x), lo_bf(a0w.y), hi_bf(a0w.y)}, a1 = (f32x4){lo_bf(a1w.x), hi_bf(a1w.x), lo_bf(a1w.y), hi_bf(a1w.y)}, gt = (f32x4){lo_bf(gw.x), hi_bf(gw.x), lo_bf(gw.y), hi_bf(gw.y)};
        const f32x4 kds = k * (1.0f + (a0 - 1.0f) * kap) + k * (1.0f + (a1 - 1.0f) * kap);
        const f32x4 t4 = r * kds * rkp; float rk = (t4[0] + t4[1]) + (t4[2] + t4[3]); rk = red16(rk);
        const f32x4 o = (yn + rk * v) * gt;
        u32x2 w; w.x = pack2(o[0], o[1]); w.y = pack2(o[2], o[3]);
        *(u32x2*)(p.hbmix + (size_t)row * DM + c) = w;
    }
}


__device__ __forceinline__ bool xcd_tile(int i, int TT, int NT, int& mt, int& nt) {
    const int per = TT >> 3; if (i >= per) return false;
    const int t = (blockIdx.x & 7) * per + i; const int band = t / (8 * NT), rem = t - band * 8 * NT;
    nt = rem >> 3; mt = band * 8 + (rem & 7); return true;
}
__global__ void __launch_bounds__(256, 2) mega(Args a_unused) {
    extern __shared__ __attribute__((aligned(16))) char smem[];
    __shared__ uint4 xbw; __shared__ int s_unit;
    kargp_t kp = (kargp_t)__builtin_amdgcn_kernarg_segment_ptr();
    const int tid = threadIdx.x; const int G = gridDim.x;
    if (tid == 0) xbw = make_uint4(0u, 0u, 0u, 0u);
    __syncthreads();
    XcdBarrier xb;
    { const P p = getP(kp); xb = xcd_barrier_post(p.bar, (volatile LAS unsigned*)&xbw); }
    for (int u = blockIdx.x; u < 384 + NCONV + 272; u += G) {
        if (u < 384) { const P p = getP(kp); ada_unit(p, u, smem); } else if (u < 384 + NCONV) { const P p = getP(kp); conv_unit(p, 0, u - 384, smem); } else { const P p = getP(kp); misc0_unit(p, u - 384 - NCONV); }
    }
    cg::this_grid().sync();
    { const P p = getP(kp); ln_phase(p, 0, 0); }
    xcd_barrier(xb);
    float* rs = (float*)(smem + RS_OFF);
#pragma unroll 1
    for (int l = 0; l < 4; ++l) {
        for (int i = blockIdx.x >> 3; ; i += G >> 3) { int mt, nt; if (!xcd_tile(i, 80 * 17, 17, mt, nt)) break; const P p = getP(kp);
            EpiZ e{p.Z, mt * 256, nt * 128};
            gemm256(p.hbmix + (size_t)mt * 256 * DM, DM, p.WtIn + (size_t)nt * 128 * DM, DM, DM, smem, e); }
        xcd_barrier(xb);
        for (int rep2 = 0; rep2 < DUP_P2; ++rep2) {
        for (;;) {
            { const P pc = getP(kp); if (tid == 0) s_unit = atomicAdd(&pc.ctr[l * 4 + 0 + 2 * rep2], 1); }
            __syncthreads(); int u = s_unit; __syncthreads();
            if (u >= 320 + 480 + 640 + 64 + 352 + 640) break;
            if (u < 320) { const P p = getP(kp); rwprep_unit(p, l, u, smem); continue; }
            u -= 320;
            if (u < 480) { const P p = getP(kp); const int mt = u / 3, np = u % 3;
                rowscale128(p.Z, mt * 128, ZQ, 256, 1e-6f, rs);
                for (int k2 = 0; k2 < 2; ++k2) { const int nt = np * 2 + k2;
                    EpiQ e{p.Qb, rs, p.ropeC, p.ropeS, mt * 128, nt * 128};
                    gemm128(p.Z + (size_t)mt * 128 * NIN + ZQ, NIN, p.WtQ + (size_t)nt * 128 * 256, 256, 256, smem, e); }
                __syncthreads(); continue; }
            u -= 480;
            if (u < 640) { const P p = getP(kp); const int mt = u >> 2, np = u & 3; const int R0 = mt * 128; const bool latr = R0 >= M_CTX;
                rowscale128(p.Z, R0, ZKV, 128, 1e-6f, rs);
                for (int k2 = 0; k2 < 2; ++k2) { const int nt = np * 2 + k2;
                    EpiKV e{latr ? p.Kb + (size_t)M_CTX * 768 : p.Kb, p.Vt, rs, latr ? R0 - M_CTX : R0, nt * 128, latr ? 12 : 8, latr ? (size_t)2097152 : (size_t)0};
                    gemm128(p.Z + (size_t)R0 * NIN + ZKV, NIN, p.WtKVn + (size_t)nt * 128 * 128, 128, 128, smem, e); }
                __syncthreads(); continue; }
            u -= 640;
            if (u < 64) { const P p = getP(kp); const int mt = u >> 2, np = u & 3;
                for (int k2 = 0; k2 < 2; ++k2) { const int nt = np * 2 + k2;
                    EpiKV e{p.Kc, p.Vtc, nullptr, mt * 128, nt * 128, 9, (size_t)0};
                    gemm128(p.CkvB + ((size_t)l * 2048 + mt * 128) * 128, 128, p.WtKV + (size_t)nt * 128 * 128, 128, 128, smem, e); }
                continue; }
            u -= 64;
            if (u < 352) { const P p = getP(kp); for (int i = 0; i < 8; ++i) small_unit(p, l, u * 8 + i); continue; }
            u -= 352;
            { const P p = getP(kp); gmlp_unit(p, l, u, smem); }
        }
        xcd_barrier(xb);
        }
        for (int rep3 = 0; rep3 < DUP_P3; ++rep3) {
        for (;;) {
            { const P pc = getP(kp); if (tid == 0) s_unit = atomicAdd(&pc.ctr[l * 4 + 1 + 2 * rep3], 1); }
            __syncthreads(); int u = s_unit; __syncthreads();
            if (u >= NSCAN + 1280) break;
#ifdef PROBE_SCAN_ONLY
            if (rep3 == 1 && u >= NSCAN) break;
#endif
#ifdef PROBE_ATTN_ONLY
            if (rep3 == 1 && u < NSCAN) continue;
#endif
            if (u < NSCAN) { const P p = getP(kp); scan_unit(p, l, u, smem); } else { const P p = getP(kp); attn_unit(p, u - NSCAN, smem); }
        }
        xcd_barrier(xb);
        }
        { const P p = getP(kp); rwcomb_phase(p, l); }
        xcd_barrier(xb);
        for (int i = blockIdx.x >> 3; ; i += G >> 3) { int mt, nt; if (!xcd_tile(i, 160 * 8, 8, mt, nt)) break; const P p = getP(kp);
            EpiRes e{p.out, p.mod + ((size_t)l * 5 + modrow_of(mt * 128)) * 6144 + 2048, mt * 128, nt * 128};
            gemm128(p.hbmix + (size_t)mt * 128 * DM, DM, p.WtOut + (size_t)nt * 128 * DM, DM, DM, smem, e); }
        xcd_barrier(xb);
        { const P p = getP(kp); ln_phase(p, l, 1); }
        xcd_barrier(xb);
        for (int rep5 = 0; rep5 < DUP_P5; ++rep5)
        for (int i = blockIdx.x >> 3; ; i += G >> 3) { int mt, nt; if (!xcd_tile(i, 80 * 44, 44, mt, nt)) break; const P p = getP(kp);
            EpiSwi e{p.hidden, mt * 256, nt * 128};
            gemm256(p.hbmix + (size_t)mt * 256 * DM, DM, p.WtF1 + (size_t)nt * 128 * DM, DM, DM, smem, e); }
        xcd_barrier(xb);
        for (int i = blockIdx.x >> 3; ; i += G >> 3) { int mt, nt; if (!xcd_tile(i, 160 * 8, 8, mt, nt)) break; const P p = getP(kp);
            EpiRes e{p.out, p.mod + ((size_t)l * 5 + modrow_of(mt * 128)) * 6144 + 5120, mt * 128, nt * 128};
            gemm128(p.hidden + (size_t)mt * 128 * DFF, DFF, p.WtF2 + (size_t)nt * 128 * DFF, DFF, DFF, smem, e); }
        xcd_barrier(xb);
        { const P p = getP(kp); ln_phase(p, l, 2); }
        if (l < 3) { for (int u = blockIdx.x; u < NCONV; u += G) { const P p = getP(kp); conv_unit(p, l + 1, u, smem); } }
        xcd_barrier(xb);
    }
}

extern "C" void kernel_launch(void* const* d_in, const int* in_sizes, int n_in, void* d_out, int out_size, void* d_ws, size_t ws_size, hipStream_t stream) {
    static int grid_blocks = 0;
    if (!grid_blocks) {
        int dev = 0, cus = 0, per_cu = 0;
        (void)hipGetDevice(&dev);
        (void)hipDeviceGetAttribute(&cus, hipDeviceAttributeMultiprocessorCount, dev);
        (void)hipFuncSetAttribute((const void*)mega, hipFuncAttributeMaxDynamicSharedMemorySize, SMEM_BYTES);
        (void)hipOccupancyMaxActiveBlocksPerMultiprocessor(&per_cu, (const void*)mega, 256, SMEM_BYTES);
        if (per_cu > 2) per_cu = 2;
        if (per_cu < 1) per_cu = 1;
        grid_blocks = (cus * per_cu) & ~7;
    }
    if (WS_TOTAL > ws_size) { fprintf(stderr, "kernel_launch: workspace too small: need %zu have %zu\n", (size_t)WS_TOTAL, ws_size); return; }
    Args a{};
    for (int i = 0; i < 36; ++i) a.in[i] = (const float*)d_in[i];
    a.out = (float*)d_out; a.ws = (char*)d_ws;
    (void)hipMemsetAsync((char*)d_ws + OFF_BAR, 0, 16384 + 4096, stream);
    void* args[] = {&a};
    hipError_t e = hipLaunchCooperativeKernel((const void*)mega, dim3(grid_blocks), dim3(256), args, SMEM_BYTES, stream);
    if (e != hipSuccess) fprintf(stderr, "cooperative launch failed: %s (grid %d)\n", hipGetErrorString(e), grid_blocks);
}
```

```cpp
#include <hip/hip_runtime.h>
#include <hip/hip_cooperative_groups.h>
#include <cstdint>
#include <cstdio>
namespace cg = cooperative_groups;

typedef unsigned short bf16_t;
typedef short bf16x8 __attribute__((ext_vector_type(8)));
typedef float f32x4 __attribute__((ext_vector_type(4)));
typedef float f32x2 __attribute__((ext_vector_type(2)));
typedef float f32x16 __attribute__((ext_vector_type(16)));
typedef unsigned u32x4 __attribute__((ext_vector_type(4)));
typedef unsigned u32x2 __attribute__((ext_vector_type(2)));

#define M_ALL 20480
#define M_CTX 4096
#define DM 1024
#define NIN 2080
#define DFF 2816
#define ALPHA_F 1.6817928305074290f
#define QSCALE (0.10206207261596575f * 1.4426950408889634f)
#define LAS __attribute__((address_space(3)))
#ifndef DUP_P2
#define DUP_P2 1
#endif
#ifndef DUP_P3
#define DUP_P3 1
#endif
#ifndef DUP_P5
#define DUP_P5 1
#endif

#define ZQ 1152
#define ZKV 1408
#define ZKR 1536
#define ZU 1568
#define ZV 1824

#define LDS_STRIDE 72
#define TILE_BYTES (128 * LDS_STRIDE * 2)
#define RS_OFF (4 * TILE_BYTES)
#define SMEM_BYTES (RS_OFF + 3072)

struct P {
    const float *x_prompt, *x_sample, *cache_ckv, *cache_krope, *state_rwkv, *c, *c_ctx, *ada_w, *ada_b, *w_in, *rw_conv, *rw_w0, *rw_w2,
        *rw_a0, *rw_a2, *rw_g2, *rw_kk, *rw_ka, *rw_rk, *rw_gn_g, *rw_gn_b, *q_norm, *q_up, *kv_norm, *kv_up, *gm_g, *gm_b, *gm_ws, *gm_bs,
        *w_out, *ln1_g, *ln1_b, *ffn_in, *ffn_out, *ln2_g, *ln2_b;
    float* out;
    unsigned* bar; int* ctr; float* mod; float* ropeC; float* ropeS; bf16_t* CkvB;
    bf16_t *WtIn, *WtQ, *WtKVn, *WtKV, *WtOut, *WtF1, *WtF2, *WsB, *W2t, *A2t, *G2t;
    bf16_t *Z, *RKV, *Ee, *Aa, *Gg, *Qb, *Kb, *Kc, *Vt, *Vtc, *hbmix, *hidden;
    float* ydir;
};


struct Args { const float* in[36]; float* out; char* ws; };
typedef const __attribute__((address_space(4))) char* kargp_t;
constexpr size_t al256(size_t x) { return (x + 255) & ~(size_t)255; }
constexpr size_t OFF_BAR = 0;
constexpr size_t OFF_CTR = OFF_BAR + 16384;
constexpr size_t OFF_MOD = OFF_CTR + 4096;
constexpr size_t OFF_ROPEC = OFF_MOD + al256((size_t)4 * 5 * 6144 * 4);
constexpr size_t OFF_ROPES = OFF_ROPEC + 65536 * 4;
constexpr size_t OFF_CKVB = OFF_ROPES + 65536 * 4;
constexpr size_t OFF_WTIN = OFF_CKVB + (size_t)4 * 2048 * 128 * 2;
constexpr size_t OFF_WTQ = OFF_WTIN + (size_t)2176 * 1024 * 2;
constexpr size_t OFF_WTKVN = OFF_WTQ + (size_t)768 * 256 * 2;
constexpr size_t OFF_WTKV = OFF_WTKVN + (size_t)1024 * 128 * 2;
constexpr size_t OFF_WTOUT = OFF_WTKV + (size_t)1024 * 128 * 2;
constexpr size_t OFF_WTF1 = OFF_WTOUT + (size_t)1024 * 1024 * 2;
constexpr size_t OFF_WTF2 = OFF_WTF1 + (size_t)5632 * 1024 * 2;
constexpr size_t OFF_WSB = OFF_WTF2 + (size_t)1024 * DFF * 2;
constexpr size_t OFF_W2T = OFF_WSB + (size_t)65536 * 2;
constexpr size_t OFF_A2T = OFF_W2T + (size_t)2 * 256 * 64 * 2;
constexpr size_t OFF_G2T = OFF_A2T + (size_t)2 * 256 * 64 * 2;
constexpr size_t OFF_Z = OFF_G2T + (size_t)256 * 128 * 2;
constexpr size_t OFF_HIDDEN = OFF_Z;
constexpr size_t OFF_RKV = OFF_Z + al256((size_t)M_ALL * NIN * 2);
constexpr size_t OFF_EE = OFF_RKV + (size_t)M_ALL * 768 * 2;
constexpr size_t OFF_AA = OFF_EE + (size_t)2 * M_ALL * 256 * 2;
constexpr size_t OFF_GG = OFF_AA + (size_t)2 * M_ALL * 256 * 2;
constexpr size_t OFF_QB = OFF_GG + (size_t)M_ALL * 256 * 2;
constexpr size_t OFF_KB = OFF_QB + (size_t)M_ALL * 768 * 2;
constexpr size_t OFF_KC = OFF_KB + (size_t)M_ALL * 768 * 2;
constexpr size_t OFF_VT = OFF_KC + (size_t)2048 * 768 * 2;
constexpr size_t OFF_VTC = OFF_VT + (size_t)M_ALL * 512 * 2;
constexpr size_t OFF_YDIR = OFF_VTC + (size_t)2048 * 512 * 2;
constexpr size_t OFF_HBMIX = OFF_YDIR + (size_t)2 * M_ALL * 256 * 4;
constexpr size_t WS_TOTAL = OFF_HBMIX + (size_t)M_ALL * DM * 2;
static_assert(OFF_RKV + (size_t)M_ALL * 768 * 2 - OFF_HIDDEN >= (size_t)M_ALL * DFF * 2, "hidden overlay");

__device__ __forceinline__ P getP(kargp_t& kp) {
    asm volatile("" : "+s"(kp));
    typedef const float* const __attribute__((address_space(4)))* inp_t;
    inp_t in = (inp_t)kp;
    P p;
    p.x_prompt = in[0]; p.x_sample = in[1]; p.cache_ckv = in[2]; p.cache_krope = in[3]; p.state_rwkv = in[4]; p.c = in[5]; p.c_ctx = in[6];
    p.ada_w = in[7]; p.ada_b = in[8]; p.w_in = in[9]; p.rw_conv = in[10]; p.rw_w0 = in[11]; p.rw_w2 = in[12]; p.rw_a0 = in[13]; p.rw_a2 = in[14];
    p.rw_g2 = in[15]; p.rw_kk = in[16]; p.rw_ka = in[17]; p.rw_rk = in[18]; p.rw_gn_g = in[19]; p.rw_gn_b = in[20]; p.q_norm = in[21]; p.q_up = in[22];
    p.kv_norm = in[23]; p.kv_up = in[24]; p.gm_g = in[25]; p.gm_b = in[26]; p.gm_ws = in[27]; p.gm_bs = in[28]; p.w_out = in[29]; p.ln1_g = in[30];
    p.ln1_b = in[31]; p.ffn_in = in[32]; p.ffn_out = in[33]; p.ln2_g = in[34]; p.ln2_b = in[35];
    p.out = (float*)in[36]; char* ws = (char*)in[37];
    p.bar = (unsigned*)(ws + OFF_BAR); p.ctr = (int*)(ws + OFF_CTR); p.mod = (float*)(ws + OFF_MOD); p.ropeC = (float*)(ws + OFF_ROPEC); p.ropeS = (float*)(ws + OFF_ROPES);
    p.CkvB = (bf16_t*)(ws + OFF_CKVB); p.WtIn = (bf16_t*)(ws + OFF_WTIN); p.WtQ = (bf16_t*)(ws + OFF_WTQ); p.WtKVn = (bf16_t*)(ws + OFF_WTKVN); p.WtKV = (bf16_t*)(ws + OFF_WTKV);
    p.WtOut = (bf16_t*)(ws + OFF_WTOUT); p.WtF1 = (bf16_t*)(ws + OFF_WTF1); p.WtF2 = (bf16_t*)(ws + OFF_WTF2); p.WsB = (bf16_t*)(ws + OFF_WSB); p.W2t = (bf16_t*)(ws + OFF_W2T);
    p.A2t = (bf16_t*)(ws + OFF_A2T); p.G2t = (bf16_t*)(ws + OFF_G2T); p.Z = (bf16_t*)(ws + OFF_Z); p.RKV = (bf16_t*)(ws + OFF_RKV); p.Ee = (bf16_t*)(ws + OFF_EE); p.Aa = (bf16_t*)(ws + OFF_AA);
    p.Gg = (bf16_t*)(ws + OFF_GG); p.Qb = (bf16_t*)(ws + OFF_QB); p.Kb = (bf16_t*)(ws + OFF_KB); p.Kc = (bf16_t*)(ws + OFF_KC); p.Vt = (bf16_t*)(ws + OFF_VT); p.Vtc = (bf16_t*)(ws + OFF_VTC);
    p.hbmix = (bf16_t*)(ws + OFF_HBMIX); p.hidden = (bf16_t*)(ws + OFF_HIDDEN); p.ydir = (float*)(ws + OFF_YDIR);
    return p;
}

__device__ __forceinline__ float bf2f(bf16_t b) { return __uint_as_float(((unsigned)b) << 16); }
__device__ __forceinline__ unsigned pack2(float lo, float hi) { unsigned r; asm("v_cvt_pk_bf16_f32 %0, %1, %2" : "=v"(r) : "v"(lo), "v"(hi)); return r; }
__device__ __forceinline__ bf16_t f2bf(float f) { return (bf16_t)(pack2(f, 0.f) & 0xffffu); }
__device__ __forceinline__ float lo_bf(unsigned w) { return __uint_as_float(w << 16); }
__device__ __forceinline__ float hi_bf(unsigned w) { return __uint_as_float(w & 0xffff0000u); }
__device__ __forceinline__ float sigmoidf_(float x) { return __builtin_amdgcn_rcpf(1.0f + __builtin_amdgcn_exp2f(-1.4426950408889634f * x)); }
__device__ __forceinline__ float tanhf_(float x) { float e = __builtin_amdgcn_exp2f(2.8853900817779268f * x); return 1.0f - 2.0f * __builtin_amdgcn_rcpf(e + 1.0f); }
__device__ __forceinline__ float geluf_(float x) { return 0.5f * x * (1.0f + tanhf_(0.7978845608028654f * (x + 0.044715f * x * x * x))); }
template <int CTRL> __device__ __forceinline__ float dpp_add(float x) {
    int y = __builtin_amdgcn_update_dpp(0, __float_as_int(x), CTRL, 0xf, 0xf, false);
    return x + __int_as_float(y);
}
__device__ __forceinline__ float red4(float x) { x = dpp_add<0xB1>(x); x = dpp_add<0x4E>(x); return x; }
__device__ __forceinline__ float red8(float x) { x = red4(x); x = dpp_add<0x141>(x); return x; }
__device__ __forceinline__ float red16(float x) { x = red8(x); x = dpp_add<0x140>(x); return x; }
__device__ __forceinline__ int opaque_tid() { int t = threadIdx.x; asm volatile("" : "+v"(t)); return t; }
__device__ __forceinline__ int modrow_of(int row) { return row < M_CTX ? 0 : 1 + ((row - M_CTX) >> 12); }

#define XB_TMO 128
#define XB_XCNT(j) (256 + 64 * (j))
#define XB_XSUB(j) (1280 + 64 * (j))
#define XB_XGEN(j) (2304 + 64 * (j))
#define XB_TOP 3328
#define XB_TOPGEN 3392
#define XCD_BAR_WORDS 3456
#define XB_SPIN_CAP (1u << 22)
__device__ __forceinline__ unsigned xb_ld(unsigned* p) { return __hip_atomic_load(p, __ATOMIC_RELAXED, __HIP_MEMORY_SCOPE_AGENT); }
__device__ __forceinline__ unsigned xb_add(unsigned* p, unsigned v) { return __hip_atomic_fetch_add(p, v, __ATOMIC_RELAXED, __HIP_MEMORY_SCOPE_AGENT); }
__device__ __forceinline__ unsigned xb_xcc_id() { return (unsigned)__builtin_amdgcn_s_getreg((3 << 11) | 20) & 0xFu; }
#define XB_SPIN(cond, bar) do { unsigned _sp = 0; while (cond) { __builtin_amdgcn_s_sleep(1); \
    if ((++_sp & 255u) == 0u) { if (xb_ld(&(bar)[XB_TMO])) break; if (_sp > XB_SPIN_CAP) { atomicAdd(&(bar)[XB_TMO], 1u); break; } } } } while (0)
struct XcdBarrier { unsigned* bar; unsigned x; volatile LAS unsigned* st; };
__device__ __forceinline__ XcdBarrier xcd_barrier_post(unsigned* bar, volatile LAS unsigned* st) {
    XcdBarrier b; b.bar = bar; b.x = xb_xcc_id(); b.st = st;
    if (threadIdx.x == 0) (void)xb_add(&bar[XB_XCNT(b.x)], 1u);
    return b;
}
__device__ __forceinline__ void xcd_barrier_complete(unsigned* bar, unsigned x, unsigned& nloc, unsigned& nx) {
    const unsigned G = gridDim.x * gridDim.y * gridDim.z;
    unsigned sum, cnt, mine, sp = 0u;
    for (;;) {
        sum = 0u; cnt = 0u; mine = 0u;
#pragma unroll
        for (unsigned j = 0; j < 16; ++j) { const unsigned c = xb_ld(&bar[XB_XCNT(j)]); sum += c; cnt += (c > 0u) ? 1u : 0u; mine = (j == x) ? c : mine; }
        if (sum == G) break;
        __builtin_amdgcn_s_sleep(1);
        if ((++sp & 255u) == 0u) { if (xb_ld(&bar[XB_TMO])) break; if (sp > XB_SPIN_CAP) { atomicAdd(&bar[XB_TMO], 1u); break; } }
    }
    nloc = mine > 0u ? mine : 1u; nx = cnt > 0u ? cnt : 1u;
}
__device__ __forceinline__ void xcd_barrier(const XcdBarrier& b) {
    asm volatile("s_waitcnt vmcnt(0)" ::: "memory");
    __syncthreads();
    if (threadIdx.x == 0) {
        unsigned* bar = b.bar;
        __builtin_amdgcn_s_waitcnt(0);
        unsigned nloc = b.st[0], nx = b.st[1];
        if (nloc == 0u) { xcd_barrier_complete(bar, b.x, nloc, nx); b.st[0] = nloc; b.st[1] = nx; }
        const unsigned old = xb_add(&bar[XB_XSUB(b.x)], 1u);
        const unsigned gen = old / nloc;
        if (old + 1u == (gen + 1u) * nloc) {
            __builtin_amdgcn_fence(__ATOMIC_RELEASE, "agent");
            asm volatile("s_waitcnt vmcnt(0)" ::: "memory");
            const unsigned og = xb_add(&bar[XB_TOP], 1u);
            const unsigned tg = og / nx;
            if (og + 1u == (tg + 1u) * nx) xb_add(&bar[XB_TOPGEN], 1u);
            else XB_SPIN(xb_ld(&bar[XB_TOPGEN]) == tg, bar);
            __builtin_amdgcn_fence(__ATOMIC_ACQUIRE, "agent");
            xb_add(&bar[XB_XGEN(b.x)], 1u);
            asm volatile("s_waitcnt vmcnt(0)" ::: "memory");
        } else {
            XB_SPIN(xb_ld(&bar[XB_XGEN(b.x)]) == gen, bar);
            __builtin_amdgcn_fence(__ATOMIC_ACQUIRE, "agent");
            asm volatile("s_waitcnt vmcnt(0)" ::: "memory");
        }
    }
    __syncthreads();
}

template <bool TR, class Epi>
__device__ __forceinline__ void gemm128(const bf16_t* __restrict__ A, int lda, const bf16_t* __restrict__ B, int ldb, int K, char* smem, const Epi& epi) {
    const int tid = opaque_tid(), lane = tid & 63, wid = tid >> 6, wr = wid >> 1, wc = wid & 1, fr = lane & 15, fq = lane >> 4;
    f32x4 acc[4][4];
#pragma unroll
    for (int m = 0; m < 4; ++m)
#pragma unroll
        for (int n = 0; n < 4; ++n) acc[m][n] = (f32x4){0.f, 0.f, 0.f, 0.f};
    const int crow = tid >> 3, ckc = tid & 7;
    const bf16_t* ap = A + (size_t)crow * lda + ckc * 8;
    const bf16_t* bp = B + (size_t)crow * ldb + ckc * 8;
    u32x4 ra[4], rb[4];
#pragma unroll
    for (int i = 0; i < 4; ++i) { ra[i] = *(const u32x4*)(ap + (size_t)(32 * i) * lda); rb[i] = *(const u32x4*)(bp + (size_t)(32 * i) * ldb); }
    {
        char* sa = smem; char* sb = smem + TILE_BYTES;
#pragma unroll
        for (int i = 0; i < 4; ++i) { *(u32x4*)(sa + ((crow + 32 * i) * LDS_STRIDE + ckc * 8) * 2) = ra[i]; *(u32x4*)(sb + ((crow + 32 * i) * LDS_STRIDE + ckc * 8) * 2) = rb[i]; }
    }
    __syncthreads();
    const int nk = K >> 6;
    for (int kt = 0; kt < nk; ++kt) {
        const bool more = (kt + 1 < nk);
        if (more) {
            const int k0 = (kt + 1) << 6;
#pragma unroll
            for (int i = 0; i < 4; ++i) { ra[i] = *(const u32x4*)(ap + (size_t)(32 * i) * lda + k0); rb[i] = *(const u32x4*)(bp + (size_t)(32 * i) * ldb + k0); }
        }
        const char* sa = smem + (kt & 1) * 2 * TILE_BYTES; const char* sb = sa + TILE_BYTES;
#pragma unroll
        for (int ks = 0; ks < 2; ++ks) {
            bf16x8 af[4], bfr[4];
#pragma unroll
            for (int m = 0; m < 4; ++m) af[m] = *(const bf16x8*)(sa + ((wr * 64 + m * 16 + fr) * LDS_STRIDE + ks * 32 + fq * 8) * 2);
#pragma unroll
            for (int n = 0; n < 4; ++n) bfr[n] = *(const bf16x8*)(sb + ((wc * 64 + n * 16 + fr) * LDS_STRIDE + ks * 32 + fq * 8) * 2);
            __builtin_amdgcn_s_setprio(1);
#pragma unroll
            for (int m = 0; m < 4; ++m)
#pragma unroll
                for (int n = 0; n < 4; ++n) acc[m][n] = TR ? __builtin_amdgcn_mfma_f32_16x16x32_bf16(bfr[n], af[m], acc[m][n], 0, 0, 0) : __builtin_amdgcn_mfma_f32_16x16x32_bf16(af[m], bfr[n], acc[m][n], 0, 0, 0);
            __builtin_amdgcn_s_setprio(0);
        }
        if (more) {
            char* da = smem + ((kt + 1) & 1) * 2 * TILE_BYTES; char* db = da + TILE_BYTES;
#pragma unroll
            for (int i = 0; i < 4; ++i) { *(u32x4*)(da + ((crow + 32 * i) * LDS_STRIDE + ckc * 8) * 2) = ra[i]; *(u32x4*)(db + ((crow + 32 * i) * LDS_STRIDE + ckc * 8) * 2) = rb[i]; }
        }
        __syncthreads();
    }
    epi(acc, wr * 64, wc * 64, fr, fq);
}


#define L2_STRIDE 40
#define A2_BYTES (256 * L2_STRIDE * 2)
#define B2_BYTES (128 * L2_STRIDE * 2)
#define ST2_BYTES (A2_BYTES + B2_BYTES)
template <class Epi>
__device__ __forceinline__ void gemm256(const bf16_t* __restrict__ A, int lda, const bf16_t* __restrict__ B, int ldb, int K, char* smem, const Epi& epi) {
    const int tid = opaque_tid(), lane = tid & 63, wid = tid >> 6, wr = wid >> 1, wc = wid & 1, fr = lane & 15, fq = lane >> 4;
    f32x4 acc[2][4][4];
#pragma unroll
    for (int hh = 0; hh < 2; ++hh)
#pragma unroll
        for (int m = 0; m < 4; ++m)
#pragma unroll
            for (int n = 0; n < 4; ++n) acc[hh][m][n] = (f32x4){0.f, 0.f, 0.f, 0.f};
    const int crow = tid >> 2, ckc = tid & 3;
    const bf16_t* ap = A + (size_t)crow * lda + ckc * 8;
    const bf16_t* bp = B + (size_t)crow * ldb + ckc * 8;
    u32x4 ra[4], rb[2];
#pragma unroll
    for (int i = 0; i < 4; ++i) ra[i] = *(const u32x4*)(ap + (size_t)(64 * i) * lda);
#pragma unroll
    for (int i = 0; i < 2; ++i) rb[i] = *(const u32x4*)(bp + (size_t)(64 * i) * ldb);
    {
        char* sa = smem; char* sb = smem + A2_BYTES;
#pragma unroll
        for (int i = 0; i < 4; ++i) *(u32x4*)(sa + ((crow + 64 * i) * L2_STRIDE + ckc * 8) * 2) = ra[i];
#pragma unroll
        for (int i = 0; i < 2; ++i) *(u32x4*)(sb + ((crow + 64 * i) * L2_STRIDE + ckc * 8) * 2) = rb[i];
    }
    __syncthreads();
    const int nk = K >> 5;
    for (int kt = 0; kt < nk; ++kt) {
        const bool more = (kt + 1 < nk);
        if (more) {
            const int k0 = (kt + 1) << 5;
#pragma unroll
            for (int i = 0; i < 4; ++i) ra[i] = *(const u32x4*)(ap + (size_t)(64 * i) * lda + k0);
#pragma unroll
            for (int i = 0; i < 2; ++i) rb[i] = *(const u32x4*)(bp + (size_t)(64 * i) * ldb + k0);
        }
        const char* sa = smem + (kt & 1) * ST2_BYTES; const char* sb = sa + A2_BYTES;
        bf16x8 bfr[4];
#pragma unroll
        for (int n = 0; n < 4; ++n) bfr[n] = *(const bf16x8*)(sb + ((wc * 64 + n * 16 + fr) * L2_STRIDE + fq * 8) * 2);
#pragma unroll
        for (int hh = 0; hh < 2; ++hh) {
            bf16x8 af[4];
#pragma unroll
            for (int m = 0; m < 4; ++m) af[m] = *(const bf16x8*)(sa + ((wr * 128 + hh * 64 + m * 16 + fr) * L2_STRIDE + fq * 8) * 2);
            __builtin_amdgcn_s_setprio(1);
#pragma unroll
            for (int m = 0; m < 4; ++m)
#pragma unroll
                for (int n = 0; n < 4; ++n) acc[hh][m][n] = __builtin_amdgcn_mfma_f32_16x16x32_bf16(bfr[n], af[m], acc[hh][m][n], 0, 0, 0);
            __builtin_amdgcn_s_setprio(0);
        }
        if (more) {
            char* da = smem + ((kt + 1) & 1) * ST2_BYTES; char* db = da + A2_BYTES;
#pragma unroll
            for (int i = 0; i < 4; ++i) *(u32x4*)(da + ((crow + 64 * i) * L2_STRIDE + ckc * 8) * 2) = ra[i];
#pragma unroll
            for (int i = 0; i < 2; ++i) *(u32x4*)(db + ((crow + 64 * i) * L2_STRIDE + ckc * 8) * 2) = rb[i];
        }
        __syncthreads();
    }
    epi(acc[0], wr * 128, wc * 64, fr, fq);
    epi(acc[1], wr * 128 + 64, wc * 64, fr, fq);
}

struct EpiZ {
    bf16_t* Z; int R0, C0;
    __device__ __forceinline__ void operator()(f32x4 (&acc)[4][4], int r0, int c0, int fr, int fq) const {
#pragma unroll
        for (int n = 0; n < 4; ++n) { const int col = C0 + c0 + n * 16 + fq * 4; if (col < NIN) {
#pragma unroll
            for (int m = 0; m < 4; ++m) { u32x2 w; w.x = pack2(acc[m][n][0], acc[m][n][1]); w.y = pack2(acc[m][n][2], acc[m][n][3]);
                *(u32x2*)(Z + (size_t)(R0 + r0 + m * 16 + fr) * NIN + col) = w; } } }
    }
};
struct EpiQ {
    bf16_t* Q; const float* rs; const float* ropeC; const float* ropeS; int R0, C0;
    __device__ __forceinline__ void operator()(f32x4 (&acc)[4][4], int r0, int c0, int fr, int fq) const {
        const bool lat = R0 >= M_CTX;
#pragma unroll
        for (int n = 0; n < 4; ++n) {
            const int cb = C0 + c0 + n * 16; const int hcs = cb % 96;
            if (lat && hcs == 80) continue;
            const bool rot = lat && hcs == 64;
#pragma unroll
            for (int m = 0; m < 4; ++m)
#pragma unroll
                for (int j = 0; j < 4; ++j) {
                    const int rl = r0 + m * 16 + fq * 4 + j; const int row = R0 + rl; const float s = rs[rl] * QSCALE;
                    const float x1 = acc[m][n][j] * s;
                    if (rot) {
                        const float x2 = acc[m][(n + 1) & 3][j] * s; const int t = (row - M_CTX) & 4095;
                        const float cv = ropeC[t * 16 + fr], sv = ropeS[t * 16 + fr];
                        Q[(size_t)row * 768 + cb + fr] = f2bf(x1 * cv - x2 * sv);
                        Q[(size_t)row * 768 + cb + 16 + fr] = f2bf(x1 * sv + x2 * cv);
                    } else Q[(size_t)row * 768 + cb + fr] = f2bf(x1);
                }
        }
    }
};
struct EpiKV {
    bf16_t* Kd; bf16_t* Vd; const float* rs; int R0, C0; int seqshift; size_t vbase0;
    __device__ __forceinline__ void operator()(f32x4 (&acc)[4][4], int r0, int c0, int fr, int fq) const {
#pragma unroll
        for (int n = 0; n < 4; ++n) {
            const int col = C0 + c0 + n * 16 + fr;
#pragma unroll
            for (int m = 0; m < 4; ++m) {
                const int rl = r0 + m * 16 + fq * 4; const int row = R0 + rl;
                float v[4];
#pragma unroll
                for (int j = 0; j < 4; ++j) v[j] = acc[m][n][j] * (rs ? rs[rl + j] : 1.0f);
                if (col < 512) {
                    const int h = col >> 6, d = col & 63;
#pragma unroll
                    for (int j = 0; j < 4; ++j) Kd[(size_t)(row + j) * 768 + h * 96 + d] = f2bf(v[j]);
                } else {
                    const int vc = col - 512, h = vc >> 6, dv = vc & 63; const int b = row >> seqshift, t = row & ((1 << seqshift) - 1);
                    u32x2 w; w.x = pack2(v[0], v[1]); w.y = pack2(v[2], v[3]);
                    *(u32x2*)(Vd + vbase0 + ((size_t)((b * 8 + h) * 64 + dv) << seqshift) + t) = w;
                }
            }
        }
    }
};
struct EpiRes {
    float* X; const float* gate; int R0, C0;
    __device__ __forceinline__ void operator()(f32x4 (&acc)[4][4], int r0, int c0, int fr, int fq) const {
#pragma unroll
        for (int n = 0; n < 4; ++n) { const int col = C0 + c0 + n * 16 + fq * 4; const f32x4 g = *(const f32x4*)(gate + col);
#pragma unroll
            for (int m = 0; m < 4; ++m) { float* px = X + (size_t)(R0 + r0 + m * 16 + fr) * DM + col; const f32x4 xv = *(const f32x4*)px; *(f32x4*)px = ALPHA_F * xv + g * acc[m][n]; } }
    }
};
struct EpiSwi {
    bf16_t* H; int R0, C0;
    __device__ __forceinline__ void operator()(f32x4 (&acc)[4][4], int r0, int c0, int fr, int fq) const {
        const int hb = ((C0 + c0) >> 1) + fq * 4;
#pragma unroll
        for (int n = 0; n < 2; ++n)
#pragma unroll
            for (int m = 0; m < 4; ++m) { float o[4];
#pragma unroll
                for (int j = 0; j < 4; ++j) { const float g = acc[m][n][j], u = acc[m][n + 2][j]; o[j] = g * sigmoidf_(g) * u; }
                u32x2 w; w.x = pack2(o[0], o[1]); w.y = pack2(o[2], o[3]);
                *(u32x2*)(H + (size_t)(R0 + r0 + m * 16 + fr) * DFF + hb + n * 16) = w; }
    }
};

__device__ __forceinline__ void ada_unit(const P& p, int u, char* smem) {
    const int tid = opaque_tid(); const int l = u / 96, c0 = (u % 96) * 64;
    float* cs = (float*)smem;
    for (int i = tid; i < 5 * 1024; i += 256) { const int r = i >> 10, k = i & 1023; const float v = (r == 0) ? p.c_ctx[k] : p.c[(r - 1) * 1024 + k]; cs[i] = v * sigmoidf_(v); }
    __syncthreads();
    const int col = tid & 63, kq = tid >> 6;
    float s0 = 0.f, s1 = 0.f, s2 = 0.f, s3 = 0.f, s4 = 0.f;
    const float* w = p.ada_w + ((size_t)l * 1024 + kq * 256) * 6144 + c0 + col;
    const float* cq = cs + kq * 256;
    for (int k = 0; k < 256; ++k) { const float wv = w[(size_t)k * 6144]; s0 += cq[k] * wv; s1 += cq[1024 + k] * wv; s2 += cq[2048 + k] * wv; s3 += cq[3072 + k] * wv; s4 += cq[4096 + k] * wv; }
    float* red = cs + 5 * 1024;
    red[(kq * 5 + 0) * 64 + col] = s0; red[(kq * 5 + 1) * 64 + col] = s1; red[(kq * 5 + 2) * 64 + col] = s2; red[(kq * 5 + 3) * 64 + col] = s3; red[(kq * 5 + 4) * 64 + col] = s4;
    __syncthreads();
    for (int o = tid; o < 320; o += 256) { const int i = o >> 6, cc = o & 63;
        const float v = red[(0 * 5 + i) * 64 + cc] + red[(1 * 5 + i) * 64 + cc] + red[(2 * 5 + i) * 64 + cc] + red[(3 * 5 + i) * 64 + cc] + p.ada_b[l * 6144 + c0 + cc];
        p.mod[((size_t)l * 5 + i) * 6144 + c0 + cc] = v; }
    __syncthreads();
}
__device__ __forceinline__ int map_col(int kind, int n) {
    if (kind == 1) { const int blk = n >> 6, r = n & 63; return r < 32 ? blk * 32 + r : DFF + blk * 32 + (r - 32); }
    if (kind == 2) { if (n < 512) return (n >> 6) * 128 + (n & 63); const int vc = n - 512; return (vc >> 6) * 128 + 64 + (vc & 63); }
    return n;
}
__device__ __forceinline__ void conv_tile(const float* src, int ldsrc, bf16_t* dst, bf16_t* dst2, int Kdst, int n0, int k0, int kind, int Nvalid, const float* kscale, char* smem) {
    const int tid = opaque_tid(); float* tile = (float*)smem;
    { const int j = tid & 63, i0 = tid >> 6; const int n = n0 + j; const int sc = (n < Nvalid) ? map_col(kind, n) : -1;
#pragma unroll 4
      for (int ii = 0; ii < 16; ++ii) { const int i = i0 + 4 * ii; tile[i * 65 + j] = (sc >= 0) ? src[(size_t)(k0 + i) * ldsrc + sc] : 0.f; } }
    __syncthreads();
    { const int i = tid & 63, j0 = tid >> 6; const float ks = kscale ? kscale[k0 + i] : 1.f;
#pragma unroll 4
      for (int jj = 0; jj < 16; ++jj) { const int jx = j0 + 4 * jj; const float v = tile[i * 65 + jx];
          dst[(size_t)(n0 + jx) * Kdst + k0 + i] = f2bf(v * ks); if (dst2) dst2[(size_t)(n0 + jx) * Kdst + k0 + i] = f2bf(v); } }
    __syncthreads();
}
#define NCONV 3032
__device__ __forceinline__ void conv_unit(const P& p, int l, int u, char* smem) {
    const float* src; int ldsrc; bf16_t* dst; bf16_t* dst2 = nullptr; int Kdst, n0, k0, kind = 0, Nvalid; const float* kscale = nullptr;
    if (u < 544) { src = p.w_in + (size_t)l * 1024 * NIN; ldsrc = NIN; dst = p.WtIn; Kdst = 1024; n0 = (u / 16) * 64; k0 = (u % 16) * 64; Nvalid = NIN; }
    else if (u < 592) { u -= 544; src = p.q_up + (size_t)l * 256 * 768; ldsrc = 768; dst = p.WtQ; Kdst = 256; n0 = (u / 4) * 64; k0 = (u % 4) * 64; Nvalid = 768; kscale = p.q_norm + l * 256; }
    else if (u < 624) { u -= 592; src = p.kv_up + (size_t)l * 128 * 1024; ldsrc = 1024; dst = p.WtKVn; dst2 = p.WtKV; Kdst = 128; n0 = (u / 2) * 64; k0 = (u % 2) * 64; kind = 2; Nvalid = 1024; kscale = p.kv_norm + l * 128; }
    else if (u < 880) { u -= 624; src = p.w_out + (size_t)l * 1024 * 1024; ldsrc = 1024; dst = p.WtOut; Kdst = 1024; n0 = (u / 16) * 64; k0 = (u % 16) * 64; Nvalid = 1024; }
    else if (u < 2288) { u -= 880; src = p.ffn_in + (size_t)l * 1024 * 5632; ldsrc = 5632; dst = p.WtF1; Kdst = 1024; n0 = (u / 16) * 64; k0 = (u % 16) * 64; kind = 1; Nvalid = 5632; }
    else if (u < 2992) { u -= 2288; src = p.ffn_out + (size_t)l * DFF * 1024; ldsrc = 1024; dst = p.WtF2; Kdst = DFF; n0 = (u / 44) * 64; k0 = (u % 44) * 64; Nvalid = 1024; }
    else if (u < 3008) { u -= 2992; const float* sp = p.gm_ws + (size_t)l * 65536 + u * 4096; bf16_t* d = p.WsB + u * 4096; for (int i = threadIdx.x; i < 4096; i += 256) d[i] = f2bf(sp[i]); return; }
    else if (u < 3016) { u -= 3008; const int d = u >> 2; src = p.rw_w2 + ((size_t)l * 2 + d) * 64 * 256; ldsrc = 256; dst = p.W2t + d * 256 * 64; Kdst = 64; n0 = (u & 3) * 64; k0 = 0; Nvalid = 256; }
    else if (u < 3024) { u -= 3016; const int d = u >> 2; src = p.rw_a2 + ((size_t)l * 2 + d) * 64 * 256; ldsrc = 256; dst = p.A2t + d * 256 * 64; Kdst = 64; n0 = (u & 3) * 64; k0 = 0; Nvalid = 256; }
    else { u -= 3024; src = p.rw_g2 + (size_t)l * 128 * 256; ldsrc = 256; dst = p.G2t; Kdst = 128; n0 = (u / 2) * 64; k0 = (u % 2) * 64; Nvalid = 256; }
    conv_tile(src, ldsrc, dst, dst2, Kdst, n0, k0, kind, Nvalid, kscale, smem);
}
__device__ __forceinline__ void misc0_unit(const P& p, int u) {
    const int tid = opaque_tid();
    if (u < 16) {
        for (int e = tid; e < 4096; e += 256) { const int idx = u * 4096 + e; const int t = idx >> 4, i = idx & 15;
            const float pos = (float)((i < 8) ? (t >> 6) : (t & 63)); const float inv = exp2f(-(float)(i & 7) * 1.6609640474436813f);
            const float ang = pos * inv; const float kf = rintf(ang * 0.15915494309189535f);
            float r = fmaf(-kf, 6.28318548202514648f, ang); r = fmaf(-kf, -1.74845553e-7f, r);
            p.ropeC[idx] = __cosf(r); p.ropeS[idx] = __sinf(r); }
    } else {
        const int v = u - 16;
        for (int e = tid; e < 4096; e += 256) { const int idx = v * 4096 + e;
            const int c = idx & 127, t = (idx >> 7) & 511, b = (idx >> 16) & 3, l = idx >> 18;
            p.CkvB[idx] = f2bf(p.cache_ckv[(((size_t)b * 4 + l) * 512 + t) * 128 + c]); }
    }
}

__device__ __forceinline__ void ln_phase(const P& p, int l, int which) {
    const int tid = opaque_tid(), lane = tid & 63, wid = tid >> 6;
    const float* g = which == 1 ? p.ln1_g + l * DM : p.ln2_g + l * DM; const float* bb = which == 1 ? p.ln1_b + l * DM : p.ln2_b + l * DM;
    const int ml = which == 2 ? l + 1 : l; const int shoff = which == 1 ? 3072 : 0, scoff = which == 1 ? 4096 : 1024;
    const bool dohb = !(which == 2 && l == 3);
    for (int row = blockIdx.x * 4 + wid; row < M_ALL; row += gridDim.x * 4) {
        float* xr = p.out + (size_t)row * DM;
        const float* src = which == 0 ? (row < M_CTX ? p.x_prompt + (size_t)row * DM : p.x_sample + (size_t)(row - M_CTX) * DM) : xr;
        f32x4 v[4];
#pragma unroll
        for (int i = 0; i < 4; ++i) v[i] = *(const f32x4*)(src + lane * 4 + 256 * i);
        if (which != 0) {
            float s = 0.f;
#pragma unroll
            for (int i = 0; i < 4; ++i) s += (v[i][0] + v[i][1]) + (v[i][2] + v[i][3]);
            s = red16(s); s += __shfl_xor(s, 16); s += __shfl_xor(s, 32);
            const float mu = s * (1.0f / 1024.0f); float q = 0.f;
#pragma unroll
            for (int i = 0; i < 4; ++i) { const f32x4 d = v[i] - mu; q += (d[0] * d[0] + d[1] * d[1]) + (d[2] * d[2] + d[3] * d[3]); }
            q = red16(q); q += __shfl_xor(q, 16); q += __shfl_xor(q, 32);
            const float rstd = rsqrtf(q * (1.0f / 1024.0f) + 1e-5f);
#pragma unroll
            for (int i = 0; i < 4; ++i) { const f32x4 gg = *(const f32x4*)(g + lane * 4 + 256 * i), bv = *(const f32x4*)(bb + lane * 4 + 256 * i); v[i] = (v[i] - mu) * rstd * gg + bv; }
        }
#pragma unroll
        for (int i = 0; i < 4; ++i) *(f32x4*)(xr + lane * 4 + 256 * i) = v[i];
        if (dohb) {
            const float* md = p.mod + ((size_t)ml * 5 + modrow_of(row)) * 6144;
#pragma unroll
            for (int i = 0; i < 4; ++i) { const f32x4 sh = *(const f32x4*)(md + shoff + lane * 4 + 256 * i), sc = *(const f32x4*)(md + scoff + lane * 4 + 256 * i);
                const f32x4 h = v[i] * (1.0f + sc) + sh; u32x2 w; w.x = pack2(h[0], h[1]); w.y = pack2(h[2], h[3]);
                *(u32x2*)(p.hbmix + (size_t)row * DM + lane * 4 + 256 * i) = w; }
        }
    }
}

__device__ __forceinline__ void rwprep_unit(const P& p, int l, int u, char* smem) {
    const int tid = opaque_tid(), lane = tid & 63, wid = tid >> 6, fr = lane & 15, fq = lane >> 4;
    const int R0 = u * 64;
    const int ss = R0 < M_CTX ? (R0 & ~255) : M_CTX + ((R0 - M_CTX) & ~4095); const int se = ss + (R0 < M_CTX ? 256 : 4096);
    bf16_t* XW = (bf16_t*)smem; bf16_t* XA = XW + 64 * 136; bf16_t* XG = XA + 64 * 136;
    const float* cw = p.rw_conv + (size_t)l * 3 * 1152;
    for (int it = tid; it < 576; it += 256) {
        const int cc = it % 144, tg = it / 144; const int c = cc * 8;
        float w0[8], w1[8], w2[8];
#pragma unroll
        for (int i = 0; i < 8; ++i) { w0[i] = cw[c + i]; w1[i] = cw[1152 + c + i]; w2[i] = cw[2304 + c + i]; }
        const int rfirst = R0 + tg * 16;
        u32x4 prev = (u32x4){0u, 0u, 0u, 0u}, cur, nxt;
        if (rfirst - 1 >= ss) prev = *(const u32x4*)(p.Z + (size_t)(rfirst - 1) * NIN + c);
        cur = *(const u32x4*)(p.Z + (size_t)rfirst * NIN + c);
        for (int tt = 0; tt < 16; ++tt) {
            const int row = rfirst + tt;
            nxt = (u32x4){0u, 0u, 0u, 0u};
            if (row + 1 < se) nxt = *(const u32x4*)(p.Z + (size_t)(row + 1) * NIN + c);
            float o[8];
#pragma unroll
            for (int i = 0; i < 4; ++i) {
                o[2 * i] = w0[2 * i] * lo_bf(prev[i]) + w1[2 * i] * lo_bf(cur[i]) + w2[2 * i] * lo_bf(nxt[i]);
                o[2 * i + 1] = w0[2 * i + 1] * hi_bf(prev[i]) + w1[2 * i + 1] * hi_bf(cur[i]) + w2[2 * i + 1] * hi_bf(nxt[i]);
            }
            if (c >= 768 && c < 896) {
#pragma unroll
                for (int i = 0; i < 8; ++i) o[i] = tanhf_(o[i]);
            } else if (c >= 1024) {
#pragma unroll
                for (int i = 0; i < 8; ++i) o[i] = sigmoidf_(o[i]);
            }
            u32x4 w; w.x = pack2(o[0], o[1]); w.y = pack2(o[2], o[3]); w.z = pack2(o[4], o[5]); w.w = pack2(o[6], o[7]);
            const int tl = tg * 16 + tt;
            if (c < 768) *(u32x4*)(p.RKV + (size_t)row * 768 + c) = w;
            else if (c < 896) *(u32x4*)(XW + tl * 136 + (c - 768)) = w;
            else if (c < 1024) *(u32x4*)(XA + tl * 136 + (c - 896)) = w;
            else *(u32x4*)(XG + tl * 136 + (c - 1024)) = w;
            prev = cur; cur = nxt;
        }
    }
    __syncthreads();
#pragma unroll 1
    for (int mh = 0; mh < 10; ++mh) {
        const int mat = mh >> 1, nh = mh & 1;
        const int d = mat & 1; const bf16_t* As; const bf16_t* Bw; int kofs, nks, ldw;
        if (mat < 2) { As = XW; Bw = p.W2t + d * 256 * 64; kofs = d * 64; nks = 2; ldw = 64; }
        else if (mat < 4) { As = XA; Bw = p.A2t + d * 256 * 64; kofs = d * 64; nks = 2; ldw = 64; }
        else { As = XG; Bw = p.G2t; kofs = 0; nks = 4; ldw = 128; }
        f32x4 acc[4][2];
#pragma unroll
        for (int m = 0; m < 4; ++m)
#pragma unroll
            for (int n = 0; n < 2; ++n) acc[m][n] = (f32x4){0.f, 0.f, 0.f, 0.f};
#pragma unroll 1
        for (int ks = 0; ks < nks; ++ks) {
            bf16x8 af[4], bfr[2];
#pragma unroll
            for (int m = 0; m < 4; ++m) af[m] = *(const bf16x8*)(As + (m * 16 + fr) * 136 + kofs + ks * 32 + fq * 8);
#pragma unroll
            for (int n = 0; n < 2; ++n) bfr[n] = *(const bf16x8*)(Bw + (size_t)(wid * 64 + nh * 32 + n * 16 + fr) * ldw + ks * 32 + fq * 8);
#pragma unroll
            for (int m = 0; m < 4; ++m)
#pragma unroll
                for (int n = 0; n < 2; ++n) acc[m][n] = __builtin_amdgcn_mfma_f32_16x16x32_bf16(af[m], bfr[n], acc[m][n], 0, 0, 0);
        }
#pragma unroll
        for (int n = 0; n < 2; ++n) {
            const int c = wid * 64 + nh * 32 + n * 16 + fr;
            float bias = 0.f; if (mat < 2) bias = p.rw_w0[(l * 2 + d) * 256 + c]; else if (mat < 4) bias = p.rw_a0[(l * 2 + d) * 256 + c];
            bf16_t* dst; float mul;
            if (mat < 2) { dst = p.Ee + ((size_t)d * M_ALL + R0) * 256 + c; mul = 0.6065306597126334f; }
            else if (mat < 4) { dst = p.Aa + ((size_t)d * M_ALL + R0) * 256 + c; mul = 1.0f; }
            else { dst = p.Gg + (size_t)R0 * 256 + c; mul = 1.0f; }
#pragma unroll
            for (int m = 0; m < 4; ++m)
#pragma unroll
                for (int j = 0; j < 4; ++j) {
                    const float x = acc[m][n][j] + bias;
                    dst[(size_t)(m * 16 + fq * 4 + j) * 256] = f2bf(mat < 4 ? mul * sigmoidf_(x) : x);
                }
        }
    }
    __syncthreads();
}
__device__ __forceinline__ void rowscale128(const bf16_t* Z, int R0, int zoff, int ncols, float eps, float* rs) {
    const int tid = opaque_tid(); const int r = tid >> 1, half = tid & 1; const int per = ncols >> 1;
    const bf16_t* zp = Z + (size_t)(R0 + r) * NIN + zoff + half * per;
    float ss = 0.f;
    for (int i = 0; i < per; i += 8) { const u32x4 w = *(const u32x4*)(zp + i);
#pragma unroll
        for (int q = 0; q < 4; ++q) { const float a = lo_bf(w[q]), b = hi_bf(w[q]); ss += a * a + b * b; } }
    ss = dpp_add<0xB1>(ss);
    if (half == 0) rs[r] = rsqrtf(ss / (float)ncols + eps);
}
__device__ __forceinline__ void small_unit(const P& p, int l, int u) {
    const int tid = opaque_tid(), sub = tid >> 5, li = tid & 31;
    if (u < 2560) {
        const int row = u * 8 + sub; const bf16_t* zr = p.Z + (size_t)row * NIN;
        const u32x2 w = *(const u32x2*)(zr + ZKV + li * 4);
        const float z0 = lo_bf(w.x), z1 = hi_bf(w.x), z2 = lo_bf(w.y), z3 = hi_bf(w.y);
        float ss = z0 * z0 + z1 * z1 + z2 * z2 + z3 * z3; ss = red16(ss); ss += __shfl_xor(ss, 16);
        const float rsv = rsqrtf(ss * (1.0f / 128.0f) + 1e-6f);
        const float x1 = bf2f(zr[ZKR + (li & 15)]), x2 = bf2f(zr[ZKR + 16 + (li & 15)]);
        float val;
        if (row < M_CTX) {
            const int b = row >> 8, t = row & 255; const size_t o = ((size_t)(b * 4 + l) * 256 + t);
            const f32x4 g = *(const f32x4*)(p.kv_norm + l * 128 + li * 4);
            *(f32x4*)(p.out + 20971520 + o * 128 + li * 4) = (f32x4){z0 * rsv * g[0], z1 * rsv * g[1], z2 * rsv * g[2], z3 * rsv * g[3]};
            val = li < 16 ? x1 : x2;
            p.out[20971520 + 2097152 + o * 32 + li] = val;
        } else {
            const int t = (row - M_CTX) & 4095; const float cv = p.ropeC[t * 16 + (li & 15)], sv = p.ropeS[t * 16 + (li & 15)];
            val = li < 16 ? x1 * cv - x2 * sv : x1 * sv + x2 * cv;
        }
        const bf16_t bv = f2bf(val);
#pragma unroll
        for (int h = 0; h < 8; ++h) p.Kb[(size_t)row * 768 + h * 96 + 64 + li] = bv;
    } else {
        const int r = (u - 2560) * 8 + sub; const int b = r >> 9, t = r & 511;
        const bf16_t bv = f2bf(p.cache_krope[((size_t)(b * 4 + l) * 512 + t) * 32 + li]);
#pragma unroll
        for (int h = 0; h < 8; ++h) p.Kc[(size_t)r * 768 + h * 96 + 64 + li] = bv;
    }
}
__device__ __forceinline__ void gmlp_unit(const P& p, int l, int u, char* smem) {
    const int tid = opaque_tid(), lane = tid & 63, wid = tid >> 6, fr = lane & 15, fq = lane >> 4;
    const int R0 = (u >> 2) * 128, g = u & 3;
    bf16_t* VnT = (bf16_t*)smem;
    {
        const int tok = tid >> 1, half = tid & 1; const bf16_t* zp = p.Z + (size_t)(R0 + tok) * NIN + ZV + g * 64 + half * 32;
        float x[32];
#pragma unroll
        for (int i = 0; i < 4; ++i) { const u32x4 w = *(const u32x4*)(zp + i * 8);
#pragma unroll
            for (int q = 0; q < 4; ++q) { x[i * 8 + 2 * q] = geluf_(lo_bf(w[q])); x[i * 8 + 2 * q + 1] = geluf_(hi_bf(w[q])); } }
        float s = 0.f;
#pragma unroll
        for (int i = 0; i < 32; ++i) s += x[i];
        s = dpp_add<0xB1>(s); const float mu = s * (1.0f / 64.0f);
        float q2 = 0.f;
#pragma unroll
        for (int i = 0; i < 32; ++i) { const float d = x[i] - mu; q2 += d * d; }
        q2 = dpp_add<0xB1>(q2); const float rstd = rsqrtf(q2 * (1.0f / 64.0f) + 1e-5f);
        const float* gg = p.gm_g + l * 256 + g * 64 + half * 32; const float* gb = p.gm_b + l * 256 + g * 64 + half * 32;
#pragma unroll
        for (int i = 0; i < 32; ++i) VnT[(half * 32 + i) * 136 + tok] = f2bf((x[i] - mu) * rstd * gg[i] + gb[i]);
    }
    __syncthreads();
    f32x4 acc[2][4];
#pragma unroll
    for (int m = 0; m < 2; ++m)
#pragma unroll
        for (int n = 0; n < 4; ++n) acc[m][n] = (f32x4){0.f, 0.f, 0.f, 0.f};
    const bf16_t* Wg = p.WsB + g * 128 * 128;
#pragma unroll
    for (int ks = 0; ks < 4; ++ks) {
        bf16x8 af[2], bfr[4];
#pragma unroll
        for (int m = 0; m < 2; ++m) af[m] = *(const bf16x8*)(Wg + (wid * 32 + m * 16 + fr) * 128 + ks * 32 + fq * 8);
#pragma unroll
        for (int n = 0; n < 4; ++n) bfr[n] = *(const bf16x8*)(VnT + (n * 16 + fr) * 136 + ks * 32 + fq * 8);
#pragma unroll
        for (int m = 0; m < 2; ++m)
#pragma unroll
            for (int n = 0; n < 4; ++n) acc[m][n] = __builtin_amdgcn_mfma_f32_16x16x32_bf16(af[m], bfr[n], acc[m][n], 0, 0, 0);
    }
#pragma unroll
    for (int m = 0; m < 2; ++m)
#pragma unroll
        for (int j = 0; j < 4; ++j) {
            const int pp = wid * 32 + m * 16 + fq * 4 + j; const float bs = p.gm_bs[l * 512 + g * 128 + pp];
#pragma unroll
            for (int n = 0; n < 4; ++n) { const int c = n * 16 + fr;
                const float uu = geluf_(bf2f(p.Z[(size_t)(R0 + pp) * NIN + ZU + g * 64 + c]));
                p.hbmix[(size_t)(R0 + pp) * DM + 768 + g * 64 + c] = f2bf(uu * (acc[m][n][j] + bs)); }
        }
    __syncthreads();
}

__device__ __forceinline__ float swap16_add(float x) {
    auto r = __builtin_amdgcn_permlane16_swap(__float_as_uint(x), __float_as_uint(x), false, false);
    return __uint_as_float(r[0]) + __uint_as_float(r[1]);
}
#define NSCAN_LAT 256
#define NSCAN (256 + 1024)
__device__ __forceinline__ void scan_unit(const P& p, int l, int u, char* smem) {
    const int tid = opaque_tid(), lane = tid & 63, wid = tid >> 6;
    int b, T, row0; const bool lat = u < NSCAN_LAT;
    if (lat) { b = u >> 6; T = 4096; row0 = M_CTX + b * 4096; } else { b = (u - NSCAN_LAT) >> 6; T = 256; row0 = b * 256; }
    const int h = (u >> 4) & 3, d = (u >> 3) & 1, rsl = u & 7;
    float* W = (float*)smem; float* NKK = W + 2048; float* KKA = NKK + 2048; float* KD = KKA + 2048; float* RR = KD + 2048; float* VS = RR + 2048; float* OUTP = VS + 256;
    const int rl = lane >> 5, kq = lane & 31; const int r8 = wid * 2 + rl; const int row = rsl * 8 + r8;
    f32x2 S = (f32x2){0.f, 0.f};
    const size_t stoff = ((((size_t)b * 4 + l) * 2 + d) * 4 + h) * 4096 + row * 64 + kq * 2;
    if (lat) S = *(const f32x2*)(p.state_rwkv + stoff);
    const int tok = tid >> 3, cg8 = tid & 7;
    float kkp[8], kap[8];
#pragma unroll
    for (int i = 0; i < 8; ++i) { kkp[i] = p.rw_kk[l * 256 + h * 64 + cg8 * 8 + i]; kap[i] = p.rw_ka[l * 256 + h * 64 + cg8 * 8 + i]; }
    const int nch = T >> 5;
    u32x4 r8v, k8, e8, a8, v8;
    int grow, grow_prev = 0; float oreg = 0.f;
    {
        const int sidx = tok; const int t = d ? T - 1 - sidx : sidx; grow = row0 + t;
        r8v = *(const u32x4*)(p.RKV + (size_t)grow * 768 + h * 64 + cg8 * 8);
        k8 = *(const u32x4*)(p.RKV + (size_t)grow * 768 + 256 + h * 64 + cg8 * 8);
        v8 = *(const u32x4*)(p.RKV + (size_t)grow * 768 + 512 + h * 64 + rsl * 8);
        e8 = *(const u32x4*)(p.Ee + ((size_t)d * M_ALL + grow) * 256 + h * 64 + cg8 * 8);
        a8 = *(const u32x4*)(p.Aa + ((size_t)d * M_ALL + grow) * 256 + h * 64 + cg8 * 8);
    }
    for (int ch = 0; ch < nch; ++ch) {
        {
            float kf[8], kkv[8], rf[8], ef[8], af[8];
#pragma unroll
            for (int q = 0; q < 4; ++q) { kf[2 * q] = lo_bf(k8[q]); kf[2 * q + 1] = hi_bf(k8[q]); rf[2 * q] = lo_bf(r8v[q]); rf[2 * q + 1] = hi_bf(r8v[q]);
                ef[2 * q] = lo_bf(e8[q]); ef[2 * q + 1] = hi_bf(e8[q]); af[2 * q] = lo_bf(a8[q]); af[2 * q + 1] = hi_bf(a8[q]); }
            float ss = 0.f;
#pragma unroll
            for (int i = 0; i < 8; ++i) { kkv[i] = kf[i] * kkp[i]; ss += kkv[i] * kkv[i]; }
            ss = red8(ss);
            const float inv = rsqrtf(fmaxf(ss, 1e-24f));
            f32x4 o0, o1; const int base = tok * 64 + cg8 * 8;
#pragma unroll
            for (int i = 0; i < 4; ++i) { o0[i] = __expf(-ef[i]); o1[i] = __expf(-ef[4 + i]); }
            *(f32x4*)(W + base) = o0; *(f32x4*)(W + base + 4) = o1;
#pragma unroll
            for (int i = 0; i < 4; ++i) { o0[i] = -kkv[i] * inv; o1[i] = -kkv[4 + i] * inv; }
            *(f32x4*)(NKK + base) = o0; *(f32x4*)(NKK + base + 4) = o1;
#pragma unroll
            for (int i = 0; i < 4; ++i) { o0[i] = kkv[i] * inv * af[i]; o1[i] = kkv[4 + i] * inv * af[4 + i]; }
            *(f32x4*)(KKA + base) = o0; *(f32x4*)(KKA + base + 4) = o1;
#pragma unroll
            for (int i = 0; i < 4; ++i) { o0[i] = kf[i] * (1.0f + (af[i] - 1.0f) * kap[i]); o1[i] = kf[4 + i] * (1.0f + (af[4 + i] - 1.0f) * kap[4 + i]); }
            *(f32x4*)(KD + base) = o0; *(f32x4*)(KD + base + 4) = o1;
#pragma unroll
            for (int i = 0; i < 4; ++i) { o0[i] = rf[i]; o1[i] = rf[4 + i]; }
            *(f32x4*)(RR + base) = o0; *(f32x4*)(RR + base + 4) = o1;
            if (cg8 == 0) {
#pragma unroll
                for (int q = 0; q < 4; ++q) { VS[tok * 8 + 2 * q] = lo_bf(v8[q]); VS[tok * 8 + 2 * q + 1] = hi_bf(v8[q]); }
            }
        }
        __syncthreads();
        if (ch > 0) p.ydir[((size_t)d * M_ALL + grow_prev) * 256 + h * 64 + rsl * 8 + cg8] = oreg;
        grow_prev = grow;
        if (ch + 1 < nch) {
            const int sidx = (ch + 1) * 32 + tok; const int t = d ? T - 1 - sidx : sidx; grow = row0 + t;
            r8v = *(const u32x4*)(p.RKV + (size_t)grow * 768 + h * 64 + cg8 * 8);
            k8 = *(const u32x4*)(p.RKV + (size_t)grow * 768 + 256 + h * 64 + cg8 * 8);
            v8 = *(const u32x4*)(p.RKV + (size_t)grow * 768 + 512 + h * 64 + rsl * 8);
            e8 = *(const u32x4*)(p.Ee + ((size_t)d * M_ALL + grow) * 256 + h * 64 + cg8 * 8);
            a8 = *(const u32x4*)(p.Aa + ((size_t)d * M_ALL + grow) * 256 + h * 64 + cg8 * 8);
        }
        {
            const float* Wq = W + kq * 2; const float* NKq = NKK + kq * 2; const float* KAq = KKA + kq * 2; const float* KDq = KD + kq * 2; const float* RRq = RR + kq * 2; const float* VSq = VS + r8;
            float* OPq = OUTP + r8 * 32 + kq;
            f32x2 wv[4], nkv[4], kav[4], kdv[4], rrv[4]; float vv[4];
#define SCAN_LD(slot, st) do { wv[slot] = *(const f32x2*)(Wq + (st) * 64); nkv[slot] = *(const f32x2*)(NKq + (st) * 64); kav[slot] = *(const f32x2*)(KAq + (st) * 64); \
        kdv[slot] = *(const f32x2*)(KDq + (st) * 64); rrv[slot] = *(const f32x2*)(RRq + (st) * 64); vv[slot] = VSq[(st) * 8]; } while (0)
            __builtin_amdgcn_s_setprio(3);
            SCAN_LD(0, 0); SCAN_LD(1, 1); SCAN_LD(2, 2);
#pragma unroll
            for (int s = 0; s < 32; ++s) {
                if (s + 3 < 32) SCAN_LD((s + 3) & 3, s + 3);
                const f32x2 w = wv[s & 3], nk = nkv[s & 3], ka = kav[s & 3], kd = kdv[s & 3], rr = rrv[s & 3]; const float v = vv[s & 3];
                float pd = fmaf(S[1], nk[1], S[0] * nk[0]);
                pd = red16(pd); pd = swap16_add(pd);
                S[0] = fmaf(S[0], w[0], fmaf(pd, ka[0], v * kd[0]));
                S[1] = fmaf(S[1], w[1], fmaf(pd, ka[1], v * kd[1]));
                OPq[s * 256] = fmaf(S[1], rr[1], S[0] * rr[0]);
            }
            __builtin_amdgcn_s_setprio(0);
        }
        __syncthreads();
        {
            const float* op = OUTP + (tok * 8 + cg8) * 32;
            f32x4 a0 = *(const f32x4*)(op), a1 = *(const f32x4*)(op + 4), a2 = *(const f32x4*)(op + 8), a3 = *(const f32x4*)(op + 12);
            f32x4 b0 = *(const f32x4*)(op + 16), b1 = *(const f32x4*)(op + 20), b2 = *(const f32x4*)(op + 24), b3 = *(const f32x4*)(op + 28);
            a0 = ((a0 + a1) + (a2 + a3)) + ((b0 + b1) + (b2 + b3));
            oreg = (a0[0] + a0[1]) + (a0[2] + a0[3]);
        }
    }
    p.ydir[((size_t)d * M_ALL + grow_prev) * 256 + h * 64 + rsl * 8 + cg8] = oreg;
    if (!lat) *(f32x2*)(p.out + 20971520 + 2097152 + 524288 + stoff) = S;
    __syncthreads();
}

#define KS_STRIDE 104
#define VS_STRIDE 68
#define KS_BYTES (64 * KS_STRIDE * 2)
#define ATT_STAGE (KS_BYTES + 64 * VS_STRIDE * 2)
__device__ __forceinline__ void attn_unit(const P& p, int u, char* smem) {
    const int tid = opaque_tid(), lane = tid & 63, wid = tid >> 6, q = lane & 31, hf = lane >> 5;
    int b, h, qt, qrow0, krow0, nown, ntot, Tv; size_t vbase, vcbase = 0; int kcrow0 = 0;
    if (u < 1024) { b = u >> 8; h = (u >> 5) & 7; qt = u & 31; krow0 = M_CTX + b * 4096; qrow0 = krow0 + qt * 128; nown = 64; ntot = 72; Tv = 4096;
        vbase = 2097152 + (size_t)(b * 8 + h) * 64 * 4096; kcrow0 = b * 512; vcbase = (size_t)(b * 8 + h) * 64 * 512; }
    else { const int v = u - 1024; b = v >> 4; h = (v >> 1) & 7; qt = v & 1; krow0 = b * 256; qrow0 = krow0 + qt * 128; nown = 4; ntot = 4; Tv = 256; vbase = (size_t)(b * 8 + h) * 64 * 256; }
    bf16x8 qf[6];
    { const bf16_t* qp = p.Qb + (size_t)(qrow0 + wid * 32 + q) * 768 + h * 96 + hf * 8;
#pragma unroll
      for (int ks = 0; ks < 6; ++ks) qf[ks] = *(const bf16x8*)(qp + ks * 16); }
    f32x16 oT[2];
#pragma unroll
    for (int i = 0; i < 16; ++i) { oT[0][i] = 0.f; oT[1][i] = 0.f; }
    float mrun = -1e30f, lrun = 0.f;
    u32x4 rk[3], rv[2];
    int krow[3], kc[3];
#pragma unroll
    for (int i = 0; i < 3; ++i) { const int c = tid + 256 * i; krow[i] = c / 12; kc[i] = c % 12; }
    const int vdv0 = tid >> 3, vkc = tid & 7;
#define ATT_LOAD(kt) do { const bf16_t* kptr; const bf16_t* vptr; int vstr; \
        if ((kt) < nown) { kptr = p.Kb + (size_t)(krow0 + (kt) * 64) * 768 + h * 96; vptr = p.Vt + vbase + (kt) * 64; vstr = Tv; } \
        else { kptr = p.Kc + (size_t)(kcrow0 + ((kt) - nown) * 64) * 768 + h * 96; vptr = p.Vtc + vcbase + ((kt) - nown) * 64; vstr = 512; } \
        _Pragma("unroll") for (int i = 0; i < 3; ++i) rk[i] = *(const u32x4*)(kptr + (size_t)krow[i] * 768 + kc[i] * 8); \
        _Pragma("unroll") for (int i = 0; i < 2; ++i) rv[i] = *(const u32x4*)(vptr + (size_t)(vdv0 + 32 * i) * vstr + vkc * 8); } while (0)
#define ATT_STORE(buf) do { char* Ks_ = smem + (buf) * ATT_STAGE; char* Vs_ = Ks_ + KS_BYTES; \
        _Pragma("unroll") for (int i = 0; i < 3; ++i) *(u32x4*)(Ks_ + (krow[i] * KS_STRIDE + kc[i] * 8) * 2) = rk[i]; \
        _Pragma("unroll") for (int i = 0; i < 2; ++i) { char* vd_ = Vs_ + ((vdv0 + 32 * i) * VS_STRIDE + vkc * 8) * 2; *(u32x2*)vd_ = (u32x2){rv[i].x, rv[i].y}; *(u32x2*)(vd_ + 8) = (u32x2){rv[i].z, rv[i].w}; } } while (0)
    ATT_LOAD(0); ATT_STORE(0);
    __syncthreads();
    for (int kt = 0; kt < ntot; ++kt) {
        const bool more = kt + 1 < ntot;
        if (more) ATT_LOAD(kt + 1);
        const char* Ks = smem + (kt & 1) * ATT_STAGE; const char* Vs = Ks + KS_BYTES;
        f32x16 sT[2];
#pragma unroll
        for (int i = 0; i < 16; ++i) { sT[0][i] = 0.f; sT[1][i] = 0.f; }
#pragma unroll
        for (int kb = 0; kb < 2; ++kb)
#pragma unroll
            for (int ks = 0; ks < 6; ++ks) { const bf16x8 kf = *(const bf16x8*)(Ks + ((kb * 32 + q) * KS_STRIDE + ks * 16 + hf * 8) * 2);
                sT[kb] = __builtin_amdgcn_mfma_f32_32x32x16_bf16(kf, qf[ks], sT[kb], 0, 0, 0); }
        float mx = sT[0][0];
#pragma unroll
        for (int i = 1; i < 16; ++i) mx = fmaxf(mx, sT[0][i]);
#pragma unroll
        for (int i = 0; i < 16; ++i) mx = fmaxf(mx, sT[1][i]);
        mx = fmaxf(mx, __shfl_xor(mx, 32));
        const float mnew = fmaxf(mrun, mx); const float alpha = __builtin_amdgcn_exp2f(mrun - mnew); const bool resc = __any(mnew > mrun); mrun = mnew;
        float psum = 0.f; bf16x8 pf[2][2];
#pragma unroll
        for (int kb = 0; kb < 2; ++kb)
#pragma unroll
            for (int s = 0; s < 2; ++s) { float e[8];
#pragma unroll
                for (int j = 0; j < 8; ++j) { e[j] = __builtin_amdgcn_exp2f(sT[kb][8 * s + j] - mnew); psum += e[j]; }
                u32x4 w; w.x = pack2(e[0], e[1]); w.y = pack2(e[2], e[3]); w.z = pack2(e[4], e[5]); w.w = pack2(e[6], e[7]);
                pf[kb][s] = __builtin_bit_cast(bf16x8, w); }
        lrun = lrun * alpha + psum;
        if (resc) {
#pragma unroll
            for (int i = 0; i < 16; ++i) { oT[0][i] *= alpha; oT[1][i] *= alpha; }
        }
#pragma unroll
        for (int kb = 0; kb < 2; ++kb)
#pragma unroll
            for (int s = 0; s < 2; ++s)
#pragma unroll
                for (int db = 0; db < 2; ++db) {
                    const char* vp = Vs + ((db * 32 + q) * VS_STRIDE + kb * 32 + 16 * s + 4 * hf) * 2;
                    const u32x2 lo = *(const u32x2*)vp, hi = *(const u32x2*)(vp + 16);
                    const u32x4 w = (u32x4){lo.x, lo.y, hi.x, hi.y};
                    oT[db] = __builtin_amdgcn_mfma_f32_32x32x16_bf16(__builtin_bit_cast(bf16x8, w), pf[kb][s], oT[db], 0, 0, 0);
                }
        if (more) ATT_STORE((kt + 1) & 1);
        __syncthreads();
    }
    const float lt = lrun + __shfl_xor(lrun, 32); const float inv = 1.0f / lt;
    bf16_t* op = p.hbmix + (size_t)(qrow0 + wid * 32 + q) * DM + 256 + h * 64;
#pragma unroll
    for (int db = 0; db < 2; ++db)
#pragma unroll
        for (int g = 0; g < 4; ++g) { u32x2 w; w.x = pack2(oT[db][4 * g] * inv, oT[db][4 * g + 1] * inv); w.y = pack2(oT[db][4 * g + 2] * inv, oT[db][4 * g + 3] * inv);
            *(u32x2*)(op + db * 32 + 8 * g + 4 * hf) = w; }
}

__device__ __forceinline__ void rwcomb_phase(const P& p, int l) {
    const int tid = opaque_tid(), lane = tid & 63, wid = tid >> 6; const int c = lane * 4;
    const f32x4 gng = *(const f32x4*)(p.rw_gn_g + l * 256 + c), gnb = *(const f32x4*)(p.rw_gn_b + l * 256 + c), kap = *(const f32x4*)(p.rw_ka + l * 256 + c), rkp = *(const f32x4*)(p.rw_rk + l * 256 + c);
    for (int row = blockIdx.x * 4 + wid; row < M_ALL; row += gridDim.x * 4) {
        const f32x4 y0 = *(const f32x4*)(p.ydir + (size_t)row * 256 + c), y1 = *(const f32x4*)(p.ydir + ((size_t)M_ALL + row) * 256 + c);
        f32x4 y = y0 + y1;
        float s = (y[0] + y[1]) + (y[2] + y[3]); s = red16(s); const float mu = s * (1.0f / 64.0f);
        const f32x4 dd = y - mu; float q2 = (dd[0] * dd[0] + dd[1] * dd[1]) + (dd[2] * dd[2] + dd[3] * dd[3]); q2 = red16(q2);
        const float rstd = rsqrtf(q2 * (1.0f / 64.0f) + 64e-5f);
        const f32x4 yn = dd * rstd * gng + gnb;
        const u32x2 rw = *(const u32x2*)(p.RKV + (size_t)row * 768 + c), kw = *(const u32x2*)(p.RKV + (size_t)row * 768 + 256 + c), vw = *(const u32x2*)(p.RKV + (size_t)row * 768 + 512 + c);
        const u32x2 a0w = *(const u32x2*)(p.Aa + (size_t)row * 256 + c), a1w = *(const u32x2*)(p.Aa + ((size_t)M_ALL + row) * 256 + c), gw = *(const u32x2*)(p.Gg + (size_t)row * 256 + c);
        const f32x4 r = (f32x4){lo_bf(rw.x), hi_bf(rw.x), lo_bf(rw.y), hi_bf(rw.y)}, k = (f32x4){lo_bf(kw.x), hi_bf(kw.x), lo_bf(kw.y), hi_bf(kw.y)}, v = (f32x4){lo_bf(vw.x), hi_bf(vw.x), lo_bf(vw.y), hi_bf(vw.y)};
        const f32x4 a0 = (f32x4){lo_bf(a0w.x), hi_bf(a0w.x), lo_bf(a0w.y), hi_bf(a0w.y)}, a1 = (f32x4){lo_bf(a1w.x), hi_bf(a1w.x), lo_bf(a1w.y), hi_bf(a1w.y)}, gt = (f32x4){lo_bf(gw.x), hi_bf(gw.x), lo_bf(gw.y), hi_bf(gw.y)};
        const f32x4 kds = k * (1.0f + (a0 - 1.0f) * kap) + k * (1.0f + (a1 - 1.0f) * kap);
        const f32x4 t4 = r * kds * rkp; float rk = (t4[0] + t4[1]) + (t4[2] + t4[3]); rk = red16(rk);
        const f32x4 o = (yn + rk * v) * gt;
        u32x2 w; w.x = pack2(o[0], o[1]); w.y = pack2(o[2], o[3]);
        *(u32x2*)(p.hbmix + (size_t)row * DM + c) = w;
    }
}


__device__ __forceinline__ bool xcd_tile(int i, int TT, int NT, int& mt, int& nt) {
    const int per = TT >> 3; if (i >= per) return false;
    const int t = (blockIdx.x & 7) * per + i; const int band = t / (8 * NT), rem = t - band * 8 * NT;
    nt = rem >> 3; mt = band * 8 + (rem & 7); return true;
}
__global__ void __launch_bounds__(256, 2) mega(Args a_unused) {
    extern __shared__ __attribute__((aligned(16))) char smem[];
    __shared__ uint4 xbw; __shared__ int s_unit;
    kargp_t kp = (kargp_t)__builtin_amdgcn_kernarg_segment_ptr();
    const int tid = threadIdx.x; const int G = gridDim.x;
    if (tid == 0) xbw = make_uint4(0u, 0u, 0u, 0u);
    __syncthreads();
    XcdBarrier xb;
    { const P p = getP(kp); xb = xcd_barrier_post(p.bar, (volatile LAS unsigned*)&xbw); }
    for (int u = blockIdx.x; u < 384 + NCONV + 272; u += G) {
        if (u < 384) { const P p = getP(kp); ada_unit(p, u, smem); } else if (u < 384 + NCONV) { const P p = getP(kp); conv_unit(p, 0, u - 384, smem); } else { const P p = getP(kp); misc0_unit(p, u - 384 - NCONV); }
    }
    cg::this_grid().sync();
    { const P p = getP(kp); ln_phase(p, 0, 0); }
    xcd_barrier(xb);
    float* rs = (float*)(smem + RS_OFF);
#pragma unroll 1
    for (int l = 0; l < 4; ++l) {
        for (int i = blockIdx.x >> 3; ; i += G >> 3) { int mt, nt; if (!xcd_tile(i, 80 * 17, 17, mt, nt)) break; const P p = getP(kp);
            EpiZ e{p.Z, mt * 256, nt * 128};
            gemm256(p.hbmix + (size_t)mt * 256 * DM, DM, p.WtIn + (size_t)nt * 128 * DM, DM, DM, smem, e); }
        xcd_barrier(xb);
        for (int rep2 = 0; rep2 < DUP_P2; ++rep2) {
        for (;;) {
            { const P pc = getP(kp); if (tid == 0) s_unit = atomicAdd(&pc.ctr[l * 4 + 0 + 2 * rep2], 1); }
            __syncthreads(); int u = s_unit; __syncthreads();
            if (u >= 320 + 480 + 640 + 64 + 352 + 640) break;
            if (u < 320) { const P p = getP(kp); rwprep_unit(p, l, u, smem); continue; }
            u -= 320;
            if (u < 480) { const P p = getP(kp); const int mt = u / 3, np = u % 3;
                rowscale128(p.Z, mt * 128, ZQ, 256, 1e-6f, rs);
                for (int k2 = 0; k2 < 2; ++k2) { const int nt = np * 2 + k2;
                    EpiQ e{p.Qb, rs, p.ropeC, p.ropeS, mt * 128, nt * 128};
                    gemm128<false>(p.Z + (size_t)mt * 128 * NIN + ZQ, NIN, p.WtQ + (size_t)nt * 128 * 256, 256, 256, smem, e); }
                __syncthreads(); continue; }
            u -= 480;
            if (u < 640) { const P p = getP(kp); const int mt = u >> 2, np = u & 3; const int R0 = mt * 128; const bool latr = R0 >= M_CTX;
                rowscale128(p.Z, R0, ZKV, 128, 1e-6f, rs);
                for (int k2 = 0; k2 < 2; ++k2) { const int nt = np * 2 + k2;
                    EpiKV e{latr ? p.Kb + (size_t)M_CTX * 768 : p.Kb, p.Vt, rs, latr ? R0 - M_CTX : R0, nt * 128, latr ? 12 : 8, latr ? (size_t)2097152 : (size_t)0};
                    gemm128<false>(p.Z + (size_t)R0 * NIN + ZKV, NIN, p.WtKVn + (size_t)nt * 128 * 128, 128, 128, smem, e); }
                __syncthreads(); continue; }
            u -= 640;
            if (u < 64) { const P p = getP(kp); const int mt = u >> 2, np = u & 3;
                for (int k2 = 0; k2 < 2; ++k2) { const int nt = np * 2 + k2;
                    EpiKV e{p.Kc, p.Vtc, nullptr, mt * 128, nt * 128, 9, (size_t)0};
                    gemm128<false>(p.CkvB + ((size_t)l * 2048 + mt * 128) * 128, 128, p.WtKV + (size_t)nt * 128 * 128, 128, 128, smem, e); }
                continue; }
            u -= 64;
            if (u < 352) { const P p = getP(kp); for (int i = 0; i < 8; ++i) small_unit(p, l, u * 8 + i); continue; }
            u -= 352;
            { const P p = getP(kp); gmlp_unit(p, l, u, smem); }
        }
        xcd_barrier(xb);
        }
        for (int rep3 = 0; rep3 < DUP_P3; ++rep3) {
        for (;;) {
            { const P pc = getP(kp); if (tid == 0) s_unit = atomicAdd(&pc.ctr[l * 4 + 1 + 2 * rep3], 1); }
            __syncthreads(); int u = s_unit; __syncthreads();
            if (u >= NSCAN + 1280) break;
#ifdef PROBE_SCAN_ONLY
            if (rep3 == 1 && u >= NSCAN) break;
#endif
#ifdef PROBE_ATTN_ONLY
            if (rep3 == 1 && u < NSCAN) continue;
#endif
            if (u < NSCAN) { const P p = getP(kp); scan_unit(p, l, u, smem); } else { const P p = getP(kp); attn_unit(p, u - NSCAN, smem); }
        }
        xcd_barrier(xb);
        }
        { const P p = getP(kp); rwcomb_phase(p, l); }
        xcd_barrier(xb);
        for (int i = blockIdx.x >> 3; ; i += G >> 3) { int mt, nt; if (!xcd_tile(i, 160 * 8, 8, mt, nt)) break; const P p = getP(kp);
            EpiRes e{p.out, p.mod + ((size_t)l * 5 + modrow_of(mt * 128)) * 6144 + 2048, mt * 128, nt * 128};
            gemm128<true>(p.hbmix + (size_t)mt * 128 * DM, DM, p.WtOut + (size_t)nt * 128 * DM, DM, DM, smem, e); }
        xcd_barrier(xb);
        { const P p = getP(kp); ln_phase(p, l, 1); }
        xcd_barrier(xb);
        for (int rep5 = 0; rep5 < DUP_P5; ++rep5)
        for (int i = blockIdx.x >> 3; ; i += G >> 3) { int mt, nt; if (!xcd_tile(i, 80 * 44, 44, mt, nt)) break; const P p = getP(kp);
            EpiSwi e{p.hidden, mt * 256, nt * 128};
            gemm256(p.hbmix + (size_t)mt * 256 * DM, DM, p.WtF1 + (size_t)nt * 128 * DM, DM, DM, smem, e); }
        xcd_barrier(xb);
        for (int i = blockIdx.x >> 3; ; i += G >> 3) { int mt, nt; if (!xcd_tile(i, 160 * 8, 8, mt, nt)) break; const P p = getP(kp);
            EpiRes e{p.out, p.mod + ((size_t)l * 5 + modrow_of(mt * 128)) * 6144 + 5120, mt * 128, nt * 128};
            gemm128<true>(p.hidden + (size_t)mt * 128 * DFF, DFF, p.WtF2 + (size_t)nt * 128 * DFF, DFF, DFF, smem, e); }
        xcd_barrier(xb);
        { const P p = getP(kp); ln_phase(p, l, 2); }
        if (l < 3) { for (int u = blockIdx.x; u < NCONV; u += G) { const P p = getP(kp); conv_unit(p, l + 1, u, smem); } }
        xcd_barrier(xb);
    }
}

extern "C" void kernel_launch(void* const* d_in, const int* in_sizes, int n_in, void* d_out, int out_size, void* d_ws, size_t ws_size, hipStream_t stream) {
    static int grid_blocks = 0;
    if (!grid_blocks) {
        int dev = 0, cus = 0, per_cu = 0;
        (void)hipGetDevice(&dev);
        (void)hipDeviceGetAttribute(&cus, hipDeviceAttributeMultiprocessorCount, dev);
        (void)hipFuncSetAttribute((const void*)mega, hipFuncAttributeMaxDynamicSharedMemorySize, SMEM_BYTES);
        (void)hipOccupancyMaxActiveBlocksPerMultiprocessor(&per_cu, (const void*)mega, 256, SMEM_BYTES);
        if (per_cu > 2) per_cu = 2;
        if (per_cu < 1) per_cu = 1;
        grid_blocks = (cus * per_cu) & ~7;
    }
    if (WS_TOTAL > ws_size) { fprintf(stderr, "kernel_launch: workspace too small: need %zu have %zu\n", (size_t)WS_TOTAL, ws_size); return; }
    Args a{};
    for (int i = 0; i < 36; ++i) a.in[i] = (const float*)d_in[i];
    a.out = (float*)d_out; a.ws = (char*)d_ws;
    (void)hipMemsetAsync((char*)d_ws + OFF_BAR, 0, 16384 + 4096, stream);
    void* args[] = {&a};
    hipError_t e = hipLaunchCooperativeKernel((const void*)mega, dim3(grid_blocks), dim3(256), args, SMEM_BYTES, stream);
    if (e != hipSuccess) fprintf(stderr, "cooperative launch failed: %s (grid %d)\n", hipGetErrorString(e), grid_blocks);
}
```

```cpp
#include <hip/hip_runtime.h>
#include <hip/hip_cooperative_groups.h>
#include <cstdint>
#include <cstdio>
namespace cg = cooperative_groups;

typedef unsigned short bf16_t;
typedef short bf16x8 __attribute__((ext_vector_type(8)));
typedef float f32x4 __attribute__((ext_vector_type(4)));
typedef float f32x2 __attribute__((ext_vector_type(2)));
typedef float f32x16 __attribute__((ext_vector_type(16)));
typedef unsigned u32x4 __attribute__((ext_vector_type(4)));
typedef unsigned u32x2 __attribute__((ext_vector_type(2)));

#define M_ALL 20480
#define M_CTX 4096
#define DM 1024
#define NIN 2080
#define DFF 2816
#define ALPHA_F 1.6817928305074290f
#define QSCALE (0.10206207261596575f * 1.4426950408889634f)
#define LAS __attribute__((address_space(3)))
#ifndef DUP_P2
#define DUP_P2 1
#endif
#ifndef DUP_P3
#define DUP_P3 1
#endif
#ifndef DUP_P5
#define DUP_P5 1
#endif

#define ZQ 1152
#define ZKV 1408
#define ZKR 1536
#define ZU 1568
#define ZV 1824

#define LDS_STRIDE 72
#define TILE_BYTES (128 * LDS_STRIDE * 2)
#define RS_OFF (4 * TILE_BYTES)
#define SMEM_BYTES (RS_OFF + 3072)

struct P {
    const float *x_prompt, *x_sample, *cache_ckv, *cache_krope, *state_rwkv, *c, *c_ctx, *ada_w, *ada_b, *w_in, *rw_conv, *rw_w0, *rw_w2,
        *rw_a0, *rw_a2, *rw_g2, *rw_kk, *rw_ka, *rw_rk, *rw_gn_g, *rw_gn_b, *q_norm, *q_up, *kv_norm, *kv_up, *gm_g, *gm_b, *gm_ws, *gm_bs,
        *w_out, *ln1_g, *ln1_b, *ffn_in, *ffn_out, *ln2_g, *ln2_b;
    float* out;
    unsigned* bar; int* ctr; float* mod; float* ropeC; float* ropeS; bf16_t* CkvB;
    bf16_t *WtIn, *WtQ, *WtKVn, *WtKV, *WtOut, *WtF1, *WtF2, *WsB, *W2t, *A2t, *G2t;
    bf16_t *Z, *RKV, *Ee, *Aa, *Gg, *Qb, *Kb, *Kc, *Vt, *Vtc, *hbmix, *hidden;
    float* ydir;
};


struct Args { const float* in[36]; float* out; char* ws; };
typedef const __attribute__((address_space(4))) char* kargp_t;
constexpr size_t al256(size_t x) { return (x + 255) & ~(size_t)255; }
constexpr size_t OFF_BAR = 0;
constexpr size_t OFF_CTR = OFF_BAR + 16384;
constexpr size_t OFF_MOD = OFF_CTR + 4096;
constexpr size_t OFF_ROPEC = OFF_MOD + al256((size_t)4 * 5 * 6144 * 4);
constexpr size_t OFF_ROPES = OFF_ROPEC + 65536 * 4;
constexpr size_t OFF_CKVB = OFF_ROPES + 65536 * 4;
constexpr size_t OFF_WTIN = OFF_CKVB + (size_t)4 * 2048 * 128 * 2;
constexpr size_t OFF_WTQ = OFF_WTIN + (size_t)2176 * 1024 * 2;
constexpr size_t OFF_WTKVN = OFF_WTQ + (size_t)768 * 256 * 2;
constexpr size_t OFF_WTKV = OFF_WTKVN + (size_t)1024 * 128 * 2;
constexpr size_t OFF_WTOUT = OFF_WTKV + (size_t)1024 * 128 * 2;
constexpr size_t OFF_WTF1 = OFF_WTOUT + (size_t)1024 * 1024 * 2;
constexpr size_t OFF_WTF2 = OFF_WTF1 + (size_t)5632 * 1024 * 2;
constexpr size_t OFF_WSB = OFF_WTF2 + (size_t)1024 * DFF * 2;
constexpr size_t OFF_W2T = OFF_WSB + (size_t)65536 * 2;
constexpr size_t OFF_A2T = OFF_W2T + (size_t)2 * 256 * 64 * 2;
constexpr size_t OFF_G2T = OFF_A2T + (size_t)2 * 256 * 64 * 2;
constexpr size_t OFF_Z = OFF_G2T + (size_t)256 * 128 * 2;
constexpr size_t OFF_HIDDEN = OFF_Z;
constexpr size_t OFF_RKV = OFF_Z + al256((size_t)M_ALL * NIN * 2);
constexpr size_t OFF_EE = OFF_RKV + (size_t)M_ALL * 768 * 2;
constexpr size_t OFF_AA = OFF_EE + (size_t)2 * M_ALL * 256 * 2;
constexpr size_t OFF_GG = OFF_AA + (size_t)2 * M_ALL * 256 * 2;
constexpr size_t OFF_QB = OFF_GG + (size_t)M_ALL * 256 * 2;
constexpr size_t OFF_KB = OFF_QB + (size_t)M_ALL * 768 * 2;
constexpr size_t OFF_KC = OFF_KB + (size_t)M_ALL * 768 * 2;
constexpr size_t OFF_VT = OFF_KC + (size_t)2048 * 768 * 2;
constexpr size_t OFF_VTC = OFF_VT + (size_t)M_ALL * 512 * 2;
constexpr size_t OFF_YDIR = OFF_VTC + (size_t)2048 * 512 * 2;
constexpr size_t OFF_HBMIX = OFF_YDIR + (size_t)2 * M_ALL * 256 * 4;
constexpr size_t WS_TOTAL = OFF_HBMIX + (size_t)M_ALL * DM * 2;
static_assert(OFF_RKV + (size_t)M_ALL * 768 * 2 - OFF_HIDDEN >= (size_t)M_ALL * DFF * 2, "hidden overlay");

__device__ __forceinline__ P getP(kargp_t& kp) {
    asm volatile("" : "+s"(kp));
    typedef const float* const __attribute__((address_space(4)))* inp_t;
    inp_t in = (inp_t)kp;
    P p;
    p.x_prompt = in[0]; p.x_sample = in[1]; p.cache_ckv = in[2]; p.cache_krope = in[3]; p.state_rwkv = in[4]; p.c = in[5]; p.c_ctx = in[6];
    p.ada_w = in[7]; p.ada_b = in[8]; p.w_in = in[9]; p.rw_conv = in[10]; p.rw_w0 = in[11]; p.rw_w2 = in[12]; p.rw_a0 = in[13]; p.rw_a2 = in[14];
    p.rw_g2 = in[15]; p.rw_kk = in[16]; p.rw_ka = in[17]; p.rw_rk = in[18]; p.rw_gn_g = in[19]; p.rw_gn_b = in[20]; p.q_norm = in[21]; p.q_up = in[22];
    p.kv_norm = in[23]; p.kv_up = in[24]; p.gm_g = in[25]; p.gm_b = in[26]; p.gm_ws = in[27]; p.gm_bs = in[28]; p.w_out = in[29]; p.ln1_g = in[30];
    p.ln1_b = in[31]; p.ffn_in = in[32]; p.ffn_out = in[33]; p.ln2_g = in[34]; p.ln2_b = in[35];
    p.out = (float*)in[36]; char* ws = (char*)in[37];
    p.bar = (unsigned*)(ws + OFF_BAR); p.ctr = (int*)(ws + OFF_CTR); p.mod = (float*)(ws + OFF_MOD); p.ropeC = (float*)(ws + OFF_ROPEC); p.ropeS = (float*)(ws + OFF_ROPES);
    p.CkvB = (bf16_t*)(ws + OFF_CKVB); p.WtIn = (bf16_t*)(ws + OFF_WTIN); p.WtQ = (bf16_t*)(ws + OFF_WTQ); p.WtKVn = (bf16_t*)(ws + OFF_WTKVN); p.WtKV = (bf16_t*)(ws + OFF_WTKV);
    p.WtOut = (bf16_t*)(ws + OFF_WTOUT); p.WtF1 = (bf16_t*)(ws + OFF_WTF1); p.WtF2 = (bf16_t*)(ws + OFF_WTF2); p.WsB = (bf16_t*)(ws + OFF_WSB); p.W2t = (bf16_t*)(ws + OFF_W2T);
    p.A2t = (bf16_t*)(ws + OFF_A2T); p.G2t = (bf16_t*)(ws + OFF_G2T); p.Z = (bf16_t*)(ws + OFF_Z); p.RKV = (bf16_t*)(ws + OFF_RKV); p.Ee = (bf16_t*)(ws + OFF_EE); p.Aa = (bf16_t*)(ws + OFF_AA);
    p.Gg = (bf16_t*)(ws + OFF_GG); p.Qb = (bf16_t*)(ws + OFF_QB); p.Kb = (bf16_t*)(ws + OFF_KB); p.Kc = (bf16_t*)(ws + OFF_KC); p.Vt = (bf16_t*)(ws + OFF_VT); p.Vtc = (bf16_t*)(ws + OFF_VTC);
    p.hbmix = (bf16_t*)(ws + OFF_HBMIX); p.hidden = (bf16_t*)(ws + OFF_HIDDEN); p.ydir = (float*)(ws + OFF_YDIR);
    return p;
}

__device__ __forceinline__ float bf2f(bf16_t b) { return __uint_as_float(((unsigned)b) << 16); }
__device__ __forceinline__ unsigned pack2(float lo, float hi) { unsigned r; asm("v_cvt_pk_bf16_f32 %0, %1, %2" : "=v"(r) : "v"(lo), "v"(hi)); return r; }
__device__ __forceinline__ bf16_t f2bf(float f) { return (bf16_t)(pack2(f, 0.f) & 0xffffu); }
__device__ __forceinline__ float lo_bf(unsigned w) { return __uint_as_float(w << 16); }
__device__ __forceinline__ float hi_bf(unsigned w) { return __uint_as_float(w & 0xffff0000u); }
__device__ __forceinline__ float sigmoidf_(float x) { return __builtin_amdgcn_rcpf(1.0f + __builtin_amdgcn_exp2f(-1.4426950408889634f * x)); }
__device__ __forceinline__ float tanhf_(float x) { float e = __builtin_amdgcn_exp2f(2.8853900817779268f * x); return 1.0f - 2.0f * __builtin_amdgcn_rcpf(e + 1.0f); }
__device__ __forceinline__ float geluf_(float x) { return 0.5f * x * (1.0f + tanhf_(0.7978845608028654f * (x + 0.044715f * x * x * x))); }
template <int CTRL> __device__ __forceinline__ float dpp_add(float x) {
    int y = __builtin_amdgcn_update_dpp(0, __float_as_int(x), CTRL, 0xf, 0xf, false);
    return x + __int_as_float(y);
}
__device__ __forceinline__ float red4(float x) { x = dpp_add<0xB1>(x); x = dpp_add<0x4E>(x); return x; }
__device__ __forceinline__ float red8(float x) { x = red4(x); x = dpp_add<0x141>(x); return x; }
__device__ __forceinline__ float red16(float x) { x = red8(x); x = dpp_add<0x140>(x); return x; }
__device__ __forceinline__ int opaque_tid() { int t = threadIdx.x; asm volatile("" : "+v"(t)); return t; }
__device__ __forceinline__ int modrow_of(int row) { return row < M_CTX ? 0 : 1 + ((row - M_CTX) >> 12); }

#define XB_TMO 128
#define XB_XCNT(j) (256 + 64 * (j))
#define XB_XSUB(j) (1280 + 64 * (j))
#define XB_XGEN(j) (2304 + 64 * (j))
#define XB_TOP 3328
#define XB_TOPGEN 3392
#define XCD_BAR_WORDS 3456
#define XB_SPIN_CAP (1u << 22)
__device__ __forceinline__ unsigned xb_ld(unsigned* p) { return __hip_atomic_load(p, __ATOMIC_RELAXED, __HIP_MEMORY_SCOPE_AGENT); }
__device__ __forceinline__ unsigned xb_add(unsigned* p, unsigned v) { return __hip_atomic_fetch_add(p, v, __ATOMIC_RELAXED, __HIP_MEMORY_SCOPE_AGENT); }
__device__ __forceinline__ unsigned xb_xcc_id() { return (unsigned)__builtin_amdgcn_s_getreg((3 << 11) | 20) & 0xFu; }
#define XB_SPIN(cond, bar) do { unsigned _sp = 0; while (cond) { __builtin_amdgcn_s_sleep(1); \
    if ((++_sp & 255u) == 0u) { if (xb_ld(&(bar)[XB_TMO])) break; if (_sp > XB_SPIN_CAP) { atomicAdd(&(bar)[XB_TMO], 1u); break; } } } } while (0)
struct XcdBarrier { unsigned* bar; unsigned x; volatile LAS unsigned* st; };
__device__ __forceinline__ XcdBarrier xcd_barrier_post(unsigned* bar, volatile LAS unsigned* st) {
    XcdBarrier b; b.bar = bar; b.x = xb_xcc_id(); b.st = st;
    if (threadIdx.x == 0) (void)xb_add(&bar[XB_XCNT(b.x)], 1u);
    return b;
}
__device__ __forceinline__ void xcd_barrier_complete(unsigned* bar, unsigned x, unsigned& nloc, unsigned& nx) {
    const unsigned G = gridDim.x * gridDim.y * gridDim.z;
    unsigned sum, cnt, mine, sp = 0u;
    for (;;) {
        sum = 0u; cnt = 0u; mine = 0u;
#pragma unroll
        for (unsigned j = 0; j < 16; ++j) { const unsigned c = xb_ld(&bar[XB_XCNT(j)]); sum += c; cnt += (c > 0u) ? 1u : 0u; mine = (j == x) ? c : mine; }
        if (sum == G) break;
        __builtin_amdgcn_s_sleep(1);
        if ((++sp & 255u) == 0u) { if (xb_ld(&bar[XB_TMO])) break; if (sp > XB_SPIN_CAP) { atomicAdd(&bar[XB_TMO], 1u); break; } }
    }
    nloc = mine > 0u ? mine : 1u; nx = cnt > 0u ? cnt : 1u;
}
__device__ __forceinline__ void xcd_barrier(const XcdBarrier& b) {
    asm volatile("s_waitcnt vmcnt(0)" ::: "memory");
    __syncthreads();
    if (threadIdx.x == 0) {
        unsigned* bar = b.bar;
        __builtin_amdgcn_s_waitcnt(0);
        unsigned nloc = b.st[0], nx = b.st[1];
        if (nloc == 0u) { xcd_barrier_complete(bar, b.x, nloc, nx); b.st[0] = nloc; b.st[1] = nx; }
        const unsigned old = xb_add(&bar[XB_XSUB(b.x)], 1u);
        const unsigned gen = old / nloc;
        if (old + 1u == (gen + 1u) * nloc) {
            __builtin_amdgcn_fence(__ATOMIC_RELEASE, "agent");
            asm volatile("s_waitcnt vmcnt(0)" ::: "memory");
            const unsigned og = xb_add(&bar[XB_TOP], 1u);
            const unsigned tg = og / nx;
            if (og + 1u == (tg + 1u) * nx) xb_add(&bar[XB_TOPGEN], 1u);
            else XB_SPIN(xb_ld(&bar[XB_TOPGEN]) == tg, bar);
            __builtin_amdgcn_fence(__ATOMIC_ACQUIRE, "agent");
            xb_add(&bar[XB_XGEN(b.x)], 1u);
            asm volatile("s_waitcnt vmcnt(0)" ::: "memory");
        } else {
            XB_SPIN(xb_ld(&bar[XB_XGEN(b.x)]) == gen, bar);
            __builtin_amdgcn_fence(__ATOMIC_ACQUIRE, "agent");
            asm volatile("s_waitcnt vmcnt(0)" ::: "memory");
        }
    }
    __syncthreads();
}

template <bool TR, class Epi>
__device__ __forceinline__ void gemm128(const bf16_t* __restrict__ A, int lda, const bf16_t* __restrict__ B, int ldb, int K, char* smem, const Epi& epi) {
    const int tid = opaque_tid(), lane = tid & 63, wid = tid >> 6, wr = wid >> 1, wc = wid & 1, fr = lane & 15, fq = lane >> 4;
    f32x4 acc[4][4];
#pragma unroll
    for (int m = 0; m < 4; ++m)
#pragma unroll
        for (int n = 0; n < 4; ++n) acc[m][n] = (f32x4){0.f, 0.f, 0.f, 0.f};
    const int crow = tid >> 3, ckc = tid & 7;
    const bf16_t* ap = A + (size_t)crow * lda + ckc * 8;
    const bf16_t* bp = B + (size_t)crow * ldb + ckc * 8;
    u32x4 ra[4], rb[4];
#pragma unroll
    for (int i = 0; i < 4; ++i) { ra[i] = *(const u32x4*)(ap + (size_t)(32 * i) * lda); rb[i] = *(const u32x4*)(bp + (size_t)(32 * i) * ldb); }
    {
        char* sa = smem; char* sb = smem + TILE_BYTES;
#pragma unroll
        for (int i = 0; i < 4; ++i) { *(u32x4*)(sa + ((crow + 32 * i) * LDS_STRIDE + ckc * 8) * 2) = ra[i]; *(u32x4*)(sb + ((crow + 32 * i) * LDS_STRIDE + ckc * 8) * 2) = rb[i]; }
    }
    __syncthreads();
    const int nk = K >> 6;
    for (int kt = 0; kt < nk; ++kt) {
        const bool more = (kt + 1 < nk);
        if (more) {
            const int k0 = (kt + 1) << 6;
#pragma unroll
            for (int i = 0; i < 4; ++i) { ra[i] = *(const u32x4*)(ap + (size_t)(32 * i) * lda + k0); rb[i] = *(const u32x4*)(bp + (size_t)(32 * i) * ldb + k0); }
        }
        const char* sa = smem + (kt & 1) * 2 * TILE_BYTES; const char* sb = sa + TILE_BYTES;
#pragma unroll
        for (int ks = 0; ks < 2; ++ks) {
            bf16x8 af[4], bfr[4];
#pragma unroll
            for (int m = 0; m < 4; ++m) af[m] = *(const bf16x8*)(sa + ((wr * 64 + m * 16 + fr) * LDS_STRIDE + ks * 32 + fq * 8) * 2);
#pragma unroll
            for (int n = 0; n < 4; ++n) bfr[n] = *(const bf16x8*)(sb + ((wc * 64 + n * 16 + fr) * LDS_STRIDE + ks * 32 + fq * 8) * 2);
            __builtin_amdgcn_s_setprio(1);
#pragma unroll
            for (int m = 0; m < 4; ++m)
#pragma unroll
                for (int n = 0; n < 4; ++n) acc[m][n] = TR ? __builtin_amdgcn_mfma_f32_16x16x32_bf16(bfr[n], af[m], acc[m][n], 0, 0, 0) : __builtin_amdgcn_mfma_f32_16x16x32_bf16(af[m], bfr[n], acc[m][n], 0, 0, 0);
            __builtin_amdgcn_s_setprio(0);
        }
        if (more) {
            char* da = smem + ((kt + 1) & 1) * 2 * TILE_BYTES; char* db = da + TILE_BYTES;
#pragma unroll
            for (int i = 0; i < 4; ++i) { *(u32x4*)(da + ((crow + 32 * i) * LDS_STRIDE + ckc * 8) * 2) = ra[i]; *(u32x4*)(db + ((crow + 32 * i) * LDS_STRIDE + ckc * 8) * 2) = rb[i]; }
        }
        __syncthreads();
    }
    epi(acc, wr * 64, wc * 64, fr, fq);
}


#define L2_STRIDE 40
#define A2_BYTES (256 * L2_STRIDE * 2)
#define B2_BYTES (128 * L2_STRIDE * 2)
#define ST2_BYTES (A2_BYTES + B2_BYTES)
template <class Epi>
__device__ __forceinline__ void gemm256(const bf16_t* __restrict__ A, int lda, const bf16_t* __restrict__ B, int ldb, int K, char* smem, const Epi& epi) {
    const int tid = opaque_tid(), lane = tid & 63, wid = tid >> 6, wr = wid >> 1, wc = wid & 1, fr = lane & 15, fq = lane >> 4;
    f32x4 acc[2][4][4];
#pragma unroll
    for (int hh = 0; hh < 2; ++hh)
#pragma unroll
        for (int m = 0; m < 4; ++m)
#pragma unroll
            for (int n = 0; n < 4; ++n) acc[hh][m][n] = (f32x4){0.f, 0.f, 0.f, 0.f};
    const int crow = tid >> 2, ckc = tid & 3;
    const bf16_t* ap = A + (size_t)crow * lda + ckc * 8;
    const bf16_t* bp = B + (size_t)crow * ldb + ckc * 8;
    u32x4 ra[4], rb[2];
#pragma unroll
    for (int i = 0; i < 4; ++i) ra[i] = *(const u32x4*)(ap + (size_t)(64 * i) * lda);
#pragma unroll
    for (int i = 0; i < 2; ++i) rb[i] = *(const u32x4*)(bp + (size_t)(64 * i) * ldb);
    {
        char* sa = smem; char* sb = smem + A2_BYTES;
#pragma unroll
        for (int i = 0; i < 4; ++i) *(u32x4*)(sa + ((crow + 64 * i) * L2_STRIDE + ckc * 8) * 2) = ra[i];
#pragma unroll
        for (int i = 0; i < 2; ++i) *(u32x4*)(sb + ((crow + 64 * i) * L2_STRIDE + ckc * 8) * 2) = rb[i];
    }
    __syncthreads();
    const int nk = K >> 5;
    for (int kt = 0; kt < nk; ++kt) {
        const bool more = (kt + 1 < nk);
        if (more) {
            const int k0 = (kt + 1) << 5;
#pragma unroll
            for (int i = 0; i < 4; ++i) ra[i] = *(const u32x4*)(ap + (size_t)(64 * i) * lda + k0);
#pragma unroll
            for (int i = 0; i < 2; ++i) rb[i] = *(const u32x4*)(bp + (size_t)(64 * i) * ldb + k0);
        }
        const char* sa = smem + (kt & 1) * ST2_BYTES; const char* sb = sa + A2_BYTES;
        bf16x8 bfr[4];
#pragma unroll
        for (int n = 0; n < 4; ++n) bfr[n] = *(const bf16x8*)(sb + ((wc * 64 + n * 16 + fr) * L2_STRIDE + fq * 8) * 2);
#pragma unroll
        for (int hh = 0; hh < 2; ++hh) {
            bf16x8 af[4];
#pragma unroll
            for (int m = 0; m < 4; ++m) af[m] = *(const bf16x8*)(sa + ((wr * 128 + hh * 64 + m * 16 + fr) * L2_STRIDE + fq * 8) * 2);
            __builtin_amdgcn_s_setprio(1);
#pragma unroll
            for (int m = 0; m < 4; ++m)
#pragma unroll
                for (int n = 0; n < 4; ++n) acc[hh][m][n] = __builtin_amdgcn_mfma_f32_16x16x32_bf16(bfr[n], af[m], acc[hh][m][n], 0, 0, 0);
            __builtin_amdgcn_s_setprio(0);
        }
        if (more) {
            char* da = smem + ((kt + 1) & 1) * ST2_BYTES; char* db = da + A2_BYTES;
#pragma unroll
            for (int i = 0; i < 4; ++i) *(u32x4*)(da + ((crow + 64 * i) * L2_STRIDE + ckc * 8) * 2) = ra[i];
#pragma unroll
            for (int i = 0; i < 2; ++i) *(u32x4*)(db + ((crow + 64 * i) * L2_STRIDE + ckc * 8) * 2) = rb[i];
        }
        __syncthreads();
    }
    epi(acc[0], wr * 128, wc * 64, fr, fq);
    epi(acc[1], wr * 128 + 64, wc * 64, fr, fq);
}

struct EpiZ {
    bf16_t* Z; int R0, C0;
    __device__ __forceinline__ void operator()(f32x4 (&acc)[4][4], int r0, int c0, int fr, int fq) const {
#pragma unroll
        for (int n = 0; n < 4; ++n) { const int col = C0 + c0 + n * 16 + fq * 4; if (col < NIN) {
#pragma unroll
            for (int m = 0; m < 4; ++m) { u32x2 w; w.x = pack2(acc[m][n][0], acc[m][n][1]); w.y = pack2(acc[m][n][2], acc[m][n][3]);
                *(u32x2*)(Z + (size_t)(R0 + r0 + m * 16 + fr) * NIN + col) = w; } } }
    }
};
struct EpiQ {
    bf16_t* Q; const float* rs; const float* ropeC; const float* ropeS; int R0, C0;
    __device__ __forceinline__ void operator()(f32x4 (&acc)[4][4], int r0, int c0, int fr, int fq) const {
        const bool lat = R0 >= M_CTX;
#pragma unroll
        for (int n = 0; n < 4; ++n) {
            const int cb = C0 + c0 + n * 16; const int hcs = cb % 96;
            if (lat && hcs == 80) continue;
            const bool rot = lat && hcs == 64;
#pragma unroll
            for (int m = 0; m < 4; ++m) {
                const int rl = r0 + m * 16 + fr; const int row = R0 + rl; const float sc = rs[rl] * QSCALE;
                const f32x4 x1 = acc[m][n] * sc; bf16_t* qp = Q + (size_t)row * 768 + cb + fq * 4;
                if (rot) {
                    const f32x4 x2 = acc[m][(n + 1) & 3] * sc; const int t = (row - M_CTX) & 4095;
                    const f32x4 cv = *(const f32x4*)(ropeC + t * 16 + fq * 4), sv = *(const f32x4*)(ropeS + t * 16 + fq * 4);
                    const f32x4 o1 = x1 * cv - x2 * sv, o2 = x1 * sv + x2 * cv;
                    u32x2 w; w.x = pack2(o1[0], o1[1]); w.y = pack2(o1[2], o1[3]); *(u32x2*)qp = w;
                    w.x = pack2(o2[0], o2[1]); w.y = pack2(o2[2], o2[3]); *(u32x2*)(qp + 16) = w;
                } else { u32x2 w; w.x = pack2(x1[0], x1[1]); w.y = pack2(x1[2], x1[3]); *(u32x2*)qp = w; }
            }
        }
    }
};
struct EpiKN {
    bf16_t* Kd; const float* rs; int R0, C0;
    __device__ __forceinline__ void operator()(f32x4 (&acc)[4][4], int r0, int c0, int fr, int fq) const {
#pragma unroll
        for (int n = 0; n < 4; ++n) { const int col = C0 + c0 + n * 16 + fq * 4; const int h = col >> 6, d = col & 63;
#pragma unroll
            for (int m = 0; m < 4; ++m) { const int rl = r0 + m * 16 + fr; const f32x4 v = acc[m][n] * (rs ? rs[rl] : 1.0f);
                u32x2 w; w.x = pack2(v[0], v[1]); w.y = pack2(v[2], v[3]); *(u32x2*)(Kd + (size_t)(R0 + rl) * 768 + h * 96 + d) = w; } }
    }
};
struct EpiKV {
    bf16_t* Kd; bf16_t* Vd; const float* rs; int R0, C0; int seqshift; size_t vbase0;
    __device__ __forceinline__ void operator()(f32x4 (&acc)[4][4], int r0, int c0, int fr, int fq) const {
#pragma unroll
        for (int n = 0; n < 4; ++n) {
            const int col = C0 + c0 + n * 16 + fr;
#pragma unroll
            for (int m = 0; m < 4; ++m) {
                const int rl = r0 + m * 16 + fq * 4; const int row = R0 + rl;
                float v[4];
#pragma unroll
                for (int j = 0; j < 4; ++j) v[j] = acc[m][n][j] * (rs ? rs[rl + j] : 1.0f);
                if (col < 512) {
                    const int h = col >> 6, d = col & 63;
#pragma unroll
                    for (int j = 0; j < 4; ++j) Kd[(size_t)(row + j) * 768 + h * 96 + d] = f2bf(v[j]);
                } else {
                    const int vc = col - 512, h = vc >> 6, dv = vc & 63; const int b = row >> seqshift, t = row & ((1 << seqshift) - 1);
                    u32x2 w; w.x = pack2(v[0], v[1]); w.y = pack2(v[2], v[3]);
                    *(u32x2*)(Vd + vbase0 + ((size_t)((b * 8 + h) * 64 + dv) << seqshift) + t) = w;
                }
            }
        }
    }
};
struct EpiRes {
    float* X; const float* gate; int R0, C0;
    __device__ __forceinline__ void operator()(f32x4 (&acc)[4][4], int r0, int c0, int fr, int fq) const {
#pragma unroll
        for (int n = 0; n < 4; ++n) { const int col = C0 + c0 + n * 16 + fq * 4; const f32x4 g = *(const f32x4*)(gate + col);
#pragma unroll
            for (int m = 0; m < 4; ++m) { float* px = X + (size_t)(R0 + r0 + m * 16 + fr) * DM + col; const f32x4 xv = *(const f32x4*)px; *(f32x4*)px = ALPHA_F * xv + g * acc[m][n]; } }
    }
};
struct EpiSwi {
    bf16_t* H; int R0, C0;
    __device__ __forceinline__ void operator()(f32x4 (&acc)[4][4], int r0, int c0, int fr, int fq) const {
        const int hb = ((C0 + c0) >> 1) + fq * 4;
#pragma unroll
        for (int n = 0; n < 2; ++n)
#pragma unroll
            for (int m = 0; m < 4; ++m) { float o[4];
#pragma unroll
                for (int j = 0; j < 4; ++j) { const float g = acc[m][n][j], u = acc[m][n + 2][j]; o[j] = g * sigmoidf_(g) * u; }
                u32x2 w; w.x = pack2(o[0], o[1]); w.y = pack2(o[2], o[3]);
                *(u32x2*)(H + (size_t)(R0 + r0 + m * 16 + fr) * DFF + hb + n * 16) = w; }
    }
};

__device__ __forceinline__ void ada_unit(const P& p, int u, char* smem) {
    const int tid = opaque_tid(); const int l = u / 96, c0 = (u % 96) * 64;
    float* cs = (float*)smem;
    for (int i = tid; i < 5 * 1024; i += 256) { const int r = i >> 10, k = i & 1023; const float v = (r == 0) ? p.c_ctx[k] : p.c[(r - 1) * 1024 + k]; cs[i] = v * sigmoidf_(v); }
    __syncthreads();
    const int col = tid & 63, kq = tid >> 6;
    float s0 = 0.f, s1 = 0.f, s2 = 0.f, s3 = 0.f, s4 = 0.f;
    const float* w = p.ada_w + ((size_t)l * 1024 + kq * 256) * 6144 + c0 + col;
    const float* cq = cs + kq * 256;
    for (int k = 0; k < 256; ++k) { const float wv = w[(size_t)k * 6144]; s0 += cq[k] * wv; s1 += cq[1024 + k] * wv; s2 += cq[2048 + k] * wv; s3 += cq[3072 + k] * wv; s4 += cq[4096 + k] * wv; }
    float* red = cs + 5 * 1024;
    red[(kq * 5 + 0) * 64 + col] = s0; red[(kq * 5 + 1) * 64 + col] = s1; red[(kq * 5 + 2) * 64 + col] = s2; red[(kq * 5 + 3) * 64 + col] = s3; red[(kq * 5 + 4) * 64 + col] = s4;
    __syncthreads();
    for (int o = tid; o < 320; o += 256) { const int i = o >> 6, cc = o & 63;
        const float v = red[(0 * 5 + i) * 64 + cc] + red[(1 * 5 + i) * 64 + cc] + red[(2 * 5 + i) * 64 + cc] + red[(3 * 5 + i) * 64 + cc] + p.ada_b[l * 6144 + c0 + cc];
        p.mod[((size_t)l * 5 + i) * 6144 + c0 + cc] = v; }
    __syncthreads();
}
__device__ __forceinline__ int map_col(int kind, int n) {
    if (kind == 1) { const int blk = n >> 6, r = n & 63; return r < 32 ? blk * 32 + r : DFF + blk * 32 + (r - 32); }
    if (kind == 2) { if (n < 512) return (n >> 6) * 128 + (n & 63); const int vc = n - 512; return (vc >> 6) * 128 + 64 + (vc & 63); }
    return n;
}
__device__ __forceinline__ void conv_tile(const float* src, int ldsrc, bf16_t* dst, bf16_t* dst2, int Kdst, int n0, int k0, int kind, int Nvalid, const float* kscale, char* smem) {
    const int tid = opaque_tid(); float* tile = (float*)smem;
    { const int j = tid & 63, i0 = tid >> 6; const int n = n0 + j; const int sc = (n < Nvalid) ? map_col(kind, n) : -1;
#pragma unroll 4
      for (int ii = 0; ii < 16; ++ii) { const int i = i0 + 4 * ii; tile[i * 65 + j] = (sc >= 0) ? src[(size_t)(k0 + i) * ldsrc + sc] : 0.f; } }
    __syncthreads();
    { const int i = tid & 63, j0 = tid >> 6; const float ks = kscale ? kscale[k0 + i] : 1.f;
#pragma unroll 4
      for (int jj = 0; jj < 16; ++jj) { const int jx = j0 + 4 * jj; const float v = tile[i * 65 + jx];
          dst[(size_t)(n0 + jx) * Kdst + k0 + i] = f2bf(v * ks); if (dst2) dst2[(size_t)(n0 + jx) * Kdst + k0 + i] = f2bf(v); } }
    __syncthreads();
}
#define NCONV 3032
__device__ __forceinline__ void conv_unit(const P& p, int l, int u, char* smem) {
    const float* src; int ldsrc; bf16_t* dst; bf16_t* dst2 = nullptr; int Kdst, n0, k0, kind = 0, Nvalid; const float* kscale = nullptr;
    if (u < 544) { src = p.w_in + (size_t)l * 1024 * NIN; ldsrc = NIN; dst = p.WtIn; Kdst = 1024; n0 = (u / 16) * 64; k0 = (u % 16) * 64; Nvalid = NIN; }
    else if (u < 592) { u -= 544; src = p.q_up + (size_t)l * 256 * 768; ldsrc = 768; dst = p.WtQ; Kdst = 256; n0 = (u / 4) * 64; k0 = (u % 4) * 64; Nvalid = 768; kscale = p.q_norm + l * 256; }
    else if (u < 624) { u -= 592; src = p.kv_up + (size_t)l * 128 * 1024; ldsrc = 1024; dst = p.WtKVn; dst2 = p.WtKV; Kdst = 128; n0 = (u / 2) * 64; k0 = (u % 2) * 64; kind = 2; Nvalid = 1024; kscale = p.kv_norm + l * 128; }
    else if (u < 880) { u -= 624; src = p.w_out + (size_t)l * 1024 * 1024; ldsrc = 1024; dst = p.WtOut; Kdst = 1024; n0 = (u / 16) * 64; k0 = (u % 16) * 64; Nvalid = 1024; }
    else if (u < 2288) { u -= 880; src = p.ffn_in + (size_t)l * 1024 * 5632; ldsrc = 5632; dst = p.WtF1; Kdst = 1024; n0 = (u / 16) * 64; k0 = (u % 16) * 64; kind = 1; Nvalid = 5632; }
    else if (u < 2992) { u -= 2288; src = p.ffn_out + (size_t)l * DFF * 1024; ldsrc = 1024; dst = p.WtF2; Kdst = DFF; n0 = (u / 44) * 64; k0 = (u % 44) * 64; Nvalid = 1024; }
    else if (u < 3008) { u -= 2992; const float* sp = p.gm_ws + (size_t)l * 65536 + u * 4096; bf16_t* d = p.WsB + u * 4096; for (int i = threadIdx.x; i < 4096; i += 256) d[i] = f2bf(sp[i]); return; }
    else if (u < 3016) { u -= 3008; const int d = u >> 2; src = p.rw_w2 + ((size_t)l * 2 + d) * 64 * 256; ldsrc = 256; dst = p.W2t + d * 256 * 64; Kdst = 64; n0 = (u & 3) * 64; k0 = 0; Nvalid = 256; }
    else if (u < 3024) { u -= 3016; const int d = u >> 2; src = p.rw_a2 + ((size_t)l * 2 + d) * 64 * 256; ldsrc = 256; dst = p.A2t + d * 256 * 64; Kdst = 64; n0 = (u & 3) * 64; k0 = 0; Nvalid = 256; }
    else { u -= 3024; src = p.rw_g2 + (size_t)l * 128 * 256; ldsrc = 256; dst = p.G2t; Kdst = 128; n0 = (u / 2) * 64; k0 = (u % 2) * 64; Nvalid = 256; }
    conv_tile(src, ldsrc, dst, dst2, Kdst, n0, k0, kind, Nvalid, kscale, smem);
}
__device__ __forceinline__ void misc0_unit(const P& p, int u) {
    const int tid = opaque_tid();
    if (u < 16) {
        for (int e = tid; e < 4096; e += 256) { const int idx = u * 4096 + e; const int t = idx >> 4, i = idx & 15;
            const float pos = (float)((i < 8) ? (t >> 6) : (t & 63)); const float inv = exp2f(-(float)(i & 7) * 1.6609640474436813f);
            const float ang = pos * inv; const float kf = rintf(ang * 0.15915494309189535f);
            float r = fmaf(-kf, 6.28318548202514648f, ang); r = fmaf(-kf, -1.74845553e-7f, r);
            p.ropeC[idx] = __cosf(r); p.ropeS[idx] = __sinf(r); }
    } else {
        const int v = u - 16;
        for (int e = tid; e < 4096; e += 256) { const int idx = v * 4096 + e;
            const int c = idx & 127, t = (idx >> 7) & 511, b = (idx >> 16) & 3, l = idx >> 18;
            p.CkvB[idx] = f2bf(p.cache_ckv[(((size_t)b * 4 + l) * 512 + t) * 128 + c]); }
    }
}

__device__ __forceinline__ void ln_phase(const P& p, int l, int which) {
    const int tid = opaque_tid(), lane = tid & 63, wid = tid >> 6;
    const float* g = which == 1 ? p.ln1_g + l * DM : p.ln2_g + l * DM; const float* bb = which == 1 ? p.ln1_b + l * DM : p.ln2_b + l * DM;
    const int ml = which == 2 ? l + 1 : l; const int shoff = which == 1 ? 3072 : 0, scoff = which == 1 ? 4096 : 1024;
    const bool dohb = !(which == 2 && l == 3);
    for (int row = blockIdx.x * 4 + wid; row < M_ALL; row += gridDim.x * 4) {
        float* xr = p.out + (size_t)row * DM;
        const float* src = which == 0 ? (row < M_CTX ? p.x_prompt + (size_t)row * DM : p.x_sample + (size_t)(row - M_CTX) * DM) : xr;
        f32x4 v[4];
#pragma unroll
        for (int i = 0; i < 4; ++i) v[i] = *(const f32x4*)(src + lane * 4 + 256 * i);
        if (which != 0) {
            float s = 0.f;
#pragma unroll
            for (int i = 0; i < 4; ++i) s += (v[i][0] + v[i][1]) + (v[i][2] + v[i][3]);
            s = red16(s); s += __shfl_xor(s, 16); s += __shfl_xor(s, 32);
            const float mu = s * (1.0f / 1024.0f); float q = 0.f;
#pragma unroll
            for (int i = 0; i < 4; ++i) { const f32x4 d = v[i] - mu; q += (d[0] * d[0] + d[1] * d[1]) + (d[2] * d[2] + d[3] * d[3]); }
            q = red16(q); q += __shfl_xor(q, 16); q += __shfl_xor(q, 32);
            const float rstd = rsqrtf(q * (1.0f / 1024.0f) + 1e-5f);
#pragma unroll
            for (int i = 0; i < 4; ++i) { const f32x4 gg = *(const f32x4*)(g + lane * 4 + 256 * i), bv = *(const f32x4*)(bb + lane * 4 + 256 * i); v[i] = (v[i] - mu) * rstd * gg + bv; }
        }
#pragma unroll
        for (int i = 0; i < 4; ++i) *(f32x4*)(xr + lane * 4 + 256 * i) = v[i];
        if (dohb) {
            const float* md = p.mod + ((size_t)ml * 5 + modrow_of(row)) * 6144;
#pragma unroll
            for (int i = 0; i < 4; ++i) { const f32x4 sh = *(const f32x4*)(md + shoff + lane * 4 + 256 * i), sc = *(const f32x4*)(md + scoff + lane * 4 + 256 * i);
                const f32x4 h = v[i] * (1.0f + sc) + sh; u32x2 w; w.x = pack2(h[0], h[1]); w.y = pack2(h[2], h[3]);
                *(u32x2*)(p.hbmix + (size_t)row * DM + lane * 4 + 256 * i) = w; }
        }
    }
}

__device__ __forceinline__ void rwprep_unit(const P& p, int l, int u, char* smem) {
    const int tid = opaque_tid(), lane = tid & 63, wid = tid >> 6, fr = lane & 15, fq = lane >> 4;
    const int R0 = u * 64;
    const int ss = R0 < M_CTX ? (R0 & ~255) : M_CTX + ((R0 - M_CTX) & ~4095); const int se = ss + (R0 < M_CTX ? 256 : 4096);
    bf16_t* XW = (bf16_t*)smem; bf16_t* XA = XW + 64 * 136; bf16_t* XG = XA + 64 * 136;
    const float* cw = p.rw_conv + (size_t)l * 3 * 1152;
    for (int it = tid; it < 576; it += 256) {
        const int cc = it % 144, tg = it / 144; const int c = cc * 8;
        float w0[8], w1[8], w2[8];
#pragma unroll
        for (int i = 0; i < 8; ++i) { w0[i] = cw[c + i]; w1[i] = cw[1152 + c + i]; w2[i] = cw[2304 + c + i]; }
        const int rfirst = R0 + tg * 16;
        u32x4 prev = (u32x4){0u, 0u, 0u, 0u}, cur, nxt;
        if (rfirst - 1 >= ss) prev = *(const u32x4*)(p.Z + (size_t)(rfirst - 1) * NIN + c);
        cur = *(const u32x4*)(p.Z + (size_t)rfirst * NIN + c);
        for (int tt = 0; tt < 16; ++tt) {
            const int row = rfirst + tt;
            nxt = (u32x4){0u, 0u, 0u, 0u};
            if (row + 1 < se) nxt = *(const u32x4*)(p.Z + (size_t)(row + 1) * NIN + c);
            float o[8];
#pragma unroll
            for (int i = 0; i < 4; ++i) {
                o[2 * i] = w0[2 * i] * lo_bf(prev[i]) + w1[2 * i] * lo_bf(cur[i]) + w2[2 * i] * lo_bf(nxt[i]);
                o[2 * i + 1] = w0[2 * i + 1] * hi_bf(prev[i]) + w1[2 * i + 1] * hi_bf(cur[i]) + w2[2 * i + 1] * hi_bf(nxt[i]);
            }
            if (c >= 768 && c < 896) {
#pragma unroll
                for (int i = 0; i < 8; ++i) o[i] = tanhf_(o[i]);
            } else if (c >= 1024) {
#pragma unroll
                for (int i = 0; i < 8; ++i) o[i] = sigmoidf_(o[i]);
            }
            u32x4 w; w.x = pack2(o[0], o[1]); w.y = pack2(o[2], o[3]); w.z = pack2(o[4], o[5]); w.w = pack2(o[6], o[7]);
            const int tl = tg * 16 + tt;
            if (c < 768) *(u32x4*)(p.RKV + (size_t)row * 768 + c) = w;
            else if (c < 896) *(u32x4*)(XW + tl * 136 + (c - 768)) = w;
            else if (c < 1024) *(u32x4*)(XA + tl * 136 + (c - 896)) = w;
            else *(u32x4*)(XG + tl * 136 + (c - 1024)) = w;
            prev = cur; cur = nxt;
        }
    }
    __syncthreads();
#pragma unroll 1
    for (int mh = 0; mh < 10; ++mh) {
        const int mat = mh >> 1, nh = mh & 1;
        const int d = mat & 1; const bf16_t* As; const bf16_t* Bw; int kofs, nks, ldw;
        if (mat < 2) { As = XW; Bw = p.W2t + d * 256 * 64; kofs = d * 64; nks = 2; ldw = 64; }
        else if (mat < 4) { As = XA; Bw = p.A2t + d * 256 * 64; kofs = d * 64; nks = 2; ldw = 64; }
        else { As = XG; Bw = p.G2t; kofs = 0; nks = 4; ldw = 128; }
        f32x4 acc[4][2];
#pragma unroll
        for (int m = 0; m < 4; ++m)
#pragma unroll
            for (int n = 0; n < 2; ++n) acc[m][n] = (f32x4){0.f, 0.f, 0.f, 0.f};
#pragma unroll 1
        for (int ks = 0; ks < nks; ++ks) {
            bf16x8 af[4], bfr[2];
#pragma unroll
            for (int m = 0; m < 4; ++m) af[m] = *(const bf16x8*)(As + (m * 16 + fr) * 136 + kofs + ks * 32 + fq * 8);
#pragma unroll
            for (int n = 0; n < 2; ++n) bfr[n] = *(const bf16x8*)(Bw + (size_t)(wid * 64 + nh * 32 + n * 16 + fr) * ldw + ks * 32 + fq * 8);
#pragma unroll
            for (int m = 0; m < 4; ++m)
#pragma unroll
                for (int n = 0; n < 2; ++n) acc[m][n] = __builtin_amdgcn_mfma_f32_16x16x32_bf16(bfr[n], af[m], acc[m][n], 0, 0, 0);
        }
#pragma unroll
        for (int n = 0; n < 2; ++n) {
            const int c = wid * 64 + nh * 32 + n * 16 + fq * 4;
            f32x4 bias = (f32x4){0.f, 0.f, 0.f, 0.f}; if (mat < 2) bias = *(const f32x4*)(p.rw_w0 + (l * 2 + d) * 256 + c); else if (mat < 4) bias = *(const f32x4*)(p.rw_a0 + (l * 2 + d) * 256 + c);
            bf16_t* dst; float mul;
            if (mat < 2) { dst = p.Ee + ((size_t)d * M_ALL + R0) * 256 + c; mul = 0.6065306597126334f; }
            else if (mat < 4) { dst = p.Aa + ((size_t)d * M_ALL + R0) * 256 + c; mul = 1.0f; }
            else { dst = p.Gg + (size_t)R0 * 256 + c; mul = 1.0f; }
#pragma unroll
            for (int m = 0; m < 4; ++m) {
                float o[4];
#pragma unroll
                for (int j = 0; j < 4; ++j) { const float x = acc[m][n][j] + bias[j]; o[j] = mat < 4 ? mul * sigmoidf_(x) : x; }
                u32x2 w; w.x = pack2(o[0], o[1]); w.y = pack2(o[2], o[3]);
                *(u32x2*)(dst + (size_t)(m * 16 + fr) * 256) = w;
            }
        }
    }
    __syncthreads();
}
__device__ __forceinline__ void rowscale128(const bf16_t* Z, int R0, int zoff, int ncols, float eps, float* rs) {
    const int tid = opaque_tid(); const int r = tid >> 1, half = tid & 1; const int per = ncols >> 1;
    const bf16_t* zp = Z + (size_t)(R0 + r) * NIN + zoff + half * per;
    float ss = 0.f;
    for (int i = 0; i < per; i += 8) { const u32x4 w = *(const u32x4*)(zp + i);
#pragma unroll
        for (int q = 0; q < 4; ++q) { const float a = lo_bf(w[q]), b = hi_bf(w[q]); ss += a * a + b * b; } }
    ss = dpp_add<0xB1>(ss);
    if (half == 0) rs[r] = rsqrtf(ss / (float)ncols + eps);
}
__device__ __forceinline__ void small_unit(const P& p, int l, int u) {
    const int tid = opaque_tid(), sub = tid >> 5, li = tid & 31;
    if (u < 2560) {
        const int row = u * 8 + sub; const bf16_t* zr = p.Z + (size_t)row * NIN;
        const u32x2 w = *(const u32x2*)(zr + ZKV + li * 4);
        const float z0 = lo_bf(w.x), z1 = hi_bf(w.x), z2 = lo_bf(w.y), z3 = hi_bf(w.y);
        float ss = z0 * z0 + z1 * z1 + z2 * z2 + z3 * z3; ss = red16(ss); ss += __shfl_xor(ss, 16);
        const float rsv = rsqrtf(ss * (1.0f / 128.0f) + 1e-6f);
        const float x1 = bf2f(zr[ZKR + (li & 15)]), x2 = bf2f(zr[ZKR + 16 + (li & 15)]);
        float val;
        if (row < M_CTX) {
            const int b = row >> 8, t = row & 255; const size_t o = ((size_t)(b * 4 + l) * 256 + t);
            const f32x4 g = *(const f32x4*)(p.kv_norm + l * 128 + li * 4);
            *(f32x4*)(p.out + 20971520 + o * 128 + li * 4) = (f32x4){z0 * rsv * g[0], z1 * rsv * g[1], z2 * rsv * g[2], z3 * rsv * g[3]};
            val = li < 16 ? x1 : x2;
            p.out[20971520 + 2097152 + o * 32 + li] = val;
        } else {
            const int t = (row - M_CTX) & 4095; const float cv = p.ropeC[t * 16 + (li & 15)], sv = p.ropeS[t * 16 + (li & 15)];
            val = li < 16 ? x1 * cv - x2 * sv : x1 * sv + x2 * cv;
        }
        const bf16_t bv = f2bf(val);
#pragma unroll
        for (int h = 0; h < 8; ++h) p.Kb[(size_t)row * 768 + h * 96 + 64 + li] = bv;
    } else {
        const int r = (u - 2560) * 8 + sub; const int b = r >> 9, t = r & 511;
        const bf16_t bv = f2bf(p.cache_krope[((size_t)(b * 4 + l) * 512 + t) * 32 + li]);
#pragma unroll
        for (int h = 0; h < 8; ++h) p.Kc[(size_t)r * 768 + h * 96 + 64 + li] = bv;
    }
}
__device__ __forceinline__ void gmlp_unit(const P& p, int l, int u, char* smem) {
    const int tid = opaque_tid(), lane = tid & 63, wid = tid >> 6, fr = lane & 15, fq = lane >> 4;
    const int R0 = (u >> 2) * 128, g = u & 3;
    bf16_t* VnT = (bf16_t*)smem;
    {
        const int tok = tid >> 1, half = tid & 1; const bf16_t* zp = p.Z + (size_t)(R0 + tok) * NIN + ZV + g * 64 + half * 32;
        float x[32];
#pragma unroll
        for (int i = 0; i < 4; ++i) { const u32x4 w = *(const u32x4*)(zp + i * 8);
#pragma unroll
            for (int q = 0; q < 4; ++q) { x[i * 8 + 2 * q] = geluf_(lo_bf(w[q])); x[i * 8 + 2 * q + 1] = geluf_(hi_bf(w[q])); } }
        float s = 0.f;
#pragma unroll
        for (int i = 0; i < 32; ++i) s += x[i];
        s = dpp_add<0xB1>(s); const float mu = s * (1.0f / 64.0f);
        float q2 = 0.f;
#pragma unroll
        for (int i = 0; i < 32; ++i) { const float d = x[i] - mu; q2 += d * d; }
        q2 = dpp_add<0xB1>(q2); const float rstd = rsqrtf(q2 * (1.0f / 64.0f) + 1e-5f);
        const float* gg = p.gm_g + l * 256 + g * 64 + half * 32; const float* gb = p.gm_b + l * 256 + g * 64 + half * 32;
#pragma unroll
        for (int i = 0; i < 32; ++i) VnT[(half * 32 + i) * 136 + tok] = f2bf((x[i] - mu) * rstd * gg[i] + gb[i]);
    }
    __syncthreads();
    f32x4 acc[2][4];
#pragma unroll
    for (int m = 0; m < 2; ++m)
#pragma unroll
        for (int n = 0; n < 4; ++n) acc[m][n] = (f32x4){0.f, 0.f, 0.f, 0.f};
    const bf16_t* Wg = p.WsB + g * 128 * 128;
#pragma unroll
    for (int ks = 0; ks < 4; ++ks) {
        bf16x8 af[2], bfr[4];
#pragma unroll
        for (int m = 0; m < 2; ++m) af[m] = *(const bf16x8*)(Wg + (wid * 32 + m * 16 + fr) * 128 + ks * 32 + fq * 8);
#pragma unroll
        for (int n = 0; n < 4; ++n) bfr[n] = *(const bf16x8*)(VnT + (n * 16 + fr) * 136 + ks * 32 + fq * 8);
#pragma unroll
        for (int m = 0; m < 2; ++m)
#pragma unroll
            for (int n = 0; n < 4; ++n) acc[m][n] = __builtin_amdgcn_mfma_f32_16x16x32_bf16(bfr[n], af[m], acc[m][n], 0, 0, 0);
    }
#pragma unroll
    for (int m = 0; m < 2; ++m) {
        const int pp = wid * 32 + m * 16 + fr; const float bs = p.gm_bs[l * 512 + g * 128 + pp];
#pragma unroll
        for (int n = 0; n < 4; ++n) { const int c = n * 16 + fq * 4;
            const u32x2 zw = *(const u32x2*)(p.Z + (size_t)(R0 + pp) * NIN + ZU + g * 64 + c);
            const float u0 = geluf_(lo_bf(zw.x)), u1 = geluf_(hi_bf(zw.x)), u2 = geluf_(lo_bf(zw.y)), u3 = geluf_(hi_bf(zw.y));
            u32x2 w; w.x = pack2(u0 * (acc[m][n][0] + bs), u1 * (acc[m][n][1] + bs)); w.y = pack2(u2 * (acc[m][n][2] + bs), u3 * (acc[m][n][3] + bs));
            *(u32x2*)(p.hbmix + (size_t)(R0 + pp) * DM + 768 + g * 64 + c) = w; }
    }
    __syncthreads();
}

__device__ __forceinline__ float swap16_add(float x) {
    auto r = __builtin_amdgcn_permlane16_swap(__float_as_uint(x), __float_as_uint(x), false, false);
    return __uint_as_float(r[0]) + __uint_as_float(r[1]);
}
#define NSCAN_LAT 256
#define NSCAN (256 + 1024)
__device__ __forceinline__ void scan_unit(const P& p, int l, int u, char* smem) {
    const int tid = opaque_tid(), lane = tid & 63, wid = tid >> 6;
    int b, T, row0; const bool lat = u < NSCAN_LAT;
    if (lat) { b = u >> 6; T = 4096; row0 = M_CTX + b * 4096; } else { b = (u - NSCAN_LAT) >> 6; T = 256; row0 = b * 256; }
    const int h = (u >> 4) & 3, d = (u >> 3) & 1, rsl = u & 7;
    float* W = (float*)smem; float* NKK = W + 2048; float* KKA = NKK + 2048; float* KD = KKA + 2048; float* RR = KD + 2048; float* VS = RR + 2048; float* OUTP = VS + 256;
    const int rl = lane >> 5, kq = lane & 31; const int r8 = wid * 2 + rl; const int row = rsl * 8 + r8;
    f32x2 S = (f32x2){0.f, 0.f};
    const size_t stoff = ((((size_t)b * 4 + l) * 2 + d) * 4 + h) * 4096 + row * 64 + kq * 2;
    if (lat) S = *(const f32x2*)(p.state_rwkv + stoff);
    const int tok = tid >> 3, cg8 = tid & 7;
    float kkp[8], kap[8];
#pragma unroll
    for (int i = 0; i < 8; ++i) { kkp[i] = p.rw_kk[l * 256 + h * 64 + cg8 * 8 + i]; kap[i] = p.rw_ka[l * 256 + h * 64 + cg8 * 8 + i]; }
    const int nch = T >> 5;
    u32x4 r8v, k8, e8, a8, v8;
    int grow, grow_prev = 0; float oreg = 0.f;
    {
        const int sidx = tok; const int t = d ? T - 1 - sidx : sidx; grow = row0 + t;
        r8v = *(const u32x4*)(p.RKV + (size_t)grow * 768 + h * 64 + cg8 * 8);
        k8 = *(const u32x4*)(p.RKV + (size_t)grow * 768 + 256 + h * 64 + cg8 * 8);
        v8 = *(const u32x4*)(p.RKV + (size_t)grow * 768 + 512 + h * 64 + rsl * 8);
        e8 = *(const u32x4*)(p.Ee + ((size_t)d * M_ALL + grow) * 256 + h * 64 + cg8 * 8);
        a8 = *(const u32x4*)(p.Aa + ((size_t)d * M_ALL + grow) * 256 + h * 64 + cg8 * 8);
    }
    for (int ch = 0; ch < nch; ++ch) {
        {
            float kf[8], kkv[8], rf[8], ef[8], af[8];
#pragma unroll
            for (int q = 0; q < 4; ++q) { kf[2 * q] = lo_bf(k8[q]); kf[2 * q + 1] = hi_bf(k8[q]); rf[2 * q] = lo_bf(r8v[q]); rf[2 * q + 1] = hi_bf(r8v[q]);
                ef[2 * q] = lo_bf(e8[q]); ef[2 * q + 1] = hi_bf(e8[q]); af[2 * q] = lo_bf(a8[q]); af[2 * q + 1] = hi_bf(a8[q]); }
            float ss = 0.f;
#pragma unroll
            for (int i = 0; i < 8; ++i) { kkv[i] = kf[i] * kkp[i]; ss += kkv[i] * kkv[i]; }
            ss = red8(ss);
            const float inv = rsqrtf(fmaxf(ss, 1e-24f));
            f32x4 o0, o1; const int base = tok * 64 + cg8 * 8;
#pragma unroll
            for (int i = 0; i < 4; ++i) { o0[i] = __expf(-ef[i]); o1[i] = __expf(-ef[4 + i]); }
            *(f32x4*)(W + base) = o0; *(f32x4*)(W + base + 4) = o1;
#pragma unroll
            for (int i = 0; i < 4; ++i) { o0[i] = -kkv[i] * inv; o1[i] = -kkv[4 + i] * inv; }
            *(f32x4*)(NKK + base) = o0; *(f32x4*)(NKK + base + 4) = o1;
#pragma unroll
            for (int i = 0; i < 4; ++i) { o0[i] = kkv[i] * inv * af[i]; o1[i] = kkv[4 + i] * inv * af[4 + i]; }
            *(f32x4*)(KKA + base) = o0; *(f32x4*)(KKA + base + 4) = o1;
#pragma unroll
            for (int i = 0; i < 4; ++i) { o0[i] = kf[i] * (1.0f + (af[i] - 1.0f) * kap[i]); o1[i] = kf[4 + i] * (1.0f + (af[4 + i] - 1.0f) * kap[4 + i]); }
            *(f32x4*)(KD + base) = o0; *(f32x4*)(KD + base + 4) = o1;
#pragma unroll
            for (int i = 0; i < 4; ++i) { o0[i] = rf[i]; o1[i] = rf[4 + i]; }
            *(f32x4*)(RR + base) = o0; *(f32x4*)(RR + base + 4) = o1;
            if (cg8 == 0) {
#pragma unroll
                for (int q = 0; q < 4; ++q) { VS[tok * 8 + 2 * q] = lo_bf(v8[q]); VS[tok * 8 + 2 * q + 1] = hi_bf(v8[q]); }
            }
        }
        __syncthreads();
        if (ch > 0) p.ydir[((size_t)d * M_ALL + grow_prev) * 256 + h * 64 + rsl * 8 + cg8] = oreg;
        grow_prev = grow;
        if (ch + 1 < nch) {
            const int sidx = (ch + 1) * 32 + tok; const int t = d ? T - 1 - sidx : sidx; grow = row0 + t;
            r8v = *(const u32x4*)(p.RKV + (size_t)grow * 768 + h * 64 + cg8 * 8);
            k8 = *(const u32x4*)(p.RKV + (size_t)grow * 768 + 256 + h * 64 + cg8 * 8);
            v8 = *(const u32x4*)(p.RKV + (size_t)grow * 768 + 512 + h * 64 + rsl * 8);
            e8 = *(const u32x4*)(p.Ee + ((size_t)d * M_ALL + grow) * 256 + h * 64 + cg8 * 8);
            a8 = *(const u32x4*)(p.Aa + ((size_t)d * M_ALL + grow) * 256 + h * 64 + cg8 * 8);
        }
        {
            const float* Wq = W + kq * 2; const float* NKq = NKK + kq * 2; const float* KAq = KKA + kq * 2; const float* KDq = KD + kq * 2; const float* RRq = RR + kq * 2; const float* VSq = VS + r8;
            float* OPq = OUTP + r8 * 32 + kq;
            f32x2 wv[4], nkv[4], kav[4], kdv[4], rrv[4]; float vv[4];
#define SCAN_LD(slot, st) do { wv[slot] = *(const f32x2*)(Wq + (st) * 64); nkv[slot] = *(const f32x2*)(NKq + (st) * 64); kav[slot] = *(const f32x2*)(KAq + (st) * 64); \
        kdv[slot] = *(const f32x2*)(KDq + (st) * 64); rrv[slot] = *(const f32x2*)(RRq + (st) * 64); vv[slot] = VSq[(st) * 8]; } while (0)
            __builtin_amdgcn_s_setprio(3);
            SCAN_LD(0, 0); SCAN_LD(1, 1); SCAN_LD(2, 2);
#pragma unroll
            for (int s = 0; s < 32; ++s) {
                if (s + 3 < 32) SCAN_LD((s + 3) & 3, s + 3);
                const f32x2 w = wv[s & 3], nk = nkv[s & 3], ka = kav[s & 3], kd = kdv[s & 3], rr = rrv[s & 3]; const float v = vv[s & 3];
                float pd = fmaf(S[1], nk[1], S[0] * nk[0]);
                pd = red16(pd); pd = swap16_add(pd);
                S[0] = fmaf(S[0], w[0], fmaf(pd, ka[0], v * kd[0]));
                S[1] = fmaf(S[1], w[1], fmaf(pd, ka[1], v * kd[1]));
                OPq[s * 256] = fmaf(S[1], rr[1], S[0] * rr[0]);
            }
            __builtin_amdgcn_s_setprio(0);
        }
        __syncthreads();
        {
            const float* op = OUTP + (tok * 8 + cg8) * 32;
            f32x4 a0 = *(const f32x4*)(op), a1 = *(const f32x4*)(op + 4), a2 = *(const f32x4*)(op + 8), a3 = *(const f32x4*)(op + 12);
            f32x4 b0 = *(const f32x4*)(op + 16), b1 = *(const f32x4*)(op + 20), b2 = *(const f32x4*)(op + 24), b3 = *(const f32x4*)(op + 28);
            a0 = ((a0 + a1) + (a2 + a3)) + ((b0 + b1) + (b2 + b3));
            oreg = (a0[0] + a0[1]) + (a0[2] + a0[3]);
        }
    }
    p.ydir[((size_t)d * M_ALL + grow_prev) * 256 + h * 64 + rsl * 8 + cg8] = oreg;
    if (!lat) *(f32x2*)(p.out + 20971520 + 2097152 + 524288 + stoff) = S;
    __syncthreads();
}

#define KS_STRIDE 104
#define VS_STRIDE 68
#define KS_BYTES (64 * KS_STRIDE * 2)
#define ATT_STAGE (KS_BYTES + 64 * VS_STRIDE * 2)
__device__ __forceinline__ void attn_unit(const P& p, int u, char* smem) {
    const int tid = opaque_tid(), lane = tid & 63, wid = tid >> 6, q = lane & 31, hf = lane >> 5;
    int b, h, qt, qrow0, krow0, nown, ntot, Tv; size_t vbase, vcbase = 0; int kcrow0 = 0;
    if (u < 1024) { b = u >> 8; h = (u >> 5) & 7; qt = u & 31; krow0 = M_CTX + b * 4096; qrow0 = krow0 + qt * 128; nown = 64; ntot = 72; Tv = 4096;
        vbase = 2097152 + (size_t)(b * 8 + h) * 64 * 4096; kcrow0 = b * 512; vcbase = (size_t)(b * 8 + h) * 64 * 512; }
    else { const int v = u - 1024; b = v >> 4; h = (v >> 1) & 7; qt = v & 1; krow0 = b * 256; qrow0 = krow0 + qt * 128; nown = 4; ntot = 4; Tv = 256; vbase = (size_t)(b * 8 + h) * 64 * 256; }
    bf16x8 qf[6];
    { const bf16_t* qp = p.Qb + (size_t)(qrow0 + wid * 32 + q) * 768 + h * 96 + hf * 8;
#pragma unroll
      for (int ks = 0; ks < 6; ++ks) qf[ks] = *(const bf16x8*)(qp + ks * 16); }
    f32x16 oT[2];
#pragma unroll
    for (int i = 0; i < 16; ++i) { oT[0][i] = 0.f; oT[1][i] = 0.f; }
    float mrun = -1e30f, lrun = 0.f;
    u32x4 rk[3], rv[2];
    int krow[3], kc[3];
#pragma unroll
    for (int i = 0; i < 3; ++i) { const int c = tid + 256 * i; krow[i] = c / 12; kc[i] = c % 12; }
    const int vdv0 = tid >> 3, vkc = tid & 7;
#define ATT_LOAD(kt) do { const bf16_t* kptr; const bf16_t* vptr; int vstr; \
        if ((kt) < nown) { kptr = p.Kb + (size_t)(krow0 + (kt) * 64) * 768 + h * 96; vptr = p.Vt + vbase + (kt) * 64; vstr = Tv; } \
        else { kptr = p.Kc + (size_t)(kcrow0 + ((kt) - nown) * 64) * 768 + h * 96; vptr = p.Vtc + vcbase + ((kt) - nown) * 64; vstr = 512; } \
        _Pragma("unroll") for (int i = 0; i < 3; ++i) rk[i] = *(const u32x4*)(kptr + (size_t)krow[i] * 768 + kc[i] * 8); \
        _Pragma("unroll") for (int i = 0; i < 2; ++i) rv[i] = *(const u32x4*)(vptr + (size_t)(vdv0 + 32 * i) * vstr + vkc * 8); } while (0)
#define ATT_STORE(buf) do { char* Ks_ = smem + (buf) * ATT_STAGE; char* Vs_ = Ks_ + KS_BYTES; \
        _Pragma("unroll") for (int i = 0; i < 3; ++i) *(u32x4*)(Ks_ + (krow[i] * KS_STRIDE + kc[i] * 8) * 2) = rk[i]; \
        _Pragma("unroll") for (int i = 0; i < 2; ++i) { char* vd_ = Vs_ + ((vdv0 + 32 * i) * VS_STRIDE + vkc * 8) * 2; *(u32x2*)vd_ = (u32x2){rv[i].x, rv[i].y}; *(u32x2*)(vd_ + 8) = (u32x2){rv[i].z, rv[i].w}; } } while (0)
    ATT_LOAD(0); ATT_STORE(0);
    __syncthreads();
    for (int kt = 0; kt < ntot; ++kt) {
        const bool more = kt + 1 < ntot;
        if (more) ATT_LOAD(kt + 1);
        const char* Ks = smem + (kt & 1) * ATT_STAGE; const char* Vs = Ks + KS_BYTES;
        f32x16 sT[2];
#pragma unroll
        for (int i = 0; i < 16; ++i) { sT[0][i] = 0.f; sT[1][i] = 0.f; }
#pragma unroll
        for (int kb = 0; kb < 2; ++kb)
#pragma unroll
            for (int ks = 0; ks < 6; ++ks) { const bf16x8 kf = *(const bf16x8*)(Ks + ((kb * 32 + q) * KS_STRIDE + ks * 16 + hf * 8) * 2);
                sT[kb] = __builtin_amdgcn_mfma_f32_32x32x16_bf16(kf, qf[ks], sT[kb], 0, 0, 0); }
        float mx = sT[0][0];
#pragma unroll
        for (int i = 1; i < 16; ++i) mx = fmaxf(mx, sT[0][i]);
#pragma unroll
        for (int i = 0; i < 16; ++i) mx = fmaxf(mx, sT[1][i]);
        mx = fmaxf(mx, __shfl_xor(mx, 32));
        const float mnew = fmaxf(mrun, mx); const float alpha = __builtin_amdgcn_exp2f(mrun - mnew); const bool resc = __any(mnew > mrun); mrun = mnew;
        float psum = 0.f; bf16x8 pf[2][2];
#pragma unroll
        for (int kb = 0; kb < 2; ++kb)
#pragma unroll
            for (int s = 0; s < 2; ++s) { float e[8];
#pragma unroll
                for (int j = 0; j < 8; ++j) { e[j] = __builtin_amdgcn_exp2f(sT[kb][8 * s + j] - mnew); psum += e[j]; }
                u32x4 w; w.x = pack2(e[0], e[1]); w.y = pack2(e[2], e[3]); w.z = pack2(e[4], e[5]); w.w = pack2(e[6], e[7]);
                pf[kb][s] = __builtin_bit_cast(bf16x8, w); }
        lrun = lrun * alpha + psum;
        if (resc) {
#pragma unroll
            for (int i = 0; i < 16; ++i) { oT[0][i] *= alpha; oT[1][i] *= alpha; }
        }
#pragma unroll
        for (int kb = 0; kb < 2; ++kb)
#pragma unroll
            for (int s = 0; s < 2; ++s)
#pragma unroll
                for (int db = 0; db < 2; ++db) {
                    const char* vp = Vs + ((db * 32 + q) * VS_STRIDE + kb * 32 + 16 * s + 4 * hf) * 2;
                    const u32x2 lo = *(const u32x2*)vp, hi = *(const u32x2*)(vp + 16);
                    const u32x4 w = (u32x4){lo.x, lo.y, hi.x, hi.y};
                    oT[db] = __builtin_amdgcn_mfma_f32_32x32x16_bf16(__builtin_bit_cast(bf16x8, w), pf[kb][s], oT[db], 0, 0, 0);
                }
        if (more) ATT_STORE((kt + 1) & 1);
        __syncthreads();
    }
    const float lt = lrun + __shfl_xor(lrun, 32); const float inv = 1.0f / lt;
    bf16_t* op = p.hbmix + (size_t)(qrow0 + wid * 32 + q) * DM + 256 + h * 64;
#pragma unroll
    for (int db = 0; db < 2; ++db)
#pragma unroll
        for (int g = 0; g < 4; ++g) { u32x2 w; w.x = pack2(oT[db][4 * g] * inv, oT[db][4 * g + 1] * inv); w.y = pack2(oT[db][4 * g + 2] * inv, oT[db][4 * g + 3] * inv);
            *(u32x2*)(op + db * 32 + 8 * g + 4 * hf) = w; }
}

__device__ __forceinline__ void rwcomb_phase(const P& p, int l) {
    const int tid = opaque_tid(), lane = tid & 63, wid = tid >> 6; const int c = lane * 4;
    const f32x4 gng = *(const f32x4*)(p.rw_gn_g + l * 256 + c), gnb = *(const f32x4*)(p.rw_gn_b + l * 256 + c), kap = *(const f32x4*)(p.rw_ka + l * 256 + c), rkp = *(const f32x4*)(p.rw_rk + l * 256 + c);
    for (int row = blockIdx.x * 4 + wid; row < M_ALL; row += gridDim.x * 4) {
        const f32x4 y0 = *(const f32x4*)(p.ydir + (size_t)row * 256 + c), y1 = *(const f32x4*)(p.ydir + ((size_t)M_ALL + row) * 256 + c);
        f32x4 y = y0 + y1;
        float s = (y[0] + y[1]) + (y[2] + y[3]); s = red16(s); const float mu = s * (1.0f / 64.0f);
        const f32x4 dd = y - mu; float q2 = (dd[0] * dd[0] + dd[1] * dd[1]) + (dd[2] * dd[2] + dd[3] * dd[3]); q2 = red16(q2);
        const float rstd = rsqrtf(q2 * (1.0f / 64.0f) + 64e-5f);
        const f32x4 yn = dd * rstd * gng + gnb;
        const u32x2 rw = *(const u32x2*)(p.RKV + (size_t)row * 768 + c), kw = *(const u32x2*)(p.RKV + (size_t)row * 768 + 256 + c), vw = *(const u32x2*)(p.RKV + (size_t)row * 768 + 512 + c);
        const u32x2 a0w = *(const u32x2*)(p.Aa + (size_t)row * 256 + c), a1w = *(const u32x2*)(p.Aa + ((size_t)M_ALL + row) * 256 + c), gw = *(const u32x2*)(p.Gg + (size_t)row * 256 + c);
        const f32x4 r = (f32x4){lo_bf(rw.x), hi_bf(rw.x), lo_bf(rw.y), hi_bf(rw.y)}, k = (f32x4){lo_bf(kw.x), hi_bf(kw.x), lo_bf(kw.y), hi_bf(kw.y)}, v = (f32x4){lo_bf(vw.x), hi_bf(vw.x), lo_bf(vw.y), hi_bf(vw.y)};
        const f32x4 a0 = (f32x4){lo_bf(a0w.x), hi_bf(a0w.x), lo_bf(a0w.y), hi_bf(a0w.y)}, a1 = (f32x4){lo_bf(a1w.x), hi_bf(a1w.x), lo_bf(a1w.y), hi_bf(a1w.y)}, gt = (f32x4){lo_bf(gw.x), hi_bf(gw.x), lo_bf(gw.y), hi_bf(gw.y)};
        const f32x4 kds = k * (1.0f + (a0 - 1.0f) * kap) + k * (1.0f + (a1 - 1.0f) * kap);
        const f32x4 t4 = r * kds * rkp; float rk = (t4[0] + t4[1]) + (t4[2] + t4[3]); rk = red16(rk);
        const f32x4 o = (yn + rk * v) * gt;
        u32x2 w; w.x = pack2(o[0], o[1]); w.y = pack2(o[2], o[3]);
        *(u32x2*)(p.hbmix + (size_t)row * DM + c) = w;
    }
}


__device__ __forceinline__ bool xcd_tile(int i, int TT, int NT, int& mt, int& nt) {
    const int per = TT >> 3; if (i >= per) return false;
    const int t = (blockIdx.x & 7) * per + i; const int band = t / (8 * NT), rem = t - band * 8 * NT;
    nt = rem >> 3; mt = band * 8 + (rem & 7); return true;
}
__global__ void __launch_bounds__(256, 2) mega(Args a_unused) {
    extern __shared__ __attribute__((aligned(16))) char smem[];
    __shared__ uint4 xbw; __shared__ int s_unit;
    kargp_t kp = (kargp_t)__builtin_amdgcn_kernarg_segment_ptr();
    const int tid = threadIdx.x; const int G = gridDim.x;
    if (tid == 0) xbw = make_uint4(0u, 0u, 0u, 0u);
    __syncthreads();
    XcdBarrier xb;
    { const P p = getP(kp); xb = xcd_barrier_post(p.bar, (volatile LAS unsigned*)&xbw); }
    for (int u = blockIdx.x; u < 384 + NCONV + 272; u += G) {
        if (u < 384) { const P p = getP(kp); ada_unit(p, u, smem); } else if (u < 384 + NCONV) { const P p = getP(kp); conv_unit(p, 0, u - 384, smem); } else { const P p = getP(kp); misc0_unit(p, u - 384 - NCONV); }
    }
    cg::this_grid().sync();
    { const P p = getP(kp); ln_phase(p, 0, 0); }
    xcd_barrier(xb);
    float* rs = (float*)(smem + RS_OFF);
#pragma unroll 1
    for (int l = 0; l < 4; ++l) {
        for (int i = blockIdx.x >> 3; ; i += G >> 3) { int mt, nt; if (!xcd_tile(i, 80 * 17, 17, mt, nt)) break; const P p = getP(kp);
            EpiZ e{p.Z, mt * 256, nt * 128};
            gemm256(p.hbmix + (size_t)mt * 256 * DM, DM, p.WtIn + (size_t)nt * 128 * DM, DM, DM, smem, e); }
        xcd_barrier(xb);
        for (int rep2 = 0; rep2 < DUP_P2; ++rep2) {
        for (;;) {
            { const P pc = getP(kp); if (tid == 0) s_unit = atomicAdd(&pc.ctr[l * 4 + 0 + 2 * rep2], 1); }
            __syncthreads(); int u = s_unit; __syncthreads();
            if (u >= 320 + 480 + 640 + 64 + 352 + 640) break;
            if (u < 320) { const P p = getP(kp); rwprep_unit(p, l, u, smem); continue; }
            u -= 320;
            if (u < 480) { const P p = getP(kp); const int mt = u / 3, np = u % 3;
                rowscale128(p.Z, mt * 128, ZQ, 256, 1e-6f, rs);
                for (int k2 = 0; k2 < 2; ++k2) { const int nt = np * 2 + k2;
                    EpiQ e{p.Qb, rs, p.ropeC, p.ropeS, mt * 128, nt * 128};
                    gemm128<true>(p.Z + (size_t)mt * 128 * NIN + ZQ, NIN, p.WtQ + (size_t)nt * 128 * 256, 256, 256, smem, e); }
                __syncthreads(); continue; }
            u -= 480;
            if (u < 640) { const P p = getP(kp); const int mt = u >> 2, np = u & 3; const int R0 = mt * 128; const bool latr = R0 >= M_CTX;
                rowscale128(p.Z, R0, ZKV, 128, 1e-6f, rs);
                for (int k2 = 0; k2 < 2; ++k2) { const int nt = np * 2 + k2;
                    if (np < 2) { EpiKN e{latr ? p.Kb + (size_t)M_CTX * 768 : p.Kb, rs, latr ? R0 - M_CTX : R0, nt * 128};
                        gemm128<true>(p.Z + (size_t)R0 * NIN + ZKV, NIN, p.WtKVn + (size_t)nt * 128 * 128, 128, 128, smem, e); }
                    else { EpiKV e{latr ? p.Kb + (size_t)M_CTX * 768 : p.Kb, p.Vt, rs, latr ? R0 - M_CTX : R0, nt * 128, latr ? 12 : 8, latr ? (size_t)2097152 : (size_t)0};
                        gemm128<false>(p.Z + (size_t)R0 * NIN + ZKV, NIN, p.WtKVn + (size_t)nt * 128 * 128, 128, 128, smem, e); } }
                __syncthreads(); continue; }
            u -= 640;
            if (u < 64) { const P p = getP(kp); const int mt = u >> 2, np = u & 3;
                for (int k2 = 0; k2 < 2; ++k2) { const int nt = np * 2 + k2;
                    if (np < 2) { EpiKN e{p.Kc, nullptr, mt * 128, nt * 128};
                        gemm128<true>(p.CkvB + ((size_t)l * 2048 + mt * 128) * 128, 128, p.WtKV + (size_t)nt * 128 * 128, 128, 128, smem, e); }
                    else { EpiKV e{p.Kc, p.Vtc, nullptr, mt * 128, nt * 128, 9, (size_t)0};
                        gemm128<false>(p.CkvB + ((size_t)l * 2048 + mt * 128) * 128, 128, p.WtKV + (size_t)nt * 128 * 128, 128, 128, smem, e); } }
                continue; }
            u -= 64;
            if (u < 352) { const P p = getP(kp); for (int i = 0; i < 8; ++i) small_unit(p, l, u * 8 + i); continue; }
            u -= 352;
            { const P p = getP(kp); gmlp_unit(p, l, u, smem); }
        }
        xcd_barrier(xb);
        }
        for (int rep3 = 0; rep3 < DUP_P3; ++rep3) {
        for (;;) {
            { const P pc = getP(kp); if (tid == 0) s_unit = atomicAdd(&pc.ctr[l * 4 + 1 + 2 * rep3], 1); }
            __syncthreads(); int u = s_unit; __syncthreads();
            if (u >= NSCAN + 1280) break;
#ifdef PROBE_SCAN_ONLY
            if (rep3 == 1 && u >= NSCAN) break;
#endif
#ifdef PROBE_ATTN_ONLY
            if (rep3 == 1 && u < NSCAN) continue;
#endif
            if (u < NSCAN) { const P p = getP(kp); scan_unit(p, l, u, smem); } else { const P p = getP(kp); attn_unit(p, u - NSCAN, smem); }
        }
        xcd_barrier(xb);
        }
        { const P p = getP(kp); rwcomb_phase(p, l); }
        xcd_barrier(xb);
        for (int i = blockIdx.x >> 3; ; i += G >> 3) { int mt, nt; if (!xcd_tile(i, 160 * 8, 8, mt, nt)) break; const P p = getP(kp);
            EpiRes e{p.out, p.mod + ((size_t)l * 5 + modrow_of(mt * 128)) * 6144 + 2048, mt * 128, nt * 128};
            gemm128<true>(p.hbmix + (size_t)mt * 128 * DM, DM, p.WtOut + (size_t)nt * 128 * DM, DM, DM, smem, e); }
        xcd_barrier(xb);
        { const P p = getP(kp); ln_phase(p, l, 1); }
        xcd_barrier(xb);
        for (int rep5 = 0; rep5 < DUP_P5; ++rep5)
        for (int i = blockIdx.x >> 3; ; i += G >> 3) { int mt, nt; if (!xcd_tile(i, 80 * 44, 44, mt, nt)) break; const P p = getP(kp);
            EpiSwi e{p.hidden, mt * 256, nt * 128};
            gemm256(p.hbmix + (size_t)mt * 256 * DM, DM, p.WtF1 + (size_t)nt * 128 * DM, DM, DM, smem, e); }
        xcd_barrier(xb);
        for (int i = blockIdx.x >> 3; ; i += G >> 3) { int mt, nt; if (!xcd_tile(i, 160 * 8, 8, mt, nt)) break; const P p = getP(kp);
            EpiRes e{p.out, p.mod + ((size_t)l * 5 + modrow_of(mt * 128)) * 6144 + 5120, mt * 128, nt * 128};
            gemm128<true>(p.hidden + (size_t)mt * 128 * DFF, DFF, p.WtF2 + (size_t)nt * 128 * DFF, DFF, DFF, smem, e); }
        xcd_barrier(xb);
        { const P p = getP(kp); ln_phase(p, l, 2); }
        if (l < 3) { for (int u = blockIdx.x; u < NCONV; u += G) { const P p = getP(kp); conv_unit(p, l + 1, u, smem); } }
        xcd_barrier(xb);
    }
}

extern "C" void kernel_launch(void* const* d_in, const int* in_sizes, int n_in, void* d_out, int out_size, void* d_ws, size_t ws_size, hipStream_t stream) {
    static int grid_blocks = 0;
    if (!grid_blocks) {
        int dev = 0, cus = 0, per_cu = 0;
        (void)hipGetDevice(&dev);
        (void)hipDeviceGetAttribute(&cus, hipDeviceAttributeMultiprocessorCount, dev);
        (void)hipFuncSetAttribute((const void*)mega, hipFuncAttributeMaxDynamicSharedMemorySize, SMEM_BYTES);
        (void)hipOccupancyMaxActiveBlocksPerMultiprocessor(&per_cu, (const void*)mega, 256, SMEM_BYTES);
        if (per_cu > 2) per_cu = 2;
        if (per_cu < 1) per_cu = 1;
        grid_blocks = (cus * per_cu) & ~7;
    }
    if (WS_TOTAL > ws_size) { fprintf(stderr, "kernel_launch: workspace too small: need %zu have %zu\n", (size_t)WS_TOTAL, ws_size); return; }
    Args a{};
    for (int i = 0; i < 36; ++i) a.in[i] = (const float*)d_in[i];
    a.out = (float*)d_out; a.ws = (char*)d_ws;
    (void)hipMemsetAsync((char*)d_ws + OFF_BAR, 0, 16384 + 4096, stream);
    void* args[] = {&a};
    hipError_t e = hipLaunchCooperativeKernel((const void*)mega, dim3(grid_blocks), dim3(256), args, SMEM_BYTES, stream);
    if (e != hipSuccess) fprintf(stderr, "cooperative launch failed: %s (grid %d)\n", hipGetErrorString(e), grid_blocks);
}
```

```cpp
#include <hip/hip_runtime.h>
#include <hip/hip_cooperative_groups.h>
#include <cstdint>
#include <cstdio>
namespace cg = cooperative_groups;

typedef unsigned short bf16_t;
typedef short bf16x8 __attribute__((ext_vector_type(8)));
typedef float f32x4 __attribute__((ext_vector_type(4)));
typedef float f32x2 __attribute__((ext_vector_type(2)));
typedef float f32x16 __attribute__((ext_vector_type(16)));
typedef unsigned u32x4 __attribute__((ext_vector_type(4)));
typedef unsigned u32x2 __attribute__((ext_vector_type(2)));

#define M_ALL 20480
#define M_CTX 4096
#define DM 1024
#define NIN 2080
#define DFF 2816
#define ALPHA_F 1.6817928305074290f
#define QSCALE (0.10206207261596575f * 1.4426950408889634f)
#define LAS __attribute__((address_space(3)))
#ifndef DUP_P2
#define DUP_P2 1
#endif
#ifndef DUP_P3
#define DUP_P3 1
#endif
#ifndef DUP_P5
#define DUP_P5 1
#endif

#define ZQ 1152
#define ZKV 1408
#define ZKR 1536
#define ZU 1568
#define ZV 1824

#define LDS_STRIDE 72
#define TILE_BYTES (128 * LDS_STRIDE * 2)
#define RS_OFF (4 * TILE_BYTES)
#define SMEM_BYTES (RS_OFF + 3072)

struct P {
    const float *x_prompt, *x_sample, *cache_ckv, *cache_krope, *state_rwkv, *c, *c_ctx, *ada_w, *ada_b, *w_in, *rw_conv, *rw_w0, *rw_w2,
        *rw_a0, *rw_a2, *rw_g2, *rw_kk, *rw_ka, *rw_rk, *rw_gn_g, *rw_gn_b, *q_norm, *q_up, *kv_norm, *kv_up, *gm_g, *gm_b, *gm_ws, *gm_bs,
        *w_out, *ln1_g, *ln1_b, *ffn_in, *ffn_out, *ln2_g, *ln2_b;
    float* out;
    unsigned* bar; int* ctr; float* mod; float* ropeC; float* ropeS; bf16_t* CkvB;
    bf16_t *WtIn, *WtQ, *WtKVn, *WtKV, *WtOut, *WtF1, *WtF2, *WsB, *W2t, *A2t, *G2t;
    bf16_t *Z, *RKV, *Ee, *Aa, *Gg, *Qb, *Kb, *Kc, *Vt, *Vtc, *hbmix, *hidden;
    float* ydir;
};


struct Args { const float* in[36]; float* out; char* ws; };
typedef const __attribute__((address_space(4))) char* kargp_t;
constexpr size_t al256(size_t x) { return (x + 255) & ~(size_t)255; }
constexpr size_t OFF_BAR = 0;
constexpr size_t OFF_CTR = OFF_BAR + 16384;
constexpr size_t OFF_MOD = OFF_CTR + 4096;
constexpr size_t OFF_ROPEC = OFF_MOD + al256((size_t)4 * 5 * 6144 * 4);
constexpr size_t OFF_ROPES = OFF_ROPEC + 65536 * 4;
constexpr size_t OFF_CKVB = OFF_ROPES + 65536 * 4;
constexpr size_t OFF_WTIN = OFF_CKVB + (size_t)4 * 2048 * 128 * 2;
constexpr size_t OFF_WTQ = OFF_WTIN + (size_t)2176 * 1024 * 2;
constexpr size_t OFF_WTKVN = OFF_WTQ + (size_t)768 * 256 * 2;
constexpr size_t OFF_WTKV = OFF_WTKVN + (size_t)1024 * 128 * 2;
constexpr size_t OFF_WTOUT = OFF_WTKV + (size_t)1024 * 128 * 2;
constexpr size_t OFF_WTF1 = OFF_WTOUT + (size_t)1024 * 1024 * 2;
constexpr size_t OFF_WTF2 = OFF_WTF1 + (size_t)5632 * 1024 * 2;
constexpr size_t OFF_WSB = OFF_WTF2 + (size_t)1024 * DFF * 2;
constexpr size_t OFF_W2T = OFF_WSB + (size_t)65536 * 2;
constexpr size_t OFF_A2T = OFF_W2T + (size_t)2 * 256 * 64 * 2;
constexpr size_t OFF_G2T = OFF_A2T + (size_t)2 * 256 * 64 * 2;
constexpr size_t OFF_Z = OFF_G2T + (size_t)256 * 128 * 2;
constexpr size_t OFF_HIDDEN = OFF_Z;
constexpr size_t OFF_RKV = OFF_Z + al256((size_t)M_ALL * NIN * 2);
constexpr size_t OFF_EE = OFF_RKV + (size_t)M_ALL * 768 * 2;
constexpr size_t OFF_AA = OFF_EE + (size_t)2 * M_ALL * 256 * 2;
constexpr size_t OFF_GG = OFF_AA + (size_t)2 * M_ALL * 256 * 2;
constexpr size_t OFF_QB = OFF_GG + (size_t)M_ALL * 256 * 2;
constexpr size_t OFF_KB = OFF_QB + (size_t)M_ALL * 768 * 2;
constexpr size_t OFF_KC = OFF_KB + (size_t)M_ALL * 768 * 2;
constexpr size_t OFF_VT = OFF_KC + (size_t)2048 * 768 * 2;
constexpr size_t OFF_VTC = OFF_VT + (size_t)M_ALL * 512 * 2;
constexpr size_t OFF_YDIR = OFF_VTC + (size_t)2048 * 512 * 2;
constexpr size_t OFF_HBMIX = OFF_YDIR + (size_t)2 * M_ALL * 256 * 4;
constexpr size_t WS_TOTAL = OFF_HBMIX + (size_t)M_ALL * DM * 2;
static_assert(OFF_RKV + (size_t)M_ALL * 768 * 2 - OFF_HIDDEN >= (size_t)M_ALL * DFF * 2, "hidden overlay");

__device__ __forceinline__ P getP(kargp_t& kp) {
    asm volatile("" : "+s"(kp));
    typedef const float* const __attribute__((address_space(4)))* inp_t;
    inp_t in = (inp_t)kp;
    P p;
    p.x_prompt = in[0]; p.x_sample = in[1]; p.cache_ckv = in[2]; p.cache_krope = in[3]; p.state_rwkv = in[4]; p.c = in[5]; p.c_ctx = in[6];
    p.ada_w = in[7]; p.ada_b = in[8]; p.w_in = in[9]; p.rw_conv = in[10]; p.rw_w0 = in[11]; p.rw_w2 = in[12]; p.rw_a0 = in[13]; p.rw_a2 = in[14];
    p.rw_g2 = in[15]; p.rw_kk = in[16]; p.rw_ka = in[17]; p.rw_rk = in[18]; p.rw_gn_g = in[19]; p.rw_gn_b = in[20]; p.q_norm = in[21]; p.q_up = in[22];
    p.kv_norm = in[23]; p.kv_up = in[24]; p.gm_g = in[25]; p.gm_b = in[26]; p.gm_ws = in[27]; p.gm_bs = in[28]; p.w_out = in[29]; p.ln1_g = in[30];
    p.ln1_b = in[31]; p.ffn_in = in[32]; p.ffn_out = in[33]; p.ln2_g = in[34]; p.ln2_b = in[35];
    p.out = (float*)in[36]; char* ws = (char*)in[37];
    p.bar = (unsigned*)(ws + OFF_BAR); p.ctr = (int*)(ws + OFF_CTR); p.mod = (float*)(ws + OFF_MOD); p.ropeC = (float*)(ws + OFF_ROPEC); p.ropeS = (float*)(ws + OFF_ROPES);
    p.CkvB = (bf16_t*)(ws + OFF_CKVB); p.WtIn = (bf16_t*)(ws + OFF_WTIN); p.WtQ = (bf16_t*)(ws + OFF_WTQ); p.WtKVn = (bf16_t*)(ws + OFF_WTKVN); p.WtKV = (bf16_t*)(ws + OFF_WTKV);
    p.WtOut = (bf16_t*)(ws + OFF_WTOUT); p.WtF1 = (bf16_t*)(ws + OFF_WTF1); p.WtF2 = (bf16_t*)(ws + OFF_WTF2); p.WsB = (bf16_t*)(ws + OFF_WSB); p.W2t = (bf16_t*)(ws + OFF_W2T);
    p.A2t = (bf16_t*)(ws + OFF_A2T); p.G2t = (bf16_t*)(ws + OFF_G2T); p.Z = (bf16_t*)(ws + OFF_Z); p.RKV = (bf16_t*)(ws + OFF_RKV); p.Ee = (bf16_t*)(ws + OFF_EE); p.Aa = (bf16_t*)(ws + OFF_AA);
    p.Gg = (bf16_t*)(ws + OFF_GG); p.Qb = (bf16_t*)(ws + OFF_QB); p.Kb = (bf16_t*)(ws + OFF_KB); p.Kc = (bf16_t*)(ws + OFF_KC); p.Vt = (bf16_t*)(ws + OFF_VT); p.Vtc = (bf16_t*)(ws + OFF_VTC);
    p.hbmix = (bf16_t*)(ws + OFF_HBMIX); p.hidden = (bf16_t*)(ws + OFF_HIDDEN); p.ydir = (float*)(ws + OFF_YDIR);
    return p;
}

__device__ __forceinline__ float bf2f(bf16_t b) { return __uint_as_float(((unsigned)b) << 16); }
__device__ __forceinline__ unsigned pack2(float lo, float hi) { unsigned r; asm("v_cvt_pk_bf16_f32 %0, %1, %2" : "=v"(r) : "v"(lo), "v"(hi)); return r; }
__device__ __forceinline__ bf16_t f2bf(float f) { return (bf16_t)(pack2(f, 0.f) & 0xffffu); }
__device__ __forceinline__ float lo_bf(unsigned w) { return __uint_as_float(w << 16); }
__device__ __forceinline__ float hi_bf(unsigned w) { return __uint_as_float(w & 0xffff0000u); }
__device__ __forceinline__ float sigmoidf_(float x) { return __builtin_amdgcn_rcpf(1.0f + __builtin_amdgcn_exp2f(-1.4426950408889634f * x)); }
__device__ __forceinline__ float tanhf_(float x) { float e = __builtin_amdgcn_exp2f(2.8853900817779268f * x); return 1.0f - 2.0f * __builtin_amdgcn_rcpf(e + 1.0f); }
__device__ __forceinline__ float geluf_(float x) { return 0.5f * x * (1.0f + tanhf_(0.7978845608028654f * (x + 0.044715f * x * x * x))); }
template <int CTRL> __device__ __forceinline__ float dpp_add(float x) {
    int y = __builtin_amdgcn_update_dpp(0, __float_as_int(x), CTRL, 0xf, 0xf, false);
    return x + __int_as_float(y);
}
__device__ __forceinline__ float red4(float x) { x = dpp_add<0xB1>(x); x = dpp_add<0x4E>(x); return x; }
__device__ __forceinline__ float red8(float x) { x = red4(x); x = dpp_add<0x141>(x); return x; }
__device__ __forceinline__ float red16(float x) { x = red8(x); x = dpp_add<0x140>(x); return x; }
__device__ __forceinline__ int opaque_tid() { int t = threadIdx.x; asm volatile("" : "+v"(t)); return t; }
__device__ __forceinline__ int modrow_of(int row) { return row < M_CTX ? 0 : 1 + ((row - M_CTX) >> 12); }

#define XB_TMO 128
#define XB_XCNT(j) (256 + 64 * (j))
#define XB_XSUB(j) (1280 + 64 * (j))
#define XB_XGEN(j) (2304 + 64 * (j))
#define XB_TOP 3328
#define XB_TOPGEN 3392
#define XCD_BAR_WORDS 3456
#define XB_SPIN_CAP (1u << 22)
__device__ __forceinline__ unsigned xb_ld(unsigned* p) { return __hip_atomic_load(p, __ATOMIC_RELAXED, __HIP_MEMORY_SCOPE_AGENT); }
__device__ __forceinline__ unsigned xb_add(unsigned* p, unsigned v) { return __hip_atomic_fetch_add(p, v, __ATOMIC_RELAXED, __HIP_MEMORY_SCOPE_AGENT); }
__device__ __forceinline__ unsigned xb_xcc_id() { return (unsigned)__builtin_amdgcn_s_getreg((3 << 11) | 20) & 0xFu; }
#define XB_SPIN(cond, bar) do { unsigned _sp = 0; while (cond) { __builtin_amdgcn_s_sleep(1); \
    if ((++_sp & 255u) == 0u) { if (xb_ld(&(bar)[XB_TMO])) break; if (_sp > XB_SPIN_CAP) { atomicAdd(&(bar)[XB_TMO], 1u); break; } } } } while (0)
struct XcdBarrier { unsigned* bar; unsigned x; volatile LAS unsigned* st; };
__device__ __forceinline__ XcdBarrier xcd_barrier_post(unsigned* bar, volatile LAS unsigned* st) {
    XcdBarrier b; b.bar = bar; b.x = xb_xcc_id(); b.st = st;
    if (threadIdx.x == 0) (void)xb_add(&bar[XB_XCNT(b.x)], 1u);
    return b;
}
__device__ __forceinline__ void xcd_barrier_complete(unsigned* bar, unsigned x, unsigned& nloc, unsigned& nx) {
    const unsigned G = gridDim.x * gridDim.y * gridDim.z;
    unsigned sum, cnt, mine, sp = 0u;
    for (;;) {
        sum = 0u; cnt = 0u; mine = 0u;
#pragma unroll
        for (unsigned j = 0; j < 16; ++j) { const unsigned c = xb_ld(&bar[XB_XCNT(j)]); sum += c; cnt += (c > 0u) ? 1u : 0u; mine = (j == x) ? c : mine; }
        if (sum == G) break;
        __builtin_amdgcn_s_sleep(1);
        if ((++sp & 255u) == 0u) { if (xb_ld(&bar[XB_TMO])) break; if (sp > XB_SPIN_CAP) { atomicAdd(&bar[XB_TMO], 1u); break; } }
    }
    nloc = mine > 0u ? mine : 1u; nx = cnt > 0u ? cnt : 1u;
}
__device__ __forceinline__ void xcd_barrier(const XcdBarrier& b) {
    asm volatile("s_waitcnt vmcnt(0)" ::: "memory");
    __syncthreads();
    if (threadIdx.x == 0) {
        unsigned* bar = b.bar;
        __builtin_amdgcn_s_waitcnt(0);
        unsigned nloc = b.st[0], nx = b.st[1];
        if (nloc == 0u) { xcd_barrier_complete(bar, b.x, nloc, nx); b.st[0] = nloc; b.st[1] = nx; }
        const unsigned old = xb_add(&bar[XB_XSUB(b.x)], 1u);
        const unsigned gen = old / nloc;
        if (old + 1u == (gen + 1u) * nloc) {
            __builtin_amdgcn_fence(__ATOMIC_RELEASE, "agent");
            asm volatile("s_waitcnt vmcnt(0)" ::: "memory");
            const unsigned og = xb_add(&bar[XB_TOP], 1u);
            const unsigned tg = og / nx;
            if (og + 1u == (tg + 1u) * nx) xb_add(&bar[XB_TOPGEN], 1u);
            else XB_SPIN(xb_ld(&bar[XB_TOPGEN]) == tg, bar);
            __builtin_amdgcn_fence(__ATOMIC_ACQUIRE, "agent");
            xb_add(&bar[XB_XGEN(b.x)], 1u);
            asm volatile("s_waitcnt vmcnt(0)" ::: "memory");
        } else {
            XB_SPIN(xb_ld(&bar[XB_XGEN(b.x)]) == gen, bar);
            __builtin_amdgcn_fence(__ATOMIC_ACQUIRE, "agent");
            asm volatile("s_waitcnt vmcnt(0)" ::: "memory");
        }
    }
    __syncthreads();
}

template <bool TR, class Epi>
__device__ __forceinline__ void gemm128(const bf16_t* __restrict__ A, int lda, const bf16_t* __restrict__ B, int ldb, int K, char* smem, const Epi& epi) {
    const int tid = opaque_tid(), lane = tid & 63, wid = tid >> 6, wr = wid >> 1, wc = wid & 1, fr = lane & 15, fq = lane >> 4;
    f32x4 acc[4][4];
#pragma unroll
    for (int m = 0; m < 4; ++m)
#pragma unroll
        for (int n = 0; n < 4; ++n) acc[m][n] = (f32x4){0.f, 0.f, 0.f, 0.f};
    const int crow = tid >> 3, ckc = tid & 7;
    const bf16_t* ap = A + (size_t)crow * lda + ckc * 8;
    const bf16_t* bp = B + (size_t)crow * ldb + ckc * 8;
    u32x4 ra[4], rb[4];
#pragma unroll
    for (int i = 0; i < 4; ++i) { ra[i] = *(const u32x4*)(ap + (size_t)(32 * i) * lda); rb[i] = *(const u32x4*)(bp + (size_t)(32 * i) * ldb); }
    {
        char* sa = smem; char* sb = smem + TILE_BYTES;
#pragma unroll
        for (int i = 0; i < 4; ++i) { *(u32x4*)(sa + ((crow + 32 * i) * LDS_STRIDE + ckc * 8) * 2) = ra[i]; *(u32x4*)(sb + ((crow + 32 * i) * LDS_STRIDE + ckc * 8) * 2) = rb[i]; }
    }
    __syncthreads();
    const int nk = K >> 6;
    for (int kt = 0; kt < nk; ++kt) {
        const bool more = (kt + 1 < nk);
        if (more) {
            const int k0 = (kt + 1) << 6;
#pragma unroll
            for (int i = 0; i < 4; ++i) { ra[i] = *(const u32x4*)(ap + (size_t)(32 * i) * lda + k0); rb[i] = *(const u32x4*)(bp + (size_t)(32 * i) * ldb + k0); }
        }
        const char* sa = smem + (kt & 1) * 2 * TILE_BYTES; const char* sb = sa + TILE_BYTES;
#pragma unroll
        for (int ks = 0; ks < 2; ++ks) {
            bf16x8 af[4], bfr[4];
#pragma unroll
            for (int m = 0; m < 4; ++m) af[m] = *(const bf16x8*)(sa + ((wr * 64 + m * 16 + fr) * LDS_STRIDE + ks * 32 + fq * 8) * 2);
#pragma unroll
            for (int n = 0; n < 4; ++n) bfr[n] = *(const bf16x8*)(sb + ((wc * 64 + n * 16 + fr) * LDS_STRIDE + ks * 32 + fq * 8) * 2);
            __builtin_amdgcn_s_setprio(1);
#pragma unroll
            for (int m = 0; m < 4; ++m)
#pragma unroll
                for (int n = 0; n < 4; ++n) acc[m][n] = TR ? __builtin_amdgcn_mfma_f32_16x16x32_bf16(bfr[n], af[m], acc[m][n], 0, 0, 0) : __builtin_amdgcn_mfma_f32_16x16x32_bf16(af[m], bfr[n], acc[m][n], 0, 0, 0);
            __builtin_amdgcn_s_setprio(0);
        }
        if (more) {
            char* da = smem + ((kt + 1) & 1) * 2 * TILE_BYTES; char* db = da + TILE_BYTES;
#pragma unroll
            for (int i = 0; i < 4; ++i) { *(u32x4*)(da + ((crow + 32 * i) * LDS_STRIDE + ckc * 8) * 2) = ra[i]; *(u32x4*)(db + ((crow + 32 * i) * LDS_STRIDE + ckc * 8) * 2) = rb[i]; }
        }
        __syncthreads();
    }
    epi(acc, wr * 64, wc * 64, fr, fq);
}


#define L2_STRIDE 40
#define A2_BYTES (256 * L2_STRIDE * 2)
#define B2_BYTES (128 * L2_STRIDE * 2)
#define ST2_BYTES (A2_BYTES + B2_BYTES)
template <class Epi>
__device__ __forceinline__ void gemm256(const bf16_t* __restrict__ A, int lda, const bf16_t* __restrict__ B, int ldb, int K, char* smem, const Epi& epi) {
    const int tid = opaque_tid(), lane = tid & 63, wid = tid >> 6, wr = wid >> 1, wc = wid & 1, fr = lane & 15, fq = lane >> 4;
    f32x4 acc[2][4][4];
#pragma unroll
    for (int hh = 0; hh < 2; ++hh)
#pragma unroll
        for (int m = 0; m < 4; ++m)
#pragma unroll
            for (int n = 0; n < 4; ++n) acc[hh][m][n] = (f32x4){0.f, 0.f, 0.f, 0.f};
    const int crow = tid >> 2, ckc = tid & 3;
    const bf16_t* ap = A + (size_t)crow * lda + ckc * 8;
    const bf16_t* bp = B + (size_t)crow * ldb + ckc * 8;
    u32x4 ra[4], rb[2];
#pragma unroll
    for (int i = 0; i < 4; ++i) ra[i] = *(const u32x4*)(ap + (size_t)(64 * i) * lda);
#pragma unroll
    for (int i = 0; i < 2; ++i) rb[i] = *(const u32x4*)(bp + (size_t)(64 * i) * ldb);
    {
        char* sa = smem; char* sb = smem + A2_BYTES;
#pragma unroll
        for (int i = 0; i < 4; ++i) *(u32x4*)(sa + ((crow + 64 * i) * L2_STRIDE + ckc * 8) * 2) = ra[i];
#pragma unroll
        for (int i = 0; i < 2; ++i) *(u32x4*)(sb + ((crow + 64 * i) * L2_STRIDE + ckc * 8) * 2) = rb[i];
    }
    __syncthreads();
    const int nk = K >> 5;
    for (int kt = 0; kt < nk; ++kt) {
        const bool more = (kt + 1 < nk);
        if (more) {
            const int k0 = (kt + 1) << 5;
#pragma unroll
            for (int i = 0; i < 4; ++i) ra[i] = *(const u32x4*)(ap + (size_t)(64 * i) * lda + k0);
#pragma unroll
            for (int i = 0; i < 2; ++i) rb[i] = *(const u32x4*)(bp + (size_t)(64 * i) * ldb + k0);
        }
        const char* sa = smem + (kt & 1) * ST2_BYTES; const char* sb = sa + A2_BYTES;
        bf16x8 bfr[4];
#pragma unroll
        for (int n = 0; n < 4; ++n) bfr[n] = *(const bf16x8*)(sb + ((wc * 64 + n * 16 + fr) * L2_STRIDE + fq * 8) * 2);
#pragma unroll
        for (int hh = 0; hh < 2; ++hh) {
            bf16x8 af[4];
#pragma unroll
            for (int m = 0; m < 4; ++m) af[m] = *(const bf16x8*)(sa + ((wr * 128 + hh * 64 + m * 16 + fr) * L2_STRIDE + fq * 8) * 2);
            __builtin_amdgcn_s_setprio(1);
#pragma unroll
            for (int m = 0; m < 4; ++m)
#pragma unroll
                for (int n = 0; n < 4; ++n) acc[hh][m][n] = __builtin_amdgcn_mfma_f32_16x16x32_bf16(bfr[n], af[m], acc[hh][m][n], 0, 0, 0);
            __builtin_amdgcn_s_setprio(0);
        }
        if (more) {
            char* da = smem + ((kt + 1) & 1) * ST2_BYTES; char* db = da + A2_BYTES;
#pragma unroll
            for (int i = 0; i < 4; ++i) *(u32x4*)(da + ((crow + 64 * i) * L2_STRIDE + ckc * 8) * 2) = ra[i];
#pragma unroll
            for (int i = 0; i < 2; ++i) *(u32x4*)(db + ((crow + 64 * i) * L2_STRIDE + ckc * 8) * 2) = rb[i];
        }
        __syncthreads();
    }
    epi(acc[0], wr * 128, wc * 64, fr, fq);
    epi(acc[1], wr * 128 + 64, wc * 64, fr, fq);
}

struct EpiZ {
    bf16_t* Z; int R0, C0;
    __device__ __forceinline__ void operator()(f32x4 (&acc)[4][4], int r0, int c0, int fr, int fq) const {
#pragma unroll
        for (int n = 0; n < 4; ++n) { const int col = C0 + c0 + n * 16 + fq * 4; if (col < NIN) {
#pragma unroll
            for (int m = 0; m < 4; ++m) { u32x2 w; w.x = pack2(acc[m][n][0], acc[m][n][1]); w.y = pack2(acc[m][n][2], acc[m][n][3]);
                *(u32x2*)(Z + (size_t)(R0 + r0 + m * 16 + fr) * NIN + col) = w; } } }
    }
};
struct EpiQ {
    bf16_t* Q; const float* rs; const float* ropeC; const float* ropeS; int R0, C0;
    __device__ __forceinline__ void operator()(f32x4 (&acc)[4][4], int r0, int c0, int fr, int fq) const {
        const bool lat = R0 >= M_CTX;
#pragma unroll
        for (int n = 0; n < 4; ++n) {
            const int cb = C0 + c0 + n * 16; const int hcs = cb % 96;
            if (lat && hcs == 80) continue;
            const bool rot = lat && hcs == 64;
#pragma unroll
            for (int m = 0; m < 4; ++m) {
                const int rl = r0 + m * 16 + fr; const int row = R0 + rl; const float sc = rs[rl] * QSCALE;
                const f32x4 x1 = acc[m][n] * sc; bf16_t* qp = Q + (size_t)row * 768 + cb + fq * 4;
                if (rot) {
                    const f32x4 x2 = acc[m][(n + 1) & 3] * sc; const int t = (row - M_CTX) & 4095;
                    const f32x4 cv = *(const f32x4*)(ropeC + t * 16 + fq * 4), sv = *(const f32x4*)(ropeS + t * 16 + fq * 4);
                    const f32x4 o1 = x1 * cv - x2 * sv, o2 = x1 * sv + x2 * cv;
                    u32x2 w; w.x = pack2(o1[0], o1[1]); w.y = pack2(o1[2], o1[3]); *(u32x2*)qp = w;
                    w.x = pack2(o2[0], o2[1]); w.y = pack2(o2[2], o2[3]); *(u32x2*)(qp + 16) = w;
                } else { u32x2 w; w.x = pack2(x1[0], x1[1]); w.y = pack2(x1[2], x1[3]); *(u32x2*)qp = w; }
            }
        }
    }
};
struct EpiKN {
    bf16_t* Kd; const float* rs; int R0, C0;
    __device__ __forceinline__ void operator()(f32x4 (&acc)[4][4], int r0, int c0, int fr, int fq) const {
#pragma unroll
        for (int n = 0; n < 4; ++n) { const int col = C0 + c0 + n * 16 + fq * 4; const int h = col >> 6, d = col & 63;
#pragma unroll
            for (int m = 0; m < 4; ++m) { const int rl = r0 + m * 16 + fr; const f32x4 v = acc[m][n] * (rs ? rs[rl] : 1.0f);
                u32x2 w; w.x = pack2(v[0], v[1]); w.y = pack2(v[2], v[3]); *(u32x2*)(Kd + (size_t)(R0 + rl) * 768 + h * 96 + d) = w; } }
    }
};
struct EpiKV {
    bf16_t* Kd; bf16_t* Vd; const float* rs; int R0, C0; int seqshift; size_t vbase0;
    __device__ __forceinline__ void operator()(f32x4 (&acc)[4][4], int r0, int c0, int fr, int fq) const {
#pragma unroll
        for (int n = 0; n < 4; ++n) {
            const int col = C0 + c0 + n * 16 + fr;
#pragma unroll
            for (int m = 0; m < 4; ++m) {
                const int rl = r0 + m * 16 + fq * 4; const int row = R0 + rl;
                float v[4];
#pragma unroll
                for (int j = 0; j < 4; ++j) v[j] = acc[m][n][j] * (rs ? rs[rl + j] : 1.0f);
                if (col < 512) {
                    const int h = col >> 6, d = col & 63;
#pragma unroll
                    for (int j = 0; j < 4; ++j) Kd[(size_t)(row + j) * 768 + h * 96 + d] = f2bf(v[j]);
                } else {
                    const int vc = col - 512, h = vc >> 6, dv = vc & 63; const int b = row >> seqshift, t = row & ((1 << seqshift) - 1);
                    u32x2 w; w.x = pack2(v[0], v[1]); w.y = pack2(v[2], v[3]);
                    *(u32x2*)(Vd + vbase0 + ((size_t)((b * 8 + h) * 64 + dv) << seqshift) + t) = w;
                }
            }
        }
    }
};
struct EpiRes {
    float* X; const float* gate; int R0, C0;
    __device__ __forceinline__ void operator()(f32x4 (&acc)[4][4], int r0, int c0, int fr, int fq) const {
#pragma unroll
        for (int n = 0; n < 4; ++n) { const int col = C0 + c0 + n * 16 + fq * 4; const f32x4 g = *(const f32x4*)(gate + col);
#pragma unroll
            for (int m = 0; m < 4; ++m) { float* px = X + (size_t)(R0 + r0 + m * 16 + fr) * DM + col; const f32x4 xv = *(const f32x4*)px; *(f32x4*)px = ALPHA_F * xv + g * acc[m][n]; } }
    }
};
struct EpiSwi {
    bf16_t* H; int R0, C0;
    __device__ __forceinline__ void operator()(f32x4 (&acc)[4][4], int r0, int c0, int fr, int fq) const {
        const int hb = ((C0 + c0) >> 1) + fq * 4;
#pragma unroll
        for (int n = 0; n < 2; ++n)
#pragma unroll
            for (int m = 0; m < 4; ++m) { float o[4];
#pragma unroll
                for (int j = 0; j < 4; ++j) { const float g = acc[m][n][j], u = acc[m][n + 2][j]; o[j] = g * sigmoidf_(g) * u; }
                u32x2 w; w.x = pack2(o[0], o[1]); w.y = pack2(o[2], o[3]);
                *(u32x2*)(H + (size_t)(R0 + r0 + m * 16 + fr) * DFF + hb + n * 16) = w; }
    }
};

__device__ __forceinline__ void ada_unit(const P& p, int u, char* smem) {
    const int tid = opaque_tid(); const int l = u / 96, c0 = (u % 96) * 64;
    float* cs = (float*)smem;
    for (int i = tid; i < 5 * 1024; i += 256) { const int r = i >> 10, k = i & 1023; const float v = (r == 0) ? p.c_ctx[k] : p.c[(r - 1) * 1024 + k]; cs[i] = v * sigmoidf_(v); }
    __syncthreads();
    const int col = tid & 63, kq = tid >> 6;
    float s0 = 0.f, s1 = 0.f, s2 = 0.f, s3 = 0.f, s4 = 0.f;
    const float* w = p.ada_w + ((size_t)l * 1024 + kq * 256) * 6144 + c0 + col;
    const float* cq = cs + kq * 256;
    for (int k = 0; k < 256; ++k) { const float wv = w[(size_t)k * 6144]; s0 += cq[k] * wv; s1 += cq[1024 + k] * wv; s2 += cq[2048 + k] * wv; s3 += cq[3072 + k] * wv; s4 += cq[4096 + k] * wv; }
    float* red = cs + 5 * 1024;
    red[(kq * 5 + 0) * 64 + col] = s0; red[(kq * 5 + 1) * 64 + col] = s1; red[(kq * 5 + 2) * 64 + col] = s2; red[(kq * 5 + 3) * 64 + col] = s3; red[(kq * 5 + 4) * 64 + col] = s4;
    __syncthreads();
    for (int o = tid; o < 320; o += 256) { const int i = o >> 6, cc = o & 63;
        const float v = red[(0 * 5 + i) * 64 + cc] + red[(1 * 5 + i) * 64 + cc] + red[(2 * 5 + i) * 64 + cc] + red[(3 * 5 + i) * 64 + cc] + p.ada_b[l * 6144 + c0 + cc];
        p.mod[((size_t)l * 5 + i) * 6144 + c0 + cc] = v; }
    __syncthreads();
}
__device__ __forceinline__ int map_col(int kind, int n) {
    if (kind == 1) { const int blk = n >> 6, r = n & 63; return r < 32 ? blk * 32 + r : DFF + blk * 32 + (r - 32); }
    if (kind == 2) { if (n < 512) return (n >> 6) * 128 + (n & 63); const int vc = n - 512; return (vc >> 6) * 128 + 64 + (vc & 63); }
    return n;
}
__device__ __forceinline__ void conv_tile(const float* src, int ldsrc, bf16_t* dst, bf16_t* dst2, int Kdst, int n0, int k0, int kind, int Nvalid, const float* kscale, char* smem) {
    const int tid = opaque_tid(); float* tile = (float*)smem;
    { const int j = tid & 63, i0 = tid >> 6; const int n = n0 + j; const int sc = (n < Nvalid) ? map_col(kind, n) : -1;
#pragma unroll 4
      for (int ii = 0; ii < 16; ++ii) { const int i = i0 + 4 * ii; tile[i * 65 + j] = (sc >= 0) ? src[(size_t)(k0 + i) * ldsrc + sc] : 0.f; } }
    __syncthreads();
    { const int i = tid & 63, j0 = tid >> 6; const float ks = kscale ? kscale[k0 + i] : 1.f;
#pragma unroll 4
      for (int jj = 0; jj < 16; ++jj) { const int jx = j0 + 4 * jj; const float v = tile[i * 65 + jx];
          dst[(size_t)(n0 + jx) * Kdst + k0 + i] = f2bf(v * ks); if (dst2) dst2[(size_t)(n0 + jx) * Kdst + k0 + i] = f2bf(v); } }
    __syncthreads();
}
#define NCONV 3032
__device__ __forceinline__ void conv_unit(const P& p, int l, int u, char* smem) {
    const float* src; int ldsrc; bf16_t* dst; bf16_t* dst2 = nullptr; int Kdst, n0, k0, kind = 0, Nvalid; const float* kscale = nullptr;
    if (u < 544) { src = p.w_in + (size_t)l * 1024 * NIN; ldsrc = NIN; dst = p.WtIn; Kdst = 1024; n0 = (u / 16) * 64; k0 = (u % 16) * 64; Nvalid = NIN; }
    else if (u < 592) { u -= 544; src = p.q_up + (size_t)l * 256 * 768; ldsrc = 768; dst = p.WtQ; Kdst = 256; n0 = (u / 4) * 64; k0 = (u % 4) * 64; Nvalid = 768; kscale = p.q_norm + l * 256; }
    else if (u < 624) { u -= 592; src = p.kv_up + (size_t)l * 128 * 1024; ldsrc = 1024; dst = p.WtKVn; dst2 = p.WtKV; Kdst = 128; n0 = (u / 2) * 64; k0 = (u % 2) * 64; kind = 2; Nvalid = 1024; kscale = p.kv_norm + l * 128; }
    else if (u < 880) { u -= 624; src = p.w_out + (size_t)l * 1024 * 1024; ldsrc = 1024; dst = p.WtOut; Kdst = 1024; n0 = (u / 16) * 64; k0 = (u % 16) * 64; Nvalid = 1024; }
    else if (u < 2288) { u -= 880; src = p.ffn_in + (size_t)l * 1024 * 5632; ldsrc = 5632; dst = p.WtF1; Kdst = 1024; n0 = (u / 16) * 64; k0 = (u % 16) * 64; kind = 1; Nvalid = 5632; }
    else if (u < 2992) { u -= 2288; src = p.ffn_out + (size_t)l * DFF * 1024; ldsrc = 1024; dst = p.WtF2; Kdst = DFF; n0 = (u / 44) * 64; k0 = (u % 44) * 64; Nvalid = 1024; }
    else if (u < 3008) { u -= 2992; const float* sp = p.gm_ws + (size_t)l * 65536 + u * 4096; bf16_t* d = p.WsB + u * 4096; for (int i = threadIdx.x; i < 4096; i += 256) d[i] = f2bf(sp[i]); return; }
    else if (u < 3016) { u -= 3008; const int d = u >> 2; src = p.rw_w2 + ((size_t)l * 2 + d) * 64 * 256; ldsrc = 256; dst = p.W2t + d * 256 * 64; Kdst = 64; n0 = (u & 3) * 64; k0 = 0; Nvalid = 256; }
    else if (u < 3024) { u -= 3016; const int d = u >> 2; src = p.rw_a2 + ((size_t)l * 2 + d) * 64 * 256; ldsrc = 256; dst = p.A2t + d * 256 * 64; Kdst = 64; n0 = (u & 3) * 64; k0 = 0; Nvalid = 256; }
    else { u -= 3024; src = p.rw_g2 + (size_t)l * 128 * 256; ldsrc = 256; dst = p.G2t; Kdst = 128; n0 = (u / 2) * 64; k0 = (u % 2) * 64; Nvalid = 256; }
    conv_tile(src, ldsrc, dst, dst2, Kdst, n0, k0, kind, Nvalid, kscale, smem);
}
__device__ __forceinline__ void misc0_unit(const P& p, int u) {
    const int tid = opaque_tid();
    if (u < 16) {
        for (int e = tid; e < 4096; e += 256) { const int idx = u * 4096 + e; const int t = idx >> 4, i = idx & 15;
            const float pos = (float)((i < 8) ? (t >> 6) : (t & 63)); const float inv = exp2f(-(float)(i & 7) * 1.6609640474436813f);
            const float ang = pos * inv; const float kf = rintf(ang * 0.15915494309189535f);
            float r = fmaf(-kf, 6.28318548202514648f, ang); r = fmaf(-kf, -1.74845553e-7f, r);
            p.ropeC[idx] = __cosf(r); p.ropeS[idx] = __sinf(r); }
    } else {
        const int v = u - 16;
        for (int e = tid; e < 4096; e += 256) { const int idx = v * 4096 + e;
            const int c = idx & 127, t = (idx >> 7) & 511, b = (idx >> 16) & 3, l = idx >> 18;
            p.CkvB[idx] = f2bf(p.cache_ckv[(((size_t)b * 4 + l) * 512 + t) * 128 + c]); }
    }
}

__device__ __forceinline__ void ln_phase(const P& p, int l, int which) {
    const int tid = opaque_tid(), lane = tid & 63, wid = tid >> 6;
    const float* g = which == 1 ? p.ln1_g + l * DM : p.ln2_g + l * DM; const float* bb = which == 1 ? p.ln1_b + l * DM : p.ln2_b + l * DM;
    const int ml = which == 2 ? l + 1 : l; const int shoff = which == 1 ? 3072 : 0, scoff = which == 1 ? 4096 : 1024;
    const bool dohb = !(which == 2 && l == 3);
    for (int row = blockIdx.x * 4 + wid; row < M_ALL; row += gridDim.x * 4) {
        float* xr = p.out + (size_t)row * DM;
        const float* src = which == 0 ? (row < M_CTX ? p.x_prompt + (size_t)row * DM : p.x_sample + (size_t)(row - M_CTX) * DM) : xr;
        f32x4 v[4];
#pragma unroll
        for (int i = 0; i < 4; ++i) v[i] = *(const f32x4*)(src + lane * 4 + 256 * i);
        if (which != 0) {
            float s = 0.f;
#pragma unroll
            for (int i = 0; i < 4; ++i) s += (v[i][0] + v[i][1]) + (v[i][2] + v[i][3]);
            s = red16(s); s += __shfl_xor(s, 16); s += __shfl_xor(s, 32);
            const float mu = s * (1.0f / 1024.0f); float q = 0.f;
#pragma unroll
            for (int i = 0; i < 4; ++i) { const f32x4 d = v[i] - mu; q += (d[0] * d[0] + d[1] * d[1]) + (d[2] * d[2] + d[3] * d[3]); }
            q = red16(q); q += __shfl_xor(q, 16); q += __shfl_xor(q, 32);
            const float rstd = rsqrtf(q * (1.0f / 1024.0f) + 1e-5f);
#pragma unroll
            for (int i = 0; i < 4; ++i) { const f32x4 gg = *(const f32x4*)(g + lane * 4 + 256 * i), bv = *(const f32x4*)(bb + lane * 4 + 256 * i); v[i] = (v[i] - mu) * rstd * gg + bv; }
        }
#pragma unroll
        for (int i = 0; i < 4; ++i) *(f32x4*)(xr + lane * 4 + 256 * i) = v[i];
        if (dohb) {
            const float* md = p.mod + ((size_t)ml * 5 + modrow_of(row)) * 6144;
#pragma unroll
            for (int i = 0; i < 4; ++i) { const f32x4 sh = *(const f32x4*)(md + shoff + lane * 4 + 256 * i), sc = *(const f32x4*)(md + scoff + lane * 4 + 256 * i);
                const f32x4 h = v[i] * (1.0f + sc) + sh; u32x2 w; w.x = pack2(h[0], h[1]); w.y = pack2(h[2], h[3]);
                *(u32x2*)(p.hbmix + (size_t)row * DM + lane * 4 + 256 * i) = w; }
        }
    }
}

__device__ __forceinline__ void rwprep_unit(const P& p, int l, int u, char* smem) {
    const int tid = opaque_tid(), lane = tid & 63, wid = tid >> 6, fr = lane & 15, fq = lane >> 4;
    const int R0 = u * 64;
    const int ss = R0 < M_CTX ? (R0 & ~255) : M_CTX + ((R0 - M_CTX) & ~4095); const int se = ss + (R0 < M_CTX ? 256 : 4096);
    bf16_t* XW = (bf16_t*)smem; bf16_t* XA = XW + 64 * 136; bf16_t* XG = XA + 64 * 136;
    const float* cw = p.rw_conv + (size_t)l * 3 * 1152;
    for (int it = tid; it < 1152; it += 256) {
        const int cc = it % 144, tg = it / 144; const int c = cc * 8;
        float w0[8], w1[8], w2[8];
#pragma unroll
        for (int i = 0; i < 8; ++i) { w0[i] = cw[c + i]; w1[i] = cw[1152 + c + i]; w2[i] = cw[2304 + c + i]; }
        const int rfirst = R0 + tg * 8;
        u32x4 rows[10];
#pragma unroll
        for (int i = 0; i < 10; ++i) { const int r = rfirst - 1 + i; rows[i] = (u32x4){0u, 0u, 0u, 0u};
            if (r >= ss && r < se) rows[i] = *(const u32x4*)(p.Z + (size_t)r * NIN + c); }
#pragma unroll
        for (int tt = 0; tt < 8; ++tt) {
            const int row = rfirst + tt;
            const u32x4 prev = rows[tt], cur = rows[tt + 1], nxt = rows[tt + 2];
            float o[8];
#pragma unroll
            for (int i = 0; i < 4; ++i) {
                o[2 * i] = w0[2 * i] * lo_bf(prev[i]) + w1[2 * i] * lo_bf(cur[i]) + w2[2 * i] * lo_bf(nxt[i]);
                o[2 * i + 1] = w0[2 * i + 1] * hi_bf(prev[i]) + w1[2 * i + 1] * hi_bf(cur[i]) + w2[2 * i + 1] * hi_bf(nxt[i]);
            }
            if (c >= 768 && c < 896) {
#pragma unroll
                for (int i = 0; i < 8; ++i) o[i] = tanhf_(o[i]);
            } else if (c >= 1024) {
#pragma unroll
                for (int i = 0; i < 8; ++i) o[i] = sigmoidf_(o[i]);
            }
            u32x4 w; w.x = pack2(o[0], o[1]); w.y = pack2(o[2], o[3]); w.z = pack2(o[4], o[5]); w.w = pack2(o[6], o[7]);
            const int tl = tg * 8 + tt;
            if (c < 768) *(u32x4*)(p.RKV + (size_t)row * 768 + c) = w;
            else if (c < 896) *(u32x4*)(XW + tl * 136 + (c - 768)) = w;
            else if (c < 1024) *(u32x4*)(XA + tl * 136 + (c - 896)) = w;
            else *(u32x4*)(XG + tl * 136 + (c - 1024)) = w;
        }
    }
    __syncthreads();
#pragma unroll 1
    for (int mh = 0; mh < 10; ++mh) {
        const int mat = mh >> 1, nh = mh & 1;
        const int d = mat & 1; const bf16_t* As; const bf16_t* Bw; int kofs, nks, ldw;
        if (mat < 2) { As = XW; Bw = p.W2t + d * 256 * 64; kofs = d * 64; nks = 2; ldw = 64; }
        else if (mat < 4) { As = XA; Bw = p.A2t + d * 256 * 64; kofs = d * 64; nks = 2; ldw = 64; }
        else { As = XG; Bw = p.G2t; kofs = 0; nks = 4; ldw = 128; }
        f32x4 acc[4][2];
#pragma unroll
        for (int m = 0; m < 4; ++m)
#pragma unroll
            for (int n = 0; n < 2; ++n) acc[m][n] = (f32x4){0.f, 0.f, 0.f, 0.f};
        bf16x8 bw[4][2];
#pragma unroll
        for (int ks = 0; ks < 4; ++ks)
#pragma unroll
            for (int n = 0; n < 2; ++n) bw[ks][n] = *(const bf16x8*)(Bw + (size_t)(wid * 64 + nh * 32 + n * 16 + fr) * ldw + (ks < nks ? ks : 0) * 32 + fq * 8);
#pragma unroll
        for (int ks = 0; ks < 4; ++ks) {
            if (ks < nks) {
                bf16x8 af[4];
#pragma unroll
                for (int m = 0; m < 4; ++m) af[m] = *(const bf16x8*)(As + (m * 16 + fr) * 136 + kofs + ks * 32 + fq * 8);
#pragma unroll
                for (int m = 0; m < 4; ++m)
#pragma unroll
                    for (int n = 0; n < 2; ++n) acc[m][n] = __builtin_amdgcn_mfma_f32_16x16x32_bf16(bw[ks][n], af[m], acc[m][n], 0, 0, 0);
            }
        }
#pragma unroll
        for (int n = 0; n < 2; ++n) {
            const int c = wid * 64 + nh * 32 + n * 16 + fq * 4;
            f32x4 bias = (f32x4){0.f, 0.f, 0.f, 0.f}; if (mat < 2) bias = *(const f32x4*)(p.rw_w0 + (l * 2 + d) * 256 + c); else if (mat < 4) bias = *(const f32x4*)(p.rw_a0 + (l * 2 + d) * 256 + c);
            bf16_t* dst; float mul;
            if (mat < 2) { dst = p.Ee + ((size_t)d * M_ALL + R0) * 256 + c; mul = 0.6065306597126334f; }
            else if (mat < 4) { dst = p.Aa + ((size_t)d * M_ALL + R0) * 256 + c; mul = 1.0f; }
            else { dst = p.Gg + (size_t)R0 * 256 + c; mul = 1.0f; }
#pragma unroll
            for (int m = 0; m < 4; ++m) {
                float o[4];
#pragma unroll
                for (int j = 0; j < 4; ++j) { const float x = acc[m][n][j] + bias[j]; o[j] = mat < 4 ? mul * sigmoidf_(x) : x; }
                u32x2 w; w.x = pack2(o[0], o[1]); w.y = pack2(o[2], o[3]);
                *(u32x2*)(dst + (size_t)(m * 16 + fr) * 256) = w;
            }
        }
    }
    __syncthreads();
}
__device__ __forceinline__ void rowscale128(const bf16_t* Z, int R0, int zoff, int ncols, float eps, float* rs) {
    const int tid = opaque_tid(); const int r = tid >> 1, half = tid & 1; const int per = ncols >> 1;
    const bf16_t* zp = Z + (size_t)(R0 + r) * NIN + zoff + half * per;
    float ss = 0.f;
    for (int i = 0; i < per; i += 8) { const u32x4 w = *(const u32x4*)(zp + i);
#pragma unroll
        for (int q = 0; q < 4; ++q) { const float a = lo_bf(w[q]), b = hi_bf(w[q]); ss += a * a + b * b; } }
    ss = dpp_add<0xB1>(ss);
    if (half == 0) rs[r] = rsqrtf(ss / (float)ncols + eps);
}
__device__ __forceinline__ void small_unit(const P& p, int l, int u) {
    const int tid = opaque_tid(), sub = tid >> 5, li = tid & 31;
    if (u < 2560) {
        const int row = u * 8 + sub; const bf16_t* zr = p.Z + (size_t)row * NIN;
        const u32x2 w = *(const u32x2*)(zr + ZKV + li * 4);
        const float z0 = lo_bf(w.x), z1 = hi_bf(w.x), z2 = lo_bf(w.y), z3 = hi_bf(w.y);
        float ss = z0 * z0 + z1 * z1 + z2 * z2 + z3 * z3; ss = red16(ss); ss += __shfl_xor(ss, 16);
        const float rsv = rsqrtf(ss * (1.0f / 128.0f) + 1e-6f);
        const float x1 = bf2f(zr[ZKR + (li & 15)]), x2 = bf2f(zr[ZKR + 16 + (li & 15)]);
        float val;
        if (row < M_CTX) {
            const int b = row >> 8, t = row & 255; const size_t o = ((size_t)(b * 4 + l) * 256 + t);
            const f32x4 g = *(const f32x4*)(p.kv_norm + l * 128 + li * 4);
            *(f32x4*)(p.out + 20971520 + o * 128 + li * 4) = (f32x4){z0 * rsv * g[0], z1 * rsv * g[1], z2 * rsv * g[2], z3 * rsv * g[3]};
            val = li < 16 ? x1 : x2;
            p.out[20971520 + 2097152 + o * 32 + li] = val;
        } else {
            const int t = (row - M_CTX) & 4095; const float cv = p.ropeC[t * 16 + (li & 15)], sv = p.ropeS[t * 16 + (li & 15)];
            val = li < 16 ? x1 * cv - x2 * sv : x1 * sv + x2 * cv;
        }
        const bf16_t bv = f2bf(val);
#pragma unroll
        for (int h = 0; h < 8; ++h) p.Kb[(size_t)row * 768 + h * 96 + 64 + li] = bv;
    } else {
        const int r = (u - 2560) * 8 + sub; const int b = r >> 9, t = r & 511;
        const bf16_t bv = f2bf(p.cache_krope[((size_t)(b * 4 + l) * 512 + t) * 32 + li]);
#pragma unroll
        for (int h = 0; h < 8; ++h) p.Kc[(size_t)r * 768 + h * 96 + 64 + li] = bv;
    }
}
__device__ __forceinline__ void gmlp_unit(const P& p, int l, int u, char* smem) {
    const int tid = opaque_tid(), lane = tid & 63, wid = tid >> 6, fr = lane & 15, fq = lane >> 4;
    const int R0 = (u >> 2) * 128, g = u & 3;
    bf16_t* VnT = (bf16_t*)smem;
    bf16x8 wsf[4][2];
    { const bf16_t* Wg0 = p.WsB + g * 128 * 128;
#pragma unroll
      for (int ks = 0; ks < 4; ++ks)
#pragma unroll
        for (int m = 0; m < 2; ++m) wsf[ks][m] = *(const bf16x8*)(Wg0 + (wid * 32 + m * 16 + fr) * 128 + ks * 32 + fq * 8); }
    {
        const int tok = tid >> 1, half = tid & 1; const bf16_t* zp = p.Z + (size_t)(R0 + tok) * NIN + ZV + g * 64 + half * 32;
        float x[32];
#pragma unroll
        for (int i = 0; i < 4; ++i) { const u32x4 w = *(const u32x4*)(zp + i * 8);
#pragma unroll
            for (int q = 0; q < 4; ++q) { x[i * 8 + 2 * q] = geluf_(lo_bf(w[q])); x[i * 8 + 2 * q + 1] = geluf_(hi_bf(w[q])); } }
        float s = 0.f;
#pragma unroll
        for (int i = 0; i < 32; ++i) s += x[i];
        s = dpp_add<0xB1>(s); const float mu = s * (1.0f / 64.0f);
        float q2 = 0.f;
#pragma unroll
        for (int i = 0; i < 32; ++i) { const float d = x[i] - mu; q2 += d * d; }
        q2 = dpp_add<0xB1>(q2); const float rstd = rsqrtf(q2 * (1.0f / 64.0f) + 1e-5f);
        const float* gg = p.gm_g + l * 256 + g * 64 + half * 32; const float* gb = p.gm_b + l * 256 + g * 64 + half * 32;
#pragma unroll
        for (int i = 0; i < 32; ++i) VnT[(half * 32 + i) * 136 + tok] = f2bf((x[i] - mu) * rstd * gg[i] + gb[i]);
    }
    __syncthreads();
    f32x4 acc[2][4];
#pragma unroll
    for (int m = 0; m < 2; ++m)
#pragma unroll
        for (int n = 0; n < 4; ++n) acc[m][n] = (f32x4){0.f, 0.f, 0.f, 0.f};
#pragma unroll
    for (int ks = 0; ks < 4; ++ks) {
        bf16x8 bfr[4];
#pragma unroll
        for (int n = 0; n < 4; ++n) bfr[n] = *(const bf16x8*)(VnT + (n * 16 + fr) * 136 + ks * 32 + fq * 8);
#pragma unroll
        for (int m = 0; m < 2; ++m)
#pragma unroll
            for (int n = 0; n < 4; ++n) acc[m][n] = __builtin_amdgcn_mfma_f32_16x16x32_bf16(bfr[n], wsf[ks][m], acc[m][n], 0, 0, 0);
    }
#pragma unroll
    for (int m = 0; m < 2; ++m) {
        const int pp = wid * 32 + m * 16 + fr; const float bs = p.gm_bs[l * 512 + g * 128 + pp];
#pragma unroll
        for (int n = 0; n < 4; ++n) { const int c = n * 16 + fq * 4;
            const u32x2 zw = *(const u32x2*)(p.Z + (size_t)(R0 + pp) * NIN + ZU + g * 64 + c);
            const float u0 = geluf_(lo_bf(zw.x)), u1 = geluf_(hi_bf(zw.x)), u2 = geluf_(lo_bf(zw.y)), u3 = geluf_(hi_bf(zw.y));
            u32x2 w; w.x = pack2(u0 * (acc[m][n][0] + bs), u1 * (acc[m][n][1] + bs)); w.y = pack2(u2 * (acc[m][n][2] + bs), u3 * (acc[m][n][3] + bs));
            *(u32x2*)(p.hbmix + (size_t)(R0 + pp) * DM + 768 + g * 64 + c) = w; }
    }
    __syncthreads();
}

__device__ __forceinline__ float swap16_add(float x) {
    auto r = __builtin_amdgcn_permlane16_swap(__float_as_uint(x), __float_as_uint(x), false, false);
    return __uint_as_float(r[0]) + __uint_as_float(r[1]);
}
#define NSCAN_LAT 256
#define NSCAN (256 + 1024)
__device__ __forceinline__ void scan_unit(const P& p, int l, int u, char* smem) {
    const int tid = opaque_tid(), lane = tid & 63, wid = tid >> 6;
    int b, T, row0; const bool lat = u < NSCAN_LAT;
    if (lat) { b = u >> 6; T = 4096; row0 = M_CTX + b * 4096; } else { b = (u - NSCAN_LAT) >> 6; T = 256; row0 = b * 256; }
    const int h = (u >> 4) & 3, d = (u >> 3) & 1, rsl = u & 7;
    float* W = (float*)smem; float* NKK = W + 2048; float* KKA = NKK + 2048; float* KD = KKA + 2048; float* RR = KD + 2048; float* VS = RR + 2048; float* OUTP = VS + 256;
    const int rl = lane >> 5, kq = lane & 31; const int r8 = wid * 2 + rl; const int row = rsl * 8 + r8;
    f32x2 S = (f32x2){0.f, 0.f};
    const size_t stoff = ((((size_t)b * 4 + l) * 2 + d) * 4 + h) * 4096 + row * 64 + kq * 2;
    if (lat) S = *(const f32x2*)(p.state_rwkv + stoff);
    const int tok = tid >> 3, cg8 = tid & 7;
    float kkp[8], kap[8];
#pragma unroll
    for (int i = 0; i < 8; ++i) { kkp[i] = p.rw_kk[l * 256 + h * 64 + cg8 * 8 + i]; kap[i] = p.rw_ka[l * 256 + h * 64 + cg8 * 8 + i]; }
    const int nch = T >> 5;
    u32x4 r8v, k8, e8, a8, v8;
    int grow, grow_prev = 0; float oreg = 0.f;
    {
        const int sidx = tok; const int t = d ? T - 1 - sidx : sidx; grow = row0 + t;
        r8v = *(const u32x4*)(p.RKV + (size_t)grow * 768 + h * 64 + cg8 * 8);
        k8 = *(const u32x4*)(p.RKV + (size_t)grow * 768 + 256 + h * 64 + cg8 * 8);
        v8 = *(const u32x4*)(p.RKV + (size_t)grow * 768 + 512 + h * 64 + rsl * 8);
        e8 = *(const u32x4*)(p.Ee + ((size_t)d * M_ALL + grow) * 256 + h * 64 + cg8 * 8);
        a8 = *(const u32x4*)(p.Aa + ((size_t)d * M_ALL + grow) * 256 + h * 64 + cg8 * 8);
    }
    for (int ch = 0; ch < nch; ++ch) {
        {
            float kf[8], kkv[8], rf[8], ef[8], af[8];
#pragma unroll
            for (int q = 0; q < 4; ++q) { kf[2 * q] = lo_bf(k8[q]); kf[2 * q + 1] = hi_bf(k8[q]); rf[2 * q] = lo_bf(r8v[q]); rf[2 * q + 1] = hi_bf(r8v[q]);
                ef[2 * q] = lo_bf(e8[q]); ef[2 * q + 1] = hi_bf(e8[q]); af[2 * q] = lo_bf(a8[q]); af[2 * q + 1] = hi_bf(a8[q]); }
            float ss = 0.f;
#pragma unroll
            for (int i = 0; i < 8; ++i) { kkv[i] = kf[i] * kkp[i]; ss += kkv[i] * kkv[i]; }
            ss = red8(ss);
            const float inv = rsqrtf(fmaxf(ss, 1e-24f));
            f32x4 o0, o1; const int base = tok * 64 + cg8 * 8;
#pragma unroll
            for (int i = 0; i < 4; ++i) { o0[i] = __expf(-ef[i]); o1[i] = __expf(-ef[4 + i]); }
            *(f32x4*)(W + base) = o0; *(f32x4*)(W + base + 4) = o1;
#pragma unroll
            for (int i = 0; i < 4; ++i) { o0[i] = -kkv[i] * inv; o1[i] = -kkv[4 + i] * inv; }
            *(f32x4*)(NKK + base) = o0; *(f32x4*)(NKK + base + 4) = o1;
#pragma unroll
            for (int i = 0; i < 4; ++i) { o0[i] = kkv[i] * inv * af[i]; o1[i] = kkv[4 + i] * inv * af[4 + i]; }
            *(f32x4*)(KKA + base) = o0; *(f32x4*)(KKA + base + 4) = o1;
#pragma unroll
            for (int i = 0; i < 4; ++i) { o0[i] = kf[i] * (1.0f + (af[i] - 1.0f) * kap[i]); o1[i] = kf[4 + i] * (1.0f + (af[4 + i] - 1.0f) * kap[4 + i]); }
            *(f32x4*)(KD + base) = o0; *(f32x4*)(KD + base + 4) = o1;
#pragma unroll
            for (int i = 0; i < 4; ++i) { o0[i] = rf[i]; o1[i] = rf[4 + i]; }
            *(f32x4*)(RR + base) = o0; *(f32x4*)(RR + base + 4) = o1;
            if (cg8 == 0) {
#pragma unroll
                for (int q = 0; q < 4; ++q) { VS[tok * 8 + 2 * q] = lo_bf(v8[q]); VS[tok * 8 + 2 * q + 1] = hi_bf(v8[q]); }
            }
        }
        __syncthreads();
        if (ch > 0) p.ydir[((size_t)d * M_ALL + grow_prev) * 256 + h * 64 + rsl * 8 + cg8] = oreg;
        grow_prev = grow;
        if (ch + 1 < nch) {
            const int sidx = (ch + 1) * 32 + tok; const int t = d ? T - 1 - sidx : sidx; grow = row0 + t;
            r8v = *(const u32x4*)(p.RKV + (size_t)grow * 768 + h * 64 + cg8 * 8);
            k8 = *(const u32x4*)(p.RKV + (size_t)grow * 768 + 256 + h * 64 + cg8 * 8);
            v8 = *(const u32x4*)(p.RKV + (size_t)grow * 768 + 512 + h * 64 + rsl * 8);
            e8 = *(const u32x4*)(p.Ee + ((size_t)d * M_ALL + grow) * 256 + h * 64 + cg8 * 8);
            a8 = *(const u32x4*)(p.Aa + ((size_t)d * M_ALL + grow) * 256 + h * 64 + cg8 * 8);
        }
        {
            const float* Wq = W + kq * 2; const float* NKq = NKK + kq * 2; const float* KAq = KKA + kq * 2; const float* KDq = KD + kq * 2; const float* RRq = RR + kq * 2; const float* VSq = VS + r8;
            float* OPq = OUTP + r8 * 32 + kq;
            f32x2 wv[4], nkv[4], kav[4], kdv[4], rrv[4]; float vv[4];
#define SCAN_LD(slot, st) do { wv[slot] = *(const f32x2*)(Wq + (st) * 64); nkv[slot] = *(const f32x2*)(NKq + (st) * 64); kav[slot] = *(const f32x2*)(KAq + (st) * 64); \
        kdv[slot] = *(const f32x2*)(KDq + (st) * 64); rrv[slot] = *(const f32x2*)(RRq + (st) * 64); vv[slot] = VSq[(st) * 8]; } while (0)
            __builtin_amdgcn_s_setprio(3);
            SCAN_LD(0, 0); SCAN_LD(1, 1); SCAN_LD(2, 2);
#pragma unroll
            for (int s = 0; s < 32; ++s) {
                if (s + 3 < 32) SCAN_LD((s + 3) & 3, s + 3);
                const f32x2 w = wv[s & 3], nk = nkv[s & 3], ka = kav[s & 3], kd = kdv[s & 3], rr = rrv[s & 3]; const float v = vv[s & 3];
                float pd = fmaf(S[1], nk[1], S[0] * nk[0]);
                pd = red16(pd); pd = swap16_add(pd);
                S[0] = fmaf(S[0], w[0], fmaf(pd, ka[0], v * kd[0]));
                S[1] = fmaf(S[1], w[1], fmaf(pd, ka[1], v * kd[1]));
                OPq[s * 256] = fmaf(S[1], rr[1], S[0] * rr[0]);
            }
            __builtin_amdgcn_s_setprio(0);
        }
        __syncthreads();
        {
            const float* op = OUTP + (tok * 8 + cg8) * 32;
            f32x4 a0 = *(const f32x4*)(op), a1 = *(const f32x4*)(op + 4), a2 = *(const f32x4*)(op + 8), a3 = *(const f32x4*)(op + 12);
            f32x4 b0 = *(const f32x4*)(op + 16), b1 = *(const f32x4*)(op + 20), b2 = *(const f32x4*)(op + 24), b3 = *(const f32x4*)(op + 28);
            a0 = ((a0 + a1) + (a2 + a3)) + ((b0 + b1) + (b2 + b3));
            oreg = (a0[0] + a0[1]) + (a0[2] + a0[3]);
        }
    }
    p.ydir[((size_t)d * M_ALL + grow_prev) * 256 + h * 64 + rsl * 8 + cg8] = oreg;
    if (!lat) *(f32x2*)(p.out + 20971520 + 2097152 + 524288 + stoff) = S;
    __syncthreads();
}

#define KS_STRIDE 104
#define VS_STRIDE 68
#define KS_BYTES (64 * KS_STRIDE * 2)
#define ATT_STAGE (KS_BYTES + 64 * VS_STRIDE * 2)
__device__ __forceinline__ void attn_unit(const P& p, int u, char* smem) {
    const int tid = opaque_tid(), lane = tid & 63, wid = tid >> 6, q = lane & 31, hf = lane >> 5;
    int b, h, qt, qrow0, krow0, nown, ntot, Tv; size_t vbase, vcbase = 0; int kcrow0 = 0;
    if (u < 1024) { b = u >> 8; h = (u >> 5) & 7; qt = u & 31; krow0 = M_CTX + b * 4096; qrow0 = krow0 + qt * 128; nown = 64; ntot = 72; Tv = 4096;
        vbase = 2097152 + (size_t)(b * 8 + h) * 64 * 4096; kcrow0 = b * 512; vcbase = (size_t)(b * 8 + h) * 64 * 512; }
    else { const int v = u - 1024; b = v >> 4; h = (v >> 1) & 7; qt = v & 1; krow0 = b * 256; qrow0 = krow0 + qt * 128; nown = 4; ntot = 4; Tv = 256; vbase = (size_t)(b * 8 + h) * 64 * 256; }
    bf16x8 qf[6];
    { const bf16_t* qp = p.Qb + (size_t)(qrow0 + wid * 32 + q) * 768 + h * 96 + hf * 8;
#pragma unroll
      for (int ks = 0; ks < 6; ++ks) qf[ks] = *(const bf16x8*)(qp + ks * 16); }
    f32x16 oT[2];
#pragma unroll
    for (int i = 0; i < 16; ++i) { oT[0][i] = 0.f; oT[1][i] = 0.f; }
    float mrun = -1e30f, lrun = 0.f;
    u32x4 rk[3], rv[2];
    int krow[3], kc[3];
#pragma unroll
    for (int i = 0; i < 3; ++i) { const int c = tid + 256 * i; krow[i] = c / 12; kc[i] = c % 12; }
    const int vdv0 = tid >> 3, vkc = tid & 7;
#define ATT_LOAD(kt) do { const bf16_t* kptr; const bf16_t* vptr; int vstr; \
        if ((kt) < nown) { kptr = p.Kb + (size_t)(krow0 + (kt) * 64) * 768 + h * 96; vptr = p.Vt + vbase + (kt) * 64; vstr = Tv; } \
        else { kptr = p.Kc + (size_t)(kcrow0 + ((kt) - nown) * 64) * 768 + h * 96; vptr = p.Vtc + vcbase + ((kt) - nown) * 64; vstr = 512; } \
        _Pragma("unroll") for (int i = 0; i < 3; ++i) rk[i] = *(const u32x4*)(kptr + (size_t)krow[i] * 768 + kc[i] * 8); \
        _Pragma("unroll") for (int i = 0; i < 2; ++i) rv[i] = *(const u32x4*)(vptr + (size_t)(vdv0 + 32 * i) * vstr + vkc * 8); } while (0)
#define ATT_STORE(buf) do { char* Ks_ = smem + (buf) * ATT_STAGE; char* Vs_ = Ks_ + KS_BYTES; \
        _Pragma("unroll") for (int i = 0; i < 3; ++i) *(u32x4*)(Ks_ + (krow[i] * KS_STRIDE + kc[i] * 8) * 2) = rk[i]; \
        _Pragma("unroll") for (int i = 0; i < 2; ++i) { char* vd_ = Vs_ + ((vdv0 + 32 * i) * VS_STRIDE + vkc * 8) * 2; *(u32x2*)vd_ = (u32x2){rv[i].x, rv[i].y}; *(u32x2*)(vd_ + 8) = (u32x2){rv[i].z, rv[i].w}; } } while (0)
    ATT_LOAD(0); ATT_STORE(0);
    __syncthreads();
    for (int kt = 0; kt < ntot; ++kt) {
        const bool more = kt + 1 < ntot;
        if (more) ATT_LOAD(kt + 1);
        const char* Ks = smem + (kt & 1) * ATT_STAGE; const char* Vs = Ks + KS_BYTES;
        f32x16 sT[2];
#pragma unroll
        for (int i = 0; i < 16; ++i) { sT[0][i] = 0.f; sT[1][i] = 0.f; }
#pragma unroll
        for (int kb = 0; kb < 2; ++kb)
#pragma unroll
            for (int ks = 0; ks < 6; ++ks) { const bf16x8 kf = *(const bf16x8*)(Ks + ((kb * 32 + q) * KS_STRIDE + ks * 16 + hf * 8) * 2);
                sT[kb] = __builtin_amdgcn_mfma_f32_32x32x16_bf16(kf, qf[ks], sT[kb], 0, 0, 0); }
        float mx = sT[0][0];
#pragma unroll
        for (int i = 1; i < 16; ++i) mx = fmaxf(mx, sT[0][i]);
#pragma unroll
        for (int i = 0; i < 16; ++i) mx = fmaxf(mx, sT[1][i]);
        mx = fmaxf(mx, __shfl_xor(mx, 32));
        const float mnew = fmaxf(mrun, mx); const float alpha = __builtin_amdgcn_exp2f(mrun - mnew); const bool resc = __any(mnew > mrun); mrun = mnew;
        float psum = 0.f; bf16x8 pf[2][2];
#pragma unroll
        for (int kb = 0; kb < 2; ++kb)
#pragma unroll
            for (int s = 0; s < 2; ++s) { float e[8];
#pragma unroll
                for (int j = 0; j < 8; ++j) { e[j] = __builtin_amdgcn_exp2f(sT[kb][8 * s + j] - mnew); psum += e[j]; }
                u32x4 w; w.x = pack2(e[0], e[1]); w.y = pack2(e[2], e[3]); w.z = pack2(e[4], e[5]); w.w = pack2(e[6], e[7]);
                pf[kb][s] = __builtin_bit_cast(bf16x8, w); }
        lrun = lrun * alpha + psum;
        if (resc) {
#pragma unroll
            for (int i = 0; i < 16; ++i) { oT[0][i] *= alpha; oT[1][i] *= alpha; }
        }
#pragma unroll
        for (int kb = 0; kb < 2; ++kb)
#pragma unroll
            for (int s = 0; s < 2; ++s)
#pragma unroll
                for (int db = 0; db < 2; ++db) {
                    const char* vp = Vs + ((db * 32 + q) * VS_STRIDE + kb * 32 + 16 * s + 4 * hf) * 2;
                    const u32x2 lo = *(const u32x2*)vp, hi = *(const u32x2*)(vp + 16);
                    const u32x4 w = (u32x4){lo.x, lo.y, hi.x, hi.y};
                    oT[db] = __builtin_amdgcn_mfma_f32_32x32x16_bf16(__builtin_bit_cast(bf16x8, w), pf[kb][s], oT[db], 0, 0, 0);
                }
        if (more) ATT_STORE((kt + 1) & 1);
        __syncthreads();
    }
    const float lt = lrun + __shfl_xor(lrun, 32); const float inv = 1.0f / lt;
    bf16_t* op = p.hbmix + (size_t)(qrow0 + wid * 32 + q) * DM + 256 + h * 64;
#pragma unroll
    for (int db = 0; db < 2; ++db)
#pragma unroll
        for (int g = 0; g < 4; ++g) { u32x2 w; w.x = pack2(oT[db][4 * g] * inv, oT[db][4 * g + 1] * inv); w.y = pack2(oT[db][4 * g + 2] * inv, oT[db][4 * g + 3] * inv);
            *(u32x2*)(op + db * 32 + 8 * g + 4 * hf) = w; }
}

__device__ __forceinline__ void rwcomb_phase(const P& p, int l) {
    const int tid = opaque_tid(), lane = tid & 63, wid = tid >> 6; const int c = lane * 4;
    const f32x4 gng = *(const f32x4*)(p.rw_gn_g + l * 256 + c), gnb = *(const f32x4*)(p.rw_gn_b + l * 256 + c), kap = *(const f32x4*)(p.rw_ka + l * 256 + c), rkp = *(const f32x4*)(p.rw_rk + l * 256 + c);
    for (int row = blockIdx.x * 4 + wid; row < M_ALL; row += gridDim.x * 4) {
        const f32x4 y0 = *(const f32x4*)(p.ydir + (size_t)row * 256 + c), y1 = *(const f32x4*)(p.ydir + ((size_t)M_ALL + row) * 256 + c);
        f32x4 y = y0 + y1;
        float s = (y[0] + y[1]) + (y[2] + y[3]); s = red16(s); const float mu = s * (1.0f / 64.0f);
        const f32x4 dd = y - mu; float q2 = (dd[0] * dd[0] + dd[1] * dd[1]) + (dd[2] * dd[2] + dd[3] * dd[3]); q2 = red16(q2);
        const float rstd = rsqrtf(q2 * (1.0f / 64.0f) + 64e-5f);
        const f32x4 yn = dd * rstd * gng + gnb;
        const u32x2 rw = *(const u32x2*)(p.RKV + (size_t)row * 768 + c), kw = *(const u32x2*)(p.RKV + (size_t)row * 768 + 256 + c), vw = *(const u32x2*)(p.RKV + (size_t)row * 768 + 512 + c);
        const u32x2 a0w = *(const u32x2*)(p.Aa + (size_t)row * 256 + c), a1w = *(const u32x2*)(p.Aa + ((size_t)M_ALL + row) * 256 + c), gw = *(const u32x2*)(p.Gg + (size_t)row * 256 + c);
        const f32x4 r = (f32x4){lo_bf(rw.x), hi_bf(rw.x), lo_bf(rw.y), hi_bf(rw.y)}, k = (f32x4){lo_bf(kw.x), hi_bf(kw.x), lo_bf(kw.y), hi_bf(kw.y)}, v = (f32x4){lo_bf(vw.x), hi_bf(vw.x), lo_bf(vw.y), hi_bf(vw.y)};
        const f32x4 a0 = (f32x4){lo_bf(a0w.x), hi_bf(a0w.x), lo_bf(a0w.y), hi_bf(a0w.y)}, a1 = (f32x4){lo_bf(a1w.x), hi_bf(a1w.x), lo_bf(a1w.y), hi_bf(a1w.y)}, gt = (f32x4){lo_bf(gw.x), hi_bf(gw.x), lo_bf(gw.y), hi_bf(gw.y)};
        const f32x4 kds = k * (1.0f + (a0 - 1.0f) * kap) + k * (1.0f + (a1 - 1.0f) * kap);
        const f32x4 t4 = r * kds * rkp; float rk = (t4[0] + t4[1]) + (t4[2] + t4[3]); rk = red16(rk);
        const f32x4 o = (yn + rk * v) * gt;
        u32x2 w; w.x = pack2(o[0], o[1]); w.y = pack2(o[2], o[3]);
        *(u32x2*)(p.hbmix + (size_t)row * DM + c) = w;
    }
}


__device__ __forceinline__ bool xcd_tile(int i, int TT, int NT, int& mt, int& nt) {
    const int per = TT >> 3; if (i >= per) return false;
    const int t = (blockIdx.x & 7) * per + i; const int band = t / (8 * NT), rem = t - band * 8 * NT;
    nt = rem >> 3; mt = band * 8 + (rem & 7); return true;
}
__global__ void __launch_bounds__(256, 2) mega(Args a_unused) {
    extern __shared__ __attribute__((aligned(16))) char smem[];
    __shared__ uint4 xbw; __shared__ int s_unit;
    kargp_t kp = (kargp_t)__builtin_amdgcn_kernarg_segment_ptr();
    const int tid = threadIdx.x; const int G = gridDim.x;
    if (tid == 0) xbw = make_uint4(0u, 0u, 0u, 0u);
    __syncthreads();
    XcdBarrier xb;
    { const P p = getP(kp); xb = xcd_barrier_post(p.bar, (volatile LAS unsigned*)&xbw); }
    for (int u = blockIdx.x; u < 384 + NCONV + 272; u += G) {
        if (u < 384) { const P p = getP(kp); ada_unit(p, u, smem); } else if (u < 384 + NCONV) { const P p = getP(kp); conv_unit(p, 0, u - 384, smem); } else { const P p = getP(kp); misc0_unit(p, u - 384 - NCONV); }
    }
    cg::this_grid().sync();
    { const P p = getP(kp); ln_phase(p, 0, 0); }
    xcd_barrier(xb);
    float* rs = (float*)(smem + RS_OFF);
#pragma unroll 1
    for (int l = 0; l < 4; ++l) {
        for (int i = blockIdx.x >> 3; ; i += G >> 3) { int mt, nt; if (!xcd_tile(i, 80 * 17, 17, mt, nt)) break; const P p = getP(kp);
            EpiZ e{p.Z, mt * 256, nt * 128};
            gemm256(p.hbmix + (size_t)mt * 256 * DM, DM, p.WtIn + (size_t)nt * 128 * DM, DM, DM, smem, e); }
        xcd_barrier(xb);
        for (int rep2 = 0; rep2 < DUP_P2; ++rep2) {
        for (;;) {
            { const P pc = getP(kp); if (tid == 0) s_unit = atomicAdd(&pc.ctr[l * 4 + 0 + 2 * rep2], 1); }
            __syncthreads(); int u = s_unit; __syncthreads();
            if (u >= 320 + 480 + 640 + 64 + 352 + 640) break;
            if (u < 320) { const P p = getP(kp); rwprep_unit(p, l, u, smem); continue; }
            u -= 320;
            if (u < 480) { const P p = getP(kp); const int mt = u / 3, np = u % 3;
                rowscale128(p.Z, mt * 128, ZQ, 256, 1e-6f, rs);
                for (int k2 = 0; k2 < 2; ++k2) { const int nt = np * 2 + k2;
                    EpiQ e{p.Qb, rs, p.ropeC, p.ropeS, mt * 128, nt * 128};
                    gemm128<true>(p.Z + (size_t)mt * 128 * NIN + ZQ, NIN, p.WtQ + (size_t)nt * 128 * 256, 256, 256, smem, e); }
                __syncthreads(); continue; }
            u -= 480;
            if (u < 640) { const P p = getP(kp); const int mt = u >> 2, np = u & 3; const int R0 = mt * 128; const bool latr = R0 >= M_CTX;
                rowscale128(p.Z, R0, ZKV, 128, 1e-6f, rs);
                for (int k2 = 0; k2 < 2; ++k2) { const int nt = np * 2 + k2;
                    if (np < 2) { EpiKN e{latr ? p.Kb + (size_t)M_CTX * 768 : p.Kb, rs, latr ? R0 - M_CTX : R0, nt * 128};
                        gemm128<true>(p.Z + (size_t)R0 * NIN + ZKV, NIN, p.WtKVn + (size_t)nt * 128 * 128, 128, 128, smem, e); }
                    else { EpiKV e{latr ? p.Kb + (size_t)M_CTX * 768 : p.Kb, p.Vt, rs, latr ? R0 - M_CTX : R0, nt * 128, latr ? 12 : 8, latr ? (size_t)2097152 : (size_t)0};
                        gemm128<false>(p.Z + (size_t)R0 * NIN + ZKV, NIN, p.WtKVn + (size_t)nt * 128 * 128, 128, 128, smem, e); } }
                __syncthreads(); continue; }
            u -= 640;
            if (u < 64) { const P p = getP(kp); const int mt = u >> 2, np = u & 3;
                for (int k2 = 0; k2 < 2; ++k2) { const int nt = np * 2 + k2;
                    if (np < 2) { EpiKN e{p.Kc, nullptr, mt * 128, nt * 128};
                        gemm128<true>(p.CkvB + ((size_t)l * 2048 + mt * 128) * 128, 128, p.WtKV + (size_t)nt * 128 * 128, 128, 128, smem, e); }
                    else { EpiKV e{p.Kc, p.Vtc, nullptr, mt * 128, nt * 128, 9, (size_t)0};
                        gemm128<false>(p.CkvB + ((size_t)l * 2048 + mt * 128) * 128, 128, p.WtKV + (size_t)nt * 128 * 128, 128, 128, smem, e); } }
                continue; }
            u -= 64;
            if (u < 352) { const P p = getP(kp); for (int i = 0; i < 8; ++i) small_unit(p, l, u * 8 + i); continue; }
            u -= 352;
            { const P p = getP(kp); gmlp_unit(p, l, u, smem); }
        }
        xcd_barrier(xb);
        }
        for (int rep3 = 0; rep3 < DUP_P3; ++rep3) {
        for (;;) {
            { const P pc = getP(kp); if (tid == 0) s_unit = atomicAdd(&pc.ctr[l * 4 + 1 + 2 * rep3], 1); }
            __syncthreads(); int u = s_unit; __syncthreads();
            if (u >= NSCAN + 1280) break;
#ifdef PROBE_SCAN_ONLY
            if (rep3 == 1 && u >= NSCAN) break;
#endif
#ifdef PROBE_ATTN_ONLY
            if (rep3 == 1 && u < NSCAN) continue;
#endif
            if (u < NSCAN) { const P p = getP(kp); scan_unit(p, l, u, smem); } else { const P p = getP(kp); attn_unit(p, u - NSCAN, smem); }
        }
        xcd_barrier(xb);
        }
        { const P p = getP(kp); rwcomb_phase(p, l); }
        xcd_barrier(xb);
        for (int i = blockIdx.x >> 3; ; i += G >> 3) { int mt, nt; if (!xcd_tile(i, 160 * 8, 8, mt, nt)) break; const P p = getP(kp);
            EpiRes e{p.out, p.mod + ((size_t)l * 5 + modrow_of(mt * 128)) * 6144 + 2048, mt * 128, nt * 128};
            gemm128<true>(p.hbmix + (size_t)mt * 128 * DM, DM, p.WtOut + (size_t)nt * 128 * DM, DM, DM, smem, e); }
        xcd_barrier(xb);
        { const P p = getP(kp); ln_phase(p, l, 1); }
        xcd_barrier(xb);
        for (int rep5 = 0; rep5 < DUP_P5; ++rep5)
        for (int i = blockIdx.x >> 3; ; i += G >> 3) { int mt, nt; if (!xcd_tile(i, 80 * 44, 44, mt, nt)) break; const P p = getP(kp);
            EpiSwi e{p.hidden, mt * 256, nt * 128};
            gemm256(p.hbmix + (size_t)mt * 256 * DM, DM, p.WtF1 + (size_t)nt * 128 * DM, DM, DM, smem, e); }
        xcd_barrier(xb);
        for (int i = blockIdx.x >> 3; ; i += G >> 3) { int mt, nt; if (!xcd_tile(i, 160 * 8, 8, mt, nt)) break; const P p = getP(kp);
            EpiRes e{p.out, p.mod + ((size_t)l * 5 + modrow_of(mt * 128)) * 6144 + 5120, mt * 128, nt * 128};
            gemm128<true>(p.hidden + (size_t)mt * 128 * DFF, DFF, p.WtF2 + (size_t)nt * 128 * DFF, DFF, DFF, smem, e); }
        xcd_barrier(xb);
        { const P p = getP(kp); ln_phase(p, l, 2); }
        if (l < 3) { for (int u = blockIdx.x; u < NCONV; u += G) { const P p = getP(kp); conv_unit(p, l + 1, u, smem); } }
        xcd_barrier(xb);
    }
}

extern "C" void kernel_launch(void* const* d_in, const int* in_sizes, int n_in, void* d_out, int out_size, void* d_ws, size_t ws_size, hipStream_t stream) {
    static int grid_blocks = 0;
    if (!grid_blocks) {
        int dev = 0, cus = 0, per_cu = 0;
        (void)hipGetDevice(&dev);
        (void)hipDeviceGetAttribute(&cus, hipDeviceAttributeMultiprocessorCount, dev);
        (void)hipFuncSetAttribute((const void*)mega, hipFuncAttributeMaxDynamicSharedMemorySize, SMEM_BYTES);
        (void)hipOccupancyMaxActiveBlocksPerMultiprocessor(&per_cu, (const void*)mega, 256, SMEM_BYTES);
        if (per_cu > 2) per_cu = 2;
        if (per_cu < 1) per_cu = 1;
        grid_blocks = (cus * per_cu) & ~7;
    }
    if (WS_TOTAL > ws_size) { fprintf(stderr, "kernel_launch: workspace too small: need %zu have %zu\n", (size_t)WS_TOTAL, ws_size); return; }
    Args a{};
    for (int i = 0; i < 36; ++i) a.in[i] = (const float*)d_in[i];
    a.out = (float*)d_out; a.ws = (char*)d_ws;
    (void)hipMemsetAsync((char*)d_ws + OFF_BAR, 0, 16384 + 4096, stream);
    void* args[] = {&a};
    hipError_t e = hipLaunchCooperativeKernel((const void*)mega, dim3(grid_blocks), dim3(256), args, SMEM_BYTES, stream);
    if (e != hipSuccess) fprintf(stderr, "cooperative launch failed: %s (grid %d)\n", hipGetErrorString(e), grid_blocks);
}
```

```cpp
#include <hip/hip_runtime.h>
#include <hip/hip_cooperative_groups.h>
#include <cstdint>
#include <cstdio>
namespace cg = cooperative_groups;

typedef unsigned short bf16_t;
typedef short bf16x8 __attribute__((ext_vector_type(8)));
typedef float f32x4 __attribute__((ext_vector_type(4)));
typedef float f32x2 __attribute__((ext_vector_type(2)));
typedef float f32x16 __attribute__((ext_vector_type(16)));
typedef unsigned u32x4 __attribute__((ext_vector_type(4)));
typedef unsigned u32x2 __attribute__((ext_vector_type(2)));

#define M_ALL 20480
#define M_CTX 4096
#define DM 1024
#define NIN 2080
#define DFF 2816
#define ALPHA_F 1.6817928305074290f
#define QSCALE (0.10206207261596575f * 1.4426950408889634f)
#define LAS __attribute__((address_space(3)))
#ifndef DUP_P2
#define DUP_P2 1
#endif
#ifndef DUP_P3
#define DUP_P3 1
#endif
#ifndef DUP_P5
#define DUP_P5 1
#endif

#define ZQ 1152
#define ZKV 1408
#define ZKR 1536
#define ZU 1568
#define ZV 1824

#define LDS_STRIDE 72
#define TILE_BYTES (128 * LDS_STRIDE * 2)
#define RS_OFF (4 * TILE_BYTES)
#define SMEM_BYTES (RS_OFF + 3072)

struct P {
    const float *x_prompt, *x_sample, *cache_ckv, *cache_krope, *state_rwkv, *c, *c_ctx, *ada_w, *ada_b, *w_in, *rw_conv, *rw_w0, *rw_w2,
        *rw_a0, *rw_a2, *rw_g2, *rw_kk, *rw_ka, *rw_rk, *rw_gn_g, *rw_gn_b, *q_norm, *q_up, *kv_norm, *kv_up, *gm_g, *gm_b, *gm_ws, *gm_bs,
        *w_out, *ln1_g, *ln1_b, *ffn_in, *ffn_out, *ln2_g, *ln2_b;
    float* out;
    unsigned* bar; int* ctr; float* mod; float* ropeC; float* ropeS; bf16_t* CkvB;
    bf16_t *WtIn, *WtQ, *WtKVn, *WtKV, *WtOut, *WtF1, *WtF2, *WsB, *W2t, *A2t, *G2t;
    bf16_t *Z, *RKV, *Ee, *Aa, *Gg, *Qb, *Kb, *Kc, *Vt, *Vtc, *hbmix, *hidden;
    float* ydir;
};


struct Args { const float* in[36]; float* out; char* ws; };
typedef const __attribute__((address_space(4))) char* kargp_t;
constexpr size_t al256(size_t x) { return (x + 255) & ~(size_t)255; }
constexpr size_t OFF_BAR = 0;
constexpr size_t OFF_CTR = OFF_BAR + 16384;
constexpr size_t OFF_MOD = OFF_CTR + 4096;
constexpr size_t OFF_ROPEC = OFF_MOD + al256((size_t)4 * 5 * 6144 * 4);
constexpr size_t OFF_ROPES = OFF_ROPEC + 65536 * 4;
constexpr size_t OFF_CKVB = OFF_ROPES + 65536 * 4;
constexpr size_t OFF_WTIN = OFF_CKVB + (size_t)4 * 2048 * 128 * 2;
constexpr size_t OFF_WTQ = OFF_WTIN + (size_t)2176 * 1024 * 2;
constexpr size_t OFF_WTKVN = OFF_WTQ + (size_t)768 * 256 * 2;
constexpr size_t OFF_WTKV = OFF_WTKVN + (size_t)1024 * 128 * 2;
constexpr size_t OFF_WTOUT = OFF_WTKV + (size_t)1024 * 128 * 2;
constexpr size_t OFF_WTF1 = OFF_WTOUT + (size_t)1024 * 1024 * 2;
constexpr size_t OFF_WTF2 = OFF_WTF1 + (size_t)5632 * 1024 * 2;
constexpr size_t OFF_WSB = OFF_WTF2 + (size_t)1024 * DFF * 2;
constexpr size_t OFF_W2T = OFF_WSB + (size_t)65536 * 2;
constexpr size_t OFF_A2T = OFF_W2T + (size_t)2 * 256 * 64 * 2;
constexpr size_t OFF_G2T = OFF_A2T + (size_t)2 * 256 * 64 * 2;
constexpr size_t OFF_Z = OFF_G2T + (size_t)256 * 128 * 2;
constexpr size_t OFF_HIDDEN = OFF_Z;
constexpr size_t OFF_RKV = OFF_Z + al256((size_t)M_ALL * NIN * 2);
constexpr size_t OFF_EE = OFF_RKV + (size_t)M_ALL * 768 * 2;
constexpr size_t OFF_AA = OFF_EE + (size_t)2 * M_ALL * 256 * 2;
constexpr size_t OFF_GG = OFF_AA + (size_t)2 * M_ALL * 256 * 2;
constexpr size_t OFF_QB = OFF_GG + (size_t)M_ALL * 256 * 2;
constexpr size_t OFF_KB = OFF_QB + (size_t)M_ALL * 768 * 2;
constexpr size_t OFF_KC = OFF_KB + (size_t)M_ALL * 768 * 2;
constexpr size_t OFF_VT = OFF_KC + (size_t)2048 * 768 * 2;
constexpr size_t OFF_VTC = OFF_VT + (size_t)M_ALL * 512 * 2;
constexpr size_t OFF_YDIR = OFF_VTC + (size_t)2048 * 512 * 2;
constexpr size_t OFF_HBMIX = OFF_YDIR + (size_t)2 * M_ALL * 256 * 4;
constexpr size_t WS_TOTAL = OFF_HBMIX + (size_t)M_ALL * DM * 2;
static_assert(OFF_RKV + (size_t)M_ALL * 768 * 2 - OFF_HIDDEN >= (size_t)M_ALL * DFF * 2, "hidden overlay");

__device__ __forceinline__ P getP(kargp_t& kp) {
    asm volatile("" : "+s"(kp));
    typedef const float* const __attribute__((address_space(4)))* inp_t;
    inp_t in = (inp_t)kp;
    P p;
    p.x_prompt = in[0]; p.x_sample = in[1]; p.cache_ckv = in[2]; p.cache_krope = in[3]; p.state_rwkv = in[4]; p.c = in[5]; p.c_ctx = in[6];
    p.ada_w = in[7]; p.ada_b = in[8]; p.w_in = in[9]; p.rw_conv = in[10]; p.rw_w0 = in[11]; p.rw_w2 = in[12]; p.rw_a0 = in[13]; p.rw_a2 = in[14];
    p.rw_g2 = in[15]; p.rw_kk = in[16]; p.rw_ka = in[17]; p.rw_rk = in[18]; p.rw_gn_g = in[19]; p.rw_gn_b = in[20]; p.q_norm = in[21]; p.q_up = in[22];
    p.kv_norm = in[23]; p.kv_up = in[24]; p.gm_g = in[25]; p.gm_b = in[26]; p.gm_ws = in[27]; p.gm_bs = in[28]; p.w_out = in[29]; p.ln1_g = in[30];
    p.ln1_b = in[31]; p.ffn_in = in[32]; p.ffn_out = in[33]; p.ln2_g = in[34]; p.ln2_b = in[35];
    p.out = (float*)in[36]; char* ws = (char*)in[37];
    p.bar = (unsigned*)(ws + OFF_BAR); p.ctr = (int*)(ws + OFF_CTR); p.mod = (float*)(ws + OFF_MOD); p.ropeC = (float*)(ws + OFF_ROPEC); p.ropeS = (float*)(ws + OFF_ROPES);
    p.CkvB = (bf16_t*)(ws + OFF_CKVB); p.WtIn = (bf16_t*)(ws + OFF_WTIN); p.WtQ = (bf16_t*)(ws + OFF_WTQ); p.WtKVn = (bf16_t*)(ws + OFF_WTKVN); p.WtKV = (bf16_t*)(ws + OFF_WTKV);
    p.WtOut = (bf16_t*)(ws + OFF_WTOUT); p.WtF1 = (bf16_t*)(ws + OFF_WTF1); p.WtF2 = (bf16_t*)(ws + OFF_WTF2); p.WsB = (bf16_t*)(ws + OFF_WSB); p.W2t = (bf16_t*)(ws + OFF_W2T);
    p.A2t = (bf16_t*)(ws + OFF_A2T); p.G2t = (bf16_t*)(ws + OFF_G2T); p.Z = (bf16_t*)(ws + OFF_Z); p.RKV = (bf16_t*)(ws + OFF_RKV); p.Ee = (bf16_t*)(ws + OFF_EE); p.Aa = (bf16_t*)(ws + OFF_AA);
    p.Gg = (bf16_t*)(ws + OFF_GG); p.Qb = (bf16_t*)(ws + OFF_QB); p.Kb = (bf16_t*)(ws + OFF_KB); p.Kc = (bf16_t*)(ws + OFF_KC); p.Vt = (bf16_t*)(ws + OFF_VT); p.Vtc = (bf16_t*)(ws + OFF_VTC);
    p.hbmix = (bf16_t*)(ws + OFF_HBMIX); p.hidden = (bf16_t*)(ws + OFF_HIDDEN); p.ydir = (float*)(ws + OFF_YDIR);
    return p;
}

__device__ __forceinline__ float bf2f(bf16_t b) { return __uint_as_float(((unsigned)b) << 16); }
__device__ __forceinline__ unsigned pack2(float lo, float hi) { unsigned r; asm("v_cvt_pk_bf16_f32 %0, %1, %2" : "=v"(r) : "v"(lo), "v"(hi)); return r; }
__device__ __forceinline__ bf16_t f2bf(float f) { return (bf16_t)(pack2(f, 0.f) & 0xffffu); }
__device__ __forceinline__ float lo_bf(unsigned w) { return __uint_as_float(w << 16); }
__device__ __forceinline__ float hi_bf(unsigned w) { return __uint_as_float(w & 0xffff0000u); }
__device__ __forceinline__ float sigmoidf_(float x) { return __builtin_amdgcn_rcpf(1.0f + __builtin_amdgcn_exp2f(-1.4426950408889634f * x)); }
__device__ __forceinline__ float tanhf_(float x) { float e = __builtin_amdgcn_exp2f(2.8853900817779268f * x); return 1.0f - 2.0f * __builtin_amdgcn_rcpf(e + 1.0f); }
__device__ __forceinline__ float geluf_(float x) { return 0.5f * x * (1.0f + tanhf_(0.7978845608028654f * (x + 0.044715f * x * x * x))); }
template <int CTRL> __device__ __forceinline__ float dpp_add(float x) {
    int y = __builtin_amdgcn_update_dpp(0, __float_as_int(x), CTRL, 0xf, 0xf, false);
    return x + __int_as_float(y);
}
__device__ __forceinline__ float red4(float x) { x = dpp_add<0xB1>(x); x = dpp_add<0x4E>(x); return x; }
__device__ __forceinline__ float red8(float x) { x = red4(x); x = dpp_add<0x141>(x); return x; }
__device__ __forceinline__ float red16(float x) { x = red8(x); x = dpp_add<0x140>(x); return x; }
__device__ __forceinline__ int opaque_tid() { int t = threadIdx.x; asm volatile("" : "+v"(t)); return t; }
__device__ __forceinline__ int modrow_of(int row) { return row < M_CTX ? 0 : 1 + ((row - M_CTX) >> 12); }

#define XB_TMO 128
#define XB_XCNT(j) (256 + 64 * (j))
#define XB_XSUB(j) (1280 + 64 * (j))
#define XB_XGEN(j) (2304 + 64 * (j))
#define XB_TOP 3328
#define XB_TOPGEN 3392
#define XCD_BAR_WORDS 3456
#define XB_SPIN_CAP (1u << 22)
__device__ __forceinline__ unsigned xb_ld(unsigned* p) { return __hip_atomic_load(p, __ATOMIC_RELAXED, __HIP_MEMORY_SCOPE_AGENT); }
__device__ __forceinline__ unsigned xb_add(unsigned* p, unsigned v) { return __hip_atomic_fetch_add(p, v, __ATOMIC_RELAXED, __HIP_MEMORY_SCOPE_AGENT); }
__device__ __forceinline__ unsigned xb_xcc_id() { return (unsigned)__builtin_amdgcn_s_getreg((3 << 11) | 20) & 0xFu; }
#define XB_SPIN(cond, bar) do { unsigned _sp = 0; while (cond) { __builtin_amdgcn_s_sleep(1); \
    if ((++_sp & 255u) == 0u) { if (xb_ld(&(bar)[XB_TMO])) break; if (_sp > XB_SPIN_CAP) { atomicAdd(&(bar)[XB_TMO], 1u); break; } } } } while (0)
struct XcdBarrier { unsigned* bar; unsigned x; volatile LAS unsigned* st; };
__device__ __forceinline__ XcdBarrier xcd_barrier_post(unsigned* bar, volatile LAS unsigned* st) {
    XcdBarrier b; b.bar = bar; b.x = xb_xcc_id(); b.st = st;
    if (threadIdx.x == 0) (void)xb_add(&bar[XB_XCNT(b.x)], 1u);
    return b;
}
__device__ __forceinline__ void xcd_barrier_complete(unsigned* bar, unsigned x, unsigned& nloc, unsigned& nx) {
    const unsigned G = gridDim.x * gridDim.y * gridDim.z;
    unsigned sum, cnt, mine, sp = 0u;
    for (;;) {
        sum = 0u; cnt = 0u; mine = 0u;
#pragma unroll
        for (unsigned j = 0; j < 16; ++j) { const unsigned c = xb_ld(&bar[XB_XCNT(j)]); sum += c; cnt += (c > 0u) ? 1u : 0u; mine = (j == x) ? c : mine; }
        if (sum == G) break;
        __builtin_amdgcn_s_sleep(1);
        if ((++sp & 255u) == 0u) { if (xb_ld(&bar[XB_TMO])) break; if (sp > XB_SPIN_CAP) { atomicAdd(&bar[XB_TMO], 1u); break; } }
    }
    nloc = mine > 0u ? mine : 1u; nx = cnt > 0u ? cnt : 1u;
}
__device__ __forceinline__ void xcd_barrier(const XcdBarrier& b) {
    asm volatile("s_waitcnt vmcnt(0)" ::: "memory");
    __syncthreads();
    if (threadIdx.x == 0) {
        unsigned* bar = b.bar;
        __builtin_amdgcn_s_waitcnt(0);
        unsigned nloc = b.st[0], nx = b.st[1];
        if (nloc == 0u) { xcd_barrier_complete(bar, b.x, nloc, nx); b.st[0] = nloc; b.st[1] = nx; }
        const unsigned old = xb_add(&bar[XB_XSUB(b.x)], 1u);
        const unsigned gen = old / nloc;
        if (old + 1u == (gen + 1u) * nloc) {
            __builtin_amdgcn_fence(__ATOMIC_RELEASE, "agent");
            asm volatile("s_waitcnt vmcnt(0)" ::: "memory");
            const unsigned og = xb_add(&bar[XB_TOP], 1u);
            const unsigned tg = og / nx;
            if (og + 1u == (tg + 1u) * nx) xb_add(&bar[XB_TOPGEN], 1u);
            else XB_SPIN(xb_ld(&bar[XB_TOPGEN]) == tg, bar);
            __builtin_amdgcn_fence(__ATOMIC_ACQUIRE, "agent");
            xb_add(&bar[XB_XGEN(b.x)], 1u);
            asm volatile("s_waitcnt vmcnt(0)" ::: "memory");
        } else {
            XB_SPIN(xb_ld(&bar[XB_XGEN(b.x)]) == gen, bar);
            __builtin_amdgcn_fence(__ATOMIC_ACQUIRE, "agent");
            asm volatile("s_waitcnt vmcnt(0)" ::: "memory");
        }
    }
    __syncthreads();
}

template <bool TR, class Epi>
__device__ __forceinline__ void gemm128(const bf16_t* __restrict__ A, int lda, const bf16_t* __restrict__ B, int ldb, int K, char* smem, const Epi& epi) {
    const int tid = opaque_tid(), lane = tid & 63, wid = tid >> 6, wr = wid >> 1, wc = wid & 1, fr = lane & 15, fq = lane >> 4;
    f32x4 acc[4][4];
#pragma unroll
    for (int m = 0; m < 4; ++m)
#pragma unroll
        for (int n = 0; n < 4; ++n) acc[m][n] = (f32x4){0.f, 0.f, 0.f, 0.f};
    const int crow = tid >> 3, ckc = tid & 7;
    const bf16_t* ap = A + (size_t)crow * lda + ckc * 8;
    const bf16_t* bp = B + (size_t)crow * ldb + ckc * 8;
    u32x4 ra[4], rb[4];
#pragma unroll
    for (int i = 0; i < 4; ++i) { ra[i] = *(const u32x4*)(ap + (size_t)(32 * i) * lda); rb[i] = *(const u32x4*)(bp + (size_t)(32 * i) * ldb); }
    {
        char* sa = smem; char* sb = smem + TILE_BYTES;
#pragma unroll
        for (int i = 0; i < 4; ++i) { *(u32x4*)(sa + ((crow + 32 * i) * LDS_STRIDE + ckc * 8) * 2) = ra[i]; *(u32x4*)(sb + ((crow + 32 * i) * LDS_STRIDE + ckc * 8) * 2) = rb[i]; }
    }
    __syncthreads();
    const int nk = K >> 6;
    for (int kt = 0; kt < nk; ++kt) {
        const bool more = (kt + 1 < nk);
        if (more) {
            const int k0 = (kt + 1) << 6;
#pragma unroll
            for (int i = 0; i < 4; ++i) { ra[i] = *(const u32x4*)(ap + (size_t)(32 * i) * lda + k0); rb[i] = *(const u32x4*)(bp + (size_t)(32 * i) * ldb + k0); }
        }
        const char* sa = smem + (kt & 1) * 2 * TILE_BYTES; const char* sb = sa + TILE_BYTES;
#pragma unroll
        for (int ks = 0; ks < 2; ++ks) {
            bf16x8 af[4], bfr[4];
#pragma unroll
            for (int m = 0; m < 4; ++m) af[m] = *(const bf16x8*)(sa + ((wr * 64 + m * 16 + fr) * LDS_STRIDE + ks * 32 + fq * 8) * 2);
#pragma unroll
            for (int n = 0; n < 4; ++n) bfr[n] = *(const bf16x8*)(sb + ((wc * 64 + n * 16 + fr) * LDS_STRIDE + ks * 32 + fq * 8) * 2);
            __builtin_amdgcn_s_setprio(1);
#pragma unroll
            for (int m = 0; m < 4; ++m)
#pragma unroll
                for (int n = 0; n < 4; ++n) acc[m][n] = TR ? __builtin_amdgcn_mfma_f32_16x16x32_bf16(bfr[n], af[m], acc[m][n], 0, 0, 0) : __builtin_amdgcn_mfma_f32_16x16x32_bf16(af[m], bfr[n], acc[m][n], 0, 0, 0);
            __builtin_amdgcn_s_setprio(0);
        }
        if (more) {
            char* da = smem + ((kt + 1) & 1) * 2 * TILE_BYTES; char* db = da + TILE_BYTES;
#pragma unroll
            for (int i = 0; i < 4; ++i) { *(u32x4*)(da + ((crow + 32 * i) * LDS_STRIDE + ckc * 8) * 2) = ra[i]; *(u32x4*)(db + ((crow + 32 * i) * LDS_STRIDE + ckc * 8) * 2) = rb[i]; }
        }
        __syncthreads();
    }
    epi(acc, wr * 64, wc * 64, fr, fq);
}


#define L2_STRIDE 40
#define A2_BYTES (256 * L2_STRIDE * 2)
#define B2_BYTES (128 * L2_STRIDE * 2)
#define ST2_BYTES (A2_BYTES + B2_BYTES)
template <class Epi>
__device__ __forceinline__ void gemm256(const bf16_t* __restrict__ A, int lda, const bf16_t* __restrict__ B, int ldb, int K, char* smem, const Epi& epi) {
    const int tid = opaque_tid(), lane = tid & 63, wid = tid >> 6, wr = wid >> 1, wc = wid & 1, fr = lane & 15, fq = lane >> 4;
    f32x4 acc[2][4][4];
#pragma unroll
    for (int hh = 0; hh < 2; ++hh)
#pragma unroll
        for (int m = 0; m < 4; ++m)
#pragma unroll
            for (int n = 0; n < 4; ++n) acc[hh][m][n] = (f32x4){0.f, 0.f, 0.f, 0.f};
    const int crow = tid >> 2, ckc = tid & 3;
    const bf16_t* ap = A + (size_t)crow * lda + ckc * 8;
    const bf16_t* bp = B + (size_t)crow * ldb + ckc * 8;
    u32x4 ra[4], rb[2];
#pragma unroll
    for (int i = 0; i < 4; ++i) ra[i] = *(const u32x4*)(ap + (size_t)(64 * i) * lda);
#pragma unroll
    for (int i = 0; i < 2; ++i) rb[i] = *(const u32x4*)(bp + (size_t)(64 * i) * ldb);
    {
        char* sa = smem; char* sb = smem + A2_BYTES;
#pragma unroll
        for (int i = 0; i < 4; ++i) *(u32x4*)(sa + ((crow + 64 * i) * L2_STRIDE + ckc * 8) * 2) = ra[i];
#pragma unroll
        for (int i = 0; i < 2; ++i) *(u32x4*)(sb + ((crow + 64 * i) * L2_STRIDE + ckc * 8) * 2) = rb[i];
    }
    __syncthreads();
    const int nk = K >> 5;
    for (int kt = 0; kt < nk; ++kt) {
        const bool more = (kt + 1 < nk);
        if (more) {
            const int k0 = (kt + 1) << 5;
#pragma unroll
            for (int i = 0; i < 4; ++i) ra[i] = *(const u32x4*)(ap + (size_t)(64 * i) * lda + k0);
#pragma unroll
            for (int i = 0; i < 2; ++i) rb[i] = *(const u32x4*)(bp + (size_t)(64 * i) * ldb + k0);
        }
        const char* sa = smem + (kt & 1) * ST2_BYTES; const char* sb = sa + A2_BYTES;
        bf16x8 bfr[4];
#pragma unroll
        for (int n = 0; n < 4; ++n) bfr[n] = *(const bf16x8*)(sb + ((wc * 64 + n * 16 + fr) * L2_STRIDE + fq * 8) * 2);
#pragma unroll
        for (int hh = 0; hh < 2; ++hh) {
            bf16x8 af[4];
#pragma unroll
            for (int m = 0; m < 4; ++m) af[m] = *(const bf16x8*)(sa + ((wr * 128 + hh * 64 + m * 16 + fr) * L2_STRIDE + fq * 8) * 2);
            __builtin_amdgcn_s_setprio(1);
#pragma unroll
            for (int m = 0; m < 4; ++m)
#pragma unroll
                for (int n = 0; n < 4; ++n) acc[hh][m][n] = __builtin_amdgcn_mfma_f32_16x16x32_bf16(bfr[n], af[m], acc[hh][m][n], 0, 0, 0);
            __builtin_amdgcn_s_setprio(0);
        }
        if (more) {
            char* da = smem + ((kt + 1) & 1) * ST2_BYTES; char* db = da + A2_BYTES;
#pragma unroll
            for (int i = 0; i < 4; ++i) *(u32x4*)(da + ((crow + 64 * i) * L2_STRIDE + ckc * 8) * 2) = ra[i];
#pragma unroll
            for (int i = 0; i < 2; ++i) *(u32x4*)(db + ((crow + 64 * i) * L2_STRIDE + ckc * 8) * 2) = rb[i];
        }
        __syncthreads();
    }
    epi(acc[0], wr * 128, wc * 64, fr, fq);
    epi(acc[1], wr * 128 + 64, wc * 64, fr, fq);
}

struct EpiZ {
    bf16_t* Z; int R0, C0;
    __device__ __forceinline__ void operator()(f32x4 (&acc)[4][4], int r0, int c0, int fr, int fq) const {
#pragma unroll
        for (int n = 0; n < 4; ++n) { const int col = C0 + c0 + n * 16 + fq * 4; if (col < NIN) {
#pragma unroll
            for (int m = 0; m < 4; ++m) { u32x2 w; w.x = pack2(acc[m][n][0], acc[m][n][1]); w.y = pack2(acc[m][n][2], acc[m][n][3]);
                *(u32x2*)(Z + (size_t)(R0 + r0 + m * 16 + fr) * NIN + col) = w; } } }
    }
};
struct EpiQ {
    bf16_t* Q; const float* rs; const float* ropeC; const float* ropeS; int R0, C0;
    __device__ __forceinline__ void operator()(f32x4 (&acc)[4][4], int r0, int c0, int fr, int fq) const {
        const bool lat = R0 >= M_CTX;
#pragma unroll
        for (int n = 0; n < 4; ++n) {
            const int cb = C0 + c0 + n * 16; const int hcs = cb % 96;
            if (lat && hcs == 80) continue;
            const bool rot = lat && hcs == 64;
#pragma unroll
            for (int m = 0; m < 4; ++m) {
                const int rl = r0 + m * 16 + fr; const int row = R0 + rl; const float sc = rs[rl] * QSCALE;
                const f32x4 x1 = acc[m][n] * sc; bf16_t* qp = Q + (size_t)row * 768 + cb + fq * 4;
                if (rot) {
                    const f32x4 x2 = acc[m][(n + 1) & 3] * sc; const int t = (row - M_CTX) & 4095;
                    const f32x4 cv = *(const f32x4*)(ropeC + t * 16 + fq * 4), sv = *(const f32x4*)(ropeS + t * 16 + fq * 4);
                    const f32x4 o1 = x1 * cv - x2 * sv, o2 = x1 * sv + x2 * cv;
                    u32x2 w; w.x = pack2(o1[0], o1[1]); w.y = pack2(o1[2], o1[3]); *(u32x2*)qp = w;
                    w.x = pack2(o2[0], o2[1]); w.y = pack2(o2[2], o2[3]); *(u32x2*)(qp + 16) = w;
                } else { u32x2 w; w.x = pack2(x1[0], x1[1]); w.y = pack2(x1[2], x1[3]); *(u32x2*)qp = w; }
            }
        }
    }
};
struct EpiKN {
    bf16_t* Kd; const float* rs; int R0, C0;
    __device__ __forceinline__ void operator()(f32x4 (&acc)[4][4], int r0, int c0, int fr, int fq) const {
#pragma unroll
        for (int n = 0; n < 4; ++n) { const int col = C0 + c0 + n * 16 + fq * 4; const int h = col >> 6, d = col & 63;
#pragma unroll
            for (int m = 0; m < 4; ++m) { const int rl = r0 + m * 16 + fr; const f32x4 v = acc[m][n] * (rs ? rs[rl] : 1.0f);
                u32x2 w; w.x = pack2(v[0], v[1]); w.y = pack2(v[2], v[3]); *(u32x2*)(Kd + (size_t)(R0 + rl) * 768 + h * 96 + d) = w; } }
    }
};
struct EpiKV {
    bf16_t* Kd; bf16_t* Vd; const float* rs; int R0, C0; int seqshift; size_t vbase0;
    __device__ __forceinline__ void operator()(f32x4 (&acc)[4][4], int r0, int c0, int fr, int fq) const {
#pragma unroll
        for (int n = 0; n < 4; ++n) {
            const int col = C0 + c0 + n * 16 + fr;
#pragma unroll
            for (int m = 0; m < 4; ++m) {
                const int rl = r0 + m * 16 + fq * 4; const int row = R0 + rl;
                float v[4];
#pragma unroll
                for (int j = 0; j < 4; ++j) v[j] = acc[m][n][j] * (rs ? rs[rl + j] : 1.0f);
                if (col < 512) {
                    const int h = col >> 6, d = col & 63;
#pragma unroll
                    for (int j = 0; j < 4; ++j) Kd[(size_t)(row + j) * 768 + h * 96 + d] = f2bf(v[j]);
                } else {
                    const int vc = col - 512, h = vc >> 6, dv = vc & 63; const int b = row >> seqshift, t = row & ((1 << seqshift) - 1);
                    u32x2 w; w.x = pack2(v[0], v[1]); w.y = pack2(v[2], v[3]);
                    *(u32x2*)(Vd + vbase0 + ((size_t)((b * 8 + h) * 64 + dv) << seqshift) + t) = w;
                }
            }
        }
    }
};
struct EpiRes {
    float* X; const float* gate; int R0, C0;
    __device__ __forceinline__ void operator()(f32x4 (&acc)[4][4], int r0, int c0, int fr, int fq) const {
#pragma unroll
        for (int n = 0; n < 4; ++n) { const int col = C0 + c0 + n * 16 + fq * 4; const f32x4 g = *(const f32x4*)(gate + col);
#pragma unroll
            for (int m = 0; m < 4; ++m) { float* px = X + (size_t)(R0 + r0 + m * 16 + fr) * DM + col; const f32x4 xv = *(const f32x4*)px; *(f32x4*)px = ALPHA_F * xv + g * acc[m][n]; } }
    }
};
struct EpiSwi {
    bf16_t* H; int R0, C0;
    __device__ __forceinline__ void operator()(f32x4 (&acc)[4][4], int r0, int c0, int fr, int fq) const {
        const int hb = ((C0 + c0) >> 1) + fq * 4;
#pragma unroll
        for (int n = 0; n < 2; ++n)
#pragma unroll
            for (int m = 0; m < 4; ++m) { float o[4];
#pragma unroll
                for (int j = 0; j < 4; ++j) { const float g = acc[m][n][j], u = acc[m][n + 2][j]; o[j] = g * sigmoidf_(g) * u; }
                u32x2 w; w.x = pack2(o[0], o[1]); w.y = pack2(o[2], o[3]);
                *(u32x2*)(H + (size_t)(R0 + r0 + m * 16 + fr) * DFF + hb + n * 16) = w; }
    }
};

__device__ __forceinline__ void ada_unit(const P& p, int u, char* smem) {
    const int tid = opaque_tid(); const int l = u / 96, c0 = (u % 96) * 64;
    float* cs = (float*)smem;
    for (int i = tid; i < 5 * 1024; i += 256) { const int r = i >> 10, k = i & 1023; const float v = (r == 0) ? p.c_ctx[k] : p.c[(r - 1) * 1024 + k]; cs[i] = v * sigmoidf_(v); }
    __syncthreads();
    const int col = tid & 63, kq = tid >> 6;
    float s0 = 0.f, s1 = 0.f, s2 = 0.f, s3 = 0.f, s4 = 0.f;
    const float* w = p.ada_w + ((size_t)l * 1024 + kq * 256) * 6144 + c0 + col;
    const float* cq = cs + kq * 256;
    for (int k = 0; k < 256; ++k) { const float wv = w[(size_t)k * 6144]; s0 += cq[k] * wv; s1 += cq[1024 + k] * wv; s2 += cq[2048 + k] * wv; s3 += cq[3072 + k] * wv; s4 += cq[4096 + k] * wv; }
    float* red = cs + 5 * 1024;
    red[(kq * 5 + 0) * 64 + col] = s0; red[(kq * 5 + 1) * 64 + col] = s1; red[(kq * 5 + 2) * 64 + col] = s2; red[(kq * 5 + 3) * 64 + col] = s3; red[(kq * 5 + 4) * 64 + col] = s4;
    __syncthreads();
    for (int o = tid; o < 320; o += 256) { const int i = o >> 6, cc = o & 63;
        const float v = red[(0 * 5 + i) * 64 + cc] + red[(1 * 5 + i) * 64 + cc] + red[(2 * 5 + i) * 64 + cc] + red[(3 * 5 + i) * 64 + cc] + p.ada_b[l * 6144 + c0 + cc];
        p.mod[((size_t)l * 5 + i) * 6144 + c0 + cc] = v; }
    __syncthreads();
}
__device__ __forceinline__ int map_col(int kind, int n) {
    if (kind == 1) { const int blk = n >> 6, r = n & 63; return r < 32 ? blk * 32 + r : DFF + blk * 32 + (r - 32); }
    if (kind == 2) { if (n < 512) return (n >> 6) * 128 + (n & 63); const int vc = n - 512; return (vc >> 6) * 128 + 64 + (vc & 63); }
    return n;
}
__device__ __forceinline__ void conv_tile(const float* src, int ldsrc, bf16_t* dst, bf16_t* dst2, int Kdst, int n0, int k0, int kind, int Nvalid, const float* kscale, char* smem) {
    const int tid = opaque_tid(); float* tile = (float*)smem;
    { const int j = tid & 63, i0 = tid >> 6; const int n = n0 + j; const int sc = (n < Nvalid) ? map_col(kind, n) : -1;
#pragma unroll 4
      for (int ii = 0; ii < 16; ++ii) { const int i = i0 + 4 * ii; tile[i * 65 + j] = (sc >= 0) ? src[(size_t)(k0 + i) * ldsrc + sc] : 0.f; } }
    __syncthreads();
    { const int i = tid & 63, j0 = tid >> 6; const float ks = kscale ? kscale[k0 + i] : 1.f;
#pragma unroll 4
      for (int jj = 0; jj < 16; ++jj) { const int jx = j0 + 4 * jj; const float v = tile[i * 65 + jx];
          dst[(size_t)(n0 + jx) * Kdst + k0 + i] = f2bf(v * ks); if (dst2) dst2[(size_t)(n0 + jx) * Kdst + k0 + i] = f2bf(v); } }
    __syncthreads();
}
#define NCONV 3032
__device__ __forceinline__ void conv_unit(const P& p, int l, int u, char* smem) {
    const float* src; int ldsrc; bf16_t* dst; bf16_t* dst2 = nullptr; int Kdst, n0, k0, kind = 0, Nvalid; const float* kscale = nullptr;
    if (u < 544) { src = p.w_in + (size_t)l * 1024 * NIN; ldsrc = NIN; dst = p.WtIn; Kdst = 1024; n0 = (u / 16) * 64; k0 = (u % 16) * 64; Nvalid = NIN; }
    else if (u < 592) { u -= 544; src = p.q_up + (size_t)l * 256 * 768; ldsrc = 768; dst = p.WtQ; Kdst = 256; n0 = (u / 4) * 64; k0 = (u % 4) * 64; Nvalid = 768; kscale = p.q_norm + l * 256; }
    else if (u < 624) { u -= 592; src = p.kv_up + (size_t)l * 128 * 1024; ldsrc = 1024; dst = p.WtKVn; dst2 = p.WtKV; Kdst = 128; n0 = (u / 2) * 64; k0 = (u % 2) * 64; kind = 2; Nvalid = 1024; kscale = p.kv_norm + l * 128; }
    else if (u < 880) { u -= 624; src = p.w_out + (size_t)l * 1024 * 1024; ldsrc = 1024; dst = p.WtOut; Kdst = 1024; n0 = (u / 16) * 64; k0 = (u % 16) * 64; Nvalid = 1024; }
    else if (u < 2288) { u -= 880; src = p.ffn_in + (size_t)l * 1024 * 5632; ldsrc = 5632; dst = p.WtF1; Kdst = 1024; n0 = (u / 16) * 64; k0 = (u % 16) * 64; kind = 1; Nvalid = 5632; }
    else if (u < 2992) { u -= 2288; src = p.ffn_out + (size_t)l * DFF * 1024; ldsrc = 1024; dst = p.WtF2; Kdst = DFF; n0 = (u / 44) * 64; k0 = (u % 44) * 64; Nvalid = 1024; }
    else if (u < 3008) { u -= 2992; const float* sp = p.gm_ws + (size_t)l * 65536 + u * 4096; bf16_t* d = p.WsB + u * 4096; for (int i = threadIdx.x; i < 4096; i += 256) d[i] = f2bf(sp[i]); return; }
    else if (u < 3016) { u -= 3008; const int d = u >> 2; src = p.rw_w2 + ((size_t)l * 2 + d) * 64 * 256; ldsrc = 256; dst = p.W2t + d * 256 * 64; Kdst = 64; n0 = (u & 3) * 64; k0 = 0; Nvalid = 256; }
    else if (u < 3024) { u -= 3016; const int d = u >> 2; src = p.rw_a2 + ((size_t)l * 2 + d) * 64 * 256; ldsrc = 256; dst = p.A2t + d * 256 * 64; Kdst = 64; n0 = (u & 3) * 64; k0 = 0; Nvalid = 256; }
    else { u -= 3024; src = p.rw_g2 + (size_t)l * 128 * 256; ldsrc = 256; dst = p.G2t; Kdst = 128; n0 = (u / 2) * 64; k0 = (u % 2) * 64; Nvalid = 256; }
    conv_tile(src, ldsrc, dst, dst2, Kdst, n0, k0, kind, Nvalid, kscale, smem);
}
__device__ __forceinline__ void misc0_unit(const P& p, int u) {
    const int tid = opaque_tid();
    if (u < 16) {
        for (int e = tid; e < 4096; e += 256) { const int idx = u * 4096 + e; const int t = idx >> 4, i = idx & 15;
            const float pos = (float)((i < 8) ? (t >> 6) : (t & 63)); const float inv = exp2f(-(float)(i & 7) * 1.6609640474436813f);
            const float ang = pos * inv; const float kf = rintf(ang * 0.15915494309189535f);
            float r = fmaf(-kf, 6.28318548202514648f, ang); r = fmaf(-kf, -1.74845553e-7f, r);
            p.ropeC[idx] = __cosf(r); p.ropeS[idx] = __sinf(r); }
    } else {
        const int v = u - 16;
        for (int e = tid; e < 4096; e += 256) { const int idx = v * 4096 + e;
            const int c = idx & 127, t = (idx >> 7) & 511, b = (idx >> 16) & 3, l = idx >> 18;
            p.CkvB[idx] = f2bf(p.cache_ckv[(((size_t)b * 4 + l) * 512 + t) * 128 + c]); }
    }
}

__device__ __forceinline__ void ln_phase(const P& p, int l, int which) {
    const int tid = opaque_tid(), lane = tid & 63, wid = tid >> 6;
    const float* g = which == 1 ? p.ln1_g + l * DM : p.ln2_g + l * DM; const float* bb = which == 1 ? p.ln1_b + l * DM : p.ln2_b + l * DM;
    const int ml = which == 2 ? l + 1 : l; const int shoff = which == 1 ? 3072 : 0, scoff = which == 1 ? 4096 : 1024;
    const bool dohb = !(which == 2 && l == 3);
    for (int row = blockIdx.x * 4 + wid; row < M_ALL; row += gridDim.x * 4) {
        float* xr = p.out + (size_t)row * DM;
        const float* src = which == 0 ? (row < M_CTX ? p.x_prompt + (size_t)row * DM : p.x_sample + (size_t)(row - M_CTX) * DM) : xr;
        f32x4 v[4];
#pragma unroll
        for (int i = 0; i < 4; ++i) v[i] = *(const f32x4*)(src + lane * 4 + 256 * i);
        if (which != 0) {
            float s = 0.f;
#pragma unroll
            for (int i = 0; i < 4; ++i) s += (v[i][0] + v[i][1]) + (v[i][2] + v[i][3]);
            s = red16(s); s += __shfl_xor(s, 16); s += __shfl_xor(s, 32);
            const float mu = s * (1.0f / 1024.0f); float q = 0.f;
#pragma unroll
            for (int i = 0; i < 4; ++i) { const f32x4 d = v[i] - mu; q += (d[0] * d[0] + d[1] * d[1]) + (d[2] * d[2] + d[3] * d[3]); }
            q = red16(q); q += __shfl_xor(q, 16); q += __shfl_xor(q, 32);
            const float rstd = rsqrtf(q * (1.0f / 1024.0f) + 1e-5f);
#pragma unroll
            for (int i = 0; i < 4; ++i) { const f32x4 gg = *(const f32x4*)(g + lane * 4 + 256 * i), bv = *(const f32x4*)(bb + lane * 4 + 256 * i); v[i] = (v[i] - mu) * rstd * gg + bv; }
        }
#pragma unroll
        for (int i = 0; i < 4; ++i) *(f32x4*)(xr + lane * 4 + 256 * i) = v[i];
        if (dohb) {
            const float* md = p.mod + ((size_t)ml * 5 + modrow_of(row)) * 6144;
#pragma unroll
            for (int i = 0; i < 4; ++i) { const f32x4 sh = *(const f32x4*)(md + shoff + lane * 4 + 256 * i), sc = *(const f32x4*)(md + scoff + lane * 4 + 256 * i);
                const f32x4 h = v[i] * (1.0f + sc) + sh; u32x2 w; w.x = pack2(h[0], h[1]); w.y = pack2(h[2], h[3]);
                *(u32x2*)(p.hbmix + (size_t)row * DM + lane * 4 + 256 * i) = w; }
        }
    }
}

__device__ __forceinline__ void rwprep_unit(const P& p, int l, int u, char* smem) {
    const int tid = opaque_tid(), lane = tid & 63, wid = tid >> 6, fr = lane & 15, fq = lane >> 4;
    const int R0 = u * 64;
    const int ss = R0 < M_CTX ? (R0 & ~255) : M_CTX + ((R0 - M_CTX) & ~4095); const int se = ss + (R0 < M_CTX ? 256 : 4096);
    bf16_t* XW = (bf16_t*)smem; bf16_t* XA = XW + 64 * 136; bf16_t* XG = XA + 64 * 136;
    const float* cw = p.rw_conv + (size_t)l * 3 * 1152;
    for (int it = tid; it < 1152; it += 256) {
        const int cc = it % 144, tg = it / 144; const int c = cc * 8;
        float w0[8], w1[8], w2[8];
#pragma unroll
        for (int i = 0; i < 8; ++i) { w0[i] = cw[c + i]; w1[i] = cw[1152 + c + i]; w2[i] = cw[2304 + c + i]; }
        const int rfirst = R0 + tg * 8;
        u32x4 rows[10];
#pragma unroll
        for (int i = 0; i < 10; ++i) { const int r = rfirst - 1 + i; rows[i] = (u32x4){0u, 0u, 0u, 0u};
            if (r >= ss && r < se) rows[i] = *(const u32x4*)(p.Z + (size_t)r * NIN + c); }
#pragma unroll
        for (int tt = 0; tt < 8; ++tt) {
            const int row = rfirst + tt;
            const u32x4 prev = rows[tt], cur = rows[tt + 1], nxt = rows[tt + 2];
            float o[8];
#pragma unroll
            for (int i = 0; i < 4; ++i) {
                o[2 * i] = w0[2 * i] * lo_bf(prev[i]) + w1[2 * i] * lo_bf(cur[i]) + w2[2 * i] * lo_bf(nxt[i]);
                o[2 * i + 1] = w0[2 * i + 1] * hi_bf(prev[i]) + w1[2 * i + 1] * hi_bf(cur[i]) + w2[2 * i + 1] * hi_bf(nxt[i]);
            }
            if (c >= 768 && c < 896) {
#pragma unroll
                for (int i = 0; i < 8; ++i) o[i] = tanhf_(o[i]);
            } else if (c >= 1024) {
#pragma unroll
                for (int i = 0; i < 8; ++i) o[i] = sigmoidf_(o[i]);
            }
            u32x4 w; w.x = pack2(o[0], o[1]); w.y = pack2(o[2], o[3]); w.z = pack2(o[4], o[5]); w.w = pack2(o[6], o[7]);
            const int tl = tg * 8 + tt;
            if (c < 768) *(u32x4*)(p.RKV + (size_t)row * 768 + c) = w;
            else if (c < 896) *(u32x4*)(XW + tl * 136 + (c - 768)) = w;
            else if (c < 1024) *(u32x4*)(XA + tl * 136 + (c - 896)) = w;
            else *(u32x4*)(XG + tl * 136 + (c - 1024)) = w;
        }
    }
    __syncthreads();
#pragma unroll 1
    for (int mh = 0; mh < 10; ++mh) {
        const int mat = mh >> 1, nh = mh & 1;
        const int d = mat & 1; const bf16_t* As; const bf16_t* Bw; int kofs, nks, ldw;
        if (mat < 2) { As = XW; Bw = p.W2t + d * 256 * 64; kofs = d * 64; nks = 2; ldw = 64; }
        else if (mat < 4) { As = XA; Bw = p.A2t + d * 256 * 64; kofs = d * 64; nks = 2; ldw = 64; }
        else { As = XG; Bw = p.G2t; kofs = 0; nks = 4; ldw = 128; }
        f32x4 acc[4][2];
#pragma unroll
        for (int m = 0; m < 4; ++m)
#pragma unroll
            for (int n = 0; n < 2; ++n) acc[m][n] = (f32x4){0.f, 0.f, 0.f, 0.f};
        bf16x8 bw[4][2];
#pragma unroll
        for (int ks = 0; ks < 4; ++ks)
#pragma unroll
            for (int n = 0; n < 2; ++n) bw[ks][n] = *(const bf16x8*)(Bw + (size_t)(wid * 64 + nh * 32 + n * 16 + fr) * ldw + (ks < nks ? ks : 0) * 32 + fq * 8);
#pragma unroll
        for (int ks = 0; ks < 4; ++ks) {
            if (ks < nks) {
                bf16x8 af[4];
#pragma unroll
                for (int m = 0; m < 4; ++m) af[m] = *(const bf16x8*)(As + (m * 16 + fr) * 136 + kofs + ks * 32 + fq * 8);
#pragma unroll
                for (int m = 0; m < 4; ++m)
#pragma unroll
                    for (int n = 0; n < 2; ++n) acc[m][n] = __builtin_amdgcn_mfma_f32_16x16x32_bf16(bw[ks][n], af[m], acc[m][n], 0, 0, 0);
            }
        }
#pragma unroll
        for (int n = 0; n < 2; ++n) {
            const int c = wid * 64 + nh * 32 + n * 16 + fq * 4;
            f32x4 bias = (f32x4){0.f, 0.f, 0.f, 0.f}; if (mat < 2) bias = *(const f32x4*)(p.rw_w0 + (l * 2 + d) * 256 + c); else if (mat < 4) bias = *(const f32x4*)(p.rw_a0 + (l * 2 + d) * 256 + c);
            bf16_t* dst; float mul;
            if (mat < 2) { dst = p.Ee + ((size_t)d * M_ALL + R0) * 256 + c; mul = 0.6065306597126334f; }
            else if (mat < 4) { dst = p.Aa + ((size_t)d * M_ALL + R0) * 256 + c; mul = 1.0f; }
            else { dst = p.Gg + (size_t)R0 * 256 + c; mul = 1.0f; }
#pragma unroll
            for (int m = 0; m < 4; ++m) {
                float o[4];
#pragma unroll
                for (int j = 0; j < 4; ++j) { const float x = acc[m][n][j] + bias[j]; o[j] = mat < 4 ? mul * sigmoidf_(x) : x; }
                u32x2 w; w.x = pack2(o[0], o[1]); w.y = pack2(o[2], o[3]);
                *(u32x2*)(dst + (size_t)(m * 16 + fr) * 256) = w;
            }
        }
    }
    __syncthreads();
}
__device__ __forceinline__ void rowscale128(const bf16_t* Z, int R0, int zoff, int ncols, float eps, float* rs) {
    const int tid = opaque_tid(); const int r = tid >> 1, half = tid & 1; const int per = ncols >> 1;
    const bf16_t* zp = Z + (size_t)(R0 + r) * NIN + zoff + half * per;
    float ss = 0.f;
    for (int i = 0; i < per; i += 8) { const u32x4 w = *(const u32x4*)(zp + i);
#pragma unroll
        for (int q = 0; q < 4; ++q) { const float a = lo_bf(w[q]), b = hi_bf(w[q]); ss += a * a + b * b; } }
    ss = dpp_add<0xB1>(ss);
    if (half == 0) rs[r] = rsqrtf(ss / (float)ncols + eps);
}
__device__ __forceinline__ void small_unit(const P& p, int l, int u) {
    const int tid = opaque_tid(), sub = tid >> 5, li = tid & 31;
    if (u < 2560) {
        const int row = u * 8 + sub; const bf16_t* zr = p.Z + (size_t)row * NIN;
        const u32x2 w = *(const u32x2*)(zr + ZKV + li * 4);
        const float z0 = lo_bf(w.x), z1 = hi_bf(w.x), z2 = lo_bf(w.y), z3 = hi_bf(w.y);
        float ss = z0 * z0 + z1 * z1 + z2 * z2 + z3 * z3; ss = red16(ss); ss += __shfl_xor(ss, 16);
        const float rsv = rsqrtf(ss * (1.0f / 128.0f) + 1e-6f);
        const float x1 = bf2f(zr[ZKR + (li & 15)]), x2 = bf2f(zr[ZKR + 16 + (li & 15)]);
        float val;
        if (row < M_CTX) {
            const int b = row >> 8, t = row & 255; const size_t o = ((size_t)(b * 4 + l) * 256 + t);
            const f32x4 g = *(const f32x4*)(p.kv_norm + l * 128 + li * 4);
            *(f32x4*)(p.out + 20971520 + o * 128 + li * 4) = (f32x4){z0 * rsv * g[0], z1 * rsv * g[1], z2 * rsv * g[2], z3 * rsv * g[3]};
            val = li < 16 ? x1 : x2;
            p.out[20971520 + 2097152 + o * 32 + li] = val;
        } else {
            const int t = (row - M_CTX) & 4095; const float cv = p.ropeC[t * 16 + (li & 15)], sv = p.ropeS[t * 16 + (li & 15)];
            val = li < 16 ? x1 * cv - x2 * sv : x1 * sv + x2 * cv;
        }
        const bf16_t bv = f2bf(val);
#pragma unroll
        for (int h = 0; h < 8; ++h) p.Kb[(size_t)row * 768 + h * 96 + 64 + li] = bv;
    } else {
        const int r = (u - 2560) * 8 + sub; const int b = r >> 9, t = r & 511;
        const bf16_t bv = f2bf(p.cache_krope[((size_t)(b * 4 + l) * 512 + t) * 32 + li]);
#pragma unroll
        for (int h = 0; h < 8; ++h) p.Kc[(size_t)r * 768 + h * 96 + 64 + li] = bv;
    }
}
__device__ __forceinline__ void gmlp_unit(const P& p, int l, int u, char* smem) {
    const int tid = opaque_tid(), lane = tid & 63, wid = tid >> 6, fr = lane & 15, fq = lane >> 4;
    const int R0 = (u >> 2) * 128, g = u & 3;
    bf16_t* VnT = (bf16_t*)smem;
    bf16x8 wsf[4][2];
    { const bf16_t* Wg0 = p.WsB + g * 128 * 128;
#pragma unroll
      for (int ks = 0; ks < 4; ++ks)
#pragma unroll
        for (int m = 0; m < 2; ++m) wsf[ks][m] = *(const bf16x8*)(Wg0 + (wid * 32 + m * 16 + fr) * 128 + ks * 32 + fq * 8); }
    {
        const int tok = tid >> 1, half = tid & 1; const bf16_t* zp = p.Z + (size_t)(R0 + tok) * NIN + ZV + g * 64 + half * 32;
        float x[32];
#pragma unroll
        for (int i = 0; i < 4; ++i) { const u32x4 w = *(const u32x4*)(zp + i * 8);
#pragma unroll
            for (int q = 0; q < 4; ++q) { x[i * 8 + 2 * q] = geluf_(lo_bf(w[q])); x[i * 8 + 2 * q + 1] = geluf_(hi_bf(w[q])); } }
        float s = 0.f;
#pragma unroll
        for (int i = 0; i < 32; ++i) s += x[i];
        s = dpp_add<0xB1>(s); const float mu = s * (1.0f / 64.0f);
        float q2 = 0.f;
#pragma unroll
        for (int i = 0; i < 32; ++i) { const float d = x[i] - mu; q2 += d * d; }
        q2 = dpp_add<0xB1>(q2); const float rstd = rsqrtf(q2 * (1.0f / 64.0f) + 1e-5f);
        const float* gg = p.gm_g + l * 256 + g * 64 + half * 32; const float* gb = p.gm_b + l * 256 + g * 64 + half * 32;
#pragma unroll
        for (int i = 0; i < 32; ++i) VnT[(half * 32 + i) * 136 + tok] = f2bf((x[i] - mu) * rstd * gg[i] + gb[i]);
    }
    __syncthreads();
    f32x4 acc[2][4];
#pragma unroll
    for (int m = 0; m < 2; ++m)
#pragma unroll
        for (int n = 0; n < 4; ++n) acc[m][n] = (f32x4){0.f, 0.f, 0.f, 0.f};
#pragma unroll
    for (int ks = 0; ks < 4; ++ks) {
        bf16x8 bfr[4];
#pragma unroll
        for (int n = 0; n < 4; ++n) bfr[n] = *(const bf16x8*)(VnT + (n * 16 + fr) * 136 + ks * 32 + fq * 8);
#pragma unroll
        for (int m = 0; m < 2; ++m)
#pragma unroll
            for (int n = 0; n < 4; ++n) acc[m][n] = __builtin_amdgcn_mfma_f32_16x16x32_bf16(bfr[n], wsf[ks][m], acc[m][n], 0, 0, 0);
    }
#pragma unroll
    for (int m = 0; m < 2; ++m) {
        const int pp = wid * 32 + m * 16 + fr; const float bs = p.gm_bs[l * 512 + g * 128 + pp];
#pragma unroll
        for (int n = 0; n < 4; ++n) { const int c = n * 16 + fq * 4;
            const u32x2 zw = *(const u32x2*)(p.Z + (size_t)(R0 + pp) * NIN + ZU + g * 64 + c);
            const float u0 = geluf_(lo_bf(zw.x)), u1 = geluf_(hi_bf(zw.x)), u2 = geluf_(lo_bf(zw.y)), u3 = geluf_(hi_bf(zw.y));
            u32x2 w; w.x = pack2(u0 * (acc[m][n][0] + bs), u1 * (acc[m][n][1] + bs)); w.y = pack2(u2 * (acc[m][n][2] + bs), u3 * (acc[m][n][3] + bs));
            *(u32x2*)(p.hbmix + (size_t)(R0 + pp) * DM + 768 + g * 64 + c) = w; }
    }
    __syncthreads();
}

__device__ __forceinline__ float swap16_add(float x) {
    auto r = __builtin_amdgcn_permlane16_swap(__float_as_uint(x), __float_as_uint(x), false, false);
    return __uint_as_float(r[0]) + __uint_as_float(r[1]);
}
#define NSCAN_LAT 256
#define NSCAN (256 + 1024)
__device__ __forceinline__ void scan_unit(const P& p, int l, int u, char* smem) {
    const int tid = opaque_tid(), lane = tid & 63, wid = tid >> 6;
    int b, T, row0; const bool lat = u < NSCAN_LAT;
    if (lat) { b = u >> 6; T = 4096; row0 = M_CTX + b * 4096; } else { b = (u - NSCAN_LAT) >> 6; T = 256; row0 = b * 256; }
    const int h = (u >> 4) & 3, d = (u >> 3) & 1, rsl = u & 7;
    float* W = (float*)smem; float* NKK = W + 2048; float* KKA = NKK + 2048; float* KD = KKA + 2048; float* RR = KD + 2048; float* VS = RR + 2048; float* OUTP = VS + 256;
    const int rl = lane >> 5, kq = lane & 31; const int r8 = wid * 2 + rl; const int row = rsl * 8 + r8;
    f32x2 S = (f32x2){0.f, 0.f};
    const size_t stoff = ((((size_t)b * 4 + l) * 2 + d) * 4 + h) * 4096 + row * 64 + kq * 2;
    if (lat) S = *(const f32x2*)(p.state_rwkv + stoff);
    const int tok = tid >> 3, cg8 = tid & 7;
    float kkp[8], kap[8];
#pragma unroll
    for (int i = 0; i < 8; ++i) { kkp[i] = p.rw_kk[l * 256 + h * 64 + cg8 * 8 + i]; kap[i] = p.rw_ka[l * 256 + h * 64 + cg8 * 8 + i]; }
    const int nch = T >> 5;
    u32x4 r8v, k8, e8, a8, v8;
    int grow, grow_prev = 0; float oreg = 0.f;
    {
        const int sidx = tok; const int t = d ? T - 1 - sidx : sidx; grow = row0 + t;
        r8v = *(const u32x4*)(p.RKV + (size_t)grow * 768 + h * 64 + cg8 * 8);
        k8 = *(const u32x4*)(p.RKV + (size_t)grow * 768 + 256 + h * 64 + cg8 * 8);
        v8 = *(const u32x4*)(p.RKV + (size_t)grow * 768 + 512 + h * 64 + rsl * 8);
        e8 = *(const u32x4*)(p.Ee + ((size_t)d * M_ALL + grow) * 256 + h * 64 + cg8 * 8);
        a8 = *(const u32x4*)(p.Aa + ((size_t)d * M_ALL + grow) * 256 + h * 64 + cg8 * 8);
    }
    for (int ch = 0; ch < nch; ++ch) {
        {
            float kf[8], kkv[8], rf[8], ef[8], af[8];
#pragma unroll
            for (int q = 0; q < 4; ++q) { kf[2 * q] = lo_bf(k8[q]); kf[2 * q + 1] = hi_bf(k8[q]); rf[2 * q] = lo_bf(r8v[q]); rf[2 * q + 1] = hi_bf(r8v[q]);
                ef[2 * q] = lo_bf(e8[q]); ef[2 * q + 1] = hi_bf(e8[q]); af[2 * q] = lo_bf(a8[q]); af[2 * q + 1] = hi_bf(a8[q]); }
            float ss = 0.f;
#pragma unroll
            for (int i = 0; i < 8; ++i) { kkv[i] = kf[i] * kkp[i]; ss += kkv[i] * kkv[i]; }
            ss = red8(ss);
            const float inv = rsqrtf(fmaxf(ss, 1e-24f));
            f32x4 o0, o1; const int base = tok * 64 + cg8 * 8;
#pragma unroll
            for (int i = 0; i < 4; ++i) { o0[i] = __expf(-ef[i]); o1[i] = __expf(-ef[4 + i]); }
            *(f32x4*)(W + base) = o0; *(f32x4*)(W + base + 4) = o1;
#pragma unroll
            for (int i = 0; i < 4; ++i) { o0[i] = -kkv[i] * inv; o1[i] = -kkv[4 + i] * inv; }
            *(f32x4*)(NKK + base) = o0; *(f32x4*)(NKK + base + 4) = o1;
#pragma unroll
            for (int i = 0; i < 4; ++i) { o0[i] = kkv[i] * inv * af[i]; o1[i] = kkv[4 + i] * inv * af[4 + i]; }
            *(f32x4*)(KKA + base) = o0; *(f32x4*)(KKA + base + 4) = o1;
#pragma unroll
            for (int i = 0; i < 4; ++i) { o0[i] = kf[i] * (1.0f + (af[i] - 1.0f) * kap[i]); o1[i] = kf[4 + i] * (1.0f + (af[4 + i] - 1.0f) * kap[4 + i]); }
            *(f32x4*)(KD + base) = o0; *(f32x4*)(KD + base + 4) = o1;
#pragma unroll
            for (int i = 0; i < 4; ++i) { o0[i] = rf[i]; o1[i] = rf[4 + i]; }
            *(f32x4*)(RR + base) = o0; *(f32x4*)(RR + base + 4) = o1;
            if (cg8 == 0) {
#pragma unroll
                for (int q = 0; q < 4; ++q) { VS[tok * 8 + 2 * q] = lo_bf(v8[q]); VS[tok * 8 + 2 * q + 1] = hi_bf(v8[q]); }
            }
        }
        __syncthreads();
        if (ch > 0) p.ydir[((size_t)d * M_ALL + grow_prev) * 256 + h * 64 + rsl * 8 + cg8] = oreg;
        grow_prev = grow;
        if (ch + 1 < nch) {
            const int sidx = (ch + 1) * 32 + tok; const int t = d ? T - 1 - sidx : sidx; grow = row0 + t;
            r8v = *(const u32x4*)(p.RKV + (size_t)grow * 768 + h * 64 + cg8 * 8);
            k8 = *(const u32x4*)(p.RKV + (size_t)grow * 768 + 256 + h * 64 + cg8 * 8);
            v8 = *(const u32x4*)(p.RKV + (size_t)grow * 768 + 512 + h * 64 + rsl * 8);
            e8 = *(const u32x4*)(p.Ee + ((size_t)d * M_ALL + grow) * 256 + h * 64 + cg8 * 8);
            a8 = *(const u32x4*)(p.Aa + ((size_t)d * M_ALL + grow) * 256 + h * 64 + cg8 * 8);
        }
        {
            const float* Wq = W + kq * 2; const float* NKq = NKK + kq * 2; const float* KAq = KKA + kq * 2; const float* KDq = KD + kq * 2; const float* RRq = RR + kq * 2; const float* VSq = VS + r8;
            float* OPq = OUTP + r8 * 32 + kq;
            f32x2 wv[4], nkv[4], kav[4], kdv[4], rrv[4]; float vv[4];
#define SCAN_LD(slot, st) do { wv[slot] = *(const f32x2*)(Wq + (st) * 64); nkv[slot] = *(const f32x2*)(NKq + (st) * 64); kav[slot] = *(const f32x2*)(KAq + (st) * 64); \
        kdv[slot] = *(const f32x2*)(KDq + (st) * 64); rrv[slot] = *(const f32x2*)(RRq + (st) * 64); vv[slot] = VSq[(st) * 8]; } while (0)
            __builtin_amdgcn_s_setprio(3);
            SCAN_LD(0, 0); SCAN_LD(1, 1); SCAN_LD(2, 2);
#pragma unroll
            for (int s = 0; s < 32; ++s) {
                if (s + 3 < 32) SCAN_LD((s + 3) & 3, s + 3);
                const f32x2 w = wv[s & 3], nk = nkv[s & 3], ka = kav[s & 3], kd = kdv[s & 3], rr = rrv[s & 3]; const float v = vv[s & 3];
                float pd = fmaf(S[1], nk[1], S[0] * nk[0]);
                pd = red16(pd); pd = swap16_add(pd);
                S[0] = fmaf(S[0], w[0], fmaf(pd, ka[0], v * kd[0]));
                S[1] = fmaf(S[1], w[1], fmaf(pd, ka[1], v * kd[1]));
                OPq[s * 256] = fmaf(S[1], rr[1], S[0] * rr[0]);
            }
            __builtin_amdgcn_s_setprio(0);
        }
        __syncthreads();
        {
            const float* op = OUTP + (tok * 8 + cg8) * 32;
            f32x4 a0 = *(const f32x4*)(op), a1 = *(const f32x4*)(op + 4), a2 = *(const f32x4*)(op + 8), a3 = *(const f32x4*)(op + 12);
            f32x4 b0 = *(const f32x4*)(op + 16), b1 = *(const f32x4*)(op + 20), b2 = *(const f32x4*)(op + 24), b3 = *(const f32x4*)(op + 28);
            a0 = ((a0 + a1) + (a2 + a3)) + ((b0 + b1) + (b2 + b3));
            oreg = (a0[0] + a0[1]) + (a0[2] + a0[3]);
        }
    }
    p.ydir[((size_t)d * M_ALL + grow_prev) * 256 + h * 64 + rsl * 8 + cg8] = oreg;
    if (!lat) *(f32x2*)(p.out + 20971520 + 2097152 + 524288 + stoff) = S;
    __syncthreads();
}

#ifndef ATT_THR
#define ATT_THR 8.0f
#endif
#define KS_STRIDE 104
#define VS_STRIDE 68
#define KS_BYTES (64 * KS_STRIDE * 2)
#define ATT_STAGE (KS_BYTES + 64 * VS_STRIDE * 2)
__device__ __forceinline__ void attn_unit(const P& p, int u, char* smem) {
    const int tid = opaque_tid(), lane = tid & 63, wid = tid >> 6, q = lane & 31, hf = lane >> 5;
    int b, h, qt, qrow0, krow0, nown, ntot, Tv; size_t vbase, vcbase = 0; int kcrow0 = 0;
    if (u < 1024) { b = u >> 8; h = (u >> 5) & 7; qt = u & 31; krow0 = M_CTX + b * 4096; qrow0 = krow0 + qt * 128; nown = 64; ntot = 72; Tv = 4096;
        vbase = 2097152 + (size_t)(b * 8 + h) * 64 * 4096; kcrow0 = b * 512; vcbase = (size_t)(b * 8 + h) * 64 * 512; }
    else { const int v = u - 1024; b = v >> 4; h = (v >> 1) & 7; qt = v & 1; krow0 = b * 256; qrow0 = krow0 + qt * 128; nown = 4; ntot = 4; Tv = 256; vbase = (size_t)(b * 8 + h) * 64 * 256; }
    bf16x8 qf[6];
    { const bf16_t* qp = p.Qb + (size_t)(qrow0 + wid * 32 + q) * 768 + h * 96 + hf * 8;
#pragma unroll
      for (int ks = 0; ks < 6; ++ks) qf[ks] = *(const bf16x8*)(qp + ks * 16); }
    f32x16 oT[2];
#pragma unroll
    for (int i = 0; i < 16; ++i) { oT[0][i] = 0.f; oT[1][i] = 0.f; }
    float mref = 0.f, lrun = 0.f; f32x16 negm;
#pragma unroll
    for (int i = 0; i < 16; ++i) negm[i] = 0.f;
    u32x4 rk[3], rv[2];
    int krow[3], kc[3];
#pragma unroll
    for (int i = 0; i < 3; ++i) { const int c = tid + 256 * i; krow[i] = c / 12; kc[i] = c % 12; }
    const int vdv0 = tid >> 3, vkc = tid & 7;
#define ATT_LOAD(kt) do { const bf16_t* kptr; const bf16_t* vptr; int vstr; \
        if ((kt) < nown) { kptr = p.Kb + (size_t)(krow0 + (kt) * 64) * 768 + h * 96; vptr = p.Vt + vbase + (kt) * 64; vstr = Tv; } \
        else { kptr = p.Kc + (size_t)(kcrow0 + ((kt) - nown) * 64) * 768 + h * 96; vptr = p.Vtc + vcbase + ((kt) - nown) * 64; vstr = 512; } \
        _Pragma("unroll") for (int i = 0; i < 3; ++i) rk[i] = *(const u32x4*)(kptr + (size_t)krow[i] * 768 + kc[i] * 8); \
        _Pragma("unroll") for (int i = 0; i < 2; ++i) rv[i] = *(const u32x4*)(vptr + (size_t)(vdv0 + 32 * i) * vstr + vkc * 8); } while (0)
#define ATT_STORE(buf) do { char* Ks_ = smem + (buf) * ATT_STAGE; char* Vs_ = Ks_ + KS_BYTES; \
        _Pragma("unroll") for (int i = 0; i < 3; ++i) *(u32x4*)(Ks_ + (krow[i] * KS_STRIDE + kc[i] * 8) * 2) = rk[i]; \
        _Pragma("unroll") for (int i = 0; i < 2; ++i) { char* vd_ = Vs_ + ((vdv0 + 32 * i) * VS_STRIDE + vkc * 8) * 2; *(u32x2*)vd_ = (u32x2){rv[i].x, rv[i].y}; *(u32x2*)(vd_ + 8) = (u32x2){rv[i].z, rv[i].w}; } } while (0)
    ATT_LOAD(0); ATT_STORE(0);
    __syncthreads();
    for (int kt = 0; kt < ntot; ++kt) {
        const bool more = kt + 1 < ntot;
        if (more) ATT_LOAD(kt + 1);
        const char* Ks = smem + (kt & 1) * ATT_STAGE; const char* Vs = Ks + KS_BYTES;
        f32x16 sT[2];
#pragma unroll
        for (int kb = 0; kb < 2; ++kb)
#pragma unroll
            for (int ks = 0; ks < 6; ++ks) { const bf16x8 kf = *(const bf16x8*)(Ks + ((kb * 32 + q) * KS_STRIDE + ks * 16 + hf * 8) * 2);
                sT[kb] = __builtin_amdgcn_mfma_f32_32x32x16_bf16(kf, qf[ks], ks == 0 ? negm : sT[kb], 0, 0, 0); }
        float mx = sT[0][0];
#pragma unroll
        for (int i = 1; i < 16; ++i) mx = fmaxf(mx, sT[0][i]);
#pragma unroll
        for (int i = 0; i < 16; ++i) mx = fmaxf(mx, sT[1][i]);
        mx = fmaxf(mx, __shfl_xor(mx, 32));
        const bool first = (kt == 0);
        if (first || __any(mx > ATT_THR)) {
            const float delta = first ? mx : ((mx > ATT_THR) ? mx : 0.f);
            const float alpha = first ? 0.f : __builtin_amdgcn_exp2f(-delta);
            mref += delta; lrun *= alpha;
#pragma unroll
            for (int i = 0; i < 16; ++i) { sT[0][i] -= delta; sT[1][i] -= delta; oT[0][i] *= alpha; oT[1][i] *= alpha; negm[i] = -mref; }
        }
        float psum = 0.f; bf16x8 pf[2][2];
#pragma unroll
        for (int kb = 0; kb < 2; ++kb)
#pragma unroll
            for (int s = 0; s < 2; ++s) { float e[8];
#pragma unroll
                for (int j = 0; j < 8; ++j) { e[j] = __builtin_amdgcn_exp2f(sT[kb][8 * s + j]); psum += e[j]; }
                u32x4 w; w.x = pack2(e[0], e[1]); w.y = pack2(e[2], e[3]); w.z = pack2(e[4], e[5]); w.w = pack2(e[6], e[7]);
                pf[kb][s] = __builtin_bit_cast(bf16x8, w); }
        lrun += psum;
#pragma unroll
        for (int kb = 0; kb < 2; ++kb)
#pragma unroll
            for (int s = 0; s < 2; ++s)
#pragma unroll
                for (int db = 0; db < 2; ++db) {
                    const char* vp = Vs + ((db * 32 + q) * VS_STRIDE + kb * 32 + 16 * s + 4 * hf) * 2;
                    const u32x2 lo = *(const u32x2*)vp, hi = *(const u32x2*)(vp + 16);
                    const u32x4 w = (u32x4){lo.x, lo.y, hi.x, hi.y};
                    oT[db] = __builtin_amdgcn_mfma_f32_32x32x16_bf16(__builtin_bit_cast(bf16x8, w), pf[kb][s], oT[db], 0, 0, 0);
                }
        if (more) ATT_STORE((kt + 1) & 1);
        __syncthreads();
    }
    const float lt = lrun + __shfl_xor(lrun, 32); const float inv = 1.0f / lt;
    bf16_t* op = p.hbmix + (size_t)(qrow0 + wid * 32 + q) * DM + 256 + h * 64;
#pragma unroll
    for (int db = 0; db < 2; ++db)
#pragma unroll
        for (int g = 0; g < 4; ++g) { u32x2 w; w.x = pack2(oT[db][4 * g] * inv, oT[db][4 * g + 1] * inv); w.y = pack2(oT[db][4 * g + 2] * inv, oT[db][4 * g + 3] * inv);
            *(u32x2*)(op + db * 32 + 8 * g + 4 * hf) = w; }
}

__device__ __forceinline__ void rwcomb_phase(const P& p, int l) {
    const int tid = opaque_tid(), lane = tid & 63, wid = tid >> 6; const int c = lane * 4;
    const f32x4 gng = *(const f32x4*)(p.rw_gn_g + l * 256 + c), gnb = *(const f32x4*)(p.rw_gn_b + l * 256 + c), kap = *(const f32x4*)(p.rw_ka + l * 256 + c), rkp = *(const f32x4*)(p.rw_rk + l * 256 + c);
    for (int row = blockIdx.x * 4 + wid; row < M_ALL; row += gridDim.x * 4) {
        const f32x4 y0 = *(const f32x4*)(p.ydir + (size_t)row * 256 + c), y1 = *(const f32x4*)(p.ydir + ((size_t)M_ALL + row) * 256 + c);
        f32x4 y = y0 + y1;
        float s = (y[0] + y[1]) + (y[2] + y[3]); s = red16(s); const float mu = s * (1.0f / 64.0f);
        const f32x4 dd = y - mu; float q2 = (dd[0] * dd[0] + dd[1] * dd[1]) + (dd[2] * dd[2] + dd[3] * dd[3]); q2 = red16(q2);
        const float rstd = rsqrtf(q2 * (1.0f / 64.0f) + 64e-5f);
        const f32x4 yn = dd * rstd * gng + gnb;
        const u32x2 rw = *(const u32x2*)(p.RKV + (size_t)row * 768 + c), kw = *(const u32x2*)(p.RKV + (size_t)row * 768 + 256 + c), vw = *(const u32x2*)(p.RKV + (size_t)row * 768 + 512 + c);
        const u32x2 a0w = *(const u32x2*)(p.Aa + (size_t)row * 256 + c), a1w = *(const u32x2*)(p.Aa + ((size_t)M_ALL + row) * 256 + c), gw = *(const u32x2*)(p.Gg + (size_t)row * 256 + c);
        const f32x4 r = (f32x4){lo_bf(rw.x), hi_bf(rw.x), lo_bf(rw.y), hi_bf(rw.y)}, k = (f32x4){lo_bf(kw.x), hi_bf(kw.x), lo_bf(kw.y), hi_bf(kw.y)}, v = (f32x4){lo_bf(vw.x), hi_bf(vw.x), lo_bf(vw.y), hi_bf(vw.y)};
        const f32x4 a0 = (f32x4){lo_bf(a0w.x), hi_bf(a0w.x), lo_bf(a0w.y), hi_bf(a0w.y)}, a1 = (f32x4){lo_bf(a1w.x), hi_bf(a1w.x), lo_bf(a1w.y), hi_bf(a1w.y)}, gt = (f32x4){lo_bf(gw.x), hi_bf(gw.x), lo_bf(gw.y), hi_bf(gw.y)};
        const f32x4 kds = k * (1.0f + (a0 - 1.0f) * kap) + k * (1.0f + (a1 - 1.0f) * kap);
        const f32x4 t4 = r * kds * rkp; float rk = (t4[0] + t4[1]) + (t4[2] + t4[3]); rk = red16(rk);
        const f32x4 o = (yn + rk * v) * gt;
        u32x2 w; w.x = pack2(o[0], o[1]); w.y = pack2(o[2], o[3]);
        *(u32x2*)(p.hbmix + (size_t)row * DM + c) = w;
    }
}


__device__ __forceinline__ bool xcd_tile(int i, int TT, int NT, int& mt, int& nt) {
    const int per = TT >> 3; if (i >= per) return false;
    const int t = (blockIdx.x & 7) * per + i; const int band = t / (8 * NT), rem = t - band * 8 * NT;
    nt = rem >> 3; mt = band * 8 + (rem & 7); return true;
}
__global__ void __launch_bounds__(256, 2) mega(Args a_unused) {
    extern __shared__ __attribute__((aligned(16))) char smem[];
    __shared__ uint4 xbw; __shared__ int s_unit;
    kargp_t kp = (kargp_t)__builtin_amdgcn_kernarg_segment_ptr();
    const int tid = threadIdx.x; const int G = gridDim.x;
    if (tid == 0) xbw = make_uint4(0u, 0u, 0u, 0u);
    __syncthreads();
    XcdBarrier xb;
    { const P p = getP(kp); xb = xcd_barrier_post(p.bar, (volatile LAS unsigned*)&xbw); }
    for (int u = blockIdx.x; u < 384 + NCONV + 272; u += G) {
        if (u < 384) { const P p = getP(kp); ada_unit(p, u, smem); } else if (u < 384 + NCONV) { const P p = getP(kp); conv_unit(p, 0, u - 384, smem); } else { const P p = getP(kp); misc0_unit(p, u - 384 - NCONV); }
    }
    cg::this_grid().sync();
    { const P p = getP(kp); ln_phase(p, 0, 0); }
    xcd_barrier(xb);
    float* rs = (float*)(smem + RS_OFF);
#pragma unroll 1
    for (int l = 0; l < 4; ++l) {
        for (int i = blockIdx.x >> 3; ; i += G >> 3) { int mt, nt; if (!xcd_tile(i, 80 * 17, 17, mt, nt)) break; const P p = getP(kp);
            EpiZ e{p.Z, mt * 256, nt * 128};
            gemm256(p.hbmix + (size_t)mt * 256 * DM, DM, p.WtIn + (size_t)nt * 128 * DM, DM, DM, smem, e); }
        xcd_barrier(xb);
        for (int rep2 = 0; rep2 < DUP_P2; ++rep2) {
        for (;;) {
            { const P pc = getP(kp); if (tid == 0) s_unit = atomicAdd(&pc.ctr[l * 4 + 0 + 2 * rep2], 1); }
            __syncthreads(); int u = s_unit; __syncthreads();
            if (u >= 320 + 480 + 640 + 64 + 352 + 640) break;
            if (u < 320) { const P p = getP(kp); rwprep_unit(p, l, u, smem); continue; }
            u -= 320;
            if (u < 480) { const P p = getP(kp); const int mt = u / 3, np = u % 3;
                rowscale128(p.Z, mt * 128, ZQ, 256, 1e-6f, rs);
                for (int k2 = 0; k2 < 2; ++k2) { const int nt = np * 2 + k2;
                    EpiQ e{p.Qb, rs, p.ropeC, p.ropeS, mt * 128, nt * 128};
                    gemm128<true>(p.Z + (size_t)mt * 128 * NIN + ZQ, NIN, p.WtQ + (size_t)nt * 128 * 256, 256, 256, smem, e); }
                __syncthreads(); continue; }
            u -= 480;
            if (u < 640) { const P p = getP(kp); const int mt = u >> 2, np = u & 3; const int R0 = mt * 128; const bool latr = R0 >= M_CTX;
                rowscale128(p.Z, R0, ZKV, 128, 1e-6f, rs);
                for (int k2 = 0; k2 < 2; ++k2) { const int nt = np * 2 + k2;
                    if (np < 2) { EpiKN e{latr ? p.Kb + (size_t)M_CTX * 768 : p.Kb, rs, latr ? R0 - M_CTX : R0, nt * 128};
                        gemm128<true>(p.Z + (size_t)R0 * NIN + ZKV, NIN, p.WtKVn + (size_t)nt * 128 * 128, 128, 128, smem, e); }
                    else { EpiKV e{latr ? p.Kb + (size_t)M_CTX * 768 : p.Kb, p.Vt, rs, latr ? R0 - M_CTX : R0, nt * 128, latr ? 12 : 8, latr ? (size_t)2097152 : (size_t)0};
                        gemm128<false>(p.Z + (size_t)R0 * NIN + ZKV, NIN, p.WtKVn + (size_t)nt * 128 * 128, 128, 128, smem, e); } }
                __syncthreads(); continue; }
            u -= 640;
            if (u < 64) { const P p = getP(kp); const int mt = u >> 2, np = u & 3;
                for (int k2 = 0; k2 < 2; ++k2) { const int nt = np * 2 + k2;
                    if (np < 2) { EpiKN e{p.Kc, nullptr, mt * 128, nt * 128};
                        gemm128<true>(p.CkvB + ((size_t)l * 2048 + mt * 128) * 128, 128, p.WtKV + (size_t)nt * 128 * 128, 128, 128, smem, e); }
                    else { EpiKV e{p.Kc, p.Vtc, nullptr, mt * 128, nt * 128, 9, (size_t)0};
                        gemm128<false>(p.CkvB + ((size_t)l * 2048 + mt * 128) * 128, 128, p.WtKV + (size_t)nt * 128 * 128, 128, 128, smem, e); } }
                continue; }
            u -= 64;
            if (u < 352) { const P p = getP(kp); for (int i = 0; i < 8; ++i) small_unit(p, l, u * 8 + i); continue; }
            u -= 352;
            { const P p = getP(kp); gmlp_unit(p, l, u, smem); }
        }
        xcd_barrier(xb);
        }
        for (int rep3 = 0; rep3 < DUP_P3; ++rep3) {
        for (;;) {
            { const P pc = getP(kp); if (tid == 0) s_unit = atomicAdd(&pc.ctr[l * 4 + 1 + 2 * rep3], 1); }
            __syncthreads(); int u = s_unit; __syncthreads();
            if (u >= NSCAN + 1280) break;
#ifdef PROBE_SCAN_ONLY
            if (rep3 == 1 && u >= NSCAN) break;
#endif
#ifdef PROBE_ATTN_ONLY
            if (rep3 == 1 && u < NSCAN) continue;
#endif
            if (u < NSCAN) { const P p = getP(kp); scan_unit(p, l, u, smem); } else { const P p = getP(kp); attn_unit(p, u - NSCAN, smem); }
        }
        xcd_barrier(xb);
        }
        { const P p = getP(kp); rwcomb_phase(p, l); }
        xcd_barrier(xb);
        for (int i = blockIdx.x >> 3; ; i += G >> 3) { int mt, nt; if (!xcd_tile(i, 160 * 8, 8, mt, nt)) break; const P p = getP(kp);
            EpiRes e{p.out, p.mod + ((size_t)l * 5 + modrow_of(mt * 128)) * 6144 + 2048, mt * 128, nt * 128};
            gemm128<true>(p.hbmix + (size_t)mt * 128 * DM, DM, p.WtOut + (size_t)nt * 128 * DM, DM, DM, smem, e); }
        xcd_barrier(xb);
        { const P p = getP(kp); ln_phase(p, l, 1); }
        xcd_barrier(xb);
        for (int rep5 = 0; rep5 < DUP_P5; ++rep5)
        for (int i = blockIdx.x >> 3; ; i += G >> 3) { int mt, nt; if (!xcd_tile(i, 80 * 44, 44, mt, nt)) break; const P p = getP(kp);
            EpiSwi e{p.hidden, mt * 256, nt * 128};
            gemm256(p.hbmix + (size_t)mt * 256 * DM, DM, p.WtF1 + (size_t)nt * 128 * DM, DM, DM, smem, e); }
        xcd_barrier(xb);
        for (int i = blockIdx.x >> 3; ; i += G >> 3) { int mt, nt; if (!xcd_tile(i, 160 * 8, 8, mt, nt)) break; const P p = getP(kp);
            EpiRes e{p.out, p.mod + ((size_t)l * 5 + modrow_of(mt * 128)) * 6144 + 5120, mt * 128, nt * 128};
            gemm128<true>(p.hidden + (size_t)mt * 128 * DFF, DFF, p.WtF2 + (size_t)nt * 128 * DFF, DFF, DFF, smem, e); }
        xcd_barrier(xb);
        { const P p = getP(kp); ln_phase(p, l, 2); }
        if (l < 3) { for (int u = blockIdx.x; u < NCONV; u += G) { const P p = getP(kp); conv_unit(p, l + 1, u, smem); } }
        xcd_barrier(xb);
    }
}

extern "C" void kernel_launch(void* const* d_in, const int* in_sizes, int n_in, void* d_out, int out_size, void* d_ws, size_t ws_size, hipStream_t stream) {
    static int grid_blocks = 0;
    if (!grid_blocks) {
        int dev = 0, cus = 0, per_cu = 0;
        (void)hipGetDevice(&dev);
        (void)hipDeviceGetAttribute(&cus, hipDeviceAttributeMultiprocessorCount, dev);
        (void)hipFuncSetAttribute((const void*)mega, hipFuncAttributeMaxDynamicSharedMemorySize, SMEM_BYTES);
        (void)hipOccupancyMaxActiveBlocksPerMultiprocessor(&per_cu, (const void*)mega, 256, SMEM_BYTES);
        if (per_cu > 2) per_cu = 2;
        if (per_cu < 1) per_cu = 1;
        grid_blocks = (cus * per_cu) & ~7;
    }
    if (WS_TOTAL > ws_size) { fprintf(stderr, "kernel_launch: workspace too small: need %zu have %zu\n", (size_t)WS_TOTAL, ws_size); return; }
    Args a{};
    for (int i = 0; i < 36; ++i) a.in[i] = (const float*)d_in[i];
    a.out = (float*)d_out; a.ws = (char*)d_ws;
    (void)hipMemsetAsync((char*)d_ws + OFF_BAR, 0, 16384 + 4096, stream);
    void* args[] = {&a};
    hipError_t e = hipLaunchCooperativeKernel((const void*)mega, dim3(grid_blocks), dim3(256), args, SMEM_BYTES, stream);
    if (e != hipSuccess) fprintf(stderr, "cooperative launch failed: %s (grid %d)\n", hipGetErrorString(e), grid_blocks);
}
```

```cpp
#include <hip/hip_runtime.h>
#include <hip/hip_cooperative_groups.h>
#include <cstdint>
#include <cstdio>
namespace cg = cooperative_groups;

typedef unsigned short bf16_t;
typedef short bf16x8 __attribute__((ext_vector_type(8)));
typedef float f32x4 __attribute__((ext_vector_type(4)));
typedef float f32x2 __attribute__((ext_vector_type(2)));
typedef float f32x16 __attribute__((ext_vector_type(16)));
typedef unsigned u32x4 __attribute__((ext_vector_type(4)));
typedef unsigned u32x2 __attribute__((ext_vector_type(2)));

#define M_ALL 20480
#define M_CTX 4096
#define DM 1024
#define NIN 2080
#define DFF 2816
#define ALPHA_F 1.6817928305074290f
#define QSCALE (0.10206207261596575f * 1.4426950408889634f)
#define LAS __attribute__((address_space(3)))
#ifndef DUP_P2
#define DUP_P2 1
#endif
#ifndef DUP_P3
#define DUP_P3 1
#endif
#ifndef DUP_P5
#define DUP_P5 1
#endif

#define ZQ 1152
#define ZKV 1408
#define ZKR 1536
#define ZU 1568
#define ZV 1824

#define LDS_STRIDE 72
#define TILE_BYTES (128 * LDS_STRIDE * 2)
#define RS_OFF (4 * TILE_BYTES)
#define SMEM_BYTES (RS_OFF + 3072)

struct P {
    const float *x_prompt, *x_sample, *cache_ckv, *cache_krope, *state_rwkv, *c, *c_ctx, *ada_w, *ada_b, *w_in, *rw_conv, *rw_w0, *rw_w2,
        *rw_a0, *rw_a2, *rw_g2, *rw_kk, *rw_ka, *rw_rk, *rw_gn_g, *rw_gn_b, *q_norm, *q_up, *kv_norm, *kv_up, *gm_g, *gm_b, *gm_ws, *gm_bs,
        *w_out, *ln1_g, *ln1_b, *ffn_in, *ffn_out, *ln2_g, *ln2_b;
    float* out;
    unsigned* bar; int* ctr; float* mod; float* ropeC; float* ropeS; bf16_t* CkvB;
    bf16_t *WtIn, *WtQ, *WtKVn, *WtKV, *WtOut, *WtF1, *WtF2, *WsB, *W2t, *A2t, *G2t;
    bf16_t *Z, *RKV, *Ee, *Aa, *Gg, *Qb, *Kb, *Kc, *Vt, *Vtc, *hbmix, *hidden;
    float* ydir;
};


struct Args { const float* in[36]; float* out; char* ws; };
typedef const __attribute__((address_space(4))) char* kargp_t;
constexpr size_t al256(size_t x) { return (x + 255) & ~(size_t)255; }
constexpr size_t OFF_BAR = 0;
constexpr size_t OFF_CTR = OFF_BAR + 16384;
constexpr size_t OFF_MOD = OFF_CTR + 4096;
constexpr size_t OFF_ROPEC = OFF_MOD + al256((size_t)4 * 5 * 6144 * 4);
constexpr size_t OFF_ROPES = OFF_ROPEC + 65536 * 4;
constexpr size_t OFF_CKVB = OFF_ROPES + 65536 * 4;
constexpr size_t OFF_WTIN = OFF_CKVB + (size_t)4 * 2048 * 128 * 2;
constexpr size_t OFF_WTQ = OFF_WTIN + (size_t)2176 * 1024 * 2;
constexpr size_t OFF_WTKVN = OFF_WTQ + (size_t)768 * 256 * 2;
constexpr size_t OFF_WTKV = OFF_WTKVN + (size_t)1024 * 128 * 2;
constexpr size_t OFF_WTOUT = OFF_WTKV + (size_t)1024 * 128 * 2;
constexpr size_t OFF_WTF1 = OFF_WTOUT + (size_t)1024 * 1024 * 2;
constexpr size_t OFF_WTF2 = OFF_WTF1 + (size_t)5632 * 1024 * 2;
constexpr size_t OFF_WSB = OFF_WTF2 + (size_t)1024 * DFF * 2;
constexpr size_t OFF_W2T = OFF_WSB + (size_t)65536 * 2;
constexpr size_t OFF_A2T = OFF_W2T + (size_t)2 * 256 * 64 * 2;
constexpr size_t OFF_G2T = OFF_A2T + (size_t)2 * 256 * 64 * 2;
constexpr size_t OFF_Z = OFF_G2T + (size_t)256 * 128 * 2;
constexpr size_t OFF_HIDDEN = OFF_Z;
constexpr size_t OFF_RKV = OFF_Z + al256((size_t)M_ALL * NIN * 2);
constexpr size_t OFF_EE = OFF_RKV + (size_t)M_ALL * 768 * 2;
constexpr size_t OFF_AA = OFF_EE + (size_t)2 * M_ALL * 256 * 2;
constexpr size_t OFF_GG = OFF_AA + (size_t)2 * M_ALL * 256 * 2;
constexpr size_t OFF_QB = OFF_GG + (size_t)M_ALL * 256 * 2;
constexpr size_t OFF_KB = OFF_QB + (size_t)M_ALL * 768 * 2;
constexpr size_t OFF_KC = OFF_KB + (size_t)M_ALL * 768 * 2;
constexpr size_t OFF_VT = OFF_KC + (size_t)2048 * 768 * 2;
constexpr size_t OFF_VTC = OFF_VT + (size_t)M_ALL * 512 * 2;
constexpr size_t OFF_YDIR = OFF_VTC + (size_t)2048 * 512 * 2;
constexpr size_t OFF_HBMIX = OFF_YDIR + (size_t)2 * M_ALL * 256 * 4;
constexpr size_t WS_TOTAL = OFF_HBMIX + (size_t)M_ALL * DM * 2;
static_assert(OFF_RKV + (size_t)M_ALL * 768 * 2 - OFF_HIDDEN >= (size_t)M_ALL * DFF * 2, "hidden overlay");

__device__ __forceinline__ P getP(kargp_t& kp) {
    asm volatile("" : "+s"(kp));
    typedef const float* const __attribute__((address_space(4)))* inp_t;
    inp_t in = (inp_t)kp;
    P p;
    p.x_prompt = in[0]; p.x_sample = in[1]; p.cache_ckv = in[2]; p.cache_krope = in[3]; p.state_rwkv = in[4]; p.c = in[5]; p.c_ctx = in[6];
    p.ada_w = in[7]; p.ada_b = in[8]; p.w_in = in[9]; p.rw_conv = in[10]; p.rw_w0 = in[11]; p.rw_w2 = in[12]; p.rw_a0 = in[13]; p.rw_a2 = in[14];
    p.rw_g2 = in[15]; p.rw_kk = in[16]; p.rw_ka = in[17]; p.rw_rk = in[18]; p.rw_gn_g = in[19]; p.rw_gn_b = in[20]; p.q_norm = in[21]; p.q_up = in[22];
    p.kv_norm = in[23]; p.kv_up = in[24]; p.gm_g = in[25]; p.gm_b = in[26]; p.gm_ws = in[27]; p.gm_bs = in[28]; p.w_out = in[29]; p.ln1_g = in[30];
    p.ln1_b = in[31]; p.ffn_in = in[32]; p.ffn_out = in[33]; p.ln2_g = in[34]; p.ln2_b = in[35];
    p.out = (float*)in[36]; char* ws = (char*)in[37];
    p.bar = (unsigned*)(ws + OFF_BAR); p.ctr = (int*)(ws + OFF_CTR); p.mod = (float*)(ws + OFF_MOD); p.ropeC = (float*)(ws + OFF_ROPEC); p.ropeS = (float*)(ws + OFF_ROPES);
    p.CkvB = (bf16_t*)(ws + OFF_CKVB); p.WtIn = (bf16_t*)(ws + OFF_WTIN); p.WtQ = (bf16_t*)(ws + OFF_WTQ); p.WtKVn = (bf16_t*)(ws + OFF_WTKVN); p.WtKV = (bf16_t*)(ws + OFF_WTKV);
    p.WtOut = (bf16_t*)(ws + OFF_WTOUT); p.WtF1 = (bf16_t*)(ws + OFF_WTF1); p.WtF2 = (bf16_t*)(ws + OFF_WTF2); p.WsB = (bf16_t*)(ws + OFF_WSB); p.W2t = (bf16_t*)(ws + OFF_W2T);
    p.A2t = (bf16_t*)(ws + OFF_A2T); p.G2t = (bf16_t*)(ws + OFF_G2T); p.Z = (bf16_t*)(ws + OFF_Z); p.RKV = (bf16_t*)(ws + OFF_RKV); p.Ee = (bf16_t*)(ws + OFF_EE); p.Aa = (bf16_t*)(ws + OFF_AA);
    p.Gg = (bf16_t*)(ws + OFF_GG); p.Qb = (bf16_t*)(ws + OFF_QB); p.Kb = (bf16_t*)(ws + OFF_KB); p.Kc = (bf16_t*)(ws + OFF_KC); p.Vt = (bf16_t*)(ws + OFF_VT); p.Vtc = (bf16_t*)(ws + OFF_VTC);
    p.hbmix = (bf16_t*)(ws + OFF_HBMIX); p.hidden = (bf16_t*)(ws + OFF_HIDDEN); p.ydir = (float*)(ws + OFF_YDIR);
    return p;
}

__device__ __forceinline__ float bf2f(bf16_t b) { return __uint_as_float(((unsigned)b) << 16); }
__device__ __forceinline__ unsigned pack2(float lo, float hi) { unsigned r; asm("v_cvt_pk_bf16_f32 %0, %1, %2" : "=v"(r) : "v"(lo), "v"(hi)); return r; }
__device__ __forceinline__ bf16_t f2bf(float f) { return (bf16_t)(pack2(f, 0.f) & 0xffffu); }
__device__ __forceinline__ float lo_bf(unsigned w) { return __uint_as_float(w << 16); }
__device__ __forceinline__ float hi_bf(unsigned w) { return __uint_as_float(w & 0xffff0000u); }
__device__ __forceinline__ float sigmoidf_(float x) { return __builtin_amdgcn_rcpf(1.0f + __builtin_amdgcn_exp2f(-1.4426950408889634f * x)); }
__device__ __forceinline__ float tanhf_(float x) { float e = __builtin_amdgcn_exp2f(2.8853900817779268f * x); return 1.0f - 2.0f * __builtin_amdgcn_rcpf(e + 1.0f); }
__device__ __forceinline__ float geluf_(float x) { return 0.5f * x * (1.0f + tanhf_(0.7978845608028654f * (x + 0.044715f * x * x * x))); }
template <int CTRL> __device__ __forceinline__ float dpp_add(float x) {
    int y = __builtin_amdgcn_update_dpp(0, __float_as_int(x), CTRL, 0xf, 0xf, false);
    return x + __int_as_float(y);
}
__device__ __forceinline__ float red4(float x) { x = dpp_add<0xB1>(x); x = dpp_add<0x4E>(x); return x; }
__device__ __forceinline__ float red8(float x) { x = red4(x); x = dpp_add<0x141>(x); return x; }
__device__ __forceinline__ float red16(float x) { x = red8(x); x = dpp_add<0x140>(x); return x; }
__device__ __forceinline__ int opaque_tid() { int t = threadIdx.x; asm volatile("" : "+v"(t)); return t; }
__device__ __forceinline__ int modrow_of(int row) { return row < M_CTX ? 0 : 1 + ((row - M_CTX) >> 12); }

#define XB_TMO 128
#define XB_XCNT(j) (256 + 64 * (j))
#define XB_XSUB(j) (1280 + 64 * (j))
#define XB_XGEN(j) (2304 + 64 * (j))
#define XB_TOP 3328
#define XB_TOPGEN 3392
#define XCD_BAR_WORDS 3456
#define XB_SPIN_CAP (1u << 22)
__device__ __forceinline__ unsigned xb_ld(unsigned* p) { return __hip_atomic_load(p, __ATOMIC_RELAXED, __HIP_MEMORY_SCOPE_AGENT); }
__device__ __forceinline__ unsigned xb_add(unsigned* p, unsigned v) { return __hip_atomic_fetch_add(p, v, __ATOMIC_RELAXED, __HIP_MEMORY_SCOPE_AGENT); }
__device__ __forceinline__ unsigned xb_xcc_id() { return (unsigned)__builtin_amdgcn_s_getreg((3 << 11) | 20) & 0xFu; }
#define XB_SPIN(cond, bar) do { unsigned _sp = 0; while (cond) { __builtin_amdgcn_s_sleep(1); \
    if ((++_sp & 255u) == 0u) { if (xb_ld(&(bar)[XB_TMO])) break; if (_sp > XB_SPIN_CAP) { atomicAdd(&(bar)[XB_TMO], 1u); break; } } } } while (0)
struct XcdBarrier { unsigned* bar; unsigned x; volatile LAS unsigned* st; };
__device__ __forceinline__ XcdBarrier xcd_barrier_post(unsigned* bar, volatile LAS unsigned* st) {
    XcdBarrier b; b.bar = bar; b.x = xb_xcc_id(); b.st = st;
    if (threadIdx.x == 0) (void)xb_add(&bar[XB_XCNT(b.x)], 1u);
    return b;
}
__device__ __forceinline__ void xcd_barrier_complete(unsigned* bar, unsigned x, unsigned& nloc, unsigned& nx) {
    const unsigned G = gridDim.x * gridDim.y * gridDim.z;
    unsigned sum, cnt, mine, sp = 0u;
    for (;;) {
        sum = 0u; cnt = 0u; mine = 0u;
#pragma unroll
        for (unsigned j = 0; j < 16; ++j) { const unsigned c = xb_ld(&bar[XB_XCNT(j)]); sum += c; cnt += (c > 0u) ? 1u : 0u; mine = (j == x) ? c : mine; }
        if (sum == G) break;
        __builtin_amdgcn_s_sleep(1);
        if ((++sp & 255u) == 0u) { if (xb_ld(&bar[XB_TMO])) break; if (sp > XB_SPIN_CAP) { atomicAdd(&bar[XB_TMO], 1u); break; } }
    }
    nloc = mine > 0u ? mine : 1u; nx = cnt > 0u ? cnt : 1u;
}
__device__ __forceinline__ void xcd_barrier(const XcdBarrier& b) {
    asm volatile("s_waitcnt vmcnt(0)" ::: "memory");
    __syncthreads();
    if (threadIdx.x == 0) {
        unsigned* bar = b.bar;
        __builtin_amdgcn_s_waitcnt(0);
        unsigned nloc = b.st[0], nx = b.st[1];
        if (nloc == 0u) { xcd_barrier_complete(bar, b.x, nloc, nx); b.st[0] = nloc; b.st[1] = nx; }
        const unsigned old = xb_add(&bar[XB_XSUB(b.x)], 1u);
        const unsigned gen = old / nloc;
        if (old + 1u == (gen + 1u) * nloc) {
            __builtin_amdgcn_fence(__ATOMIC_RELEASE, "agent");
            asm volatile("s_waitcnt vmcnt(0)" ::: "memory");
            const unsigned og = xb_add(&bar[XB_TOP], 1u);
            const unsigned tg = og / nx;
            if (og + 1u == (tg + 1u) * nx) xb_add(&bar[XB_TOPGEN], 1u);
            else XB_SPIN(xb_ld(&bar[XB_TOPGEN]) == tg, bar);
            __builtin_amdgcn_fence(__ATOMIC_ACQUIRE, "agent");
            xb_add(&bar[XB_XGEN(b.x)], 1u);
            asm volatile("s_waitcnt vmcnt(0)" ::: "memory");
        } else {
            XB_SPIN(xb_ld(&bar[XB_XGEN(b.x)]) == gen, bar);
            __builtin_amdgcn_fence(__ATOMIC_ACQUIRE, "agent");
            asm volatile("s_waitcnt vmcnt(0)" ::: "memory");
        }
    }
    __syncthreads();
}

template <bool TR, class Epi>
__device__ __forceinline__ void gemm128(const bf16_t* __restrict__ A, int lda, const bf16_t* __restrict__ B, int ldb, int K, char* smem, const Epi& epi) {
    const int tid = opaque_tid(), lane = tid & 63, wid = tid >> 6, wr = wid >> 1, wc = wid & 1, fr = lane & 15, fq = lane >> 4;
    f32x4 acc[4][4];
#pragma unroll
    for (int m = 0; m < 4; ++m)
#pragma unroll
        for (int n = 0; n < 4; ++n) acc[m][n] = (f32x4){0.f, 0.f, 0.f, 0.f};
    const int crow = tid >> 3, ckc = tid & 7;
    const bf16_t* ap = A + (size_t)crow * lda + ckc * 8;
    const bf16_t* bp = B + (size_t)crow * ldb + ckc * 8;
    u32x4 ra[4], rb[4];
#pragma unroll
    for (int i = 0; i < 4; ++i) { ra[i] = *(const u32x4*)(ap + (size_t)(32 * i) * lda); rb[i] = *(const u32x4*)(bp + (size_t)(32 * i) * ldb); }
    {
        char* sa = smem; char* sb = smem + TILE_BYTES;
#pragma unroll
        for (int i = 0; i < 4; ++i) { *(u32x4*)(sa + ((crow + 32 * i) * LDS_STRIDE + ckc * 8) * 2) = ra[i]; *(u32x4*)(sb + ((crow + 32 * i) * LDS_STRIDE + ckc * 8) * 2) = rb[i]; }
    }
    __syncthreads();
    const int nk = K >> 6;
    for (int kt = 0; kt < nk; ++kt) {
        const bool more = (kt + 1 < nk);
        if (more) {
            const int k0 = (kt + 1) << 6;
#pragma unroll
            for (int i = 0; i < 4; ++i) { ra[i] = *(const u32x4*)(ap + (size_t)(32 * i) * lda + k0); rb[i] = *(const u32x4*)(bp + (size_t)(32 * i) * ldb + k0); }
        }
        const char* sa = smem + (kt & 1) * 2 * TILE_BYTES; const char* sb = sa + TILE_BYTES;
#pragma unroll
        for (int ks = 0; ks < 2; ++ks) {
            bf16x8 af[4], bfr[4];
#pragma unroll
            for (int m = 0; m < 4; ++m) af[m] = *(const bf16x8*)(sa + ((wr * 64 + m * 16 + fr) * LDS_STRIDE + ks * 32 + fq * 8) * 2);
#pragma unroll
            for (int n = 0; n < 4; ++n) bfr[n] = *(const bf16x8*)(sb + ((wc * 64 + n * 16 + fr) * LDS_STRIDE + ks * 32 + fq * 8) * 2);
            __builtin_amdgcn_s_setprio(1);
#pragma unroll
            for (int m = 0; m < 4; ++m)
#pragma unroll
                for (int n = 0; n < 4; ++n) acc[m][n] = TR ? __builtin_amdgcn_mfma_f32_16x16x32_bf16(bfr[n], af[m], acc[m][n], 0, 0, 0) : __builtin_amdgcn_mfma_f32_16x16x32_bf16(af[m], bfr[n], acc[m][n], 0, 0, 0);
            __builtin_amdgcn_s_setprio(0);
        }
        if (more) {
            char* da = smem + ((kt + 1) & 1) * 2 * TILE_BYTES; char* db = da + TILE_BYTES;
#pragma unroll
            for (int i = 0; i < 4; ++i) { *(u32x4*)(da + ((crow + 32 * i) * LDS_STRIDE + ckc * 8) * 2) = ra[i]; *(u32x4*)(db + ((crow + 32 * i) * LDS_STRIDE + ckc * 8) * 2) = rb[i]; }
        }
        __syncthreads();
    }
    epi(acc, wr * 64, wc * 64, fr, fq);
}


#define L2_STRIDE 40
#define A2_BYTES (256 * L2_STRIDE * 2)
#define B2_BYTES (128 * L2_STRIDE * 2)
#define ST2_BYTES (A2_BYTES + B2_BYTES)
template <class Epi>
__device__ __forceinline__ void gemm256(const bf16_t* __restrict__ A, int lda, const bf16_t* __restrict__ B, int ldb, int K, char* smem, const Epi& epi) {
    const int tid = opaque_tid(), lane = tid & 63, wid = tid >> 6, wr = wid >> 1, wc = wid & 1, fr = lane & 15, fq = lane >> 4;
    f32x4 acc[2][4][4];
#pragma unroll
    for (int hh = 0; hh < 2; ++hh)
#pragma unroll
        for (int m = 0; m < 4; ++m)
#pragma unroll
            for (int n = 0; n < 4; ++n) acc[hh][m][n] = (f32x4){0.f, 0.f, 0.f, 0.f};
    const int crow = tid >> 2, ckc = tid & 3;
    const bf16_t* ap = A + (size_t)crow * lda + ckc * 8;
    const bf16_t* bp = B + (size_t)crow * ldb + ckc * 8;
    u32x4 ra[4], rb[2];
#pragma unroll
    for (int i = 0; i < 4; ++i) ra[i] = *(const u32x4*)(ap + (size_t)(64 * i) * lda);
#pragma unroll
    for (int i = 0; i < 2; ++i) rb[i] = *(const u32x4*)(bp + (size_t)(64 * i) * ldb);
    {
        char* sa = smem; char* sb = smem + A2_BYTES;
#pragma unroll
        for (int i = 0; i < 4; ++i) *(u32x4*)(sa + ((crow + 64 * i) * L2_STRIDE + ckc * 8) * 2) = ra[i];
#pragma unroll
        for (int i = 0; i < 2; ++i) *(u32x4*)(sb + ((crow + 64 * i) * L2_STRIDE + ckc * 8) * 2) = rb[i];
    }
    __syncthreads();
    const int nk = K >> 5;
    for (int kt = 0; kt < nk; ++kt) {
        const bool more = (kt + 1 < nk);
        if (more) {
            const int k0 = (kt + 1) << 5;
#pragma unroll
            for (int i = 0; i < 4; ++i) ra[i] = *(const u32x4*)(ap + (size_t)(64 * i) * lda + k0);
#pragma unroll
            for (int i = 0; i < 2; ++i) rb[i] = *(const u32x4*)(bp + (size_t)(64 * i) * ldb + k0);
        }
        const char* sa = smem + (kt & 1) * ST2_BYTES; const char* sb = sa + A2_BYTES;
        bf16x8 bfr[4];
#pragma unroll
        for (int n = 0; n < 4; ++n) bfr[n] = *(const bf16x8*)(sb + ((wc * 64 + n * 16 + fr) * L2_STRIDE + fq * 8) * 2);
#pragma unroll
        for (int hh = 0; hh < 2; ++hh) {
            bf16x8 af[4];
#pragma unroll
            for (int m = 0; m < 4; ++m) af[m] = *(const bf16x8*)(sa + ((wr * 128 + hh * 64 + m * 16 + fr) * L2_STRIDE + fq * 8) * 2);
            __builtin_amdgcn_s_setprio(1);
#pragma unroll
            for (int m = 0; m < 4; ++m)
#pragma unroll
                for (int n = 0; n < 4; ++n) acc[hh][m][n] = __builtin_amdgcn_mfma_f32_16x16x32_bf16(bfr[n], af[m], acc[hh][m][n], 0, 0, 0);
            __builtin_amdgcn_s_setprio(0);
        }
        if (more) {
            char* da = smem + ((kt + 1) & 1) * ST2_BYTES; char* db = da + A2_BYTES;
#pragma unroll
            for (int i = 0; i < 4; ++i) *(u32x4*)(da + ((crow + 64 * i) * L2_STRIDE + ckc * 8) * 2) = ra[i];
#pragma unroll
            for (int i = 0; i < 2; ++i) *(u32x4*)(db + ((crow + 64 * i) * L2_STRIDE + ckc * 8) * 2) = rb[i];
        }
        __syncthreads();
    }
    epi(acc[0], wr * 128, wc * 64, fr, fq);
    epi(acc[1], wr * 128 + 64, wc * 64, fr, fq);
}

struct EpiZ {
    bf16_t* Z; int R0, C0;
    __device__ __forceinline__ void operator()(f32x4 (&acc)[4][4], int r0, int c0, int fr, int fq) const {
#pragma unroll
        for (int n = 0; n < 4; ++n) { const int col = C0 + c0 + n * 16 + fq * 4; if (col < NIN) {
#pragma unroll
            for (int m = 0; m < 4; ++m) { u32x2 w; w.x = pack2(acc[m][n][0], acc[m][n][1]); w.y = pack2(acc[m][n][2], acc[m][n][3]);
                *(u32x2*)(Z + (size_t)(R0 + r0 + m * 16 + fr) * NIN + col) = w; } } }
    }
};
struct EpiQ {
    bf16_t* Q; const float* rs; const float* ropeC; const float* ropeS; int R0, C0;
    __device__ __forceinline__ void operator()(f32x4 (&acc)[4][4], int r0, int c0, int fr, int fq) const {
        const bool lat = R0 >= M_CTX;
#pragma unroll
        for (int n = 0; n < 4; ++n) {
            const int cb = C0 + c0 + n * 16; const int hcs = cb % 96;
            if (lat && hcs == 80) continue;
            const bool rot = lat && hcs == 64;
#pragma unroll
            for (int m = 0; m < 4; ++m) {
                const int rl = r0 + m * 16 + fr; const int row = R0 + rl; const float sc = rs[rl] * QSCALE;
                const f32x4 x1 = acc[m][n] * sc; bf16_t* qp = Q + (size_t)row * 768 + cb + fq * 4;
                if (rot) {
                    const f32x4 x2 = acc[m][(n + 1) & 3] * sc; const int t = (row - M_CTX) & 4095;
                    const f32x4 cv = *(const f32x4*)(ropeC + t * 16 + fq * 4), sv = *(const f32x4*)(ropeS + t * 16 + fq * 4);
                    const f32x4 o1 = x1 * cv - x2 * sv, o2 = x1 * sv + x2 * cv;
                    u32x2 w; w.x = pack2(o1[0], o1[1]); w.y = pack2(o1[2], o1[3]); *(u32x2*)qp = w;
                    w.x = pack2(o2[0], o2[1]); w.y = pack2(o2[2], o2[3]); *(u32x2*)(qp + 16) = w;
                } else { u32x2 w; w.x = pack2(x1[0], x1[1]); w.y = pack2(x1[2], x1[3]); *(u32x2*)qp = w; }
            }
        }
    }
};
struct EpiKN {
    bf16_t* Kd; const float* rs; int R0, C0;
    __device__ __forceinline__ void operator()(f32x4 (&acc)[4][4], int r0, int c0, int fr, int fq) const {
#pragma unroll
        for (int n = 0; n < 4; ++n) { const int col = C0 + c0 + n * 16 + fq * 4; const int h = col >> 6, d = col & 63;
#pragma unroll
            for (int m = 0; m < 4; ++m) { const int rl = r0 + m * 16 + fr; const f32x4 v = acc[m][n] * (rs ? rs[rl] : 1.0f);
                u32x2 w; w.x = pack2(v[0], v[1]); w.y = pack2(v[2], v[3]); *(u32x2*)(Kd + (size_t)(R0 + rl) * 768 + h * 96 + d) = w; } }
    }
};
struct EpiKV {
    bf16_t* Kd; bf16_t* Vd; const float* rs; int R0, C0; int seqshift; size_t vbase0;
    __device__ __forceinline__ void operator()(f32x4 (&acc)[4][4], int r0, int c0, int fr, int fq) const {
#pragma unroll
        for (int n = 0; n < 4; ++n) {
            const int col = C0 + c0 + n * 16 + fr;
#pragma unroll
            for (int m = 0; m < 4; ++m) {
                const int rl = r0 + m * 16 + fq * 4; const int row = R0 + rl;
                float v[4];
#pragma unroll
                for (int j = 0; j < 4; ++j) v[j] = acc[m][n][j] * (rs ? rs[rl + j] : 1.0f);
                if (col < 512) {
                    const int h = col >> 6, d = col & 63;
#pragma unroll
                    for (int j = 0; j < 4; ++j) Kd[(size_t)(row + j) * 768 + h * 96 + d] = f2bf(v[j]);
                } else {
                    const int vc = col - 512, h = vc >> 6, dv = vc & 63; const int b = row >> seqshift, t = row & ((1 << seqshift) - 1);
                    u32x2 w; w.x = pack2(v[0], v[1]); w.y = pack2(v[2], v[3]);
                    *(u32x2*)(Vd + vbase0 + ((size_t)((b * 8 + h) * 64 + dv) << seqshift) + t) = w;
                }
            }
        }
    }
};
struct EpiRes {
    float* X; const float* gate; int R0, C0;
    __device__ __forceinline__ void operator()(f32x4 (&acc)[4][4], int r0, int c0, int fr, int fq) const {
#pragma unroll
        for (int n = 0; n < 4; ++n) { const int col = C0 + c0 + n * 16 + fq * 4; const f32x4 g = *(const f32x4*)(gate + col);
#pragma unroll
            for (int m = 0; m < 4; ++m) { float* px = X + (size_t)(R0 + r0 + m * 16 + fr) * DM + col; const f32x4 xv = *(const f32x4*)px; *(f32x4*)px = ALPHA_F * xv + g * acc[m][n]; } }
    }
};
struct EpiSwi {
    bf16_t* H; int R0, C0;
    __device__ __forceinline__ void operator()(f32x4 (&acc)[4][4], int r0, int c0, int fr, int fq) const {
        const int hb = ((C0 + c0) >> 1) + fq * 4;
#pragma unroll
        for (int n = 0; n < 2; ++n)
#pragma unroll
            for (int m = 0; m < 4; ++m) { float o[4];
#pragma unroll
                for (int j = 0; j < 4; ++j) { const float g = acc[m][n][j], u = acc[m][n + 2][j]; o[j] = g * sigmoidf_(g) * u; }
                u32x2 w; w.x = pack2(o[0], o[1]); w.y = pack2(o[2], o[3]);
                *(u32x2*)(H + (size_t)(R0 + r0 + m * 16 + fr) * DFF + hb + n * 16) = w; }
    }
};

__device__ __forceinline__ void ada_unit(const P& p, int u, char* smem) {
    const int tid = opaque_tid(); const int l = u / 96, c0 = (u % 96) * 64;
    float* cs = (float*)smem;
    for (int i = tid; i < 5 * 1024; i += 256) { const int r = i >> 10, k = i & 1023; const float v = (r == 0) ? p.c_ctx[k] : p.c[(r - 1) * 1024 + k]; cs[i] = v * sigmoidf_(v); }
    __syncthreads();
    const int col = tid & 63, kq = tid >> 6;
    float s0 = 0.f, s1 = 0.f, s2 = 0.f, s3 = 0.f, s4 = 0.f;
    const float* w = p.ada_w + ((size_t)l * 1024 + kq * 256) * 6144 + c0 + col;
    const float* cq = cs + kq * 256;
    for (int k = 0; k < 256; ++k) { const float wv = w[(size_t)k * 6144]; s0 += cq[k] * wv; s1 += cq[1024 + k] * wv; s2 += cq[2048 + k] * wv; s3 += cq[3072 + k] * wv; s4 += cq[4096 + k] * wv; }
    float* red = cs + 5 * 1024;
    red[(kq * 5 + 0) * 64 + col] = s0; red[(kq * 5 + 1) * 64 + col] = s1; red[(kq * 5 + 2) * 64 + col] = s2; red[(kq * 5 + 3) * 64 + col] = s3; red[(kq * 5 + 4) * 64 + col] = s4;
    __syncthreads();
    for (int o = tid; o < 320; o += 256) { const int i = o >> 6, cc = o & 63;
        const float v = red[(0 * 5 + i) * 64 + cc] + red[(1 * 5 + i) * 64 + cc] + red[(2 * 5 + i) * 64 + cc] + red[(3 * 5 + i) * 64 + cc] + p.ada_b[l * 6144 + c0 + cc];
        p.mod[((size_t)l * 5 + i) * 6144 + c0 + cc] = v; }
    __syncthreads();
}
__device__ __forceinline__ int map_col(int kind, int n) {
    if (kind == 1) { const int blk = n >> 6, r = n & 63; return r < 32 ? blk * 32 + r : DFF + blk * 32 + (r - 32); }
    if (kind == 2) { if (n < 512) return (n >> 6) * 128 + (n & 63); const int vc = n - 512; return (vc >> 6) * 128 + 64 + (vc & 63); }
    return n;
}
__device__ __forceinline__ void conv_tile(const float* src, int ldsrc, bf16_t* dst, bf16_t* dst2, int Kdst, int n0, int k0, int kind, int Nvalid, const float* kscale, char* smem) {
    const int tid = opaque_tid(); float* tile = (float*)smem;
    { const int j = tid & 63, i0 = tid >> 6; const int n = n0 + j; const int sc = (n < Nvalid) ? map_col(kind, n) : -1;
#pragma unroll 4
      for (int ii = 0; ii < 16; ++ii) { const int i = i0 + 4 * ii; tile[i * 65 + j] = (sc >= 0) ? src[(size_t)(k0 + i) * ldsrc + sc] : 0.f; } }
    __syncthreads();
    { const int i = tid & 63, j0 = tid >> 6; const float ks = kscale ? kscale[k0 + i] : 1.f;
#pragma unroll 4
      for (int jj = 0; jj < 16; ++jj) { const int jx = j0 + 4 * jj; const float v = tile[i * 65 + jx];
          dst[(size_t)(n0 + jx) * Kdst + k0 + i] = f2bf(v * ks); if (dst2) dst2[(size_t)(n0 + jx) * Kdst + k0 + i] = f2bf(v); } }
    __syncthreads();
}
#define NCONV 3032
__device__ __forceinline__ void conv_unit(const P& p, int l, int u, char* smem) {
    const float* src; int ldsrc; bf16_t* dst; bf16_t* dst2 = nullptr; int Kdst, n0, k0, kind = 0, Nvalid; const float* kscale = nullptr;
    if (u < 544) { src = p.w_in + (size_t)l * 1024 * NIN; ldsrc = NIN; dst = p.WtIn; Kdst = 1024; n0 = (u / 16) * 64; k0 = (u % 16) * 64; Nvalid = NIN; }
    else if (u < 592) { u -= 544; src = p.q_up + (size_t)l * 256 * 768; ldsrc = 768; dst = p.WtQ; Kdst = 256; n0 = (u / 4) * 64; k0 = (u % 4) * 64; Nvalid = 768; kscale = p.q_norm + l * 256; }
    else if (u < 624) { u -= 592; src = p.kv_up + (size_t)l * 128 * 1024; ldsrc = 1024; dst = p.WtKVn; dst2 = p.WtKV; Kdst = 128; n0 = (u / 2) * 64; k0 = (u % 2) * 64; kind = 2; Nvalid = 1024; kscale = p.kv_norm + l * 128; }
    else if (u < 880) { u -= 624; src = p.w_out + (size_t)l * 1024 * 1024; ldsrc = 1024; dst = p.WtOut; Kdst = 1024; n0 = (u / 16) * 64; k0 = (u % 16) * 64; Nvalid = 1024; }
    else if (u < 2288) { u -= 880; src = p.ffn_in + (size_t)l * 1024 * 5632; ldsrc = 5632; dst = p.WtF1; Kdst = 1024; n0 = (u / 16) * 64; k0 = (u % 16) * 64; kind = 1; Nvalid = 5632; }
    else if (u < 2992) { u -= 2288; src = p.ffn_out + (size_t)l * DFF * 1024; ldsrc = 1024; dst = p.WtF2; Kdst = DFF; n0 = (u / 44) * 64; k0 = (u % 44) * 64; Nvalid = 1024; }
    else if (u < 3008) { u -= 2992; const float* sp = p.gm_ws + (size_t)l * 65536 + u * 4096; bf16_t* d = p.WsB + u * 4096; for (int i = threadIdx.x; i < 4096; i += 256) d[i] = f2bf(sp[i]); return; }
    else if (u < 3016) { u -= 3008; const int d = u >> 2; src = p.rw_w2 + ((size_t)l * 2 + d) * 64 * 256; ldsrc = 256; dst = p.W2t + d * 256 * 64; Kdst = 64; n0 = (u & 3) * 64; k0 = 0; Nvalid = 256; }
    else if (u < 3024) { u -= 3016; const int d = u >> 2; src = p.rw_a2 + ((size_t)l * 2 + d) * 64 * 256; ldsrc = 256; dst = p.A2t + d * 256 * 64; Kdst = 64; n0 = (u & 3) * 64; k0 = 0; Nvalid = 256; }
    else { u -= 3024; src = p.rw_g2 + (size_t)l * 128 * 256; ldsrc = 256; dst = p.G2t; Kdst = 128; n0 = (u / 2) * 64; k0 = (u % 2) * 64; Nvalid = 256; }
    conv_tile(src, ldsrc, dst, dst2, Kdst, n0, k0, kind, Nvalid, kscale, smem);
}
__device__ __forceinline__ void misc0_unit(const P& p, int u) {
    const int tid = opaque_tid();
    if (u < 16) {
        for (int e = tid; e < 4096; e += 256) { const int idx = u * 4096 + e; const int t = idx >> 4, i = idx & 15;
            const float pos = (float)((i < 8) ? (t >> 6) : (t & 63)); const float inv = exp2f(-(float)(i & 7) * 1.6609640474436813f);
            const float ang = pos * inv; const float kf = rintf(ang * 0.15915494309189535f);
            float r = fmaf(-kf, 6.28318548202514648f, ang); r = fmaf(-kf, -1.74845553e-7f, r);
            p.ropeC[idx] = __cosf(r); p.ropeS[idx] = __sinf(r); }
    } else {
        const int v = u - 16;
        for (int e = tid; e < 4096; e += 256) { const int idx = v * 4096 + e;
            const int c = idx & 127, t = (idx >> 7) & 511, b = (idx >> 16) & 3, l = idx >> 18;
            p.CkvB[idx] = f2bf(p.cache_ckv[(((size_t)b * 4 + l) * 512 + t) * 128 + c]); }
    }
}

__device__ __forceinline__ void ln_phase(const P& p, int l, int which) {
    const int tid = opaque_tid(), lane = tid & 63, wid = tid >> 6;
    const float* g = which == 1 ? p.ln1_g + l * DM : p.ln2_g + l * DM; const float* bb = which == 1 ? p.ln1_b + l * DM : p.ln2_b + l * DM;
    const int ml = which == 2 ? l + 1 : l; const int shoff = which == 1 ? 3072 : 0, scoff = which == 1 ? 4096 : 1024;
    const bool dohb = !(which == 2 && l == 3);
    for (int row = blockIdx.x * 4 + wid; row < M_ALL; row += gridDim.x * 4) {
        float* xr = p.out + (size_t)row * DM;
        const float* src = which == 0 ? (row < M_CTX ? p.x_prompt + (size_t)row * DM : p.x_sample + (size_t)(row - M_CTX) * DM) : xr;
        f32x4 v[4];
#pragma unroll
        for (int i = 0; i < 4; ++i) v[i] = *(const f32x4*)(src + lane * 4 + 256 * i);
        if (which != 0) {
            float s = 0.f;
#pragma unroll
            for (int i = 0; i < 4; ++i) s += (v[i][0] + v[i][1]) + (v[i][2] + v[i][3]);
            s = red16(s); s += __shfl_xor(s, 16); s += __shfl_xor(s, 32);
            const float mu = s * (1.0f / 1024.0f); float q = 0.f;
#pragma unroll
            for (int i = 0; i < 4; ++i) { const f32x4 d = v[i] - mu; q += (d[0] * d[0] + d[1] * d[1]) + (d[2] * d[2] + d[3] * d[3]); }
            q = red16(q); q += __shfl_xor(q, 16); q += __shfl_xor(q, 32);
            const float rstd = rsqrtf(q * (1.0f / 1024.0f) + 1e-5f);
#pragma unroll
            for (int i = 0; i < 4; ++i) { const f32x4 gg = *(const f32x4*)(g + lane * 4 + 256 * i), bv = *(const f32x4*)(bb + lane * 4 + 256 * i); v[i] = (v[i] - mu) * rstd * gg + bv; }
        }
#pragma unroll
        for (int i = 0; i < 4; ++i) *(f32x4*)(xr + lane * 4 + 256 * i) = v[i];
        if (dohb) {
            const float* md = p.mod + ((size_t)ml * 5 + modrow_of(row)) * 6144;
#pragma unroll
            for (int i = 0; i < 4; ++i) { const f32x4 sh = *(const f32x4*)(md + shoff + lane * 4 + 256 * i), sc = *(const f32x4*)(md + scoff + lane * 4 + 256 * i);
                const f32x4 h = v[i] * (1.0f + sc) + sh; u32x2 w; w.x = pack2(h[0], h[1]); w.y = pack2(h[2], h[3]);
                *(u32x2*)(p.hbmix + (size_t)row * DM + lane * 4 + 256 * i) = w; }
        }
    }
}

__device__ __forceinline__ void rwprep_unit(const P& p, int l, int u, char* smem) {
    const int tid = opaque_tid(), lane = tid & 63, wid = tid >> 6, fr = lane & 15, fq = lane >> 4;
    const int R0 = u * 64;
    const int ss = R0 < M_CTX ? (R0 & ~255) : M_CTX + ((R0 - M_CTX) & ~4095); const int se = ss + (R0 < M_CTX ? 256 : 4096);
    bf16_t* XW = (bf16_t*)smem; bf16_t* XA = XW + 64 * 136; bf16_t* XG = XA + 64 * 136;
    const float* cw = p.rw_conv + (size_t)l * 3 * 1152;
    for (int it = tid; it < 1152; it += 256) {
        const int cc = it % 144, tg = it / 144; const int c = cc * 8;
        float w0[8], w1[8], w2[8];
#pragma unroll
        for (int i = 0; i < 8; ++i) { w0[i] = cw[c + i]; w1[i] = cw[1152 + c + i]; w2[i] = cw[2304 + c + i]; }
        const int rfirst = R0 + tg * 8;
        u32x4 rows[10];
#pragma unroll
        for (int i = 0; i < 10; ++i) { const int r = rfirst - 1 + i; rows[i] = (u32x4){0u, 0u, 0u, 0u};
            if (r >= ss && r < se) rows[i] = *(const u32x4*)(p.Z + (size_t)r * NIN + c); }
#pragma unroll
        for (int tt = 0; tt < 8; ++tt) {
            const int row = rfirst + tt;
            const u32x4 prev = rows[tt], cur = rows[tt + 1], nxt = rows[tt + 2];
            float o[8];
#pragma unroll
            for (int i = 0; i < 4; ++i) {
                o[2 * i] = w0[2 * i] * lo_bf(prev[i]) + w1[2 * i] * lo_bf(cur[i]) + w2[2 * i] * lo_bf(nxt[i]);
                o[2 * i + 1] = w0[2 * i + 1] * hi_bf(prev[i]) + w1[2 * i + 1] * hi_bf(cur[i]) + w2[2 * i + 1] * hi_bf(nxt[i]);
            }
            if (c >= 768 && c < 896) {
#pragma unroll
                for (int i = 0; i < 8; ++i) o[i] = tanhf_(o[i]);
            } else if (c >= 1024) {
#pragma unroll
                for (int i = 0; i < 8; ++i) o[i] = sigmoidf_(o[i]);
            }
            u32x4 w; w.x = pack2(o[0], o[1]); w.y = pack2(o[2], o[3]); w.z = pack2(o[4], o[5]); w.w = pack2(o[6], o[7]);
            const int tl = tg * 8 + tt;
            if (c < 768) *(u32x4*)(p.RKV + (size_t)row * 768 + c) = w;
            else if (c < 896) *(u32x4*)(XW + tl * 136 + (c - 768)) = w;
            else if (c < 1024) *(u32x4*)(XA + tl * 136 + (c - 896)) = w;
            else *(u32x4*)(XG + tl * 136 + (c - 1024)) = w;
        }
    }
    __syncthreads();
#pragma unroll 1
    for (int mh = 0; mh < 10; ++mh) {
        const int mat = mh >> 1, nh = mh & 1;
        const int d = mat & 1; const bf16_t* As; const bf16_t* Bw; int kofs, nks, ldw;
        if (mat < 2) { As = XW; Bw = p.W2t + d * 256 * 64; kofs = d * 64; nks = 2; ldw = 64; }
        else if (mat < 4) { As = XA; Bw = p.A2t + d * 256 * 64; kofs = d * 64; nks = 2; ldw = 64; }
        else { As = XG; Bw = p.G2t; kofs = 0; nks = 4; ldw = 128; }
        f32x4 acc[4][2];
#pragma unroll
        for (int m = 0; m < 4; ++m)
#pragma unroll
            for (int n = 0; n < 2; ++n) acc[m][n] = (f32x4){0.f, 0.f, 0.f, 0.f};
        bf16x8 bw[4][2];
#pragma unroll
        for (int ks = 0; ks < 4; ++ks)
#pragma unroll
            for (int n = 0; n < 2; ++n) bw[ks][n] = *(const bf16x8*)(Bw + (size_t)(wid * 64 + nh * 32 + n * 16 + fr) * ldw + (ks < nks ? ks : 0) * 32 + fq * 8);
#pragma unroll
        for (int ks = 0; ks < 4; ++ks) {
            if (ks < nks) {
                bf16x8 af[4];
#pragma unroll
                for (int m = 0; m < 4; ++m) af[m] = *(const bf16x8*)(As + (m * 16 + fr) * 136 + kofs + ks * 32 + fq * 8);
#pragma unroll
                for (int m = 0; m < 4; ++m)
#pragma unroll
                    for (int n = 0; n < 2; ++n) acc[m][n] = __builtin_amdgcn_mfma_f32_16x16x32_bf16(bw[ks][n], af[m], acc[m][n], 0, 0, 0);
            }
        }
#pragma unroll
        for (int n = 0; n < 2; ++n) {
            const int c = wid * 64 + nh * 32 + n * 16 + fq * 4;
            f32x4 bias = (f32x4){0.f, 0.f, 0.f, 0.f}; if (mat < 2) bias = *(const f32x4*)(p.rw_w0 + (l * 2 + d) * 256 + c); else if (mat < 4) bias = *(const f32x4*)(p.rw_a0 + (l * 2 + d) * 256 + c);
            bf16_t* dst; float mul;
            if (mat < 2) { dst = p.Ee + ((size_t)d * M_ALL + R0) * 256 + c; mul = 0.6065306597126334f; }
            else if (mat < 4) { dst = p.Aa + ((size_t)d * M_ALL + R0) * 256 + c; mul = 1.0f; }
            else { dst = p.Gg + (size_t)R0 * 256 + c; mul = 1.0f; }
#pragma unroll
            for (int m = 0; m < 4; ++m) {
                float o[4];
#pragma unroll
                for (int j = 0; j < 4; ++j) { const float x = acc[m][n][j] + bias[j]; o[j] = mat < 4 ? mul * sigmoidf_(x) : x; }
                u32x2 w; w.x = pack2(o[0], o[1]); w.y = pack2(o[2], o[3]);
                *(u32x2*)(dst + (size_t)(m * 16 + fr) * 256) = w;
            }
        }
    }
    __syncthreads();
}
__device__ __forceinline__ void rowscale128(const bf16_t* Z, int R0, int zoff, int ncols, float eps, float* rs) {
    const int tid = opaque_tid(); const int r = tid >> 1, half = tid & 1; const int per = ncols >> 1;
    const bf16_t* zp = Z + (size_t)(R0 + r) * NIN + zoff + half * per;
    float ss = 0.f;
    for (int i = 0; i < per; i += 8) { const u32x4 w = *(const u32x4*)(zp + i);
#pragma unroll
        for (int q = 0; q < 4; ++q) { const float a = lo_bf(w[q]), b = hi_bf(w[q]); ss += a * a + b * b; } }
    ss = dpp_add<0xB1>(ss);
    if (half == 0) rs[r] = rsqrtf(ss / (float)ncols + eps);
}
__device__ __forceinline__ void small_unit(const P& p, int l, int u) {
    const int tid = opaque_tid(), sub = tid >> 5, li = tid & 31;
    if (u < 2560) {
        const int row = u * 8 + sub; const bf16_t* zr = p.Z + (size_t)row * NIN;
        const u32x2 w = *(const u32x2*)(zr + ZKV + li * 4);
        const float z0 = lo_bf(w.x), z1 = hi_bf(w.x), z2 = lo_bf(w.y), z3 = hi_bf(w.y);
        float ss = z0 * z0 + z1 * z1 + z2 * z2 + z3 * z3; ss = red16(ss); ss += __shfl_xor(ss, 16);
        const float rsv = rsqrtf(ss * (1.0f / 128.0f) + 1e-6f);
        const float x1 = bf2f(zr[ZKR + (li & 15)]), x2 = bf2f(zr[ZKR + 16 + (li & 15)]);
        float val;
        if (row < M_CTX) {
            const int b = row >> 8, t = row & 255; const size_t o = ((size_t)(b * 4 + l) * 256 + t);
            const f32x4 g = *(const f32x4*)(p.kv_norm + l * 128 + li * 4);
            *(f32x4*)(p.out + 20971520 + o * 128 + li * 4) = (f32x4){z0 * rsv * g[0], z1 * rsv * g[1], z2 * rsv * g[2], z3 * rsv * g[3]};
            val = li < 16 ? x1 : x2;
            p.out[20971520 + 2097152 + o * 32 + li] = val;
        } else {
            const int t = (row - M_CTX) & 4095; const float cv = p.ropeC[t * 16 + (li & 15)], sv = p.ropeS[t * 16 + (li & 15)];
            val = li < 16 ? x1 * cv - x2 * sv : x1 * sv + x2 * cv;
        }
        const bf16_t bv = f2bf(val);
#pragma unroll
        for (int h = 0; h < 8; ++h) p.Kb[(size_t)row * 768 + h * 96 + 64 + li] = bv;
    } else {
        const int r = (u - 2560) * 8 + sub; const int b = r >> 9, t = r & 511;
        const bf16_t bv = f2bf(p.cache_krope[((size_t)(b * 4 + l) * 512 + t) * 32 + li]);
#pragma unroll
        for (int h = 0; h < 8; ++h) p.Kc[(size_t)r * 768 + h * 96 + 64 + li] = bv;
    }
}
__device__ __forceinline__ void gmlp_unit(const P& p, int l, int u, char* smem) {
    const int tid = opaque_tid(), lane = tid & 63, wid = tid >> 6, fr = lane & 15, fq = lane >> 4;
    const int R0 = (u >> 2) * 128, g = u & 3;
    bf16_t* VnT = (bf16_t*)smem;
    bf16x8 wsf[4][2];
    { const bf16_t* Wg0 = p.WsB + g * 128 * 128;
#pragma unroll
      for (int ks = 0; ks < 4; ++ks)
#pragma unroll
        for (int m = 0; m < 2; ++m) wsf[ks][m] = *(const bf16x8*)(Wg0 + (wid * 32 + m * 16 + fr) * 128 + ks * 32 + fq * 8); }
    {
        const int tok = tid >> 1, half = tid & 1; const bf16_t* zp = p.Z + (size_t)(R0 + tok) * NIN + ZV + g * 64 + half * 32;
        float x[32];
#pragma unroll
        for (int i = 0; i < 4; ++i) { const u32x4 w = *(const u32x4*)(zp + i * 8);
#pragma unroll
            for (int q = 0; q < 4; ++q) { x[i * 8 + 2 * q] = geluf_(lo_bf(w[q])); x[i * 8 + 2 * q + 1] = geluf_(hi_bf(w[q])); } }
        float s = 0.f;
#pragma unroll
        for (int i = 0; i < 32; ++i) s += x[i];
        s = dpp_add<0xB1>(s); const float mu = s * (1.0f / 64.0f);
        float q2 = 0.f;
#pragma unroll
        for (int i = 0; i < 32; ++i) { const float d = x[i] - mu; q2 += d * d; }
        q2 = dpp_add<0xB1>(q2); const float rstd = rsqrtf(q2 * (1.0f / 64.0f) + 1e-5f);
        const float* gg = p.gm_g + l * 256 + g * 64 + half * 32; const float* gb = p.gm_b + l * 256 + g * 64 + half * 32;
#pragma unroll
        for (int i = 0; i < 32; ++i) VnT[(half * 32 + i) * 136 + tok] = f2bf((x[i] - mu) * rstd * gg[i] + gb[i]);
    }
    __syncthreads();
    f32x4 acc[2][4];
#pragma unroll
    for (int m = 0; m < 2; ++m)
#pragma unroll
        for (int n = 0; n < 4; ++n) acc[m][n] = (f32x4){0.f, 0.f, 0.f, 0.f};
#pragma unroll
    for (int ks = 0; ks < 4; ++ks) {
        bf16x8 bfr[4];
#pragma unroll
        for (int n = 0; n < 4; ++n) bfr[n] = *(const bf16x8*)(VnT + (n * 16 + fr) * 136 + ks * 32 + fq * 8);
#pragma unroll
        for (int m = 0; m < 2; ++m)
#pragma unroll
            for (int n = 0; n < 4; ++n) acc[m][n] = __builtin_amdgcn_mfma_f32_16x16x32_bf16(bfr[n], wsf[ks][m], acc[m][n], 0, 0, 0);
    }
#pragma unroll
    for (int m = 0; m < 2; ++m) {
        const int pp = wid * 32 + m * 16 + fr; const float bs = p.gm_bs[l * 512 + g * 128 + pp];
#pragma unroll
        for (int n = 0; n < 4; ++n) { const int c = n * 16 + fq * 4;
            const u32x2 zw = *(const u32x2*)(p.Z + (size_t)(R0 + pp) * NIN + ZU + g * 64 + c);
            const float u0 = geluf_(lo_bf(zw.x)), u1 = geluf_(hi_bf(zw.x)), u2 = geluf_(lo_bf(zw.y)), u3 = geluf_(hi_bf(zw.y));
            u32x2 w; w.x = pack2(u0 * (acc[m][n][0] + bs), u1 * (acc[m][n][1] + bs)); w.y = pack2(u2 * (acc[m][n][2] + bs), u3 * (acc[m][n][3] + bs));
            *(u32x2*)(p.hbmix + (size_t)(R0 + pp) * DM + 768 + g * 64 + c) = w; }
    }
    __syncthreads();
}

__device__ __forceinline__ float swap16_add(float x) {
    auto r = __builtin_amdgcn_permlane16_swap(__float_as_uint(x), __float_as_uint(x), false, false);
    return __uint_as_float(r[0]) + __uint_as_float(r[1]);
}
#define NSCAN_LAT 256
#define NSCAN (256 + 1024)
__device__ __forceinline__ void scan_unit(const P& p, int l, int u, char* smem) {
    const int tid = opaque_tid(), lane = tid & 63, wid = tid >> 6;
    int b, T, row0; const bool lat = u < NSCAN_LAT;
    if (lat) { b = u >> 6; T = 4096; row0 = M_CTX + b * 4096; } else { b = (u - NSCAN_LAT) >> 6; T = 256; row0 = b * 256; }
    const int h = (u >> 4) & 3, d = (u >> 3) & 1, rsl = u & 7;
    float* W = (float*)smem; float* NKK = W + 2048; float* KKA = NKK + 2048; float* KD = KKA + 2048; float* RR = KD + 2048; float* VS = RR + 2048; float* OUTP = VS + 256;
    const int rl = lane >> 5, kq = lane & 31; const int r8 = wid * 2 + rl; const int row = rsl * 8 + r8;
    f32x2 S = (f32x2){0.f, 0.f};
    const size_t stoff = ((((size_t)b * 4 + l) * 2 + d) * 4 + h) * 4096 + row * 64 + kq * 2;
    if (lat) S = *(const f32x2*)(p.state_rwkv + stoff);
    const int tok = tid >> 3, cg8 = tid & 7;
    float kkp[8], kap[8];
#pragma unroll
    for (int i = 0; i < 8; ++i) { kkp[i] = p.rw_kk[l * 256 + h * 64 + cg8 * 8 + i]; kap[i] = p.rw_ka[l * 256 + h * 64 + cg8 * 8 + i]; }
    const int nch = T >> 5;
    u32x4 r8v, k8, e8, a8, v8;
    int grow, grow_prev = 0; float oreg = 0.f;
    {
        const int sidx = tok; const int t = d ? T - 1 - sidx : sidx; grow = row0 + t;
        r8v = *(const u32x4*)(p.RKV + (size_t)grow * 768 + h * 64 + cg8 * 8);
        k8 = *(const u32x4*)(p.RKV + (size_t)grow * 768 + 256 + h * 64 + cg8 * 8);
        v8 = *(const u32x4*)(p.RKV + (size_t)grow * 768 + 512 + h * 64 + rsl * 8);
        e8 = *(const u32x4*)(p.Ee + ((size_t)d * M_ALL + grow) * 256 + h * 64 + cg8 * 8);
        a8 = *(const u32x4*)(p.Aa + ((size_t)d * M_ALL + grow) * 256 + h * 64 + cg8 * 8);
    }
    for (int ch = 0; ch < nch; ++ch) {
        {
            float kf[8], kkv[8], rf[8], ef[8], af[8];
#pragma unroll
            for (int q = 0; q < 4; ++q) { kf[2 * q] = lo_bf(k8[q]); kf[2 * q + 1] = hi_bf(k8[q]); rf[2 * q] = lo_bf(r8v[q]); rf[2 * q + 1] = hi_bf(r8v[q]);
                ef[2 * q] = lo_bf(e8[q]); ef[2 * q + 1] = hi_bf(e8[q]); af[2 * q] = lo_bf(a8[q]); af[2 * q + 1] = hi_bf(a8[q]); }
            float ss = 0.f;
#pragma unroll
            for (int i = 0; i < 8; ++i) { kkv[i] = kf[i] * kkp[i]; ss += kkv[i] * kkv[i]; }
            ss = red8(ss);
            const float inv = rsqrtf(fmaxf(ss, 1e-24f));
            f32x4 o0, o1; const int base = tok * 64 + cg8 * 8;
#pragma unroll
            for (int i = 0; i < 4; ++i) { o0[i] = __expf(-ef[i]); o1[i] = __expf(-ef[4 + i]); }
            *(f32x4*)(W + base) = o0; *(f32x4*)(W + base + 4) = o1;
#pragma unroll
            for (int i = 0; i < 4; ++i) { o0[i] = -kkv[i] * inv; o1[i] = -kkv[4 + i] * inv; }
            *(f32x4*)(NKK + base) = o0; *(f32x4*)(NKK + base + 4) = o1;
#pragma unroll
            for (int i = 0; i < 4; ++i) { o0[i] = kkv[i] * inv * af[i]; o1[i] = kkv[4 + i] * inv * af[4 + i]; }
            *(f32x4*)(KKA + base) = o0; *(f32x4*)(KKA + base + 4) = o1;
#pragma unroll
            for (int i = 0; i < 4; ++i) { o0[i] = kf[i] * (1.0f + (af[i] - 1.0f) * kap[i]); o1[i] = kf[4 + i] * (1.0f + (af[4 + i] - 1.0f) * kap[4 + i]); }
            *(f32x4*)(KD + base) = o0; *(f32x4*)(KD + base + 4) = o1;
#pragma unroll
            for (int i = 0; i < 4; ++i) { o0[i] = rf[i]; o1[i] = rf[4 + i]; }
            *(f32x4*)(RR + base) = o0; *(f32x4*)(RR + base + 4) = o1;
            if (cg8 == 0) {
#pragma unroll
                for (int q = 0; q < 4; ++q) { VS[tok * 8 + 2 * q] = lo_bf(v8[q]); VS[tok * 8 + 2 * q + 1] = hi_bf(v8[q]); }
            }
        }
        __syncthreads();
        if (ch > 0) p.ydir[((size_t)d * M_ALL + grow_prev) * 256 + h * 64 + rsl * 8 + cg8] = oreg;
        grow_prev = grow;
        if (ch + 1 < nch) {
            const int sidx = (ch + 1) * 32 + tok; const int t = d ? T - 1 - sidx : sidx; grow = row0 + t;
            r8v = *(const u32x4*)(p.RKV + (size_t)grow * 768 + h * 64 + cg8 * 8);
            k8 = *(const u32x4*)(p.RKV + (size_t)grow * 768 + 256 + h * 64 + cg8 * 8);
            v8 = *(const u32x4*)(p.RKV + (size_t)grow * 768 + 512 + h * 64 + rsl * 8);
            e8 = *(const u32x4*)(p.Ee + ((size_t)d * M_ALL + grow) * 256 + h * 64 + cg8 * 8);
            a8 = *(const u32x4*)(p.Aa + ((size_t)d * M_ALL + grow) * 256 + h * 64 + cg8 * 8);
        }
        {
            const float* Wq = W + kq * 2; const float* NKq = NKK + kq * 2; const float* KAq = KKA + kq * 2; const float* KDq = KD + kq * 2; const float* RRq = RR + kq * 2; const float* VSq = VS + r8;
            float* OPq = OUTP + r8 * 32 + kq;
            f32x2 wv[4], nkv[4], kav[4], kdv[4], rrv[4]; float vv[4];
#define SCAN_LD(slot, st) do { wv[slot] = *(const f32x2*)(Wq + (st) * 64); nkv[slot] = *(const f32x2*)(NKq + (st) * 64); kav[slot] = *(const f32x2*)(KAq + (st) * 64); \
        kdv[slot] = *(const f32x2*)(KDq + (st) * 64); rrv[slot] = *(const f32x2*)(RRq + (st) * 64); vv[slot] = VSq[(st) * 8]; } while (0)
            __builtin_amdgcn_s_setprio(3);
            SCAN_LD(0, 0); SCAN_LD(1, 1); SCAN_LD(2, 2);
#pragma unroll
            for (int s = 0; s < 32; ++s) {
                if (s + 3 < 32) SCAN_LD((s + 3) & 3, s + 3);
                const f32x2 w = wv[s & 3], nk = nkv[s & 3], ka = kav[s & 3], kd = kdv[s & 3], rr = rrv[s & 3]; const float v = vv[s & 3];
                float pd = fmaf(S[1], nk[1], S[0] * nk[0]);
                pd = red16(pd); pd = swap16_add(pd);
                S[0] = fmaf(S[0], w[0], fmaf(pd, ka[0], v * kd[0]));
                S[1] = fmaf(S[1], w[1], fmaf(pd, ka[1], v * kd[1]));
                OPq[s * 256] = fmaf(S[1], rr[1], S[0] * rr[0]);
            }
            __builtin_amdgcn_s_setprio(0);
        }
        __syncthreads();
        {
            const float* op = OUTP + (tok * 8 + cg8) * 32;
            f32x4 a0 = *(const f32x4*)(op), a1 = *(const f32x4*)(op + 4), a2 = *(const f32x4*)(op + 8), a3 = *(const f32x4*)(op + 12);
            f32x4 b0 = *(const f32x4*)(op + 16), b1 = *(const f32x4*)(op + 20), b2 = *(const f32x4*)(op + 24), b3 = *(const f32x4*)(op + 28);
            a0 = ((a0 + a1) + (a2 + a3)) + ((b0 + b1) + (b2 + b3));
            oreg = (a0[0] + a0[1]) + (a0[2] + a0[3]);
        }
    }
    p.ydir[((size_t)d * M_ALL + grow_prev) * 256 + h * 64 + rsl * 8 + cg8] = oreg;
    if (!lat) *(f32x2*)(p.out + 20971520 + 2097152 + 524288 + stoff) = S;
    __syncthreads();
}

#ifndef ATT_THR
#define ATT_THR 8.0f
#endif
#define KS_STRIDE 104
#define VS_STRIDE 68
#define KS_BYTES (64 * KS_STRIDE * 2)
#define ATT_STAGE (KS_BYTES + 64 * VS_STRIDE * 2)
__device__ __forceinline__ void attn_unit(const P& p, int u, char* smem) {
    const int tid = opaque_tid(), lane = tid & 63, wid = tid >> 6, q = lane & 31, hf = lane >> 5;
    int b, h, qt, qrow0, krow0, nown, ntot, Tv; size_t vbase, vcbase = 0; int kcrow0 = 0;
    if (u < 1024) { b = u >> 8; h = (u >> 5) & 7; qt = u & 31; krow0 = M_CTX + b * 4096; qrow0 = krow0 + qt * 128; nown = 64; ntot = 72; Tv = 4096;
        vbase = 2097152 + (size_t)(b * 8 + h) * 64 * 4096; kcrow0 = b * 512; vcbase = (size_t)(b * 8 + h) * 64 * 512; }
    else { const int v = u - 1024; b = v >> 4; h = (v >> 1) & 7; qt = v & 1; krow0 = b * 256; qrow0 = krow0 + qt * 128; nown = 4; ntot = 4; Tv = 256; vbase = (size_t)(b * 8 + h) * 64 * 256; }
    bf16x8 qf[6];
    { const bf16_t* qp = p.Qb + (size_t)(qrow0 + wid * 32 + q) * 768 + h * 96 + hf * 8;
#pragma unroll
      for (int ks = 0; ks < 6; ++ks) qf[ks] = *(const bf16x8*)(qp + ks * 16); }
    f32x16 oT[2];
#pragma unroll
    for (int i = 0; i < 16; ++i) { oT[0][i] = 0.f; oT[1][i] = 0.f; }
    float mref = 0.f, lrun = 0.f; f32x16 negm;
#pragma unroll
    for (int i = 0; i < 16; ++i) negm[i] = 0.f;
    u32x4 rk[3], rv[2];
    int krow[3], kc[3];
#pragma unroll
    for (int i = 0; i < 3; ++i) { const int c = tid + 256 * i; krow[i] = c / 12; kc[i] = c % 12; }
    const int vdv0 = tid >> 3, vkc = tid & 7;
#define ATT_LOAD(kt) do { const bf16_t* kptr; const bf16_t* vptr; int vstr; \
        if ((kt) < nown) { kptr = p.Kb + (size_t)(krow0 + (kt) * 64) * 768 + h * 96; vptr = p.Vt + vbase + (kt) * 64; vstr = Tv; } \
        else { kptr = p.Kc + (size_t)(kcrow0 + ((kt) - nown) * 64) * 768 + h * 96; vptr = p.Vtc + vcbase + ((kt) - nown) * 64; vstr = 512; } \
        _Pragma("unroll") for (int i = 0; i < 3; ++i) rk[i] = *(const u32x4*)(kptr + (size_t)krow[i] * 768 + kc[i] * 8); \
        _Pragma("unroll") for (int i = 0; i < 2; ++i) rv[i] = *(const u32x4*)(vptr + (size_t)(vdv0 + 32 * i) * vstr + vkc * 8); } while (0)
#define ATT_STORE(buf) do { char* Ks_ = smem + (buf) * ATT_STAGE; char* Vs_ = Ks_ + KS_BYTES; \
        _Pragma("unroll") for (int i = 0; i < 3; ++i) *(u32x4*)(Ks_ + (krow[i] * KS_STRIDE + kc[i] * 8) * 2) = rk[i]; \
        _Pragma("unroll") for (int i = 0; i < 2; ++i) { char* vd_ = Vs_ + ((vdv0 + 32 * i) * VS_STRIDE + vkc * 8) * 2; *(u32x2*)vd_ = (u32x2){rv[i].x, rv[i].y}; *(u32x2*)(vd_ + 8) = (u32x2){rv[i].z, rv[i].w}; } } while (0)
    ATT_LOAD(0); ATT_STORE(0);
    __syncthreads();
    for (int kt = 0; kt < ntot; ++kt) {
        const bool more = kt + 1 < ntot;
        if (more) ATT_LOAD(kt + 1);
        const char* Ks = smem + (kt & 1) * ATT_STAGE; const char* Vs = Ks + KS_BYTES;
        f32x16 sT[2];
#pragma unroll
        for (int kb = 0; kb < 2; ++kb)
#pragma unroll
            for (int ks = 0; ks < 6; ++ks) { const bf16x8 kf = *(const bf16x8*)(Ks + ((kb * 32 + q) * KS_STRIDE + ks * 16 + hf * 8) * 2);
                sT[kb] = __builtin_amdgcn_mfma_f32_32x32x16_bf16(kf, qf[ks], ks == 0 ? negm : sT[kb], 0, 0, 0); }
        float mx = sT[0][0];
#pragma unroll
        for (int i = 1; i < 16; ++i) mx = fmaxf(mx, sT[0][i]);
#pragma unroll
        for (int i = 0; i < 16; ++i) mx = fmaxf(mx, sT[1][i]);
        { auto r_ = __builtin_amdgcn_permlane32_swap(__float_as_uint(mx), __float_as_uint(mx), false, false);
          mx = fmaxf(__uint_as_float(r_[0]), __uint_as_float(r_[1])); }
        const bool first = (kt == 0);
        if (first || __any(mx > ATT_THR)) {
            const float delta = first ? mx : ((mx > ATT_THR) ? mx : 0.f);
            const float alpha = first ? 0.f : __builtin_amdgcn_exp2f(-delta);
            mref += delta; lrun *= alpha;
#pragma unroll
            for (int i = 0; i < 16; ++i) { sT[0][i] -= delta; sT[1][i] -= delta; oT[0][i] *= alpha; oT[1][i] *= alpha; negm[i] = -mref; }
        }
        float psum = 0.f; bf16x8 pf[2][2];
#pragma unroll
        for (int kb = 0; kb < 2; ++kb)
#pragma unroll
            for (int s = 0; s < 2; ++s) { float e[8];
#pragma unroll
                for (int j = 0; j < 8; ++j) { e[j] = __builtin_amdgcn_exp2f(sT[kb][8 * s + j]); psum += e[j]; }
                u32x4 w; w.x = pack2(e[0], e[1]); w.y = pack2(e[2], e[3]); w.z = pack2(e[4], e[5]); w.w = pack2(e[6], e[7]);
                pf[kb][s] = __builtin_bit_cast(bf16x8, w); }
        lrun += psum;
#pragma unroll
        for (int kb = 0; kb < 2; ++kb)
#pragma unroll
            for (int s = 0; s < 2; ++s)
#pragma unroll
                for (int db = 0; db < 2; ++db) {
                    const char* vp = Vs + ((db * 32 + q) * VS_STRIDE + kb * 32 + 16 * s + 4 * hf) * 2;
                    const u32x2 lo = *(const u32x2*)vp, hi = *(const u32x2*)(vp + 16);
                    const u32x4 w = (u32x4){lo.x, lo.y, hi.x, hi.y};
                    oT[db] = __builtin_amdgcn_mfma_f32_32x32x16_bf16(__builtin_bit_cast(bf16x8, w), pf[kb][s], oT[db], 0, 0, 0);
                }
        if (more) ATT_STORE((kt + 1) & 1);
        __syncthreads();
    }
    const float lt = lrun + __shfl_xor(lrun, 32); const float inv = 1.0f / lt;
    bf16_t* op = p.hbmix + (size_t)(qrow0 + wid * 32 + q) * DM + 256 + h * 64;
#pragma unroll
    for (int db = 0; db < 2; ++db)
#pragma unroll
        for (int g = 0; g < 4; ++g) { u32x2 w; w.x = pack2(oT[db][4 * g] * inv, oT[db][4 * g + 1] * inv); w.y = pack2(oT[db][4 * g + 2] * inv, oT[db][4 * g + 3] * inv);
            *(u32x2*)(op + db * 32 + 8 * g + 4 * hf) = w; }
}

__device__ __forceinline__ void rwcomb_phase(const P& p, int l) {
    const int tid = opaque_tid(), lane = tid & 63, wid = tid >> 6; const int c = lane * 4;
    const f32x4 gng = *(const f32x4*)(p.rw_gn_g + l * 256 + c), gnb = *(const f32x4*)(p.rw_gn_b + l * 256 + c), kap = *(const f32x4*)(p.rw_ka + l * 256 + c), rkp = *(const f32x4*)(p.rw_rk + l * 256 + c);
    for (int row = blockIdx.x * 4 + wid; row < M_ALL; row += gridDim.x * 4) {
        const f32x4 y0 = *(const f32x4*)(p.ydir + (size_t)row * 256 + c), y1 = *(const f32x4*)(p.ydir + ((size_t)M_ALL + row) * 256 + c);
        f32x4 y = y0 + y1;
        float s = (y[0] + y[1]) + (y[2] + y[3]); s = red16(s); const float mu = s * (1.0f / 64.0f);
        const f32x4 dd = y - mu; float q2 = (dd[0] * dd[0] + dd[1] * dd[1]) + (dd[2] * dd[2] + dd[3] * dd[3]); q2 = red16(q2);
        const float rstd = rsqrtf(q2 * (1.0f / 64.0f) + 64e-5f);
        const f32x4 yn = dd * rstd * gng + gnb;
        const u32x2 rw = *(const u32x2*)(p.RKV + (size_t)row * 768 + c), kw = *(const u32x2*)(p.RKV + (size_t)row * 768 + 256 + c), vw = *(const u32x2*)(p.RKV + (size_t)row * 768 + 512 + c);
        const u32x2 a0w = *(const u32x2*)(p.Aa + (size_t)row * 256 + c), a1w = *(const u32x2*)(p.Aa + ((size_t)M_ALL + row) * 256 + c), gw = *(const u32x2*)(p.Gg + (size_t)row * 256 + c);
        const f32x4 r = (f32x4){lo_bf(rw.x), hi_bf(rw.x), lo_bf(rw.y), hi_bf(rw.y)}, k = (f32x4){lo_bf(kw.x), hi_bf(kw.x), lo_bf(kw.y), hi_bf(kw.y)}, v = (f32x4){lo_bf(vw.x), hi_bf(vw.x), lo_bf(vw.y), hi_bf(vw.y)};
        const f32x4 a0 = (f32x4){lo_bf(a0w.x), hi_bf(a0w.x), lo_bf(a0w.y), hi_bf(a0w.y)}, a1 = (f32x4){lo_bf(a1w.x), hi_bf(a1w.x), lo_bf(a1w.y), hi_bf(a1w.y)}, gt = (f32x4){lo_bf(gw.x), hi_bf(gw.x), lo_bf(gw.y), hi_bf(gw.y)};
        const f32x4 kds = k * (1.0f + (a0 - 1.0f) * kap) + k * (1.0f + (a1 - 1.0f) * kap);
        const f32x4 t4 = r * kds * rkp; float rk = (t4[0] + t4[1]) + (t4[2] + t4[3]); rk = red16(rk);
        const f32x4 o = (yn + rk * v) * gt;
        u32x2 w; w.x = pack2(o[0], o[1]); w.y = pack2(o[2], o[3]);
        *(u32x2*)(p.hbmix + (size_t)row * DM + c) = w;
    }
}


__device__ __forceinline__ bool xcd_tile(int i, int TT, int NT, int& mt, int& nt) {
    const int per = TT >> 3; if (i >= per) return false;
    const int t = (blockIdx.x & 7) * per + i; const int band = t / (8 * NT), rem = t - band * 8 * NT;
    nt = rem >> 3; mt = band * 8 + (rem & 7); return true;
}
__global__ void __launch_bounds__(256, 2) mega(Args a_unused) {
    extern __shared__ __attribute__((aligned(16))) char smem[];
    __shared__ uint4 xbw; __shared__ int s_unit;
    kargp_t kp = (kargp_t)__builtin_amdgcn_kernarg_segment_ptr();
    const int tid = threadIdx.x; const int G = gridDim.x;
    if (tid == 0) xbw = make_uint4(0u, 0u, 0u, 0u);
    __syncthreads();
    XcdBarrier xb;
    { const P p = getP(kp); xb = xcd_barrier_post(p.bar, (volatile LAS unsigned*)&xbw); }
    for (int u = blockIdx.x; u < 384 + NCONV + 272; u += G) {
        if (u < 384) { const P p = getP(kp); ada_unit(p, u, smem); } else if (u < 384 + NCONV) { const P p = getP(kp); conv_unit(p, 0, u - 384, smem); } else { const P p = getP(kp); misc0_unit(p, u - 384 - NCONV); }
    }
    cg::this_grid().sync();
    { const P p = getP(kp); ln_phase(p, 0, 0); }
    xcd_barrier(xb);
    float* rs = (float*)(smem + RS_OFF);
#pragma unroll 1
    for (int l = 0; l < 4; ++l) {
        for (int i = blockIdx.x >> 3; ; i += G >> 3) { int mt, nt; if (!xcd_tile(i, 80 * 17, 17, mt, nt)) break; const P p = getP(kp);
            EpiZ e{p.Z, mt * 256, nt * 128};
            gemm256(p.hbmix + (size_t)mt * 256 * DM, DM, p.WtIn + (size_t)nt * 128 * DM, DM, DM, smem, e); }
        xcd_barrier(xb);
        for (int rep2 = 0; rep2 < DUP_P2; ++rep2) {
        for (;;) {
            { const P pc = getP(kp); if (tid == 0) s_unit = atomicAdd(&pc.ctr[l * 4 + 0 + 2 * rep2], 1); }
            __syncthreads(); int u = s_unit; __syncthreads();
            if (u >= 320 + 480 + 640 + 64 + 352 + 640) break;
            if (u < 320) { const P p = getP(kp); rwprep_unit(p, l, u, smem); continue; }
            u -= 320;
            if (u < 480) { const P p = getP(kp); const int mt = u / 3, np = u % 3;
                rowscale128(p.Z, mt * 128, ZQ, 256, 1e-6f, rs);
                for (int k2 = 0; k2 < 2; ++k2) { const int nt = np * 2 + k2;
                    EpiQ e{p.Qb, rs, p.ropeC, p.ropeS, mt * 128, nt * 128};
                    gemm128<true>(p.Z + (size_t)mt * 128 * NIN + ZQ, NIN, p.WtQ + (size_t)nt * 128 * 256, 256, 256, smem, e); }
                __syncthreads(); continue; }
            u -= 480;
            if (u < 640) { const P p = getP(kp); const int mt = u >> 2, np = u & 3; const int R0 = mt * 128; const bool latr = R0 >= M_CTX;
                rowscale128(p.Z, R0, ZKV, 128, 1e-6f, rs);
                for (int k2 = 0; k2 < 2; ++k2) { const int nt = np * 2 + k2;
                    if (np < 2) { EpiKN e{latr ? p.Kb + (size_t)M_CTX * 768 : p.Kb, rs, latr ? R0 - M_CTX : R0, nt * 128};
                        gemm128<true>(p.Z + (size_t)R0 * NIN + ZKV, NIN, p.WtKVn + (size_t)nt * 128 * 128, 128, 128, smem, e); }
                    else { EpiKV e{latr ? p.Kb + (size_t)M_CTX * 768 : p.Kb, p.Vt, rs, latr ? R0 - M_CTX : R0, nt * 128, latr ? 12 : 8, latr ? (size_t)2097152 : (size_t)0};
                        gemm128<false>(p.Z + (size_t)R0 * NIN + ZKV, NIN, p.WtKVn + (size_t)nt * 128 * 128, 128, 128, smem, e); } }
                __syncthreads(); continue; }
            u -= 640;
            if (u < 64) { const P p = getP(kp); const int mt = u >> 2, np = u & 3;
                for (int k2 = 0; k2 < 2; ++k2) { const int nt = np * 2 + k2;
                    if (np < 2) { EpiKN e{p.Kc, nullptr, mt * 128, nt * 128};
                        gemm128<true>(p.CkvB + ((size_t)l * 2048 + mt * 128) * 128, 128, p.WtKV + (size_t)nt * 128 * 128, 128, 128, smem, e); }
                    else { EpiKV e{p.Kc, p.Vtc, nullptr, mt * 128, nt * 128, 9, (size_t)0};
                        gemm128<false>(p.CkvB + ((size_t)l * 2048 + mt * 128) * 128, 128, p.WtKV + (size_t)nt * 128 * 128, 128, 128, smem, e); } }
                continue; }
            u -= 64;
            if (u < 352) { const P p = getP(kp); for (int i = 0; i < 8; ++i) small_unit(p, l, u * 8 + i); continue; }
            u -= 352;
            { const P p = getP(kp); gmlp_unit(p, l, u, smem); }
        }
        xcd_barrier(xb);
        }
        for (int rep3 = 0; rep3 < DUP_P3; ++rep3) {
        for (;;) {
            { const P pc = getP(kp); if (tid == 0) s_unit = atomicAdd(&pc.ctr[l * 4 + 1 + 2 * rep3], 1); }
            __syncthreads(); int u = s_unit; __syncthreads();
            if (u >= NSCAN + 1280) break;
#ifdef PROBE_SCAN_ONLY
            if (rep3 == 1 && u >= NSCAN) break;
#endif
#ifdef PROBE_ATTN_ONLY
            if (rep3 == 1 && u < NSCAN) continue;
#endif
            if (u < NSCAN) { const P p = getP(kp); scan_unit(p, l, u, smem); } else { const P p = getP(kp); attn_unit(p, u - NSCAN, smem); }
        }
        xcd_barrier(xb);
        }
        { const P p = getP(kp); rwcomb_phase(p, l); }
        xcd_barrier(xb);
        for (int i = blockIdx.x >> 3; ; i += G >> 3) { int mt, nt; if (!xcd_tile(i, 160 * 8, 8, mt, nt)) break; const P p = getP(kp);
            EpiRes e{p.out, p.mod + ((size_t)l * 5 + modrow_of(mt * 128)) * 6144 + 2048, mt * 128, nt * 128};
            gemm128<true>(p.hbmix + (size_t)mt * 128 * DM, DM, p.WtOut + (size_t)nt * 128 * DM, DM, DM, smem, e); }
        xcd_barrier(xb);
        { const P p = getP(kp); ln_phase(p, l, 1); }
        xcd_barrier(xb);
        for (int rep5 = 0; rep5 < DUP_P5; ++rep5)
        for (int i = blockIdx.x >> 3; ; i += G >> 3) { int mt, nt; if (!xcd_tile(i, 80 * 44, 44, mt, nt)) break; const P p = getP(kp);
            EpiSwi e{p.hidden, mt * 256, nt * 128};
            gemm256(p.hbmix + (size_t)mt * 256 * DM, DM, p.WtF1 + (size_t)nt * 128 * DM, DM, DM, smem, e); }
        xcd_barrier(xb);
        for (int i = blockIdx.x >> 3; ; i += G >> 3) { int mt, nt; if (!xcd_tile(i, 160 * 8, 8, mt, nt)) break; const P p = getP(kp);
            EpiRes e{p.out, p.mod + ((size_t)l * 5 + modrow_of(mt * 128)) * 6144 + 5120, mt * 128, nt * 128};
            gemm128<true>(p.hidden + (size_t)mt * 128 * DFF, DFF, p.WtF2 + (size_t)nt * 128 * DFF, DFF, DFF, smem, e); }
        xcd_barrier(xb);
        { const P p = getP(kp); ln_phase(p, l, 2); }
        if (l < 3) { for (int u = blockIdx.x; u < NCONV; u += G) { const P p = getP(kp); conv_unit(p, l + 1, u, smem); } }
        xcd_barrier(xb);
    }
}

extern "C" void kernel_launch(void* const* d_in, const int* in_sizes, int n_in, void* d_out, int out_size, void* d_ws, size_t ws_size, hipStream_t stream) {
    static int grid_blocks = 0;
    if (!grid_blocks) {
        int dev = 0, cus = 0, per_cu = 0;
        (void)hipGetDevice(&dev);
        (void)hipDeviceGetAttribute(&cus, hipDeviceAttributeMultiprocessorCount, dev);
        (void)hipFuncSetAttribute((const void*)mega, hipFuncAttributeMaxDynamicSharedMemorySize, SMEM_BYTES);
        (void)hipOccupancyMaxActiveBlocksPerMultiprocessor(&per_cu, (const void*)mega, 256, SMEM_BYTES);
        if (per_cu > 2) per_cu = 2;
        if (per_cu < 1) per_cu = 1;
        grid_blocks = (cus * per_cu) & ~7;
    }
    if (WS_TOTAL > ws_size) { fprintf(stderr, "kernel_launch: workspace too small: need %zu have %zu\n", (size_t)WS_TOTAL, ws_size); return; }
    Args a{};
    for (int i = 0; i < 36; ++i) a.in[i] = (const float*)d_in[i];
    a.out = (float*)d_out; a.ws = (char*)d_ws;
    (void)hipMemsetAsync((char*)d_ws + OFF_BAR, 0, 16384 + 4096, stream);
    void* args[] = {&a};
    hipError_t e = hipLaunchCooperativeKernel((const void*)mega, dim3(grid_blocks), dim3(256), args, SMEM_BYTES, stream);
    if (e != hipSuccess) fprintf(stderr, "cooperative launch failed: %s (grid %d)\n", hipGetErrorString(e), grid_blocks);
}
```

```cpp
#include <hip/hip_runtime.h>
#include <hip/hip_cooperative_groups.h>
#include <cstdint>
#include <cstdio>
namespace cg = cooperative_groups;

typedef unsigned short bf16_t;
typedef short bf16x8 __attribute__((ext_vector_type(8)));
typedef float f32x4 __attribute__((ext_vector_type(4)));
typedef float f32x2 __attribute__((ext_vector_type(2)));
typedef float f32x16 __attribute__((ext_vector_type(16)));
typedef unsigned u32x4 __attribute__((ext_vector_type(4)));
typedef unsigned u32x2 __attribute__((ext_vector_type(2)));

#define M_ALL 20480
#define M_CTX 4096
#define DM 1024
#define NIN 2080
#define DFF 2816
#define ALPHA_F 1.6817928305074290f
#define QSCALE (0.10206207261596575f * 1.4426950408889634f)
#define LAS __attribute__((address_space(3)))
#ifndef DUP_P2
#define DUP_P2 1
#endif
#ifndef DUP_P3
#define DUP_P3 1
#endif
#ifndef DUP_P5
#define DUP_P5 1
#endif

#define ZQ 1152
#define ZKV 1408
#define ZKR 1536
#define ZU 1568
#define ZV 1824

#define LDS_STRIDE 72
#define TILE_BYTES (128 * LDS_STRIDE * 2)
#define RS_OFF (4 * TILE_BYTES)
#define SMEM_BYTES (RS_OFF + 3072)

struct P {
    const float *x_prompt, *x_sample, *cache_ckv, *cache_krope, *state_rwkv, *c, *c_ctx, *ada_w, *ada_b, *w_in, *rw_conv, *rw_w0, *rw_w2,
        *rw_a0, *rw_a2, *rw_g2, *rw_kk, *rw_ka, *rw_rk, *rw_gn_g, *rw_gn_b, *q_norm, *q_up, *kv_norm, *kv_up, *gm_g, *gm_b, *gm_ws, *gm_bs,
        *w_out, *ln1_g, *ln1_b, *ffn_in, *ffn_out, *ln2_g, *ln2_b;
    float* out;
    unsigned* bar; int* ctr; float* mod; float* ropeC; float* ropeS; bf16_t* CkvB;
    bf16_t *WtIn, *WtQ, *WtKVn, *WtKV, *WtOut, *WtF1, *WtF2, *WsB, *W2t, *A2t, *G2t;
    bf16_t *Z, *RKV, *Ee, *Aa, *Gg, *Qb, *Kb, *Kc, *Vt, *Vtc, *hbmix, *hidden;
    float* ydir;
};


struct Args { const float* in[36]; float* out; char* ws; };
typedef const __attribute__((address_space(4))) char* kargp_t;
constexpr size_t al256(size_t x) { return (x + 255) & ~(size_t)255; }
constexpr size_t OFF_BAR = 0;
constexpr size_t OFF_CTR = OFF_BAR + 16384;
constexpr size_t OFF_MOD = OFF_CTR + 4096;
constexpr size_t OFF_ROPEC = OFF_MOD + al256((size_t)4 * 5 * 6144 * 4);
constexpr size_t OFF_ROPES = OFF_ROPEC + 65536 * 4;
constexpr size_t OFF_CKVB = OFF_ROPES + 65536 * 4;
constexpr size_t OFF_WTIN = OFF_CKVB + (size_t)4 * 2048 * 128 * 2;
constexpr size_t OFF_WTQ = OFF_WTIN + (size_t)2176 * 1024 * 2;
constexpr size_t OFF_WTKVN = OFF_WTQ + (size_t)768 * 256 * 2;
constexpr size_t OFF_WTKV = OFF_WTKVN + (size_t)1024 * 128 * 2;
constexpr size_t OFF_WTOUT = OFF_WTKV + (size_t)1024 * 128 * 2;
constexpr size_t OFF_WTF1 = OFF_WTOUT + (size_t)1024 * 1024 * 2;
constexpr size_t OFF_WTF2 = OFF_WTF1 + (size_t)5632 * 1024 * 2;
constexpr size_t OFF_WSB = OFF_WTF2 + (size_t)1024 * DFF * 2;
constexpr size_t OFF_W2T = OFF_WSB + (size_t)65536 * 2;
constexpr size_t OFF_A2T = OFF_W2T + (size_t)2 * 256 * 64 * 2;
constexpr size_t OFF_G2T = OFF_A2T + (size_t)2 * 256 * 64 * 2;
constexpr size_t OFF_Z = OFF_G2T + (size_t)256 * 128 * 2;
constexpr size_t OFF_HIDDEN = OFF_Z;
constexpr size_t OFF_RKV = OFF_Z + al256((size_t)M_ALL * NIN * 2);
constexpr size_t OFF_EE = OFF_RKV + (size_t)M_ALL * 768 * 2;
constexpr size_t OFF_AA = OFF_EE + (size_t)2 * M_ALL * 256 * 2;
constexpr size_t OFF_GG = OFF_AA + (size_t)2 * M_ALL * 256 * 2;
constexpr size_t OFF_QB = OFF_GG + (size_t)M_ALL * 256 * 2;
constexpr size_t OFF_KB = OFF_QB + (size_t)M_ALL * 768 * 2;
constexpr size_t OFF_KC = OFF_KB + (size_t)M_ALL * 768 * 2;
constexpr size_t OFF_VT = OFF_KC + (size_t)2048 * 768 * 2;
constexpr size_t OFF_VTC = OFF_VT + (size_t)M_ALL * 512 * 2;
constexpr size_t OFF_YDIR = OFF_VTC + (size_t)2048 * 512 * 2;
constexpr size_t OFF_HBMIX = OFF_YDIR + (size_t)2 * M_ALL * 256 * 4;
constexpr size_t WS_TOTAL = OFF_HBMIX + (size_t)M_ALL * DM * 2;
static_assert(OFF_RKV + (size_t)M_ALL * 768 * 2 - OFF_HIDDEN >= (size_t)M_ALL * DFF * 2, "hidden overlay");

__device__ __forceinline__ P getP(kargp_t& kp) {
    asm volatile("" : "+s"(kp));
    typedef const float* const __attribute__((address_space(4)))* inp_t;
    inp_t in = (inp_t)kp;
    P p;
    p.x_prompt = in[0]; p.x_sample = in[1]; p.cache_ckv = in[2]; p.cache_krope = in[3]; p.state_rwkv = in[4]; p.c = in[5]; p.c_ctx = in[6];
    p.ada_w = in[7]; p.ada_b = in[8]; p.w_in = in[9]; p.rw_conv = in[10]; p.rw_w0 = in[11]; p.rw_w2 = in[12]; p.rw_a0 = in[13]; p.rw_a2 = in[14];
    p.rw_g2 = in[15]; p.rw_kk = in[16]; p.rw_ka = in[17]; p.rw_rk = in[18]; p.rw_gn_g = in[19]; p.rw_gn_b = in[20]; p.q_norm = in[21]; p.q_up = in[22];
    p.kv_norm = in[23]; p.kv_up = in[24]; p.gm_g = in[25]; p.gm_b = in[26]; p.gm_ws = in[27]; p.gm_bs = in[28]; p.w_out = in[29]; p.ln1_g = in[30];
    p.ln1_b = in[31]; p.ffn_in = in[32]; p.ffn_out = in[33]; p.ln2_g = in[34]; p.ln2_b = in[35];
    p.out = (float*)in[36]; char* ws = (char*)in[37];
    p.bar = (unsigned*)(ws + OFF_BAR); p.ctr = (int*)(ws + OFF_CTR); p.mod = (float*)(ws + OFF_MOD); p.ropeC = (float*)(ws + OFF_ROPEC); p.ropeS = (float*)(ws + OFF_ROPES);
    p.CkvB = (bf16_t*)(ws + OFF_CKVB); p.WtIn = (bf16_t*)(ws + OFF_WTIN); p.WtQ = (bf16_t*)(ws + OFF_WTQ); p.WtKVn = (bf16_t*)(ws + OFF_WTKVN); p.WtKV = (bf16_t*)(ws + OFF_WTKV);
    p.WtOut = (bf16_t*)(ws + OFF_WTOUT); p.WtF1 = (bf16_t*)(ws + OFF_WTF1); p.WtF2 = (bf16_t*)(ws + OFF_WTF2); p.WsB = (bf16_t*)(ws + OFF_WSB); p.W2t = (bf16_t*)(ws + OFF_W2T);
    p.A2t = (bf16_t*)(ws + OFF_A2T); p.G2t = (bf16_t*)(ws + OFF_G2T); p.Z = (bf16_t*)(ws + OFF_Z); p.RKV = (bf16_t*)(ws + OFF_RKV); p.Ee = (bf16_t*)(ws + OFF_EE); p.Aa = (bf16_t*)(ws + OFF_AA);
    p.Gg = (bf16_t*)(ws + OFF_GG); p.Qb = (bf16_t*)(ws + OFF_QB); p.Kb = (bf16_t*)(ws + OFF_KB); p.Kc = (bf16_t*)(ws + OFF_KC); p.Vt = (bf16_t*)(ws + OFF_VT); p.Vtc = (bf16_t*)(ws + OFF_VTC);
    p.hbmix = (bf16_t*)(ws + OFF_HBMIX); p.hidden = (bf16_t*)(ws + OFF_HIDDEN); p.ydir = (float*)(ws + OFF_YDIR);
    return p;
}

__device__ __forceinline__ float bf2f(bf16_t b) { return __uint_as_float(((unsigned)b) << 16); }
__device__ __forceinline__ unsigned pack2(float lo, float hi) { unsigned r; asm("v_cvt_pk_bf16_f32 %0, %1, %2" : "=v"(r) : "v"(lo), "v"(hi)); return r; }
__device__ __forceinline__ bf16_t f2bf(float f) { return (bf16_t)(pack2(f, 0.f) & 0xffffu); }
__device__ __forceinline__ float lo_bf(unsigned w) { return __uint_as_float(w << 16); }
__device__ __forceinline__ float hi_bf(unsigned w) { return __uint_as_float(w & 0xffff0000u); }
__device__ __forceinline__ float sigmoidf_(float x) { return __builtin_amdgcn_rcpf(1.0f + __builtin_amdgcn_exp2f(-1.4426950408889634f * x)); }
__device__ __forceinline__ float tanhf_(float x) { float e = __builtin_amdgcn_exp2f(2.8853900817779268f * x); return 1.0f - 2.0f * __builtin_amdgcn_rcpf(e + 1.0f); }
__device__ __forceinline__ float geluf_(float x) { return 0.5f * x * (1.0f + tanhf_(0.7978845608028654f * (x + 0.044715f * x * x * x))); }
template <int CTRL> __device__ __forceinline__ float dpp_add(float x) {
    int y = __builtin_amdgcn_update_dpp(0, __float_as_int(x), CTRL, 0xf, 0xf, false);
    return x + __int_as_float(y);
}
__device__ __forceinline__ float red4(float x) { x = dpp_add<0xB1>(x); x = dpp_add<0x4E>(x); return x; }
__device__ __forceinline__ float red8(float x) { x = red4(x); x = dpp_add<0x141>(x); return x; }
__device__ __forceinline__ float red16(float x) { x = red8(x); x = dpp_add<0x140>(x); return x; }
__device__ __forceinline__ int opaque_tid() { int t = threadIdx.x; asm volatile("" : "+v"(t)); return t; }
__device__ __forceinline__ int modrow_of(int row) { return row < M_CTX ? 0 : 1 + ((row - M_CTX) >> 12); }

#define XB_TMO 128
#define XB_XCNT(j) (256 + 64 * (j))
#define XB_XSUB(j) (1280 + 64 * (j))
#define XB_XGEN(j) (2304 + 64 * (j))
#define XB_TOP 3328
#define XB_TOPGEN 3392
#define XCD_BAR_WORDS 3456
#define XB_SPIN_CAP (1u << 22)
__device__ __forceinline__ unsigned xb_ld(unsigned* p) { return __hip_atomic_load(p, __ATOMIC_RELAXED, __HIP_MEMORY_SCOPE_AGENT); }
__device__ __forceinline__ unsigned xb_add(unsigned* p, unsigned v) { return __hip_atomic_fetch_add(p, v, __ATOMIC_RELAXED, __HIP_MEMORY_SCOPE_AGENT); }
__device__ __forceinline__ unsigned xb_xcc_id() { return (unsigned)__builtin_amdgcn_s_getreg((3 << 11) | 20) & 0xFu; }
#define XB_SPIN(cond, bar) do { unsigned _sp = 0; while (cond) { __builtin_amdgcn_s_sleep(1); \
    if ((++_sp & 255u) == 0u) { if (xb_ld(&(bar)[XB_TMO])) break; if (_sp > XB_SPIN_CAP) { atomicAdd(&(bar)[XB_TMO], 1u); break; } } } } while (0)
struct XcdBarrier { unsigned* bar; unsigned x; volatile LAS unsigned* st; };
__device__ __forceinline__ XcdBarrier xcd_barrier_post(unsigned* bar, volatile LAS unsigned* st) {
    XcdBarrier b; b.bar = bar; b.x = xb_xcc_id(); b.st = st;
    if (threadIdx.x == 0) (void)xb_add(&bar[XB_XCNT(b.x)], 1u);
    return b;
}
__device__ __forceinline__ void xcd_barrier_complete(unsigned* bar, unsigned x, unsigned& nloc, unsigned& nx) {
    const unsigned G = gridDim.x * gridDim.y * gridDim.z;
    unsigned sum, cnt, mine, sp = 0u;
    for (;;) {
        sum = 0u; cnt = 0u; mine = 0u;
#pragma unroll
        for (unsigned j = 0; j < 16; ++j) { const unsigned c = xb_ld(&bar[XB_XCNT(j)]); sum += c; cnt += (c > 0u) ? 1u : 0u; mine = (j == x) ? c : mine; }
        if (sum == G) break;
        __builtin_amdgcn_s_sleep(1);
        if ((++sp & 255u) == 0u) { if (xb_ld(&bar[XB_TMO])) break; if (sp > XB_SPIN_CAP) { atomicAdd(&bar[XB_TMO], 1u); break; } }
    }
    nloc = mine > 0u ? mine : 1u; nx = cnt > 0u ? cnt : 1u;
}
__device__ __forceinline__ void xcd_barrier(const XcdBarrier& b) {
    asm volatile("s_waitcnt vmcnt(0)" ::: "memory");
    __syncthreads();
    if (threadIdx.x == 0) {
        unsigned* bar = b.bar;
        __builtin_amdgcn_s_waitcnt(0);
        unsigned nloc = b.st[0], nx = b.st[1];
        if (nloc == 0u) { xcd_barrier_complete(bar, b.x, nloc, nx); b.st[0] = nloc; b.st[1] = nx; }
        const unsigned old = xb_add(&bar[XB_XSUB(b.x)], 1u);
        const unsigned gen = old / nloc;
        if (old + 1u == (gen + 1u) * nloc) {
            __builtin_amdgcn_fence(__ATOMIC_RELEASE, "agent");
            asm volatile("s_waitcnt vmcnt(0)" ::: "memory");
            const unsigned og = xb_add(&bar[XB_TOP], 1u);
            const unsigned tg = og / nx;
            if (og + 1u == (tg + 1u) * nx) xb_add(&bar[XB_TOPGEN], 1u);
            else XB_SPIN(xb_ld(&bar[XB_TOPGEN]) == tg, bar);
            __builtin_amdgcn_fence(__ATOMIC_ACQUIRE, "agent");
            xb_add(&bar[XB_XGEN(b.x)], 1u);
            asm volatile("s_waitcnt vmcnt(0)" ::: "memory");
        } else {
            XB_SPIN(xb_ld(&bar[XB_XGEN(b.x)]) == gen, bar);
            __builtin_amdgcn_fence(__ATOMIC_ACQUIRE, "agent");
            asm volatile("s_waitcnt vmcnt(0)" ::: "memory");
        }
    }
    __syncthreads();
}

template <bool TR, class Epi>
__device__ __forceinline__ void gemm128(const bf16_t* __restrict__ A, int lda, const bf16_t* __restrict__ B, int ldb, int K, char* smem, const Epi& epi) {
    const int tid = opaque_tid(), lane = tid & 63, wid = tid >> 6, wr = wid >> 1, wc = wid & 1, fr = lane & 15, fq = lane >> 4;
    f32x4 acc[4][4];
#pragma unroll
    for (int m = 0; m < 4; ++m)
#pragma unroll
        for (int n = 0; n < 4; ++n) acc[m][n] = (f32x4){0.f, 0.f, 0.f, 0.f};
    const int crow = tid >> 3, ckc = tid & 7;
    const bf16_t* ap = A + (size_t)crow * lda + ckc * 8;
    const bf16_t* bp = B + (size_t)crow * ldb + ckc * 8;
    u32x4 ra[4], rb[4];
#pragma unroll
    for (int i = 0; i < 4; ++i) { ra[i] = *(const u32x4*)(ap + (size_t)(32 * i) * lda); rb[i] = *(const u32x4*)(bp + (size_t)(32 * i) * ldb); }
    {
        char* sa = smem; char* sb = smem + TILE_BYTES;
#pragma unroll
        for (int i = 0; i < 4; ++i) { *(u32x4*)(sa + ((crow + 32 * i) * LDS_STRIDE + ckc * 8) * 2) = ra[i]; *(u32x4*)(sb + ((crow + 32 * i) * LDS_STRIDE + ckc * 8) * 2) = rb[i]; }
    }
    __syncthreads();
    const int nk = K >> 6;
    for (int kt = 0; kt < nk; ++kt) {
        const bool more = (kt + 1 < nk);
        if (more) {
            const int k0 = (kt + 1) << 6;
#pragma unroll
            for (int i = 0; i < 4; ++i) { ra[i] = *(const u32x4*)(ap + (size_t)(32 * i) * lda + k0); rb[i] = *(const u32x4*)(bp + (size_t)(32 * i) * ldb + k0); }
        }
        const char* sa = smem + (kt & 1) * 2 * TILE_BYTES; const char* sb = sa + TILE_BYTES;
#pragma unroll
        for (int ks = 0; ks < 2; ++ks) {
            bf16x8 af[4], bfr[4];
#pragma unroll
            for (int m = 0; m < 4; ++m) af[m] = *(const bf16x8*)(sa + ((wr * 64 + m * 16 + fr) * LDS_STRIDE + ks * 32 + fq * 8) * 2);
#pragma unroll
            for (int n = 0; n < 4; ++n) bfr[n] = *(const bf16x8*)(sb + ((wc * 64 + n * 16 + fr) * LDS_STRIDE + ks * 32 + fq * 8) * 2);
            __builtin_amdgcn_s_setprio(1);
#pragma unroll
            for (int m = 0; m < 4; ++m)
#pragma unroll
                for (int n = 0; n < 4; ++n) acc[m][n] = TR ? __builtin_amdgcn_mfma_f32_16x16x32_bf16(bfr[n], af[m], acc[m][n], 0, 0, 0) : __builtin_amdgcn_mfma_f32_16x16x32_bf16(af[m], bfr[n], acc[m][n], 0, 0, 0);
            __builtin_amdgcn_s_setprio(0);
        }
        if (more) {
            char* da = smem + ((kt + 1) & 1) * 2 * TILE_BYTES; char* db = da + TILE_BYTES;
#pragma unroll
            for (int i = 0; i < 4; ++i) { *(u32x4*)(da + ((crow + 32 * i) * LDS_STRIDE + ckc * 8) * 2) = ra[i]; *(u32x4*)(db + ((crow + 32 * i) * LDS_STRIDE + ckc * 8) * 2) = rb[i]; }
        }
        __syncthreads();
    }
    epi(acc, wr * 64, wc * 64, fr, fq);
}


#define L2_STRIDE 40
#define A2_BYTES (256 * L2_STRIDE * 2)
#define B2_BYTES (128 * L2_STRIDE * 2)
#define ST2_BYTES (A2_BYTES + B2_BYTES)
template <class Epi>
__device__ __forceinline__ void gemm256(const bf16_t* __restrict__ A, int lda, const bf16_t* __restrict__ B, int ldb, int K, char* smem, const Epi& epi) {
    const int tid = opaque_tid(), lane = tid & 63, wid = tid >> 6, wr = wid >> 1, wc = wid & 1, fr = lane & 15, fq = lane >> 4;
    f32x4 acc[2][4][4];
#pragma unroll
    for (int hh = 0; hh < 2; ++hh)
#pragma unroll
        for (int m = 0; m < 4; ++m)
#pragma unroll
            for (int n = 0; n < 4; ++n) acc[hh][m][n] = (f32x4){0.f, 0.f, 0.f, 0.f};
    const int crow = tid >> 2, ckc = tid & 3;
    const bf16_t* ap = A + (size_t)crow * lda + ckc * 8;
    const bf16_t* bp = B + (size_t)crow * ldb + ckc * 8;
    u32x4 ra[4], rb[2];
#pragma unroll
    for (int i = 0; i < 4; ++i) ra[i] = *(const u32x4*)(ap + (size_t)(64 * i) * lda);
#pragma unroll
    for (int i = 0; i < 2; ++i) rb[i] = *(const u32x4*)(bp + (size_t)(64 * i) * ldb);
    {
        char* sa = smem; char* sb = smem + A2_BYTES;
#pragma unroll
        for (int i = 0; i < 4; ++i) *(u32x4*)(sa + ((crow + 64 * i) * L2_STRIDE + ckc * 8) * 2) = ra[i];
#pragma unroll
        for (int i = 0; i < 2; ++i) *(u32x4*)(sb + ((crow + 64 * i) * L2_STRIDE + ckc * 8) * 2) = rb[i];
    }
    __syncthreads();
    const int nk = K >> 5;
    for (int kt = 0; kt < nk; ++kt) {
        const bool more = (kt + 1 < nk);
        if (more) {
            const int k0 = (kt + 1) << 5;
#pragma unroll
            for (int i = 0; i < 4; ++i) ra[i] = *(const u32x4*)(ap + (size_t)(64 * i) * lda + k0);
#pragma unroll
            for (int i = 0; i < 2; ++i) rb[i] = *(const u32x4*)(bp + (size_t)(64 * i) * ldb + k0);
        }
        const char* sa = smem + (kt & 1) * ST2_BYTES; const char* sb = sa + A2_BYTES;
        bf16x8 bfr[4];
#pragma unroll
        for (int n = 0; n < 4; ++n) bfr[n] = *(const bf16x8*)(sb + ((wc * 64 + n * 16 + fr) * L2_STRIDE + fq * 8) * 2);
#pragma unroll
        for (int hh = 0; hh < 2; ++hh) {
            bf16x8 af[4];
#pragma unroll
            for (int m = 0; m < 4; ++m) af[m] = *(const bf16x8*)(sa + ((wr * 128 + hh * 64 + m * 16 + fr) * L2_STRIDE + fq * 8) * 2);
            __builtin_amdgcn_s_setprio(1);
#pragma unroll
            for (int m = 0; m < 4; ++m)
#pragma unroll
                for (int n = 0; n < 4; ++n) acc[hh][m][n] = __builtin_amdgcn_mfma_f32_16x16x32_bf16(bfr[n], af[m], acc[hh][m][n], 0, 0, 0);
            __builtin_amdgcn_s_setprio(0);
        }
        if (more) {
            char* da = smem + ((kt + 1) & 1) * ST2_BYTES; char* db = da + A2_BYTES;
#pragma unroll
            for (int i = 0; i < 4; ++i) *(u32x4*)(da + ((crow + 64 * i) * L2_STRIDE + ckc * 8) * 2) = ra[i];
#pragma unroll
            for (int i = 0; i < 2; ++i) *(u32x4*)(db + ((crow + 64 * i) * L2_STRIDE + ckc * 8) * 2) = rb[i];
        }
        __syncthreads();
    }
    epi(acc[0], wr * 128, wc * 64, fr, fq);
    epi(acc[1], wr * 128 + 64, wc * 64, fr, fq);
}

struct EpiZ {
    bf16_t* Z; int R0, C0;
    __device__ __forceinline__ void operator()(f32x4 (&acc)[4][4], int r0, int c0, int fr, int fq) const {
#pragma unroll
        for (int n = 0; n < 4; ++n) { const int col = C0 + c0 + n * 16 + fq * 4; if (col < NIN) {
#pragma unroll
            for (int m = 0; m < 4; ++m) { u32x2 w; w.x = pack2(acc[m][n][0], acc[m][n][1]); w.y = pack2(acc[m][n][2], acc[m][n][3]);
                *(u32x2*)(Z + (size_t)(R0 + r0 + m * 16 + fr) * NIN + col) = w; } } }
    }
};
struct EpiQ {
    bf16_t* Q; const float* rs; const float* ropeC; const float* ropeS; int R0, C0;
    __device__ __forceinline__ void operator()(f32x4 (&acc)[4][4], int r0, int c0, int fr, int fq) const {
        const bool lat = R0 >= M_CTX;
#pragma unroll
        for (int n = 0; n < 4; ++n) {
            const int cb = C0 + c0 + n * 16; const int hcs = cb % 96;
            if (lat && hcs == 80) continue;
            const bool rot = lat && hcs == 64;
#pragma unroll
            for (int m = 0; m < 4; ++m) {
                const int rl = r0 + m * 16 + fr; const int row = R0 + rl; const float sc = rs[rl] * QSCALE;
                const f32x4 x1 = acc[m][n] * sc; bf16_t* qp = Q + (size_t)row * 768 + cb + fq * 4;
                if (rot) {
                    const f32x4 x2 = acc[m][(n + 1) & 3] * sc; const int t = (row - M_CTX) & 4095;
                    const f32x4 cv = *(const f32x4*)(ropeC + t * 16 + fq * 4), sv = *(const f32x4*)(ropeS + t * 16 + fq * 4);
                    const f32x4 o1 = x1 * cv - x2 * sv, o2 = x1 * sv + x2 * cv;
                    u32x2 w; w.x = pack2(o1[0], o1[1]); w.y = pack2(o1[2], o1[3]); *(u32x2*)qp = w;
                    w.x = pack2(o2[0], o2[1]); w.y = pack2(o2[2], o2[3]); *(u32x2*)(qp + 16) = w;
                } else { u32x2 w; w.x = pack2(x1[0], x1[1]); w.y = pack2(x1[2], x1[3]); *(u32x2*)qp = w; }
            }
        }
    }
};
struct EpiKN {
    bf16_t* Kd; const float* rs; int R0, C0;
    __device__ __forceinline__ void operator()(f32x4 (&acc)[4][4], int r0, int c0, int fr, int fq) const {
#pragma unroll
        for (int n = 0; n < 4; ++n) { const int col = C0 + c0 + n * 16 + fq * 4; const int h = col >> 6, d = col & 63;
#pragma unroll
            for (int m = 0; m < 4; ++m) { const int rl = r0 + m * 16 + fr; const f32x4 v = acc[m][n] * (rs ? rs[rl] : 1.0f);
                u32x2 w; w.x = pack2(v[0], v[1]); w.y = pack2(v[2], v[3]); *(u32x2*)(Kd + (size_t)(R0 + rl) * 768 + h * 96 + d) = w; } }
    }
};
struct EpiKV {
    bf16_t* Kd; bf16_t* Vd; const float* rs; int R0, C0; int seqshift; size_t vbase0;
    __device__ __forceinline__ void operator()(f32x4 (&acc)[4][4], int r0, int c0, int fr, int fq) const {
#pragma unroll
        for (int n = 0; n < 4; ++n) {
            const int col = C0 + c0 + n * 16 + fr;
#pragma unroll
            for (int m = 0; m < 4; ++m) {
                const int rl = r0 + m * 16 + fq * 4; const int row = R0 + rl;
                float v[4];
#pragma unroll
                for (int j = 0; j < 4; ++j) v[j] = acc[m][n][j] * (rs ? rs[rl + j] : 1.0f);
                if (col < 512) {
                    const int h = col >> 6, d = col & 63;
#pragma unroll
                    for (int j = 0; j < 4; ++j) Kd[(size_t)(row + j) * 768 + h * 96 + d] = f2bf(v[j]);
                } else {
                    const int vc = col - 512, h = vc >> 6, dv = vc & 63; const int b = row >> seqshift, t = row & ((1 << seqshift) - 1);
                    u32x2 w; w.x = pack2(v[0], v[1]); w.y = pack2(v[2], v[3]);
                    *(u32x2*)(Vd + vbase0 + ((size_t)((b * 8 + h) * 64 + dv) << seqshift) + t) = w;
                }
            }
        }
    }
};
struct EpiRes {
    float* X; const float* gate; int R0, C0;
    __device__ __forceinline__ void operator()(f32x4 (&acc)[4][4], int r0, int c0, int fr, int fq) const {
#pragma unroll
        for (int n = 0; n < 4; ++n) { const int col = C0 + c0 + n * 16 + fq * 4; const f32x4 g = *(const f32x4*)(gate + col);
#pragma unroll
            for (int m = 0; m < 4; ++m) { float* px = X + (size_t)(R0 + r0 + m * 16 + fr) * DM + col; const f32x4 xv = *(const f32x4*)px; *(f32x4*)px = ALPHA_F * xv + g * acc[m][n]; } }
    }
};
struct EpiSwi {
    bf16_t* H; int R0, C0;
    __device__ __forceinline__ void operator()(f32x4 (&acc)[4][4], int r0, int c0, int fr, int fq) const {
        const int hb = ((C0 + c0) >> 1) + fq * 4;
#pragma unroll
        for (int n = 0; n < 2; ++n)
#pragma unroll
            for (int m = 0; m < 4; ++m) { float o[4];
#pragma unroll
                for (int j = 0; j < 4; ++j) { const float g = acc[m][n][j], u = acc[m][n + 2][j]; o[j] = g * sigmoidf_(g) * u; }
                u32x2 w; w.x = pack2(o[0], o[1]); w.y = pack2(o[2], o[3]);
                *(u32x2*)(H + (size_t)(R0 + r0 + m * 16 + fr) * DFF + hb + n * 16) = w; }
    }
};

__device__ __forceinline__ void ada_unit(const P& p, int u, char* smem) {
    const int tid = opaque_tid(); const int l = u / 96, c0 = (u % 96) * 64;
    float* cs = (float*)smem;
    for (int i = tid; i < 5 * 1024; i += 256) { const int r = i >> 10, k = i & 1023; const float v = (r == 0) ? p.c_ctx[k] : p.c[(r - 1) * 1024 + k]; cs[i] = v * sigmoidf_(v); }
    __syncthreads();
    const int col = tid & 63, kq = tid >> 6;
    float s0 = 0.f, s1 = 0.f, s2 = 0.f, s3 = 0.f, s4 = 0.f;
    const float* w = p.ada_w + ((size_t)l * 1024 + kq * 256) * 6144 + c0 + col;
    const float* cq = cs + kq * 256;
    for (int k = 0; k < 256; ++k) { const float wv = w[(size_t)k * 6144]; s0 += cq[k] * wv; s1 += cq[1024 + k] * wv; s2 += cq[2048 + k] * wv; s3 += cq[3072 + k] * wv; s4 += cq[4096 + k] * wv; }
    float* red = cs + 5 * 1024;
    red[(kq * 5 + 0) * 64 + col] = s0; red[(kq * 5 + 1) * 64 + col] = s1; red[(kq * 5 + 2) * 64 + col] = s2; red[(kq * 5 + 3) * 64 + col] = s3; red[(kq * 5 + 4) * 64 + col] = s4;
    __syncthreads();
    for (int o = tid; o < 320; o += 256) { const int i = o >> 6, cc = o & 63;
        const float v = red[(0 * 5 + i) * 64 + cc] + red[(1 * 5 + i) * 64 + cc] + red[(2 * 5 + i) * 64 + cc] + red[(3 * 5 + i) * 64 + cc] + p.ada_b[l * 6144 + c0 + cc];
        p.mod[((size_t)l * 5 + i) * 6144 + c0 + cc] = v; }
    __syncthreads();
}
__device__ __forceinline__ int map_col(int kind, int n) {
    if (kind == 1) { const int blk = n >> 6, r = n & 63; return r < 32 ? blk * 32 + r : DFF + blk * 32 + (r - 32); }
    if (kind == 2) { if (n < 512) return (n >> 6) * 128 + (n & 63); const int vc = n - 512; return (vc >> 6) * 128 + 64 + (vc & 63); }
    return n;
}
__device__ __forceinline__ void conv_tile(const float* src, int ldsrc, bf16_t* dst, bf16_t* dst2, int Kdst, int n0, int k0, int kind, int Nvalid, const float* kscale, char* smem) {
    const int tid = opaque_tid(); float* tile = (float*)smem;
    { const int j = tid & 63, i0 = tid >> 6; const int n = n0 + j; const int sc = (n < Nvalid) ? map_col(kind, n) : -1;
#pragma unroll 4
      for (int ii = 0; ii < 16; ++ii) { const int i = i0 + 4 * ii; tile[i * 65 + j] = (sc >= 0) ? src[(size_t)(k0 + i) * ldsrc + sc] : 0.f; } }
    __syncthreads();
    { const int i = tid & 63, j0 = tid >> 6; const float ks = kscale ? kscale[k0 + i] : 1.f;
#pragma unroll 4
      for (int jj = 0; jj < 16; ++jj) { const int jx = j0 + 4 * jj; const float v = tile[i * 65 + jx];
          dst[(size_t)(n0 + jx) * Kdst + k0 + i] = f2bf(v * ks); if (dst2) dst2[(size_t)(n0 + jx) * Kdst + k0 + i] = f2bf(v); } }
    __syncthreads();
}
#define NCONV 3032
__device__ __forceinline__ void conv_unit(const P& p, int l, int u, char* smem) {
    const float* src; int ldsrc; bf16_t* dst; bf16_t* dst2 = nullptr; int Kdst, n0, k0, kind = 0, Nvalid; const float* kscale = nullptr;
    if (u < 544) { src = p.w_in + (size_t)l * 1024 * NIN; ldsrc = NIN; dst = p.WtIn; Kdst = 1024; n0 = (u / 16) * 64; k0 = (u % 16) * 64; Nvalid = NIN; }
    else if (u < 592) { u -= 544; src = p.q_up + (size_t)l * 256 * 768; ldsrc = 768; dst = p.WtQ; Kdst = 256; n0 = (u / 4) * 64; k0 = (u % 4) * 64; Nvalid = 768; kscale = p.q_norm + l * 256; }
    else if (u < 624) { u -= 592; src = p.kv_up + (size_t)l * 128 * 1024; ldsrc = 1024; dst = p.WtKVn; dst2 = p.WtKV; Kdst = 128; n0 = (u / 2) * 64; k0 = (u % 2) * 64; kind = 2; Nvalid = 1024; kscale = p.kv_norm + l * 128; }
    else if (u < 880) { u -= 624; src = p.w_out + (size_t)l * 1024 * 1024; ldsrc = 1024; dst = p.WtOut; Kdst = 1024; n0 = (u / 16) * 64; k0 = (u % 16) * 64; Nvalid = 1024; }
    else if (u < 2288) { u -= 880; src = p.ffn_in + (size_t)l * 1024 * 5632; ldsrc = 5632; dst = p.WtF1; Kdst = 1024; n0 = (u / 16) * 64; k0 = (u % 16) * 64; kind = 1; Nvalid = 5632; }
    else if (u < 2992) { u -= 2288; src = p.ffn_out + (size_t)l * DFF * 1024; ldsrc = 1024; dst = p.WtF2; Kdst = DFF; n0 = (u / 44) * 64; k0 = (u % 44) * 64; Nvalid = 1024; }
    else if (u < 3008) { u -= 2992; const float* sp = p.gm_ws + (size_t)l * 65536 + u * 4096; bf16_t* d = p.WsB + u * 4096; for (int i = threadIdx.x; i < 4096; i += 256) d[i] = f2bf(sp[i]); return; }
    else if (u < 3016) { u -= 3008; const int d = u >> 2; src = p.rw_w2 + ((size_t)l * 2 + d) * 64 * 256; ldsrc = 256; dst = p.W2t + d * 256 * 64; Kdst = 64; n0 = (u & 3) * 64; k0 = 0; Nvalid = 256; }
    else if (u < 3024) { u -= 3016; const int d = u >> 2; src = p.rw_a2 + ((size_t)l * 2 + d) * 64 * 256; ldsrc = 256; dst = p.A2t + d * 256 * 64; Kdst = 64; n0 = (u & 3) * 64; k0 = 0; Nvalid = 256; }
    else { u -= 3024; src = p.rw_g2 + (size_t)l * 128 * 256; ldsrc = 256; dst = p.G2t; Kdst = 128; n0 = (u / 2) * 64; k0 = (u % 2) * 64; Nvalid = 256; }
    conv_tile(src, ldsrc, dst, dst2, Kdst, n0, k0, kind, Nvalid, kscale, smem);
}
__device__ __forceinline__ void misc0_unit(const P& p, int u) {
    const int tid = opaque_tid();
    if (u < 16) {
        for (int e = tid; e < 4096; e += 256) { const int idx = u * 4096 + e; const int t = idx >> 4, i = idx & 15;
            const float pos = (float)((i < 8) ? (t >> 6) : (t & 63)); const float inv = exp2f(-(float)(i & 7) * 1.6609640474436813f);
            const float ang = pos * inv; const float kf = rintf(ang * 0.15915494309189535f);
            float r = fmaf(-kf, 6.28318548202514648f, ang); r = fmaf(-kf, -1.74845553e-7f, r);
            p.ropeC[idx] = __cosf(r); p.ropeS[idx] = __sinf(r); }
    } else {
        const int v = u - 16;
        for (int e = tid; e < 4096; e += 256) { const int idx = v * 4096 + e;
            const int c = idx & 127, t = (idx >> 7) & 511, b = (idx >> 16) & 3, l = idx >> 18;
            p.CkvB[idx] = f2bf(p.cache_ckv[(((size_t)b * 4 + l) * 512 + t) * 128 + c]); }
    }
}

__device__ __forceinline__ void ln_phase(const P& p, int l, int which) {
    const int tid = opaque_tid(), lane = tid & 63, wid = tid >> 6;
    const float* g = which == 1 ? p.ln1_g + l * DM : p.ln2_g + l * DM; const float* bb = which == 1 ? p.ln1_b + l * DM : p.ln2_b + l * DM;
    const int ml = which == 2 ? l + 1 : l; const int shoff = which == 1 ? 3072 : 0, scoff = which == 1 ? 4096 : 1024;
    const bool dohb = !(which == 2 && l == 3);
    for (int row = blockIdx.x * 4 + wid; row < M_ALL; row += gridDim.x * 4) {
        float* xr = p.out + (size_t)row * DM;
        const float* src = which == 0 ? (row < M_CTX ? p.x_prompt + (size_t)row * DM : p.x_sample + (size_t)(row - M_CTX) * DM) : xr;
        f32x4 v[4];
#pragma unroll
        for (int i = 0; i < 4; ++i) v[i] = *(const f32x4*)(src + lane * 4 + 256 * i);
        if (which != 0) {
            float s = 0.f;
#pragma unroll
            for (int i = 0; i < 4; ++i) s += (v[i][0] + v[i][1]) + (v[i][2] + v[i][3]);
            s = red16(s); s += __shfl_xor(s, 16); s += __shfl_xor(s, 32);
            const float mu = s * (1.0f / 1024.0f); float q = 0.f;
#pragma unroll
            for (int i = 0; i < 4; ++i) { const f32x4 d = v[i] - mu; q += (d[0] * d[0] + d[1] * d[1]) + (d[2] * d[2] + d[3] * d[3]); }
            q = red16(q); q += __shfl_xor(q, 16); q += __shfl_xor(q, 32);
            const float rstd = rsqrtf(q * (1.0f / 1024.0f) + 1e-5f);
#pragma unroll
            for (int i = 0; i < 4; ++i) { const f32x4 gg = *(const f32x4*)(g + lane * 4 + 256 * i), bv = *(const f32x4*)(bb + lane * 4 + 256 * i); v[i] = (v[i] - mu) * rstd * gg + bv; }
        }
#pragma unroll
        for (int i = 0; i < 4; ++i) *(f32x4*)(xr + lane * 4 + 256 * i) = v[i];
        if (dohb) {
            const float* md = p.mod + ((size_t)ml * 5 + modrow_of(row)) * 6144;
#pragma unroll
            for (int i = 0; i < 4; ++i) { const f32x4 sh = *(const f32x4*)(md + shoff + lane * 4 + 256 * i), sc = *(const f32x4*)(md + scoff + lane * 4 + 256 * i);
                const f32x4 h = v[i] * (1.0f + sc) + sh; u32x2 w; w.x = pack2(h[0], h[1]); w.y = pack2(h[2], h[3]);
                *(u32x2*)(p.hbmix + (size_t)row * DM + lane * 4 + 256 * i) = w; }
        }
    }
}

__device__ __forceinline__ void rwprep_unit(const P& p, int l, int u, char* smem) {
    const int tid = opaque_tid(), lane = tid & 63, wid = tid >> 6, fr = lane & 15, fq = lane >> 4;
    const int R0 = u * 64;
    const int ss = R0 < M_CTX ? (R0 & ~255) : M_CTX + ((R0 - M_CTX) & ~4095); const int se = ss + (R0 < M_CTX ? 256 : 4096);
    bf16_t* XW = (bf16_t*)smem; bf16_t* XA = XW + 64 * 136; bf16_t* XG = XA + 64 * 136;
    const float* cw = p.rw_conv + (size_t)l * 3 * 1152;
    for (int it = tid; it < 1152; it += 256) {
        const int cc = it % 144, tg = it / 144; const int c = cc * 8;
        float w0[8], w1[8], w2[8];
#pragma unroll
        for (int i = 0; i < 8; ++i) { w0[i] = cw[c + i]; w1[i] = cw[1152 + c + i]; w2[i] = cw[2304 + c + i]; }
        const int rfirst = R0 + tg * 8;
        u32x4 rows[10];
#pragma unroll
        for (int i = 0; i < 10; ++i) { const int r = rfirst - 1 + i; rows[i] = (u32x4){0u, 0u, 0u, 0u};
            if (r >= ss && r < se) rows[i] = *(const u32x4*)(p.Z + (size_t)r * NIN + c); }
#pragma unroll
        for (int tt = 0; tt < 8; ++tt) {
            const int row = rfirst + tt;
            const u32x4 prev = rows[tt], cur = rows[tt + 1], nxt = rows[tt + 2];
            float o[8];
#pragma unroll
            for (int i = 0; i < 4; ++i) {
                o[2 * i] = w0[2 * i] * lo_bf(prev[i]) + w1[2 * i] * lo_bf(cur[i]) + w2[2 * i] * lo_bf(nxt[i]);
                o[2 * i + 1] = w0[2 * i + 1] * hi_bf(prev[i]) + w1[2 * i + 1] * hi_bf(cur[i]) + w2[2 * i + 1] * hi_bf(nxt[i]);
            }
            if (c >= 768 && c < 896) {
#pragma unroll
                for (int i = 0; i < 8; ++i) o[i] = tanhf_(o[i]);
            } else if (c >= 1024) {
#pragma unroll
                for (int i = 0; i < 8; ++i) o[i] = sigmoidf_(o[i]);
            }
            u32x4 w; w.x = pack2(o[0], o[1]); w.y = pack2(o[2], o[3]); w.z = pack2(o[4], o[5]); w.w = pack2(o[6], o[7]);
            const int tl = tg * 8 + tt;
            if (c < 768) *(u32x4*)(p.RKV + (size_t)row * 768 + c) = w;
            else if (c < 896) *(u32x4*)(XW + tl * 136 + (c - 768)) = w;
            else if (c < 1024) *(u32x4*)(XA + tl * 136 + (c - 896)) = w;
            else *(u32x4*)(XG + tl * 136 + (c - 1024)) = w;
        }
    }
    __syncthreads();
#pragma unroll 1
    for (int mh = 0; mh < 10; ++mh) {
        const int mat = mh >> 1, nh = mh & 1;
        const int d = mat & 1; const bf16_t* As; const bf16_t* Bw; int kofs, nks, ldw;
        if (mat < 2) { As = XW; Bw = p.W2t + d * 256 * 64; kofs = d * 64; nks = 2; ldw = 64; }
        else if (mat < 4) { As = XA; Bw = p.A2t + d * 256 * 64; kofs = d * 64; nks = 2; ldw = 64; }
        else { As = XG; Bw = p.G2t; kofs = 0; nks = 4; ldw = 128; }
        f32x4 acc[4][2];
#pragma unroll
        for (int m = 0; m < 4; ++m)
#pragma unroll
            for (int n = 0; n < 2; ++n) acc[m][n] = (f32x4){0.f, 0.f, 0.f, 0.f};
        bf16x8 bw[4][2];
#pragma unroll
        for (int ks = 0; ks < 4; ++ks)
#pragma unroll
            for (int n = 0; n < 2; ++n) bw[ks][n] = *(const bf16x8*)(Bw + (size_t)(wid * 64 + nh * 32 + n * 16 + fr) * ldw + (ks < nks ? ks : 0) * 32 + fq * 8);
#pragma unroll
        for (int ks = 0; ks < 4; ++ks) {
            if (ks < nks) {
                bf16x8 af[4];
#pragma unroll
                for (int m = 0; m < 4; ++m) af[m] = *(const bf16x8*)(As + (m * 16 + fr) * 136 + kofs + ks * 32 + fq * 8);
#pragma unroll
                for (int m = 0; m < 4; ++m)
#pragma unroll
                    for (int n = 0; n < 2; ++n) acc[m][n] = __builtin_amdgcn_mfma_f32_16x16x32_bf16(bw[ks][n], af[m], acc[m][n], 0, 0, 0);
            }
        }
#pragma unroll
        for (int n = 0; n < 2; ++n) {
            const int c = wid * 64 + nh * 32 + n * 16 + fq * 4;
            f32x4 bias = (f32x4){0.f, 0.f, 0.f, 0.f}; if (mat < 2) bias = *(const f32x4*)(p.rw_w0 + (l * 2 + d) * 256 + c); else if (mat < 4) bias = *(const f32x4*)(p.rw_a0 + (l * 2 + d) * 256 + c);
            bf16_t* dst; float mul;
            if (mat < 2) { dst = p.Ee + ((size_t)d * M_ALL + R0) * 256 + c; mul = 0.6065306597126334f; }
            else if (mat < 4) { dst = p.Aa + ((size_t)d * M_ALL + R0) * 256 + c; mul = 1.0f; }
            else { dst = p.Gg + (size_t)R0 * 256 + c; mul = 1.0f; }
#pragma unroll
            for (int m = 0; m < 4; ++m) {
                float o[4];
#pragma unroll
                for (int j = 0; j < 4; ++j) { const float x = acc[m][n][j] + bias[j]; o[j] = mat < 4 ? mul * sigmoidf_(x) : x; }
                u32x2 w; w.x = pack2(o[0], o[1]); w.y = pack2(o[2], o[3]);
                *(u32x2*)(dst + (size_t)(m * 16 + fr) * 256) = w;
            }
        }
    }
    __syncthreads();
}
__device__ __forceinline__ void rowscale128(const bf16_t* Z, int R0, int zoff, int ncols, float eps, float* rs) {
    const int tid = opaque_tid(); const int r = tid >> 1, half = tid & 1; const int per = ncols >> 1;
    const bf16_t* zp = Z + (size_t)(R0 + r) * NIN + zoff + half * per;
    float ss = 0.f;
    for (int i = 0; i < per; i += 8) { const u32x4 w = *(const u32x4*)(zp + i);
#pragma unroll
        for (int q = 0; q < 4; ++q) { const float a = lo_bf(w[q]), b = hi_bf(w[q]); ss += a * a + b * b; } }
    ss = dpp_add<0xB1>(ss);
    if (half == 0) rs[r] = rsqrtf(ss / (float)ncols + eps);
}
__device__ __forceinline__ void small_unit(const P& p, int l, int u) {
    const int tid = opaque_tid(), sub = tid >> 5, li = tid & 31;
    if (u < 2560) {
        const int row = u * 8 + sub; const bf16_t* zr = p.Z + (size_t)row * NIN;
        const u32x2 w = *(const u32x2*)(zr + ZKV + li * 4);
        const float z0 = lo_bf(w.x), z1 = hi_bf(w.x), z2 = lo_bf(w.y), z3 = hi_bf(w.y);
        float ss = z0 * z0 + z1 * z1 + z2 * z2 + z3 * z3; ss = red16(ss); ss += __shfl_xor(ss, 16);
        const float rsv = rsqrtf(ss * (1.0f / 128.0f) + 1e-6f);
        const float x1 = bf2f(zr[ZKR + (li & 15)]), x2 = bf2f(zr[ZKR + 16 + (li & 15)]);
        float val;
        if (row < M_CTX) {
            const int b = row >> 8, t = row & 255; const size_t o = ((size_t)(b * 4 + l) * 256 + t);
            const f32x4 g = *(const f32x4*)(p.kv_norm + l * 128 + li * 4);
            *(f32x4*)(p.out + 20971520 + o * 128 + li * 4) = (f32x4){z0 * rsv * g[0], z1 * rsv * g[1], z2 * rsv * g[2], z3 * rsv * g[3]};
            val = li < 16 ? x1 : x2;
            p.out[20971520 + 2097152 + o * 32 + li] = val;
        } else {
            const int t = (row - M_CTX) & 4095; const float cv = p.ropeC[t * 16 + (li & 15)], sv = p.ropeS[t * 16 + (li & 15)];
            val = li < 16 ? x1 * cv - x2 * sv : x1 * sv + x2 * cv;
        }
        const bf16_t bv = f2bf(val);
#pragma unroll
        for (int h = 0; h < 8; ++h) p.Kb[(size_t)row * 768 + h * 96 + 64 + li] = bv;
    } else {
        const int r = (u - 2560) * 8 + sub; const int b = r >> 9, t = r & 511;
        const bf16_t bv = f2bf(p.cache_krope[((size_t)(b * 4 + l) * 512 + t) * 32 + li]);
#pragma unroll
        for (int h = 0; h < 8; ++h) p.Kc[(size_t)r * 768 + h * 96 + 64 + li] = bv;
    }
}
__device__ __forceinline__ void gmlp_unit(const P& p, int l, int u, char* smem) {
    const int tid = opaque_tid(), lane = tid & 63, wid = tid >> 6, fr = lane & 15, fq = lane >> 4;
    const int R0 = (u >> 2) * 128, g = u & 3;
    bf16_t* VnT = (bf16_t*)smem;
    bf16x8 wsf[4][2];
    { const bf16_t* Wg0 = p.WsB + g * 128 * 128;
#pragma unroll
      for (int ks = 0; ks < 4; ++ks)
#pragma unroll
        for (int m = 0; m < 2; ++m) wsf[ks][m] = *(const bf16x8*)(Wg0 + (wid * 32 + m * 16 + fr) * 128 + ks * 32 + fq * 8); }
    {
        const int tok = tid >> 1, half = tid & 1; const bf16_t* zp = p.Z + (size_t)(R0 + tok) * NIN + ZV + g * 64 + half * 32;
        float x[32];
#pragma unroll
        for (int i = 0; i < 4; ++i) { const u32x4 w = *(const u32x4*)(zp + i * 8);
#pragma unroll
            for (int q = 0; q < 4; ++q) { x[i * 8 + 2 * q] = geluf_(lo_bf(w[q])); x[i * 8 + 2 * q + 1] = geluf_(hi_bf(w[q])); } }
        float s = 0.f;
#pragma unroll
        for (int i = 0; i < 32; ++i) s += x[i];
        s = dpp_add<0xB1>(s); const float mu = s * (1.0f / 64.0f);
        float q2 = 0.f;
#pragma unroll
        for (int i = 0; i < 32; ++i) { const float d = x[i] - mu; q2 += d * d; }
        q2 = dpp_add<0xB1>(q2); const float rstd = rsqrtf(q2 * (1.0f / 64.0f) + 1e-5f);
        const float* gg = p.gm_g + l * 256 + g * 64 + half * 32; const float* gb = p.gm_b + l * 256 + g * 64 + half * 32;
#pragma unroll
        for (int i = 0; i < 32; ++i) VnT[(half * 32 + i) * 136 + tok] = f2bf((x[i] - mu) * rstd * gg[i] + gb[i]);
    }
    __syncthreads();
    f32x4 acc[2][4];
#pragma unroll
    for (int m = 0; m < 2; ++m)
#pragma unroll
        for (int n = 0; n < 4; ++n) acc[m][n] = (f32x4){0.f, 0.f, 0.f, 0.f};
#pragma unroll
    for (int ks = 0; ks < 4; ++ks) {
        bf16x8 bfr[4];
#pragma unroll
        for (int n = 0; n < 4; ++n) bfr[n] = *(const bf16x8*)(VnT + (n * 16 + fr) * 136 + ks * 32 + fq * 8);
#pragma unroll
        for (int m = 0; m < 2; ++m)
#pragma unroll
            for (int n = 0; n < 4; ++n) acc[m][n] = __builtin_amdgcn_mfma_f32_16x16x32_bf16(bfr[n], wsf[ks][m], acc[m][n], 0, 0, 0);
    }
#pragma unroll
    for (int m = 0; m < 2; ++m) {
        const int pp = wid * 32 + m * 16 + fr; const float bs = p.gm_bs[l * 512 + g * 128 + pp];
#pragma unroll
        for (int n = 0; n < 4; ++n) { const int c = n * 16 + fq * 4;
            const u32x2 zw = *(const u32x2*)(p.Z + (size_t)(R0 + pp) * NIN + ZU + g * 64 + c);
            const float u0 = geluf_(lo_bf(zw.x)), u1 = geluf_(hi_bf(zw.x)), u2 = geluf_(lo_bf(zw.y)), u3 = geluf_(hi_bf(zw.y));
            u32x2 w; w.x = pack2(u0 * (acc[m][n][0] + bs), u1 * (acc[m][n][1] + bs)); w.y = pack2(u2 * (acc[m][n][2] + bs), u3 * (acc[m][n][3] + bs));
            *(u32x2*)(p.hbmix + (size_t)(R0 + pp) * DM + 768 + g * 64 + c) = w; }
    }
    __syncthreads();
}

__device__ __forceinline__ float swap16_add(float x) {
    auto r = __builtin_amdgcn_permlane16_swap(__float_as_uint(x), __float_as_uint(x), false, false);
    return __uint_as_float(r[0]) + __uint_as_float(r[1]);
}
#define NSCAN_LAT 256
#define NSCAN (256 + 1024)
__device__ __forceinline__ void scan_unit(const P& p, int l, int u, char* smem) {
    const int tid = opaque_tid(), lane = tid & 63, wid = tid >> 6;
    int b, T, row0; const bool lat = u < NSCAN_LAT;
    if (lat) { b = u >> 6; T = 4096; row0 = M_CTX + b * 4096; } else { b = (u - NSCAN_LAT) >> 6; T = 256; row0 = b * 256; }
    const int h = (u >> 4) & 3, d = (u >> 3) & 1, rsl = u & 7;
    float* W = (float*)smem; float* NKK = W + 2048; float* KKA = NKK + 2048; float* KD = KKA + 2048; float* RR = KD + 2048; float* VS = RR + 2048; float* OUTP = VS + 256;
    const int rl = lane >> 5, kq = lane & 31; const int r8 = wid * 2 + rl; const int row = rsl * 8 + r8;
    f32x2 S = (f32x2){0.f, 0.f};
    const size_t stoff = ((((size_t)b * 4 + l) * 2 + d) * 4 + h) * 4096 + row * 64 + kq * 2;
    if (lat) S = *(const f32x2*)(p.state_rwkv + stoff);
    const int tok = tid >> 3, cg8 = tid & 7;
    float kkp[8], kap[8];
#pragma unroll
    for (int i = 0; i < 8; ++i) { kkp[i] = p.rw_kk[l * 256 + h * 64 + cg8 * 8 + i]; kap[i] = p.rw_ka[l * 256 + h * 64 + cg8 * 8 + i]; }
    const int nch = T >> 5;
    u32x4 r8v, k8, e8, a8, v8;
    int grow, grow_prev = 0; float oreg = 0.f;
    {
        const int sidx = tok; const int t = d ? T - 1 - sidx : sidx; grow = row0 + t;
        r8v = *(const u32x4*)(p.RKV + (size_t)grow * 768 + h * 64 + cg8 * 8);
        k8 = *(const u32x4*)(p.RKV + (size_t)grow * 768 + 256 + h * 64 + cg8 * 8);
        v8 = *(const u32x4*)(p.RKV + (size_t)grow * 768 + 512 + h * 64 + rsl * 8);
        e8 = *(const u32x4*)(p.Ee + ((size_t)d * M_ALL + grow) * 256 + h * 64 + cg8 * 8);
        a8 = *(const u32x4*)(p.Aa + ((size_t)d * M_ALL + grow) * 256 + h * 64 + cg8 * 8);
    }
    for (int ch = 0; ch < nch; ++ch) {
        {
            float kf[8], kkv[8], rf[8], ef[8], af[8];
#pragma unroll
            for (int q = 0; q < 4; ++q) { kf[2 * q] = lo_bf(k8[q]); kf[2 * q + 1] = hi_bf(k8[q]); rf[2 * q] = lo_bf(r8v[q]); rf[2 * q + 1] = hi_bf(r8v[q]);
                ef[2 * q] = lo_bf(e8[q]); ef[2 * q + 1] = hi_bf(e8[q]); af[2 * q] = lo_bf(a8[q]); af[2 * q + 1] = hi_bf(a8[q]); }
            float ss = 0.f;
#pragma unroll
            for (int i = 0; i < 8; ++i) { kkv[i] = kf[i] * kkp[i]; ss += kkv[i] * kkv[i]; }
            ss = red8(ss);
            const float inv = rsqrtf(fmaxf(ss, 1e-24f));
            f32x4 o0, o1; const int base = tok * 64 + cg8 * 8;
#pragma unroll
            for (int i = 0; i < 4; ++i) { o0[i] = __expf(-ef[i]); o1[i] = __expf(-ef[4 + i]); }
            *(f32x4*)(W + base) = o0; *(f32x4*)(W + base + 4) = o1;
#pragma unroll
            for (int i = 0; i < 4; ++i) { o0[i] = -kkv[i] * inv; o1[i] = -kkv[4 + i] * inv; }
            *(f32x4*)(NKK + base) = o0; *(f32x4*)(NKK + base + 4) = o1;
#pragma unroll
            for (int i = 0; i < 4; ++i) { o0[i] = kkv[i] * inv * af[i]; o1[i] = kkv[4 + i] * inv * af[4 + i]; }
            *(f32x4*)(KKA + base) = o0; *(f32x4*)(KKA + base + 4) = o1;
#pragma unroll
            for (int i = 0; i < 4; ++i) { o0[i] = kf[i] * (1.0f + (af[i] - 1.0f) * kap[i]); o1[i] = kf[4 + i] * (1.0f + (af[4 + i] - 1.0f) * kap[4 + i]); }
            *(f32x4*)(KD + base) = o0; *(f32x4*)(KD + base + 4) = o1;
#pragma unroll
            for (int i = 0; i < 4; ++i) { o0[i] = rf[i]; o1[i] = rf[4 + i]; }
            *(f32x4*)(RR + base) = o0; *(f32x4*)(RR + base + 4) = o1;
            if (cg8 == 0) {
#pragma unroll
                for (int q = 0; q < 4; ++q) { VS[tok * 8 + 2 * q] = lo_bf(v8[q]); VS[tok * 8 + 2 * q + 1] = hi_bf(v8[q]); }
            }
        }
        __syncthreads();
        if (ch > 0) p.ydir[((size_t)d * M_ALL + grow_prev) * 256 + h * 64 + rsl * 8 + cg8] = oreg;
        grow_prev = grow;
        if (ch + 1 < nch) {
            const int sidx = (ch + 1) * 32 + tok; const int t = d ? T - 1 - sidx : sidx; grow = row0 + t;
            r8v = *(const u32x4*)(p.RKV + (size_t)grow * 768 + h * 64 + cg8 * 8);
            k8 = *(const u32x4*)(p.RKV + (size_t)grow * 768 + 256 + h * 64 + cg8 * 8);
            v8 = *(const u32x4*)(p.RKV + (size_t)grow * 768 + 512 + h * 64 + rsl * 8);
            e8 = *(const u32x4*)(p.Ee + ((size_t)d * M_ALL + grow) * 256 + h * 64 + cg8 * 8);
            a8 = *(const u32x4*)(p.Aa + ((size_t)d * M_ALL + grow) * 256 + h * 64 + cg8 * 8);
        }
        {
            const float* Wq = W + kq * 2; const float* NKq = NKK + kq * 2; const float* KAq = KKA + kq * 2; const float* KDq = KD + kq * 2; const float* RRq = RR + kq * 2; const float* VSq = VS + r8;
            float* OPq = OUTP + r8 * 32 + kq;
            f32x2 wv[4], nkv[4], kav[4], kdv[4], rrv[4]; float vv[4];
#define SCAN_LD(slot, st) do { wv[slot] = *(const f32x2*)(Wq + (st) * 64); nkv[slot] = *(const f32x2*)(NKq + (st) * 64); kav[slot] = *(const f32x2*)(KAq + (st) * 64); \
        kdv[slot] = *(const f32x2*)(KDq + (st) * 64); rrv[slot] = *(const f32x2*)(RRq + (st) * 64); vv[slot] = VSq[(st) * 8]; } while (0)
            __builtin_amdgcn_s_setprio(3);
            SCAN_LD(0, 0); SCAN_LD(1, 1); SCAN_LD(2, 2);
#pragma unroll
            for (int s = 0; s < 32; ++s) {
                if (s + 3 < 32) SCAN_LD((s + 3) & 3, s + 3);
                const f32x2 w = wv[s & 3], nk = nkv[s & 3], ka = kav[s & 3], kd = kdv[s & 3], rr = rrv[s & 3]; const float v = vv[s & 3];
                float pd = fmaf(S[1], nk[1], S[0] * nk[0]);
                pd = red16(pd); pd = swap16_add(pd);
                S[0] = fmaf(S[0], w[0], fmaf(pd, ka[0], v * kd[0]));
                S[1] = fmaf(S[1], w[1], fmaf(pd, ka[1], v * kd[1]));
                OPq[s * 256] = fmaf(S[1], rr[1], S[0] * rr[0]);
            }
            __builtin_amdgcn_s_setprio(0);
        }
        __syncthreads();
        {
            const float* op = OUTP + (tok * 8 + cg8) * 32;
            f32x4 a0 = *(const f32x4*)(op), a1 = *(const f32x4*)(op + 4), a2 = *(const f32x4*)(op + 8), a3 = *(const f32x4*)(op + 12);
            f32x4 b0 = *(const f32x4*)(op + 16), b1 = *(const f32x4*)(op + 20), b2 = *(const f32x4*)(op + 24), b3 = *(const f32x4*)(op + 28);
            a0 = ((a0 + a1) + (a2 + a3)) + ((b0 + b1) + (b2 + b3));
            oreg = (a0[0] + a0[1]) + (a0[2] + a0[3]);
        }
    }
    p.ydir[((size_t)d * M_ALL + grow_prev) * 256 + h * 64 + rsl * 8 + cg8] = oreg;
    if (!lat) *(f32x2*)(p.out + 20971520 + 2097152 + 524288 + stoff) = S;
    __syncthreads();
}

#ifndef ATT_THR
#define ATT_THR 8.0f
#endif
#define KS_STRIDE 104
#define VS_STRIDE 68
#define KS_BYTES (64 * KS_STRIDE * 2)
#define ATT_STAGE (KS_BYTES + 64 * VS_STRIDE * 2)
__device__ __forceinline__ void attn_unit(const P& p, int u, char* smem) {
    const int tid = opaque_tid(), lane = tid & 63, wid = tid >> 6, q = lane & 31, hf = lane >> 5;
    int b, h, qt, qrow0, krow0, nown, ntot, Tv; size_t vbase, vcbase = 0; int kcrow0 = 0;
    if (u < 1024) { b = u >> 8; h = (u >> 5) & 7; qt = u & 31; krow0 = M_CTX + b * 4096; qrow0 = krow0 + qt * 128; nown = 64; ntot = 72; Tv = 4096;
        vbase = 2097152 + (size_t)(b * 8 + h) * 64 * 4096; kcrow0 = b * 512; vcbase = (size_t)(b * 8 + h) * 64 * 512; }
    else { const int v = u - 1024; b = v >> 4; h = (v >> 1) & 7; qt = v & 1; krow0 = b * 256; qrow0 = krow0 + qt * 128; nown = 4; ntot = 4; Tv = 256; vbase = (size_t)(b * 8 + h) * 64 * 256; }
    bf16x8 qf[6];
    { const bf16_t* qp = p.Qb + (size_t)(qrow0 + wid * 32 + q) * 768 + h * 96 + hf * 8;
#pragma unroll
      for (int ks = 0; ks < 6; ++ks) qf[ks] = *(const bf16x8*)(qp + ks * 16); }
    f32x16 oT[2];
#pragma unroll
    for (int i = 0; i < 16; ++i) { oT[0][i] = 0.f; oT[1][i] = 0.f; }
    float mref = 0.f, lrun = 0.f; f32x16 negm;
#pragma unroll
    for (int i = 0; i < 16; ++i) negm[i] = 0.f;
    u32x4 rk[3], rv[2];
    int krow[3], kc[3];
#pragma unroll
    for (int i = 0; i < 3; ++i) { const int c = tid + 256 * i; krow[i] = c / 12; kc[i] = c % 12; }
    const int vdv0 = tid >> 3, vkc = tid & 7;
#define ATT_LOAD(kt) do { const bf16_t* kptr; const bf16_t* vptr; int vstr; \
        if ((kt) < nown) { kptr = p.Kb + (size_t)(krow0 + (kt) * 64) * 768 + h * 96; vptr = p.Vt + vbase + (kt) * 64; vstr = Tv; } \
        else { kptr = p.Kc + (size_t)(kcrow0 + ((kt) - nown) * 64) * 768 + h * 96; vptr = p.Vtc + vcbase + ((kt) - nown) * 64; vstr = 512; } \
        _Pragma("unroll") for (int i = 0; i < 3; ++i) rk[i] = *(const u32x4*)(kptr + (size_t)krow[i] * 768 + kc[i] * 8); \
        _Pragma("unroll") for (int i = 0; i < 2; ++i) rv[i] = *(const u32x4*)(vptr + (size_t)(vdv0 + 32 * i) * vstr + vkc * 8); } while (0)
#define ATT_STORE(buf) do { char* Ks_ = smem + (buf) * ATT_STAGE; char* Vs_ = Ks_ + KS_BYTES; \
        _Pragma("unroll") for (int i = 0; i < 3; ++i) *(u32x4*)(Ks_ + (krow[i] * KS_STRIDE + kc[i] * 8) * 2) = rk[i]; \
        _Pragma("unroll") for (int i = 0; i < 2; ++i) { char* vd_ = Vs_ + ((vdv0 + 32 * i) * VS_STRIDE + vkc * 8) * 2; *(u32x2*)vd_ = (u32x2){rv[i].x, rv[i].y}; *(u32x2*)(vd_ + 8) = (u32x2){rv[i].z, rv[i].w}; } } while (0)
    ATT_LOAD(0); ATT_STORE(0);
    __syncthreads();
    for (int kt = 0; kt < ntot; ++kt) {
        const bool more = kt + 1 < ntot;
        if (more) ATT_LOAD(kt + 1);
        const char* Ks = smem + (kt & 1) * ATT_STAGE; const char* Vs = Ks + KS_BYTES;
        f32x16 sT[2];
#pragma unroll
        for (int kb = 0; kb < 2; ++kb)
#pragma unroll
            for (int ks = 0; ks < 6; ++ks) { const bf16x8 kf = *(const bf16x8*)(Ks + ((kb * 32 + q) * KS_STRIDE + ks * 16 + hf * 8) * 2);
                sT[kb] = __builtin_amdgcn_mfma_f32_32x32x16_bf16(kf, qf[ks], ks == 0 ? negm : sT[kb], 0, 0, 0); }
        bf16x8 pf[2][2]; float psum0 = 0.f;
#define ATT_EXP(kb_, acc_) do { _Pragma("unroll") for (int s_ = 0; s_ < 2; ++s_) { float e_[8]; \
            _Pragma("unroll") for (int j_ = 0; j_ < 8; ++j_) { e_[j_] = __builtin_amdgcn_exp2f(sT[kb_][8 * s_ + j_]); acc_ += e_[j_]; } \
            u32x4 w_; w_.x = pack2(e_[0], e_[1]); w_.y = pack2(e_[2], e_[3]); w_.z = pack2(e_[4], e_[5]); w_.w = pack2(e_[6], e_[7]); \
            pf[kb_][s_] = __builtin_bit_cast(bf16x8, w_); } } while (0)
        ATT_EXP(0, psum0);
        float mx = sT[0][0];
#pragma unroll
        for (int i = 1; i < 16; ++i) mx = fmaxf(mx, sT[0][i]);
#pragma unroll
        for (int i = 0; i < 16; ++i) mx = fmaxf(mx, sT[1][i]);
        { auto r_ = __builtin_amdgcn_permlane32_swap(__float_as_uint(mx), __float_as_uint(mx), false, false);
          mx = fmaxf(__uint_as_float(r_[0]), __uint_as_float(r_[1])); }
        const bool first = (kt == 0);
        if (first || __any(mx > ATT_THR)) {
            const float delta = first ? mx : ((mx > ATT_THR) ? mx : 0.f);
            const float alpha = first ? 0.f : __builtin_amdgcn_exp2f(-delta);
            mref += delta; lrun *= alpha;
#pragma unroll
            for (int i = 0; i < 16; ++i) { sT[0][i] -= delta; sT[1][i] -= delta; oT[0][i] *= alpha; oT[1][i] *= alpha; negm[i] = -mref; }
            psum0 = 0.f; ATT_EXP(0, psum0);
        }
        float psum1 = 0.f;
        ATT_EXP(1, psum1);
        lrun += psum0 + psum1;
#pragma unroll
        for (int kb = 0; kb < 2; ++kb)
#pragma unroll
            for (int s = 0; s < 2; ++s)
#pragma unroll
                for (int db = 0; db < 2; ++db) {
                    const char* vp = Vs + ((db * 32 + q) * VS_STRIDE + kb * 32 + 16 * s + 4 * hf) * 2;
                    const u32x2 lo = *(const u32x2*)vp, hi = *(const u32x2*)(vp + 16);
                    const u32x4 w = (u32x4){lo.x, lo.y, hi.x, hi.y};
                    oT[db] = __builtin_amdgcn_mfma_f32_32x32x16_bf16(__builtin_bit_cast(bf16x8, w), pf[kb][s], oT[db], 0, 0, 0);
                }
        if (more) ATT_STORE((kt + 1) & 1);
        __syncthreads();
    }
    const float lt = lrun + __shfl_xor(lrun, 32); const float inv = 1.0f / lt;
    bf16_t* op = p.hbmix + (size_t)(qrow0 + wid * 32 + q) * DM + 256 + h * 64;
#pragma unroll
    for (int db = 0; db < 2; ++db)
#pragma unroll
        for (int g = 0; g < 4; ++g) { u32x2 w; w.x = pack2(oT[db][4 * g] * inv, oT[db][4 * g + 1] * inv); w.y = pack2(oT[db][4 * g + 2] * inv, oT[db][4 * g + 3] * inv);
            *(u32x2*)(op + db * 32 + 8 * g + 4 * hf) = w; }
}

__device__ __forceinline__ void rwcomb_phase(const P& p, int l) {
    const int tid = opaque_tid(), lane = tid & 63, wid = tid >> 6; const int c = lane * 4;
    const f32x4 gng = *(const f32x4*)(p.rw_gn_g + l * 256 + c), gnb = *(const f32x4*)(p.rw_gn_b + l * 256 + c), kap = *(const f32x4*)(p.rw_ka + l * 256 + c), rkp = *(const f32x4*)(p.rw_rk + l * 256 + c);
    for (int row = blockIdx.x * 4 + wid; row < M_ALL; row += gridDim.x * 4) {
        const f32x4 y0 = *(const f32x4*)(p.ydir + (size_t)row * 256 + c), y1 = *(const f32x4*)(p.ydir + ((size_t)M_ALL + row) * 256 + c);
        f32x4 y = y0 + y1;
        float s = (y[0] + y[1]) + (y[2] + y[3]); s = red16(s); const float mu = s * (1.0f / 64.0f);
        const f32x4 dd = y - mu; float q2 = (dd[0] * dd[0] + dd[1] * dd[1]) + (dd[2] * dd[2] + dd[3] * dd[3]); q2 = red16(q2);
        const float rstd = rsqrtf(q2 * (1.0f / 64.0f) + 64e-5f);
        const f32x4 yn = dd * rstd * gng + gnb;
        const u32x2 rw = *(const u32x2*)(p.RKV + (size_t)row * 768 + c), kw = *(const u32x2*)(p.RKV + (size_t)row * 768 + 256 + c), vw = *(const u32x2*)(p.RKV + (size_t)row * 768 + 512 + c);
        const u32x2 a0w = *(const u32x2*)(p.Aa + (size_t)row * 256 + c), a1w = *(const u32x2*)(p.Aa + ((size_t)M_ALL + row) * 256 + c), gw = *(const u32x2*)(p.Gg + (size_t)row * 256 + c);
        const f32x4 r = (f32x4){lo_bf(rw.x), hi_bf(rw.x), lo_bf(rw.y), hi_bf(rw.y)}, k = (f32x4){lo_bf(kw.x), hi_bf(kw.x), lo_bf(kw.y), hi_bf(kw.y)}, v = (f32x4){lo_bf(vw.x), hi_bf(vw.x), lo_bf(vw.y), hi_bf(vw.y)};
        const f32x4 a0 = (f32x4){lo_bf(a0w.x), hi_bf(a0w.x), lo_bf(a0w.y), hi_bf(a0w.y)}, a1 = (f32x4){lo_bf(a1w.x), hi_bf(a1w.x), lo_bf(a1w.y), hi_bf(a1w.y)}, gt = (f32x4){lo_bf(gw.x), hi_bf(gw.x), lo_bf(gw.y), hi_bf(gw.y)};
        const f32x4 kds = k * (1.0f + (a0 - 1.0f) * kap) + k * (1.0f + (a1 - 1.0f) * kap);
        const f32x4 t4 = r * kds * rkp; float rk = (t4[0] + t4[1]) + (t4[2] + t4[3]); rk = red16(rk);
        const f32x4 o = (yn + rk * v) * gt;
        u32x2 w; w.x = pack2(o[0], o[1]); w.y = pack2(o[2], o[3]);
        *(u32x2*)(p.hbmix + (size_t)row * DM + c) = w;
    }
}


__device__ __forceinline__ bool xcd_tile(int i, int TT, int NT, int& mt, int& nt) {
    const int per = TT >> 3; if (i >= per) return false;
    const int t = (blockIdx.x & 7) * per + i; const int band = t / (8 * NT), rem = t - band * 8 * NT;
    nt = rem >> 3; mt = band * 8 + (rem & 7); return true;
}
__global__ void __launch_bounds__(256, 2) mega(Args a_unused) {
    extern __shared__ __attribute__((aligned(16))) char smem[];
    __shared__ uint4 xbw; __shared__ int s_unit;
    kargp_t kp = (kargp_t)__builtin_amdgcn_kernarg_segment_ptr();
    const int tid = threadIdx.x; const int G = gridDim.x;
    if (tid == 0) xbw = make_uint4(0u, 0u, 0u, 0u);
    __syncthreads();
    XcdBarrier xb;
    { const P p = getP(kp); xb = xcd_barrier_post(p.bar, (volatile LAS unsigned*)&xbw); }
    for (int u = blockIdx.x; u < 384 + NCONV + 272; u += G) {
        if (u < 384) { const P p = getP(kp); ada_unit(p, u, smem); } else if (u < 384 + NCONV) { const P p = getP(kp); conv_unit(p, 0, u - 384, smem); } else { const P p = getP(kp); misc0_unit(p, u - 384 - NCONV); }
    }
    cg::this_grid().sync();
    { const P p = getP(kp); ln_phase(p, 0, 0); }
    xcd_barrier(xb);
    float* rs = (float*)(smem + RS_OFF);
#pragma unroll 1
    for (int l = 0; l < 4; ++l) {
        for (int i = blockIdx.x >> 3; ; i += G >> 3) { int mt, nt; if (!xcd_tile(i, 80 * 17, 17, mt, nt)) break; const P p = getP(kp);
            EpiZ e{p.Z, mt * 256, nt * 128};
            gemm256(p.hbmix + (size_t)mt * 256 * DM, DM, p.WtIn + (size_t)nt * 128 * DM, DM, DM, smem, e); }
        xcd_barrier(xb);
        for (int rep2 = 0; rep2 < DUP_P2; ++rep2) {
        for (;;) {
            { const P pc = getP(kp); if (tid == 0) s_unit = atomicAdd(&pc.ctr[l * 4 + 0 + 2 * rep2], 1); }
            __syncthreads(); int u = s_unit; __syncthreads();
            if (u >= 320 + 480 + 640 + 64 + 352 + 640) break;
            if (u < 320) { const P p = getP(kp); rwprep_unit(p, l, u, smem); continue; }
            u -= 320;
            if (u < 480) { const P p = getP(kp); const int mt = u / 3, np = u % 3;
                rowscale128(p.Z, mt * 128, ZQ, 256, 1e-6f, rs);
                for (int k2 = 0; k2 < 2; ++k2) { const int nt = np * 2 + k2;
                    EpiQ e{p.Qb, rs, p.ropeC, p.ropeS, mt * 128, nt * 128};
                    gemm128<true>(p.Z + (size_t)mt * 128 * NIN + ZQ, NIN, p.WtQ + (size_t)nt * 128 * 256, 256, 256, smem, e); }
                __syncthreads(); continue; }
            u -= 480;
            if (u < 640) { const P p = getP(kp); const int mt = u >> 2, np = u & 3; const int R0 = mt * 128; const bool latr = R0 >= M_CTX;
                rowscale128(p.Z, R0, ZKV, 128, 1e-6f, rs);
                for (int k2 = 0; k2 < 2; ++k2) { const int nt = np * 2 + k2;
                    if (np < 2) { EpiKN e{latr ? p.Kb + (size_t)M_CTX * 768 : p.Kb, rs, latr ? R0 - M_CTX : R0, nt * 128};
                        gemm128<true>(p.Z + (size_t)R0 * NIN + ZKV, NIN, p.WtKVn + (size_t)nt * 128 * 128, 128, 128, smem, e); }
                    else { EpiKV e{latr ? p.Kb + (size_t)M_CTX * 768 : p.Kb, p.Vt, rs, latr ? R0 - M_CTX : R0, nt * 128, latr ? 12 : 8, latr ? (size_t)2097152 : (size_t)0};
                        gemm128<false>(p.Z + (size_t)R0 * NIN + ZKV, NIN, p.WtKVn + (size_t)nt * 128 * 128, 128, 128, smem, e); } }
                __syncthreads(); continue; }
            u -= 640;
            if (u < 64) { const P p = getP(kp); const int mt = u >> 2, np = u & 3;
                for (int k2 = 0; k2 < 2; ++k2) { const int nt = np * 2 + k2;
                    if (np < 2) { EpiKN e{p.Kc, nullptr, mt * 128, nt * 128};
                        gemm128<true>(p.CkvB + ((size_t)l * 2048 + mt * 128) * 128, 128, p.WtKV + (size_t)nt * 128 * 128, 128, 128, smem, e); }
                    else { EpiKV e{p.Kc, p.Vtc, nullptr, mt * 128, nt * 128, 9, (size_t)0};
                        gemm128<false>(p.CkvB + ((size_t)l * 2048 + mt * 128) * 128, 128, p.WtKV + (size_t)nt * 128 * 128, 128, 128, smem, e); } }
                continue; }
            u -= 64;
            if (u < 352) { const P p = getP(kp); for (int i = 0; i < 8; ++i) small_unit(p, l, u * 8 + i); continue; }
            u -= 352;
            { const P p = getP(kp); gmlp_unit(p, l, u, smem); }
        }
        xcd_barrier(xb);
        }
        for (int rep3 = 0; rep3 < DUP_P3; ++rep3) {
        for (;;) {
            { const P pc = getP(kp); if (tid == 0) s_unit = atomicAdd(&pc.ctr[l * 4 + 1 + 2 * rep3], 1); }
            __syncthreads(); int u = s_unit; __syncthreads();
            if (u >= NSCAN + 1280) break;
#ifdef PROBE_SCAN_ONLY
            if (rep3 == 1 && u >= NSCAN) break;
#endif
#ifdef PROBE_ATTN_ONLY
            if (rep3 == 1 && u < NSCAN) continue;
#endif
            if (u < NSCAN) { const P p = getP(kp); scan_unit(p, l, u, smem); } else { const P p = getP(kp); attn_unit(p, u - NSCAN, smem); }
        }
        xcd_barrier(xb);
        }
        { const P p = getP(kp); rwcomb_phase(p, l); }
        xcd_barrier(xb);
        for (int i = blockIdx.x >> 3; ; i += G >> 3) { int mt, nt; if (!xcd_tile(i, 160 * 8, 8, mt, nt)) break; const P p = getP(kp);
            EpiRes e{p.out, p.mod + ((size_t)l * 5 + modrow_of(mt * 128)) * 6144 + 2048, mt * 128, nt * 128};
            gemm128<true>(p.hbmix + (size_t)mt * 128 * DM, DM, p.WtOut + (size_t)nt * 128 * DM, DM, DM, smem, e); }
        xcd_barrier(xb);
        { const P p = getP(kp); ln_phase(p, l, 1); }
        xcd_barrier(xb);
        for (int rep5 = 0; rep5 < DUP_P5; ++rep5)
        for (int i = blockIdx.x >> 3; ; i += G >> 3) { int mt, nt; if (!xcd_tile(i, 80 * 44, 44, mt, nt)) break; const P p = getP(kp);
            EpiSwi e{p.hidden, mt * 256, nt * 128};
            gemm256(p.hbmix + (size_t)mt * 256 * DM, DM, p.WtF1 + (size_t)nt * 128 * DM, DM, DM, smem, e); }
        xcd_barrier(xb);
        for (int i = blockIdx.x >> 3; ; i += G >> 3) { int mt, nt; if (!xcd_tile(i, 160 * 8, 8, mt, nt)) break; const P p = getP(kp);
            EpiRes e{p.out, p.mod + ((size_t)l * 5 + modrow_of(mt * 128)) * 6144 + 5120, mt * 128, nt * 128};
            gemm128<true>(p.hidden + (size_t)mt * 128 * DFF, DFF, p.WtF2 + (size_t)nt * 128 * DFF, DFF, DFF, smem, e); }
        xcd_barrier(xb);
        { const P p = getP(kp); ln_phase(p, l, 2); }
        if (l < 3) { for (int u = blockIdx.x; u < NCONV; u += G) { const P p = getP(kp); conv_unit(p, l + 1, u, smem); } }
        xcd_barrier(xb);
    }
}

extern "C" void kernel_launch(void* const* d_in, const int* in_sizes, int n_in, void* d_out, int out_size, void* d_ws, size_t ws_size, hipStream_t stream) {
    static int grid_blocks = 0;
    if (!grid_blocks) {
        int dev = 0, cus = 0, per_cu = 0;
        (void)hipGetDevice(&dev);
        (void)hipDeviceGetAttribute(&cus, hipDeviceAttributeMultiprocessorCount, dev);
        (void)hipFuncSetAttribute((const void*)mega, hipFuncAttributeMaxDynamicSharedMemorySize, SMEM_BYTES);
        (void)hipOccupancyMaxActiveBlocksPerMultiprocessor(&per_cu, (const void*)mega, 256, SMEM_BYTES);
        if (per_cu > 2) per_cu = 2;
        if (per_cu < 1) per_cu = 1;
        grid_blocks = (cus * per_cu) & ~7;
    }
    if (WS_TOTAL > ws_size) { fprintf(stderr, "kernel_launch: workspace too small: need %zu have %zu\n", (size_t)WS_TOTAL, ws_size); return; }
    Args a{};
    for (int i = 0; i < 36; ++i) a.in[i] = (const float*)d_in[i];
    a.out = (float*)d_out; a.ws = (char*)d_ws;
    (void)hipMemsetAsync((char*)d_ws + OFF_BAR, 0, 16384 + 4096, stream);
    void* args[] = {&a};
    hipError_t e = hipLaunchCooperativeKernel((const void*)mega, dim3(grid_blocks), dim3(256), args, SMEM_BYTES, stream);
    if (e != hipSuccess) fprintf(stderr, "cooperative launch failed: %s (grid %d)\n", hipGetErrorString(e), grid_blocks);
}
```

```cpp
#include <hip/hip_runtime.h>
#include <hip/hip_cooperative_groups.h>
#include <cstdint>
#include <cstdio>
namespace cg = cooperative_groups;

typedef unsigned short bf16_t;
typedef short bf16x8 __attribute__((ext_vector_type(8)));
typedef float f32x4 __attribute__((ext_vector_type(4)));
typedef float f32x2 __attribute__((ext_vector_type(2)));
typedef float f32x16 __attribute__((ext_vector_type(16)));
typedef unsigned u32x4 __attribute__((ext_vector_type(4)));
typedef unsigned u32x2 __attribute__((ext_vector_type(2)));

#define M_ALL 20480
#define M_CTX 4096
#define DM 1024
#define NIN 2080
#define DFF 2816
#define ALPHA_F 1.6817928305074290f
#define QSCALE (0.10206207261596575f * 1.4426950408889634f)
#define LAS __attribute__((address_space(3)))
#ifndef DUP_P2
#define DUP_P2 1
#endif
#ifndef DUP_P3
#define DUP_P3 1
#endif
#ifndef DUP_P5
#define DUP_P5 1
#endif

#define ZQ 1152
#define ZKV 1408
#define ZKR 1536
#define ZU 1568
#define ZV 1824

#define LDS_STRIDE 72
#define TILE_BYTES (128 * LDS_STRIDE * 2)
#define RS_OFF (4 * TILE_BYTES)
#define SMEM_BYTES (RS_OFF + 3072)

struct P {
    const float *x_prompt, *x_sample, *cache_ckv, *cache_krope, *state_rwkv, *c, *c_ctx, *ada_w, *ada_b, *w_in, *rw_conv, *rw_w0, *rw_w2,
        *rw_a0, *rw_a2, *rw_g2, *rw_kk, *rw_ka, *rw_rk, *rw_gn_g, *rw_gn_b, *q_norm, *q_up, *kv_norm, *kv_up, *gm_g, *gm_b, *gm_ws, *gm_bs,
        *w_out, *ln1_g, *ln1_b, *ffn_in, *ffn_out, *ln2_g, *ln2_b;
    float* out;
    unsigned* bar; int* ctr; float* mod; float* ropeC; float* ropeS; bf16_t* CkvB;
    bf16_t *WtIn, *WtQ, *WtKVn, *WtKV, *WtOut, *WtF1, *WtF2, *WsB, *W2t, *A2t, *G2t;
    bf16_t *Z, *RKV, *Ee, *Aa, *Gg, *Qb, *Kb, *Kc, *Vt, *Vtc, *hbmix, *hidden;
    float* ydir;
};


struct Args { const float* in[36]; float* out; char* ws; };
typedef const __attribute__((address_space(4))) char* kargp_t;
constexpr size_t al256(size_t x) { return (x + 255) & ~(size_t)255; }
constexpr size_t OFF_BAR = 0;
constexpr size_t OFF_CTR = OFF_BAR + 16384;
constexpr size_t OFF_MOD = OFF_CTR + 4096;
constexpr size_t OFF_ROPEC = OFF_MOD + al256((size_t)4 * 5 * 6144 * 4);
constexpr size_t OFF_ROPES = OFF_ROPEC + 65536 * 4;
constexpr size_t OFF_CKVB = OFF_ROPES + 65536 * 4;
constexpr size_t OFF_WTIN = OFF_CKVB + (size_t)4 * 2048 * 128 * 2;
constexpr size_t OFF_WTQ = OFF_WTIN + (size_t)2176 * 1024 * 2;
constexpr size_t OFF_WTKVN = OFF_WTQ + (size_t)768 * 256 * 2;
constexpr size_t OFF_WTKV = OFF_WTKVN + (size_t)1024 * 128 * 2;
constexpr size_t OFF_WTOUT = OFF_WTKV + (size_t)1024 * 128 * 2;
constexpr size_t OFF_WTF1 = OFF_WTOUT + (size_t)1024 * 1024 * 2;
constexpr size_t OFF_WTF2 = OFF_WTF1 + (size_t)5632 * 1024 * 2;
constexpr size_t OFF_WSB = OFF_WTF2 + (size_t)1024 * DFF * 2;
constexpr size_t OFF_W2T = OFF_WSB + (size_t)65536 * 2;
constexpr size_t OFF_A2T = OFF_W2T + (size_t)2 * 256 * 64 * 2;
constexpr size_t OFF_G2T = OFF_A2T + (size_t)2 * 256 * 64 * 2;
constexpr size_t OFF_Z = OFF_G2T + (size_t)256 * 128 * 2;
constexpr size_t OFF_HIDDEN = OFF_Z;
constexpr size_t OFF_RKV = OFF_Z + al256((size_t)M_ALL * NIN * 2);
constexpr size_t OFF_EE = OFF_RKV + (size_t)M_ALL * 768 * 2;
constexpr size_t OFF_AA = OFF_EE + (size_t)2 * M_ALL * 256 * 2;
constexpr size_t OFF_GG = OFF_AA + (size_t)2 * M_ALL * 256 * 2;
constexpr size_t OFF_QB = OFF_GG + (size_t)M_ALL * 256 * 2;
constexpr size_t OFF_KB = OFF_QB + (size_t)M_ALL * 768 * 2;
constexpr size_t OFF_KC = OFF_KB + (size_t)M_ALL * 768 * 2;
constexpr size_t OFF_VT = OFF_KC + (size_t)2048 * 768 * 2;
constexpr size_t OFF_VTC = OFF_VT + (size_t)M_ALL * 512 * 2;
constexpr size_t OFF_YDIR = OFF_VTC + (size_t)2048 * 512 * 2;
constexpr size_t OFF_HBMIX = OFF_YDIR + (size_t)2 * M_ALL * 256 * 4;
constexpr size_t WS_TOTAL = OFF_HBMIX + (size_t)M_ALL * DM * 2;
static_assert(OFF_RKV + (size_t)M_ALL * 768 * 2 - OFF_HIDDEN >= (size_t)M_ALL * DFF * 2, "hidden overlay");

__device__ __forceinline__ P getP(kargp_t& kp) {
    asm volatile("" : "+s"(kp));
    typedef const float* const __attribute__((address_space(4)))* inp_t;
    inp_t in = (inp_t)kp;
    P p;
    p.x_prompt = in[0]; p.x_sample = in[1]; p.cache_ckv = in[2]; p.cache_krope = in[3]; p.state_rwkv = in[4]; p.c = in[5]; p.c_ctx = in[6];
    p.ada_w = in[7]; p.ada_b = in[8]; p.w_in = in[9]; p.rw_conv = in[10]; p.rw_w0 = in[11]; p.rw_w2 = in[12]; p.rw_a0 = in[13]; p.rw_a2 = in[14];
    p.rw_g2 = in[15]; p.rw_kk = in[16]; p.rw_ka = in[17]; p.rw_rk = in[18]; p.rw_gn_g = in[19]; p.rw_gn_b = in[20]; p.q_norm = in[21]; p.q_up = in[22];
    p.kv_norm = in[23]; p.kv_up = in[24]; p.gm_g = in[25]; p.gm_b = in[26]; p.gm_ws = in[27]; p.gm_bs = in[28]; p.w_out = in[29]; p.ln1_g = in[30];
    p.ln1_b = in[31]; p.ffn_in = in[32]; p.ffn_out = in[33]; p.ln2_g = in[34]; p.ln2_b = in[35];
    p.out = (float*)in[36]; char* ws = (char*)in[37];
    p.bar = (unsigned*)(ws + OFF_BAR); p.ctr = (int*)(ws + OFF_CTR); p.mod = (float*)(ws + OFF_MOD); p.ropeC = (float*)(ws + OFF_ROPEC); p.ropeS = (float*)(ws + OFF_ROPES);
    p.CkvB = (bf16_t*)(ws + OFF_CKVB); p.WtIn = (bf16_t*)(ws + OFF_WTIN); p.WtQ = (bf16_t*)(ws + OFF_WTQ); p.WtKVn = (bf16_t*)(ws + OFF_WTKVN); p.WtKV = (bf16_t*)(ws + OFF_WTKV);
    p.WtOut = (bf16_t*)(ws + OFF_WTOUT); p.WtF1 = (bf16_t*)(ws + OFF_WTF1); p.WtF2 = (bf16_t*)(ws + OFF_WTF2); p.WsB = (bf16_t*)(ws + OFF_WSB); p.W2t = (bf16_t*)(ws + OFF_W2T);
    p.A2t = (bf16_t*)(ws + OFF_A2T); p.G2t = (bf16_t*)(ws + OFF_G2T); p.Z = (bf16_t*)(ws + OFF_Z); p.RKV = (bf16_t*)(ws + OFF_RKV); p.Ee = (bf16_t*)(ws + OFF_EE); p.Aa = (bf16_t*)(ws + OFF_AA);
    p.Gg = (bf16_t*)(ws + OFF_GG); p.Qb = (bf16_t*)(ws + OFF_QB); p.Kb = (bf16_t*)(ws + OFF_KB); p.Kc = (bf16_t*)(ws + OFF_KC); p.Vt = (bf16_t*)(ws + OFF_VT); p.Vtc = (bf16_t*)(ws + OFF_VTC);
    p.hbmix = (bf16_t*)(ws + OFF_HBMIX); p.hidden = (bf16_t*)(ws + OFF_HIDDEN); p.ydir = (float*)(ws + OFF_YDIR);
    return p;
}

__device__ __forceinline__ float bf2f(bf16_t b) { return __uint_as_float(((unsigned)b) << 16); }
__device__ __forceinline__ unsigned pack2(float lo, float hi) { unsigned r; asm("v_cvt_pk_bf16_f32 %0, %1, %2" : "=v"(r) : "v"(lo), "v"(hi)); return r; }
__device__ __forceinline__ bf16_t f2bf(float f) { return (bf16_t)(pack2(f, 0.f) & 0xffffu); }
__device__ __forceinline__ float lo_bf(unsigned w) { return __uint_as_float(w << 16); }
__device__ __forceinline__ float hi_bf(unsigned w) { return __uint_as_float(w & 0xffff0000u); }
__device__ __forceinline__ float sigmoidf_(float x) { return __builtin_amdgcn_rcpf(1.0f + __builtin_amdgcn_exp2f(-1.4426950408889634f * x)); }
__device__ __forceinline__ float tanhf_(float x) { float e = __builtin_amdgcn_exp2f(2.8853900817779268f * x); return 1.0f - 2.0f * __builtin_amdgcn_rcpf(e + 1.0f); }
__device__ __forceinline__ float geluf_(float x) { return 0.5f * x * (1.0f + tanhf_(0.7978845608028654f * (x + 0.044715f * x * x * x))); }
template <int CTRL> __device__ __forceinline__ float dpp_add(float x) {
    int y = __builtin_amdgcn_update_dpp(0, __float_as_int(x), CTRL, 0xf, 0xf, false);
    return x + __int_as_float(y);
}
__device__ __forceinline__ float red4(float x) { x = dpp_add<0xB1>(x); x = dpp_add<0x4E>(x); return x; }
__device__ __forceinline__ float red8(float x) { x = red4(x); x = dpp_add<0x141>(x); return x; }
__device__ __forceinline__ float red16(float x) { x = red8(x); x = dpp_add<0x140>(x); return x; }
__device__ __forceinline__ int opaque_tid() { int t = threadIdx.x; asm volatile("" : "+v"(t)); return t; }
__device__ __forceinline__ int modrow_of(int row) { return row < M_CTX ? 0 : 1 + ((row - M_CTX) >> 12); }

#define XB_TMO 128
#define XB_XCNT(j) (256 + 64 * (j))
#define XB_XSUB(j) (1280 + 64 * (j))
#define XB_XGEN(j) (2304 + 64 * (j))
#define XB_TOP 3328
#define XB_TOPGEN 3392
#define XCD_BAR_WORDS 3456
#define XB_SPIN_CAP (1u << 22)
__device__ __forceinline__ unsigned xb_ld(unsigned* p) { return __hip_atomic_load(p, __ATOMIC_RELAXED, __HIP_MEMORY_SCOPE_AGENT); }
__device__ __forceinline__ unsigned xb_add(unsigned* p, unsigned v) { return __hip_atomic_fetch_add(p, v, __ATOMIC_RELAXED, __HIP_MEMORY_SCOPE_AGENT); }
__device__ __forceinline__ unsigned xb_xcc_id() { return (unsigned)__builtin_amdgcn_s_getreg((3 << 11) | 20) & 0xFu; }
#define XB_SPIN(cond, bar) do { unsigned _sp = 0; while (cond) { __builtin_amdgcn_s_sleep(1); \
    if ((++_sp & 255u) == 0u) { if (xb_ld(&(bar)[XB_TMO])) break; if (_sp > XB_SPIN_CAP) { atomicAdd(&(bar)[XB_TMO], 1u); break; } } } } while (0)
struct XcdBarrier { unsigned* bar; unsigned x; volatile LAS unsigned* st; };
__device__ __forceinline__ XcdBarrier xcd_barrier_post(unsigned* bar, volatile LAS unsigned* st) {
    XcdBarrier b; b.bar = bar; b.x = xb_xcc_id(); b.st = st;
    if (threadIdx.x == 0) (void)xb_add(&bar[XB_XCNT(b.x)], 1u);
    return b;
}
__device__ __forceinline__ void xcd_barrier_complete(unsigned* bar, unsigned x, unsigned& nloc, unsigned& nx) {
    const unsigned G = gridDim.x * gridDim.y * gridDim.z;
    unsigned sum, cnt, mine, sp = 0u;
    for (;;) {
        sum = 0u; cnt = 0u; mine = 0u;
#pragma unroll
        for (unsigned j = 0; j < 16; ++j) { const unsigned c = xb_ld(&bar[XB_XCNT(j)]); sum += c; cnt += (c > 0u) ? 1u : 0u; mine = (j == x) ? c : mine; }
        if (sum == G) break;
        __builtin_amdgcn_s_sleep(1);
        if ((++sp & 255u) == 0u) { if (xb_ld(&bar[XB_TMO])) break; if (sp > XB_SPIN_CAP) { atomicAdd(&bar[XB_TMO], 1u); break; } }
    }
    nloc = mine > 0u ? mine : 1u; nx = cnt > 0u ? cnt : 1u;
}
__device__ __forceinline__ void xcd_barrier(const XcdBarrier& b) {
    asm volatile("s_waitcnt vmcnt(0)" ::: "memory");
    __syncthreads();
    if (threadIdx.x == 0) {
        unsigned* bar = b.bar;
        __builtin_amdgcn_s_waitcnt(0);
        unsigned nloc = b.st[0], nx = b.st[1];
        if (nloc == 0u) { xcd_barrier_complete(bar, b.x, nloc, nx); b.st[0] = nloc; b.st[1] = nx; }
        const unsigned old = xb_add(&bar[XB_XSUB(b.x)], 1u);
        const unsigned gen = old / nloc;
        if (old + 1u == (gen + 1u) * nloc) {
            __builtin_amdgcn_fence(__ATOMIC_RELEASE, "agent");
            asm volatile("s_waitcnt vmcnt(0)" ::: "memory");
            const unsigned og = xb_add(&bar[XB_TOP], 1u);
            const unsigned tg = og / nx;
            if (og + 1u == (tg + 1u) * nx) xb_add(&bar[XB_TOPGEN], 1u);
            else XB_SPIN(xb_ld(&bar[XB_TOPGEN]) == tg, bar);
            __builtin_amdgcn_fence(__ATOMIC_ACQUIRE, "agent");
            xb_add(&bar[XB_XGEN(b.x)], 1u);
            asm volatile("s_waitcnt vmcnt(0)" ::: "memory");
        } else {
            XB_SPIN(xb_ld(&bar[XB_XGEN(b.x)]) == gen, bar);
            __builtin_amdgcn_fence(__ATOMIC_ACQUIRE, "agent");
            asm volatile("s_waitcnt vmcnt(0)" ::: "memory");
        }
    }
    __syncthreads();
}

template <bool TR, class Epi>
__device__ __forceinline__ void gemm128(const bf16_t* __restrict__ A, int lda, const bf16_t* __restrict__ B, int ldb, int K, char* smem, const Epi& epi) {
    const int tid = opaque_tid(), lane = tid & 63, wid = tid >> 6, wr = wid >> 1, wc = wid & 1, fr = lane & 15, fq = lane >> 4;
    f32x4 acc[4][4];
#pragma unroll
    for (int m = 0; m < 4; ++m)
#pragma unroll
        for (int n = 0; n < 4; ++n) acc[m][n] = (f32x4){0.f, 0.f, 0.f, 0.f};
    const int crow = tid >> 3, ckc = tid & 7;
    const bf16_t* ap = A + (size_t)crow * lda + ckc * 8;
    const bf16_t* bp = B + (size_t)crow * ldb + ckc * 8;
    u32x4 ra[4], rb[4];
#pragma unroll
    for (int i = 0; i < 4; ++i) { ra[i] = *(const u32x4*)(ap + (size_t)(32 * i) * lda); rb[i] = *(const u32x4*)(bp + (size_t)(32 * i) * ldb); }
    {
        char* sa = smem; char* sb = smem + TILE_BYTES;
#pragma unroll
        for (int i = 0; i < 4; ++i) { *(u32x4*)(sa + ((crow + 32 * i) * LDS_STRIDE + ckc * 8) * 2) = ra[i]; *(u32x4*)(sb + ((crow + 32 * i) * LDS_STRIDE + ckc * 8) * 2) = rb[i]; }
    }
    __syncthreads();
    const int nk = K >> 6;
    for (int kt = 0; kt < nk; ++kt) {
        const bool more = (kt + 1 < nk);
        if (more) {
            const int k0 = (kt + 1) << 6;
#pragma unroll
            for (int i = 0; i < 4; ++i) { ra[i] = *(const u32x4*)(ap + (size_t)(32 * i) * lda + k0); rb[i] = *(const u32x4*)(bp + (size_t)(32 * i) * ldb + k0); }
        }
        const char* sa = smem + (kt & 1) * 2 * TILE_BYTES; const char* sb = sa + TILE_BYTES;
#pragma unroll
        for (int ks = 0; ks < 2; ++ks) {
            bf16x8 af[4], bfr[4];
#pragma unroll
            for (int m = 0; m < 4; ++m) af[m] = *(const bf16x8*)(sa + ((wr * 64 + m * 16 + fr) * LDS_STRIDE + ks * 32 + fq * 8) * 2);
#pragma unroll
            for (int n = 0; n < 4; ++n) bfr[n] = *(const bf16x8*)(sb + ((wc * 64 + n * 16 + fr) * LDS_STRIDE + ks * 32 + fq * 8) * 2);
            __builtin_amdgcn_s_setprio(1);
#pragma unroll
            for (int m = 0; m < 4; ++m)
#pragma unroll
                for (int n = 0; n < 4; ++n) acc[m][n] = TR ? __builtin_amdgcn_mfma_f32_16x16x32_bf16(bfr[n], af[m], acc[m][n], 0, 0, 0) : __builtin_amdgcn_mfma_f32_16x16x32_bf16(af[m], bfr[n], acc[m][n], 0, 0, 0);
            __builtin_amdgcn_s_setprio(0);
        }
        if (more) {
            char* da = smem + ((kt + 1) & 1) * 2 * TILE_BYTES; char* db = da + TILE_BYTES;
#pragma unroll
            for (int i = 0; i < 4; ++i) { *(u32x4*)(da + ((crow + 32 * i) * LDS_STRIDE + ckc * 8) * 2) = ra[i]; *(u32x4*)(db + ((crow + 32 * i) * LDS_STRIDE + ckc * 8) * 2) = rb[i]; }
        }
        __syncthreads();
    }
    epi(acc, wr * 64, wc * 64, fr, fq);
}


#define L2_STRIDE 40
#define A2_BYTES (256 * L2_STRIDE * 2)
#define B2_BYTES (128 * L2_STRIDE * 2)
#define ST2_BYTES (A2_BYTES + B2_BYTES)
template <class Epi>
__device__ __forceinline__ void gemm256(const bf16_t* __restrict__ A, int lda, const bf16_t* __restrict__ B, int ldb, int K, char* smem, const Epi& epi) {
    const int tid = opaque_tid(), lane = tid & 63, wid = tid >> 6, wr = wid >> 1, wc = wid & 1, fr = lane & 15, fq = lane >> 4;
    f32x4 acc[2][4][4];
#pragma unroll
    for (int hh = 0; hh < 2; ++hh)
#pragma unroll
        for (int m = 0; m < 4; ++m)
#pragma unroll
            for (int n = 0; n < 4; ++n) acc[hh][m][n] = (f32x4){0.f, 0.f, 0.f, 0.f};
    const int crow = tid >> 2, ckc = tid & 3;
    const bf16_t* ap = A + (size_t)crow * lda + ckc * 8;
    const bf16_t* bp = B + (size_t)crow * ldb + ckc * 8;
    u32x4 ra[4], rb[2];
#pragma unroll
    for (int i = 0; i < 4; ++i) ra[i] = *(const u32x4*)(ap + (size_t)(64 * i) * lda);
#pragma unroll
    for (int i = 0; i < 2; ++i) rb[i] = *(const u32x4*)(bp + (size_t)(64 * i) * ldb);
    {
        char* sa = smem; char* sb = smem + A2_BYTES;
#pragma unroll
        for (int i = 0; i < 4; ++i) *(u32x4*)(sa + ((crow + 64 * i) * L2_STRIDE + ckc * 8) * 2) = ra[i];
#pragma unroll
        for (int i = 0; i < 2; ++i) *(u32x4*)(sb + ((crow + 64 * i) * L2_STRIDE + ckc * 8) * 2) = rb[i];
    }
    __syncthreads();
    const int nk = K >> 5;
    for (int kt = 0; kt < nk; ++kt) {
        const bool more = (kt + 1 < nk);
        if (more) {
            const int k0 = (kt + 1) << 5;
#pragma unroll
            for (int i = 0; i < 4; ++i) ra[i] = *(const u32x4*)(ap + (size_t)(64 * i) * lda + k0);
#pragma unroll
            for (int i = 0; i < 2; ++i) rb[i] = *(const u32x4*)(bp + (size_t)(64 * i) * ldb + k0);
        }
        const char* sa = smem + (kt & 1) * ST2_BYTES; const char* sb = sa + A2_BYTES;
        bf16x8 bfr[4];
#pragma unroll
        for (int n = 0; n < 4; ++n) bfr[n] = *(const bf16x8*)(sb + ((wc * 64 + n * 16 + fr) * L2_STRIDE + fq * 8) * 2);
#pragma unroll
        for (int hh = 0; hh < 2; ++hh) {
            bf16x8 af[4];
#pragma unroll
            for (int m = 0; m < 4; ++m) af[m] = *(const bf16x8*)(sa + ((wr * 128 + hh * 64 + m * 16 + fr) * L2_STRIDE + fq * 8) * 2);
            __builtin_amdgcn_s_setprio(1);
#pragma unroll
            for (int m = 0; m < 4; ++m)
#pragma unroll
                for (int n = 0; n < 4; ++n) acc[hh][m][n] = __builtin_amdgcn_mfma_f32_16x16x32_bf16(bfr[n], af[m], acc[hh][m][n], 0, 0, 0);
            __builtin_amdgcn_s_setprio(0);
        }
        if (more) {
            char* da = smem + ((kt + 1) & 1) * ST2_BYTES; char* db = da + A2_BYTES;
#pragma unroll
            for (int i = 0; i < 4; ++i) *(u32x4*)(da + ((crow + 64 * i) * L2_STRIDE + ckc * 8) * 2) = ra[i];
#pragma unroll
            for (int i = 0; i < 2; ++i) *(u32x4*)(db + ((crow + 64 * i) * L2_STRIDE + ckc * 8) * 2) = rb[i];
        }
        __syncthreads();
    }
    epi(acc[0], wr * 128, wc * 64, fr, fq);
    epi(acc[1], wr * 128 + 64, wc * 64, fr, fq);
}

struct EpiZ {
    bf16_t* Z; int R0, C0;
    __device__ __forceinline__ void operator()(f32x4 (&acc)[4][4], int r0, int c0, int fr, int fq) const {
#pragma unroll
        for (int n = 0; n < 4; ++n) { const int col = C0 + c0 + n * 16 + fq * 4; if (col < NIN) {
#pragma unroll
            for (int m = 0; m < 4; ++m) { u32x2 w; w.x = pack2(acc[m][n][0], acc[m][n][1]); w.y = pack2(acc[m][n][2], acc[m][n][3]);
                *(u32x2*)(Z + (size_t)(R0 + r0 + m * 16 + fr) * NIN + col) = w; } } }
    }
};
struct EpiQ {
    bf16_t* Q; const float* rs; const float* ropeC; const float* ropeS; int R0, C0;
    __device__ __forceinline__ void operator()(f32x4 (&acc)[4][4], int r0, int c0, int fr, int fq) const {
        const bool lat = R0 >= M_CTX;
#pragma unroll
        for (int n = 0; n < 4; ++n) {
            const int cb = C0 + c0 + n * 16; const int hcs = cb % 96;
            if (lat && hcs == 80) continue;
            const bool rot = lat && hcs == 64;
#pragma unroll
            for (int m = 0; m < 4; ++m) {
                const int rl = r0 + m * 16 + fr; const int row = R0 + rl; const float sc = rs[rl] * QSCALE;
                const f32x4 x1 = acc[m][n] * sc; bf16_t* qp = Q + (size_t)row * 768 + cb + fq * 4;
                if (rot) {
                    const f32x4 x2 = acc[m][(n + 1) & 3] * sc; const int t = (row - M_CTX) & 4095;
                    const f32x4 cv = *(const f32x4*)(ropeC + t * 16 + fq * 4), sv = *(const f32x4*)(ropeS + t * 16 + fq * 4);
                    const f32x4 o1 = x1 * cv - x2 * sv, o2 = x1 * sv + x2 * cv;
                    u32x2 w; w.x = pack2(o1[0], o1[1]); w.y = pack2(o1[2], o1[3]); *(u32x2*)qp = w;
                    w.x = pack2(o2[0], o2[1]); w.y = pack2(o2[2], o2[3]); *(u32x2*)(qp + 16) = w;
                } else { u32x2 w; w.x = pack2(x1[0], x1[1]); w.y = pack2(x1[2], x1[3]); *(u32x2*)qp = w; }
            }
        }
    }
};
struct EpiKN {
    bf16_t* Kd; const float* rs; int R0, C0;
    __device__ __forceinline__ void operator()(f32x4 (&acc)[4][4], int r0, int c0, int fr, int fq) const {
#pragma unroll
        for (int n = 0; n < 4; ++n) { const int col = C0 + c0 + n * 16 + fq * 4; const int h = col >> 6, d = col & 63;
#pragma unroll
            for (int m = 0; m < 4; ++m) { const int rl = r0 + m * 16 + fr; const f32x4 v = acc[m][n] * (rs ? rs[rl] : 1.0f);
                u32x2 w; w.x = pack2(v[0], v[1]); w.y = pack2(v[2], v[3]); *(u32x2*)(Kd + (size_t)(R0 + rl) * 768 + h * 96 + d) = w; } }
    }
};
struct EpiKV {
    bf16_t* Kd; bf16_t* Vd; const float* rs; int R0, C0; int seqshift; size_t vbase0;
    __device__ __forceinline__ void operator()(f32x4 (&acc)[4][4], int r0, int c0, int fr, int fq) const {
#pragma unroll
        for (int n = 0; n < 4; ++n) {
            const int col = C0 + c0 + n * 16 + fr;
#pragma unroll
            for (int m = 0; m < 4; ++m) {
                const int rl = r0 + m * 16 + fq * 4; const int row = R0 + rl;
                float v[4];
#pragma unroll
                for (int j = 0; j < 4; ++j) v[j] = acc[m][n][j] * (rs ? rs[rl + j] : 1.0f);
                if (col < 512) {
                    const int h = col >> 6, d = col & 63;
#pragma unroll
                    for (int j = 0; j < 4; ++j) Kd[(size_t)(row + j) * 768 + h * 96 + d] = f2bf(v[j]);
                } else {
                    const int vc = col - 512, h = vc >> 6, dv = vc & 63; const int b = row >> seqshift, t = row & ((1 << seqshift) - 1);
                    u32x2 w; w.x = pack2(v[0], v[1]); w.y = pack2(v[2], v[3]);
                    *(u32x2*)(Vd + vbase0 + ((size_t)((b * 8 + h) * 64 + dv) << seqshift) + t) = w;
                }
            }
        }
    }
};
struct EpiRes {
    float* X; const float* gate; int R0, C0;
    __device__ __forceinline__ void operator()(f32x4 (&acc)[4][4], int r0, int c0, int fr, int fq) const {
#pragma unroll
        for (int n = 0; n < 4; ++n) { const int col = C0 + c0 + n * 16 + fq * 4; const f32x4 g = *(const f32x4*)(gate + col);
#pragma unroll
            for (int m = 0; m < 4; ++m) { float* px = X + (size_t)(R0 + r0 + m * 16 + fr) * DM + col; const f32x4 xv = *(const f32x4*)px; *(f32x4*)px = ALPHA_F * xv + g * acc[m][n]; } }
    }
};
struct EpiSwi {
    bf16_t* H; int R0, C0;
    __device__ __forceinline__ void operator()(f32x4 (&acc)[4][4], int r0, int c0, int fr, int fq) const {
        const int hb = ((C0 + c0) >> 1) + fq * 4;
#pragma unroll
        for (int n = 0; n < 2; ++n)
#pragma unroll
            for (int m = 0; m < 4; ++m) { float o[4];
#pragma unroll
                for (int j = 0; j < 4; ++j) { const float g = acc[m][n][j], u = acc[m][n + 2][j]; o[j] = g * sigmoidf_(g) * u; }
                u32x2 w; w.x = pack2(o[0], o[1]); w.y = pack2(o[2], o[3]);
                *(u32x2*)(H + (size_t)(R0 + r0 + m * 16 + fr) * DFF + hb + n * 16) = w; }
    }
};

__device__ __forceinline__ void ada_unit(const P& p, int u, char* smem) {
    const int tid = opaque_tid(); const int l = u / 96, c0 = (u % 96) * 64;
    float* cs = (float*)smem;
    for (int i = tid; i < 5 * 1024; i += 256) { const int r = i >> 10, k = i & 1023; const float v = (r == 0) ? p.c_ctx[k] : p.c[(r - 1) * 1024 + k]; cs[i] = v * sigmoidf_(v); }
    __syncthreads();
    const int col = tid & 63, kq = tid >> 6;
    float s0 = 0.f, s1 = 0.f, s2 = 0.f, s3 = 0.f, s4 = 0.f;
    const float* w = p.ada_w + ((size_t)l * 1024 + kq * 256) * 6144 + c0 + col;
    const float* cq = cs + kq * 256;
    for (int k = 0; k < 256; ++k) { const float wv = w[(size_t)k * 6144]; s0 += cq[k] * wv; s1 += cq[1024 + k] * wv; s2 += cq[2048 + k] * wv; s3 += cq[3072 + k] * wv; s4 += cq[4096 + k] * wv; }
    float* red = cs + 5 * 1024;
    red[(kq * 5 + 0) * 64 + col] = s0; red[(kq * 5 + 1) * 64 + col] = s1; red[(kq * 5 + 2) * 64 + col] = s2; red[(kq * 5 + 3) * 64 + col] = s3; red[(kq * 5 + 4) * 64 + col] = s4;
    __syncthreads();
    for (int o = tid; o < 320; o += 256) { const int i = o >> 6, cc = o & 63;
        const float v = red[(0 * 5 + i) * 64 + cc] + red[(1 * 5 + i) * 64 + cc] + red[(2 * 5 + i) * 64 + cc] + red[(3 * 5 + i) * 64 + cc] + p.ada_b[l * 6144 + c0 + cc];
        p.mod[((size_t)l * 5 + i) * 6144 + c0 + cc] = v; }
    __syncthreads();
}
__device__ __forceinline__ int map_col(int kind, int n) {
    if (kind == 1) { const int blk = n >> 6, r = n & 63; return r < 32 ? blk * 32 + r : DFF + blk * 32 + (r - 32); }
    if (kind == 2) { if (n < 512) return (n >> 6) * 128 + (n & 63); const int vc = n - 512; return (vc >> 6) * 128 + 64 + (vc & 63); }
    return n;
}
__device__ __forceinline__ void conv_tile(const float* src, int ldsrc, bf16_t* dst, bf16_t* dst2, int Kdst, int n0, int k0, int kind, int Nvalid, const float* kscale, char* smem) {
    const int tid = opaque_tid(); float* tile = (float*)smem;
    { const int nq = tid & 15, kq = tid >> 4; const int n = n0 + nq * 4; const int sc = (n < Nvalid) ? map_col(kind, n) : -1;
#pragma unroll
      for (int ps = 0; ps < 4; ++ps) { const int i = kq + 16 * ps;
          f32x4 v = (f32x4){0.f, 0.f, 0.f, 0.f}; if (sc >= 0) v = *(const f32x4*)(src + (size_t)(k0 + i) * ldsrc + sc);
          tile[i * 65 + nq * 4 + 0] = v[0]; tile[i * 65 + nq * 4 + 1] = v[1]; tile[i * 65 + nq * 4 + 2] = v[2]; tile[i * 65 + nq * 4 + 3] = v[3]; } }
    __syncthreads();
    { const int i2 = tid & 31, j0 = tid >> 5;
      const float ks0 = kscale ? kscale[k0 + 2 * i2] : 1.f, ks1 = kscale ? kscale[k0 + 2 * i2 + 1] : 1.f;
#pragma unroll
      for (int jj = 0; jj < 8; ++jj) { const int jx = j0 + 8 * jj; const float v0 = tile[(2 * i2) * 65 + jx], v1 = tile[(2 * i2 + 1) * 65 + jx];
          *(unsigned*)(dst + (size_t)(n0 + jx) * Kdst + k0 + 2 * i2) = pack2(v0 * ks0, v1 * ks1);
          if (dst2) *(unsigned*)(dst2 + (size_t)(n0 + jx) * Kdst + k0 + 2 * i2) = pack2(v0, v1); } }
    __syncthreads();
}
#define NCONV 3032
__device__ __forceinline__ void conv_unit(const P& p, int l, int u, char* smem) {
    const float* src; int ldsrc; bf16_t* dst; bf16_t* dst2 = nullptr; int Kdst, n0, k0, kind = 0, Nvalid; const float* kscale = nullptr;
    if (u < 544) { src = p.w_in + (size_t)l * 1024 * NIN; ldsrc = NIN; dst = p.WtIn; Kdst = 1024; n0 = (u / 16) * 64; k0 = (u % 16) * 64; Nvalid = NIN; }
    else if (u < 592) { u -= 544; src = p.q_up + (size_t)l * 256 * 768; ldsrc = 768; dst = p.WtQ; Kdst = 256; n0 = (u / 4) * 64; k0 = (u % 4) * 64; Nvalid = 768; kscale = p.q_norm + l * 256; }
    else if (u < 624) { u -= 592; src = p.kv_up + (size_t)l * 128 * 1024; ldsrc = 1024; dst = p.WtKVn; dst2 = p.WtKV; Kdst = 128; n0 = (u / 2) * 64; k0 = (u % 2) * 64; kind = 2; Nvalid = 1024; kscale = p.kv_norm + l * 128; }
    else if (u < 880) { u -= 624; src = p.w_out + (size_t)l * 1024 * 1024; ldsrc = 1024; dst = p.WtOut; Kdst = 1024; n0 = (u / 16) * 64; k0 = (u % 16) * 64; Nvalid = 1024; }
    else if (u < 2288) { u -= 880; src = p.ffn_in + (size_t)l * 1024 * 5632; ldsrc = 5632; dst = p.WtF1; Kdst = 1024; n0 = (u / 16) * 64; k0 = (u % 16) * 64; kind = 1; Nvalid = 5632; }
    else if (u < 2992) { u -= 2288; src = p.ffn_out + (size_t)l * DFF * 1024; ldsrc = 1024; dst = p.WtF2; Kdst = DFF; n0 = (u / 44) * 64; k0 = (u % 44) * 64; Nvalid = 1024; }
    else if (u < 3008) { u -= 2992; const float* sp = p.gm_ws + (size_t)l * 65536 + u * 4096; bf16_t* d = p.WsB + u * 4096; for (int i = threadIdx.x; i < 4096; i += 256) d[i] = f2bf(sp[i]); return; }
    else if (u < 3016) { u -= 3008; const int d = u >> 2; src = p.rw_w2 + ((size_t)l * 2 + d) * 64 * 256; ldsrc = 256; dst = p.W2t + d * 256 * 64; Kdst = 64; n0 = (u & 3) * 64; k0 = 0; Nvalid = 256; }
    else if (u < 3024) { u -= 3016; const int d = u >> 2; src = p.rw_a2 + ((size_t)l * 2 + d) * 64 * 256; ldsrc = 256; dst = p.A2t + d * 256 * 64; Kdst = 64; n0 = (u & 3) * 64; k0 = 0; Nvalid = 256; }
    else { u -= 3024; src = p.rw_g2 + (size_t)l * 128 * 256; ldsrc = 256; dst = p.G2t; Kdst = 128; n0 = (u / 2) * 64; k0 = (u % 2) * 64; Nvalid = 256; }
    conv_tile(src, ldsrc, dst, dst2, Kdst, n0, k0, kind, Nvalid, kscale, smem);
}
__device__ __forceinline__ void misc0_unit(const P& p, int u) {
    const int tid = opaque_tid();
    if (u < 16) {
        for (int e = tid; e < 4096; e += 256) { const int idx = u * 4096 + e; const int t = idx >> 4, i = idx & 15;
            const float pos = (float)((i < 8) ? (t >> 6) : (t & 63)); const float inv = exp2f(-(float)(i & 7) * 1.6609640474436813f);
            const float ang = pos * inv; const float kf = rintf(ang * 0.15915494309189535f);
            float r = fmaf(-kf, 6.28318548202514648f, ang); r = fmaf(-kf, -1.74845553e-7f, r);
            p.ropeC[idx] = __cosf(r); p.ropeS[idx] = __sinf(r); }
    } else {
        const int v = u - 16;
        for (int e = tid; e < 4096; e += 256) { const int idx = v * 4096 + e;
            const int c = idx & 127, t = (idx >> 7) & 511, b = (idx >> 16) & 3, l = idx >> 18;
            p.CkvB[idx] = f2bf(p.cache_ckv[(((size_t)b * 4 + l) * 512 + t) * 128 + c]); }
    }
}

__device__ __forceinline__ void ln_phase(const P& p, int l, int which) {
    const int tid = opaque_tid(), lane = tid & 63, wid = tid >> 6;
    const float* g = which == 1 ? p.ln1_g + l * DM : p.ln2_g + l * DM; const float* bb = which == 1 ? p.ln1_b + l * DM : p.ln2_b + l * DM;
    const int ml = which == 2 ? l + 1 : l; const int shoff = which == 1 ? 3072 : 0, scoff = which == 1 ? 4096 : 1024;
    const bool dohb = !(which == 2 && l == 3);
    for (int row = blockIdx.x * 4 + wid; row < M_ALL; row += gridDim.x * 4) {
        float* xr = p.out + (size_t)row * DM;
        const float* src = which == 0 ? (row < M_CTX ? p.x_prompt + (size_t)row * DM : p.x_sample + (size_t)(row - M_CTX) * DM) : xr;
        f32x4 v[4];
#pragma unroll
        for (int i = 0; i < 4; ++i) v[i] = *(const f32x4*)(src + lane * 4 + 256 * i);
        if (which != 0) {
            float s = 0.f;
#pragma unroll
            for (int i = 0; i < 4; ++i) s += (v[i][0] + v[i][1]) + (v[i][2] + v[i][3]);
            s = red16(s); s += __shfl_xor(s, 16); s += __shfl_xor(s, 32);
            const float mu = s * (1.0f / 1024.0f); float q = 0.f;
#pragma unroll
            for (int i = 0; i < 4; ++i) { const f32x4 d = v[i] - mu; q += (d[0] * d[0] + d[1] * d[1]) + (d[2] * d[2] + d[3] * d[3]); }
            q = red16(q); q += __shfl_xor(q, 16); q += __shfl_xor(q, 32);
            const float rstd = rsqrtf(q * (1.0f / 1024.0f) + 1e-5f);
#pragma unroll
            for (int i = 0; i < 4; ++i) { const f32x4 gg = *(const f32x4*)(g + lane * 4 + 256 * i), bv = *(const f32x4*)(bb + lane * 4 + 256 * i); v[i] = (v[i] - mu) * rstd * gg + bv; }
        }
#pragma unroll
        for (int i = 0; i < 4; ++i) *(f32x4*)(xr + lane * 4 + 256 * i) = v[i];
        if (dohb) {
            const float* md = p.mod + ((size_t)ml * 5 + modrow_of(row)) * 6144;
#pragma unroll
            for (int i = 0; i < 4; ++i) { const f32x4 sh = *(const f32x4*)(md + shoff + lane * 4 + 256 * i), sc = *(const f32x4*)(md + scoff + lane * 4 + 256 * i);
                const f32x4 h = v[i] * (1.0f + sc) + sh; u32x2 w; w.x = pack2(h[0], h[1]); w.y = pack2(h[2], h[3]);
                *(u32x2*)(p.hbmix + (size_t)row * DM + lane * 4 + 256 * i) = w; }
        }
    }
}

__device__ __forceinline__ void rwprep_unit(const P& p, int l, int u, char* smem) {
    const int tid = opaque_tid(), lane = tid & 63, wid = tid >> 6, fr = lane & 15, fq = lane >> 4;
    const int R0 = u * 64;
    const int ss = R0 < M_CTX ? (R0 & ~255) : M_CTX + ((R0 - M_CTX) & ~4095); const int se = ss + (R0 < M_CTX ? 256 : 4096);
    bf16_t* XW = (bf16_t*)smem; bf16_t* XA = XW + 64 * 136; bf16_t* XG = XA + 64 * 136;
    const float* cw = p.rw_conv + (size_t)l * 3 * 1152;
    for (int it = tid; it < 1152; it += 256) {
        const int cc = it % 144, tg = it / 144; const int c = cc * 8;
        float w0[8], w1[8], w2[8];
#pragma unroll
        for (int i = 0; i < 8; ++i) { w0[i] = cw[c + i]; w1[i] = cw[1152 + c + i]; w2[i] = cw[2304 + c + i]; }
        const int rfirst = R0 + tg * 8;
        u32x4 rows[10];
#pragma unroll
        for (int i = 0; i < 10; ++i) { const int r = rfirst - 1 + i; rows[i] = (u32x4){0u, 0u, 0u, 0u};
            if (r >= ss && r < se) rows[i] = *(const u32x4*)(p.Z + (size_t)r * NIN + c); }
#pragma unroll
        for (int tt = 0; tt < 8; ++tt) {
            const int row = rfirst + tt;
            const u32x4 prev = rows[tt], cur = rows[tt + 1], nxt = rows[tt + 2];
            float o[8];
#pragma unroll
            for (int i = 0; i < 4; ++i) {
                o[2 * i] = w0[2 * i] * lo_bf(prev[i]) + w1[2 * i] * lo_bf(cur[i]) + w2[2 * i] * lo_bf(nxt[i]);
                o[2 * i + 1] = w0[2 * i + 1] * hi_bf(prev[i]) + w1[2 * i + 1] * hi_bf(cur[i]) + w2[2 * i + 1] * hi_bf(nxt[i]);
            }
            if (c >= 768 && c < 896) {
#pragma unroll
                for (int i = 0; i < 8; ++i) o[i] = tanhf_(o[i]);
            } else if (c >= 1024) {
#pragma unroll
                for (int i = 0; i < 8; ++i) o[i] = sigmoidf_(o[i]);
            }
            u32x4 w; w.x = pack2(o[0], o[1]); w.y = pack2(o[2], o[3]); w.z = pack2(o[4], o[5]); w.w = pack2(o[6], o[7]);
            const int tl = tg * 8 + tt;
            if (c < 768) *(u32x4*)(p.RKV + (size_t)row * 768 + c) = w;
            else if (c < 896) *(u32x4*)(XW + tl * 136 + (c - 768)) = w;
            else if (c < 1024) *(u32x4*)(XA + tl * 136 + (c - 896)) = w;
            else *(u32x4*)(XG + tl * 136 + (c - 1024)) = w;
        }
    }
    __syncthreads();
#pragma unroll 1
    for (int mh = 0; mh < 10; ++mh) {
        const int mat = mh >> 1, nh = mh & 1;
        const int d = mat & 1; const bf16_t* As; const bf16_t* Bw; int kofs, nks, ldw;
        if (mat < 2) { As = XW; Bw = p.W2t + d * 256 * 64; kofs = d * 64; nks = 2; ldw = 64; }
        else if (mat < 4) { As = XA; Bw = p.A2t + d * 256 * 64; kofs = d * 64; nks = 2; ldw = 64; }
        else { As = XG; Bw = p.G2t; kofs = 0; nks = 4; ldw = 128; }
        f32x4 acc[4][2];
#pragma unroll
        for (int m = 0; m < 4; ++m)
#pragma unroll
            for (int n = 0; n < 2; ++n) acc[m][n] = (f32x4){0.f, 0.f, 0.f, 0.f};
        bf16x8 bw[4][2];
#pragma unroll
        for (int ks = 0; ks < 4; ++ks)
#pragma unroll
            for (int n = 0; n < 2; ++n) bw[ks][n] = *(const bf16x8*)(Bw + (size_t)(wid * 64 + nh * 32 + n * 16 + fr) * ldw + (ks < nks ? ks : 0) * 32 + fq * 8);
#pragma unroll
        for (int ks = 0; ks < 4; ++ks) {
            if (ks < nks) {
                bf16x8 af[4];
#pragma unroll
                for (int m = 0; m < 4; ++m) af[m] = *(const bf16x8*)(As + (m * 16 + fr) * 136 + kofs + ks * 32 + fq * 8);
#pragma unroll
                for (int m = 0; m < 4; ++m)
#pragma unroll
                    for (int n = 0; n < 2; ++n) acc[m][n] = __builtin_amdgcn_mfma_f32_16x16x32_bf16(bw[ks][n], af[m], acc[m][n], 0, 0, 0);
            }
        }
#pragma unroll
        for (int n = 0; n < 2; ++n) {
            const int c = wid * 64 + nh * 32 + n * 16 + fq * 4;
            f32x4 bias = (f32x4){0.f, 0.f, 0.f, 0.f}; if (mat < 2) bias = *(const f32x4*)(p.rw_w0 + (l * 2 + d) * 256 + c); else if (mat < 4) bias = *(const f32x4*)(p.rw_a0 + (l * 2 + d) * 256 + c);
            bf16_t* dst; float mul;
            if (mat < 2) { dst = p.Ee + ((size_t)d * M_ALL + R0) * 256 + c; mul = 0.6065306597126334f; }
            else if (mat < 4) { dst = p.Aa + ((size_t)d * M_ALL + R0) * 256 + c; mul = 1.0f; }
            else { dst = p.Gg + (size_t)R0 * 256 + c; mul = 1.0f; }
#pragma unroll
            for (int m = 0; m < 4; ++m) {
                float o[4];
#pragma unroll
                for (int j = 0; j < 4; ++j) { const float x = acc[m][n][j] + bias[j]; o[j] = mat < 4 ? mul * sigmoidf_(x) : x; }
                u32x2 w; w.x = pack2(o[0], o[1]); w.y = pack2(o[2], o[3]);
                *(u32x2*)(dst + (size_t)(m * 16 + fr) * 256) = w;
            }
        }
    }
    __syncthreads();
}
__device__ __forceinline__ void rowscale128(const bf16_t* Z, int R0, int zoff, int ncols, float eps, float* rs) {
    const int tid = opaque_tid(); const int r = tid >> 1, half = tid & 1; const int per = ncols >> 1;
    const bf16_t* zp = Z + (size_t)(R0 + r) * NIN + zoff + half * per;
    float ss = 0.f;
    for (int i = 0; i < per; i += 8) { const u32x4 w = *(const u32x4*)(zp + i);
#pragma unroll
        for (int q = 0; q < 4; ++q) { const float a = lo_bf(w[q]), b = hi_bf(w[q]); ss += a * a + b * b; } }
    ss = dpp_add<0xB1>(ss);
    if (half == 0) rs[r] = rsqrtf(ss / (float)ncols + eps);
}
__device__ __forceinline__ void small_unit(const P& p, int l, int u) {
    const int tid = opaque_tid(), sub = tid >> 5, li = tid & 31;
    if (u < 2560) {
        const int row = u * 8 + sub; const bf16_t* zr = p.Z + (size_t)row * NIN;
        const u32x2 w = *(const u32x2*)(zr + ZKV + li * 4);
        const float z0 = lo_bf(w.x), z1 = hi_bf(w.x), z2 = lo_bf(w.y), z3 = hi_bf(w.y);
        float ss = z0 * z0 + z1 * z1 + z2 * z2 + z3 * z3; ss = red16(ss); ss += __shfl_xor(ss, 16);
        const float rsv = rsqrtf(ss * (1.0f / 128.0f) + 1e-6f);
        const float x1 = bf2f(zr[ZKR + (li & 15)]), x2 = bf2f(zr[ZKR + 16 + (li & 15)]);
        float val;
        if (row < M_CTX) {
            const int b = row >> 8, t = row & 255; const size_t o = ((size_t)(b * 4 + l) * 256 + t);
            const f32x4 g = *(const f32x4*)(p.kv_norm + l * 128 + li * 4);
            *(f32x4*)(p.out + 20971520 + o * 128 + li * 4) = (f32x4){z0 * rsv * g[0], z1 * rsv * g[1], z2 * rsv * g[2], z3 * rsv * g[3]};
            val = li < 16 ? x1 : x2;
            p.out[20971520 + 2097152 + o * 32 + li] = val;
        } else {
            const int t = (row - M_CTX) & 4095; const float cv = p.ropeC[t * 16 + (li & 15)], sv = p.ropeS[t * 16 + (li & 15)];
            val = li < 16 ? x1 * cv - x2 * sv : x1 * sv + x2 * cv;
        }
        const bf16_t bv = f2bf(val);
#pragma unroll
        for (int h = 0; h < 8; ++h) p.Kb[(size_t)row * 768 + h * 96 + 64 + li] = bv;
    } else {
        const int r = (u - 2560) * 8 + sub; const int b = r >> 9, t = r & 511;
        const bf16_t bv = f2bf(p.cache_krope[((size_t)(b * 4 + l) * 512 + t) * 32 + li]);
#pragma unroll
        for (int h = 0; h < 8; ++h) p.Kc[(size_t)r * 768 + h * 96 + 64 + li] = bv;
    }
}
__device__ __forceinline__ void gmlp_unit(const P& p, int l, int u, char* smem) {
    const int tid = opaque_tid(), lane = tid & 63, wid = tid >> 6, fr = lane & 15, fq = lane >> 4;
    const int R0 = (u >> 2) * 128, g = u & 3;
    bf16_t* VnT = (bf16_t*)smem;
    bf16x8 wsf[4][2];
    { const bf16_t* Wg0 = p.WsB + g * 128 * 128;
#pragma unroll
      for (int ks = 0; ks < 4; ++ks)
#pragma unroll
        for (int m = 0; m < 2; ++m) wsf[ks][m] = *(const bf16x8*)(Wg0 + (wid * 32 + m * 16 + fr) * 128 + ks * 32 + fq * 8); }
    {
        const int tok = tid >> 1, half = tid & 1; const bf16_t* zp = p.Z + (size_t)(R0 + tok) * NIN + ZV + g * 64 + half * 32;
        float x[32];
#pragma unroll
        for (int i = 0; i < 4; ++i) { const u32x4 w = *(const u32x4*)(zp + i * 8);
#pragma unroll
            for (int q = 0; q < 4; ++q) { x[i * 8 + 2 * q] = geluf_(lo_bf(w[q])); x[i * 8 + 2 * q + 1] = geluf_(hi_bf(w[q])); } }
        float s = 0.f;
#pragma unroll
        for (int i = 0; i < 32; ++i) s += x[i];
        s = dpp_add<0xB1>(s); const float mu = s * (1.0f / 64.0f);
        float q2 = 0.f;
#pragma unroll
        for (int i = 0; i < 32; ++i) { const float d = x[i] - mu; q2 += d * d; }
        q2 = dpp_add<0xB1>(q2); const float rstd = rsqrtf(q2 * (1.0f / 64.0f) + 1e-5f);
        const float* gg = p.gm_g + l * 256 + g * 64 + half * 32; const float* gb = p.gm_b + l * 256 + g * 64 + half * 32;
#pragma unroll
        for (int i = 0; i < 32; ++i) VnT[(half * 32 + i) * 136 + tok] = f2bf((x[i] - mu) * rstd * gg[i] + gb[i]);
    }
    __syncthreads();
    f32x4 acc[2][4];
#pragma unroll
    for (int m = 0; m < 2; ++m)
#pragma unroll
        for (int n = 0; n < 4; ++n) acc[m][n] = (f32x4){0.f, 0.f, 0.f, 0.f};
#pragma unroll
    for (int ks = 0; ks < 4; ++ks) {
        bf16x8 bfr[4];
#pragma unroll
        for (int n = 0; n < 4; ++n) bfr[n] = *(const bf16x8*)(VnT + (n * 16 + fr) * 136 + ks * 32 + fq * 8);
#pragma unroll
        for (int m = 0; m < 2; ++m)
#pragma unroll
            for (int n = 0; n < 4; ++n) acc[m][n] = __builtin_amdgcn_mfma_f32_16x16x32_bf16(bfr[n], wsf[ks][m], acc[m][n], 0, 0, 0);
    }
#pragma unroll
    for (int m = 0; m < 2; ++m) {
        const int pp = wid * 32 + m * 16 + fr; const float bs = p.gm_bs[l * 512 + g * 128 + pp];
#pragma unroll
        for (int n = 0; n < 4; ++n) { const int c = n * 16 + fq * 4;
            const u32x2 zw = *(const u32x2*)(p.Z + (size_t)(R0 + pp) * NIN + ZU + g * 64 + c);
            const float u0 = geluf_(lo_bf(zw.x)), u1 = geluf_(hi_bf(zw.x)), u2 = geluf_(lo_bf(zw.y)), u3 = geluf_(hi_bf(zw.y));
            u32x2 w; w.x = pack2(u0 * (acc[m][n][0] + bs), u1 * (acc[m][n][1] + bs)); w.y = pack2(u2 * (acc[m][n][2] + bs), u3 * (acc[m][n][3] + bs));
            *(u32x2*)(p.hbmix + (size_t)(R0 + pp) * DM + 768 + g * 64 + c) = w; }
    }
    __syncthreads();
}

__device__ __forceinline__ float swap16_add(float x) {
    auto r = __builtin_amdgcn_permlane16_swap(__float_as_uint(x), __float_as_uint(x), false, false);
    return __uint_as_float(r[0]) + __uint_as_float(r[1]);
}
#define NSCAN_LAT 256
#define NSCAN (256 + 1024)
__device__ __forceinline__ void scan_unit(const P& p, int l, int u, char* smem) {
    const int tid = opaque_tid(), lane = tid & 63, wid = tid >> 6;
    int b, T, row0; const bool lat = u < NSCAN_LAT;
    if (lat) { b = u >> 6; T = 4096; row0 = M_CTX + b * 4096; } else { b = (u - NSCAN_LAT) >> 6; T = 256; row0 = b * 256; }
    const int h = (u >> 4) & 3, d = (u >> 3) & 1, rsl = u & 7;
    float* W = (float*)smem; float* NKK = W + 2048; float* KKA = NKK + 2048; float* KD = KKA + 2048; float* RR = KD + 2048; float* VS = RR + 2048; float* OUTP = VS + 256;
    const int rl = lane >> 5, kq = lane & 31; const int r8 = wid * 2 + rl; const int row = rsl * 8 + r8;
    f32x2 S = (f32x2){0.f, 0.f};
    const size_t stoff = ((((size_t)b * 4 + l) * 2 + d) * 4 + h) * 4096 + row * 64 + kq * 2;
    if (lat) S = *(const f32x2*)(p.state_rwkv + stoff);
    const int tok = tid >> 3, cg8 = tid & 7;
    float kkp[8], kap[8];
#pragma unroll
    for (int i = 0; i < 8; ++i) { kkp[i] = p.rw_kk[l * 256 + h * 64 + cg8 * 8 + i]; kap[i] = p.rw_ka[l * 256 + h * 64 + cg8 * 8 + i]; }
    const int nch = T >> 5;
    u32x4 r8v, k8, e8, a8, v8;
    int grow, grow_prev = 0; float oreg = 0.f;
    {
        const int sidx = tok; const int t = d ? T - 1 - sidx : sidx; grow = row0 + t;
        r8v = *(const u32x4*)(p.RKV + (size_t)grow * 768 + h * 64 + cg8 * 8);
        k8 = *(const u32x4*)(p.RKV + (size_t)grow * 768 + 256 + h * 64 + cg8 * 8);
        v8 = *(const u32x4*)(p.RKV + (size_t)grow * 768 + 512 + h * 64 + rsl * 8);
        e8 = *(const u32x4*)(p.Ee + ((size_t)d * M_ALL + grow) * 256 + h * 64 + cg8 * 8);
        a8 = *(const u32x4*)(p.Aa + ((size_t)d * M_ALL + grow) * 256 + h * 64 + cg8 * 8);
    }
    for (int ch = 0; ch < nch; ++ch) {
        {
            float kf[8], kkv[8], rf[8], ef[8], af[8];
#pragma unroll
            for (int q = 0; q < 4; ++q) { kf[2 * q] = lo_bf(k8[q]); kf[2 * q + 1] = hi_bf(k8[q]); rf[2 * q] = lo_bf(r8v[q]); rf[2 * q + 1] = hi_bf(r8v[q]);
                ef[2 * q] = lo_bf(e8[q]); ef[2 * q + 1] = hi_bf(e8[q]); af[2 * q] = lo_bf(a8[q]); af[2 * q + 1] = hi_bf(a8[q]); }
            float ss = 0.f;
#pragma unroll
            for (int i = 0; i < 8; ++i) { kkv[i] = kf[i] * kkp[i]; ss += kkv[i] * kkv[i]; }
            ss = red8(ss);
            const float inv = rsqrtf(fmaxf(ss, 1e-24f));
            f32x4 o0, o1; const int base = tok * 64 + cg8 * 8;
#pragma unroll
            for (int i = 0; i < 4; ++i) { o0[i] = __expf(-ef[i]); o1[i] = __expf(-ef[4 + i]); }
            *(f32x4*)(W + base) = o0; *(f32x4*)(W + base + 4) = o1;
#pragma unroll
            for (int i = 0; i < 4; ++i) { o0[i] = -kkv[i] * inv; o1[i] = -kkv[4 + i] * inv; }
            *(f32x4*)(NKK + base) = o0; *(f32x4*)(NKK + base + 4) = o1;
#pragma unroll
            for (int i = 0; i < 4; ++i) { o0[i] = kkv[i] * inv * af[i]; o1[i] = kkv[4 + i] * inv * af[4 + i]; }
            *(f32x4*)(KKA + base) = o0; *(f32x4*)(KKA + base + 4) = o1;
#pragma unroll
            for (int i = 0; i < 4; ++i) { o0[i] = kf[i] * (1.0f + (af[i] - 1.0f) * kap[i]); o1[i] = kf[4 + i] * (1.0f + (af[4 + i] - 1.0f) * kap[4 + i]); }
            *(f32x4*)(KD + base) = o0; *(f32x4*)(KD + base + 4) = o1;
#pragma unroll
            for (int i = 0; i < 4; ++i) { o0[i] = rf[i]; o1[i] = rf[4 + i]; }
            *(f32x4*)(RR + base) = o0; *(f32x4*)(RR + base + 4) = o1;
            if (cg8 == 0) {
#pragma unroll
                for (int q = 0; q < 4; ++q) { VS[tok * 8 + 2 * q] = lo_bf(v8[q]); VS[tok * 8 + 2 * q + 1] = hi_bf(v8[q]); }
            }
        }
        __syncthreads();
        if (ch > 0) p.ydir[((size_t)d * M_ALL + grow_prev) * 256 + h * 64 + rsl * 8 + cg8] = oreg;
        grow_prev = grow;
        if (ch + 1 < nch) {
            const int sidx = (ch + 1) * 32 + tok; const int t = d ? T - 1 - sidx : sidx; grow = row0 + t;
            r8v = *(const u32x4*)(p.RKV + (size_t)grow * 768 + h * 64 + cg8 * 8);
            k8 = *(const u32x4*)(p.RKV + (size_t)grow * 768 + 256 + h * 64 + cg8 * 8);
            v8 = *(const u32x4*)(p.RKV + (size_t)grow * 768 + 512 + h * 64 + rsl * 8);
            e8 = *(const u32x4*)(p.Ee + ((size_t)d * M_ALL + grow) * 256 + h * 64 + cg8 * 8);
            a8 = *(const u32x4*)(p.Aa + ((size_t)d * M_ALL + grow) * 256 + h * 64 + cg8 * 8);
        }
        {
            const float* Wq = W + kq * 2; const float* NKq = NKK + kq * 2; const float* KAq = KKA + kq * 2; const float* KDq = KD + kq * 2; const float* RRq = RR + kq * 2; const float* VSq = VS + r8;
            float* OPq = OUTP + r8 * 32 + kq;
            f32x2 wv[4], nkv[4], kav[4], kdv[4], rrv[4]; float vv[4];
#define SCAN_LD(slot, st) do { wv[slot] = *(const f32x2*)(Wq + (st) * 64); nkv[slot] = *(const f32x2*)(NKq + (st) * 64); kav[slot] = *(const f32x2*)(KAq + (st) * 64); \
        kdv[slot] = *(const f32x2*)(KDq + (st) * 64); rrv[slot] = *(const f32x2*)(RRq + (st) * 64); vv[slot] = VSq[(st) * 8]; } while (0)
            __builtin_amdgcn_s_setprio(3);
            SCAN_LD(0, 0); SCAN_LD(1, 1); SCAN_LD(2, 2);
#pragma unroll
            for (int s = 0; s < 32; ++s) {
                if (s + 3 < 32) SCAN_LD((s + 3) & 3, s + 3);
                const f32x2 w = wv[s & 3], nk = nkv[s & 3], ka = kav[s & 3], kd = kdv[s & 3], rr = rrv[s & 3]; const float v = vv[s & 3];
                float pd = fmaf(S[1], nk[1], S[0] * nk[0]);
                pd = red16(pd); pd = swap16_add(pd);
                S[0] = fmaf(S[0], w[0], fmaf(pd, ka[0], v * kd[0]));
                S[1] = fmaf(S[1], w[1], fmaf(pd, ka[1], v * kd[1]));
                OPq[s * 256] = fmaf(S[1], rr[1], S[0] * rr[0]);
            }
            __builtin_amdgcn_s_setprio(0);
        }
        __syncthreads();
        {
            const float* op = OUTP + (tok * 8 + cg8) * 32;
            f32x4 a0 = *(const f32x4*)(op), a1 = *(const f32x4*)(op + 4), a2 = *(const f32x4*)(op + 8), a3 = *(const f32x4*)(op + 12);
            f32x4 b0 = *(const f32x4*)(op + 16), b1 = *(const f32x4*)(op + 20), b2 = *(const f32x4*)(op + 24), b3 = *(const f32x4*)(op + 28);
            a0 = ((a0 + a1) + (a2 + a3)) + ((b0 + b1) + (b2 + b3));
            oreg = (a0[0] + a0[1]) + (a0[2] + a0[3]);
        }
    }
    p.ydir[((size_t)d * M_ALL + grow_prev) * 256 + h * 64 + rsl * 8 + cg8] = oreg;
    if (!lat) *(f32x2*)(p.out + 20971520 + 2097152 + 524288 + stoff) = S;
    __syncthreads();
}

#ifndef ATT_THR
#define ATT_THR 8.0f
#endif
#define KS_STRIDE 104
#define VS_STRIDE 68
#define KS_BYTES (64 * KS_STRIDE * 2)
#define ATT_STAGE (KS_BYTES + 64 * VS_STRIDE * 2)
__device__ __forceinline__ void attn_unit(const P& p, int u, char* smem) {
    const int tid = opaque_tid(), lane = tid & 63, wid = tid >> 6, q = lane & 31, hf = lane >> 5;
    int b, h, qt, qrow0, krow0, nown, ntot, Tv; size_t vbase, vcbase = 0; int kcrow0 = 0;
    if (u < 1024) { b = u >> 8; h = (u >> 5) & 7; qt = u & 31; krow0 = M_CTX + b * 4096; qrow0 = krow0 + qt * 128; nown = 64; ntot = 72; Tv = 4096;
        vbase = 2097152 + (size_t)(b * 8 + h) * 64 * 4096; kcrow0 = b * 512; vcbase = (size_t)(b * 8 + h) * 64 * 512; }
    else { const int v = u - 1024; b = v >> 4; h = (v >> 1) & 7; qt = v & 1; krow0 = b * 256; qrow0 = krow0 + qt * 128; nown = 4; ntot = 4; Tv = 256; vbase = (size_t)(b * 8 + h) * 64 * 256; }
    bf16x8 qf[6];
    { const bf16_t* qp = p.Qb + (size_t)(qrow0 + wid * 32 + q) * 768 + h * 96 + hf * 8;
#pragma unroll
      for (int ks = 0; ks < 6; ++ks) qf[ks] = *(const bf16x8*)(qp + ks * 16); }
    f32x16 oT[2];
#pragma unroll
    for (int i = 0; i < 16; ++i) { oT[0][i] = 0.f; oT[1][i] = 0.f; }
    float mref = 0.f, lrun = 0.f; f32x16 negm;
#pragma unroll
    for (int i = 0; i < 16; ++i) negm[i] = 0.f;
    u32x4 rk[3], rv[2];
    int krow[3], kc[3];
#pragma unroll
    for (int i = 0; i < 3; ++i) { const int c = tid + 256 * i; krow[i] = c / 12; kc[i] = c % 12; }
    const int vdv0 = tid >> 3, vkc = tid & 7;
#define ATT_LOAD(kt) do { const bf16_t* kptr; const bf16_t* vptr; int vstr; \
        if ((kt) < nown) { kptr = p.Kb + (size_t)(krow0 + (kt) * 64) * 768 + h * 96; vptr = p.Vt + vbase + (kt) * 64; vstr = Tv; } \
        else { kptr = p.Kc + (size_t)(kcrow0 + ((kt) - nown) * 64) * 768 + h * 96; vptr = p.Vtc + vcbase + ((kt) - nown) * 64; vstr = 512; } \
        _Pragma("unroll") for (int i = 0; i < 3; ++i) rk[i] = *(const u32x4*)(kptr + (size_t)krow[i] * 768 + kc[i] * 8); \
        _Pragma("unroll") for (int i = 0; i < 2; ++i) rv[i] = *(const u32x4*)(vptr + (size_t)(vdv0 + 32 * i) * vstr + vkc * 8); } while (0)
#define ATT_STORE(buf) do { char* Ks_ = smem + (buf) * ATT_STAGE; char* Vs_ = Ks_ + KS_BYTES; \
        _Pragma("unroll") for (int i = 0; i < 3; ++i) *(u32x4*)(Ks_ + (krow[i] * KS_STRIDE + kc[i] * 8) * 2) = rk[i]; \
        _Pragma("unroll") for (int i = 0; i < 2; ++i) { char* vd_ = Vs_ + ((vdv0 + 32 * i) * VS_STRIDE + vkc * 8) * 2; *(u32x2*)vd_ = (u32x2){rv[i].x, rv[i].y}; *(u32x2*)(vd_ + 8) = (u32x2){rv[i].z, rv[i].w}; } } while (0)
    ATT_LOAD(0); ATT_STORE(0);
    __syncthreads();
    for (int kt = 0; kt < ntot; ++kt) {
        const bool more = kt + 1 < ntot;
        if (more) ATT_LOAD(kt + 1);
        const char* Ks = smem + (kt & 1) * ATT_STAGE; const char* Vs = Ks + KS_BYTES;
        f32x16 sT[2];
#pragma unroll
        for (int kb = 0; kb < 2; ++kb)
#pragma unroll
            for (int ks = 0; ks < 6; ++ks) { const bf16x8 kf = *(const bf16x8*)(Ks + ((kb * 32 + q) * KS_STRIDE + ks * 16 + hf * 8) * 2);
                sT[kb] = __builtin_amdgcn_mfma_f32_32x32x16_bf16(kf, qf[ks], ks == 0 ? negm : sT[kb], 0, 0, 0); }
        bf16x8 pf[2][2]; float psum0 = 0.f;
#define ATT_EXP(kb_, acc_) do { _Pragma("unroll") for (int s_ = 0; s_ < 2; ++s_) { float e_[8]; \
            _Pragma("unroll") for (int j_ = 0; j_ < 8; ++j_) { e_[j_] = __builtin_amdgcn_exp2f(sT[kb_][8 * s_ + j_]); acc_ += e_[j_]; } \
            u32x4 w_; w_.x = pack2(e_[0], e_[1]); w_.y = pack2(e_[2], e_[3]); w_.z = pack2(e_[4], e_[5]); w_.w = pack2(e_[6], e_[7]); \
            pf[kb_][s_] = __builtin_bit_cast(bf16x8, w_); } } while (0)
        ATT_EXP(0, psum0);
        float mx = sT[0][0];
#pragma unroll
        for (int i = 1; i < 16; ++i) mx = fmaxf(mx, sT[0][i]);
#pragma unroll
        for (int i = 0; i < 16; ++i) mx = fmaxf(mx, sT[1][i]);
        { auto r_ = __builtin_amdgcn_permlane32_swap(__float_as_uint(mx), __float_as_uint(mx), false, false);
          mx = fmaxf(__uint_as_float(r_[0]), __uint_as_float(r_[1])); }
        const bool first = (kt == 0);
        if (first || __any(mx > ATT_THR)) {
            const float delta = first ? mx : ((mx > ATT_THR) ? mx : 0.f);
            const float alpha = first ? 0.f : __builtin_amdgcn_exp2f(-delta);
            mref += delta; lrun *= alpha;
#pragma unroll
            for (int i = 0; i < 16; ++i) { sT[0][i] -= delta; sT[1][i] -= delta; oT[0][i] *= alpha; oT[1][i] *= alpha; negm[i] = -mref; }
            psum0 = 0.f; ATT_EXP(0, psum0);
        }
        float psum1 = 0.f;
        ATT_EXP(1, psum1);
        lrun += psum0 + psum1;
#pragma unroll
        for (int kb = 0; kb < 2; ++kb)
#pragma unroll
            for (int s = 0; s < 2; ++s)
#pragma unroll
                for (int db = 0; db < 2; ++db) {
                    const char* vp = Vs + ((db * 32 + q) * VS_STRIDE + kb * 32 + 16 * s + 4 * hf) * 2;
                    const u32x2 lo = *(const u32x2*)vp, hi = *(const u32x2*)(vp + 16);
                    const u32x4 w = (u32x4){lo.x, lo.y, hi.x, hi.y};
                    oT[db] = __builtin_amdgcn_mfma_f32_32x32x16_bf16(__builtin_bit_cast(bf16x8, w), pf[kb][s], oT[db], 0, 0, 0);
                }
        if (more) ATT_STORE((kt + 1) & 1);
        __syncthreads();
    }
    const float lt = lrun + __shfl_xor(lrun, 32); const float inv = 1.0f / lt;
    bf16_t* op = p.hbmix + (size_t)(qrow0 + wid * 32 + q) * DM + 256 + h * 64;
#pragma unroll
    for (int db = 0; db < 2; ++db)
#pragma unroll
        for (int g = 0; g < 4; ++g) { u32x2 w; w.x = pack2(oT[db][4 * g] * inv, oT[db][4 * g + 1] * inv); w.y = pack2(oT[db][4 * g + 2] * inv, oT[db][4 * g + 3] * inv);
            *(u32x2*)(op + db * 32 + 8 * g + 4 * hf) = w; }
}

__device__ __forceinline__ void rwcomb_phase(const P& p, int l) {
    const int tid = opaque_tid(), lane = tid & 63, wid = tid >> 6; const int c = lane * 4;
    const f32x4 gng = *(const f32x4*)(p.rw_gn_g + l * 256 + c), gnb = *(const f32x4*)(p.rw_gn_b + l * 256 + c), kap = *(const f32x4*)(p.rw_ka + l * 256 + c), rkp = *(const f32x4*)(p.rw_rk + l * 256 + c);
    for (int row = blockIdx.x * 4 + wid; row < M_ALL; row += gridDim.x * 4) {
        const f32x4 y0 = *(const f32x4*)(p.ydir + (size_t)row * 256 + c), y1 = *(const f32x4*)(p.ydir + ((size_t)M_ALL + row) * 256 + c);
        f32x4 y = y0 + y1;
        float s = (y[0] + y[1]) + (y[2] + y[3]); s = red16(s); const float mu = s * (1.0f / 64.0f);
        const f32x4 dd = y - mu; float q2 = (dd[0] * dd[0] + dd[1] * dd[1]) + (dd[2] * dd[2] + dd[3] * dd[3]); q2 = red16(q2);
        const float rstd = rsqrtf(q2 * (1.0f / 64.0f) + 64e-5f);
        const f32x4 yn = dd * rstd * gng + gnb;
        const u32x2 rw = *(const u32x2*)(p.RKV + (size_t)row * 768 + c), kw = *(const u32x2*)(p.RKV + (size_t)row * 768 + 256 + c), vw = *(const u32x2*)(p.RKV + (size_t)row * 768 + 512 + c);
        const u32x2 a0w = *(const u32x2*)(p.Aa + (size_t)row * 256 + c), a1w = *(const u32x2*)(p.Aa + ((size_t)M_ALL + row) * 256 + c), gw = *(const u32x2*)(p.Gg + (size_t)row * 256 + c);
        const f32x4 r = (f32x4){lo_bf(rw.x), hi_bf(rw.x), lo_bf(rw.y), hi_bf(rw.y)}, k = (f32x4){lo_bf(kw.x), hi_bf(kw.x), lo_bf(kw.y), hi_bf(kw.y)}, v = (f32x4){lo_bf(vw.x), hi_bf(vw.x), lo_bf(vw.y), hi_bf(vw.y)};
        const f32x4 a0 = (f32x4){lo_bf(a0w.x), hi_bf(a0w.x), lo_bf(a0w.y), hi_bf(a0w.y)}, a1 = (f32x4){lo_bf(a1w.x), hi_bf(a1w.x), lo_bf(a1w.y), hi_bf(a1w.y)}, gt = (f32x4){lo_bf(gw.x), hi_bf(gw.x), lo_bf(gw.y), hi_bf(gw.y)};
        const f32x4 kds = k * (1.0f + (a0 - 1.0f) * kap) + k * (1.0f + (a1 - 1.0f) * kap);
        const f32x4 t4 = r * kds * rkp; float rk = (t4[0] + t4[1]) + (t4[2] + t4[3]); rk = red16(rk);
        const f32x4 o = (yn + rk * v) * gt;
        u32x2 w; w.x = pack2(o[0], o[1]); w.y = pack2(o[2], o[3]);
        *(u32x2*)(p.hbmix + (size_t)row * DM + c) = w;
    }
}


__device__ __forceinline__ bool xcd_tile(int i, int TT, int NT, int& mt, int& nt) {
    const int per = TT >> 3; if (i >= per) return false;
    const int t = (blockIdx.x & 7) * per + i; const int band = t / (8 * NT), rem = t - band * 8 * NT;
    nt = rem >> 3; mt = band * 8 + (rem & 7); return true;
}
__global__ void __launch_bounds__(256, 2) mega(Args a_unused) {
    extern __shared__ __attribute__((aligned(16))) char smem[];
    __shared__ uint4 xbw; __shared__ int s_unit;
    kargp_t kp = (kargp_t)__builtin_amdgcn_kernarg_segment_ptr();
    const int tid = threadIdx.x; const int G = gridDim.x;
    if (tid == 0) xbw = make_uint4(0u, 0u, 0u, 0u);
    __syncthreads();
    XcdBarrier xb;
    { const P p = getP(kp); xb = xcd_barrier_post(p.bar, (volatile LAS unsigned*)&xbw); }
    for (int u = blockIdx.x; u < 384 + NCONV + 272; u += G) {
        if (u < 384) { const P p = getP(kp); ada_unit(p, u, smem); } else if (u < 384 + NCONV) { const P p = getP(kp); conv_unit(p, 0, u - 384, smem); } else { const P p = getP(kp); misc0_unit(p, u - 384 - NCONV); }
    }
    cg::this_grid().sync();
    { const P p = getP(kp); ln_phase(p, 0, 0); }
    xcd_barrier(xb);
    float* rs = (float*)(smem + RS_OFF);
#pragma unroll 1
    for (int l = 0; l < 4; ++l) {
        for (int i = blockIdx.x >> 3; ; i += G >> 3) { int mt, nt; if (!xcd_tile(i, 80 * 17, 17, mt, nt)) break; const P p = getP(kp);
            EpiZ e{p.Z, mt * 256, nt * 128};
            gemm256(p.hbmix + (size_t)mt * 256 * DM, DM, p.WtIn + (size_t)nt * 128 * DM, DM, DM, smem, e); }
        xcd_barrier(xb);
        for (int rep2 = 0; rep2 < DUP_P2; ++rep2) {
        for (;;) {
            { const P pc = getP(kp); if (tid == 0) s_unit = atomicAdd(&pc.ctr[l * 4 + 0 + 2 * rep2], 1); }
            __syncthreads(); int u = s_unit; __syncthreads();
            if (u >= 320 + 480 + 640 + 64 + 352 + 640) break;
            if (u < 320) { const P p = getP(kp); rwprep_unit(p, l, u, smem); continue; }
            u -= 320;
            if (u < 480) { const P p = getP(kp); const int mt = u / 3, np = u % 3;
                rowscale128(p.Z, mt * 128, ZQ, 256, 1e-6f, rs);
                for (int k2 = 0; k2 < 2; ++k2) { const int nt = np * 2 + k2;
                    EpiQ e{p.Qb, rs, p.ropeC, p.ropeS, mt * 128, nt * 128};
                    gemm128<true>(p.Z + (size_t)mt * 128 * NIN + ZQ, NIN, p.WtQ + (size_t)nt * 128 * 256, 256, 256, smem, e); }
                __syncthreads(); continue; }
            u -= 480;
            if (u < 640) { const P p = getP(kp); const int mt = u >> 2, np = u & 3; const int R0 = mt * 128; const bool latr = R0 >= M_CTX;
                rowscale128(p.Z, R0, ZKV, 128, 1e-6f, rs);
                for (int k2 = 0; k2 < 2; ++k2) { const int nt = np * 2 + k2;
                    if (np < 2) { EpiKN e{latr ? p.Kb + (size_t)M_CTX * 768 : p.Kb, rs, latr ? R0 - M_CTX : R0, nt * 128};
                        gemm128<true>(p.Z + (size_t)R0 * NIN + ZKV, NIN, p.WtKVn + (size_t)nt * 128 * 128, 128, 128, smem, e); }
                    else { EpiKV e{latr ? p.Kb + (size_t)M_CTX * 768 : p.Kb, p.Vt, rs, latr ? R0 - M_CTX : R0, nt * 128, latr ? 12 : 8, latr ? (size_t)2097152 : (size_t)0};
                        gemm128<false>(p.Z + (size_t)R0 * NIN + ZKV, NIN, p.WtKVn + (size_t)nt * 128 * 128, 128, 128, smem, e); } }
                __syncthreads(); continue; }
            u -= 640;
            if (u < 64) { const P p = getP(kp); const int mt = u >> 2, np = u & 3;
                for (int k2 = 0; k2 < 2; ++k2) { const int nt = np * 2 + k2;
                    if (np < 2) { EpiKN e{p.Kc, nullptr, mt * 128, nt * 128};
                        gemm128<true>(p.CkvB + ((size_t)l * 2048 + mt * 128) * 128, 128, p.WtKV + (size_t)nt * 128 * 128, 128, 128, smem, e); }
                    else { EpiKV e{p.Kc, p.Vtc, nullptr, mt * 128, nt * 128, 9, (size_t)0};
                        gemm128<false>(p.CkvB + ((size_t)l * 2048 + mt * 128) * 128, 128, p.WtKV + (size_t)nt * 128 * 128, 128, 128, smem, e); } }
                continue; }
            u -= 64;
            if (u < 352) { const P p = getP(kp); for (int i = 0; i < 8; ++i) small_unit(p, l, u * 8 + i); continue; }
            u -= 352;
            { const P p = getP(kp); gmlp_unit(p, l, u, smem); }
        }
        xcd_barrier(xb);
        }
        for (int rep3 = 0; rep3 < DUP_P3; ++rep3) {
        for (;;) {
            { const P pc = getP(kp); if (tid == 0) s_unit = atomicAdd(&pc.ctr[l * 4 + 1 + 2 * rep3], 1); }
            __syncthreads(); int u = s_unit; __syncthreads();
            if (u >= NSCAN + 1280) break;
#ifdef PROBE_SCAN_ONLY
            if (rep3 == 1 && u >= NSCAN) break;
#endif
#ifdef PROBE_ATTN_ONLY
            if (rep3 == 1 && u < NSCAN) continue;
#endif
            if (u < NSCAN) { const P p = getP(kp); scan_unit(p, l, u, smem); } else { const P p = getP(kp); attn_unit(p, u - NSCAN, smem); }
        }
        xcd_barrier(xb);
        }
        { const P p = getP(kp); rwcomb_phase(p, l); }
        xcd_barrier(xb);
        for (int i = blockIdx.x >> 3; ; i += G >> 3) { int mt, nt; if (!xcd_tile(i, 160 * 8, 8, mt, nt)) break; const P p = getP(kp);
            EpiRes e{p.out, p.mod + ((size_t)l * 5 + modrow_of(mt * 128)) * 6144 + 2048, mt * 128, nt * 128};
            gemm128<true>(p.hbmix + (size_t)mt * 128 * DM, DM, p.WtOut + (size_t)nt * 128 * DM, DM, DM, smem, e); }
        xcd_barrier(xb);
        { const P p = getP(kp); ln_phase(p, l, 1); }
        xcd_barrier(xb);
        for (int rep5 = 0; rep5 < DUP_P5; ++rep5)
        for (int i = blockIdx.x >> 3; ; i += G >> 3) { int mt, nt; if (!xcd_tile(i, 80 * 44, 44, mt, nt)) break; const P p = getP(kp);
            EpiSwi e{p.hidden, mt * 256, nt * 128};
            gemm256(p.hbmix + (size_t)mt * 256 * DM, DM, p.WtF1 + (size_t)nt * 128 * DM, DM, DM, smem, e); }
        xcd_barrier(xb);
        for (int i = blockIdx.x >> 3; ; i += G >> 3) { int mt, nt; if (!xcd_tile(i, 160 * 8, 8, mt, nt)) break; const P p = getP(kp);
            EpiRes e{p.out, p.mod + ((size_t)l * 5 + modrow_of(mt * 128)) * 6144 + 5120, mt * 128, nt * 128};
            gemm128<true>(p.hidden + (size_t)mt * 128 * DFF, DFF, p.WtF2 + (size_t)nt * 128 * DFF, DFF, DFF, smem, e); }
        xcd_barrier(xb);
        { const P p = getP(kp); ln_phase(p, l, 2); }
        if (l < 3) { for (int u = blockIdx.x; u < NCONV; u += G) { const P p = getP(kp); conv_unit(p, l + 1, u, smem); } }
        xcd_barrier(xb);
    }
}

extern "C" void kernel_launch(void* const* d_in, const int* in_sizes, int n_in, void* d_out, int out_size, void* d_ws, size_t ws_size, hipStream_t stream) {
    static int grid_blocks = 0;
    if (!grid_blocks) {
        int dev = 0, cus = 0, per_cu = 0;
        (void)hipGetDevice(&dev);
        (void)hipDeviceGetAttribute(&cus, hipDeviceAttributeMultiprocessorCount, dev);
        (void)hipFuncSetAttribute((const void*)mega, hipFuncAttributeMaxDynamicSharedMemorySize, SMEM_BYTES);
        (void)hipOccupancyMaxActiveBlocksPerMultiprocessor(&per_cu, (const void*)mega, 256, SMEM_BYTES);
        if (per_cu > 2) per_cu = 2;
        if (per_cu < 1) per_cu = 1;
        grid_blocks = (cus * per_cu) & ~7;
    }
    if (WS_TOTAL > ws_size) { fprintf(stderr, "kernel_launch: workspace too small: need %zu have %zu\n", (size_t)WS_TOTAL, ws_size); return; }
    Args a{};
    for (int i = 0; i < 36; ++i) a.in[i] = (const float*)d_in[i];
    a.out = (float*)d_out; a.ws = (char*)d_ws;
    (void)hipMemsetAsync((char*)d_ws + OFF_BAR, 0, 16384 + 4096, stream);
    void* args[] = {&a};
    hipError_t e = hipLaunchCooperativeKernel((const void*)mega, dim3(grid_blocks), dim3(256), args, SMEM_BYTES, stream);
    if (e != hipSuccess) fprintf(stderr, "cooperative launch failed: %s (grid %d)\n", hipGetErrorString(e), grid_blocks);
}
```

```cpp
#include <hip/hip_runtime.h>
#include <hip/hip_cooperative_groups.h>
#include <cstdint>
#include <cstdio>
namespace cg = cooperative_groups;

typedef unsigned short bf16_t;
typedef short bf16x8 __attribute__((ext_vector_type(8)));
typedef float f32x4 __attribute__((ext_vector_type(4)));
typedef float f32x2 __attribute__((ext_vector_type(2)));
typedef float f32x16 __attribute__((ext_vector_type(16)));
typedef unsigned u32x4 __attribute__((ext_vector_type(4)));
typedef unsigned u32x2 __attribute__((ext_vector_type(2)));

#define M_ALL 20480
#define M_CTX 4096
#define DM 1024
#define NIN 2080
#define DFF 2816
#define ALPHA_F 1.6817928305074290f
#define QSCALE (0.10206207261596575f * 1.4426950408889634f)
#define LAS __attribute__((address_space(3)))
#ifndef DUP_P2
#define DUP_P2 1
#endif
#ifndef DUP_P3
#define DUP_P3 1
#endif
#ifndef DUP_P5
#define DUP_P5 1
#endif

#define ZQ 1152
#define ZKV 1408
#define ZKR 1536
#define ZU 1568
#define ZV 1824

#define LDS_STRIDE 72
#define TILE_BYTES (128 * LDS_STRIDE * 2)
#define RS_OFF (4 * TILE_BYTES)
#define SMEM_BYTES (RS_OFF + 3072)

struct P {
    const float *x_prompt, *x_sample, *cache_ckv, *cache_krope, *state_rwkv, *c, *c_ctx, *ada_w, *ada_b, *w_in, *rw_conv, *rw_w0, *rw_w2,
        *rw_a0, *rw_a2, *rw_g2, *rw_kk, *rw_ka, *rw_rk, *rw_gn_g, *rw_gn_b, *q_norm, *q_up, *kv_norm, *kv_up, *gm_g, *gm_b, *gm_ws, *gm_bs,
        *w_out, *ln1_g, *ln1_b, *ffn_in, *ffn_out, *ln2_g, *ln2_b;
    float* out;
    unsigned* bar; int* ctr; float* mod; float* ropeC; float* ropeS; bf16_t* CkvB;
    bf16_t *WtIn, *WtQ, *WtKVn, *WtKV, *WtOut, *WtF1, *WtF2, *WsB, *W2t, *A2t, *G2t;
    bf16_t *Z, *RKV, *Ee, *Aa, *Gg, *Qb, *Kb, *Kc, *Vt, *Vtc, *hbmix, *hidden;
    float* ydir;
};


struct Args { const float* in[36]; float* out; char* ws; };
typedef const __attribute__((address_space(4))) char* kargp_t;
constexpr size_t al256(size_t x) { return (x + 255) & ~(size_t)255; }
constexpr size_t OFF_BAR = 0;
constexpr size_t OFF_CTR = OFF_BAR + 16384;
constexpr size_t OFF_MOD = OFF_CTR + 4096;
constexpr size_t OFF_ROPEC = OFF_MOD + al256((size_t)4 * 5 * 6144 * 4);
constexpr size_t OFF_ROPES = OFF_ROPEC + 65536 * 4;
constexpr size_t OFF_CKVB = OFF_ROPES + 65536 * 4;
constexpr size_t OFF_WTIN = OFF_CKVB + (size_t)4 * 2048 * 128 * 2;
constexpr size_t OFF_WTQ = OFF_WTIN + (size_t)2176 * 1024 * 2;
constexpr size_t OFF_WTKVN = OFF_WTQ + (size_t)768 * 256 * 2;
constexpr size_t OFF_WTKV = OFF_WTKVN + (size_t)1024 * 128 * 2;
constexpr size_t OFF_WTOUT = OFF_WTKV + (size_t)1024 * 128 * 2;
constexpr size_t OFF_WTF1 = OFF_WTOUT + (size_t)1024 * 1024 * 2;
constexpr size_t OFF_WTF2 = OFF_WTF1 + (size_t)5632 * 1024 * 2;
constexpr size_t OFF_WSB = OFF_WTF2 + (size_t)1024 * DFF * 2;
constexpr size_t OFF_W2T = OFF_WSB + (size_t)65536 * 2;
constexpr size_t OFF_A2T = OFF_W2T + (size_t)2 * 256 * 64 * 2;
constexpr size_t OFF_G2T = OFF_A2T + (size_t)2 * 256 * 64 * 2;
constexpr size_t OFF_Z = OFF_G2T + (size_t)256 * 128 * 2;
constexpr size_t OFF_HIDDEN = OFF_Z;
constexpr size_t OFF_RKV = OFF_Z + al256((size_t)M_ALL * NIN * 2);
constexpr size_t OFF_EE = OFF_RKV + (size_t)M_ALL * 768 * 2;
constexpr size_t OFF_AA = OFF_EE + (size_t)2 * M_ALL * 256 * 2;
constexpr size_t OFF_GG = OFF_AA + (size_t)2 * M_ALL * 256 * 2;
constexpr size_t OFF_QB = OFF_GG + (size_t)M_ALL * 256 * 2;
constexpr size_t OFF_KB = OFF_QB + (size_t)M_ALL * 768 * 2;
constexpr size_t OFF_KC = OFF_KB + (size_t)M_ALL * 768 * 2;
constexpr size_t OFF_VT = OFF_KC + (size_t)2048 * 768 * 2;
constexpr size_t OFF_VTC = OFF_VT + (size_t)M_ALL * 512 * 2;
constexpr size_t OFF_YDIR = OFF_VTC + (size_t)2048 * 512 * 2;
constexpr size_t OFF_HBMIX = OFF_YDIR + (size_t)2 * M_ALL * 256 * 4;
constexpr size_t WS_TOTAL = OFF_HBMIX + (size_t)M_ALL * DM * 2;
static_assert(OFF_RKV + (size_t)M_ALL * 768 * 2 - OFF_HIDDEN >= (size_t)M_ALL * DFF * 2, "hidden overlay");

__device__ __forceinline__ P getP(kargp_t& kp) {
    asm volatile("" : "+s"(kp));
    typedef const float* const __attribute__((address_space(4)))* inp_t;
    inp_t in = (inp_t)kp;
    P p;
    p.x_prompt = in[0]; p.x_sample = in[1]; p.cache_ckv = in[2]; p.cache_krope = in[3]; p.state_rwkv = in[4]; p.c = in[5]; p.c_ctx = in[6];
    p.ada_w = in[7]; p.ada_b = in[8]; p.w_in = in[9]; p.rw_conv = in[10]; p.rw_w0 = in[11]; p.rw_w2 = in[12]; p.rw_a0 = in[13]; p.rw_a2 = in[14];
    p.rw_g2 = in[15]; p.rw_kk = in[16]; p.rw_ka = in[17]; p.rw_rk = in[18]; p.rw_gn_g = in[19]; p.rw_gn_b = in[20]; p.q_norm = in[21]; p.q_up = in[22];
    p.kv_norm = in[23]; p.kv_up = in[24]; p.gm_g = in[25]; p.gm_b = in[26]; p.gm_ws = in[27]; p.gm_bs = in[28]; p.w_out = in[29]; p.ln1_g = in[30];
    p.ln1_b = in[31]; p.ffn_in = in[32]; p.ffn_out = in[33]; p.ln2_g = in[34]; p.ln2_b = in[35];
    p.out = (float*)in[36]; char* ws = (char*)in[37];
    p.bar = (unsigned*)(ws + OFF_BAR); p.ctr = (int*)(ws + OFF_CTR); p.mod = (float*)(ws + OFF_MOD); p.ropeC = (float*)(ws + OFF_ROPEC); p.ropeS = (float*)(ws + OFF_ROPES);
    p.CkvB = (bf16_t*)(ws + OFF_CKVB); p.WtIn = (bf16_t*)(ws + OFF_WTIN); p.WtQ = (bf16_t*)(ws + OFF_WTQ); p.WtKVn = (bf16_t*)(ws + OFF_WTKVN); p.WtKV = (bf16_t*)(ws + OFF_WTKV);
    p.WtOut = (bf16_t*)(ws + OFF_WTOUT); p.WtF1 = (bf16_t*)(ws + OFF_WTF1); p.WtF2 = (bf16_t*)(ws + OFF_WTF2); p.WsB = (bf16_t*)(ws + OFF_WSB); p.W2t = (bf16_t*)(ws + OFF_W2T);
    p.A2t = (bf16_t*)(ws + OFF_A2T); p.G2t = (bf16_t*)(ws + OFF_G2T); p.Z = (bf16_t*)(ws + OFF_Z); p.RKV = (bf16_t*)(ws + OFF_RKV); p.Ee = (bf16_t*)(ws + OFF_EE); p.Aa = (bf16_t*)(ws + OFF_AA);
    p.Gg = (bf16_t*)(ws + OFF_GG); p.Qb = (bf16_t*)(ws + OFF_QB); p.Kb = (bf16_t*)(ws + OFF_KB); p.Kc = (bf16_t*)(ws + OFF_KC); p.Vt = (bf16_t*)(ws + OFF_VT); p.Vtc = (bf16_t*)(ws + OFF_VTC);
    p.hbmix = (bf16_t*)(ws + OFF_HBMIX); p.hidden = (bf16_t*)(ws + OFF_HIDDEN); p.ydir = (float*)(ws + OFF_YDIR);
    return p;
}

__device__ __forceinline__ float bf2f(bf16_t b) { return __uint_as_float(((unsigned)b) << 16); }
__device__ __forceinline__ unsigned pack2(float lo, float hi) { unsigned r; asm("v_cvt_pk_bf16_f32 %0, %1, %2" : "=v"(r) : "v"(lo), "v"(hi)); return r; }
__device__ __forceinline__ bf16_t f2bf(float f) { return (bf16_t)(pack2(f, 0.f) & 0xffffu); }
__device__ __forceinline__ float lo_bf(unsigned w) { return __uint_as_float(w << 16); }
__device__ __forceinline__ float hi_bf(unsigned w) { return __uint_as_float(w & 0xffff0000u); }
__device__ __forceinline__ float sigmoidf_(float x) { return __builtin_amdgcn_rcpf(1.0f + __builtin_amdgcn_exp2f(-1.4426950408889634f * x)); }
__device__ __forceinline__ float tanhf_(float x) { float e = __builtin_amdgcn_exp2f(2.8853900817779268f * x); return 1.0f - 2.0f * __builtin_amdgcn_rcpf(e + 1.0f); }
__device__ __forceinline__ float geluf_(float x) { return 0.5f * x * (1.0f + tanhf_(0.7978845608028654f * (x + 0.044715f * x * x * x))); }
template <int CTRL> __device__ __forceinline__ float dpp_add(float x) {
    int y = __builtin_amdgcn_update_dpp(0, __float_as_int(x), CTRL, 0xf, 0xf, false);
    return x + __int_as_float(y);
}
__device__ __forceinline__ float red4(float x) { x = dpp_add<0xB1>(x); x = dpp_add<0x4E>(x); return x; }
__device__ __forceinline__ float red8(float x) { x = red4(x); x = dpp_add<0x141>(x); return x; }
__device__ __forceinline__ float red16(float x) { x = red8(x); x = dpp_add<0x140>(x); return x; }
__device__ __forceinline__ int opaque_tid() { int t = threadIdx.x; asm volatile("" : "+v"(t)); return t; }
__device__ __forceinline__ int modrow_of(int row) { return row < M_CTX ? 0 : 1 + ((row - M_CTX) >> 12); }

#define XB_TMO 128
#define XB_XCNT(j) (256 + 64 * (j))
#define XB_XSUB(j) (1280 + 64 * (j))
#define XB_XGEN(j) (2304 + 64 * (j))
#define XB_TOP 3328
#define XB_TOPGEN 3392
#define XCD_BAR_WORDS 3456
#define XB_SPIN_CAP (1u << 22)
__device__ __forceinline__ unsigned xb_ld(unsigned* p) { return __hip_atomic_load(p, __ATOMIC_RELAXED, __HIP_MEMORY_SCOPE_AGENT); }
__device__ __forceinline__ unsigned xb_add(unsigned* p, unsigned v) { return __hip_atomic_fetch_add(p, v, __ATOMIC_RELAXED, __HIP_MEMORY_SCOPE_AGENT); }
__device__ __forceinline__ unsigned xb_xcc_id() { return (unsigned)__builtin_amdgcn_s_getreg((3 << 11) | 20) & 0xFu; }
#define XB_SPIN(cond, bar) do { unsigned _sp = 0; while (cond) { __builtin_amdgcn_s_sleep(1); \
    if ((++_sp & 255u) == 0u) { if (xb_ld(&(bar)[XB_TMO])) break; if (_sp > XB_SPIN_CAP) { atomicAdd(&(bar)[XB_TMO], 1u); break; } } } } while (0)
struct XcdBarrier { unsigned* bar; unsigned x; volatile LAS unsigned* st; };
__device__ __forceinline__ XcdBarrier xcd_barrier_post(unsigned* bar, volatile LAS unsigned* st) {
    XcdBarrier b; b.bar = bar; b.x = xb_xcc_id(); b.st = st;
    if (threadIdx.x == 0) (void)xb_add(&bar[XB_XCNT(b.x)], 1u);
    return b;
}
__device__ __forceinline__ void xcd_barrier_complete(unsigned* bar, unsigned x, unsigned& nloc, unsigned& nx) {
    const unsigned G = gridDim.x * gridDim.y * gridDim.z;
    unsigned sum, cnt, mine, sp = 0u;
    for (;;) {
        sum = 0u; cnt = 0u; mine = 0u;
#pragma unroll
        for (unsigned j = 0; j < 16; ++j) { const unsigned c = xb_ld(&bar[XB_XCNT(j)]); sum += c; cnt += (c > 0u) ? 1u : 0u; mine = (j == x) ? c : mine; }
        if (sum == G) break;
        __builtin_amdgcn_s_sleep(1);
        if ((++sp & 255u) == 0u) { if (xb_ld(&bar[XB_TMO])) break; if (sp > XB_SPIN_CAP) { atomicAdd(&bar[XB_TMO], 1u); break; } }
    }
    nloc = mine > 0u ? mine : 1u; nx = cnt > 0u ? cnt : 1u;
}
__device__ __forceinline__ void xcd_barrier(const XcdBarrier& b) {
    asm volatile("s_waitcnt vmcnt(0)" ::: "memory");
    __syncthreads();
    if (threadIdx.x == 0) {
        unsigned* bar = b.bar;
        __builtin_amdgcn_s_waitcnt(0);
        unsigned nloc = b.st[0], nx = b.st[1];
        if (nloc == 0u) { xcd_barrier_complete(bar, b.x, nloc, nx); b.st[0] = nloc; b.st[1] = nx; }
        const unsigned old = xb_add(&bar[XB_XSUB(b.x)], 1u);
        const unsigned gen = old / nloc;
        if (old + 1u == (gen + 1u) * nloc) {
            __builtin_amdgcn_fence(__ATOMIC_RELEASE, "agent");
            asm volatile("s_waitcnt vmcnt(0)" ::: "memory");
            const unsigned og = xb_add(&bar[XB_TOP], 1u);
            const unsigned tg = og / nx;
            if (og + 1u == (tg + 1u) * nx) xb_add(&bar[XB_TOPGEN], 1u);
            else XB_SPIN(xb_ld(&bar[XB_TOPGEN]) == tg, bar);
            __builtin_amdgcn_fence(__ATOMIC_ACQUIRE, "agent");
            xb_add(&bar[XB_XGEN(b.x)], 1u);
            asm volatile("s_waitcnt vmcnt(0)" ::: "memory");
        } else {
            XB_SPIN(xb_ld(&bar[XB_XGEN(b.x)]) == gen, bar);
            __builtin_amdgcn_fence(__ATOMIC_ACQUIRE, "agent");
            asm volatile("s_waitcnt vmcnt(0)" ::: "memory");
        }
    }
    __syncthreads();
}

template <bool TR, class Epi>
__device__ __forceinline__ void gemm128(const bf16_t* __restrict__ A, int lda, const bf16_t* __restrict__ B, int ldb, int K, char* smem, const Epi& epi) {
    const int tid = opaque_tid(), lane = tid & 63, wid = tid >> 6, wr = wid >> 1, wc = wid & 1, fr = lane & 15, fq = lane >> 4;
    f32x4 acc[4][4];
#pragma unroll
    for (int m = 0; m < 4; ++m)
#pragma unroll
        for (int n = 0; n < 4; ++n) acc[m][n] = (f32x4){0.f, 0.f, 0.f, 0.f};
    const int crow = tid >> 3, ckc = tid & 7;
    const bf16_t* ap = A + (size_t)crow * lda + ckc * 8;
    const bf16_t* bp = B + (size_t)crow * ldb + ckc * 8;
    u32x4 ra[4], rb[4];
#pragma unroll
    for (int i = 0; i < 4; ++i) { ra[i] = *(const u32x4*)(ap + (size_t)(32 * i) * lda); rb[i] = *(const u32x4*)(bp + (size_t)(32 * i) * ldb); }
    {
        char* sa = smem; char* sb = smem + TILE_BYTES;
#pragma unroll
        for (int i = 0; i < 4; ++i) { *(u32x4*)(sa + ((crow + 32 * i) * LDS_STRIDE + ckc * 8) * 2) = ra[i]; *(u32x4*)(sb + ((crow + 32 * i) * LDS_STRIDE + ckc * 8) * 2) = rb[i]; }
    }
    __syncthreads();
    const int nk = K >> 6;
    for (int kt = 0; kt < nk; ++kt) {
        const bool more = (kt + 1 < nk);
        if (more) {
            const int k0 = (kt + 1) << 6;
#pragma unroll
            for (int i = 0; i < 4; ++i) { ra[i] = *(const u32x4*)(ap + (size_t)(32 * i) * lda + k0); rb[i] = *(const u32x4*)(bp + (size_t)(32 * i) * ldb + k0); }
        }
        const char* sa = smem + (kt & 1) * 2 * TILE_BYTES; const char* sb = sa + TILE_BYTES;
#pragma unroll
        for (int ks = 0; ks < 2; ++ks) {
            bf16x8 af[4], bfr[4];
#pragma unroll
            for (int m = 0; m < 4; ++m) af[m] = *(const bf16x8*)(sa + ((wr * 64 + m * 16 + fr) * LDS_STRIDE + ks * 32 + fq * 8) * 2);
#pragma unroll
            for (int n = 0; n < 4; ++n) bfr[n] = *(const bf16x8*)(sb + ((wc * 64 + n * 16 + fr) * LDS_STRIDE + ks * 32 + fq * 8) * 2);
            __builtin_amdgcn_s_setprio(1);
#pragma unroll
            for (int m = 0; m < 4; ++m)
#pragma unroll
                for (int n = 0; n < 4; ++n) acc[m][n] = TR ? __builtin_amdgcn_mfma_f32_16x16x32_bf16(bfr[n], af[m], acc[m][n], 0, 0, 0) : __builtin_amdgcn_mfma_f32_16x16x32_bf16(af[m], bfr[n], acc[m][n], 0, 0, 0);
            __builtin_amdgcn_s_setprio(0);
        }
        if (more) {
            char* da = smem + ((kt + 1) & 1) * 2 * TILE_BYTES; char* db = da + TILE_BYTES;
#pragma unroll
            for (int i = 0; i < 4; ++i) { *(u32x4*)(da + ((crow + 32 * i) * LDS_STRIDE + ckc * 8) * 2) = ra[i]; *(u32x4*)(db + ((crow + 32 * i) * LDS_STRIDE + ckc * 8) * 2) = rb[i]; }
        }
        __syncthreads();
    }
    epi(acc, wr * 64, wc * 64, fr, fq);
}


#define L2_STRIDE 40
#define A2_BYTES (256 * L2_STRIDE * 2)
#define B2_BYTES (128 * L2_STRIDE * 2)
#define ST2_BYTES (A2_BYTES + B2_BYTES)
template <class Epi>
__device__ __forceinline__ void gemm256(const bf16_t* __restrict__ A, int lda, const bf16_t* __restrict__ B, int ldb, int K, char* smem, const Epi& epi) {
    const int tid = opaque_tid(), lane = tid & 63, wid = tid >> 6, wr = wid >> 1, wc = wid & 1, fr = lane & 15, fq = lane >> 4;
    f32x4 acc[2][4][4];
#pragma unroll
    for (int hh = 0; hh < 2; ++hh)
#pragma unroll
        for (int m = 0; m < 4; ++m)
#pragma unroll
            for (int n = 0; n < 4; ++n) acc[hh][m][n] = (f32x4){0.f, 0.f, 0.f, 0.f};
    const int crow = tid >> 2, ckc = tid & 3;
    const bf16_t* ap = A + (size_t)crow * lda + ckc * 8;
    const bf16_t* bp = B + (size_t)crow * ldb + ckc * 8;
    u32x4 ra[4], rb[2];
#pragma unroll
    for (int i = 0; i < 4; ++i) ra[i] = *(const u32x4*)(ap + (size_t)(64 * i) * lda);
#pragma unroll
    for (int i = 0; i < 2; ++i) rb[i] = *(const u32x4*)(bp + (size_t)(64 * i) * ldb);
    {
        char* sa = smem; char* sb = smem + A2_BYTES;
#pragma unroll
        for (int i = 0; i < 4; ++i) *(u32x4*)(sa + ((crow + 64 * i) * L2_STRIDE + ckc * 8) * 2) = ra[i];
#pragma unroll
        for (int i = 0; i < 2; ++i) *(u32x4*)(sb + ((crow + 64 * i) * L2_STRIDE + ckc * 8) * 2) = rb[i];
    }
    __syncthreads();
    const int nk = K >> 5;
    for (int kt = 0; kt < nk; ++kt) {
        const bool more = (kt + 1 < nk);
        if (more) {
            const int k0 = (kt + 1) << 5;
#pragma unroll
            for (int i = 0; i < 4; ++i) ra[i] = *(const u32x4*)(ap + (size_t)(64 * i) * lda + k0);
#pragma unroll
            for (int i = 0; i < 2; ++i) rb[i] = *(const u32x4*)(bp + (size_t)(64 * i) * ldb + k0);
        }
        const char* sa = smem + (kt & 1) * ST2_BYTES; const char* sb = sa + A2_BYTES;
        bf16x8 bfr[4];
#pragma unroll
        for (int n = 0; n < 4; ++n) bfr[n] = *(const bf16x8*)(sb + ((wc * 64 + n * 16 + fr) * L2_STRIDE + fq * 8) * 2);
#pragma unroll
        for (int hh = 0; hh < 2; ++hh) {
            bf16x8 af[4];
#pragma unroll
            for (int m = 0; m < 4; ++m) af[m] = *(const bf16x8*)(sa + ((wr * 128 + hh * 64 + m * 16 + fr) * L2_STRIDE + fq * 8) * 2);
            __builtin_amdgcn_s_setprio(1);
#pragma unroll
            for (int m = 0; m < 4; ++m)
#pragma unroll
                for (int n = 0; n < 4; ++n) acc[hh][m][n] = __builtin_amdgcn_mfma_f32_16x16x32_bf16(bfr[n], af[m], acc[hh][m][n], 0, 0, 0);
            __builtin_amdgcn_s_setprio(0);
        }
        if (more) {
            char* da = smem + ((kt + 1) & 1) * ST2_BYTES; char* db = da + A2_BYTES;
#pragma unroll
            for (int i = 0; i < 4; ++i) *(u32x4*)(da + ((crow + 64 * i) * L2_STRIDE + ckc * 8) * 2) = ra[i];
#pragma unroll
            for (int i = 0; i < 2; ++i) *(u32x4*)(db + ((crow + 64 * i) * L2_STRIDE + ckc * 8) * 2) = rb[i];
        }
        __syncthreads();
    }
    epi(acc[0], wr * 128, wc * 64, fr, fq);
    epi(acc[1], wr * 128 + 64, wc * 64, fr, fq);
}

struct EpiZ {
    bf16_t* Z; int R0, C0;
    __device__ __forceinline__ void operator()(f32x4 (&acc)[4][4], int r0, int c0, int fr, int fq) const {
#pragma unroll
        for (int n = 0; n < 4; ++n) { const int col = C0 + c0 + n * 16 + fq * 4; if (col < NIN) {
#pragma unroll
            for (int m = 0; m < 4; ++m) { u32x2 w; w.x = pack2(acc[m][n][0], acc[m][n][1]); w.y = pack2(acc[m][n][2], acc[m][n][3]);
                *(u32x2*)(Z + (size_t)(R0 + r0 + m * 16 + fr) * NIN + col) = w; } } }
    }
};
struct EpiQ {
    bf16_t* Q; const float* rs; const float* ropeC; const float* ropeS; int R0, C0;
    __device__ __forceinline__ void operator()(f32x4 (&acc)[4][4], int r0, int c0, int fr, int fq) const {
        const bool lat = R0 >= M_CTX;
#pragma unroll
        for (int n = 0; n < 4; ++n) {
            const int cb = C0 + c0 + n * 16; const int hcs = cb % 96;
            if (lat && hcs == 80) continue;
            const bool rot = lat && hcs == 64;
#pragma unroll
            for (int m = 0; m < 4; ++m) {
                const int rl = r0 + m * 16 + fr; const int row = R0 + rl; const float sc = rs[rl] * QSCALE;
                const f32x4 x1 = acc[m][n] * sc; bf16_t* qp = Q + (size_t)row * 768 + cb + fq * 4;
                if (rot) {
                    const f32x4 x2 = acc[m][(n + 1) & 3] * sc; const int t = (row - M_CTX) & 4095;
                    const f32x4 cv = *(const f32x4*)(ropeC + t * 16 + fq * 4), sv = *(const f32x4*)(ropeS + t * 16 + fq * 4);
                    const f32x4 o1 = x1 * cv - x2 * sv, o2 = x1 * sv + x2 * cv;
                    u32x2 w; w.x = pack2(o1[0], o1[1]); w.y = pack2(o1[2], o1[3]); *(u32x2*)qp = w;
                    w.x = pack2(o2[0], o2[1]); w.y = pack2(o2[2], o2[3]); *(u32x2*)(qp + 16) = w;
                } else { u32x2 w; w.x = pack2(x1[0], x1[1]); w.y = pack2(x1[2], x1[3]); *(u32x2*)qp = w; }
            }
        }
    }
};
struct EpiKN {
    bf16_t* Kd; const float* rs; int R0, C0;
    __device__ __forceinline__ void operator()(f32x4 (&acc)[4][4], int r0, int c0, int fr, int fq) const {
#pragma unroll
        for (int n = 0; n < 4; ++n) { const int col = C0 + c0 + n * 16 + fq * 4; const int h = col >> 6, d = col & 63;
#pragma unroll
            for (int m = 0; m < 4; ++m) { const int rl = r0 + m * 16 + fr; const f32x4 v = acc[m][n] * (rs ? rs[rl] : 1.0f);
                u32x2 w; w.x = pack2(v[0], v[1]); w.y = pack2(v[2], v[3]); *(u32x2*)(Kd + (size_t)(R0 + rl) * 768 + h * 96 + d) = w; } }
    }
};
struct EpiKV {
    bf16_t* Kd; bf16_t* Vd; const float* rs; int R0, C0; int seqshift; size_t vbase0;
    __device__ __forceinline__ void operator()(f32x4 (&acc)[4][4], int r0, int c0, int fr, int fq) const {
#pragma unroll
        for (int n = 0; n < 4; ++n) {
            const int col = C0 + c0 + n * 16 + fr;
#pragma unroll
            for (int m = 0; m < 4; ++m) {
                const int rl = r0 + m * 16 + fq * 4; const int row = R0 + rl;
                float v[4];
#pragma unroll
                for (int j = 0; j < 4; ++j) v[j] = acc[m][n][j] * (rs ? rs[rl + j] : 1.0f);
                if (col < 512) {
                    const int h = col >> 6, d = col & 63;
#pragma unroll
                    for (int j = 0; j < 4; ++j) Kd[(size_t)(row + j) * 768 + h * 96 + d] = f2bf(v[j]);
                } else {
                    const int vc = col - 512, h = vc >> 6, dv = vc & 63; const int b = row >> seqshift, t = row & ((1 << seqshift) - 1);
                    u32x2 w; w.x = pack2(v[0], v[1]); w.y = pack2(v[2], v[3]);
                    *(u32x2*)(Vd + vbase0 + ((size_t)((b * 8 + h) * 64 + dv) << seqshift) + t) = w;
                }
            }
        }
    }
};
struct EpiRes {
    float* X; const float* gate; int R0, C0;
    __device__ __forceinline__ void operator()(f32x4 (&acc)[4][4], int r0, int c0, int fr, int fq) const {
#pragma unroll
        for (int n = 0; n < 4; ++n) { const int col = C0 + c0 + n * 16 + fq * 4; const f32x4 g = *(const f32x4*)(gate + col);
#pragma unroll
            for (int m = 0; m < 4; ++m) { float* px = X + (size_t)(R0 + r0 + m * 16 + fr) * DM + col; const f32x4 xv = *(const f32x4*)px; *(f32x4*)px = ALPHA_F * xv + g * acc[m][n]; } }
    }
};
struct EpiSwi {
    bf16_t* H; int R0, C0;
    __device__ __forceinline__ void operator()(f32x4 (&acc)[4][4], int r0, int c0, int fr, int fq) const {
        const int hb = ((C0 + c0) >> 1) + fq * 4;
#pragma unroll
        for (int n = 0; n < 2; ++n)
#pragma unroll
            for (int m = 0; m < 4; ++m) { float o[4];
#pragma unroll
                for (int j = 0; j < 4; ++j) { const float g = acc[m][n][j], u = acc[m][n + 2][j]; o[j] = g * sigmoidf_(g) * u; }
                u32x2 w; w.x = pack2(o[0], o[1]); w.y = pack2(o[2], o[3]);
                *(u32x2*)(H + (size_t)(R0 + r0 + m * 16 + fr) * DFF + hb + n * 16) = w; }
    }
};

#define NADA 192
__device__ __forceinline__ void ada_unit(const P& p, int u, char* smem) {
    const int tid = opaque_tid(); const int l = u / 48, c0 = (u % 48) * 128;
    float* cs = (float*)smem;
    for (int i = tid; i < 5 * 1024; i += 256) { const int r = i >> 10, k = i & 1023; const float v = (r == 0) ? p.c_ctx[k] : p.c[(r - 1) * 1024 + k]; cs[i] = v * sigmoidf_(v); }
    __syncthreads();
    const int cq = tid & 31, kg = tid >> 5;
    f32x4 s0 = (f32x4){0.f, 0.f, 0.f, 0.f}, s1 = s0, s2 = s0, s3 = s0, s4 = s0;
    const float* w = p.ada_w + ((size_t)l * 1024 + kg * 128) * 6144 + c0 + cq * 4;
    const float* cq_ = cs + kg * 128;
#pragma unroll 8
    for (int k = 0; k < 128; ++k) { const f32x4 wv = *(const f32x4*)(w + (size_t)k * 6144);
        s0 += cq_[k] * wv; s1 += cq_[1024 + k] * wv; s2 += cq_[2048 + k] * wv; s3 += cq_[3072 + k] * wv; s4 += cq_[4096 + k] * wv; }
    float* red = cs + 5 * 1024;
    *(f32x4*)(red + (kg * 5 + 0) * 128 + cq * 4) = s0; *(f32x4*)(red + (kg * 5 + 1) * 128 + cq * 4) = s1; *(f32x4*)(red + (kg * 5 + 2) * 128 + cq * 4) = s2;
    *(f32x4*)(red + (kg * 5 + 3) * 128 + cq * 4) = s3; *(f32x4*)(red + (kg * 5 + 4) * 128 + cq * 4) = s4;
    __syncthreads();
    for (int o = tid; o < 640; o += 256) { const int i = o >> 7, cc = o & 127; float v = p.ada_b[l * 6144 + c0 + cc];
#pragma unroll
        for (int g = 0; g < 8; ++g) v += red[(g * 5 + i) * 128 + cc];
        p.mod[((size_t)l * 5 + i) * 6144 + c0 + cc] = v; }
    __syncthreads();
}
__device__ __forceinline__ int map_col(int kind, int n) {
    if (kind == 1) { const int blk = n >> 6, r = n & 63; return r < 32 ? blk * 32 + r : DFF + blk * 32 + (r - 32); }
    if (kind == 2) { if (n < 512) return (n >> 6) * 128 + (n & 63); const int vc = n - 512; return (vc >> 6) * 128 + 64 + (vc & 63); }
    return n;
}
__device__ __forceinline__ void conv_tile(const float* src, int ldsrc, bf16_t* dst, bf16_t* dst2, int Kdst, int n0, int k0, int kind, int Nvalid, const float* kscale, char* smem) {
    const int tid = opaque_tid(); float* tile = (float*)smem;
    { const int nq = tid & 15, kq = tid >> 4; const int n = n0 + nq * 4; const int sc = (n < Nvalid) ? map_col(kind, n) : -1;
#pragma unroll
      for (int ps = 0; ps < 4; ++ps) { const int i = kq + 16 * ps;
          f32x4 v = (f32x4){0.f, 0.f, 0.f, 0.f}; if (sc >= 0) v = *(const f32x4*)(src + (size_t)(k0 + i) * ldsrc + sc);
          tile[i * 65 + nq * 4 + 0] = v[0]; tile[i * 65 + nq * 4 + 1] = v[1]; tile[i * 65 + nq * 4 + 2] = v[2]; tile[i * 65 + nq * 4 + 3] = v[3]; } }
    __syncthreads();
    { const int i2 = tid & 31, j0 = tid >> 5;
      const float ks0 = kscale ? kscale[k0 + 2 * i2] : 1.f, ks1 = kscale ? kscale[k0 + 2 * i2 + 1] : 1.f;
#pragma unroll
      for (int jj = 0; jj < 8; ++jj) { const int jx = j0 + 8 * jj; const float v0 = tile[(2 * i2) * 65 + jx], v1 = tile[(2 * i2 + 1) * 65 + jx];
          *(unsigned*)(dst + (size_t)(n0 + jx) * Kdst + k0 + 2 * i2) = pack2(v0 * ks0, v1 * ks1);
          if (dst2) *(unsigned*)(dst2 + (size_t)(n0 + jx) * Kdst + k0 + 2 * i2) = pack2(v0, v1); } }
    __syncthreads();
}
#define NCONV 3032
__device__ __forceinline__ void conv_unit(const P& p, int l, int u, char* smem) {
    const float* src; int ldsrc; bf16_t* dst; bf16_t* dst2 = nullptr; int Kdst, n0, k0, kind = 0, Nvalid; const float* kscale = nullptr;
    if (u < 544) { src = p.w_in + (size_t)l * 1024 * NIN; ldsrc = NIN; dst = p.WtIn; Kdst = 1024; n0 = (u / 16) * 64; k0 = (u % 16) * 64; Nvalid = NIN; }
    else if (u < 592) { u -= 544; src = p.q_up + (size_t)l * 256 * 768; ldsrc = 768; dst = p.WtQ; Kdst = 256; n0 = (u / 4) * 64; k0 = (u % 4) * 64; Nvalid = 768; kscale = p.q_norm + l * 256; }
    else if (u < 624) { u -= 592; src = p.kv_up + (size_t)l * 128 * 1024; ldsrc = 1024; dst = p.WtKVn; dst2 = p.WtKV; Kdst = 128; n0 = (u / 2) * 64; k0 = (u % 2) * 64; kind = 2; Nvalid = 1024; kscale = p.kv_norm + l * 128; }
    else if (u < 880) { u -= 624; src = p.w_out + (size_t)l * 1024 * 1024; ldsrc = 1024; dst = p.WtOut; Kdst = 1024; n0 = (u / 16) * 64; k0 = (u % 16) * 64; Nvalid = 1024; }
    else if (u < 2288) { u -= 880; src = p.ffn_in + (size_t)l * 1024 * 5632; ldsrc = 5632; dst = p.WtF1; Kdst = 1024; n0 = (u / 16) * 64; k0 = (u % 16) * 64; kind = 1; Nvalid = 5632; }
    else if (u < 2992) { u -= 2288; src = p.ffn_out + (size_t)l * DFF * 1024; ldsrc = 1024; dst = p.WtF2; Kdst = DFF; n0 = (u / 44) * 64; k0 = (u % 44) * 64; Nvalid = 1024; }
    else if (u < 3008) { u -= 2992; const float* sp = p.gm_ws + (size_t)l * 65536 + u * 4096; bf16_t* d = p.WsB + u * 4096; for (int i = threadIdx.x; i < 4096; i += 256) d[i] = f2bf(sp[i]); return; }
    else if (u < 3016) { u -= 3008; const int d = u >> 2; src = p.rw_w2 + ((size_t)l * 2 + d) * 64 * 256; ldsrc = 256; dst = p.W2t + d * 256 * 64; Kdst = 64; n0 = (u & 3) * 64; k0 = 0; Nvalid = 256; }
    else if (u < 3024) { u -= 3016; const int d = u >> 2; src = p.rw_a2 + ((size_t)l * 2 + d) * 64 * 256; ldsrc = 256; dst = p.A2t + d * 256 * 64; Kdst = 64; n0 = (u & 3) * 64; k0 = 0; Nvalid = 256; }
    else { u -= 3024; src = p.rw_g2 + (size_t)l * 128 * 256; ldsrc = 256; dst = p.G2t; Kdst = 128; n0 = (u / 2) * 64; k0 = (u % 2) * 64; Nvalid = 256; }
    conv_tile(src, ldsrc, dst, dst2, Kdst, n0, k0, kind, Nvalid, kscale, smem);
}
__device__ __forceinline__ void misc0_unit(const P& p, int u) {
    const int tid = opaque_tid();
    if (u < 16) {
        for (int e = tid; e < 4096; e += 256) { const int idx = u * 4096 + e; const int t = idx >> 4, i = idx & 15;
            const float pos = (float)((i < 8) ? (t >> 6) : (t & 63)); const float inv = exp2f(-(float)(i & 7) * 1.6609640474436813f);
            const float ang = pos * inv; const float kf = rintf(ang * 0.15915494309189535f);
            float r = fmaf(-kf, 6.28318548202514648f, ang); r = fmaf(-kf, -1.74845553e-7f, r);
            p.ropeC[idx] = __cosf(r); p.ropeS[idx] = __sinf(r); }
    } else {
        const int v = u - 16;
        for (int e = tid; e < 4096; e += 256) { const int idx = v * 4096 + e;
            const int c = idx & 127, t = (idx >> 7) & 511, b = (idx >> 16) & 3, l = idx >> 18;
            p.CkvB[idx] = f2bf(p.cache_ckv[(((size_t)b * 4 + l) * 512 + t) * 128 + c]); }
    }
}

__device__ __forceinline__ void ln_phase(const P& p, int l, int which) {
    const int tid = opaque_tid(), lane = tid & 63, wid = tid >> 6;
    const float* g = which == 1 ? p.ln1_g + l * DM : p.ln2_g + l * DM; const float* bb = which == 1 ? p.ln1_b + l * DM : p.ln2_b + l * DM;
    const int ml = which == 2 ? l + 1 : l; const int shoff = which == 1 ? 3072 : 0, scoff = which == 1 ? 4096 : 1024;
    const bool dohb = !(which == 2 && l == 3);
    for (int row = blockIdx.x * 4 + wid; row < M_ALL; row += gridDim.x * 4) {
        float* xr = p.out + (size_t)row * DM;
        const float* src = which == 0 ? (row < M_CTX ? p.x_prompt + (size_t)row * DM : p.x_sample + (size_t)(row - M_CTX) * DM) : xr;
        f32x4 v[4];
#pragma unroll
        for (int i = 0; i < 4; ++i) v[i] = *(const f32x4*)(src + lane * 4 + 256 * i);
        if (which != 0) {
            float s = 0.f;
#pragma unroll
            for (int i = 0; i < 4; ++i) s += (v[i][0] + v[i][1]) + (v[i][2] + v[i][3]);
            s = red16(s); s += __shfl_xor(s, 16); s += __shfl_xor(s, 32);
            const float mu = s * (1.0f / 1024.0f); float q = 0.f;
#pragma unroll
            for (int i = 0; i < 4; ++i) { const f32x4 d = v[i] - mu; q += (d[0] * d[0] + d[1] * d[1]) + (d[2] * d[2] + d[3] * d[3]); }
            q = red16(q); q += __shfl_xor(q, 16); q += __shfl_xor(q, 32);
            const float rstd = rsqrtf(q * (1.0f / 1024.0f) + 1e-5f);
#pragma unroll
            for (int i = 0; i < 4; ++i) { const f32x4 gg = *(const f32x4*)(g + lane * 4 + 256 * i), bv = *(const f32x4*)(bb + lane * 4 + 256 * i); v[i] = (v[i] - mu) * rstd * gg + bv; }
        }
#pragma unroll
        for (int i = 0; i < 4; ++i) *(f32x4*)(xr + lane * 4 + 256 * i) = v[i];
        if (dohb) {
            const float* md = p.mod + ((size_t)ml * 5 + modrow_of(row)) * 6144;
#pragma unroll
            for (int i = 0; i < 4; ++i) { const f32x4 sh = *(const f32x4*)(md + shoff + lane * 4 + 256 * i), sc = *(const f32x4*)(md + scoff + lane * 4 + 256 * i);
                const f32x4 h = v[i] * (1.0f + sc) + sh; u32x2 w; w.x = pack2(h[0], h[1]); w.y = pack2(h[2], h[3]);
                *(u32x2*)(p.hbmix + (size_t)row * DM + lane * 4 + 256 * i) = w; }
        }
    }
}

__device__ __forceinline__ void rwprep_unit(const P& p, int l, int u, char* smem) {
    const int tid = opaque_tid(), lane = tid & 63, wid = tid >> 6, fr = lane & 15, fq = lane >> 4;
    const int R0 = u * 64;
    const int ss = R0 < M_CTX ? (R0 & ~255) : M_CTX + ((R0 - M_CTX) & ~4095); const int se = ss + (R0 < M_CTX ? 256 : 4096);
    bf16_t* XW = (bf16_t*)smem; bf16_t* XA = XW + 64 * 136; bf16_t* XG = XA + 64 * 136;
    const float* cw = p.rw_conv + (size_t)l * 3 * 1152;
    for (int it = tid; it < 1152; it += 256) {
        const int cc = it % 144, tg = it / 144; const int c = cc * 8;
        float w0[8], w1[8], w2[8];
#pragma unroll
        for (int i = 0; i < 8; ++i) { w0[i] = cw[c + i]; w1[i] = cw[1152 + c + i]; w2[i] = cw[2304 + c + i]; }
        const int rfirst = R0 + tg * 8;
        u32x4 rows[10];
#pragma unroll
        for (int i = 0; i < 10; ++i) { const int r = rfirst - 1 + i; rows[i] = (u32x4){0u, 0u, 0u, 0u};
            if (r >= ss && r < se) rows[i] = *(const u32x4*)(p.Z + (size_t)r * NIN + c); }
#pragma unroll
        for (int tt = 0; tt < 8; ++tt) {
            const int row = rfirst + tt;
            const u32x4 prev = rows[tt], cur = rows[tt + 1], nxt = rows[tt + 2];
            float o[8];
#pragma unroll
            for (int i = 0; i < 4; ++i) {
                o[2 * i] = w0[2 * i] * lo_bf(prev[i]) + w1[2 * i] * lo_bf(cur[i]) + w2[2 * i] * lo_bf(nxt[i]);
                o[2 * i + 1] = w0[2 * i + 1] * hi_bf(prev[i]) + w1[2 * i + 1] * hi_bf(cur[i]) + w2[2 * i + 1] * hi_bf(nxt[i]);
            }
            if (c >= 768 && c < 896) {
#pragma unroll
                for (int i = 0; i < 8; ++i) o[i] = tanhf_(o[i]);
            } else if (c >= 1024) {
#pragma unroll
                for (int i = 0; i < 8; ++i) o[i] = sigmoidf_(o[i]);
            }
            u32x4 w; w.x = pack2(o[0], o[1]); w.y = pack2(o[2], o[3]); w.z = pack2(o[4], o[5]); w.w = pack2(o[6], o[7]);
            const int tl = tg * 8 + tt;
            if (c < 768) *(u32x4*)(p.RKV + (size_t)row * 768 + c) = w;
            else if (c < 896) *(u32x4*)(XW + tl * 136 + (c - 768)) = w;
            else if (c < 1024) *(u32x4*)(XA + tl * 136 + (c - 896)) = w;
            else *(u32x4*)(XG + tl * 136 + (c - 1024)) = w;
        }
    }
    __syncthreads();
#pragma unroll 1
    for (int mh = 0; mh < 10; ++mh) {
        const int mat = mh >> 1, nh = mh & 1;
        const int d = mat & 1; const bf16_t* As; const bf16_t* Bw; int kofs, nks, ldw;
        if (mat < 2) { As = XW; Bw = p.W2t + d * 256 * 64; kofs = d * 64; nks = 2; ldw = 64; }
        else if (mat < 4) { As = XA; Bw = p.A2t + d * 256 * 64; kofs = d * 64; nks = 2; ldw = 64; }
        else { As = XG; Bw = p.G2t; kofs = 0; nks = 4; ldw = 128; }
        f32x4 acc[4][2];
#pragma unroll
        for (int m = 0; m < 4; ++m)
#pragma unroll
            for (int n = 0; n < 2; ++n) acc[m][n] = (f32x4){0.f, 0.f, 0.f, 0.f};
        bf16x8 bw[4][2];
#pragma unroll
        for (int ks = 0; ks < 4; ++ks)
#pragma unroll
            for (int n = 0; n < 2; ++n) bw[ks][n] = *(const bf16x8*)(Bw + (size_t)(wid * 64 + nh * 32 + n * 16 + fr) * ldw + (ks < nks ? ks : 0) * 32 + fq * 8);
#pragma unroll
        for (int ks = 0; ks < 4; ++ks) {
            if (ks < nks) {
                bf16x8 af[4];
#pragma unroll
                for (int m = 0; m < 4; ++m) af[m] = *(const bf16x8*)(As + (m * 16 + fr) * 136 + kofs + ks * 32 + fq * 8);
#pragma unroll
                for (int m = 0; m < 4; ++m)
#pragma unroll
                    for (int n = 0; n < 2; ++n) acc[m][n] = __builtin_amdgcn_mfma_f32_16x16x32_bf16(bw[ks][n], af[m], acc[m][n], 0, 0, 0);
            }
        }
#pragma unroll
        for (int n = 0; n < 2; ++n) {
            const int c = wid * 64 + nh * 32 + n * 16 + fq * 4;
            f32x4 bias = (f32x4){0.f, 0.f, 0.f, 0.f}; if (mat < 2) bias = *(const f32x4*)(p.rw_w0 + (l * 2 + d) * 256 + c); else if (mat < 4) bias = *(const f32x4*)(p.rw_a0 + (l * 2 + d) * 256 + c);
            bf16_t* dst; float mul;
            if (mat < 2) { dst = p.Ee + ((size_t)d * M_ALL + R0) * 256 + c; mul = 0.6065306597126334f; }
            else if (mat < 4) { dst = p.Aa + ((size_t)d * M_ALL + R0) * 256 + c; mul = 1.0f; }
            else { dst = p.Gg + (size_t)R0 * 256 + c; mul = 1.0f; }
#pragma unroll
            for (int m = 0; m < 4; ++m) {
                float o[4];
#pragma unroll
                for (int j = 0; j < 4; ++j) { const float x = acc[m][n][j] + bias[j]; o[j] = mat < 4 ? mul * sigmoidf_(x) : x; }
                u32x2 w; w.x = pack2(o[0], o[1]); w.y = pack2(o[2], o[3]);
                *(u32x2*)(dst + (size_t)(m * 16 + fr) * 256) = w;
            }
        }
    }
    __syncthreads();
}
__device__ __forceinline__ void rowscale128(const bf16_t* Z, int R0, int zoff, int ncols, float eps, float* rs) {
    const int tid = opaque_tid(); const int r = tid >> 1, half = tid & 1; const int per = ncols >> 1;
    const bf16_t* zp = Z + (size_t)(R0 + r) * NIN + zoff + half * per;
    float ss = 0.f;
    for (int i = 0; i < per; i += 8) { const u32x4 w = *(const u32x4*)(zp + i);
#pragma unroll
        for (int q = 0; q < 4; ++q) { const float a = lo_bf(w[q]), b = hi_bf(w[q]); ss += a * a + b * b; } }
    ss = dpp_add<0xB1>(ss);
    if (half == 0) rs[r] = rsqrtf(ss / (float)ncols + eps);
}
__device__ __forceinline__ void small_unit(const P& p, int l, int u) {
    const int tid = opaque_tid(), sub = tid >> 5, li = tid & 31;
    if (u < 2560) {
        const int row = u * 8 + sub; const bf16_t* zr = p.Z + (size_t)row * NIN;
        const u32x2 w = *(const u32x2*)(zr + ZKV + li * 4);
        const float z0 = lo_bf(w.x), z1 = hi_bf(w.x), z2 = lo_bf(w.y), z3 = hi_bf(w.y);
        float ss = z0 * z0 + z1 * z1 + z2 * z2 + z3 * z3; ss = red16(ss); ss += __shfl_xor(ss, 16);
        const float rsv = rsqrtf(ss * (1.0f / 128.0f) + 1e-6f);
        const float x1 = bf2f(zr[ZKR + (li & 15)]), x2 = bf2f(zr[ZKR + 16 + (li & 15)]);
        float val;
        if (row < M_CTX) {
            const int b = row >> 8, t = row & 255; const size_t o = ((size_t)(b * 4 + l) * 256 + t);
            const f32x4 g = *(const f32x4*)(p.kv_norm + l * 128 + li * 4);
            *(f32x4*)(p.out + 20971520 + o * 128 + li * 4) = (f32x4){z0 * rsv * g[0], z1 * rsv * g[1], z2 * rsv * g[2], z3 * rsv * g[3]};
            val = li < 16 ? x1 : x2;
            p.out[20971520 + 2097152 + o * 32 + li] = val;
        } else {
            const int t = (row - M_CTX) & 4095; const float cv = p.ropeC[t * 16 + (li & 15)], sv = p.ropeS[t * 16 + (li & 15)];
            val = li < 16 ? x1 * cv - x2 * sv : x1 * sv + x2 * cv;
        }
        const bf16_t bv = f2bf(val);
#pragma unroll
        for (int h = 0; h < 8; ++h) p.Kb[(size_t)row * 768 + h * 96 + 64 + li] = bv;
    } else {
        const int r = (u - 2560) * 8 + sub; const int b = r >> 9, t = r & 511;
        const bf16_t bv = f2bf(p.cache_krope[((size_t)(b * 4 + l) * 512 + t) * 32 + li]);
#pragma unroll
        for (int h = 0; h < 8; ++h) p.Kc[(size_t)r * 768 + h * 96 + 64 + li] = bv;
    }
}
__device__ __forceinline__ void gmlp_unit(const P& p, int l, int u, char* smem) {
    const int tid = opaque_tid(), lane = tid & 63, wid = tid >> 6, fr = lane & 15, fq = lane >> 4;
    const int R0 = (u >> 2) * 128, g = u & 3;
    bf16_t* VnT = (bf16_t*)smem;
    bf16x8 wsf[4][2];
    { const bf16_t* Wg0 = p.WsB + g * 128 * 128;
#pragma unroll
      for (int ks = 0; ks < 4; ++ks)
#pragma unroll
        for (int m = 0; m < 2; ++m) wsf[ks][m] = *(const bf16x8*)(Wg0 + (wid * 32 + m * 16 + fr) * 128 + ks * 32 + fq * 8); }
    {
        const int tok = tid >> 1, half = tid & 1; const bf16_t* zp = p.Z + (size_t)(R0 + tok) * NIN + ZV + g * 64 + half * 32;
        float x[32];
#pragma unroll
        for (int i = 0; i < 4; ++i) { const u32x4 w = *(const u32x4*)(zp + i * 8);
#pragma unroll
            for (int q = 0; q < 4; ++q) { x[i * 8 + 2 * q] = geluf_(lo_bf(w[q])); x[i * 8 + 2 * q + 1] = geluf_(hi_bf(w[q])); } }
        float s = 0.f;
#pragma unroll
        for (int i = 0; i < 32; ++i) s += x[i];
        s = dpp_add<0xB1>(s); const float mu = s * (1.0f / 64.0f);
        float q2 = 0.f;
#pragma unroll
        for (int i = 0; i < 32; ++i) { const float d = x[i] - mu; q2 += d * d; }
        q2 = dpp_add<0xB1>(q2); const float rstd = rsqrtf(q2 * (1.0f / 64.0f) + 1e-5f);
        const float* gg = p.gm_g + l * 256 + g * 64 + half * 32; const float* gb = p.gm_b + l * 256 + g * 64 + half * 32;
#pragma unroll
        for (int i = 0; i < 32; ++i) VnT[(half * 32 + i) * 136 + tok] = f2bf((x[i] - mu) * rstd * gg[i] + gb[i]);
    }
    __syncthreads();
    f32x4 acc[2][4];
#pragma unroll
    for (int m = 0; m < 2; ++m)
#pragma unroll
        for (int n = 0; n < 4; ++n) acc[m][n] = (f32x4){0.f, 0.f, 0.f, 0.f};
#pragma unroll
    for (int ks = 0; ks < 4; ++ks) {
        bf16x8 bfr[4];
#pragma unroll
        for (int n = 0; n < 4; ++n) bfr[n] = *(const bf16x8*)(VnT + (n * 16 + fr) * 136 + ks * 32 + fq * 8);
#pragma unroll
        for (int m = 0; m < 2; ++m)
#pragma unroll
            for (int n = 0; n < 4; ++n) acc[m][n] = __builtin_amdgcn_mfma_f32_16x16x32_bf16(bfr[n], wsf[ks][m], acc[m][n], 0, 0, 0);
    }
#pragma unroll
    for (int m = 0; m < 2; ++m) {
        const int pp = wid * 32 + m * 16 + fr; const float bs = p.gm_bs[l * 512 + g * 128 + pp];
#pragma unroll
        for (int n = 0; n < 4; ++n) { const int c = n * 16 + fq * 4;
            const u32x2 zw = *(const u32x2*)(p.Z + (size_t)(R0 + pp) * NIN + ZU + g * 64 + c);
            const float u0 = geluf_(lo_bf(zw.x)), u1 = geluf_(hi_bf(zw.x)), u2 = geluf_(lo_bf(zw.y)), u3 = geluf_(hi_bf(zw.y));
            u32x2 w; w.x = pack2(u0 * (acc[m][n][0] + bs), u1 * (acc[m][n][1] + bs)); w.y = pack2(u2 * (acc[m][n][2] + bs), u3 * (acc[m][n][3] + bs));
            *(u32x2*)(p.hbmix + (size_t)(R0 + pp) * DM + 768 + g * 64 + c) = w; }
    }
    __syncthreads();
}

__device__ __forceinline__ float swap16_add(float x) {
    auto r = __builtin_amdgcn_permlane16_swap(__float_as_uint(x), __float_as_uint(x), false, false);
    return __uint_as_float(r[0]) + __uint_as_float(r[1]);
}
#define NSCAN_LAT 256
#define NSCAN (256 + 1024)
__device__ __forceinline__ void scan_unit(const P& p, int l, int u, char* smem) {
    const int tid = opaque_tid(), lane = tid & 63, wid = tid >> 6;
    int b, T, row0; const bool lat = u < NSCAN_LAT;
    if (lat) { b = u >> 6; T = 4096; row0 = M_CTX + b * 4096; } else { b = (u - NSCAN_LAT) >> 6; T = 256; row0 = b * 256; }
    const int h = (u >> 4) & 3, d = (u >> 3) & 1, rsl = u & 7;
    float* W = (float*)smem; float* NKK = W + 2048; float* KKA = NKK + 2048; float* KD = KKA + 2048; float* RR = KD + 2048; float* VS = RR + 2048; float* OUTP = VS + 256;
    const int rl = lane >> 5, kq = lane & 31; const int r8 = wid * 2 + rl; const int row = rsl * 8 + r8;
    f32x2 S = (f32x2){0.f, 0.f};
    const size_t stoff = ((((size_t)b * 4 + l) * 2 + d) * 4 + h) * 4096 + row * 64 + kq * 2;
    if (lat) S = *(const f32x2*)(p.state_rwkv + stoff);
    const int tok = tid >> 3, cg8 = tid & 7;
    float kkp[8], kap[8];
#pragma unroll
    for (int i = 0; i < 8; ++i) { kkp[i] = p.rw_kk[l * 256 + h * 64 + cg8 * 8 + i]; kap[i] = p.rw_ka[l * 256 + h * 64 + cg8 * 8 + i]; }
    const int nch = T >> 5;
    u32x4 r8v, k8, e8, a8, v8;
    int grow, grow_prev = 0; float oreg = 0.f;
    {
        const int sidx = tok; const int t = d ? T - 1 - sidx : sidx; grow = row0 + t;
        r8v = *(const u32x4*)(p.RKV + (size_t)grow * 768 + h * 64 + cg8 * 8);
        k8 = *(const u32x4*)(p.RKV + (size_t)grow * 768 + 256 + h * 64 + cg8 * 8);
        v8 = *(const u32x4*)(p.RKV + (size_t)grow * 768 + 512 + h * 64 + rsl * 8);
        e8 = *(const u32x4*)(p.Ee + ((size_t)d * M_ALL + grow) * 256 + h * 64 + cg8 * 8);
        a8 = *(const u32x4*)(p.Aa + ((size_t)d * M_ALL + grow) * 256 + h * 64 + cg8 * 8);
    }
    for (int ch = 0; ch < nch; ++ch) {
        {
            float kf[8], kkv[8], rf[8], ef[8], af[8];
#pragma unroll
            for (int q = 0; q < 4; ++q) { kf[2 * q] = lo_bf(k8[q]); kf[2 * q + 1] = hi_bf(k8[q]); rf[2 * q] = lo_bf(r8v[q]); rf[2 * q + 1] = hi_bf(r8v[q]);
                ef[2 * q] = lo_bf(e8[q]); ef[2 * q + 1] = hi_bf(e8[q]); af[2 * q] = lo_bf(a8[q]); af[2 * q + 1] = hi_bf(a8[q]); }
            float ss = 0.f;
#pragma unroll
            for (int i = 0; i < 8; ++i) { kkv[i] = kf[i] * kkp[i]; ss += kkv[i] * kkv[i]; }
            ss = red8(ss);
            const float inv = rsqrtf(fmaxf(ss, 1e-24f));
            f32x4 o0, o1; const int base = tok * 64 + cg8 * 8;
#pragma unroll
            for (int i = 0; i < 4; ++i) { o0[i] = __expf(-ef[i]); o1[i] = __expf(-ef[4 + i]); }
            *(f32x4*)(W + base) = o0; *(f32x4*)(W + base + 4) = o1;
#pragma unroll
            for (int i = 0; i < 4; ++i) { o0[i] = -kkv[i] * inv; o1[i] = -kkv[4 + i] * inv; }
            *(f32x4*)(NKK + base) = o0; *(f32x4*)(NKK + base + 4) = o1;
#pragma unroll
            for (int i = 0; i < 4; ++i) { o0[i] = kkv[i] * inv * af[i]; o1[i] = kkv[4 + i] * inv * af[4 + i]; }
            *(f32x4*)(KKA + base) = o0; *(f32x4*)(KKA + base + 4) = o1;
#pragma unroll
            for (int i = 0; i < 4; ++i) { o0[i] = kf[i] * (1.0f + (af[i] - 1.0f) * kap[i]); o1[i] = kf[4 + i] * (1.0f + (af[4 + i] - 1.0f) * kap[4 + i]); }
            *(f32x4*)(KD + base) = o0; *(f32x4*)(KD + base + 4) = o1;
#pragma unroll
            for (int i = 0; i < 4; ++i) { o0[i] = rf[i]; o1[i] = rf[4 + i]; }
            *(f32x4*)(RR + base) = o0; *(f32x4*)(RR + base + 4) = o1;
            if (cg8 == 0) {
#pragma unroll
                for (int q = 0; q < 4; ++q) { VS[tok * 8 + 2 * q] = lo_bf(v8[q]); VS[tok * 8 + 2 * q + 1] = hi_bf(v8[q]); }
            }
        }
        __syncthreads();
        if (ch > 0) p.ydir[((size_t)d * M_ALL + grow_prev) * 256 + h * 64 + rsl * 8 + cg8] = oreg;
        grow_prev = grow;
        if (ch + 1 < nch) {
            const int sidx = (ch + 1) * 32 + tok; const int t = d ? T - 1 - sidx : sidx; grow = row0 + t;
            r8v = *(const u32x4*)(p.RKV + (size_t)grow * 768 + h * 64 + cg8 * 8);
            k8 = *(const u32x4*)(p.RKV + (size_t)grow * 768 + 256 + h * 64 + cg8 * 8);
            v8 = *(const u32x4*)(p.RKV + (size_t)grow * 768 + 512 + h * 64 + rsl * 8);
            e8 = *(const u32x4*)(p.Ee + ((size_t)d * M_ALL + grow) * 256 + h * 64 + cg8 * 8);
            a8 = *(const u32x4*)(p.Aa + ((size_t)d * M_ALL + grow) * 256 + h * 64 + cg8 * 8);
        }
        {
            const float* Wq = W + kq * 2; const float* NKq = NKK + kq * 2; const float* KAq = KKA + kq * 2; const float* KDq = KD + kq * 2; const float* RRq = RR + kq * 2; const float* VSq = VS + r8;
            float* OPq = OUTP + r8 * 32 + kq;
            f32x2 wv[4], nkv[4], kav[4], kdv[4], rrv[4]; float vv[4];
#define SCAN_LD(slot, st) do { wv[slot] = *(const f32x2*)(Wq + (st) * 64); nkv[slot] = *(const f32x2*)(NKq + (st) * 64); kav[slot] = *(const f32x2*)(KAq + (st) * 64); \
        kdv[slot] = *(const f32x2*)(KDq + (st) * 64); rrv[slot] = *(const f32x2*)(RRq + (st) * 64); vv[slot] = VSq[(st) * 8]; } while (0)
            __builtin_amdgcn_s_setprio(3);
            SCAN_LD(0, 0); SCAN_LD(1, 1); SCAN_LD(2, 2);
#pragma unroll
            for (int s = 0; s < 32; ++s) {
                if (s + 3 < 32) SCAN_LD((s + 3) & 3, s + 3);
                const f32x2 w = wv[s & 3], nk = nkv[s & 3], ka = kav[s & 3], kd = kdv[s & 3], rr = rrv[s & 3]; const float v = vv[s & 3];
                float pd = fmaf(S[1], nk[1], S[0] * nk[0]);
                pd = red16(pd); pd = swap16_add(pd);
                S[0] = fmaf(S[0], w[0], fmaf(pd, ka[0], v * kd[0]));
                S[1] = fmaf(S[1], w[1], fmaf(pd, ka[1], v * kd[1]));
                OPq[s * 256] = fmaf(S[1], rr[1], S[0] * rr[0]);
            }
            __builtin_amdgcn_s_setprio(0);
        }
        __syncthreads();
        {
            const float* op = OUTP + (tok * 8 + cg8) * 32;
            f32x4 a0 = *(const f32x4*)(op), a1 = *(const f32x4*)(op + 4), a2 = *(const f32x4*)(op + 8), a3 = *(const f32x4*)(op + 12);
            f32x4 b0 = *(const f32x4*)(op + 16), b1 = *(const f32x4*)(op + 20), b2 = *(const f32x4*)(op + 24), b3 = *(const f32x4*)(op + 28);
            a0 = ((a0 + a1) + (a2 + a3)) + ((b0 + b1) + (b2 + b3));
            oreg = (a0[0] + a0[1]) + (a0[2] + a0[3]);
        }
    }
    p.ydir[((size_t)d * M_ALL + grow_prev) * 256 + h * 64 + rsl * 8 + cg8] = oreg;
    if (!lat) *(f32x2*)(p.out + 20971520 + 2097152 + 524288 + stoff) = S;
    __syncthreads();
}

#ifndef ATT_THR
#define ATT_THR 8.0f
#endif
#define KS_STRIDE 104
#define VS_STRIDE 68
#define KS_BYTES (64 * KS_STRIDE * 2)
#define ATT_STAGE (KS_BYTES + 64 * VS_STRIDE * 2)
__device__ __forceinline__ void attn_unit(const P& p, int u, char* smem) {
    const int tid = opaque_tid(), lane = tid & 63, wid = tid >> 6, q = lane & 31, hf = lane >> 5;
    int b, h, qt, qrow0, krow0, nown, ntot, Tv; size_t vbase, vcbase = 0; int kcrow0 = 0;
    if (u < 1024) { b = u >> 8; h = (u >> 5) & 7; qt = u & 31; krow0 = M_CTX + b * 4096; qrow0 = krow0 + qt * 128; nown = 64; ntot = 72; Tv = 4096;
        vbase = 2097152 + (size_t)(b * 8 + h) * 64 * 4096; kcrow0 = b * 512; vcbase = (size_t)(b * 8 + h) * 64 * 512; }
    else { const int v = u - 1024; b = v >> 4; h = (v >> 1) & 7; qt = v & 1; krow0 = b * 256; qrow0 = krow0 + qt * 128; nown = 4; ntot = 4; Tv = 256; vbase = (size_t)(b * 8 + h) * 64 * 256; }
    bf16x8 qf[6];
    { const bf16_t* qp = p.Qb + (size_t)(qrow0 + wid * 32 + q) * 768 + h * 96 + hf * 8;
#pragma unroll
      for (int ks = 0; ks < 6; ++ks) qf[ks] = *(const bf16x8*)(qp + ks * 16); }
    f32x16 oT[2];
#pragma unroll
    for (int i = 0; i < 16; ++i) { oT[0][i] = 0.f; oT[1][i] = 0.f; }
    float mref = 0.f, lrun = 0.f; f32x16 negm;
#pragma unroll
    for (int i = 0; i < 16; ++i) negm[i] = 0.f;
    u32x4 rk[3], rv[2];
    int krow[3], kc[3];
#pragma unroll
    for (int i = 0; i < 3; ++i) { const int c = tid + 256 * i; krow[i] = c / 12; kc[i] = c % 12; }
    const int vdv0 = tid >> 3, vkc = tid & 7;
#define ATT_LOAD(kt) do { const bf16_t* kptr; const bf16_t* vptr; int vstr; \
        if ((kt) < nown) { kptr = p.Kb + (size_t)(krow0 + (kt) * 64) * 768 + h * 96; vptr = p.Vt + vbase + (kt) * 64; vstr = Tv; } \
        else { kptr = p.Kc + (size_t)(kcrow0 + ((kt) - nown) * 64) * 768 + h * 96; vptr = p.Vtc + vcbase + ((kt) - nown) * 64; vstr = 512; } \
        _Pragma("unroll") for (int i = 0; i < 3; ++i) rk[i] = *(const u32x4*)(kptr + (size_t)krow[i] * 768 + kc[i] * 8); \
        _Pragma("unroll") for (int i = 0; i < 2; ++i) rv[i] = *(const u32x4*)(vptr + (size_t)(vdv0 + 32 * i) * vstr + vkc * 8); } while (0)
#define ATT_STORE(buf) do { char* Ks_ = smem + (buf) * ATT_STAGE; char* Vs_ = Ks_ + KS_BYTES; \
        _Pragma("unroll") for (int i = 0; i < 3; ++i) *(u32x4*)(Ks_ + (krow[i] * KS_STRIDE + kc[i] * 8) * 2) = rk[i]; \
        _Pragma("unroll") for (int i = 0; i < 2; ++i) { char* vd_ = Vs_ + ((vdv0 + 32 * i) * VS_STRIDE + vkc * 8) * 2; *(u32x2*)vd_ = (u32x2){rv[i].x, rv[i].y}; *(u32x2*)(vd_ + 8) = (u32x2){rv[i].z, rv[i].w}; } } while (0)
    ATT_LOAD(0); ATT_STORE(0);
    __syncthreads();
    for (int kt = 0; kt < ntot; ++kt) {
        const bool more = kt + 1 < ntot;
        if (more) ATT_LOAD(kt + 1);
        const char* Ks = smem + (kt & 1) * ATT_STAGE; const char* Vs = Ks + KS_BYTES;
        f32x16 sT[2];
#pragma unroll
        for (int kb = 0; kb < 2; ++kb)
#pragma unroll
            for (int ks = 0; ks < 6; ++ks) { const bf16x8 kf = *(const bf16x8*)(Ks + ((kb * 32 + q) * KS_STRIDE + ks * 16 + hf * 8) * 2);
                sT[kb] = __builtin_amdgcn_mfma_f32_32x32x16_bf16(kf, qf[ks], ks == 0 ? negm : sT[kb], 0, 0, 0); }
        bf16x8 pf[2][2]; float psum0 = 0.f;
#define ATT_EXP(kb_, acc_) do { _Pragma("unroll") for (int s_ = 0; s_ < 2; ++s_) { float e_[8]; \
            _Pragma("unroll") for (int j_ = 0; j_ < 8; ++j_) { e_[j_] = __builtin_amdgcn_exp2f(sT[kb_][8 * s_ + j_]); acc_ += e_[j_]; } \
            u32x4 w_; w_.x = pack2(e_[0], e_[1]); w_.y = pack2(e_[2], e_[3]); w_.z = pack2(e_[4], e_[5]); w_.w = pack2(e_[6], e_[7]); \
            pf[kb_][s_] = __builtin_bit_cast(bf16x8, w_); } } while (0)
        ATT_EXP(0, psum0);
        float mx = sT[0][0];
#pragma unroll
        for (int i = 1; i < 16; ++i) mx = fmaxf(mx, sT[0][i]);
#pragma unroll
        for (int i = 0; i < 16; ++i) mx = fmaxf(mx, sT[1][i]);
        { auto r_ = __builtin_amdgcn_permlane32_swap(__float_as_uint(mx), __float_as_uint(mx), false, false);
          mx = fmaxf(__uint_as_float(r_[0]), __uint_as_float(r_[1])); }
        const bool first = (kt == 0);
        if (first || __any(mx > ATT_THR)) {
            const float delta = first ? mx : ((mx > ATT_THR) ? mx : 0.f);
            const float alpha = first ? 0.f : __builtin_amdgcn_exp2f(-delta);
            mref += delta; lrun *= alpha;
#pragma unroll
            for (int i = 0; i < 16; ++i) { sT[0][i] -= delta; sT[1][i] -= delta; oT[0][i] *= alpha; oT[1][i] *= alpha; negm[i] = -mref; }
            psum0 = 0.f; ATT_EXP(0, psum0);
        }
        float psum1 = 0.f;
        ATT_EXP(1, psum1);
        lrun += psum0 + psum1;
#pragma unroll
        for (int kb = 0; kb < 2; ++kb)
#pragma unroll
            for (int s = 0; s < 2; ++s)
#pragma unroll
                for (int db = 0; db < 2; ++db) {
                    const char* vp = Vs + ((db * 32 + q) * VS_STRIDE + kb * 32 + 16 * s + 4 * hf) * 2;
                    const u32x2 lo = *(const u32x2*)vp, hi = *(const u32x2*)(vp + 16);
                    const u32x4 w = (u32x4){lo.x, lo.y, hi.x, hi.y};
                    oT[db] = __builtin_amdgcn_mfma_f32_32x32x16_bf16(__builtin_bit_cast(bf16x8, w), pf[kb][s], oT[db], 0, 0, 0);
                }
        if (more) ATT_STORE((kt + 1) & 1);
        __syncthreads();
    }
    const float lt = lrun + __shfl_xor(lrun, 32); const float inv = 1.0f / lt;
    bf16_t* op = p.hbmix + (size_t)(qrow0 + wid * 32 + q) * DM + 256 + h * 64;
#pragma unroll
    for (int db = 0; db < 2; ++db)
#pragma unroll
        for (int g = 0; g < 4; ++g) { u32x2 w; w.x = pack2(oT[db][4 * g] * inv, oT[db][4 * g + 1] * inv); w.y = pack2(oT[db][4 * g + 2] * inv, oT[db][4 * g + 3] * inv);
            *(u32x2*)(op + db * 32 + 8 * g + 4 * hf) = w; }
}

__device__ __forceinline__ void rwcomb_phase(const P& p, int l) {
    const int tid = opaque_tid(), lane = tid & 63, wid = tid >> 6; const int c = lane * 4;
    const f32x4 gng = *(const f32x4*)(p.rw_gn_g + l * 256 + c), gnb = *(const f32x4*)(p.rw_gn_b + l * 256 + c), kap = *(const f32x4*)(p.rw_ka + l * 256 + c), rkp = *(const f32x4*)(p.rw_rk + l * 256 + c);
    for (int row = blockIdx.x * 4 + wid; row < M_ALL; row += gridDim.x * 4) {
        const f32x4 y0 = *(const f32x4*)(p.ydir + (size_t)row * 256 + c), y1 = *(const f32x4*)(p.ydir + ((size_t)M_ALL + row) * 256 + c);
        f32x4 y = y0 + y1;
        float s = (y[0] + y[1]) + (y[2] + y[3]); s = red16(s); const float mu = s * (1.0f / 64.0f);
        const f32x4 dd = y - mu; float q2 = (dd[0] * dd[0] + dd[1] * dd[1]) + (dd[2] * dd[2] + dd[3] * dd[3]); q2 = red16(q2);
        const float rstd = rsqrtf(q2 * (1.0f / 64.0f) + 64e-5f);
        const f32x4 yn = dd * rstd * gng + gnb;
        const u32x2 rw = *(const u32x2*)(p.RKV + (size_t)row * 768 + c), kw = *(const u32x2*)(p.RKV + (size_t)row * 768 + 256 + c), vw = *(const u32x2*)(p.RKV + (size_t)row * 768 + 512 + c);
        const u32x2 a0w = *(const u32x2*)(p.Aa + (size_t)row * 256 + c), a1w = *(const u32x2*)(p.Aa + ((size_t)M_ALL + row) * 256 + c), gw = *(const u32x2*)(p.Gg + (size_t)row * 256 + c);
        const f32x4 r = (f32x4){lo_bf(rw.x), hi_bf(rw.x), lo_bf(rw.y), hi_bf(rw.y)}, k = (f32x4){lo_bf(kw.x), hi_bf(kw.x), lo_bf(kw.y), hi_bf(kw.y)}, v = (f32x4){lo_bf(vw.x), hi_bf(vw.x), lo_bf(vw.y), hi_bf(vw.y)};
        const f32x4 a0 = (f32x4){lo_bf(a0w.x), hi_bf(a0w.x), lo_bf(a0w.y), hi_bf(a0w.y)}, a1 = (f32x4){lo_bf(a1w.x), hi_bf(a1w.x), lo_bf(a1w.y), hi_bf(a1w.y)}, gt = (f32x4){lo_bf(gw.x), hi_bf(gw.x), lo_bf(gw.y), hi_bf(gw.y)};
        const f32x4 kds = k * (1.0f + (a0 - 1.0f) * kap) + k * (1.0f + (a1 - 1.0f) * kap);
        const f32x4 t4 = r * kds * rkp; float rk = (t4[0] + t4[1]) + (t4[2] + t4[3]); rk = red16(rk);
        const f32x4 o = (yn + rk * v) * gt;
        u32x2 w; w.x = pack2(o[0], o[1]); w.y = pack2(o[2], o[3]);
        *(u32x2*)(p.hbmix + (size_t)row * DM + c) = w;
    }
}


__device__ __forceinline__ bool xcd_tile(int i, int TT, int NT, int& mt, int& nt) {
    const int per = TT >> 3; if (i >= per) return false;
    const int t = (blockIdx.x & 7) * per + i; const int band = t / (8 * NT), rem = t - band * 8 * NT;
    nt = rem >> 3; mt = band * 8 + (rem & 7); return true;
}
__global__ void __launch_bounds__(256, 2) mega(Args a_unused) {
    extern __shared__ __attribute__((aligned(16))) char smem[];
    __shared__ uint4 xbw; __shared__ int s_unit;
    kargp_t kp = (kargp_t)__builtin_amdgcn_kernarg_segment_ptr();
    const int tid = threadIdx.x; const int G = gridDim.x;
    if (tid == 0) xbw = make_uint4(0u, 0u, 0u, 0u);
    __syncthreads();
    XcdBarrier xb;
    { const P p = getP(kp); xb = xcd_barrier_post(p.bar, (volatile LAS unsigned*)&xbw); }
    for (int u = blockIdx.x; u < NADA + NCONV + 272; u += G) {
        if (u < NADA) { const P p = getP(kp); ada_unit(p, u, smem); } else if (u < NADA + NCONV) { const P p = getP(kp); conv_unit(p, 0, u - NADA, smem); } else { const P p = getP(kp); misc0_unit(p, u - NADA - NCONV); }
    }
    cg::this_grid().sync();
    { const P p = getP(kp); ln_phase(p, 0, 0); }
    xcd_barrier(xb);
    float* rs = (float*)(smem + RS_OFF);
#pragma unroll 1
    for (int l = 0; l < 4; ++l) {
        for (int i = blockIdx.x >> 3; ; i += G >> 3) { int mt, nt; if (!xcd_tile(i, 80 * 17, 17, mt, nt)) break; const P p = getP(kp);
            EpiZ e{p.Z, mt * 256, nt * 128};
            gemm256(p.hbmix + (size_t)mt * 256 * DM, DM, p.WtIn + (size_t)nt * 128 * DM, DM, DM, smem, e); }
        xcd_barrier(xb);
        for (int rep2 = 0; rep2 < DUP_P2; ++rep2) {
        for (;;) {
            { const P pc = getP(kp); if (tid == 0) s_unit = atomicAdd(&pc.ctr[l * 4 + 0 + 2 * rep2], 1); }
            __syncthreads(); int u = s_unit; __syncthreads();
            if (u >= 320 + 480 + 640 + 64 + 352 + 640) break;
            if (u < 320) { const P p = getP(kp); rwprep_unit(p, l, u, smem); continue; }
            u -= 320;
            if (u < 480) { const P p = getP(kp); const int mt = u / 3, np = u % 3;
                rowscale128(p.Z, mt * 128, ZQ, 256, 1e-6f, rs);
                for (int k2 = 0; k2 < 2; ++k2) { const int nt = np * 2 + k2;
                    EpiQ e{p.Qb, rs, p.ropeC, p.ropeS, mt * 128, nt * 128};
                    gemm128<true>(p.Z + (size_t)mt * 128 * NIN + ZQ, NIN, p.WtQ + (size_t)nt * 128 * 256, 256, 256, smem, e); }
                __syncthreads(); continue; }
            u -= 480;
            if (u < 640) { const P p = getP(kp); const int mt = u >> 2, np = u & 3; const int R0 = mt * 128; const bool latr = R0 >= M_CTX;
                rowscale128(p.Z, R0, ZKV, 128, 1e-6f, rs);
                for (int k2 = 0; k2 < 2; ++k2) { const int nt = np * 2 + k2;
                    if (np < 2) { EpiKN e{latr ? p.Kb + (size_t)M_CTX * 768 : p.Kb, rs, latr ? R0 - M_CTX : R0, nt * 128};
                        gemm128<true>(p.Z + (size_t)R0 * NIN + ZKV, NIN, p.WtKVn + (size_t)nt * 128 * 128, 128, 128, smem, e); }
                    else { EpiKV e{latr ? p.Kb + (size_t)M_CTX * 768 : p.Kb, p.Vt, rs, latr ? R0 - M_CTX : R0, nt * 128, latr ? 12 : 8, latr ? (size_t)2097152 : (size_t)0};
                        gemm128<false>(p.Z + (size_t)R0 * NIN + ZKV, NIN, p.WtKVn + (size_t)nt * 128 * 128, 128, 128, smem, e); } }
                __syncthreads(); continue; }
            u -= 640;
            if (u < 64) { const P p = getP(kp); const int mt = u >> 2, np = u & 3;
                for (int k2 = 0; k2 < 2; ++k2) { const int nt = np * 2 + k2;
                    if (np < 2) { EpiKN e{p.Kc, nullptr, mt * 128, nt * 128};
                        gemm128<true>(p.CkvB + ((size_t)l * 2048 + mt * 128) * 128, 128, p.WtKV + (size_t)nt * 128 * 128, 128, 128, smem, e); }
                    else { EpiKV e{p.Kc, p.Vtc, nullptr, mt * 128, nt * 128, 9, (size_t)0};
                        gemm128<false>(p.CkvB + ((size_t)l * 2048 + mt * 128) * 128, 128, p.WtKV + (size_t)nt * 128 * 128, 128, 128, smem, e); } }
                continue; }
            u -= 64;
            if (u < 352) { const P p = getP(kp); for (int i = 0; i < 8; ++i) small_unit(p, l, u * 8 + i); continue; }
            u -= 352;
            { const P p = getP(kp); gmlp_unit(p, l, u, smem); }
        }
        xcd_barrier(xb);
        }
        for (int rep3 = 0; rep3 < DUP_P3; ++rep3) {
        for (;;) {
            { const P pc = getP(kp); if (tid == 0) s_unit = atomicAdd(&pc.ctr[l * 4 + 1 + 2 * rep3], 1); }
            __syncthreads(); int u = s_unit; __syncthreads();
            if (u >= NSCAN + 1280) break;
#ifdef PROBE_SCAN_ONLY
            if (rep3 == 1 && u >= NSCAN) break;
#endif
#ifdef PROBE_ATTN_ONLY
            if (rep3 == 1 && u < NSCAN) continue;
#endif
            if (u < NSCAN) { const P p = getP(kp); scan_unit(p, l, u, smem); } else { const P p = getP(kp); attn_unit(p, u - NSCAN, smem); }
        }
        xcd_barrier(xb);
        }
        { const P p = getP(kp); rwcomb_phase(p, l); }
        xcd_barrier(xb);
        for (int i = blockIdx.x >> 3; ; i += G >> 3) { int mt, nt; if (!xcd_tile(i, 160 * 8, 8, mt, nt)) break; const P p = getP(kp);
            EpiRes e{p.out, p.mod + ((size_t)l * 5 + modrow_of(mt * 128)) * 6144 + 2048, mt * 128, nt * 128};
            gemm128<true>(p.hbmix + (size_t)mt * 128 * DM, DM, p.WtOut + (size_t)nt * 128 * DM, DM, DM, smem, e); }
        xcd_barrier(xb);
        { const P p = getP(kp); ln_phase(p, l, 1); }
        xcd_barrier(xb);
        for (int rep5 = 0; rep5 < DUP_P5; ++rep5)
        for (int i = blockIdx.x >> 3; ; i += G >> 3) { int mt, nt; if (!xcd_tile(i, 80 * 44, 44, mt, nt)) break; const P p = getP(kp);
            EpiSwi e{p.hidden, mt * 256, nt * 128};
            gemm256(p.hbmix + (size_t)mt * 256 * DM, DM, p.WtF1 + (size_t)nt * 128 * DM, DM, DM, smem, e); }
        xcd_barrier(xb);
        for (int i = blockIdx.x >> 3; ; i += G >> 3) { int mt, nt; if (!xcd_tile(i, 160 * 8, 8, mt, nt)) break; const P p = getP(kp);
            EpiRes e{p.out, p.mod + ((size_t)l * 5 + modrow_of(mt * 128)) * 6144 + 5120, mt * 128, nt * 128};
            gemm128<true>(p.hidden + (size_t)mt * 128 * DFF, DFF, p.WtF2 + (size_t)nt * 128 * DFF, DFF, DFF, smem, e); }
        xcd_barrier(xb);
        { const P p = getP(kp); ln_phase(p, l, 2); }
        if (l < 3) { for (int u = blockIdx.x; u < NCONV; u += G) { const P p = getP(kp); conv_unit(p, l + 1, u, smem); } }
        xcd_barrier(xb);
    }
}

extern "C" void kernel_launch(void* const* d_in, const int* in_sizes, int n_in, void* d_out, int out_size, void* d_ws, size_t ws_size, hipStream_t stream) {
    static int grid_blocks = 0;
    if (!grid_blocks) {
        int dev = 0, cus = 0, per_cu = 0;
        (void)hipGetDevice(&dev);
        (void)hipDeviceGetAttribute(&cus, hipDeviceAttributeMultiprocessorCount, dev);
        (void)hipFuncSetAttribute((const void*)mega, hipFuncAttributeMaxDynamicSharedMemorySize, SMEM_BYTES);
        (void)hipOccupancyMaxActiveBlocksPerMultiprocessor(&per_cu, (const void*)mega, 256, SMEM_BYTES);
        if (per_cu > 2) per_cu = 2;
        if (per_cu < 1) per_cu = 1;
        grid_blocks = (cus * per_cu) & ~7;
    }
    if (WS_TOTAL > ws_size) { fprintf(stderr, "kernel_launch: workspace too small: need %zu have %zu\n", (size_t)WS_TOTAL, ws_size); return; }
    Args a{};
    for (int i = 0; i < 36; ++i) a.in[i] = (const float*)d_in[i];
    a.out = (float*)d_out; a.ws = (char*)d_ws;
    (void)hipMemsetAsync((char*)d_ws + OFF_BAR, 0, 16384 + 4096, stream);
    void* args[] = {&a};
    hipError_t e = hipLaunchCooperativeKernel((const void*)mega, dim3(grid_blocks), dim3(256), args, SMEM_BYTES, stream);
    if (e != hipSuccess) fprintf(stderr, "cooperative launch failed: %s (grid %d)\n", hipGetErrorString(e), grid_blocks);
}
```

```cpp
#include <hip/hip_runtime.h>
#include <hip/hip_cooperative_groups.h>
#include <cstdint>
#include <cstdio>
namespace cg = cooperative_groups;

typedef unsigned short bf16_t;
typedef short bf16x8 __attribute__((ext_vector_type(8)));
typedef float f32x4 __attribute__((ext_vector_type(4)));
typedef float f32x2 __attribute__((ext_vector_type(2)));
typedef float f32x16 __attribute__((ext_vector_type(16)));
typedef unsigned u32x4 __attribute__((ext_vector_type(4)));
typedef unsigned u32x2 __attribute__((ext_vector_type(2)));

#define M_ALL 20480
#define M_CTX 4096
#define DM 1024
#define NIN 2080
#define DFF 2816
#define ALPHA_F 1.6817928305074290f
#define QSCALE (0.10206207261596575f * 1.4426950408889634f)
#define LAS __attribute__((address_space(3)))
#ifndef DUP_P2
#define DUP_P2 1
#endif
#ifndef DUP_P3
#define DUP_P3 1
#endif
#ifndef DUP_P5
#define DUP_P5 1
#endif

#define ZQ 1152
#define ZKV 1408
#define ZKR 1536
#define ZU 1568
#define ZV 1824

#define LDS_STRIDE 72
#define TILE_BYTES (128 * LDS_STRIDE * 2)
#define RS_OFF (4 * TILE_BYTES)
#define SMEM_BYTES (RS_OFF + 3072)

struct P {
    const float *x_prompt, *x_sample, *cache_ckv, *cache_krope, *state_rwkv, *c, *c_ctx, *ada_w, *ada_b, *w_in, *rw_conv, *rw_w0, *rw_w2,
        *rw_a0, *rw_a2, *rw_g2, *rw_kk, *rw_ka, *rw_rk, *rw_gn_g, *rw_gn_b, *q_norm, *q_up, *kv_norm, *kv_up, *gm_g, *gm_b, *gm_ws, *gm_bs,
        *w_out, *ln1_g, *ln1_b, *ffn_in, *ffn_out, *ln2_g, *ln2_b;
    float* out;
    unsigned* bar; int* ctr; float* mod; float* ropeC; float* ropeS; bf16_t* CkvB;
    bf16_t *WtIn, *WtQ, *WtKVn, *WtKV, *WtOut, *WtF1, *WtF2, *WsB, *W2t, *A2t, *G2t;
    bf16_t *Z, *RKV, *Ee, *Aa, *Gg, *Qb, *Kb, *Kc, *Vt, *Vtc, *hbmix, *hidden;
    float* ydir;
};


struct Args { const float* in[36]; float* out; char* ws; };
typedef const __attribute__((address_space(4))) char* kargp_t;
constexpr size_t al256(size_t x) { return (x + 255) & ~(size_t)255; }
constexpr size_t OFF_BAR = 0;
constexpr size_t OFF_CTR = OFF_BAR + 16384;
constexpr size_t OFF_MOD = OFF_CTR + 4096;
constexpr size_t OFF_ROPEC = OFF_MOD + al256((size_t)4 * 5 * 6144 * 4);
constexpr size_t OFF_ROPES = OFF_ROPEC + 65536 * 4;
constexpr size_t OFF_CKVB = OFF_ROPES + 65536 * 4;
constexpr size_t OFF_WTIN = OFF_CKVB + (size_t)4 * 2048 * 128 * 2;
constexpr size_t OFF_WTQ = OFF_WTIN + (size_t)2176 * 1024 * 2;
constexpr size_t OFF_WTKVN = OFF_WTQ + (size_t)768 * 256 * 2;
constexpr size_t OFF_WTKV = OFF_WTKVN + (size_t)1024 * 128 * 2;
constexpr size_t OFF_WTOUT = OFF_WTKV + (size_t)1024 * 128 * 2;
constexpr size_t OFF_WTF1 = OFF_WTOUT + (size_t)1024 * 1024 * 2;
constexpr size_t OFF_WTF2 = OFF_WTF1 + (size_t)5632 * 1024 * 2;
constexpr size_t OFF_WSB = OFF_WTF2 + (size_t)1024 * DFF * 2;
constexpr size_t OFF_W2T = OFF_WSB + (size_t)65536 * 2;
constexpr size_t OFF_A2T = OFF_W2T + (size_t)2 * 256 * 64 * 2;
constexpr size_t OFF_G2T = OFF_A2T + (size_t)2 * 256 * 64 * 2;
constexpr size_t OFF_Z = OFF_G2T + (size_t)256 * 128 * 2;
constexpr size_t OFF_HIDDEN = OFF_Z;
constexpr size_t OFF_RKV = OFF_Z + al256((size_t)M_ALL * NIN * 2);
constexpr size_t OFF_EE = OFF_RKV + (size_t)M_ALL * 768 * 2;
constexpr size_t OFF_AA = OFF_EE + (size_t)2 * M_ALL * 256 * 2;
constexpr size_t OFF_GG = OFF_AA + (size_t)2 * M_ALL * 256 * 2;
constexpr size_t OFF_QB = OFF_GG + (size_t)M_ALL * 256 * 2;
constexpr size_t OFF_KB = OFF_QB + (size_t)M_ALL * 768 * 2;
constexpr size_t OFF_KC = OFF_KB + (size_t)M_ALL * 768 * 2;
constexpr size_t OFF_VT = OFF_KC + (size_t)2048 * 768 * 2;
constexpr size_t OFF_VTC = OFF_VT + (size_t)M_ALL * 512 * 2;
constexpr size_t OFF_YDIR = OFF_VTC + (size_t)2048 * 512 * 2;
constexpr size_t OFF_HBMIX = OFF_YDIR + (size_t)2 * M_ALL * 256 * 4;
constexpr size_t WS_TOTAL = OFF_HBMIX + (size_t)M_ALL * DM * 2;
static_assert(OFF_RKV + (size_t)M_ALL * 768 * 2 - OFF_HIDDEN >= (size_t)M_ALL * DFF * 2, "hidden overlay");

__device__ __forceinline__ P getP(kargp_t& kp) {
    asm volatile("" : "+s"(kp));
    typedef const float* const __attribute__((address_space(4)))* inp_t;
    inp_t in = (inp_t)kp;
    P p;
    p.x_prompt = in[0]; p.x_sample = in[1]; p.cache_ckv = in[2]; p.cache_krope = in[3]; p.state_rwkv = in[4]; p.c = in[5]; p.c_ctx = in[6];
    p.ada_w = in[7]; p.ada_b = in[8]; p.w_in = in[9]; p.rw_conv = in[10]; p.rw_w0 = in[11]; p.rw_w2 = in[12]; p.rw_a0 = in[13]; p.rw_a2 = in[14];
    p.rw_g2 = in[15]; p.rw_kk = in[16]; p.rw_ka = in[17]; p.rw_rk = in[18]; p.rw_gn_g = in[19]; p.rw_gn_b = in[20]; p.q_norm = in[21]; p.q_up = in[22];
    p.kv_norm = in[23]; p.kv_up = in[24]; p.gm_g = in[25]; p.gm_b = in[26]; p.gm_ws = in[27]; p.gm_bs = in[28]; p.w_out = in[29]; p.ln1_g = in[30];
    p.ln1_b = in[31]; p.ffn_in = in[32]; p.ffn_out = in[33]; p.ln2_g = in[34]; p.ln2_b = in[35];
    p.out = (float*)in[36]; char* ws = (char*)in[37];
    p.bar = (unsigned*)(ws + OFF_BAR); p.ctr = (int*)(ws + OFF_CTR); p.mod = (float*)(ws + OFF_MOD); p.ropeC = (float*)(ws + OFF_ROPEC); p.ropeS = (float*)(ws + OFF_ROPES);
    p.CkvB = (bf16_t*)(ws + OFF_CKVB); p.WtIn = (bf16_t*)(ws + OFF_WTIN); p.WtQ = (bf16_t*)(ws + OFF_WTQ); p.WtKVn = (bf16_t*)(ws + OFF_WTKVN); p.WtKV = (bf16_t*)(ws + OFF_WTKV);
    p.WtOut = (bf16_t*)(ws + OFF_WTOUT); p.WtF1 = (bf16_t*)(ws + OFF_WTF1); p.WtF2 = (bf16_t*)(ws + OFF_WTF2); p.WsB = (bf16_t*)(ws + OFF_WSB); p.W2t = (bf16_t*)(ws + OFF_W2T);
    p.A2t = (bf16_t*)(ws + OFF_A2T); p.G2t = (bf16_t*)(ws + OFF_G2T); p.Z = (bf16_t*)(ws + OFF_Z); p.RKV = (bf16_t*)(ws + OFF_RKV); p.Ee = (bf16_t*)(ws + OFF_EE); p.Aa = (bf16_t*)(ws + OFF_AA);
    p.Gg = (bf16_t*)(ws + OFF_GG); p.Qb = (bf16_t*)(ws + OFF_QB); p.Kb = (bf16_t*)(ws + OFF_KB); p.Kc = (bf16_t*)(ws + OFF_KC); p.Vt = (bf16_t*)(ws + OFF_VT); p.Vtc = (bf16_t*)(ws + OFF_VTC);
    p.hbmix = (bf16_t*)(ws + OFF_HBMIX); p.hidden = (bf16_t*)(ws + OFF_HIDDEN); p.ydir = (float*)(ws + OFF_YDIR);
    return p;
}

__device__ __forceinline__ float bf2f(bf16_t b) { return __uint_as_float(((unsigned)b) << 16); }
__device__ __forceinline__ unsigned pack2(float lo, float hi) { unsigned r; asm("v_cvt_pk_bf16_f32 %0, %1, %2" : "=v"(r) : "v"(lo), "v"(hi)); return r; }
__device__ __forceinline__ bf16_t f2bf(float f) { return (bf16_t)(pack2(f, 0.f) & 0xffffu); }
__device__ __forceinline__ float lo_bf(unsigned w) { return __uint_as_float(w << 16); }
__device__ __forceinline__ float hi_bf(unsigned w) { return __uint_as_float(w & 0xffff0000u); }
__device__ __forceinline__ float sigmoidf_(float x) { return __builtin_amdgcn_rcpf(1.0f + __builtin_amdgcn_exp2f(-1.4426950408889634f * x)); }
__device__ __forceinline__ float tanhf_(float x) { float e = __builtin_amdgcn_exp2f(2.8853900817779268f * x); return 1.0f - 2.0f * __builtin_amdgcn_rcpf(e + 1.0f); }
__device__ __forceinline__ float geluf_(float x) { return 0.5f * x * (1.0f + tanhf_(0.7978845608028654f * (x + 0.044715f * x * x * x))); }
template <int CTRL> __device__ __forceinline__ float dpp_add(float x) {
    int y = __builtin_amdgcn_update_dpp(0, __float_as_int(x), CTRL, 0xf, 0xf, false);
    return x + __int_as_float(y);
}
__device__ __forceinline__ float red4(float x) { x = dpp_add<0xB1>(x); x = dpp_add<0x4E>(x); return x; }
__device__ __forceinline__ float red8(float x) { x = red4(x); x = dpp_add<0x141>(x); return x; }
__device__ __forceinline__ float red16(float x) { x = red8(x); x = dpp_add<0x140>(x); return x; }
__device__ __forceinline__ int opaque_tid() { int t = threadIdx.x; asm volatile("" : "+v"(t)); return t; }
__device__ __forceinline__ int modrow_of(int row) { return row < M_CTX ? 0 : 1 + ((row - M_CTX) >> 12); }

#define XB_TMO 128
#define XB_XCNT(j) (256 + 64 * (j))
#define XB_XSUB(j) (1280 + 64 * (j))
#define XB_XGEN(j) (2304 + 64 * (j))
#define XB_TOP 3328
#define XB_TOPGEN 3392
#define XCD_BAR_WORDS 3456
#define XB_SPIN_CAP (1u << 22)
__device__ __forceinline__ unsigned xb_ld(unsigned* p) { return __hip_atomic_load(p, __ATOMIC_RELAXED, __HIP_MEMORY_SCOPE_AGENT); }
__device__ __forceinline__ unsigned xb_add(unsigned* p, unsigned v) { return __hip_atomic_fetch_add(p, v, __ATOMIC_RELAXED, __HIP_MEMORY_SCOPE_AGENT); }
__device__ __forceinline__ unsigned xb_xcc_id() { return (unsigned)__builtin_amdgcn_s_getreg((3 << 11) | 20) & 0xFu; }
#define XB_SPIN(cond, bar) do { unsigned _sp = 0; while (cond) { __builtin_amdgcn_s_sleep(1); \
    if ((++_sp & 255u) == 0u) { if (xb_ld(&(bar)[XB_TMO])) break; if (_sp > XB_SPIN_CAP) { atomicAdd(&(bar)[XB_TMO], 1u); break; } } } } while (0)
struct XcdBarrier { unsigned* bar; unsigned x; volatile LAS unsigned* st; };
__device__ __forceinline__ XcdBarrier xcd_barrier_post(unsigned* bar, volatile LAS unsigned* st) {
    XcdBarrier b; b.bar = bar; b.x = xb_xcc_id(); b.st = st;
    if (threadIdx.x == 0) (void)xb_add(&bar[XB_XCNT(b.x)], 1u);
    return b;
}
__device__ __forceinline__ void xcd_barrier_complete(unsigned* bar, unsigned x, unsigned& nloc, unsigned& nx) {
    const unsigned G = gridDim.x * gridDim.y * gridDim.z;
    unsigned sum, cnt, mine, sp = 0u;
    for (;;) {
        sum = 0u; cnt = 0u; mine = 0u;
#pragma unroll
        for (unsigned j = 0; j < 16; ++j) { const unsigned c = xb_ld(&bar[XB_XCNT(j)]); sum += c; cnt += (c > 0u) ? 1u : 0u; mine = (j == x) ? c : mine; }
        if (sum == G) break;
        __builtin_amdgcn_s_sleep(1);
        if ((++sp & 255u) == 0u) { if (xb_ld(&bar[XB_TMO])) break; if (sp > XB_SPIN_CAP) { atomicAdd(&bar[XB_TMO], 1u); break; } }
    }
    nloc = mine > 0u ? mine : 1u; nx = cnt > 0u ? cnt : 1u;
}
__device__ __forceinline__ void xcd_barrier(const XcdBarrier& b) {
    asm volatile("s_waitcnt vmcnt(0)" ::: "memory");
    __syncthreads();
    if (threadIdx.x == 0) {
        unsigned* bar = b.bar;
        __builtin_amdgcn_s_waitcnt(0);
        unsigned nloc = b.st[0], nx = b.st[1];
        if (nloc == 0u) { xcd_barrier_complete(bar, b.x, nloc, nx); b.st[0] = nloc; b.st[1] = nx; }
        const unsigned old = xb_add(&bar[XB_XSUB(b.x)], 1u);
        const unsigned gen = old / nloc;
        if (old + 1u == (gen + 1u) * nloc) {
            __builtin_amdgcn_fence(__ATOMIC_RELEASE, "agent");
            asm volatile("s_waitcnt vmcnt(0)" ::: "memory");
            const unsigned og = xb_add(&bar[XB_TOP], 1u);
            const unsigned tg = og / nx;
            if (og + 1u == (tg + 1u) * nx) xb_add(&bar[XB_TOPGEN], 1u);
            else XB_SPIN(xb_ld(&bar[XB_TOPGEN]) == tg, bar);
            __builtin_amdgcn_fence(__ATOMIC_ACQUIRE, "agent");
            xb_add(&bar[XB_XGEN(b.x)], 1u);
            asm volatile("s_waitcnt vmcnt(0)" ::: "memory");
        } else {
            XB_SPIN(xb_ld(&bar[XB_XGEN(b.x)]) == gen, bar);
            __builtin_amdgcn_fence(__ATOMIC_ACQUIRE, "agent");
            asm volatile("s_waitcnt vmcnt(0)" ::: "memory");
        }
    }
    __syncthreads();
}

template <bool TR, class Epi>
__device__ __forceinline__ void gemm128(const bf16_t* __restrict__ A, int lda, const bf16_t* __restrict__ B, int ldb, int K, char* smem, const Epi& epi) {
    const int tid = opaque_tid(), lane = tid & 63, wid = tid >> 6, wr = wid >> 1, wc = wid & 1, fr = lane & 15, fq = lane >> 4;
    f32x4 acc[4][4];
#pragma unroll
    for (int m = 0; m < 4; ++m)
#pragma unroll
        for (int n = 0; n < 4; ++n) acc[m][n] = (f32x4){0.f, 0.f, 0.f, 0.f};
    const int crow = tid >> 3, ckc = tid & 7;
    const bf16_t* ap = A + (size_t)crow * lda + ckc * 8;
    const bf16_t* bp = B + (size_t)crow * ldb + ckc * 8;
    u32x4 ra[4], rb[4];
#pragma unroll
    for (int i = 0; i < 4; ++i) { ra[i] = *(const u32x4*)(ap + (size_t)(32 * i) * lda); rb[i] = *(const u32x4*)(bp + (size_t)(32 * i) * ldb); }
    {
        char* sa = smem; char* sb = smem + TILE_BYTES;
#pragma unroll
        for (int i = 0; i < 4; ++i) { *(u32x4*)(sa + ((crow + 32 * i) * LDS_STRIDE + ckc * 8) * 2) = ra[i]; *(u32x4*)(sb + ((crow + 32 * i) * LDS_STRIDE + ckc * 8) * 2) = rb[i]; }
    }
    __syncthreads();
    const int nk = K >> 6;
    for (int kt = 0; kt < nk; ++kt) {
        const bool more = (kt + 1 < nk);
        if (more) {
            const int k0 = (kt + 1) << 6;
#pragma unroll
            for (int i = 0; i < 4; ++i) { ra[i] = *(const u32x4*)(ap + (size_t)(32 * i) * lda + k0); rb[i] = *(const u32x4*)(bp + (size_t)(32 * i) * ldb + k0); }
        }
        const char* sa = smem + (kt & 1) * 2 * TILE_BYTES; const char* sb = sa + TILE_BYTES;
#pragma unroll
        for (int ks = 0; ks < 2; ++ks) {
            bf16x8 af[4], bfr[4];
#pragma unroll
            for (int m = 0; m < 4; ++m) af[m] = *(const bf16x8*)(sa + ((wr * 64 + m * 16 + fr) * LDS_STRIDE + ks * 32 + fq * 8) * 2);
#pragma unroll
            for (int n = 0; n < 4; ++n) bfr[n] = *(const bf16x8*)(sb + ((wc * 64 + n * 16 + fr) * LDS_STRIDE + ks * 32 + fq * 8) * 2);
            __builtin_amdgcn_s_setprio(1);
#pragma unroll
            for (int m = 0; m < 4; ++m)
#pragma unroll
                for (int n = 0; n < 4; ++n) acc[m][n] = TR ? __builtin_amdgcn_mfma_f32_16x16x32_bf16(bfr[n], af[m], acc[m][n], 0, 0, 0) : __builtin_amdgcn_mfma_f32_16x16x32_bf16(af[m], bfr[n], acc[m][n], 0, 0, 0);
            __builtin_amdgcn_s_setprio(0);
        }
        if (more) {
            char* da = smem + ((kt + 1) & 1) * 2 * TILE_BYTES; char* db = da + TILE_BYTES;
#pragma unroll
            for (int i = 0; i < 4; ++i) { *(u32x4*)(da + ((crow + 32 * i) * LDS_STRIDE + ckc * 8) * 2) = ra[i]; *(u32x4*)(db + ((crow + 32 * i) * LDS_STRIDE + ckc * 8) * 2) = rb[i]; }
        }
        __syncthreads();
    }
    epi(acc, wr * 64, wc * 64, fr, fq);
}


#define L2_STRIDE 40
#define A2_BYTES (256 * L2_STRIDE * 2)
#define B2_BYTES (128 * L2_STRIDE * 2)
#define ST2_BYTES (A2_BYTES + B2_BYTES)
template <class Epi>
__device__ __forceinline__ void gemm256(const bf16_t* __restrict__ A, int lda, const bf16_t* __restrict__ B, int ldb, int K, char* smem, const Epi& epi) {
    const int tid = opaque_tid(), lane = tid & 63, wid = tid >> 6, wr = wid >> 1, wc = wid & 1, fr = lane & 15, fq = lane >> 4;
    f32x4 acc[2][4][4];
#pragma unroll
    for (int hh = 0; hh < 2; ++hh)
#pragma unroll
        for (int m = 0; m < 4; ++m)
#pragma unroll
            for (int n = 0; n < 4; ++n) acc[hh][m][n] = (f32x4){0.f, 0.f, 0.f, 0.f};
    const int crow = tid >> 2, ckc = tid & 3;
    const bf16_t* ap = A + (size_t)crow * lda + ckc * 8;
    const bf16_t* bp = B + (size_t)crow * ldb + ckc * 8;
    u32x4 ra[4], rb[2];
#pragma unroll
    for (int i = 0; i < 4; ++i) ra[i] = *(const u32x4*)(ap + (size_t)(64 * i) * lda);
#pragma unroll
    for (int i = 0; i < 2; ++i) rb[i] = *(const u32x4*)(bp + (size_t)(64 * i) * ldb);
    {
        char* sa = smem; char* sb = smem + A2_BYTES;
#pragma unroll
        for (int i = 0; i < 4; ++i) *(u32x4*)(sa + ((crow + 64 * i) * L2_STRIDE + ckc * 8) * 2) = ra[i];
#pragma unroll
        for (int i = 0; i < 2; ++i) *(u32x4*)(sb + ((crow + 64 * i) * L2_STRIDE + ckc * 8) * 2) = rb[i];
    }
    __syncthreads();
    const int nk = K >> 5;
    for (int kt = 0; kt < nk; ++kt) {
        const bool more = (kt + 1 < nk);
        if (more) {
            const int k0 = (kt + 1) << 5;
#pragma unroll
            for (int i = 0; i < 4; ++i) ra[i] = *(const u32x4*)(ap + (size_t)(64 * i) * lda + k0);
#pragma unroll
            for (int i = 0; i < 2; ++i) rb[i] = *(const u32x4*)(bp + (size_t)(64 * i) * ldb + k0);
        }
        const char* sa = smem + (kt & 1) * ST2_BYTES; const char* sb = sa + A2_BYTES;
        bf16x8 bfr[4];
#pragma unroll
        for (int n = 0; n < 4; ++n) bfr[n] = *(const bf16x8*)(sb + ((wc * 64 + n * 16 + fr) * L2_STRIDE + fq * 8) * 2);
#pragma unroll
        for (int hh = 0; hh < 2; ++hh) {
            bf16x8 af[4];
#pragma unroll
            for (int m = 0; m < 4; ++m) af[m] = *(const bf16x8*)(sa + ((wr * 128 + hh * 64 + m * 16 + fr) * L2_STRIDE + fq * 8) * 2);
            __builtin_amdgcn_s_setprio(1);
#pragma unroll
            for (int m = 0; m < 4; ++m)
#pragma unroll
                for (int n = 0; n < 4; ++n) acc[hh][m][n] = __builtin_amdgcn_mfma_f32_16x16x32_bf16(bfr[n], af[m], acc[hh][m][n], 0, 0, 0);
            __builtin_amdgcn_s_setprio(0);
        }
        if (more) {
            char* da = smem + ((kt + 1) & 1) * ST2_BYTES; char* db = da + A2_BYTES;
#pragma unroll
            for (int i = 0; i < 4; ++i) *(u32x4*)(da + ((crow + 64 * i) * L2_STRIDE + ckc * 8) * 2) = ra[i];
#pragma unroll
            for (int i = 0; i < 2; ++i) *(u32x4*)(db + ((crow + 64 * i) * L2_STRIDE + ckc * 8) * 2) = rb[i];
        }
        __syncthreads();
    }
    epi(acc[0], wr * 128, wc * 64, fr, fq);
    epi(acc[1], wr * 128 + 64, wc * 64, fr, fq);
}

struct EpiZ {
    bf16_t* Z; int R0, C0;
    __device__ __forceinline__ void operator()(f32x4 (&acc)[4][4], int r0, int c0, int fr, int fq) const {
#pragma unroll
        for (int n = 0; n < 4; ++n) { const int col = C0 + c0 + n * 16 + fq * 4; if (col < NIN) {
#pragma unroll
            for (int m = 0; m < 4; ++m) { u32x2 w; w.x = pack2(acc[m][n][0], acc[m][n][1]); w.y = pack2(acc[m][n][2], acc[m][n][3]);
                *(u32x2*)(Z + (size_t)(R0 + r0 + m * 16 + fr) * NIN + col) = w; } } }
    }
};
struct EpiQ {
    bf16_t* Q; const float* rs; const float* ropeC; const float* ropeS; int R0, C0;
    __device__ __forceinline__ void operator()(f32x4 (&acc)[4][4], int r0, int c0, int fr, int fq) const {
        const bool lat = R0 >= M_CTX;
#pragma unroll
        for (int n = 0; n < 4; ++n) {
            const int cb = C0 + c0 + n * 16; const int hcs = cb % 96;
            if (lat && hcs == 80) continue;
            const bool rot = lat && hcs == 64;
#pragma unroll
            for (int m = 0; m < 4; ++m) {
                const int rl = r0 + m * 16 + fr; const int row = R0 + rl; const float sc = rs[rl] * QSCALE;
                const f32x4 x1 = acc[m][n] * sc; bf16_t* qp = Q + (size_t)row * 768 + cb + fq * 4;
                if (rot) {
                    const f32x4 x2 = acc[m][(n + 1) & 3] * sc; const int t = (row - M_CTX) & 4095;
                    const f32x4 cv = *(const f32x4*)(ropeC + t * 16 + fq * 4), sv = *(const f32x4*)(ropeS + t * 16 + fq * 4);
                    const f32x4 o1 = x1 * cv - x2 * sv, o2 = x1 * sv + x2 * cv;
                    u32x2 w; w.x = pack2(o1[0], o1[1]); w.y = pack2(o1[2], o1[3]); *(u32x2*)qp = w;
                    w.x = pack2(o2[0], o2[1]); w.y = pack2(o2[2], o2[3]); *(u32x2*)(qp + 16) = w;
                } else { u32x2 w; w.x = pack2(x1[0], x1[1]); w.y = pack2(x1[2], x1[3]); *(u32x2*)qp = w; }
            }
        }
    }
};
struct EpiKN {
    bf16_t* Kd; const float* rs; int R0, C0;
    __device__ __forceinline__ void operator()(f32x4 (&acc)[4][4], int r0, int c0, int fr, int fq) const {
#pragma unroll
        for (int n = 0; n < 4; ++n) { const int col = C0 + c0 + n * 16 + fq * 4; const int h = col >> 6, d = col & 63;
#pragma unroll
            for (int m = 0; m < 4; ++m) { const int rl = r0 + m * 16 + fr; const f32x4 v = acc[m][n] * (rs ? rs[rl] : 1.0f);
                u32x2 w; w.x = pack2(v[0], v[1]); w.y = pack2(v[2], v[3]); *(u32x2*)(Kd + (size_t)(R0 + rl) * 768 + h * 96 + d) = w; } }
    }
};
struct EpiKV {
    bf16_t* Kd; bf16_t* Vd; const float* rs; int R0, C0; int seqshift; size_t vbase0;
    __device__ __forceinline__ void operator()(f32x4 (&acc)[4][4], int r0, int c0, int fr, int fq) const {
#pragma unroll
        for (int n = 0; n < 4; ++n) {
            const int col = C0 + c0 + n * 16 + fr;
#pragma unroll
            for (int m = 0; m < 4; ++m) {
                const int rl = r0 + m * 16 + fq * 4; const int row = R0 + rl;
                float v[4];
#pragma unroll
                for (int j = 0; j < 4; ++j) v[j] = acc[m][n][j] * (rs ? rs[rl + j] : 1.0f);
                if (col < 512) {
                    const int h = col >> 6, d = col & 63;
#pragma unroll
                    for (int j = 0; j < 4; ++j) Kd[(size_t)(row + j) * 768 + h * 96 + d] = f2bf(v[j]);
                } else {
                    const int vc = col - 512, h = vc >> 6, dv = vc & 63; const int b = row >> seqshift, t = row & ((1 << seqshift) - 1);
                    u32x2 w; w.x = pack2(v[0], v[1]); w.y = pack2(v[2], v[3]);
                    *(u32x2*)(Vd + vbase0 + ((size_t)((b * 8 + h) * 64 + dv) << seqshift) + t) = w;
                }
            }
        }
    }
};
struct EpiRes {
    float* X; const float* gate; int R0, C0;
    __device__ __forceinline__ void operator()(f32x4 (&acc)[4][4], int r0, int c0, int fr, int fq) const {
#pragma unroll
        for (int n = 0; n < 4; ++n) { const int col = C0 + c0 + n * 16 + fq * 4; const f32x4 g = *(const f32x4*)(gate + col);
#pragma unroll
            for (int m = 0; m < 4; ++m) { float* px = X + (size_t)(R0 + r0 + m * 16 + fr) * DM + col; const f32x4 xv = *(const f32x4*)px; *(f32x4*)px = ALPHA_F * xv + g * acc[m][n]; } }
    }
};
struct EpiSwi {
    bf16_t* H; int R0, C0;
    __device__ __forceinline__ void operator()(f32x4 (&acc)[4][4], int r0, int c0, int fr, int fq) const {
        const int hb = ((C0 + c0) >> 1) + fq * 4;
#pragma unroll
        for (int n = 0; n < 2; ++n)
#pragma unroll
            for (int m = 0; m < 4; ++m) { float o[4];
#pragma unroll
                for (int j = 0; j < 4; ++j) { const float g = acc[m][n][j], u = acc[m][n + 2][j]; o[j] = g * sigmoidf_(g) * u; }
                u32x2 w; w.x = pack2(o[0], o[1]); w.y = pack2(o[2], o[3]);
                *(u32x2*)(H + (size_t)(R0 + r0 + m * 16 + fr) * DFF + hb + n * 16) = w; }
    }
};

#define NADA 192
__device__ __forceinline__ void ada_unit(const P& p, int u, char* smem) {
    const int tid = opaque_tid(); const int l = u / 48, c0 = (u % 48) * 128;
    float* cs = (float*)smem;
    for (int i = tid; i < 5 * 1024; i += 256) { const int r = i >> 10, k = i & 1023; const float v = (r == 0) ? p.c_ctx[k] : p.c[(r - 1) * 1024 + k]; cs[i] = v * sigmoidf_(v); }
    __syncthreads();
    const int cq = tid & 31, kg = tid >> 5;
    f32x4 s0 = (f32x4){0.f, 0.f, 0.f, 0.f}, s1 = s0, s2 = s0, s3 = s0, s4 = s0;
    const float* w = p.ada_w + ((size_t)l * 1024 + kg * 128) * 6144 + c0 + cq * 4;
    const float* cq_ = cs + kg * 128;
#pragma unroll 8
    for (int k = 0; k < 128; ++k) { const f32x4 wv = *(const f32x4*)(w + (size_t)k * 6144);
        s0 += cq_[k] * wv; s1 += cq_[1024 + k] * wv; s2 += cq_[2048 + k] * wv; s3 += cq_[3072 + k] * wv; s4 += cq_[4096 + k] * wv; }
    float* red = cs + 5 * 1024;
    *(f32x4*)(red + (kg * 5 + 0) * 128 + cq * 4) = s0; *(f32x4*)(red + (kg * 5 + 1) * 128 + cq * 4) = s1; *(f32x4*)(red + (kg * 5 + 2) * 128 + cq * 4) = s2;
    *(f32x4*)(red + (kg * 5 + 3) * 128 + cq * 4) = s3; *(f32x4*)(red + (kg * 5 + 4) * 128 + cq * 4) = s4;
    __syncthreads();
    for (int o = tid; o < 640; o += 256) { const int i = o >> 7, cc = o & 127; float v = p.ada_b[l * 6144 + c0 + cc];
#pragma unroll
        for (int g = 0; g < 8; ++g) v += red[(g * 5 + i) * 128 + cc];
        p.mod[((size_t)l * 5 + i) * 6144 + c0 + cc] = v; }
    __syncthreads();
}
__device__ __forceinline__ int map_col(int kind, int n) {
    if (kind == 1) { const int blk = n >> 6, r = n & 63; return r < 32 ? blk * 32 + r : DFF + blk * 32 + (r - 32); }
    if (kind == 2) { if (n < 512) return (n >> 6) * 128 + (n & 63); const int vc = n - 512; return (vc >> 6) * 128 + 64 + (vc & 63); }
    return n;
}
__device__ __forceinline__ void conv_tile(const float* src, int ldsrc, bf16_t* dst, bf16_t* dst2, int Kdst, int n0, int k0, int kind, int Nvalid, const float* kscale, char* smem) {
    const int tid = opaque_tid(); float* tile = (float*)smem;
    { const int nq = tid & 15, kq = tid >> 4; const int n = n0 + nq * 4; const int sc = (n < Nvalid) ? map_col(kind, n) : -1;
#pragma unroll
      for (int ps = 0; ps < 4; ++ps) { const int i = kq + 16 * ps;
          f32x4 v = (f32x4){0.f, 0.f, 0.f, 0.f}; if (sc >= 0) v = *(const f32x4*)(src + (size_t)(k0 + i) * ldsrc + sc);
          tile[i * 65 + nq * 4 + 0] = v[0]; tile[i * 65 + nq * 4 + 1] = v[1]; tile[i * 65 + nq * 4 + 2] = v[2]; tile[i * 65 + nq * 4 + 3] = v[3]; } }
    __syncthreads();
    { const int i2 = tid & 31, j0 = tid >> 5;
      const float ks0 = kscale ? kscale[k0 + 2 * i2] : 1.f, ks1 = kscale ? kscale[k0 + 2 * i2 + 1] : 1.f;
#pragma unroll
      for (int jj = 0; jj < 8; ++jj) { const int jx = j0 + 8 * jj; const float v0 = tile[(2 * i2) * 65 + jx], v1 = tile[(2 * i2 + 1) * 65 + jx];
          *(unsigned*)(dst + (size_t)(n0 + jx) * Kdst + k0 + 2 * i2) = pack2(v0 * ks0, v1 * ks1);
          if (dst2) *(unsigned*)(dst2 + (size_t)(n0 + jx) * Kdst + k0 + 2 * i2) = pack2(v0, v1); } }
    __syncthreads();
}
#define NCONV 3032
__device__ __forceinline__ void conv_unit(const P& p, int l, int u, char* smem) {
    const float* src; int ldsrc; bf16_t* dst; bf16_t* dst2 = nullptr; int Kdst, n0, k0, kind = 0, Nvalid; const float* kscale = nullptr;
    if (u < 544) { src = p.w_in + (size_t)l * 1024 * NIN; ldsrc = NIN; dst = p.WtIn; Kdst = 1024; n0 = (u / 16) * 64; k0 = (u % 16) * 64; Nvalid = NIN; }
    else if (u < 592) { u -= 544; src = p.q_up + (size_t)l * 256 * 768; ldsrc = 768; dst = p.WtQ; Kdst = 256; n0 = (u / 4) * 64; k0 = (u % 4) * 64; Nvalid = 768; kscale = p.q_norm + l * 256; }
    else if (u < 624) { u -= 592; src = p.kv_up + (size_t)l * 128 * 1024; ldsrc = 1024; dst = p.WtKVn; dst2 = p.WtKV; Kdst = 128; n0 = (u / 2) * 64; k0 = (u % 2) * 64; kind = 2; Nvalid = 1024; kscale = p.kv_norm + l * 128; }
    else if (u < 880) { u -= 624; src = p.w_out + (size_t)l * 1024 * 1024; ldsrc = 1024; dst = p.WtOut; Kdst = 1024; n0 = (u / 16) * 64; k0 = (u % 16) * 64; Nvalid = 1024; }
    else if (u < 2288) { u -= 880; src = p.ffn_in + (size_t)l * 1024 * 5632; ldsrc = 5632; dst = p.WtF1; Kdst = 1024; n0 = (u / 16) * 64; k0 = (u % 16) * 64; kind = 1; Nvalid = 5632; }
    else if (u < 2992) { u -= 2288; src = p.ffn_out + (size_t)l * DFF * 1024; ldsrc = 1024; dst = p.WtF2; Kdst = DFF; n0 = (u / 44) * 64; k0 = (u % 44) * 64; Nvalid = 1024; }
    else if (u < 3008) { u -= 2992; const float* sp = p.gm_ws + (size_t)l * 65536 + u * 4096; bf16_t* d = p.WsB + u * 4096; for (int i = threadIdx.x; i < 512; i += 256) { const f32x4 x0 = *(const f32x4*)(sp + i * 8), x1 = *(const f32x4*)(sp + i * 8 + 4); u32x4 w; w.x = pack2(x0[0], x0[1]); w.y = pack2(x0[2], x0[3]); w.z = pack2(x1[0], x1[1]); w.w = pack2(x1[2], x1[3]); *(u32x4*)(d + i * 8) = w; } return; }
    else if (u < 3016) { u -= 3008; const int d = u >> 2; src = p.rw_w2 + ((size_t)l * 2 + d) * 64 * 256; ldsrc = 256; dst = p.W2t + d * 256 * 64; Kdst = 64; n0 = (u & 3) * 64; k0 = 0; Nvalid = 256; }
    else if (u < 3024) { u -= 3016; const int d = u >> 2; src = p.rw_a2 + ((size_t)l * 2 + d) * 64 * 256; ldsrc = 256; dst = p.A2t + d * 256 * 64; Kdst = 64; n0 = (u & 3) * 64; k0 = 0; Nvalid = 256; }
    else { u -= 3024; src = p.rw_g2 + (size_t)l * 128 * 256; ldsrc = 256; dst = p.G2t; Kdst = 128; n0 = (u / 2) * 64; k0 = (u % 2) * 64; Nvalid = 256; }
    conv_tile(src, ldsrc, dst, dst2, Kdst, n0, k0, kind, Nvalid, kscale, smem);
}
__device__ __forceinline__ void misc0_unit(const P& p, int u) {
    const int tid = opaque_tid();
    if (u < 16) {
        for (int e = tid; e < 4096; e += 256) { const int idx = u * 4096 + e; const int t = idx >> 4, i = idx & 15;
            const float pos = (float)((i < 8) ? (t >> 6) : (t & 63)); const float inv = exp2f(-(float)(i & 7) * 1.6609640474436813f);
            const float ang = pos * inv; const float kf = rintf(ang * 0.15915494309189535f);
            float r = fmaf(-kf, 6.28318548202514648f, ang); r = fmaf(-kf, -1.74845553e-7f, r);
            p.ropeC[idx] = __cosf(r); p.ropeS[idx] = __sinf(r); }
    } else {
        const int v = u - 16;
        for (int e = tid; e < 512; e += 256) { const int idx = v * 4096 + e * 8;
            const int c = idx & 127, t = (idx >> 7) & 511, b = (idx >> 16) & 3, l = idx >> 18;
            const float* sp = p.cache_ckv + (((size_t)b * 4 + l) * 512 + t) * 128 + c; const f32x4 x0 = *(const f32x4*)sp, x1 = *(const f32x4*)(sp + 4);
            u32x4 w; w.x = pack2(x0[0], x0[1]); w.y = pack2(x0[2], x0[3]); w.z = pack2(x1[0], x1[1]); w.w = pack2(x1[2], x1[3]);
            *(u32x4*)(p.CkvB + idx) = w; }
    }
}

__device__ __forceinline__ void ln_phase(const P& p, int l, int which) {
    const int tid = opaque_tid(), lane = tid & 63, wid = tid >> 6;
    const float* g = which == 1 ? p.ln1_g + l * DM : p.ln2_g + l * DM; const float* bb = which == 1 ? p.ln1_b + l * DM : p.ln2_b + l * DM;
    const int ml = which == 2 ? l + 1 : l; const int shoff = which == 1 ? 3072 : 0, scoff = which == 1 ? 4096 : 1024;
    const bool dohb = !(which == 2 && l == 3);
    for (int row = blockIdx.x * 4 + wid; row < M_ALL; row += gridDim.x * 4) {
        float* xr = p.out + (size_t)row * DM;
        const float* src = which == 0 ? (row < M_CTX ? p.x_prompt + (size_t)row * DM : p.x_sample + (size_t)(row - M_CTX) * DM) : xr;
        f32x4 v[4];
#pragma unroll
        for (int i = 0; i < 4; ++i) v[i] = *(const f32x4*)(src + lane * 4 + 256 * i);
        if (which != 0) {
            float s = 0.f;
#pragma unroll
            for (int i = 0; i < 4; ++i) s += (v[i][0] + v[i][1]) + (v[i][2] + v[i][3]);
            s = red16(s); s += __shfl_xor(s, 16); s += __shfl_xor(s, 32);
            const float mu = s * (1.0f / 1024.0f); float q = 0.f;
#pragma unroll
            for (int i = 0; i < 4; ++i) { const f32x4 d = v[i] - mu; q += (d[0] * d[0] + d[1] * d[1]) + (d[2] * d[2] + d[3] * d[3]); }
            q = red16(q); q += __shfl_xor(q, 16); q += __shfl_xor(q, 32);
            const float rstd = rsqrtf(q * (1.0f / 1024.0f) + 1e-5f);
#pragma unroll
            for (int i = 0; i < 4; ++i) { const f32x4 gg = *(const f32x4*)(g + lane * 4 + 256 * i), bv = *(const f32x4*)(bb + lane * 4 + 256 * i); v[i] = (v[i] - mu) * rstd * gg + bv; }
        }
#pragma unroll
        for (int i = 0; i < 4; ++i) *(f32x4*)(xr + lane * 4 + 256 * i) = v[i];
        if (dohb) {
            const float* md = p.mod + ((size_t)ml * 5 + modrow_of(row)) * 6144;
#pragma unroll
            for (int i = 0; i < 4; ++i) { const f32x4 sh = *(const f32x4*)(md + shoff + lane * 4 + 256 * i), sc = *(const f32x4*)(md + scoff + lane * 4 + 256 * i);
                const f32x4 h = v[i] * (1.0f + sc) + sh; u32x2 w; w.x = pack2(h[0], h[1]); w.y = pack2(h[2], h[3]);
                *(u32x2*)(p.hbmix + (size_t)row * DM + lane * 4 + 256 * i) = w; }
        }
    }
}

__device__ __forceinline__ void rwprep_unit(const P& p, int l, int u, char* smem) {
    const int tid = opaque_tid(), lane = tid & 63, wid = tid >> 6, fr = lane & 15, fq = lane >> 4;
    const int R0 = u * 64;
    const int ss = R0 < M_CTX ? (R0 & ~255) : M_CTX + ((R0 - M_CTX) & ~4095); const int se = ss + (R0 < M_CTX ? 256 : 4096);
    bf16_t* XW = (bf16_t*)smem; bf16_t* XA = XW + 64 * 136; bf16_t* XG = XA + 64 * 136;
    const float* cw = p.rw_conv + (size_t)l * 3 * 1152;
    for (int it = tid; it < 1152; it += 256) {
        const int cc = it % 144, tg = it / 144; const int c = cc * 8;
        float w0[8], w1[8], w2[8];
#pragma unroll
        for (int i = 0; i < 8; ++i) { w0[i] = cw[c + i]; w1[i] = cw[1152 + c + i]; w2[i] = cw[2304 + c + i]; }
        const int rfirst = R0 + tg * 8;
        u32x4 rows[10];
#pragma unroll
        for (int i = 0; i < 10; ++i) { const int r = rfirst - 1 + i; rows[i] = (u32x4){0u, 0u, 0u, 0u};
            if (r >= ss && r < se) rows[i] = *(const u32x4*)(p.Z + (size_t)r * NIN + c); }
#pragma unroll
        for (int tt = 0; tt < 8; ++tt) {
            const int row = rfirst + tt;
            const u32x4 prev = rows[tt], cur = rows[tt + 1], nxt = rows[tt + 2];
            float o[8];
#pragma unroll
            for (int i = 0; i < 4; ++i) {
                o[2 * i] = w0[2 * i] * lo_bf(prev[i]) + w1[2 * i] * lo_bf(cur[i]) + w2[2 * i] * lo_bf(nxt[i]);
                o[2 * i + 1] = w0[2 * i + 1] * hi_bf(prev[i]) + w1[2 * i + 1] * hi_bf(cur[i]) + w2[2 * i + 1] * hi_bf(nxt[i]);
            }
            if (c >= 768 && c < 896) {
#pragma unroll
                for (int i = 0; i < 8; ++i) o[i] = tanhf_(o[i]);
            } else if (c >= 1024) {
#pragma unroll
                for (int i = 0; i < 8; ++i) o[i] = sigmoidf_(o[i]);
            }
            u32x4 w; w.x = pack2(o[0], o[1]); w.y = pack2(o[2], o[3]); w.z = pack2(o[4], o[5]); w.w = pack2(o[6], o[7]);
            const int tl = tg * 8 + tt;
            if (c < 768) *(u32x4*)(p.RKV + (size_t)row * 768 + c) = w;
            else if (c < 896) *(u32x4*)(XW + tl * 136 + (c - 768)) = w;
            else if (c < 1024) *(u32x4*)(XA + tl * 136 + (c - 896)) = w;
            else *(u32x4*)(XG + tl * 136 + (c - 1024)) = w;
        }
    }
    __syncthreads();
#pragma unroll 1
    for (int mh = 0; mh < 10; ++mh) {
        const int mat = mh >> 1, nh = mh & 1;
        const int d = mat & 1; const bf16_t* As; const bf16_t* Bw; int kofs, nks, ldw;
        if (mat < 2) { As = XW; Bw = p.W2t + d * 256 * 64; kofs = d * 64; nks = 2; ldw = 64; }
        else if (mat < 4) { As = XA; Bw = p.A2t + d * 256 * 64; kofs = d * 64; nks = 2; ldw = 64; }
        else { As = XG; Bw = p.G2t; kofs = 0; nks = 4; ldw = 128; }
        f32x4 acc[4][2];
#pragma unroll
        for (int m = 0; m < 4; ++m)
#pragma unroll
            for (int n = 0; n < 2; ++n) acc[m][n] = (f32x4){0.f, 0.f, 0.f, 0.f};
        bf16x8 bw[4][2];
#pragma unroll
        for (int ks = 0; ks < 4; ++ks)
#pragma unroll
            for (int n = 0; n < 2; ++n) bw[ks][n] = *(const bf16x8*)(Bw + (size_t)(wid * 64 + nh * 32 + n * 16 + fr) * ldw + (ks < nks ? ks : 0) * 32 + fq * 8);
#pragma unroll
        for (int ks = 0; ks < 4; ++ks) {
            if (ks < nks) {
                bf16x8 af[4];
#pragma unroll
                for (int m = 0; m < 4; ++m) af[m] = *(const bf16x8*)(As + (m * 16 + fr) * 136 + kofs + ks * 32 + fq * 8);
#pragma unroll
                for (int m = 0; m < 4; ++m)
#pragma unroll
                    for (int n = 0; n < 2; ++n) acc[m][n] = __builtin_amdgcn_mfma_f32_16x16x32_bf16(bw[ks][n], af[m], acc[m][n], 0, 0, 0);
            }
        }
#pragma unroll
        for (int n = 0; n < 2; ++n) {
            const int c = wid * 64 + nh * 32 + n * 16 + fq * 4;
            f32x4 bias = (f32x4){0.f, 0.f, 0.f, 0.f}; if (mat < 2) bias = *(const f32x4*)(p.rw_w0 + (l * 2 + d) * 256 + c); else if (mat < 4) bias = *(const f32x4*)(p.rw_a0 + (l * 2 + d) * 256 + c);
            bf16_t* dst; float mul;
            if (mat < 2) { dst = p.Ee + ((size_t)d * M_ALL + R0) * 256 + c; mul = 0.6065306597126334f; }
            else if (mat < 4) { dst = p.Aa + ((size_t)d * M_ALL + R0) * 256 + c; mul = 1.0f; }
            else { dst = p.Gg + (size_t)R0 * 256 + c; mul = 1.0f; }
#pragma unroll
            for (int m = 0; m < 4; ++m) {
                float o[4];
#pragma unroll
                for (int j = 0; j < 4; ++j) { const float x = acc[m][n][j] + bias[j]; o[j] = mat < 4 ? mul * sigmoidf_(x) : x; }
                u32x2 w; w.x = pack2(o[0], o[1]); w.y = pack2(o[2], o[3]);
                *(u32x2*)(dst + (size_t)(m * 16 + fr) * 256) = w;
            }
        }
    }
    __syncthreads();
}
__device__ __forceinline__ void rowscale128(const bf16_t* Z, int R0, int zoff, int ncols, float eps, float* rs) {
    const int tid = opaque_tid(); const int r = tid >> 1, half = tid & 1; const int per = ncols >> 1;
    const bf16_t* zp = Z + (size_t)(R0 + r) * NIN + zoff + half * per;
    float ss = 0.f;
    for (int i = 0; i < per; i += 8) { const u32x4 w = *(const u32x4*)(zp + i);
#pragma unroll
        for (int q = 0; q < 4; ++q) { const float a = lo_bf(w[q]), b = hi_bf(w[q]); ss += a * a + b * b; } }
    ss = dpp_add<0xB1>(ss);
    if (half == 0) rs[r] = rsqrtf(ss / (float)ncols + eps);
}
__device__ __forceinline__ void small_unit(const P& p, int l, int u) {
    const int tid = opaque_tid(), sub = tid >> 5, li = tid & 31;
    if (u < 2560) {
        const int row = u * 8 + sub; const bf16_t* zr = p.Z + (size_t)row * NIN;
        const u32x2 w = *(const u32x2*)(zr + ZKV + li * 4);
        const float z0 = lo_bf(w.x), z1 = hi_bf(w.x), z2 = lo_bf(w.y), z3 = hi_bf(w.y);
        float ss = z0 * z0 + z1 * z1 + z2 * z2 + z3 * z3; ss = red16(ss); ss += __shfl_xor(ss, 16);
        const float rsv = rsqrtf(ss * (1.0f / 128.0f) + 1e-6f);
        const float x1 = bf2f(zr[ZKR + (li & 15)]), x2 = bf2f(zr[ZKR + 16 + (li & 15)]);
        float val;
        if (row < M_CTX) {
            const int b = row >> 8, t = row & 255; const size_t o = ((size_t)(b * 4 + l) * 256 + t);
            const f32x4 g = *(const f32x4*)(p.kv_norm + l * 128 + li * 4);
            *(f32x4*)(p.out + 20971520 + o * 128 + li * 4) = (f32x4){z0 * rsv * g[0], z1 * rsv * g[1], z2 * rsv * g[2], z3 * rsv * g[3]};
            val = li < 16 ? x1 : x2;
            p.out[20971520 + 2097152 + o * 32 + li] = val;
        } else {
            const int t = (row - M_CTX) & 4095; const float cv = p.ropeC[t * 16 + (li & 15)], sv = p.ropeS[t * 16 + (li & 15)];
            val = li < 16 ? x1 * cv - x2 * sv : x1 * sv + x2 * cv;
        }
        const bf16_t bv = f2bf(val);
#pragma unroll
        for (int h = 0; h < 8; ++h) p.Kb[(size_t)row * 768 + h * 96 + 64 + li] = bv;
    } else {
        const int r = (u - 2560) * 8 + sub; const int b = r >> 9, t = r & 511;
        const bf16_t bv = f2bf(p.cache_krope[((size_t)(b * 4 + l) * 512 + t) * 32 + li]);
#pragma unroll
        for (int h = 0; h < 8; ++h) p.Kc[(size_t)r * 768 + h * 96 + 64 + li] = bv;
    }
}
__device__ __forceinline__ void gmlp_unit(const P& p, int l, int u, char* smem) {
    const int tid = opaque_tid(), lane = tid & 63, wid = tid >> 6, fr = lane & 15, fq = lane >> 4;
    const int R0 = (u >> 2) * 128, g = u & 3;
    bf16_t* VnT = (bf16_t*)smem;
    bf16x8 wsf[4][2];
    { const bf16_t* Wg0 = p.WsB + g * 128 * 128;
#pragma unroll
      for (int ks = 0; ks < 4; ++ks)
#pragma unroll
        for (int m = 0; m < 2; ++m) wsf[ks][m] = *(const bf16x8*)(Wg0 + (wid * 32 + m * 16 + fr) * 128 + ks * 32 + fq * 8); }
    {
        const int tok = tid >> 1, half = tid & 1; const bf16_t* zp = p.Z + (size_t)(R0 + tok) * NIN + ZV + g * 64 + half * 32;
        float x[32];
#pragma unroll
        for (int i = 0; i < 4; ++i) { const u32x4 w = *(const u32x4*)(zp + i * 8);
#pragma unroll
            for (int q = 0; q < 4; ++q) { x[i * 8 + 2 * q] = geluf_(lo_bf(w[q])); x[i * 8 + 2 * q + 1] = geluf_(hi_bf(w[q])); } }
        float s = 0.f;
#pragma unroll
        for (int i = 0; i < 32; ++i) s += x[i];
        s = dpp_add<0xB1>(s); const float mu = s * (1.0f / 64.0f);
        float q2 = 0.f;
#pragma unroll
        for (int i = 0; i < 32; ++i) { const float d = x[i] - mu; q2 += d * d; }
        q2 = dpp_add<0xB1>(q2); const float rstd = rsqrtf(q2 * (1.0f / 64.0f) + 1e-5f);
        const float* gg = p.gm_g + l * 256 + g * 64 + half * 32; const float* gb = p.gm_b + l * 256 + g * 64 + half * 32;
#pragma unroll
        for (int i = 0; i < 32; ++i) VnT[(half * 32 + i) * 136 + tok] = f2bf((x[i] - mu) * rstd * gg[i] + gb[i]);
    }
    __syncthreads();
    f32x4 acc[2][4];
#pragma unroll
    for (int m = 0; m < 2; ++m)
#pragma unroll
        for (int n = 0; n < 4; ++n) acc[m][n] = (f32x4){0.f, 0.f, 0.f, 0.f};
#pragma unroll
    for (int ks = 0; ks < 4; ++ks) {
        bf16x8 bfr[4];
#pragma unroll
        for (int n = 0; n < 4; ++n) bfr[n] = *(const bf16x8*)(VnT + (n * 16 + fr) * 136 + ks * 32 + fq * 8);
#pragma unroll
        for (int m = 0; m < 2; ++m)
#pragma unroll
            for (int n = 0; n < 4; ++n) acc[m][n] = __builtin_amdgcn_mfma_f32_16x16x32_bf16(bfr[n], wsf[ks][m], acc[m][n], 0, 0, 0);
    }
#pragma unroll
    for (int m = 0; m < 2; ++m) {
        const int pp = wid * 32 + m * 16 + fr; const float bs = p.gm_bs[l * 512 + g * 128 + pp];
#pragma unroll
        for (int n = 0; n < 4; ++n) { const int c = n * 16 + fq * 4;
            const u32x2 zw = *(const u32x2*)(p.Z + (size_t)(R0 + pp) * NIN + ZU + g * 64 + c);
            const float u0 = geluf_(lo_bf(zw.x)), u1 = geluf_(hi_bf(zw.x)), u2 = geluf_(lo_bf(zw.y)), u3 = geluf_(hi_bf(zw.y));
            u32x2 w; w.x = pack2(u0 * (acc[m][n][0] + bs), u1 * (acc[m][n][1] + bs)); w.y = pack2(u2 * (acc[m][n][2] + bs), u3 * (acc[m][n][3] + bs));
            *(u32x2*)(p.hbmix + (size_t)(R0 + pp) * DM + 768 + g * 64 + c) = w; }
    }
    __syncthreads();
}

__device__ __forceinline__ float swap16_add(float x) {
    auto r = __builtin_amdgcn_permlane16_swap(__float_as_uint(x), __float_as_uint(x), false, false);
    return __uint_as_float(r[0]) + __uint_as_float(r[1]);
}
#define NSCAN_LAT 256
#define NSCAN (256 + 1024)
__device__ __forceinline__ void scan_unit(const P& p, int l, int u, char* smem) {
    const int tid = opaque_tid(), lane = tid & 63, wid = tid >> 6;
    int b, T, row0; const bool lat = u < NSCAN_LAT;
    if (lat) { b = u >> 6; T = 4096; row0 = M_CTX + b * 4096; } else { b = (u - NSCAN_LAT) >> 6; T = 256; row0 = b * 256; }
    const int h = (u >> 4) & 3, d = (u >> 3) & 1, rsl = u & 7;
    float* W = (float*)smem; float* NKK = W + 2048; float* KKA = NKK + 2048; float* KD = KKA + 2048; float* RR = KD + 2048; float* VS = RR + 2048; float* OUTP = VS + 256;
    const int rl = lane >> 5, kq = lane & 31; const int r8 = wid * 2 + rl; const int row = rsl * 8 + r8;
    f32x2 S = (f32x2){0.f, 0.f};
    const size_t stoff = ((((size_t)b * 4 + l) * 2 + d) * 4 + h) * 4096 + row * 64 + kq * 2;
    if (lat) S = *(const f32x2*)(p.state_rwkv + stoff);
    const int tok = tid >> 3, cg8 = tid & 7;
    float kkp[8], kap[8];
#pragma unroll
    for (int i = 0; i < 8; ++i) { kkp[i] = p.rw_kk[l * 256 + h * 64 + cg8 * 8 + i]; kap[i] = p.rw_ka[l * 256 + h * 64 + cg8 * 8 + i]; }
    const int nch = T >> 5;
    u32x4 r8v, k8, e8, a8, v8;
    int grow, grow_prev = 0; float oreg = 0.f;
    {
        const int sidx = tok; const int t = d ? T - 1 - sidx : sidx; grow = row0 + t;
        r8v = *(const u32x4*)(p.RKV + (size_t)grow * 768 + h * 64 + cg8 * 8);
        k8 = *(const u32x4*)(p.RKV + (size_t)grow * 768 + 256 + h * 64 + cg8 * 8);
        v8 = *(const u32x4*)(p.RKV + (size_t)grow * 768 + 512 + h * 64 + rsl * 8);
        e8 = *(const u32x4*)(p.Ee + ((size_t)d * M_ALL + grow) * 256 + h * 64 + cg8 * 8);
        a8 = *(const u32x4*)(p.Aa + ((size_t)d * M_ALL + grow) * 256 + h * 64 + cg8 * 8);
    }
    for (int ch = 0; ch < nch; ++ch) {
        {
            float kf[8], kkv[8], rf[8], ef[8], af[8];
#pragma unroll
            for (int q = 0; q < 4; ++q) { kf[2 * q] = lo_bf(k8[q]); kf[2 * q + 1] = hi_bf(k8[q]); rf[2 * q] = lo_bf(r8v[q]); rf[2 * q + 1] = hi_bf(r8v[q]);
                ef[2 * q] = lo_bf(e8[q]); ef[2 * q + 1] = hi_bf(e8[q]); af[2 * q] = lo_bf(a8[q]); af[2 * q + 1] = hi_bf(a8[q]); }
            float ss = 0.f;
#pragma unroll
            for (int i = 0; i < 8; ++i) { kkv[i] = kf[i] * kkp[i]; ss += kkv[i] * kkv[i]; }
            ss = red8(ss);
            const float inv = rsqrtf(fmaxf(ss, 1e-24f));
            f32x4 o0, o1; const int base = tok * 64 + cg8 * 8;
#pragma unroll
            for (int i = 0; i < 4; ++i) { o0[i] = __expf(-ef[i]); o1[i] = __expf(-ef[4 + i]); }
            *(f32x4*)(W + base) = o0; *(f32x4*)(W + base + 4) = o1;
#pragma unroll
            for (int i = 0; i < 4; ++i) { o0[i] = -kkv[i] * inv; o1[i] = -kkv[4 + i] * inv; }
            *(f32x4*)(NKK + base) = o0; *(f32x4*)(NKK + base + 4) = o1;
#pragma unroll
            for (int i = 0; i < 4; ++i) { o0[i] = kkv[i] * inv * af[i]; o1[i] = kkv[4 + i] * inv * af[4 + i]; }
            *(f32x4*)(KKA + base) = o0; *(f32x4*)(KKA + base + 4) = o1;
#pragma unroll
            for (int i = 0; i < 4; ++i) { o0[i] = kf[i] * (1.0f + (af[i] - 1.0f) * kap[i]); o1[i] = kf[4 + i] * (1.0f + (af[4 + i] - 1.0f) * kap[4 + i]); }
            *(f32x4*)(KD + base) = o0; *(f32x4*)(KD + base + 4) = o1;
#pragma unroll
            for (int i = 0; i < 4; ++i) { o0[i] = rf[i]; o1[i] = rf[4 + i]; }
            *(f32x4*)(RR + base) = o0; *(f32x4*)(RR + base + 4) = o1;
            if (cg8 == 0) {
#pragma unroll
                for (int q = 0; q < 4; ++q) { VS[tok * 8 + 2 * q] = lo_bf(v8[q]); VS[tok * 8 + 2 * q + 1] = hi_bf(v8[q]); }
            }
        }
        __syncthreads();
        if (ch > 0) p.ydir[((size_t)d * M_ALL + grow_prev) * 256 + h * 64 + rsl * 8 + cg8] = oreg;
        grow_prev = grow;
        if (ch + 1 < nch) {
            const int sidx = (ch + 1) * 32 + tok; const int t = d ? T - 1 - sidx : sidx; grow = row0 + t;
            r8v = *(const u32x4*)(p.RKV + (size_t)grow * 768 + h * 64 + cg8 * 8);
            k8 = *(const u32x4*)(p.RKV + (size_t)grow * 768 + 256 + h * 64 + cg8 * 8);
            v8 = *(const u32x4*)(p.RKV + (size_t)grow * 768 + 512 + h * 64 + rsl * 8);
            e8 = *(const u32x4*)(p.Ee + ((size_t)d * M_ALL + grow) * 256 + h * 64 + cg8 * 8);
            a8 = *(const u32x4*)(p.Aa + ((size_t)d * M_ALL + grow) * 256 + h * 64 + cg8 * 8);
        }
        {
            const float* Wq = W + kq * 2; const float* NKq = NKK + kq * 2; const float* KAq = KKA + kq * 2; const float* KDq = KD + kq * 2; const float* RRq = RR + kq * 2; const float* VSq = VS + r8;
            float* OPq = OUTP + r8 * 32 + kq;
            f32x2 wv[4], nkv[4], kav[4], kdv[4], rrv[4]; float vv[4];
#define SCAN_LD(slot, st) do { wv[slot] = *(const f32x2*)(Wq + (st) * 64); nkv[slot] = *(const f32x2*)(NKq + (st) * 64); kav[slot] = *(const f32x2*)(KAq + (st) * 64); \
        kdv[slot] = *(const f32x2*)(KDq + (st) * 64); rrv[slot] = *(const f32x2*)(RRq + (st) * 64); vv[slot] = VSq[(st) * 8]; } while (0)
            __builtin_amdgcn_s_setprio(3);
            SCAN_LD(0, 0); SCAN_LD(1, 1); SCAN_LD(2, 2);
#pragma unroll
            for (int s = 0; s < 32; ++s) {
                if (s + 3 < 32) SCAN_LD((s + 3) & 3, s + 3);
                const f32x2 w = wv[s & 3], nk = nkv[s & 3], ka = kav[s & 3], kd = kdv[s & 3], rr = rrv[s & 3]; const float v = vv[s & 3];
                float pd = fmaf(S[1], nk[1], S[0] * nk[0]);
                pd = red16(pd); pd = swap16_add(pd);
                S[0] = fmaf(S[0], w[0], fmaf(pd, ka[0], v * kd[0]));
                S[1] = fmaf(S[1], w[1], fmaf(pd, ka[1], v * kd[1]));
                OPq[s * 256] = fmaf(S[1], rr[1], S[0] * rr[0]);
            }
            __builtin_amdgcn_s_setprio(0);
        }
        __syncthreads();
        {
            const float* op = OUTP + (tok * 8 + cg8) * 32;
            f32x4 a0 = *(const f32x4*)(op), a1 = *(const f32x4*)(op + 4), a2 = *(const f32x4*)(op + 8), a3 = *(const f32x4*)(op + 12);
            f32x4 b0 = *(const f32x4*)(op + 16), b1 = *(const f32x4*)(op + 20), b2 = *(const f32x4*)(op + 24), b3 = *(const f32x4*)(op + 28);
            a0 = ((a0 + a1) + (a2 + a3)) + ((b0 + b1) + (b2 + b3));
            oreg = (a0[0] + a0[1]) + (a0[2] + a0[3]);
        }
    }
    p.ydir[((size_t)d * M_ALL + grow_prev) * 256 + h * 64 + rsl * 8 + cg8] = oreg;
    if (!lat) *(f32x2*)(p.out + 20971520 + 2097152 + 524288 + stoff) = S;
    __syncthreads();
}

#ifndef ATT_THR
#define ATT_THR 8.0f
#endif
#define KS_STRIDE 104
#define VS_STRIDE 68
#define KS_BYTES (64 * KS_STRIDE * 2)
#define ATT_STAGE (KS_BYTES + 64 * VS_STRIDE * 2)
__device__ __forceinline__ void attn_unit(const P& p, int u, char* smem) {
    const int tid = opaque_tid(), lane = tid & 63, wid = tid >> 6, q = lane & 31, hf = lane >> 5;
    int b, h, qt, qrow0, krow0, nown, ntot, Tv; size_t vbase, vcbase = 0; int kcrow0 = 0;
    if (u < 1024) { b = u >> 8; h = (u >> 5) & 7; qt = u & 31; krow0 = M_CTX + b * 4096; qrow0 = krow0 + qt * 128; nown = 64; ntot = 72; Tv = 4096;
        vbase = 2097152 + (size_t)(b * 8 + h) * 64 * 4096; kcrow0 = b * 512; vcbase = (size_t)(b * 8 + h) * 64 * 512; }
    else { const int v = u - 1024; b = v >> 4; h = (v >> 1) & 7; qt = v & 1; krow0 = b * 256; qrow0 = krow0 + qt * 128; nown = 4; ntot = 4; Tv = 256; vbase = (size_t)(b * 8 + h) * 64 * 256; }
    bf16x8 qf[6];
    { const bf16_t* qp = p.Qb + (size_t)(qrow0 + wid * 32 + q) * 768 + h * 96 + hf * 8;
#pragma unroll
      for (int ks = 0; ks < 6; ++ks) qf[ks] = *(const bf16x8*)(qp + ks * 16); }
    f32x16 oT[2];
#pragma unroll
    for (int i = 0; i < 16; ++i) { oT[0][i] = 0.f; oT[1][i] = 0.f; }
    float mref = 0.f, lrun = 0.f; f32x16 negm;
#pragma unroll
    for (int i = 0; i < 16; ++i) negm[i] = 0.f;
    u32x4 rk[3], rv[2];
    int krow[3], kc[3];
#pragma unroll
    for (int i = 0; i < 3; ++i) { const int c = tid + 256 * i; krow[i] = c / 12; kc[i] = c % 12; }
    const int vdv0 = tid >> 3, vkc = tid & 7;
#define ATT_LOAD(kt) do { const bf16_t* kptr; const bf16_t* vptr; int vstr; \
        if ((kt) < nown) { kptr = p.Kb + (size_t)(krow0 + (kt) * 64) * 768 + h * 96; vptr = p.Vt + vbase + (kt) * 64; vstr = Tv; } \
        else { kptr = p.Kc + (size_t)(kcrow0 + ((kt) - nown) * 64) * 768 + h * 96; vptr = p.Vtc + vcbase + ((kt) - nown) * 64; vstr = 512; } \
        _Pragma("unroll") for (int i = 0; i < 3; ++i) rk[i] = *(const u32x4*)(kptr + (size_t)krow[i] * 768 + kc[i] * 8); \
        _Pragma("unroll") for (int i = 0; i < 2; ++i) rv[i] = *(const u32x4*)(vptr + (size_t)(vdv0 + 32 * i) * vstr + vkc * 8); } while (0)
#define ATT_STORE(buf) do { char* Ks_ = smem + (buf) * ATT_STAGE; char* Vs_ = Ks_ + KS_BYTES; \
        _Pragma("unroll") for (int i = 0; i < 3; ++i) *(u32x4*)(Ks_ + (krow[i] * KS_STRIDE + kc[i] * 8) * 2) = rk[i]; \
        _Pragma("unroll") for (int i = 0; i < 2; ++i) { char* vd_ = Vs_ + ((vdv0 + 32 * i) * VS_STRIDE + vkc * 8) * 2; *(u32x2*)vd_ = (u32x2){rv[i].x, rv[i].y}; *(u32x2*)(vd_ + 8) = (u32x2){rv[i].z, rv[i].w}; } } while (0)
    ATT_LOAD(0); ATT_STORE(0);
    __syncthreads();
    for (int kt = 0; kt < ntot; ++kt) {
        const bool more = kt + 1 < ntot;
        if (more) ATT_LOAD(kt + 1);
        const char* Ks = smem + (kt & 1) * ATT_STAGE; const char* Vs = Ks + KS_BYTES;
        f32x16 sT[2];
#pragma unroll
        for (int kb = 0; kb < 2; ++kb)
#pragma unroll
            for (int ks = 0; ks < 6; ++ks) { const bf16x8 kf = *(const bf16x8*)(Ks + ((kb * 32 + q) * KS_STRIDE + ks * 16 + hf * 8) * 2);
                sT[kb] = __builtin_amdgcn_mfma_f32_32x32x16_bf16(kf, qf[ks], ks == 0 ? negm : sT[kb], 0, 0, 0); }
        bf16x8 pf[2][2]; float psum0 = 0.f;
#define ATT_EXP(kb_, acc_) do { _Pragma("unroll") for (int s_ = 0; s_ < 2; ++s_) { float e_[8]; \
            _Pragma("unroll") for (int j_ = 0; j_ < 8; ++j_) { e_[j_] = __builtin_amdgcn_exp2f(sT[kb_][8 * s_ + j_]); acc_ += e_[j_]; } \
            u32x4 w_; w_.x = pack2(e_[0], e_[1]); w_.y = pack2(e_[2], e_[3]); w_.z = pack2(e_[4], e_[5]); w_.w = pack2(e_[6], e_[7]); \
            pf[kb_][s_] = __builtin_bit_cast(bf16x8, w_); } } while (0)
        ATT_EXP(0, psum0);
        float mx = sT[0][0];
#pragma unroll
        for (int i = 1; i < 16; ++i) mx = fmaxf(mx, sT[0][i]);
#pragma unroll
        for (int i = 0; i < 16; ++i) mx = fmaxf(mx, sT[1][i]);
        { auto r_ = __builtin_amdgcn_permlane32_swap(__float_as_uint(mx), __float_as_uint(mx), false, false);
          mx = fmaxf(__uint_as_float(r_[0]), __uint_as_float(r_[1])); }
        const bool first = (kt == 0);
        if (first || __any(mx > ATT_THR)) {
            const float delta = first ? mx : ((mx > ATT_THR) ? mx : 0.f);
            const float alpha = first ? 0.f : __builtin_amdgcn_exp2f(-delta);
            mref += delta; lrun *= alpha;
#pragma unroll
            for (int i = 0; i < 16; ++i) { sT[0][i] -= delta; sT[1][i] -= delta; oT[0][i] *= alpha; oT[1][i] *= alpha; negm[i] = -mref; }
            psum0 = 0.f; ATT_EXP(0, psum0);
        }
        float psum1 = 0.f;
        ATT_EXP(1, psum1);
        lrun += psum0 + psum1;
#pragma unroll
        for (int kb = 0; kb < 2; ++kb)
#pragma unroll
            for (int s = 0; s < 2; ++s)
#pragma unroll
                for (int db = 0; db < 2; ++db) {
                    const char* vp = Vs + ((db * 32 + q) * VS_STRIDE + kb * 32 + 16 * s + 4 * hf) * 2;
                    const u32x2 lo = *(const u32x2*)vp, hi = *(const u32x2*)(vp + 16);
                    const u32x4 w = (u32x4){lo.x, lo.y, hi.x, hi.y};
                    oT[db] = __builtin_amdgcn_mfma_f32_32x32x16_bf16(__builtin_bit_cast(bf16x8, w), pf[kb][s], oT[db], 0, 0, 0);
                }
        if (more) ATT_STORE((kt + 1) & 1);
        __syncthreads();
    }
    const float lt = lrun + __shfl_xor(lrun, 32); const float inv = 1.0f / lt;
    bf16_t* op = p.hbmix + (size_t)(qrow0 + wid * 32 + q) * DM + 256 + h * 64;
#pragma unroll
    for (int db = 0; db < 2; ++db)
#pragma unroll
        for (int g = 0; g < 4; ++g) { u32x2 w; w.x = pack2(oT[db][4 * g] * inv, oT[db][4 * g + 1] * inv); w.y = pack2(oT[db][4 * g + 2] * inv, oT[db][4 * g + 3] * inv);
            *(u32x2*)(op + db * 32 + 8 * g + 4 * hf) = w; }
}

__device__ __forceinline__ void rwcomb_phase(const P& p, int l) {
    const int tid = opaque_tid(), lane = tid & 63, wid = tid >> 6; const int c = lane * 4;
    const f32x4 gng = *(const f32x4*)(p.rw_gn_g + l * 256 + c), gnb = *(const f32x4*)(p.rw_gn_b + l * 256 + c), kap = *(const f32x4*)(p.rw_ka + l * 256 + c), rkp = *(const f32x4*)(p.rw_rk + l * 256 + c);
    for (int row = blockIdx.x * 4 + wid; row < M_ALL; row += gridDim.x * 4) {
        const f32x4 y0 = *(const f32x4*)(p.ydir + (size_t)row * 256 + c), y1 = *(const f32x4*)(p.ydir + ((size_t)M_ALL + row) * 256 + c);
        f32x4 y = y0 + y1;
        float s = (y[0] + y[1]) + (y[2] + y[3]); s = red16(s); const float mu = s * (1.0f / 64.0f);
        const f32x4 dd = y - mu; float q2 = (dd[0] * dd[0] + dd[1] * dd[1]) + (dd[2] * dd[2] + dd[3] * dd[3]); q2 = red16(q2);
        const float rstd = rsqrtf(q2 * (1.0f / 64.0f) + 64e-5f);
        const f32x4 yn = dd * rstd * gng + gnb;
        const u32x2 rw = *(const u32x2*)(p.RKV + (size_t)row * 768 + c), kw = *(const u32x2*)(p.RKV + (size_t)row * 768 + 256 + c), vw = *(const u32x2*)(p.RKV + (size_t)row * 768 + 512 + c);
        const u32x2 a0w = *(const u32x2*)(p.Aa + (size_t)row * 256 + c), a1w = *(const u32x2*)(p.Aa + ((size_t)M_ALL + row) * 256 + c), gw = *(const u32x2*)(p.Gg + (size_t)row * 256 + c);
        const f32x4 r = (f32x4){lo_bf(rw.x), hi_bf(rw.x), lo_bf(rw.y), hi_bf(rw.y)}, k = (f32x4){lo_bf(kw.x), hi_bf(kw.x), lo_bf(kw.y), hi_bf(kw.y)}, v = (f32x4){lo_bf(vw.x), hi_bf(vw.x), lo_bf(vw.y), hi_bf(vw.y)};
        const f32x4 a0 = (f32x4){lo_bf(a0w.x), hi_bf(a0w.x), lo_bf(a0w.y), hi_bf(a0w.y)}, a1 = (f32x4){lo_bf(a1w.x), hi_bf(a1w.x), lo_bf(a1w.y), hi_bf(a1w.y)}, gt = (f32x4){lo_bf(gw.x), hi_bf(gw.x), lo_bf(gw.y), hi_bf(gw.y)};
        const f32x4 kds = k * (1.0f + (a0 - 1.0f) * kap) + k * (1.0f + (a1 - 1.0f) * kap);
        const f32x4 t4 = r * kds * rkp; float rk = (t4[0] + t4[1]) + (t4[2] + t4[3]); rk = red16(rk);
        const f32x4 o = (yn + rk * v) * gt;
        u32x2 w; w.x = pack2(o[0], o[1]); w.y = pack2(o[2], o[3]);
        *(u32x2*)(p.hbmix + (size_t)row * DM + c) = w;
    }
}


__device__ __forceinline__ bool xcd_tile(int i, int TT, int NT, int& mt, int& nt) {
    const int per = TT >> 3; if (i >= per) return false;
    const int t = (blockIdx.x & 7) * per + i; const int band = t / (8 * NT), rem = t - band * 8 * NT;
    nt = rem >> 3; mt = band * 8 + (rem & 7); return true;
}
__global__ void __launch_bounds__(256, 2) mega(Args a_unused) {
    extern __shared__ __attribute__((aligned(16))) char smem[];
    __shared__ uint4 xbw; __shared__ int s_unit;
    kargp_t kp = (kargp_t)__builtin_amdgcn_kernarg_segment_ptr();
    const int tid = threadIdx.x; const int G = gridDim.x;
    if (tid == 0) xbw = make_uint4(0u, 0u, 0u, 0u);
    __syncthreads();
    XcdBarrier xb;
    { const P p = getP(kp); xb = xcd_barrier_post(p.bar, (volatile LAS unsigned*)&xbw); }
    for (int u = blockIdx.x; u < NADA + NCONV + 272; u += G) {
        if (u < NADA) { const P p = getP(kp); ada_unit(p, u, smem); } else if (u < NADA + NCONV) { const P p = getP(kp); conv_unit(p, 0, u - NADA, smem); } else { const P p = getP(kp); misc0_unit(p, u - NADA - NCONV); }
    }
    cg::this_grid().sync();
    { const P p = getP(kp); ln_phase(p, 0, 0); }
    xcd_barrier(xb);
    float* rs = (float*)(smem + RS_OFF);
#pragma unroll 1
    for (int l = 0; l < 4; ++l) {
        for (int i = blockIdx.x >> 3; ; i += G >> 3) { int mt, nt; if (!xcd_tile(i, 80 * 17, 17, mt, nt)) break; const P p = getP(kp);
            EpiZ e{p.Z, mt * 256, nt * 128};
            gemm256(p.hbmix + (size_t)mt * 256 * DM, DM, p.WtIn + (size_t)nt * 128 * DM, DM, DM, smem, e); }
        xcd_barrier(xb);
        for (int rep2 = 0; rep2 < DUP_P2; ++rep2) {
        for (;;) {
            { const P pc = getP(kp); if (tid == 0) s_unit = atomicAdd(&pc.ctr[l * 4 + 0 + 2 * rep2], 1); }
            __syncthreads(); int u = s_unit; __syncthreads();
            if (u >= 320 + 480 + 640 + 64 + 352 + 640) break;
            if (u < 320) { const P p = getP(kp); rwprep_unit(p, l, u, smem); continue; }
            u -= 320;
            if (u < 480) { const P p = getP(kp); const int mt = u / 3, np = u % 3;
                rowscale128(p.Z, mt * 128, ZQ, 256, 1e-6f, rs);
                for (int k2 = 0; k2 < 2; ++k2) { const int nt = np * 2 + k2;
                    EpiQ e{p.Qb, rs, p.ropeC, p.ropeS, mt * 128, nt * 128};
                    gemm128<true>(p.Z + (size_t)mt * 128 * NIN + ZQ, NIN, p.WtQ + (size_t)nt * 128 * 256, 256, 256, smem, e); }
                __syncthreads(); continue; }
            u -= 480;
            if (u < 640) { const P p = getP(kp); const int mt = u >> 2, np = u & 3; const int R0 = mt * 128; const bool latr = R0 >= M_CTX;
                rowscale128(p.Z, R0, ZKV, 128, 1e-6f, rs);
                for (int k2 = 0; k2 < 2; ++k2) { const int nt = np * 2 + k2;
                    if (np < 2) { EpiKN e{latr ? p.Kb + (size_t)M_CTX * 768 : p.Kb, rs, latr ? R0 - M_CTX : R0, nt * 128};
                        gemm128<true>(p.Z + (size_t)R0 * NIN + ZKV, NIN, p.WtKVn + (size_t)nt * 128 * 128, 128, 128, smem, e); }
                    else { EpiKV e{latr ? p.Kb + (size_t)M_CTX * 768 : p.Kb, p.Vt, rs, latr ? R0 - M_CTX : R0, nt * 128, latr ? 12 : 8, latr ? (size_t)2097152 : (size_t)0};
                        gemm128<false>(p.Z + (size_t)R0 * NIN + ZKV, NIN, p.WtKVn + (size_t)nt * 128 * 128, 128, 128, smem, e); } }
                __syncthreads(); continue; }
            u -= 640;
            if (u < 64) { const P p = getP(kp); const int mt = u >> 2, np = u & 3;
                for (int k2 = 0; k2 < 2; ++k2) { const int nt = np * 2 + k2;
                    if (np < 2) { EpiKN e{p.Kc, nullptr, mt * 128, nt * 128};
                        gemm128<true>(p.CkvB + ((size_t)l * 2048 + mt * 128) * 128, 128, p.WtKV + (size_t)nt * 128 * 128, 128, 128, smem, e); }
                    else { EpiKV e{p.Kc, p.Vtc, nullptr, mt * 128, nt * 128, 9, (size_t)0};
                        gemm128<false>(p.CkvB + ((size_t)l * 2048 + mt * 128) * 128, 128, p.WtKV + (size_t)nt * 128 * 128, 128, 128, smem, e); } }
                continue; }
            u -= 64;
            if (u < 352) { const P p = getP(kp); for (int i = 0; i < 8; ++i) small_unit(p, l, u * 8 + i); continue; }
            u -= 352;
            { const P p = getP(kp); gmlp_unit(p, l, u, smem); }
        }
        xcd_barrier(xb);
        }
        for (int rep3 = 0; rep3 < DUP_P3; ++rep3) {
        for (;;) {
            { const P pc = getP(kp); if (tid == 0) s_unit = atomicAdd(&pc.ctr[l * 4 + 1 + 2 * rep3], 1); }
            __syncthreads(); int u = s_unit; __syncthreads();
            if (u >= NSCAN + 1280) break;
#ifdef PROBE_SCAN_ONLY
            if (rep3 == 1 && u >= NSCAN) break;
#endif
#ifdef PROBE_ATTN_ONLY
            if (rep3 == 1 && u < NSCAN) continue;
#endif
            if (u < NSCAN) { const P p = getP(kp); scan_unit(p, l, u, smem); } else { const P p = getP(kp); attn_unit(p, u - NSCAN, smem); }
        }
        xcd_barrier(xb);
        }
        { const P p = getP(kp); rwcomb_phase(p, l); }
        xcd_barrier(xb);
        for (int i = blockIdx.x >> 3; ; i += G >> 3) { int mt, nt; if (!xcd_tile(i, 160 * 8, 8, mt, nt)) break; const P p = getP(kp);
            EpiRes e{p.out, p.mod + ((size_t)l * 5 + modrow_of(mt * 128)) * 6144 + 2048, mt * 128, nt * 128};
            gemm128<true>(p.hbmix + (size_t)mt * 128 * DM, DM, p.WtOut + (size_t)nt * 128 * DM, DM, DM, smem, e); }
        xcd_barrier(xb);
        { const P p = getP(kp); ln_phase(p, l, 1); }
        xcd_barrier(xb);
        for (int rep5 = 0; rep5 < DUP_P5; ++rep5)
        for (int i = blockIdx.x >> 3; ; i += G >> 3) { int mt, nt; if (!xcd_tile(i, 80 * 44, 44, mt, nt)) break; const P p = getP(kp);
            EpiSwi e{p.hidden, mt * 256, nt * 128};
            gemm256(p.hbmix + (size_t)mt * 256 * DM, DM, p.WtF1 + (size_t)nt * 128 * DM, DM, DM, smem, e); }
        xcd_barrier(xb);
        for (int i = blockIdx.x >> 3; ; i += G >> 3) { int mt, nt; if (!xcd_tile(i, 160 * 8, 8, mt, nt)) break; const P p = getP(kp);
            EpiRes e{p.out, p.mod + ((size_t)l * 5 + modrow_of(mt * 128)) * 6144 + 5120, mt * 128, nt * 128};
            gemm128<true>(p.hidden + (size_t)mt * 128 * DFF, DFF, p.WtF2 + (size_t)nt * 128 * DFF, DFF, DFF, smem, e); }
        xcd_barrier(xb);
        { const P p = getP(kp); ln_phase(p, l, 2); }
        if (l < 3) { for (int u = blockIdx.x; u < NCONV; u += G) { const P p = getP(kp); conv_unit(p, l + 1, u, smem); } }
        xcd_barrier(xb);
    }
}

extern "C" void kernel_launch(void* const* d_in, const int* in_sizes, int n_in, void* d_out, int out_size, void* d_ws, size_t ws_size, hipStream_t stream) {
    static int grid_blocks = 0;
    if (!grid_blocks) {
        int dev = 0, cus = 0, per_cu = 0;
        (void)hipGetDevice(&dev);
        (void)hipDeviceGetAttribute(&cus, hipDeviceAttributeMultiprocessorCount, dev);
        (void)hipFuncSetAttribute((const void*)mega, hipFuncAttributeMaxDynamicSharedMemorySize, SMEM_BYTES);
        (void)hipOccupancyMaxActiveBlocksPerMultiprocessor(&per_cu, (const void*)mega, 256, SMEM_BYTES);
        if (per_cu > 2) per_cu = 2;
        if (per_cu < 1) per_cu = 1;
        grid_blocks = (cus * per_cu) & ~7;
    }
    if (WS_TOTAL > ws_size) { fprintf(stderr, "kernel_launch: workspace too small: need %zu have %zu\n", (size_t)WS_TOTAL, ws_size); return; }
    Args a{};
    for (int i = 0; i < 36; ++i) a.in[i] = (const float*)d_in[i];
    a.out = (float*)d_out; a.ws = (char*)d_ws;
    (void)hipMemsetAsync((char*)d_ws + OFF_BAR, 0, 16384 + 4096, stream);
    void* args[] = {&a};
    hipError_t e = hipLaunchCooperativeKernel((const void*)mega, dim3(grid_blocks), dim3(256), args, SMEM_BYTES, stream);
    if (e != hipSuccess) fprintf(stderr, "cooperative launch failed: %s (grid %d)\n", hipGetErrorString(e), grid_blocks);
}
```
